# Optimizing an MI355X kernel written in HIP

```python
import jax, jax.numpy as jnp
from jax import lax
import numpy as np

D_MODEL = 2048
BATCH = 2
SEQ = 4096
DEPTH = 2
DEC_BATCH = 128
DEC_SEQ = 1
PAST_LEN = 8192
PAGE_SIZE = 128

HEAD_DIM = 64
N_Q_HEADS = 16
N_KV_HEADS = 4
GROUP = N_Q_HEADS // N_KV_HEADS
ATTN_WIDTH = N_Q_HEADS * HEAD_DIM
KV_WIDTH = N_KV_HEADS * HEAD_DIM
WINDOW = 128
ATTN_BLOCK = WINDOW
ROPE_THETA = 10000.0
POOL_WIDTH = D_MODEL // 4
POOL_WINDOWS = (2, 4, 8, 16)
POOL_GROUPS = len(POOL_WINDOWS)
POOL_GROUP_WIDTH = POOL_WIDTH // POOL_GROUPS
POOL_PAD = max(POOL_WINDOWS) - 1
RWKV_HEAD_DIM = 64
RWKV_WIDTH = D_MODEL // 4
RWKV_HEADS = RWKV_WIDTH // RWKV_HEAD_DIM
DECAY_LORA = 96
ICLR_LORA = 96
GATE_LORA = 256
VRES_LORA = 32
RWKV_SPLITS = (RWKV_WIDTH, RWKV_WIDTH, RWKV_WIDTH, DECAY_LORA, ICLR_LORA, GATE_LORA)
RWKV_PROJ = sum(RWKV_SPLITS)
N_BRANCH = 3
IN_SPLITS = (ATTN_WIDTH, KV_WIDTH, KV_WIDTH, POOL_WIDTH, RWKV_PROJ, N_BRANCH * D_MODEL)
IN_WIDTH = sum(IN_SPLITS)
D_FF = ((8 * D_MODEL + 3 * 256 - 1) // (3 * 256)) * 256
RMS_EPS = 1e-6
LNX_EPS = 64e-5
NEG_INF = -1e30

kernel_name = 'hybrid_swa_pool_rwkv7_adaln_step'


def _split(z, sizes):
    idx = np.cumsum(sizes)[:-1].tolist()
    return jnp.split(z, idx, axis=-1)


def _rms_norm(x, g):
    xf = x.astype(jnp.float32)
    return xf * lax.rsqrt(jnp.mean(xf * xf, axis=-1, keepdims=True) + RMS_EPS) * g.astype(jnp.float32)


def _mod_norm(x, g, shift, scale):
    y = _rms_norm(x, g) * (1.0 + scale.astype(jnp.float32)) + shift.astype(jnp.float32)
    return y.astype(x.dtype)


def _rope(x, pos):
    half = HEAD_DIM // 2
    inv = ROPE_THETA ** (-jnp.arange(half, dtype=jnp.float32) * 2.0 / HEAD_DIM)
    ang = pos.astype(jnp.float32)[:, None] * inv[None, :]
    cos = jnp.cos(ang)[None, :, None, :]
    sin = jnp.sin(ang)[None, :, None, :]
    xf = x.astype(jnp.float32)
    x1, x2 = xf[..., :half], xf[..., half:]
    return jnp.concatenate([x1 * cos - x2 * sin, x2 * cos + x1 * sin], axis=-1).astype(x.dtype)


def _sink_softmax(s, mask, sink):
    sink = sink.astype(jnp.float32).reshape(N_KV_HEADS, GROUP, 1, 1)
    s = jnp.where(mask, s, NEG_INF)
    m = jnp.maximum(jnp.max(s, axis=-1, keepdims=True), sink)
    p = jnp.exp(s - m)
    return p / (jnp.sum(p, axis=-1, keepdims=True) + jnp.exp(sink - m))


def _attn_prompt(q, k, v, sink):
    B, T = q.shape[:2]
    nb = T // ATTN_BLOCK
    qb = q.reshape(B, nb, ATTN_BLOCK, N_KV_HEADS, GROUP, HEAD_DIM)

    def with_prev(t):
        tb = t.reshape(B, nb, ATTN_BLOCK, N_KV_HEADS, HEAD_DIM)
        prev = jnp.concatenate([jnp.zeros_like(tb[:, :1]), tb[:, :-1]], axis=1)
        return jnp.concatenate([prev, tb], axis=2)

    kw, vw = with_prev(k), with_prev(v)
    s = jnp.einsum('bnqhgd,bnkhd->bnhgqk', qb, kw).astype(jnp.float32) * (HEAD_DIM ** -0.5)
    blk = jnp.arange(nb)[:, None] * ATTN_BLOCK
    qpos = blk + jnp.arange(ATTN_BLOCK)[None, :]
    kpos = blk - ATTN_BLOCK + jnp.arange(2 * ATTN_BLOCK)[None, :]
    rel = qpos[:, :, None] - kpos[:, None, :]
    mask = (rel >= 0) & (rel <= WINDOW) & (kpos[:, None, :] >= 0)
    p = _sink_softmax(s, mask[None, :, None, None], sink)
    o = jnp.einsum('bnhgqk,bnkhd->bnqhgd', p, vw.astype(jnp.float32))
    return o.reshape(B, T, ATTN_WIDTH).astype(q.dtype)


def _attn_sample(q, k, v, k_buf, v_buf, q_pos, sink):
    B, S = q.shape[:2]
    L = k_buf.shape[1]
    k_all = jnp.concatenate([k_buf.astype(k.dtype), k], axis=1)
    v_all = jnp.concatenate([v_buf.astype(v.dtype), v], axis=1)
    kpos = jnp.concatenate([q_pos[0] - L + jnp.arange(L), q_pos])
    qg = q.reshape(B, S, N_KV_HEADS, GROUP, HEAD_DIM)
    s = jnp.einsum('bqhgd,bkhd->bhgqk', qg, k_all).astype(jnp.float32) * (HEAD_DIM ** -0.5)
    rel = q_pos[:, None] - kpos[None, :]
    mask = (rel >= 0) & (rel <= WINDOW)
    p = _sink_softmax(s, mask, sink)
    o = jnp.einsum('bhgqk,bkhd->bqhgd', p, v_all.astype(jnp.float32)).reshape(B, S, ATTN_WIDTH)
    return o.astype(q.dtype), k_all[:, -L:], v_all[:, -L:]


def _pool(u, u_prev, pos, pool_w, pool_scale):
    B, T, _ = u.shape
    u_ext = jnp.concatenate([u_prev.astype(u.dtype), u], axis=1)
    uf = u_ext.astype(jnp.float32)
    cs = jnp.concatenate([jnp.zeros((B, 1, POOL_WIDTH), jnp.float32), jnp.cumsum(uf, axis=1)], axis=1)
    end = cs[:, POOL_PAD + 1:]
    means = []
    for gi, w in enumerate(POOL_WINDOWS):
        lo, hi = gi * POOL_GROUP_WIDTH, (gi + 1) * POOL_GROUP_WIDTH
        start = cs[:, POOL_PAD + 1 - w:POOL_PAD + 1 - w + T, lo:hi]
        cnt = jnp.minimum(pos + 1, w).astype(jnp.float32)[None, :, None]
        means.append((end[..., lo:hi] - start) / cnt)
    d = jnp.concatenate(means, axis=-1) - uf[:, POOL_PAD:]
    z = jnp.einsum('btgc,gcd->btgd', d.reshape(B, T, POOL_GROUPS, POOL_GROUP_WIDTH), pool_w.astype(jnp.float32))
    z = z.reshape(B, T, POOL_WIDTH) * pool_scale.astype(jnp.float32)
    return z.astype(u.dtype), u_ext[:, -POOL_PAD:]


def _heads(t):
    return t.reshape(t.shape[:-1] + (RWKV_HEADS, RWKV_HEAD_DIM))


def _wkv_step(S, inp):
    r_t, w_t, k_t, v_t, a_t, b_t = inp
    sa = jnp.einsum('bhij,bhj->bhi', S, a_t)
    S = S * w_t[:, :, None, :] + sa[..., None] * b_t[:, :, None, :] + v_t[..., None] * k_t[:, :, None, :]
    return S, jnp.einsum('bhij,bhj->bhi', S, r_t)


def _rwkv(pr, shift_prev, wkv0, lp, vres, v_first):
    B, T, _ = pr.shape
    f32 = jnp.float32
    prev = jnp.concatenate([shift_prev[:, None, :].astype(pr.dtype), pr[:, :-1]], axis=1)
    xm = pr + (prev - pr) * lp['rwkv_mu']
    r, k, v, dw, da, dg = _split(xm, RWKV_SPLITS)
    w_log = -jax.nn.softplus(-(lp['rwkv_w0'] + jnp.tanh(dw) @ lp['rwkv_w2']).astype(f32)) - 0.5
    decay = jnp.exp(-jnp.exp(w_log))
    a = jax.nn.sigmoid((lp['rwkv_a0'] + da @ lp['rwkv_a2']).astype(f32))
    g = (jax.nn.sigmoid(dg) @ lp['rwkv_g2']).astype(f32)
    if vres is None:
        v_first = v
    else:
        vw1, vw2, vb = vres
        v = v + (v_first - v) * jax.nn.sigmoid(vb + (v @ vw1) @ vw2)
    r, k, v = r.astype(f32), k.astype(f32), v.astype(f32)
    kk = _heads(k * lp['rwkv_k_k'].astype(f32))
    kk = kk / jnp.maximum(jnp.sqrt(jnp.sum(kk * kk, axis=-1, keepdims=True)), 1e-12)
    k = k * (1.0 + (a - 1.0) * lp['rwkv_k_a'].astype(f32))
    rh, kh, vh, ah, wh = _heads(r), _heads(k), _heads(v), _heads(a), _heads(decay)
    seq = tuple(jnp.moveaxis(t, 1, 0) for t in (rh, wh, kh, vh, -kk, kk * ah))
    S, y = lax.scan(_wkv_step, wkv0.astype(f32), seq)
    y = jnp.moveaxis(y, 0, 1)
    mu = jnp.mean(y, axis=-1, keepdims=True)
    var = jnp.mean(jnp.square(y - mu), axis=-1, keepdims=True)
    y = ((y - mu) * lax.rsqrt(var + LNX_EPS)).reshape(B, T, RWKV_WIDTH)
    y = y * lp['rwkv_lnx_g'].astype(f32) + lp['rwkv_lnx_b'].astype(f32)
    bonus = jnp.sum(rh * kh * lp['rwkv_r_k'].astype(f32), axis=-1, keepdims=True) * vh
    y = (y + bonus.reshape(B, T, RWKV_WIDTH)) * g
    return y.astype(pr.dtype), v_first, pr[:, -1], S


def _layer(x, c, pos, lp, vres, v_first, past):
    B, T, _ = x.shape
    mod = jax.nn.silu(c) @ lp['ada_w'] + lp['ada_b']
    sh1, sc1, gt1, sh2, sc2, gt2 = jnp.split(mod[:, None, :], 6, axis=-1)
    h = _mod_norm(x, lp['norm1_g'], sh1, sc1)
    q, k, v, u, pr, gl = _split(h @ lp['w_in'], IN_SPLITS)
    q = _rope(q.reshape(B, T, N_Q_HEADS, HEAD_DIM), pos)
    k = _rope(k.reshape(B, T, N_KV_HEADS, HEAD_DIM), pos)
    v = v.reshape(B, T, N_KV_HEADS, HEAD_DIM)
    if past is None:
        o_attn = _attn_prompt(q, k, v, lp['attn_sink'])
        k_new, v_new = k[:, -WINDOW:], v[:, -WINDOW:]
        pool_prev = jnp.zeros((B, POOL_PAD, POOL_WIDTH), x.dtype)
        shift_prev = jnp.zeros((B, RWKV_PROJ), x.dtype)
        wkv0 = jnp.zeros((B, RWKV_HEADS, RWKV_HEAD_DIM, RWKV_HEAD_DIM), jnp.float32)
    else:
        k_buf, v_buf, pool_prev, shift_prev, wkv0 = past
        o_attn, k_new, v_new = _attn_sample(q, k, v, k_buf, v_buf, pos, lp['attn_sink'])
    z_pool, pool_new = _pool(u, pool_prev, pos, lp['pool_w'], lp['pool_scale'])
    y_rwkv, v_first, shift_new, wkv_new = _rwkv(pr, shift_prev, wkv0, lp, vres, v_first)
    g_attn, g_pool, g_rwkv = jnp.split(jax.nn.sigmoid(gl), N_BRANCH, axis=-1)
    merged = (g_attn * (o_attn @ lp['w_attn_out'])
              + g_pool * (z_pool @ lp['w_pool_out'])
              + g_rwkv * (y_rwkv @ lp['w_rwkv_out']))
    x = x + (1.0 + gt1) * (merged @ lp['w_o'])
    h2 = _mod_norm(x, lp['norm2_g'], sh2, sc2)
    ffn = (jax.nn.silu(h2 @ lp['w_ffn_gate']) * (h2 @ lp['w_ffn_up'])) @ lp['w_ffn_down']
    x = x + (1.0 + gt2) * ffn
    return x, v_first, (k_new, v_new, pool_new, shift_new, wkv_new)


def _trunk(x, c, pos, layers, vres, pasts, final_g):
    v_first = None
    new = []
    for l in range(DEPTH):
        x, v_first, st = _layer(x, c, pos, layers[l], vres[l], v_first, pasts[l])
        new.append(st)
    y = _rms_norm(x, final_g).astype(x.dtype)
    return y, [jnp.stack([s[i] for s in new]) for i in range(5)]


def setup_inputs(seed: int = 0) -> dict:
    key = jax.random.key(seed)
    ks = iter(jax.random.split(key, 48))
    f32 = jnp.float32

    def nrm(shape, scale):
        return jax.random.normal(next(ks), shape, f32) * scale

    def gain(shape, s=0.02):
        return 1.0 + nrm(shape, s)

    L = DEPTH
    win_len = min(WINDOW, PAST_LEN)
    return {
        'x_prompt': nrm((BATCH, SEQ, D_MODEL), 1.0),
        'x_sample': nrm((DEC_BATCH, DEC_SEQ, D_MODEL), 1.0),
        'c_prompt': nrm((BATCH, D_MODEL), 1.0),
        'c_sample': nrm((DEC_BATCH, D_MODEL), 1.0),
        'cache_k_win': nrm((L, DEC_BATCH, win_len, N_KV_HEADS, HEAD_DIM), 1.0),
        'cache_v_win': nrm((L, DEC_BATCH, win_len, N_KV_HEADS, HEAD_DIM), 1.0),
        'state_pool': nrm((L, DEC_BATCH, POOL_PAD, POOL_WIDTH), 1.0),
        'state_shift': nrm((L, DEC_BATCH, RWKV_PROJ), 1.0),
        'state_wkv': nrm((L, DEC_BATCH, RWKV_HEADS, RWKV_HEAD_DIM, RWKV_HEAD_DIM), 0.3),
        'ada_w': nrm((L, D_MODEL, 6 * D_MODEL), 0.5 * D_MODEL ** -0.5),
        'ada_b': nrm((L, 6 * D_MODEL), 0.02),
        'norm1_g': gain((L, D_MODEL)),
        'norm2_g': gain((L, D_MODEL)),
        'w_in': nrm((L, D_MODEL, IN_WIDTH), D_MODEL ** -0.5),
        'attn_sink': nrm((L, N_Q_HEADS), 1.0),
        'w_attn_out': nrm((L, ATTN_WIDTH, D_MODEL), ATTN_WIDTH ** -0.5),
        'pool_w': nrm((L, POOL_GROUPS, POOL_GROUP_WIDTH, POOL_GROUP_WIDTH), POOL_GROUP_WIDTH ** -0.5),
        'pool_scale': gain((L, POOL_WIDTH), 0.1),
        'w_pool_out': nrm((L, POOL_WIDTH, D_MODEL), POOL_WIDTH ** -0.5),
        'rwkv_mu': jax.random.uniform(next(ks), (L, RWKV_PROJ), f32),
        'rwkv_w0': -0.5 + nrm((L, RWKV_WIDTH), 0.5),
        'rwkv_w2': nrm((L, DECAY_LORA, RWKV_WIDTH), 0.5 * DECAY_LORA ** -0.5),
        'rwkv_a0': nrm((L, RWKV_WIDTH), 0.1),
        'rwkv_a2': nrm((L, ICLR_LORA, RWKV_WIDTH), 0.5 * ICLR_LORA ** -0.5),
        'rwkv_g2': nrm((L, GATE_LORA, RWKV_WIDTH), GATE_LORA ** -0.5),
        'rwkv_k_k': 0.85 + nrm((L, RWKV_WIDTH), 0.05),
        'rwkv_k_a': gain((L, RWKV_WIDTH), 0.05),
        'rwkv_r_k': nrm((L, RWKV_HEADS, RWKV_HEAD_DIM), 0.1),
        'rwkv_lnx_g': gain((L, RWKV_WIDTH)),
        'rwkv_lnx_b': nrm((L, RWKV_WIDTH), 0.01),
        'w_rwkv_out': nrm((L, RWKV_WIDTH, D_MODEL), RWKV_WIDTH ** -0.5),
        'vres_w1': nrm((L - 1, RWKV_WIDTH, VRES_LORA), RWKV_WIDTH ** -0.5),
        'vres_w2': nrm((L - 1, VRES_LORA, RWKV_WIDTH), VRES_LORA ** -0.5),
        'vres_b': nrm((L - 1, RWKV_WIDTH), 0.1),
        'w_o': nrm((L, D_MODEL, D_MODEL), D_MODEL ** -0.5),
        'w_ffn_gate': nrm((L, D_MODEL, D_FF), D_MODEL ** -0.5),
        'w_ffn_up': nrm((L, D_MODEL, D_FF), D_MODEL ** -0.5),
        'w_ffn_down': nrm((L, D_FF, D_MODEL), D_FF ** -0.5),
        'final_norm_g': gain((D_MODEL,)),
    }


def reference(x_prompt, x_sample, c_prompt, c_sample, cache_k_win, cache_v_win, state_pool, state_shift, state_wkv,
              ada_w, ada_b, norm1_g, norm2_g, w_in, attn_sink, w_attn_out, pool_w, pool_scale, w_pool_out,
              rwkv_mu, rwkv_w0, rwkv_w2, rwkv_a0, rwkv_a2, rwkv_g2, rwkv_k_k, rwkv_k_a, rwkv_r_k,
              rwkv_lnx_g, rwkv_lnx_b, w_rwkv_out, vres_w1, vres_w2, vres_b, w_o,
              w_ffn_gate, w_ffn_up, w_ffn_down, final_norm_g):
    layers = [dict(ada_w=ada_w[l], ada_b=ada_b[l], norm1_g=norm1_g[l], norm2_g=norm2_g[l], w_in=w_in[l],
                   attn_sink=attn_sink[l], w_attn_out=w_attn_out[l], pool_w=pool_w[l], pool_scale=pool_scale[l],
                   w_pool_out=w_pool_out[l], rwkv_mu=rwkv_mu[l], rwkv_w0=rwkv_w0[l], rwkv_w2=rwkv_w2[l],
                   rwkv_a0=rwkv_a0[l], rwkv_a2=rwkv_a2[l], rwkv_g2=rwkv_g2[l], rwkv_k_k=rwkv_k_k[l],
                   rwkv_k_a=rwkv_k_a[l], rwkv_r_k=rwkv_r_k[l], rwkv_lnx_g=rwkv_lnx_g[l], rwkv_lnx_b=rwkv_lnx_b[l],
                   w_rwkv_out=w_rwkv_out[l], w_o=w_o[l], w_ffn_gate=w_ffn_gate[l], w_ffn_up=w_ffn_up[l],
                   w_ffn_down=w_ffn_down[l])
              for l in range(DEPTH)]
    vres = [None] + [(vres_w1[l - 1], vres_w2[l - 1], vres_b[l - 1]) for l in range(1, DEPTH)]
    pasts = [(cache_k_win[l], cache_v_win[l], state_pool[l], state_shift[l], state_wkv[l]) for l in range(DEPTH)]
    pos_p = jnp.arange(x_prompt.shape[1])
    pos_s = PAST_LEN + jnp.arange(x_sample.shape[1])
    y_prompt, st_p = _trunk(x_prompt, c_prompt, pos_p, layers, vres, [None] * DEPTH, final_norm_g)
    y_sample, st_s = _trunk(x_sample, c_sample, pos_s, layers, vres, pasts, final_norm_g)
    k_win_p, v_win_p, pool_p, shift_p, wkv_p = st_p
    k_win_s, v_win_s, pool_s, shift_s, wkv_s = st_s
    return (y_prompt, y_sample, k_win_p, v_win_p, pool_p, shift_p, wkv_p, k_win_s, v_win_s, pool_s, shift_s, wkv_s)
```

```cpp
#include <hip/hip_runtime.h>
#include <cstdio>
namespace nv {
constexpr int D = 2048, SEQ = 4096, NB = 2, MP = NB * SEQ, NS = 128, M = MP + NS, NL = 2;
constexpr int INW = 10176, OQ = 0, OK_ = 1024, OV = 1280, OU = 1536, OPR = 2048, OGL = 4032;
constexpr int RP = 1984, DFF = 5632, NMOD = NB + NS;
constexpr int PASTLEN = 8192;

__device__ __forceinline__ float sigm(float x) { return 1.f / (1.f + expf(-x)); }
__device__ __forceinline__ float silu(float x) { return x / (1.f + expf(-x)); }
__device__ __forceinline__ int modrow(int m) { return m < MP ? m / SEQ : NB + (m - MP); }
__device__ __forceinline__ int posof(int m) { return m < MP ? m % SEQ : PASTLEN; }

__global__ void __launch_bounds__(256) gemm(const float* __restrict__ A, int lda, const float* __restrict__ B, int ldb, float* __restrict__ C, int ldc, int Mm, int N, int K) {
    __shared__ float As[16][68], Bs[16][68];
    const int tx = threadIdx.x & 15, ty = threadIdx.x >> 4, m0 = blockIdx.y * 64, n0 = blockIdx.x * 64;
    float acc[4][4];
#pragma unroll
    for (int i = 0; i < 4; ++i)
#pragma unroll
        for (int j = 0; j < 4; ++j) acc[i][j] = 0.f;
    for (int k0 = 0; k0 < K; k0 += 16) {
        for (int i = threadIdx.x; i < 1024; i += 256) { const int r = i >> 4, c = i & 15; As[c][r] = (m0 + r < Mm) ? A[(size_t)(m0 + r) * lda + k0 + c] : 0.f; }
        for (int i = threadIdx.x; i < 1024; i += 256) { const int r = i >> 6, c = i & 63; Bs[r][c] = (n0 + c < N) ? B[(size_t)(k0 + r) * ldb + n0 + c] : 0.f; }
        __syncthreads();
#pragma unroll
        for (int kk = 0; kk < 16; ++kk) {
            float a[4], b[4];
#pragma unroll
            for (int i = 0; i < 4; ++i) { a[i] = As[kk][ty * 4 + i]; b[i] = Bs[kk][tx * 4 + i]; }
#pragma unroll
            for (int i = 0; i < 4; ++i)
#pragma unroll
                for (int j = 0; j < 4; ++j) acc[i][j] += a[i] * b[j];
        }
        __syncthreads();
    }
#pragma unroll
    for (int i = 0; i < 4; ++i)
#pragma unroll
        for (int j = 0; j < 4; ++j) { const int m = m0 + ty * 4 + i, n = n0 + tx * 4 + j; if (m < Mm && n < N) C[(size_t)m * ldc + n] = acc[i][j]; }
}

__global__ void silu_c(const float* cp, const float* cs, float* out) {
    const int i = blockIdx.x * blockDim.x + threadIdx.x; if (i >= NMOD * D) return;
    const int r = i / D, k = i % D; const float c = r < NB ? cp[r * D + k] : cs[(r - NB) * D + k]; out[i] = silu(c);
}
__global__ void add_bias(float* mod, const float* b, int n, int N) { const int i = blockIdx.x * blockDim.x + threadIdx.x; if (i < n) mod[i] += b[i % N]; }

__global__ void __launch_bounds__(256) modnorm(const float* xa, const float* xb, const float* g, const float* mod, int sh_off, int sc_off, float* out, size_t out_split_off) {
    const int m = blockIdx.x; const float* x = m < MP ? xa + (size_t)m * D : xb + (size_t)(m - MP) * D;
    __shared__ float red[256]; float s = 0.f;
    for (int k = threadIdx.x; k < D; k += 256) { const float v = x[k]; s += v * v; }
    red[threadIdx.x] = s; __syncthreads();
    for (int o = 128; o > 0; o >>= 1) { if (threadIdx.x < o) red[threadIdx.x] += red[threadIdx.x + o]; __syncthreads(); }
    const float rs = rsqrtf(red[0] / D + 1e-6f); const int br = modrow(m);
    float* o = m < MP ? out + (size_t)m * D : out + out_split_off + (size_t)(m - MP) * D;
    for (int k = threadIdx.x; k < D; k += 256) { float v = x[k] * rs * g[k]; if (mod) v = v * (1.f + mod[(size_t)br * 6 * D + sc_off + k]) + mod[(size_t)br * 6 * D + sh_off + k]; o[k] = v; }
}

__global__ void rope(float* z) {
    const int i = blockIdx.x * blockDim.x + threadIdx.x; if (i >= M * 20 * 32) return;
    const int m = i / 640, hh = (i / 32) % 20, d = i % 32; const float pos = (float)posof(m);
    const float inv = powf(10000.f, -(float)d * 2.0f / 64.f), ang = pos * inv, c = cosf(ang), s = sinf(ang);
    float* p = z + (size_t)m * INW + hh * 64; const float x1 = p[d], x2 = p[d + 32]; p[d] = x1 * c - x2 * s; p[d + 32] = x2 * c + x1 * s;
}

__global__ void attn_prompt(const float* z, const float* sink, float* oattn) {
    const int i = blockIdx.x * blockDim.x + threadIdx.x; if (i >= MP * 16) return;
    const int m = i / 16, hq = i % 16, hk = hq / 4, t = m % SEQ; const float* q = z + (size_t)m * INW + OQ + hq * 64;
    const int lo = t - 128 < 0 ? 0 : t - 128; const float sk = sink[hq];
    float mx = sk;
    for (int kp = lo; kp <= t; ++kp) { const float* k = z + (size_t)(m - t + kp) * INW + OK_ + hk * 64; float s = 0.f; for (int d = 0; d < 64; ++d) s += q[d] * k[d]; s *= 0.125f; mx = fmaxf(mx, s); }
    float den = expf(sk - mx); float o[64];
#pragma unroll
    for (int d = 0; d < 64; ++d) o[d] = 0.f;
    for (int kp = lo; kp <= t; ++kp) { const float* k = z + (size_t)(m - t + kp) * INW + OK_ + hk * 64; const float* v = z + (size_t)(m - t + kp) * INW + OV + hk * 64; float s = 0.f; for (int d = 0; d < 64; ++d) s += q[d] * k[d]; s *= 0.125f;
        const float p = expf(s - mx); den += p;
#pragma unroll
        for (int d = 0; d < 64; ++d) o[d] += p * v[d]; }
#pragma unroll
    for (int d = 0; d < 64; ++d) oattn[(size_t)m * 1024 + hq * 64 + d] = o[d] / den;
}
__global__ void attn_sample(const float* z, const float* sink, const float* ck, const float* cv, float* oattn) {
    const int i = blockIdx.x * blockDim.x + threadIdx.x; if (i >= NS * 16) return;
    const int s_ = i / 16, hq = i % 16, hk = hq / 4, m = MP + s_; const float* q = z + (size_t)m * INW + OQ + hq * 64; const float sk = sink[hq];
    float mx = sk;
    for (int j = 0; j <= 128; ++j) { const float* k = j < 128 ? ck + ((size_t)(s_ * 128 + j) * 4 + hk) * 64 : z + (size_t)m * INW + OK_ + hk * 64; float s = 0.f; for (int d = 0; d < 64; ++d) s += q[d] * k[d]; s *= 0.125f; mx = fmaxf(mx, s); }
    float den = expf(sk - mx); float o[64];
#pragma unroll
    for (int d = 0; d < 64; ++d) o[d] = 0.f;
    for (int j = 0; j <= 128; ++j) { const float* k = j < 128 ? ck + ((size_t)(s_ * 128 + j) * 4 + hk) * 64 : z + (size_t)m * INW + OK_ + hk * 64;
        const float* v = j < 128 ? cv + ((size_t)(s_ * 128 + j) * 4 + hk) * 64 : z + (size_t)m * INW + OV + hk * 64; float s = 0.f; for (int d = 0; d < 64; ++d) s += q[d] * k[d]; s *= 0.125f;
        const float p = expf(s - mx); den += p;
#pragma unroll
        for (int d = 0; d < 64; ++d) o[d] += p * v[d]; }
#pragma unroll
    for (int d = 0; d < 64; ++d) oattn[(size_t)m * 1024 + hq * 64 + d] = o[d] / den;
}
__global__ void kv_out(const float* z, const float* ck, const float* cv, float* kp, float* vp, float* ks, float* vs) {
    const int i = blockIdx.x * blockDim.x + threadIdx.x;
    if (i < NB * 128 * 256) { const int b = i / (128 * 256), j = (i / 256) % 128, c = i % 256; const size_t m = (size_t)b * SEQ + SEQ - 128 + j; kp[i] = z[m * INW + OK_ + c]; vp[i] = z[m * INW + OV + c]; }
    if (i < NS * 128 * 256) { const int s_ = i / (128 * 256), j = (i / 256) % 128, c = i % 256;
        if (j < 127) { ks[i] = ck[i + 256]; vs[i] = cv[i + 256]; } else { ks[i] = z[(size_t)(MP + s_) * INW + OK_ + c]; vs[i] = z[(size_t)(MP + s_) * INW + OV + c]; } }
}
__global__ void pool_d(const float* z, const float* spool, float* dbuf) {
    const int i = blockIdx.x * blockDim.x + threadIdx.x; if (i >= M * 512) return;
    const int m = i / 512, c = i % 512, gi = c / 128, w = 2 << gi; float sum = 0.f; float cnt;
    if (m < MP) { const int t = m % SEQ; for (int j = 0; j < w; ++j) if (t - j >= 0) sum += z[(size_t)(m - j) * INW + OU + c]; cnt = (float)(t + 1 < w ? t + 1 : w); }
    else { const int s_ = m - MP; sum = z[(size_t)m * INW + OU + c]; for (int j = 1; j < w; ++j) sum += spool[((size_t)s_ * 15 + 15 - j) * 512 + c]; cnt = (float)w; }
    dbuf[i] = sum / cnt - z[(size_t)m * INW + OU + c];
}
__global__ void pool_z(const float* dbuf, const float* pw, const float* pscale, float* zpool) {
    const int i = blockIdx.x * blockDim.x + threadIdx.x; if (i >= M * 512) return;
    const int m = i / 512, c = i % 512, gi = c / 128, e = c % 128; float s = 0.f;
    for (int k = 0; k < 128; ++k) s += dbuf[(size_t)m * 512 + gi * 128 + k] * pw[(gi * 128 + k) * 128 + e];
    zpool[i] = s * pscale[c];
}
__global__ void pool_out(const float* z, const float* spool, float* pp, float* ps) {
    const int i = blockIdx.x * blockDim.x + threadIdx.x;
    if (i < NB * 15 * 512) { const int b = i / (15 * 512), j = (i / 512) % 15, c = i % 512; pp[i] = z[((size_t)b * SEQ + SEQ - 15 + j) * INW + OU + c]; }
    if (i < NS * 15 * 512) { const int s_ = i / (15 * 512), j = (i / 512) % 15, c = i % 512; ps[i] = j < 14 ? spool[i + 512] : z[(size_t)(MP + s_) * INW + OU + c]; }
}
__global__ void rwkv_xm(const float* z, const float* sshift, const float* mu, float* xm) {
    const int i = blockIdx.x * blockDim.x + threadIdx.x; if (i >= M * RP) return;
    const int m = i / RP, c = i % RP; const float p = z[(size_t)m * INW + OPR + c]; float pv;
    if (m < MP) pv = (m % SEQ) ? z[(size_t)(m - 1) * INW + OPR + c] : 0.f; else pv = sshift[(size_t)(m - MP) * RP + c];
    xm[i] = p + (pv - p) * mu[c];
}
__global__ void shift_out(const float* z, float* sp, float* ss) {
    const int i = blockIdx.x * blockDim.x + threadIdx.x;
    if (i < NB * RP) { const int b = i / RP, c = i % RP; sp[i] = z[((size_t)b * SEQ + SEQ - 1) * INW + OPR + c]; }
    if (i < NS * RP) { const int s_ = i / RP, c = i % RP; ss[i] = z[(size_t)(MP + s_) * INW + OPR + c]; }
}
__global__ void __launch_bounds__(64) rwkv_prep(const float* xm, const float* w0, const float* w2, const float* a0, const float* a2, const float* g2, const float* k_k, const float* k_a,
                                                 const float* T2, const float* vb, float* vfirst, int has_vres,
                                                 float* R, float* W, float* Kk, float* V, float* A, float* Bb, float* G) {
    const int m = blockIdx.x / 8, h = blockIdx.x % 8, c = h * 64 + threadIdx.x; const float* x = xm + (size_t)m * RP;
    float s = w0[c]; for (int k = 0; k < 96; ++k) s += tanhf(x[1536 + k]) * w2[k * 512 + c];
    const float z_ = -s; const float sp = z_ > 20.f ? z_ : log1pf(expf(z_)); const float wlog = -sp - 0.5f; const float decay = expf(-expf(wlog));
    float sa = a0[c]; for (int k = 0; k < 96; ++k) sa += x[1632 + k] * a2[k * 512 + c]; const float a = sigm(sa);
    float g = 0.f; for (int k = 0; k < 256; ++k) g += sigm(x[1728 + k]) * g2[k * 512 + c];
    float v = x[1024 + c];
    if (!has_vres) vfirst[(size_t)m * 512 + c] = v;
    else { const float acc = vb[c] + T2[(size_t)m * 512 + c]; v = v + (vfirst[(size_t)m * 512 + c] - v) * sigm(acc); }
    const float r = x[c], k = x[512 + c]; float kk = k * k_k[c];
    __shared__ float red[64]; red[threadIdx.x] = kk * kk; __syncthreads();
    for (int o = 32; o > 0; o >>= 1) { if (threadIdx.x < o) red[threadIdx.x] += red[threadIdx.x + o]; __syncthreads(); }
    kk = kk / fmaxf(sqrtf(red[0]), 1e-12f); const float k2 = k * (1.f + (a - 1.f) * k_a[c]);
    const size_t o = (size_t)m * 512 + c; R[o] = r; W[o] = decay; Kk[o] = k2; V[o] = v; A[o] = -kk; Bb[o] = kk * a; G[o] = g;
}
__global__ void __launch_bounds__(64) rwkv_scan(const float* R, const float* W, const float* Kk, const float* V, const float* A, const float* Bb, const float* S0, float* Sout, float* Y, int row0, int T) {
    const int seq = blockIdx.x / 8, h = blockIdx.x % 8, i = threadIdx.x; float S[64];
#pragma unroll
    for (int j = 0; j < 64; ++j) S[j] = S0 ? S0[(((size_t)seq * 8 + h) * 64 + i) * 64 + j] : 0.f;
    __shared__ float sr[16][64], sw[16][64], sk[16][64], sa[16][64], sb[16][64], sv[16][64];
    for (int t0 = 0; t0 < T; t0 += 16) { const int nt = T - t0 < 16 ? T - t0 : 16;
        __syncthreads();
        for (int tt = 0; tt < nt; ++tt) { const size_t o = ((size_t)row0 + (size_t)seq * T + t0 + tt) * 512 + h * 64 + i; sr[tt][i] = R[o]; sw[tt][i] = W[o]; sk[tt][i] = Kk[o]; sa[tt][i] = A[o]; sb[tt][i] = Bb[o]; sv[tt][i] = V[o]; }
        __syncthreads();
        for (int tt = 0; tt < nt; ++tt) { float dot = 0.f; const float v = sv[tt][i];
#pragma unroll
            for (int j = 0; j < 64; ++j) dot += S[j] * sa[tt][j];
            float y = 0.f;
#pragma unroll
            for (int j = 0; j < 64; ++j) { S[j] = S[j] * sw[tt][j] + dot * sb[tt][j] + v * sk[tt][j]; y += S[j] * sr[tt][j]; }
            Y[((size_t)row0 + (size_t)seq * T + t0 + tt) * 512 + h * 64 + i] = y; } }
#pragma unroll
    for (int j = 0; j < 64; ++j) Sout[(((size_t)seq * 8 + h) * 64 + i) * 64 + j] = S[j];
}
__global__ void __launch_bounds__(64) rwkv_post(const float* Y, const float* R, const float* Kk, const float* V, const float* G, const float* r_k, const float* lg, const float* lb, float* yout) {
    const int m = blockIdx.x / 8, h = blockIdx.x % 8, i = threadIdx.x, c = h * 64 + i; const size_t o = (size_t)m * 512 + c;
    __shared__ float red[64]; const float y = Y[o];
    red[i] = y; __syncthreads(); for (int s = 32; s > 0; s >>= 1) { if (i < s) red[i] += red[i + s]; __syncthreads(); } const float mu = red[0] / 64.f; __syncthreads();
    red[i] = (y - mu) * (y - mu); __syncthreads(); for (int s = 32; s > 0; s >>= 1) { if (i < s) red[i] += red[i + s]; __syncthreads(); } const float var = red[0] / 64.f; __syncthreads();
    red[i] = R[o] * Kk[o] * r_k[c]; __syncthreads(); for (int s = 32; s > 0; s >>= 1) { if (i < s) red[i] += red[i + s]; __syncthreads(); } const float bon = red[0];
    yout[o] = ((y - mu) * rsqrtf(var + 64e-5f) * lg[c] + lb[c] + bon * V[o]) * G[o];
}
__global__ void merge_acc(const float* z, const float* P, int goff, float* merged, int first) {
    const int i = blockIdx.x * blockDim.x + threadIdx.x; if (i >= M * D) return; const int m = i / D, n = i % D;
    const float v = sigm(z[(size_t)m * INW + OGL + goff + n]) * P[i]; merged[i] = first ? v : merged[i] + v;
}
__global__ void resid(const float* xa, const float* xb, const float* P, const float* mod, int gt_off, float* xout) {
    const int i = blockIdx.x * blockDim.x + threadIdx.x; if (i >= M * D) return; const int m = i / D, n = i % D;
    const float x = m < MP ? xa[i] : xb[(size_t)(m - MP) * D + n]; xout[i] = x + (1.f + mod[(size_t)modrow(m) * 6 * D + gt_off + n]) * P[i];
}
__global__ void swiglu(const float* gbuf, const float* ubuf, float* act, int n) { const int i = blockIdx.x * blockDim.x + threadIdx.x; if (i < n) act[i] = silu(gbuf[i]) * ubuf[i]; }

struct In { const float* p[39]; };
inline void G(hipStream_t st, const float* A, int lda, const float* B, int ldb, float* C, int ldc, int Mm, int N, int K) { gemm<<<dim3((N + 63) / 64, (Mm + 63) / 64), 256, 0, st>>>(A, lda, B, ldb, C, ldc, Mm, N, K); }
#define EW(n) ((int)(((size_t)(n) + 255) / 256)), 256, 0, st

struct WS { float *silc, *mod, *h, *z, *xm, *R, *W, *K, *V, *A, *B, *G, *Y, *vfirst, *dbuf, *cat_a, *cat_p, *cat_r, *P, *merged, *x1, *xres, *fg, *fu, *T1; };
inline size_t carve(float* base, WS& w) {
    size_t o = 0; auto take = [&](size_t n) { float* p = base + o; o += (n + 63) & ~(size_t)63; return p; };
    w.silc = take((size_t)NMOD * D); w.mod = take((size_t)NL * NMOD * 6 * D); w.T1 = take((size_t)M * 32);
    w.h = take((size_t)M * D); w.P = w.h;
    w.xm = take((size_t)M * D); w.x1 = w.xm;
    w.cat_a = take((size_t)M * 1024); w.cat_p = take((size_t)M * 512); w.cat_r = take((size_t)M * 512); w.xres = take((size_t)M * D);
    w.z = take((size_t)M * INW);
    w.R = take((size_t)M * 512); w.W = take((size_t)M * 512); w.K = take((size_t)M * 512); w.V = take((size_t)M * 512); w.A = take((size_t)M * 512); w.B = take((size_t)M * 512); w.G = take((size_t)M * 512);
    w.Y = take((size_t)M * 512); w.vfirst = take((size_t)M * 512); w.dbuf = take((size_t)M * 512);
    w.merged = w.R;
    w.fg = w.z; w.fu = w.z + (size_t)M * DFF;
    return o;
}
constexpr size_t O_YP = 0, O_YS = O_YP + (size_t)MP * D, O_KP = O_YS + (size_t)NS * D, O_VP = O_KP + (size_t)NL * NB * 128 * 256, O_PP = O_VP + (size_t)NL * NB * 128 * 256,
                 O_SP = O_PP + (size_t)NL * NB * 15 * 512, O_WP = O_SP + (size_t)NL * NB * RP, O_KS = O_WP + (size_t)NL * NB * 8 * 4096, O_VS = O_KS + (size_t)NL * NS * 128 * 256,
                 O_PS = O_VS + (size_t)NL * NS * 128 * 256, O_SS = O_PS + (size_t)NL * NS * 15 * 512, O_WS = O_SS + (size_t)NL * NS * RP, O_END = O_WS + (size_t)NL * NS * 8 * 4096;

inline void forward(const In& in, float* out, float* wsf, hipStream_t st) {
    WS w; carve(wsf, w);
    const float *xp = in.p[0], *xs = in.p[1];
    silu_c<<<EW(NMOD * D)>>>(in.p[2], in.p[3], w.silc);
    for (int l = 0; l < NL; ++l) { G(st, w.silc, D, in.p[9] + (size_t)l * D * 6 * D, 6 * D, w.mod + (size_t)l * NMOD * 6 * D, 6 * D, NMOD, 6 * D, D);
        add_bias<<<EW(NMOD * 6 * D)>>>(w.mod + (size_t)l * NMOD * 6 * D, in.p[10] + (size_t)l * 6 * D, NMOD * 6 * D, 6 * D); }
    const float* xa = xp; const float* xb = xs;
    for (int l = 0; l < NL; ++l) {
        const float* mod = w.mod + (size_t)l * NMOD * 6 * D;
        modnorm<<<M, 256, 0, st>>>(xa, xb, in.p[11] + l * D, mod, 0, D, w.h, (size_t)MP * D);
        G(st, w.h, D, in.p[13] + (size_t)l * D * INW, INW, w.z, INW, M, INW, D);
        rope<<<EW(M * 640)>>>(w.z);
        const float* ck = in.p[4] + (size_t)l * NS * 128 * 256; const float* cv = in.p[5] + (size_t)l * NS * 128 * 256;
        attn_prompt<<<(MP * 16 + 63) / 64, 64, 0, st>>>(w.z, in.p[14] + l * 16, w.cat_a);
        attn_sample<<<(NS * 16 + 63) / 64, 64, 0, st>>>(w.z, in.p[14] + l * 16, ck, cv, w.cat_a);
        kv_out<<<EW(NS * 128 * 256)>>>(w.z, ck, cv, out + O_KP + (size_t)l * NB * 128 * 256, out + O_VP + (size_t)l * NB * 128 * 256, out + O_KS + (size_t)l * NS * 128 * 256, out + O_VS + (size_t)l * NS * 128 * 256);
        const float* sp = in.p[6] + (size_t)l * NS * 15 * 512;
        pool_d<<<EW(M * 512)>>>(w.z, sp, w.dbuf);
        pool_z<<<EW(M * 512)>>>(w.dbuf, in.p[16] + (size_t)l * 4 * 128 * 128, in.p[17] + l * 512, w.cat_p);
        pool_out<<<EW(NS * 15 * 512)>>>(w.z, sp, out + O_PP + (size_t)l * NB * 15 * 512, out + O_PS + (size_t)l * NS * 15 * 512);
        rwkv_xm<<<EW((size_t)M * RP)>>>(w.z, in.p[7] + (size_t)l * NS * RP, in.p[19] + l * RP, w.xm);
        shift_out<<<EW(NS * RP)>>>(w.z, out + O_SP + (size_t)l * NB * RP, out + O_SS + (size_t)l * NS * RP);
        if (l > 0) { G(st, w.xm + 1024, RP, in.p[31], 32, w.T1, 32, M, 32, 512); G(st, w.T1, 32, in.p[32], 512, w.dbuf, 512, M, 512, 32); }
        rwkv_prep<<<M * 8, 64, 0, st>>>(w.xm, in.p[20] + l * 512, in.p[21] + (size_t)l * 96 * 512, in.p[22] + l * 512, in.p[23] + (size_t)l * 96 * 512, in.p[24] + (size_t)l * 256 * 512, in.p[25] + l * 512, in.p[26] + l * 512,
                                         w.dbuf, in.p[33], w.vfirst, l > 0, w.R, w.W, w.K, w.V, w.A, w.B, w.G);
        rwkv_scan<<<NB * 8, 64, 0, st>>>(w.R, w.W, w.K, w.V, w.A, w.B, nullptr, out + O_WP + (size_t)l * NB * 8 * 4096, w.Y, 0, SEQ);
        rwkv_scan<<<NS * 8, 64, 0, st>>>(w.R, w.W, w.K, w.V, w.A, w.B, in.p[8] + (size_t)l * NS * 8 * 4096, out + O_WS + (size_t)l * NS * 8 * 4096, w.Y, MP, 1);
        rwkv_post<<<M * 8, 64, 0, st>>>(w.Y, w.R, w.K, w.V, w.G, in.p[27] + l * 512, in.p[28] + l * 512, in.p[29] + l * 512, w.cat_r);
        G(st, w.cat_a, 1024, in.p[15] + (size_t)l * 1024 * D, D, w.P, D, M, D, 1024); merge_acc<<<EW((size_t)M * D)>>>(w.z, w.P, 0, w.merged, 1);
        G(st, w.cat_p, 512, in.p[18] + (size_t)l * 512 * D, D, w.P, D, M, D, 512);   merge_acc<<<EW((size_t)M * D)>>>(w.z, w.P, D, w.merged, 0);
        G(st, w.cat_r, 512, in.p[30] + (size_t)l * 512 * D, D, w.P, D, M, D, 512);   merge_acc<<<EW((size_t)M * D)>>>(w.z, w.P, 2 * D, w.merged, 0);
        G(st, w.merged, D, in.p[34] + (size_t)l * D * D, D, w.P, D, M, D, D);
        resid<<<EW((size_t)M * D)>>>(xa, xb, w.P, mod, 2 * D, w.x1);
        modnorm<<<M, 256, 0, st>>>(w.x1, w.x1 + (size_t)MP * D, in.p[12] + l * D, mod, 3 * D, 4 * D, w.h, (size_t)MP * D);
        G(st, w.h, D, in.p[35] + (size_t)l * D * DFF, DFF, w.fg, DFF, M, DFF, D);
        G(st, w.h, D, in.p[36] + (size_t)l * D * DFF, DFF, w.fu, DFF, M, DFF, D);
        swiglu<<<EW((size_t)M * DFF)>>>(w.fg, w.fu, w.fg, M * DFF);
        G(st, w.fg, DFF, in.p[37] + (size_t)l * DFF * D, D, w.P, D, M, D, DFF);
        resid<<<EW((size_t)M * D)>>>(w.x1, w.x1 + (size_t)MP * D, w.P, mod, 5 * D, w.xres);
        xa = w.xres; xb = w.xres + (size_t)MP * D;
    }
    modnorm<<<M, 256, 0, st>>>(xa, xb, in.p[38], nullptr, 0, 0, out + O_YP, (size_t)MP * D);
}
#undef EW
}
extern "C" void kernel_launch(void* const* d_in, const int* in_sizes, int n_in, void* d_out, int out_size, void* d_ws, size_t ws_size, hipStream_t stream) {
    nv::WS w; const size_t need = nv::carve((float*)d_ws, w) * 4;
    if (n_in != 39 || (size_t)out_size != nv::O_END || ws_size < need) { fprintf(stderr, "kernel_launch: unexpected shapes: n_in %d out %d (want %zu) ws %zu (need %zu)\n", n_in, out_size, (size_t)nv::O_END, ws_size, need); return; }
    nv::In in; for (int i = 0; i < 39; ++i) in.p[i] = (const float*)d_in[i];
    nv::forward(in, (float*)d_out, (float*)d_ws, stream);
}
```

```cpp
#define MK_DEBUG 0
#include <hip/hip_runtime.h>
#include <hip/hip_cooperative_groups.h>
#include <cstdio>
#include <cstdint>
namespace dbg {
constexpr int NPROBE = 16384, NSPECIAL = 2048, NIDS = 64;
struct Ctx { float* probes; float* err; int on; };
__device__ __forceinline__ unsigned hash32(unsigned x) { x ^= x >> 16; x *= 0x7feb352dU; x ^= x >> 15; x *= 0x846ca68bU; x ^= x >> 16; return x; }
__device__ __forceinline__ void probe_rc(int id, int k, int R, int C, int& r, int& c) {
    const unsigned h1 = hash32((unsigned)(id * 1000003 + k * 2 + 1)), h2 = hash32((unsigned)(id * 7919 + k * 2 + 77777));
    c = (int)(h2 % (unsigned)C);
    if (R == 8320 && k < NSPECIAL) { const int sp[16] = {0, 1, 15, 16, 127, 128, 129, 4095, 4096, 4097, 8190, 8191, 8192, 8193, 8255, 8319}; r = sp[k >> 7]; }
    else r = (int)(h1 % (unsigned)R);
}
enum { K_F32 = 0, K_BF16 = 1, K_QPERM = 2 };
__device__ __forceinline__ float opt_read(const void* p, int kind, size_t ld, int coff, int r, int c) {
    if (kind == K_F32) return ((const float*)p)[(size_t)r * ld + coff + c];
    if (kind == K_QPERM) { const int h = c >> 6, d = c & 63, pp = 32 * ((d >> 4) & 1) + 8 * ((d >> 2) & 3) + 4 * (d >> 5) + (d & 3); c = h * 64 + pp; }
    const unsigned short b = ((const unsigned short*)p)[(size_t)r * ld + coff + c]; return __builtin_bit_cast(float, (unsigned)b << 16);
}
__global__ void probe_save(float* probes, int id, const void* p, int kind, size_t ld, int coff, int R, int C) {
    const int k = blockIdx.x * blockDim.x + threadIdx.x; if (k >= NPROBE) return; int r, c; probe_rc(id, k, R, C, r, c);
    probes[(size_t)id * NPROBE + k] = opt_read(p, kind, ld, coff, r, c);
}
__global__ void probe_cmp(const float* probes, float* err, int id, const float* gold, size_t ld, int coff, int R, int C, int sig) {
    const int k = blockIdx.x * blockDim.x + threadIdx.x; if (k >= NPROBE) return; int r, c; probe_rc(id, k, R, C, r, c);
    float g = gold[(size_t)r * ld + coff + c]; if (sig) g = 1.f / (1.f + expf(-g));
    float o = probes[(size_t)id * NPROBE + k]; float d = o - g; if (!(d == d) || fabsf(d) > 1e18f) d = 1e18f;
    const int sp = (R == 8320 && k < NSPECIAL) ? 0 : 2;
    atomicAdd(&err[id * 4 + sp], d * d); atomicAdd(&err[id * 4 + sp + 1], g * g);
}
__global__ void inject(const float* err, float* out, float* ys, int nids, int want_id) {
    if (threadIdx.x || blockIdx.x) return;
    int rid = 89, which = 0; float rel = 1e-3f;
    for (int id = 0; id < nids; ++id) {
        const float r_rand = sqrtf(err[id * 4 + 2] / fmaxf(err[id * 4 + 3], 1e-30f)), r_sp = err[id * 4 + 1] > 0.f ? sqrtf(err[id * 4 + 0] / fmaxf(err[id * 4 + 1], 1e-30f)) : 0.f;
        if (want_id >= 0) { if (id == want_id) { rid = id; which = 0; rel = r_rand; break; } continue; }
        if (r_rand > 0.05f) { rid = id; which = 0; rel = r_rand; break; } else if (r_sp > 0.10f) { rid = id; which = 1; rel = r_sp; break; } }
    const float c1 = (float)(10 + rid) * (which ? 1e5f : 1e3f); float f = (log10f(fmaxf(rel, 1e-3f)) + 3.f) * 0.25f; f = fminf(fmaxf(f, 0.f), 1.f);
    out[0] = c1; ys[0] = c1 * (0.2f + 0.6f * f);
}
inline void save(const Ctx* c, hipStream_t st, int id, const void* p, int kind, size_t ld, int coff, int R, int C) { if (c && c->on) probe_save<<<NPROBE / 256, 256, 0, st>>>(c->probes, id, p, kind, ld, coff, R, C); }
inline void cmp(const Ctx* c, hipStream_t st, int id, const float* gold, size_t ld, int coff, int R, int C, int sig = 0) { if (c && c->on) probe_cmp<<<NPROBE / 256, 256, 0, st>>>(c->probes, c->err, id, gold, ld, coff, R, C, sig); }
enum { T_MOD = 0, T_L0 = 1, T_PER_L = 23, T_OUT0 = T_L0 + 2 * T_PER_L, T_N = T_OUT0 + 12 };
enum { T_H1 = 0, T_Q, T_K, T_V, T_U, T_PR, T_GT, T_OA, T_ZP, T_R, T_W, T_KK, T_VV, T_A, T_B, T_G, T_Y, T_YR, T_MG, T_X1, T_H2, T_ACT, T_X2 };
}
namespace nv {
constexpr int D = 2048, SEQ = 4096, NB = 2, MP = NB * SEQ, NS = 128, M = MP + NS, NL = 2;
constexpr int INW = 10176, OQ = 0, OK_ = 1024, OV = 1280, OU = 1536, OPR = 2048, OGL = 4032;
constexpr int RP = 1984, DFF = 5632, NMOD = NB + NS;
constexpr int PASTLEN = 8192;

__device__ __forceinline__ float sigm(float x) { return 1.f / (1.f + expf(-x)); }
__device__ __forceinline__ float silu(float x) { return x / (1.f + expf(-x)); }
__device__ __forceinline__ int modrow(int m) { return m < MP ? m / SEQ : NB + (m - MP); }
__device__ __forceinline__ int posof(int m) { return m < MP ? m % SEQ : PASTLEN; }

__global__ void __launch_bounds__(256) gemm(const float* __restrict__ A, int lda, const float* __restrict__ B, int ldb, float* __restrict__ C, int ldc, int Mm, int N, int K) {
    __shared__ float As[16][68], Bs[16][68];
    const int tx = threadIdx.x & 15, ty = threadIdx.x >> 4, m0 = blockIdx.y * 64, n0 = blockIdx.x * 64;
    float acc[4][4];
#pragma unroll
    for (int i = 0; i < 4; ++i)
#pragma unroll
        for (int j = 0; j < 4; ++j) acc[i][j] = 0.f;
    for (int k0 = 0; k0 < K; k0 += 16) {
        for (int i = threadIdx.x; i < 1024; i += 256) { const int r = i >> 4, c = i & 15; As[c][r] = (m0 + r < Mm) ? A[(size_t)(m0 + r) * lda + k0 + c] : 0.f; }
        for (int i = threadIdx.x; i < 1024; i += 256) { const int r = i >> 6, c = i & 63; Bs[r][c] = (n0 + c < N) ? B[(size_t)(k0 + r) * ldb + n0 + c] : 0.f; }
        __syncthreads();
#pragma unroll
        for (int kk = 0; kk < 16; ++kk) {
            float a[4], b[4];
#pragma unroll
            for (int i = 0; i < 4; ++i) { a[i] = As[kk][ty * 4 + i]; b[i] = Bs[kk][tx * 4 + i]; }
#pragma unroll
            for (int i = 0; i < 4; ++i)
#pragma unroll
                for (int j = 0; j < 4; ++j) acc[i][j] += a[i] * b[j];
        }
        __syncthreads();
    }
#pragma unroll
    for (int i = 0; i < 4; ++i)
#pragma unroll
        for (int j = 0; j < 4; ++j) { const int m = m0 + ty * 4 + i, n = n0 + tx * 4 + j; if (m < Mm && n < N) C[(size_t)m * ldc + n] = acc[i][j]; }
}

__global__ void silu_c(const float* cp, const float* cs, float* out) {
    const int i = blockIdx.x * blockDim.x + threadIdx.x; if (i >= NMOD * D) return;
    const int r = i / D, k = i % D; const float c = r < NB ? cp[r * D + k] : cs[(r - NB) * D + k]; out[i] = silu(c);
}
__global__ void add_bias(float* mod, const float* b, int n, int N) { const int i = blockIdx.x * blockDim.x + threadIdx.x; if (i < n) mod[i] += b[i % N]; }

__global__ void __launch_bounds__(256) modnorm(const float* xa, const float* xb, const float* g, const float* mod, int sh_off, int sc_off, float* out, size_t out_split_off) {
    const int m = blockIdx.x; const float* x = m < MP ? xa + (size_t)m * D : xb + (size_t)(m - MP) * D;
    __shared__ float red[256]; float s = 0.f;
    for (int k = threadIdx.x; k < D; k += 256) { const float v = x[k]; s += v * v; }
    red[threadIdx.x] = s; __syncthreads();
    for (int o = 128; o > 0; o >>= 1) { if (threadIdx.x < o) red[threadIdx.x] += red[threadIdx.x + o]; __syncthreads(); }
    const float rs = rsqrtf(red[0] / D + 1e-6f); const int br = modrow(m);
    float* o = m < MP ? out + (size_t)m * D : out + out_split_off + (size_t)(m - MP) * D;
    for (int k = threadIdx.x; k < D; k += 256) { float v = x[k] * rs * g[k]; if (mod) v = v * (1.f + mod[(size_t)br * 6 * D + sc_off + k]) + mod[(size_t)br * 6 * D + sh_off + k]; o[k] = v; }
}

__global__ void rope(float* z) {
    const int i = blockIdx.x * blockDim.x + threadIdx.x; if (i >= M * 20 * 32) return;
    const int m = i / 640, hh = (i / 32) % 20, d = i % 32; const float pos = (float)posof(m);
    const float inv = powf(10000.f, -(float)d * 2.0f / 64.f), ang = pos * inv, c = cosf(ang), s = sinf(ang);
    float* p = z + (size_t)m * INW + hh * 64; const float x1 = p[d], x2 = p[d + 32]; p[d] = x1 * c - x2 * s; p[d + 32] = x2 * c + x1 * s;
}

__global__ void attn_prompt(const float* z, const float* sink, float* oattn) {
    const int i = blockIdx.x * blockDim.x + threadIdx.x; if (i >= MP * 16) return;
    const int m = i / 16, hq = i % 16, hk = hq / 4, t = m % SEQ; const float* q = z + (size_t)m * INW + OQ + hq * 64;
    const int lo = t - 128 < 0 ? 0 : t - 128; const float sk = sink[hq];
    float mx = sk;
    for (int kp = lo; kp <= t; ++kp) { const float* k = z + (size_t)(m - t + kp) * INW + OK_ + hk * 64; float s = 0.f; for (int d = 0; d < 64; ++d) s += q[d] * k[d]; s *= 0.125f; mx = fmaxf(mx, s); }
    float den = expf(sk - mx); float o[64];
#pragma unroll
    for (int d = 0; d < 64; ++d) o[d] = 0.f;
    for (int kp = lo; kp <= t; ++kp) { const float* k = z + (size_t)(m - t + kp) * INW + OK_ + hk * 64; const float* v = z + (size_t)(m - t + kp) * INW + OV + hk * 64; float s = 0.f; for (int d = 0; d < 64; ++d) s += q[d] * k[d]; s *= 0.125f;
        const float p = expf(s - mx); den += p;
#pragma unroll
        for (int d = 0; d < 64; ++d) o[d] += p * v[d]; }
#pragma unroll
    for (int d = 0; d < 64; ++d) oattn[(size_t)m * 1024 + hq * 64 + d] = o[d] / den;
}
__global__ void attn_sample(const float* z, const float* sink, const float* ck, const float* cv, float* oattn) {
    const int i = blockIdx.x * blockDim.x + threadIdx.x; if (i >= NS * 16) return;
    const int s_ = i / 16, hq = i % 16, hk = hq / 4, m = MP + s_; const float* q = z + (size_t)m * INW + OQ + hq * 64; const float sk = sink[hq];
    float mx = sk;
    for (int j = 0; j <= 128; ++j) { const float* k = j < 128 ? ck + ((size_t)(s_ * 128 + j) * 4 + hk) * 64 : z + (size_t)m * INW + OK_ + hk * 64; float s = 0.f; for (int d = 0; d < 64; ++d) s += q[d] * k[d]; s *= 0.125f; mx = fmaxf(mx, s); }
    float den = expf(sk - mx); float o[64];
#pragma unroll
    for (int d = 0; d < 64; ++d) o[d] = 0.f;
    for (int j = 0; j <= 128; ++j) { const float* k = j < 128 ? ck + ((size_t)(s_ * 128 + j) * 4 + hk) * 64 : z + (size_t)m * INW + OK_ + hk * 64;
        const float* v = j < 128 ? cv + ((size_t)(s_ * 128 + j) * 4 + hk) * 64 : z + (size_t)m * INW + OV + hk * 64; float s = 0.f; for (int d = 0; d < 64; ++d) s += q[d] * k[d]; s *= 0.125f;
        const float p = expf(s - mx); den += p;
#pragma unroll
        for (int d = 0; d < 64; ++d) o[d] += p * v[d]; }
#pragma unroll
    for (int d = 0; d < 64; ++d) oattn[(size_t)m * 1024 + hq * 64 + d] = o[d] / den;
}
__global__ void kv_out(const float* z, const float* ck, const float* cv, float* kp, float* vp, float* ks, float* vs) {
    const int i = blockIdx.x * blockDim.x + threadIdx.x;
    if (i < NB * 128 * 256) { const int b = i / (128 * 256), j = (i / 256) % 128, c = i % 256; const size_t m = (size_t)b * SEQ + SEQ - 128 + j; kp[i] = z[m * INW + OK_ + c]; vp[i] = z[m * INW + OV + c]; }
    if (i < NS * 128 * 256) { const int s_ = i / (128 * 256), j = (i / 256) % 128, c = i % 256;
        if (j < 127) { ks[i] = ck[i + 256]; vs[i] = cv[i + 256]; } else { ks[i] = z[(size_t)(MP + s_) * INW + OK_ + c]; vs[i] = z[(size_t)(MP + s_) * INW + OV + c]; } }
}
__global__ void pool_d(const float* z, const float* spool, float* dbuf) {
    const int i = blockIdx.x * blockDim.x + threadIdx.x; if (i >= M * 512) return;
    const int m = i / 512, c = i % 512, gi = c / 128, w = 2 << gi; float sum = 0.f; float cnt;
    if (m < MP) { const int t = m % SEQ; for (int j = 0; j < w; ++j) if (t - j >= 0) sum += z[(size_t)(m - j) * INW + OU + c]; cnt = (float)(t + 1 < w ? t + 1 : w); }
    else { const int s_ = m - MP; sum = z[(size_t)m * INW + OU + c]; for (int j = 1; j < w; ++j) sum += spool[((size_t)s_ * 15 + 15 - j) * 512 + c]; cnt = (float)w; }
    dbuf[i] = sum / cnt - z[(size_t)m * INW + OU + c];
}
__global__ void pool_z(const float* dbuf, const float* pw, const float* pscale, float* zpool) {
    const int i = blockIdx.x * blockDim.x + threadIdx.x; if (i >= M * 512) return;
    const int m = i / 512, c = i % 512, gi = c / 128, e = c % 128; float s = 0.f;
    for (int k = 0; k < 128; ++k) s += dbuf[(size_t)m * 512 + gi * 128 + k] * pw[(gi * 128 + k) * 128 + e];
    zpool[i] = s * pscale[c];
}
__global__ void pool_out(const float* z, const float* spool, float* pp, float* ps) {
    const int i = blockIdx.x * blockDim.x + threadIdx.x;
    if (i < NB * 15 * 512) { const int b = i / (15 * 512), j = (i / 512) % 15, c = i % 512; pp[i] = z[((size_t)b * SEQ + SEQ - 15 + j) * INW + OU + c]; }
    if (i < NS * 15 * 512) { const int s_ = i / (15 * 512), j = (i / 512) % 15, c = i % 512; ps[i] = j < 14 ? spool[i + 512] : z[(size_t)(MP + s_) * INW + OU + c]; }
}
__global__ void rwkv_xm(const float* z, const float* sshift, const float* mu, float* xm) {
    const int i = blockIdx.x * blockDim.x + threadIdx.x; if (i >= M * RP) return;
    const int m = i / RP, c = i % RP; const float p = z[(size_t)m * INW + OPR + c]; float pv;
    if (m < MP) pv = (m % SEQ) ? z[(size_t)(m - 1) * INW + OPR + c] : 0.f; else pv = sshift[(size_t)(m - MP) * RP + c];
    xm[i] = p + (pv - p) * mu[c];
}
__global__ void shift_out(const float* z, float* sp, float* ss) {
    const int i = blockIdx.x * blockDim.x + threadIdx.x;
    if (i < NB * RP) { const int b = i / RP, c = i % RP; sp[i] = z[((size_t)b * SEQ + SEQ - 1) * INW + OPR + c]; }
    if (i < NS * RP) { const int s_ = i / RP, c = i % RP; ss[i] = z[(size_t)(MP + s_) * INW + OPR + c]; }
}
__global__ void __launch_bounds__(64) rwkv_prep(const float* xm, const float* w0, const float* w2, const float* a0, const float* a2, const float* g2, const float* k_k, const float* k_a,
                                                 const float* T2, const float* vb, float* vfirst, int has_vres,
                                                 float* R, float* W, float* Kk, float* V, float* A, float* Bb, float* G) {
    const int m = blockIdx.x / 8, h = blockIdx.x % 8, c = h * 64 + threadIdx.x; const float* x = xm + (size_t)m * RP;
    float s = w0[c]; for (int k = 0; k < 96; ++k) s += tanhf(x[1536 + k]) * w2[k * 512 + c];
    const float z_ = -s; const float sp = z_ > 20.f ? z_ : log1pf(expf(z_)); const float wlog = -sp - 0.5f; const float decay = expf(-expf(wlog));
    float sa = a0[c]; for (int k = 0; k < 96; ++k) sa += x[1632 + k] * a2[k * 512 + c]; const float a = sigm(sa);
    float g = 0.f; for (int k = 0; k < 256; ++k) g += sigm(x[1728 + k]) * g2[k * 512 + c];
    float v = x[1024 + c];
    if (!has_vres) vfirst[(size_t)m * 512 + c] = v;
    else { const float acc = vb[c] + T2[(size_t)m * 512 + c]; v = v + (vfirst[(size_t)m * 512 + c] - v) * sigm(acc); }
    const float r = x[c], k = x[512 + c]; float kk = k * k_k[c];
    __shared__ float red[64]; red[threadIdx.x] = kk * kk; __syncthreads();
    for (int o = 32; o > 0; o >>= 1) { if (threadIdx.x < o) red[threadIdx.x] += red[threadIdx.x + o]; __syncthreads(); }
    kk = kk / fmaxf(sqrtf(red[0]), 1e-12f); const float k2 = k * (1.f + (a - 1.f) * k_a[c]);
    const size_t o = (size_t)m * 512 + c; R[o] = r; W[o] = decay; Kk[o] = k2; V[o] = v; A[o] = -kk; Bb[o] = kk * a; G[o] = g;
}
__global__ void __launch_bounds__(64) rwkv_scan(const float* R, const float* W, const float* Kk, const float* V, const float* A, const float* Bb, const float* S0, float* Sout, float* Y, int row0, int T) {
    const int seq = blockIdx.x / 8, h = blockIdx.x % 8, i = threadIdx.x; float S[64];
#pragma unroll
    for (int j = 0; j < 64; ++j) S[j] = S0 ? S0[(((size_t)seq * 8 + h) * 64 + i) * 64 + j] : 0.f;
    __shared__ float sr[16][64], sw[16][64], sk[16][64], sa[16][64], sb[16][64], sv[16][64];
    for (int t0 = 0; t0 < T; t0 += 16) { const int nt = T - t0 < 16 ? T - t0 : 16;
        __syncthreads();
        for (int tt = 0; tt < nt; ++tt) { const size_t o = ((size_t)row0 + (size_t)seq * T + t0 + tt) * 512 + h * 64 + i; sr[tt][i] = R[o]; sw[tt][i] = W[o]; sk[tt][i] = Kk[o]; sa[tt][i] = A[o]; sb[tt][i] = Bb[o]; sv[tt][i] = V[o]; }
        __syncthreads();
        for (int tt = 0; tt < nt; ++tt) { float dot = 0.f; const float v = sv[tt][i];
#pragma unroll
            for (int j = 0; j < 64; ++j) dot += S[j] * sa[tt][j];
            float y = 0.f;
#pragma unroll
            for (int j = 0; j < 64; ++j) { S[j] = S[j] * sw[tt][j] + dot * sb[tt][j] + v * sk[tt][j]; y += S[j] * sr[tt][j]; }
            Y[((size_t)row0 + (size_t)seq * T + t0 + tt) * 512 + h * 64 + i] = y; } }
#pragma unroll
    for (int j = 0; j < 64; ++j) Sout[(((size_t)seq * 8 + h) * 64 + i) * 64 + j] = S[j];
}
__global__ void __launch_bounds__(64) rwkv_post(const float* Y, const float* R, const float* Kk, const float* V, const float* G, const float* r_k, const float* lg, const float* lb, float* yout) {
    const int m = blockIdx.x / 8, h = blockIdx.x % 8, i = threadIdx.x, c = h * 64 + i; const size_t o = (size_t)m * 512 + c;
    __shared__ float red[64]; const float y = Y[o];
    red[i] = y; __syncthreads(); for (int s = 32; s > 0; s >>= 1) { if (i < s) red[i] += red[i + s]; __syncthreads(); } const float mu = red[0] / 64.f; __syncthreads();
    red[i] = (y - mu) * (y - mu); __syncthreads(); for (int s = 32; s > 0; s >>= 1) { if (i < s) red[i] += red[i + s]; __syncthreads(); } const float var = red[0] / 64.f; __syncthreads();
    red[i] = R[o] * Kk[o] * r_k[c]; __syncthreads(); for (int s = 32; s > 0; s >>= 1) { if (i < s) red[i] += red[i + s]; __syncthreads(); } const float bon = red[0];
    yout[o] = ((y - mu) * rsqrtf(var + 64e-5f) * lg[c] + lb[c] + bon * V[o]) * G[o];
}
__global__ void merge_acc(const float* z, const float* P, int goff, float* merged, int first) {
    const int i = blockIdx.x * blockDim.x + threadIdx.x; if (i >= M * D) return; const int m = i / D, n = i % D;
    const float v = sigm(z[(size_t)m * INW + OGL + goff + n]) * P[i]; merged[i] = first ? v : merged[i] + v;
}
__global__ void resid(const float* xa, const float* xb, const float* P, const float* mod, int gt_off, float* xout) {
    const int i = blockIdx.x * blockDim.x + threadIdx.x; if (i >= M * D) return; const int m = i / D, n = i % D;
    const float x = m < MP ? xa[i] : xb[(size_t)(m - MP) * D + n]; xout[i] = x + (1.f + mod[(size_t)modrow(m) * 6 * D + gt_off + n]) * P[i];
}
__global__ void swiglu(const float* gbuf, const float* ubuf, float* act, int n) { const int i = blockIdx.x * blockDim.x + threadIdx.x; if (i < n) act[i] = silu(gbuf[i]) * ubuf[i]; }

struct In { const float* p[39]; };
inline void G(hipStream_t st, const float* A, int lda, const float* B, int ldb, float* C, int ldc, int Mm, int N, int K) { gemm<<<dim3((N + 63) / 64, (Mm + 63) / 64), 256, 0, st>>>(A, lda, B, ldb, C, ldc, Mm, N, K); }
#define EW(n) ((int)(((size_t)(n) + 255) / 256)), 256, 0, st

struct WS { float *silc, *mod, *h, *z, *xm, *R, *W, *K, *V, *A, *B, *G, *Y, *vfirst, *dbuf, *cat_a, *cat_p, *cat_r, *P, *merged, *x1, *xres, *fg, *fu, *T1; };
inline size_t carve(float* base, WS& w) {
    size_t o = 0; auto take = [&](size_t n) { float* p = base + o; o += (n + 63) & ~(size_t)63; return p; };
    w.silc = take((size_t)NMOD * D); w.mod = take((size_t)NL * NMOD * 6 * D); w.T1 = take((size_t)M * 32);
    w.h = take((size_t)M * D); w.P = w.h;
    w.xm = take((size_t)M * D); w.x1 = w.xm;
    w.cat_a = take((size_t)M * 1024); w.cat_p = take((size_t)M * 512); w.cat_r = take((size_t)M * 512); w.xres = take((size_t)M * D);
    w.z = take((size_t)M * INW);
    w.R = take((size_t)M * 512); w.W = take((size_t)M * 512); w.K = take((size_t)M * 512); w.V = take((size_t)M * 512); w.A = take((size_t)M * 512); w.B = take((size_t)M * 512); w.G = take((size_t)M * 512);
    w.Y = take((size_t)M * 512); w.vfirst = take((size_t)M * 512); w.dbuf = take((size_t)M * 512);
    w.merged = w.R;
    w.fg = w.z; w.fu = w.z + (size_t)M * DFF;
    return o;
}
constexpr size_t O_YP = 0, O_YS = O_YP + (size_t)MP * D, O_KP = O_YS + (size_t)NS * D, O_VP = O_KP + (size_t)NL * NB * 128 * 256, O_PP = O_VP + (size_t)NL * NB * 128 * 256,
                 O_SP = O_PP + (size_t)NL * NB * 15 * 512, O_WP = O_SP + (size_t)NL * NB * RP, O_KS = O_WP + (size_t)NL * NB * 8 * 4096, O_VS = O_KS + (size_t)NL * NS * 128 * 256,
                 O_PS = O_VS + (size_t)NL * NS * 128 * 256, O_SS = O_PS + (size_t)NL * NS * 15 * 512, O_WS = O_SS + (size_t)NL * NS * RP, O_END = O_WS + (size_t)NL * NS * 8 * 4096;

inline void forward(const In& in, float* out, float* wsf, hipStream_t st, const dbg::Ctx* dc = nullptr) {
    using namespace dbg;
    WS w; carve(wsf, w);
    const float *xp = in.p[0], *xs = in.p[1];
    silu_c<<<EW(NMOD * D)>>>(in.p[2], in.p[3], w.silc);
    for (int l = 0; l < NL; ++l) { G(st, w.silc, D, in.p[9] + (size_t)l * D * 6 * D, 6 * D, w.mod + (size_t)l * NMOD * 6 * D, 6 * D, NMOD, 6 * D, D);
        add_bias<<<EW(NMOD * 6 * D)>>>(w.mod + (size_t)l * NMOD * 6 * D, in.p[10] + (size_t)l * 6 * D, NMOD * 6 * D, 6 * D); }
    cmp(dc, st, T_MOD, w.mod, 6 * D, 0, NL * NMOD, 6 * D);
    const float* xa = xp; const float* xb = xs;
    for (int l = 0; l < NL; ++l) {
        const float* mod = w.mod + (size_t)l * NMOD * 6 * D; const int tb = T_L0 + l * T_PER_L;
        modnorm<<<M, 256, 0, st>>>(xa, xb, in.p[11] + l * D, mod, 0, D, w.h, (size_t)MP * D);
        cmp(dc, st, tb + T_H1, w.h, D, 0, M, D);
        G(st, w.h, D, in.p[13] + (size_t)l * D * INW, INW, w.z, INW, M, INW, D);
        rope<<<EW(M * 640)>>>(w.z);
        cmp(dc, st, tb + T_Q, w.z, INW, OQ, M, 1024); cmp(dc, st, tb + T_K, w.z, INW, OK_, M, 256); cmp(dc, st, tb + T_V, w.z, INW, OV, M, 256); cmp(dc, st, tb + T_U, w.z, INW, OU, M, 512);
        cmp(dc, st, tb + T_PR, w.z, INW, OPR, M, RP); cmp(dc, st, tb + T_GT, w.z, INW, OGL, M, 6144, 1);
        const float* ck = in.p[4] + (size_t)l * NS * 128 * 256; const float* cv = in.p[5] + (size_t)l * NS * 128 * 256;
        attn_prompt<<<(MP * 16 + 63) / 64, 64, 0, st>>>(w.z, in.p[14] + l * 16, w.cat_a);
        attn_sample<<<(NS * 16 + 63) / 64, 64, 0, st>>>(w.z, in.p[14] + l * 16, ck, cv, w.cat_a);
        kv_out<<<EW(NS * 128 * 256)>>>(w.z, ck, cv, out + O_KP + (size_t)l * NB * 128 * 256, out + O_VP + (size_t)l * NB * 128 * 256, out + O_KS + (size_t)l * NS * 128 * 256, out + O_VS + (size_t)l * NS * 128 * 256);
        const float* sp = in.p[6] + (size_t)l * NS * 15 * 512;
        pool_d<<<EW(M * 512)>>>(w.z, sp, w.dbuf);
        pool_z<<<EW(M * 512)>>>(w.dbuf, in.p[16] + (size_t)l * 4 * 128 * 128, in.p[17] + l * 512, w.cat_p);
        pool_out<<<EW(NS * 15 * 512)>>>(w.z, sp, out + O_PP + (size_t)l * NB * 15 * 512, out + O_PS + (size_t)l * NS * 15 * 512);
        rwkv_xm<<<EW((size_t)M * RP)>>>(w.z, in.p[7] + (size_t)l * NS * RP, in.p[19] + l * RP, w.xm);
        shift_out<<<EW(NS * RP)>>>(w.z, out + O_SP + (size_t)l * NB * RP, out + O_SS + (size_t)l * NS * RP);
        if (l > 0) { G(st, w.xm + 1024, RP, in.p[31], 32, w.T1, 32, M, 32, 512); G(st, w.T1, 32, in.p[32], 512, w.dbuf, 512, M, 512, 32); }
        if (l > 0) { cmp(dc, st, 59, w.dbuf, 512, 0, M, 512); cmp(dc, st, 60, w.T1, 32, 0, M, 32); }
        rwkv_prep<<<M * 8, 64, 0, st>>>(w.xm, in.p[20] + l * 512, in.p[21] + (size_t)l * 96 * 512, in.p[22] + l * 512, in.p[23] + (size_t)l * 96 * 512, in.p[24] + (size_t)l * 256 * 512, in.p[25] + l * 512, in.p[26] + l * 512,
                                         w.dbuf, in.p[33], w.vfirst, l > 0, w.R, w.W, w.K, w.V, w.A, w.B, w.G);
        cmp(dc, st, tb + T_OA, w.cat_a, 1024, 0, M, 1024); cmp(dc, st, tb + T_ZP, w.cat_p, 512, 0, M, 512);
        cmp(dc, st, tb + T_R, w.R, 512, 0, M, 512); cmp(dc, st, tb + T_W, w.W, 512, 0, M, 512); cmp(dc, st, tb + T_KK, w.K, 512, 0, M, 512); cmp(dc, st, tb + T_VV, w.V, 512, 0, M, 512);
        cmp(dc, st, tb + T_A, w.A, 512, 0, M, 512); cmp(dc, st, tb + T_B, w.B, 512, 0, M, 512); cmp(dc, st, tb + T_G, w.G, 512, 0, M, 512);
        rwkv_scan<<<NB * 8, 64, 0, st>>>(w.R, w.W, w.K, w.V, w.A, w.B, nullptr, out + O_WP + (size_t)l * NB * 8 * 4096, w.Y, 0, SEQ);
        rwkv_scan<<<NS * 8, 64, 0, st>>>(w.R, w.W, w.K, w.V, w.A, w.B, in.p[8] + (size_t)l * NS * 8 * 4096, out + O_WS + (size_t)l * NS * 8 * 4096, w.Y, MP, 1);
        cmp(dc, st, tb + T_Y, w.Y, 512, 0, M, 512);
        rwkv_post<<<M * 8, 64, 0, st>>>(w.Y, w.R, w.K, w.V, w.G, in.p[27] + l * 512, in.p[28] + l * 512, in.p[29] + l * 512, w.cat_r);
        cmp(dc, st, tb + T_YR, w.cat_r, 512, 0, M, 512);
        G(st, w.cat_a, 1024, in.p[15] + (size_t)l * 1024 * D, D, w.P, D, M, D, 1024); merge_acc<<<EW((size_t)M * D)>>>(w.z, w.P, 0, w.merged, 1);
        G(st, w.cat_p, 512, in.p[18] + (size_t)l * 512 * D, D, w.P, D, M, D, 512);   merge_acc<<<EW((size_t)M * D)>>>(w.z, w.P, D, w.merged, 0);
        G(st, w.cat_r, 512, in.p[30] + (size_t)l * 512 * D, D, w.P, D, M, D, 512);   merge_acc<<<EW((size_t)M * D)>>>(w.z, w.P, 2 * D, w.merged, 0);
        cmp(dc, st, tb + T_MG, w.merged, D, 0, M, D);
        G(st, w.merged, D, in.p[34] + (size_t)l * D * D, D, w.P, D, M, D, D);
        resid<<<EW((size_t)M * D)>>>(xa, xb, w.P, mod, 2 * D, w.x1);
        cmp(dc, st, tb + T_X1, w.x1, D, 0, M, D);
        modnorm<<<M, 256, 0, st>>>(w.x1, w.x1 + (size_t)MP * D, in.p[12] + l * D, mod, 3 * D, 4 * D, w.h, (size_t)MP * D);
        cmp(dc, st, tb + T_H2, w.h, D, 0, M, D);
        G(st, w.h, D, in.p[35] + (size_t)l * D * DFF, DFF, w.fg, DFF, M, DFF, D);
        G(st, w.h, D, in.p[36] + (size_t)l * D * DFF, DFF, w.fu, DFF, M, DFF, D);
        swiglu<<<EW((size_t)M * DFF)>>>(w.fg, w.fu, w.fg, M * DFF);
        cmp(dc, st, tb + T_ACT, w.fg, DFF, 0, M, DFF);
        G(st, w.fg, DFF, in.p[37] + (size_t)l * DFF * D, D, w.P, D, M, D, DFF);
        resid<<<EW((size_t)M * D)>>>(w.x1, w.x1 + (size_t)MP * D, w.P, mod, 5 * D, w.xres);
        cmp(dc, st, tb + T_X2, w.xres, D, 0, M, D);
        xa = w.xres; xb = w.xres + (size_t)MP * D;
    }
    modnorm<<<M, 256, 0, st>>>(xa, xb, in.p[38], nullptr, 0, 0, out + O_YP, (size_t)MP * D);
}
#undef EW
}
namespace mk {
#define LAS __attribute__((address_space(3)))
#define GAS __attribute__((address_space(1)))
typedef unsigned short bf16;
typedef short bf16x8 __attribute__((ext_vector_type(8)));
typedef float f32x4 __attribute__((ext_vector_type(4)));
typedef float f32x2 __attribute__((ext_vector_type(2)));
typedef unsigned u32x4 __attribute__((ext_vector_type(4)));
typedef unsigned u32x2 __attribute__((ext_vector_type(2)));

constexpr int D = 2048, SEQ = 4096, NB = 2, MP = NB * SEQ, NS = 128, M = MP + NS, MPAD = 8448, NL = 2, NMOD = NB + NS;
constexpr int NIN = 10240, NGU = 11264, DFF = 5632, NADA = 6 * D, RP = 1984, PASTLEN = 8192;
constexpr int NWAVES = 8, NTHR = 512;

constexpr size_t al(size_t x) { return (x + 255) & ~(size_t)255; }
constexpr size_t WL_IN = 0, WL_CAT = WL_IN + al((size_t)NIN * D * 2), WL_O = WL_CAT + al((size_t)D * D * 2), WL_GU = WL_O + al((size_t)D * D * 2), WL_DN = WL_GU + al((size_t)NGU * D * 2),
                 WL_W2 = WL_DN + al((size_t)D * DFF * 2), WL_A2 = WL_W2 + al(512 * 96 * 2), WL_G2 = WL_A2 + al(512 * 96 * 2), WL_V1 = WL_G2 + al(512 * 256 * 2), WL_V2 = WL_V1 + al(32 * 512 * 2),
                 WL_PW = WL_V2 + al(512 * 32 * 2), WL_SIZE = WL_PW + al(4 * 128 * 128 * 2);
constexpr size_t WS_W = 0;
constexpr size_t WS_ROPE = WS_W + 2 * WL_SIZE;
constexpr size_t WS_SILC = WS_ROPE + al((size_t)4097 * 64 * 4);
constexpr size_t WS_MOD = WS_SILC + al((size_t)256 * D * 2);
constexpr size_t WS_X = WS_MOD + al((size_t)NL * NMOD * NADA * 4);
constexpr size_t WS_H = WS_X + al((size_t)MPAD * D * 4);
constexpr size_t WS_Q = WS_H + al((size_t)MPAD * D * 2);
constexpr size_t WS_K = WS_Q + al((size_t)MPAD * 1024 * 2);
constexpr size_t WS_V = WS_K + al((size_t)MPAD * 256 * 2);
constexpr size_t WS_U = WS_V + al((size_t)MPAD * 256 * 2);
constexpr size_t WS_PR = WS_U + al((size_t)MPAD * 512 * 4);
constexpr size_t WS_MG = WS_PR;
constexpr size_t WS_CAT = WS_PR + al((size_t)MPAD * D * 4);
constexpr size_t WS_RW = WS_CAT + al((size_t)MPAD * D * 2);
constexpr size_t RW_STRIDE = al((size_t)MPAD * 512 * 4);
constexpr size_t WS_GT = WS_RW + 9 * RW_STRIDE;
constexpr size_t WS_ADAW = WS_GT;
constexpr size_t WS_END = WS_GT + al((size_t)MPAD * 6144 * 2);
static_assert((size_t)2 * NADA * D * 2 <= (size_t)MPAD * 6144 * 2, "ada weights fit under the gates");

constexpr size_t O_YP = 0, O_YS = O_YP + (size_t)MP * D, O_KP = O_YS + (size_t)NS * D, O_VP = O_KP + (size_t)NL * NB * 128 * 256, O_PP = O_VP + (size_t)NL * NB * 128 * 256,
                 O_SP = O_PP + (size_t)NL * NB * 15 * 512, O_WP = O_SP + (size_t)NL * NB * RP, O_KS = O_WP + (size_t)NL * NB * 8 * 4096, O_VS = O_KS + (size_t)NL * NS * 128 * 256,
                 O_PS = O_VS + (size_t)NL * NS * 128 * 256, O_SS = O_PS + (size_t)NL * NS * 15 * 512, O_WS = O_SS + (size_t)NL * NS * RP, O_END = O_WS + (size_t)NL * NS * 8 * 4096;

__device__ __forceinline__ unsigned f2bf(float f) { unsigned u = __builtin_bit_cast(unsigned, f); return (u + 0x7fffu + ((u >> 16) & 1u)) >> 16; }
__device__ __forceinline__ unsigned pk2(float lo, float hi) { return f2bf(lo) | (f2bf(hi) << 16); }
__device__ __forceinline__ float bf2f(unsigned short b) { return __builtin_bit_cast(float, (unsigned)b << 16); }
__device__ __forceinline__ float bflo(unsigned w) { return __builtin_bit_cast(float, w << 16); }
__device__ __forceinline__ float bfhi(unsigned w) { return __builtin_bit_cast(float, w & 0xffff0000u); }
__device__ __forceinline__ float fsigm(float x) { return 1.f / (1.f + __expf(-x)); }
__device__ __forceinline__ float wave_sum(float v) {
#pragma unroll
    for (int o = 1; o < 64; o <<= 1) v += __shfl_xor(v, o);
    return v;
}
__device__ __forceinline__ int modrow(int m) { return m < MP ? (m >> 12) : NB + (m - MP); }
__device__ __forceinline__ int posidx(int m) { return m < MP ? (m & (SEQ - 1)) : 4096; }
__device__ __forceinline__ int pi_d(int p) { return 32 * ((p >> 2) & 1) + 16 * (p >> 5) + 4 * ((p >> 3) & 3) + (p & 3); }

struct Args { const float* in[39]; float* out; unsigned char* ws; int ph_lo, ph_hi; };

struct Frame {
    LAS unsigned char* lds;
    int tid, lane, wave, G, bid;
    float* out; unsigned char* ws;
};
template <int K> __device__ __forceinline__ const float* inp() { GAS const float* p; asm volatile("s_load_dwordx2 %0, %1, %2\n\ts_waitcnt lgkmcnt(0)" : "=s"(p) : "s"(__builtin_amdgcn_kernarg_segment_ptr()), "n"(K * 8) : "memory"); return (const float*)p; }
#define INP(k) inp<k>()
__device__ __forceinline__ unsigned char* wl(const Frame& F, int l, size_t off) { return F.ws + WS_W + (size_t)l * WL_SIZE + off; }
__device__ __forceinline__ float* rwbuf(const Frame& F, int i) { return (float*)(F.ws + WS_RW + (size_t)i * RW_STRIDE); }
enum { RW_R = 0, RW_W, RW_K, RW_V, RW_A, RW_B, RW_G, RW_Y, RW_VF };

struct TSrc { const float* w; long long d2; int ld; int mode; };
__device__ __forceinline__ const float* colsrc(const TSrc& s, int n) {
    if (s.mode == 0) return s.w + n;
    if (s.mode == 1) {
        if (n < 1280) { const int h = n >> 6, p = n & 63; return s.w + h * 64 + pi_d(p); }
        if (n < 4032) return s.w + n;
        if (n < 4096) return nullptr;
        return s.w + (n - 64);
    }
      { const int g8 = n >> 3, i = n & 7; return (const float*)((const char*)s.w + (i < 4 ? 0ll : s.d2)) + 4 * g8 + (i & 3); }
}
__device__ __forceinline__ void transpose_item(const TSrc& s, int K, bf16* WT, size_t ldt, int kcol0, LAS float* scr, int kb, int nb, int lane) {
    const int k0 = 64 * kb, n0 = 32 * nb;
    const float* cp = colsrc(s, n0 + (lane & 31));
#pragma unroll 8
    for (int i = 0; i < 32; ++i) { const int kk = 2 * i + (lane >> 5); scr[kk * 33 + (lane & 31)] = cp ? cp[(size_t)(k0 + kk) * s.ld] : 0.f; }
    asm volatile("s_waitcnt lgkmcnt(0)" ::: "memory");
    const int c = lane & 7;
#pragma unroll
    for (int j = 0; j < 4; ++j) { const int n = (lane >> 3) + 8 * j; const LAS float* p = scr + (8 * c) * 33 + n;
        u32x4 o; o.x = pk2(p[0 * 33], p[1 * 33]); o.y = pk2(p[2 * 33], p[3 * 33]); o.z = pk2(p[4 * 33], p[5 * 33]); o.w = pk2(p[6 * 33], p[7 * 33]);
        *(u32x4*)(WT + (size_t)(n0 + n) * ldt + kcol0 + k0 + 8 * c) = o; }
    asm volatile("s_waitcnt lgkmcnt(0)" ::: "memory");
}
__device__ __forceinline__ void small_transpose(const float* src, int K, int N, bf16* dst, int ldt, int gt, int ngt) {
    for (int i = gt; i < N * K; i += ngt) { const int n = i / K, k = i - n * K; dst[(size_t)n * ldt + k] = (bf16)f2bf(src[(size_t)k * N + n]); }
}
__device__ __forceinline__ void p0_prologue(const Frame& F) {
    LAS float* scr = (LAS float*)(F.lds + F.wave * 16384);
    const int gw = F.bid * NWAVES + F.wave, NGW = F.G * NWAVES;
    constexpr int J_ADA = 32 * 384, J_IN = 32 * 320, J_CA = 16 * 64, J_CP = 8 * 64, J_CR = 8 * 64, J_O = 32 * 64, J_GU = 32 * 352, J_DN = 88 * 64;
    constexpr int PER_L = J_ADA + J_IN + J_CA + J_CP + J_CR + J_O + J_GU + J_DN;
    for (int it = gw; it < NL * PER_L; it += NGW) {
        const int l = it / PER_L; int r = it - l * PER_L;
        TSrc s; s.d2 = 0; s.mode = 0; bf16* WT; size_t ldt; int K, nn, kcol0 = 0;
        if (r < J_ADA) { s.w = INP(9) + (size_t)l * D * NADA; s.ld = NADA; WT = (bf16*)(F.ws + WS_ADAW) + (size_t)l * NADA * D; ldt = D; K = D; nn = 384; }
        else if ((r -= J_ADA) < J_IN) { s.w = INP(13) + (size_t)l * D * 10176; s.ld = 10176; s.mode = 1; WT = (bf16*)wl(F, l, WL_IN); ldt = D; K = D; nn = 320; }
        else if ((r -= J_IN) < J_CA) { s.w = INP(15) + (size_t)l * 1024 * D; s.ld = D; WT = (bf16*)wl(F, l, WL_CAT); ldt = D; K = 1024; nn = 64; }
        else if ((r -= J_CA) < J_CP) { s.w = INP(18) + (size_t)l * 512 * D; s.ld = D; WT = (bf16*)wl(F, l, WL_CAT); ldt = D; K = 512; nn = 64; kcol0 = 1024; }
        else if ((r -= J_CP) < J_CR) { s.w = INP(30) + (size_t)l * 512 * D; s.ld = D; WT = (bf16*)wl(F, l, WL_CAT); ldt = D; K = 512; nn = 64; kcol0 = 1536; }
        else if ((r -= J_CR) < J_O) { s.w = INP(34) + (size_t)l * D * D; s.ld = D; WT = (bf16*)wl(F, l, WL_O); ldt = D; K = D; nn = 64; }
        else if ((r -= J_O) < J_GU) { s.w = INP(35) + (size_t)l * D * DFF; s.d2 = (const char*)INP(36) - (const char*)INP(35); s.ld = DFF; s.mode = 2; WT = (bf16*)wl(F, l, WL_GU); ldt = D; K = D; nn = 352; }
        else { r -= J_GU; s.w = INP(37) + (size_t)l * DFF * D; s.ld = D; WT = (bf16*)wl(F, l, WL_DN); ldt = DFF; K = DFF; nn = 64; }
        (void)K;
        transpose_item(s, K, WT, ldt, kcol0, scr, r / nn, r % nn, F.lane);
    }
    const int gt = F.bid * NTHR + F.tid, ngt = F.G * NTHR;
    for (int l = 0; l < NL; ++l) {
        small_transpose(INP(21) + (size_t)l * 96 * 512, 96, 512, (bf16*)wl(F, l, WL_W2), 96, gt, ngt);
        small_transpose(INP(23) + (size_t)l * 96 * 512, 96, 512, (bf16*)wl(F, l, WL_A2), 96, gt, ngt);
        small_transpose(INP(24) + (size_t)l * 256 * 512, 256, 512, (bf16*)wl(F, l, WL_G2), 256, gt, ngt);
        for (int g = 0; g < 4; ++g) small_transpose(INP(16) + ((size_t)l * 4 + g) * 128 * 128, 128, 128, (bf16*)wl(F, l, WL_PW) + g * 128 * 128, 128, gt, ngt);
    }
    small_transpose(INP(31), 512, 32, (bf16*)wl(F, 1, WL_V1), 512, gt, ngt);
    small_transpose(INP(32), 32, 512, (bf16*)wl(F, 1, WL_V2), 32, gt, ngt);
    for (int i = gt; i < 256 * D; i += ngt) { const int r = i >> 11, k = i & (D - 1); float v = 0.f;
        if (r < NMOD) { const float c = r < NB ? INP(2)[r * D + k] : INP(3)[(r - NB) * D + k]; v = c / (1.f + expf(-c)); }
        ((bf16*)(F.ws + WS_SILC))[i] = (bf16)f2bf(v); }
    for (int i = gt; i < 4097 * 32; i += ngt) { const int p = i >> 5, d = i & 31; const float pos = p < 4096 ? (float)p : (float)PASTLEN;
        const float inv = powf(10000.f, -(float)d * (2.0f / 64.f)), ang = pos * inv; float* t = (float*)(F.ws + WS_ROPE) + (size_t)p * 64; t[d] = cosf(ang); t[32 + d] = sinf(ang); }
}

__device__ __forceinline__ void norm_phase(const Frame& F, int l, int which  ) {
    const int gw = F.bid * NWAVES + F.wave, NGW = F.G * NWAVES;
    const float* g = which == 0 ? INP(11) + l * D : which == 1 ? INP(12) + l * D : INP(38); const float* xp0 = INP(0); const float* xp1 = INP(1);
    for (int m = gw; m < M; m += NGW) {
        const float* xr = (which == 0 && l == 0) ? (m < MP ? xp0 + (size_t)m * D : xp1 + (size_t)(m - MP) * D) : (const float*)(F.ws + WS_X) + (size_t)m * D;
        f32x4 v[8]; float s = 0.f;
#pragma unroll
        for (int j = 0; j < 8; ++j) { v[j] = *(const f32x4*)(xr + j * 256 + F.lane * 4); s += (v[j].x * v[j].x + v[j].y * v[j].y) + (v[j].z * v[j].z + v[j].w * v[j].w); }
        const float rs = rsqrtf(wave_sum(s) * (1.f / D) + 1e-6f);
        if (which == 2) { float* o = F.out + O_YP + (size_t)m * D;
#pragma unroll
            for (int j = 0; j < 8; ++j) { const f32x4 gg = *(const f32x4*)(g + j * 256 + F.lane * 4); *(f32x4*)(o + j * 256 + F.lane * 4) = v[j] * rs * gg; } }
        else { const float* mod = (const float*)(F.ws + WS_MOD) + ((size_t)l * NMOD + modrow(m)) * NADA + (which == 0 ? 0 : 3 * D);
            bf16* o = (bf16*)(F.ws + WS_H) + (size_t)m * D;
#pragma unroll
            for (int j = 0; j < 8; ++j) { const int c = j * 256 + F.lane * 4; const f32x4 gg = *(const f32x4*)(g + c), sh = *(const f32x4*)(mod + c), sc = *(const f32x4*)(mod + D + c);
                const f32x4 y = v[j] * rs * gg * (sc + 1.f) + sh; u32x2 w; w.x = pk2(y.x, y.y); w.y = pk2(y.z, y.w); *(u32x2*)(o + c) = w; } }
    }
}
}
namespace mk {
constexpr int BM = 256, BK = 64, HALF = 128, HTB = HALF * BK * 2, STAGE_BYTES = 8 * HTB, NXCD = 8, WGM = 8;
__device__ __forceinline__ int lds_byte(int r, int c) { const int st = (r >> 4) * 2 + (c >> 5), rr = r & 15, cc = c & 31, ob = rr * 64 + cc * 2; return st * 1024 + (ob ^ (((ob >> 9) & 1) << 5)); }
__device__ __forceinline__ void stage_rc(int b, int& R, int& C) { const int st = b / 1024, sb = b % 1024, swz = sb ^ (((sb >> 9) & 1) << 5); R = (st >> 1) * 16 + swz / 64; C = (st & 1) * 32 + (swz % 64) / 2; }
__device__ __forceinline__ int perm32(int rho) { const int n = rho >> 4, i = rho & 15; return 8 * (i >> 2) + 4 * n + (i & 3); }

struct Unit { int pm, pn, seg; };
enum { G_ADA = 0, G_IN, G_MG, G_WO, G_GU, G_DN };
struct Gemm { const bf16* A; const bf16* Bt; int ld, M, N, K, mode, layer; };

struct Sched {
    int nM, nN, G, c, nseg;
    __device__ __forceinline__ void init(const Gemm& g, int G_, int c_) { nM = g.M / BM; nN = g.N / BM; G = G_; c = c_; nseg = g.mode == G_MG ? 3 : 1; }
    __device__ __forceinline__ bool next(int i, Unit& u) const {
        const int ti = i / nseg, seg = i - ti * nseg, nwg = nM * nN;
        const long L = (long)ti * G + c; if (L >= nwg) return false;
        int wgid = (int)L; { const int q = nwg / NXCD, r = nwg % NXCD, xcd = wgid % NXCD, off = wgid / NXCD; wgid = (xcd < r ? xcd * (q + 1) : r * (q + 1) + (xcd - r) * q) + off; }
        const int nig = WGM * nN, gid = wgid / nig, fm = gid * WGM, gsz = (nM - fm) < WGM ? (nM - fm) : WGM;
        u.pm = fm + ((wgid % nig) % gsz); u.pn = (wgid % nig) / gsz; u.seg = seg;
        return true;
    }
};

typedef __bf16 bf16x2_t __attribute__((ext_vector_type(2)));
__device__ __forceinline__ unsigned cvt_pk_bf16(float lo, float hi) { const f32x2 v = {lo, hi}; const bf16x2_t b = __builtin_convertvector(v, bf16x2_t); return __builtin_bit_cast(unsigned, b); }
__device__ __forceinline__ f32x4 sig4(f32x4 v) { f32x4 r; r.x = fsigm(v.x); r.y = fsigm(v.y); r.z = fsigm(v.z); r.w = fsigm(v.w); return r; }

struct Epi {
    const Frame* F; int mode, layer;
    __device__ __forceinline__ void operator()(const f32x4 (&acc)[2][2][4][2], const Unit& u, int wr, int wc, int fr, int fq) const {
        const Frame& Fr = *F; const int l = layer;
        int row0 = u.pm * BM + wr * 64 + fr; const int colb = u.pn * BM + wc * 32 + 8 * fq;
        asm volatile("" : "+v"(row0));
        unsigned char* ws = Fr.ws;
        if (mode == G_ADA) {
            const float* ab = INP(10);
#pragma unroll
            for (int ai = 0; ai < 2; ++ai)
#pragma unroll
                for (int m = 0; m < 4; ++m) { const int r = row0 + ai * HALF + m * 16; if (r < NMOD) {
#pragma unroll
                    for (int bj = 0; bj < 2; ++bj) { const int c = colb + bj * HALF, ll = c / NADA, j = c - ll * NADA; float* o = (float*)(ws + WS_MOD) + ((size_t)ll * NMOD + r) * NADA + j;
                        *(f32x4*)o = acc[ai][bj][m][0] + *(const f32x4*)(ab + c); *(f32x4*)(o + 4) = acc[ai][bj][m][1] + *(const f32x4*)(ab + c + 4); } } }
        } else if (mode == G_IN) {
            const int pn = u.pn;
            if (pn < 5) {
                const int wp = wc & 1; const float* rt = (const float*)(ws + WS_ROPE);
#pragma unroll
                for (int ai = 0; ai < 2; ++ai)
#pragma unroll
                    for (int m = 0; m < 4; ++m) { const int r = row0 + ai * HALF + m * 16; if (r < M) {
                        const float* tp = rt + (size_t)posidx(r) * 64 + 16 * wp + 4 * fq; const f32x4 cs = *(const f32x4*)tp, sn = *(const f32x4*)(tp + 32);
#pragma unroll
                        for (int bj = 0; bj < 2; ++bj) { const f32x4 x1 = acc[ai][bj][m][0], x2 = acc[ai][bj][m][1]; const f32x4 o1 = x1 * cs - x2 * sn, o2 = x2 * cs + x1 * sn;
                            u32x4 w; w.x = cvt_pk_bf16(o1.x, o1.y); w.y = cvt_pk_bf16(o1.z, o1.w); w.z = cvt_pk_bf16(o2.x, o2.y); w.w = cvt_pk_bf16(o2.z, o2.w);
                            const int hc = bj * HALF + wc * 32 + 8 * fq;
                            if (pn < 4) *(u32x4*)((bf16*)(ws + WS_Q) + (size_t)r * 1024 + pn * 256 + hc) = w;
                            else { *(u32x4*)((bf16*)(ws + WS_K) + (size_t)r * 256 + hc) = w;
                                const int hk = hc >> 6, d1 = 16 * wp + 4 * fq; float* ko = nullptr;
                                if (r < MP) { const int t = r & (SEQ - 1); if (t >= SEQ - 128) ko = Fr.out + O_KP + ((((size_t)l * NB + (r >> 12)) * 128 + (t - (SEQ - 128))) * 4 + hk) * 64; }
                                else ko = Fr.out + O_KS + ((((size_t)l * NS + (r - MP)) * 128 + 127) * 4 + hk) * 64;
                                if (ko) { *(f32x4*)(ko + d1) = o1; *(f32x4*)(ko + d1 + 32) = o2; } } } } }
            } else if (pn == 5) {
#pragma unroll
                for (int ai = 0; ai < 2; ++ai)
#pragma unroll
                    for (int m = 0; m < 4; ++m) { const int r = row0 + ai * HALF + m * 16; if (r < M) {
#pragma unroll
                        for (int bj = 0; bj < 2; ++bj) { const f32x4 v0 = acc[ai][bj][m][0], v1 = acc[ai][bj][m][1]; const int hc = bj * HALF + wc * 32 + 8 * fq;
                            u32x4 w; w.x = cvt_pk_bf16(v0.x, v0.y); w.y = cvt_pk_bf16(v0.z, v0.w); w.z = cvt_pk_bf16(v1.x, v1.y); w.w = cvt_pk_bf16(v1.z, v1.w);
                            *(u32x4*)((bf16*)(ws + WS_V) + (size_t)r * 256 + hc) = w;
                            float* vo = nullptr;
                            if (r < MP) { const int t = r & (SEQ - 1); if (t >= SEQ - 128) vo = Fr.out + O_VP + (((size_t)l * NB + (r >> 12)) * 128 + (t - (SEQ - 128))) * 256; }
                            else vo = Fr.out + O_VS + (((size_t)l * NS + (r - MP)) * 128 + 127) * 256;
                            if (vo) { *(f32x4*)(vo + hc) = v0; *(f32x4*)(vo + hc + 4) = v1; } } } }
            } else if (pn < 16) {
                float* base = pn < 8 ? (float*)(ws + WS_U) : (float*)(ws + WS_PR); const int ld = pn < 8 ? 512 : 2048, c0 = (pn < 8 ? (pn - 6) : (pn - 8)) * 256 + wc * 32 + 8 * fq;
#pragma unroll
                for (int ai = 0; ai < 2; ++ai)
#pragma unroll
                    for (int m = 0; m < 4; ++m) { const int r = row0 + ai * HALF + m * 16; if (r < M) {
#pragma unroll
                        for (int bj = 0; bj < 2; ++bj) { float* o = base + (size_t)r * ld + c0 + bj * HALF; *(f32x4*)o = acc[ai][bj][m][0]; *(f32x4*)(o + 4) = acc[ai][bj][m][1]; } } }
            } else {
                const int c0 = (pn - 16) * 256 + wc * 32 + 8 * fq;
#pragma unroll
                for (int ai = 0; ai < 2; ++ai)
#pragma unroll
                    for (int m = 0; m < 4; ++m) { const int r = row0 + ai * HALF + m * 16; if (r < M) {
#pragma unroll
                        for (int bj = 0; bj < 2; ++bj) { const f32x4 v0 = sig4(acc[ai][bj][m][0]), v1 = sig4(acc[ai][bj][m][1]);
                            u32x4 w; w.x = cvt_pk_bf16(v0.x, v0.y); w.y = cvt_pk_bf16(v0.z, v0.w); w.z = cvt_pk_bf16(v1.x, v1.y); w.w = cvt_pk_bf16(v1.z, v1.w);
                            *(u32x4*)((bf16*)(ws + WS_GT) + (size_t)r * 6144 + c0 + bj * HALF) = w; } } }
            }
        } else if (mode == G_MG) {
            const int c0 = u.pn * BM + wc * 32 + 8 * fq;
#pragma unroll
            for (int ai = 0; ai < 2; ++ai)
#pragma unroll
                for (int m = 0; m < 4; ++m) { const int r = row0 + ai * HALF + m * 16; if (r < M) {
#pragma unroll
                    for (int bj = 0; bj < 2; ++bj) { const int c = c0 + bj * HALF; const u32x4 gw = *(const u32x4*)((const bf16*)(ws + WS_GT) + (size_t)r * 6144 + u.seg * D + c);
                        bf16* mp = (bf16*)(ws + WS_MG) + (size_t)r * D + c; f32x4 v0 = acc[ai][bj][m][0], v1 = acc[ai][bj][m][1];
                        v0.x *= bflo(gw.x); v0.y *= bfhi(gw.x); v0.z *= bflo(gw.y); v0.w *= bfhi(gw.y); v1.x *= bflo(gw.z); v1.y *= bfhi(gw.z); v1.z *= bflo(gw.w); v1.w *= bfhi(gw.w);
                        if (u.seg > 0) { const u32x4 ow = *(const u32x4*)mp; v0.x += bflo(ow.x); v0.y += bfhi(ow.x); v0.z += bflo(ow.y); v0.w += bfhi(ow.y); v1.x += bflo(ow.z); v1.y += bfhi(ow.z); v1.z += bflo(ow.w); v1.w += bfhi(ow.w); }
                        u32x4 w; w.x = cvt_pk_bf16(v0.x, v0.y); w.y = cvt_pk_bf16(v0.z, v0.w); w.z = cvt_pk_bf16(v1.x, v1.y); w.w = cvt_pk_bf16(v1.z, v1.w); *(u32x4*)mp = w; } } }
        } else if (mode == G_WO || mode == G_DN) {
            const int c0 = u.pn * BM + wc * 32 + 8 * fq; const int goff = mode == G_WO ? 2 * D : 5 * D;
#pragma unroll
            for (int ai = 0; ai < 2; ++ai)
#pragma unroll
                for (int m = 0; m < 4; ++m) { const int r = row0 + ai * HALF + m * 16; if (r < M) {
                    const float* gp = (const float*)(ws + WS_MOD) + ((size_t)l * NMOD + modrow(r)) * NADA + goff;
                    const float* xin = (mode == G_WO && l == 0) ? (r < MP ? INP(0) + (size_t)r * D : INP(1) + (size_t)(r - MP) * D) : (const float*)(ws + WS_X) + (size_t)r * D;
                    float* xo = (float*)(ws + WS_X) + (size_t)r * D;
#pragma unroll
                    for (int bj = 0; bj < 2; ++bj) { const int c = c0 + bj * HALF;
                        const f32x4 g0 = *(const f32x4*)(gp + c), g1 = *(const f32x4*)(gp + c + 4), x0 = *(const f32x4*)(xin + c), x1 = *(const f32x4*)(xin + c + 4);
                        *(f32x4*)(xo + c) = x0 + (g0 + 1.f) * acc[ai][bj][m][0]; *(f32x4*)(xo + c + 4) = x1 + (g1 + 1.f) * acc[ai][bj][m][1]; } } }
        } else {
            const int c0 = u.pn * 128 + wc * 16 + 4 * fq;
#pragma unroll
            for (int ai = 0; ai < 2; ++ai)
#pragma unroll
                for (int m = 0; m < 4; ++m) { const int r = row0 + ai * HALF + m * 16; if (r < M) {
#pragma unroll
                    for (int bj = 0; bj < 2; ++bj) { const f32x4 g = acc[ai][bj][m][0], up = acc[ai][bj][m][1]; const f32x4 a = g * sig4(g) * up;
                        u32x2 w; w.x = cvt_pk_bf16(a.x, a.y); w.y = cvt_pk_bf16(a.z, a.w); *(u32x2*)((bf16*)(ws + WS_GT) + (size_t)r * DFF + c0 + bj * 64) = w; } } }
        }
    }
};

__device__ __forceinline__ void gemm_phase(LAS unsigned char* lds, const Gemm g, const Sched& S, const Epi& E) {
    const int tid = threadIdx.x, wid = __builtin_amdgcn_readfirstlane(tid >> 6), lane = tid & 63, wr = wid >> 2, wc = wid & 3, fr = lane & 15, fq = lane >> 4;
    unsigned voffA[2], voffB[2];
#pragma unroll
    for (int i = 0; i < 2; ++i) { int R, C; stage_rc(tid * 16 + i * 8192, R, C); const int Rb = (R & ~31) + perm32(R & 31);
        voffA[i] = (unsigned)(R * g.ld + C) * 2u; voffB[i] = (unsigned)(Rb * g.ld + C) * 2u; }
    constexpr unsigned kstep = BK * 2;
    const unsigned hstep = (unsigned)HALF * (unsigned)g.ld * 2u; const bool segd = g.mode == G_MG; const int ntfull = g.K / BK;
#define PG8_KA(u) (segd ? ((u).seg == 0 ? 0u : (u).seg == 1 ? 1024u : 1536u) : 0u)
#define PG8_NT(u) (segd ? ((u).seg == 0 ? 16 : 8) : ntfull)
#define PG8_TILE(p, u) (((unsigned)(p) * (unsigned)BM * (unsigned)g.ld + PG8_KA(u)) * 2u)
    const unsigned ldsw = (unsigned)wid * 1024u;
    const int aoff = lds_byte(wr * 64 + fr, fq * 8), boff = lds_byte(wc * 32 + fr, fq * 8);
#define PG8_SA(b, h) (((b) * 2 + (h)) * HTB)
#define PG8_SB(b, h) ((4 + (b) * 2 + (h)) * HTB)
#define PG8_STAGE(bufoff, gbase, soff, voff) do { _Pragma("unroll") for (int _i = 0; _i < 2; ++_i) \
        __builtin_amdgcn_global_load_lds((const unsigned*)((const char*)(gbase) + (size_t)((voff)[_i] + (unsigned)(soff))), (LAS unsigned*)(lds + (bufoff) + ldsw + _i * 8192), 16, 0, 0); } while (0)
#define PG8_STA(bufoff, soff) PG8_STAGE(bufoff, g.A, soff, voffA)
#define PG8_STB(bufoff, soff) PG8_STAGE(bufoff, g.Bt, soff, voffB)
#define PG8_LDA(dst, b, h) do { _Pragma("unroll") for (int m = 0; m < 4; ++m) _Pragma("unroll") for (int k = 0; k < 2; ++k) dst[m][k] = *(const LAS bf16x8*)(lds + PG8_SA(b, h) + aoff + m * 2048 + k * 1024); } while (0)
#define PG8_LDB(dst, b, h) do { _Pragma("unroll") for (int n = 0; n < 2; ++n) _Pragma("unroll") for (int k = 0; k < 2; ++k) dst[n][k] = *(const LAS bf16x8*)(lds + PG8_SB(b, h) + boff + n * 2048 + k * 1024); } while (0)
#define PG8_MMA(ai, bj, At, Bt) do { __builtin_amdgcn_s_setprio(1); _Pragma("unroll") for (int m = 0; m < 4; ++m) _Pragma("unroll") for (int n = 0; n < 2; ++n) _Pragma("unroll") for (int k = 0; k < 2; ++k) \
        acc[ai][bj][m][n] = __builtin_amdgcn_mfma_f32_16x16x32_bf16(Bt[n][k], At[m][k], acc[ai][bj][m][n], 0, 0, 0); __builtin_amdgcn_s_setprio(0); } while (0)
#define PG8_WAIT_V(n) asm volatile("s_waitcnt vmcnt(" #n ")" ::: "memory")
#define PG8_WAIT_L(n) asm volatile("s_waitcnt lgkmcnt(" #n ")" ::: "memory")
#define PG8_BAR __builtin_amdgcn_s_barrier()
#define PG8_SCHED __builtin_amdgcn_sched_barrier(0)
    Unit cur, nxt; int ui = 0;
    if (!S.next(0, cur)) return;
    f32x4 acc[2][2][4][2];
#pragma unroll
    for (int a = 0; a < 2; ++a)
#pragma unroll
        for (int b = 0; b < 2; ++b)
#pragma unroll
            for (int m = 0; m < 4; ++m)
#pragma unroll
                for (int n = 0; n < 2; ++n) acc[a][b][m][n] = (f32x4){0.f, 0.f, 0.f, 0.f};
    bf16x8 At[4][2], B0[2][2], B1[2][2];
    unsigned cA = PG8_TILE(cur.pm, cur), cB = PG8_TILE(cur.pn, cur);
    PG8_STB(PG8_SB(0, 0), cB); PG8_STB(PG8_SB(0, 1), cB + hstep); PG8_STA(PG8_SA(0, 0), cA); PG8_STA(PG8_SA(0, 1), cA + hstep);
    if (wr == 1) PG8_BAR;
    PG8_WAIT_V(2); PG8_BAR;
    PG8_STB(PG8_SB(1, 0), cB + kstep); PG8_STA(PG8_SA(1, 0), cA + kstep); PG8_STB(PG8_SB(1, 1), cB + hstep + kstep);
    PG8_WAIT_V(6); PG8_BAR;
    for (;;) {
        const bool has_next = S.next(ui + 1, nxt);
        const unsigned nA = has_next ? PG8_TILE(nxt.pm, nxt) : cA, nB = has_next ? PG8_TILE(nxt.pn, nxt) : cB;
        const int nt = PG8_NT(cur);
        for (int t = 0; t < nt; t += 2) {
            const bool last = (t == nt - 2);
            const unsigned a1 = cA + (unsigned)(t + 1) * kstep;
            const unsigned a2 = last ? nA : cA + (unsigned)(t + 2) * kstep, b2 = last ? nB : cB + (unsigned)(t + 2) * kstep;
            const unsigned a3 = a2 + kstep, b3 = b2 + kstep;
            PG8_LDB(B0, 0, 0); PG8_LDB(B1, 0, 1); PG8_SCHED; PG8_LDA(At, 0, 0); PG8_STA(PG8_SA(1, 1), a1 + hstep);
            PG8_WAIT_V(8); PG8_WAIT_L(0); PG8_BAR; PG8_MMA(0, 0, At, B0); PG8_MMA(0, 1, At, B1); PG8_BAR; PG8_SCHED;
            PG8_LDA(At, 0, 1); PG8_STB(PG8_SB(0, 0), b2); PG8_STB(PG8_SB(0, 1), b2 + hstep); PG8_STA(PG8_SA(0, 0), a2);
            PG8_WAIT_V(8); PG8_WAIT_L(0); PG8_BAR; PG8_MMA(1, 0, At, B0); PG8_MMA(1, 1, At, B1); PG8_BAR; PG8_SCHED;
            PG8_LDB(B0, 1, 0); PG8_LDB(B1, 1, 1); PG8_SCHED; PG8_LDA(At, 1, 0); PG8_STA(PG8_SA(0, 1), a2 + hstep);
            PG8_WAIT_V(8); PG8_WAIT_L(0); PG8_BAR; PG8_MMA(0, 0, At, B0); PG8_MMA(0, 1, At, B1); PG8_BAR; PG8_SCHED;
            PG8_LDA(At, 1, 1); PG8_STB(PG8_SB(1, 0), b3); PG8_STB(PG8_SB(1, 1), b3 + hstep); PG8_STA(PG8_SA(1, 0), a3);
            PG8_WAIT_V(8); PG8_WAIT_L(0); PG8_BAR; PG8_MMA(1, 0, At, B0); PG8_MMA(1, 1, At, B1); PG8_BAR; PG8_SCHED;
        }
        if (wr == 0) PG8_BAR;
        E(acc, cur, wr, wc, fr, fq);
        if (!has_next) break;
#pragma unroll
        for (int a = 0; a < 2; ++a)
#pragma unroll
            for (int b = 0; b < 2; ++b)
#pragma unroll
                for (int m = 0; m < 4; ++m)
#pragma unroll
                    for (int n = 0; n < 2; ++n) acc[a][b][m][n] = (f32x4){0.f, 0.f, 0.f, 0.f};
        cur = nxt; cA = nA; cB = nB; ++ui;
        if (wr == 1) PG8_BAR;
    }
    PG8_WAIT_V(0);
    PG8_BAR;
#undef PG8_KA
#undef PG8_NT
#undef PG8_TILE
#undef PG8_STA
#undef PG8_STB
#undef PG8_SA
#undef PG8_SB
#undef PG8_STAGE
#undef PG8_LDA
#undef PG8_LDB
#undef PG8_MMA
#undef PG8_WAIT_V
#undef PG8_WAIT_L
#undef PG8_BAR
#undef PG8_SCHED
}
}
namespace mk {
#define MFMA16(a, b, c) __builtin_amdgcn_mfma_f32_16x16x32_bf16((a), (b), (c), 0, 0, 0)
__device__ __forceinline__ bf16x8 pack8(f32x4 a, f32x4 b) { u32x4 w; w.x = cvt_pk_bf16(a.x, a.y); w.y = cvt_pk_bf16(a.z, a.w); w.z = cvt_pk_bf16(b.x, b.y); w.w = cvt_pk_bf16(b.z, b.w); return __builtin_bit_cast(bf16x8, w); }
typedef short s16x4 __attribute__((ext_vector_type(4)));
__device__ __forceinline__ bf16x8 cat44(s16x4 a, s16x4 b) { return (bf16x8){a[0], a[1], a[2], a[3], b[0], b[1], b[2], b[3]}; }
constexpr float LOG2E = 1.4426950408889634f;

constexpr int AK_STRIDE = 144, AV_STRIDE = 560;
constexpr int A_KOFF = 0, A_VOFF = 256 * AK_STRIDE, A_BYTES = A_VOFF + 64 * AV_STRIDE;
__device__ __forceinline__ void attn_prompt_unit(const Frame& F, int l, int b, int blk, int hk) {
    LAS unsigned char* Ks = F.lds + A_KOFF; LAS unsigned char* Vt = F.lds + A_VOFF;
    const bf16* Kg = (const bf16*)(F.ws + WS_K); const bf16* Vg = (const bf16*)(F.ws + WS_V); const bf16* Qg = (const bf16*)(F.ws + WS_Q);
    const int kp0 = blk * 128 - 128;
    for (int ch = F.tid; ch < 2048; ch += NTHR) { const int i = ch >> 3, dc = ch & 7, kp = kp0 + i;
        u32x4 kv = (u32x4){0u, 0u, 0u, 0u}, vv = kv;
        if (kp >= 0) { const size_t m = (size_t)b * SEQ + kp; kv = *(const u32x4*)(Kg + m * 256 + hk * 64 + dc * 8); vv = *(const u32x4*)(Vg + m * 256 + hk * 64 + dc * 8); }
        *(LAS u32x4*)(Ks + i * AK_STRIDE + dc * 16) = kv;
        LAS unsigned short* vp = (LAS unsigned short*)(Vt + (dc * 8) * AV_STRIDE) + i;
        vp[0 * (AV_STRIDE / 2)] = (unsigned short)(vv.x & 0xffff); vp[1 * (AV_STRIDE / 2)] = (unsigned short)(vv.x >> 16); vp[2 * (AV_STRIDE / 2)] = (unsigned short)(vv.y & 0xffff); vp[3 * (AV_STRIDE / 2)] = (unsigned short)(vv.y >> 16);
        vp[4 * (AV_STRIDE / 2)] = (unsigned short)(vv.z & 0xffff); vp[5 * (AV_STRIDE / 2)] = (unsigned short)(vv.z >> 16); vp[6 * (AV_STRIDE / 2)] = (unsigned short)(vv.w & 0xffff); vp[7 * (AV_STRIDE / 2)] = (unsigned short)(vv.w >> 16); }
    for (int i = F.tid; i < 64 * 24; i += NTHR) { const int d = i / 24, c = i % 24; ((LAS unsigned short*)(Vt + d * AV_STRIDE))[256 + c] = 0; }
    __syncthreads();
    const int g = F.lane >> 4, c16 = F.lane & 15;
    const float* sinkp = INP(14) + l * 16;
    for (int it = 0; it < 4; ++it) {
        const int gi = F.wave * 4 + it, hq = hk * 4 + (gi >> 3), qs = gi & 7;
        const int tqr = 16 * qs + c16;
        const size_t mq = (size_t)b * SEQ + blk * 128 + tqr;
        const bf16x8 q0 = *(const bf16x8*)(Qg + mq * 1024 + hq * 64 + 8 * g), q1 = *(const bf16x8*)(Qg + mq * 1024 + hq * 64 + 32 + 8 * g);
        f32x4 s[10];
#pragma unroll
        for (int j = 0; j < 9; ++j) { LAS const unsigned char* kr = Ks + (16 * (qs + j) + c16) * AK_STRIDE + 16 * g;
            const bf16x8 k0 = *(LAS const bf16x8*)kr, k1 = *(LAS const bf16x8*)(kr + 64);
            f32x4 a = (f32x4){0.f, 0.f, 0.f, 0.f}; a = MFMA16(k0, q0, a); a = MFMA16(k1, q1, a); s[j] = a; }
        const float sk2 = sinkp[hq] * LOG2E; float mx = sk2;
#pragma unroll
        for (int j = 0; j < 9; ++j)
#pragma unroll
            for (int r = 0; r < 4; ++r) { const int i = 16 * (qs + j) + 4 * g + r; const bool ok = (i >= tqr) && (i <= tqr + 128) && (kp0 + i >= 0);
                const float v = ok ? s[j][r] * (0.125f * LOG2E) : -1e30f; s[j][r] = v; mx = fmaxf(mx, v); }
        mx = fmaxf(mx, __shfl_xor(mx, 16)); mx = fmaxf(mx, __shfl_xor(mx, 32));
        float sum = 0.f;
#pragma unroll
        for (int j = 0; j < 9; ++j)
#pragma unroll
            for (int r = 0; r < 4; ++r) { const float p = __builtin_amdgcn_exp2f(s[j][r] - mx); s[j][r] = p; sum += p; }
        s[9] = (f32x4){0.f, 0.f, 0.f, 0.f};
        sum += __shfl_xor(sum, 16); sum += __shfl_xor(sum, 32);
        const float rl = 1.f / (sum + __builtin_amdgcn_exp2f(sk2 - mx));
        f32x4 o[4];
#pragma unroll
        for (int dt = 0; dt < 4; ++dt) o[dt] = (f32x4){0.f, 0.f, 0.f, 0.f};
#pragma unroll
        for (int kk = 0; kk < 5; ++kk) { const bf16x8 pf = pack8(s[2 * kk], s[2 * kk + 1]);
#pragma unroll
            for (int dt = 0; dt < 4; ++dt) { LAS const unsigned char* vr = Vt + (16 * dt + c16) * AV_STRIDE + (16 * (qs + 2 * kk) + 4 * g) * 2;
                const s16x4 v0 = *(LAS const s16x4*)vr, v1 = *(LAS const s16x4*)(vr + 32);
                o[dt] = MFMA16(cat44(v0, v1), pf, o[dt]); } }
        bf16* op = (bf16*)(F.ws + WS_CAT) + mq * D + hq * 64 + 4 * g;
#pragma unroll
        for (int dt = 0; dt < 4; ++dt) { const f32x4 v = o[dt] * rl; u32x2 w; w.x = cvt_pk_bf16(v.x, v.y); w.y = cvt_pk_bf16(v.z, v.w); *(u32x2*)(op + 16 * dt) = w; }
    }
    __syncthreads();
}

__device__ __forceinline__ void attn_sample_unit(const Frame& F, int l, int s_) {
    LAS float* qn = (LAS float*)F.lds;
    LAS float* kn = qn + 1024;
    LAS float* vn = kn + 256;
    LAS float* sc = vn + 256;
    LAS float* rl = sc + 16 * 132;
    const int m = MP + s_; const float* sinkp = INP(14) + l * 16;
    const float* ck = INP(4) + ((size_t)l * NS + s_) * 128 * 256; const float* cv = INP(5) + ((size_t)l * NS + s_) * 128 * 256;
    for (int i = F.tid; i < 1024; i += NTHR) { const int h = i >> 6, p = i & 63; qn[h * 64 + pi_d(p)] = bf2f(((const bf16*)(F.ws + WS_Q))[(size_t)m * 1024 + i]) * (0.125f * LOG2E); }
    if (F.tid < 256) { const int h = F.tid >> 6, p = F.tid & 63; kn[h * 64 + pi_d(p)] = bf2f(((const bf16*)(F.ws + WS_K))[(size_t)m * 256 + F.tid]); vn[F.tid] = bf2f(((const bf16*)(F.ws + WS_V))[(size_t)m * 256 + F.tid]); }
    { float* ko = F.out + O_KS + ((size_t)l * NS + s_) * 128 * 256; float* vo = F.out + O_VS + ((size_t)l * NS + s_) * 128 * 256;
      for (int i = F.tid; i < 127 * 64; i += NTHR) { *(f32x4*)(ko + 4 * i) = *(const f32x4*)(ck + 256 + 4 * i); *(f32x4*)(vo + 4 * i) = *(const f32x4*)(cv + 256 + 4 * i); } }
    __syncthreads();
    for (int idx = F.tid; idx < 16 * 129; idx += NTHR) { const int hq = idx / 129, j = idx - hq * 129, hk = hq >> 2; float a = 0.f;
        if (j < 128) { const float* kr = ck + (size_t)j * 256 + hk * 64;
#pragma unroll
            for (int d = 0; d < 64; d += 4) { const f32x4 kv = *(const f32x4*)(kr + d); a += qn[hq * 64 + d] * kv.x + qn[hq * 64 + d + 1] * kv.y + qn[hq * 64 + d + 2] * kv.z + qn[hq * 64 + d + 3] * kv.w; } }
        else { for (int d = 0; d < 64; ++d) a += qn[hq * 64 + d] * kn[hk * 64 + d]; }
        sc[hq * 132 + j] = a; }
    __syncthreads();
    for (int hh = 0; hh < 2; ++hh) { const int hq = F.wave * 2 + hh; const float sk2 = sinkp[hq] * LOG2E;
        float mx = sk2; for (int j = F.lane; j < 129; j += 64) mx = fmaxf(mx, sc[hq * 132 + j]);
#pragma unroll
        for (int o = 1; o < 64; o <<= 1) mx = fmaxf(mx, __shfl_xor(mx, o));
        float sum = 0.f; for (int j = F.lane; j < 129; j += 64) { const float p = __builtin_amdgcn_exp2f(sc[hq * 132 + j] - mx); sc[hq * 132 + j] = p; sum += p; }
        sum = wave_sum(sum); if (F.lane == 0) rl[hq] = 1.f / (sum + __builtin_amdgcn_exp2f(sk2 - mx)); }
    __syncthreads();
    for (int idx = F.tid; idx < 1024; idx += NTHR) { const int hq = idx >> 6, d = idx & 63, hk = hq >> 2; float a = 0.f;
        for (int j = 0; j < 128; ++j) a += sc[hq * 132 + j] * cv[(size_t)j * 256 + hk * 64 + d];
        a += sc[hq * 132 + 128] * vn[hk * 64 + d];
        ((bf16*)(F.ws + WS_CAT))[(size_t)m * D + idx] = (bf16)f2bf(a * rl[hq]); }
    __syncthreads();
}

constexpr int PL_STRIDE = 272;
__device__ __forceinline__ void pool_unit(const Frame& F, int l, int rt, int gi) {
    LAS unsigned char* dT = F.lds; LAS unsigned char* Wt = F.lds + 128 * PL_STRIDE;
    const float* U = (const float*)(F.ws + WS_U); const int w = 2 << gi, m0 = rt * 128;
    { const bf16* pw = (const bf16*)wl(F, l, WL_PW) + (size_t)gi * 128 * 128;
      for (int ch = F.tid; ch < 2048; ch += NTHR) { const int e = ch >> 4, cc = ch & 15; *(LAS u32x4*)(Wt + e * PL_STRIDE + cc * 16) = *(const u32x4*)(pw + e * 128 + cc * 8); } }
    { const int c = F.tid & 127, strip = F.tid >> 7, col = gi * 128 + c;
      if (rt < 64) { const int t0 = (m0 & (SEQ - 1)) + 32 * strip; const float* up = U + (size_t)(m0 + 32 * strip) * 512 + col;
          float sum = 0.f; for (int j = 1; j < w; ++j) if (t0 - j >= 0) sum += up[-(ptrdiff_t)j * 512];
          for (int k = 0; k < 32; ++k) { const int t = t0 + k; const float uc = up[(size_t)k * 512]; sum += uc; const float cnt = (float)(t + 1 < w ? t + 1 : w);
              ((LAS unsigned short*)(dT + (32 * strip + k) * PL_STRIDE))[c] = (unsigned short)f2bf(sum / cnt - uc);
              if (t - w + 1 >= 0) sum -= up[(ptrdiff_t)(k - w + 1) * 512]; } }
      else { const float* sp = INP(6) + (size_t)l * NS * 15 * 512;
          for (int k = 0; k < 32; ++k) { const int s_ = 32 * strip + k; const float uc = U[(size_t)(MP + s_) * 512 + col]; float sum = uc;
              for (int j = 1; j < w; ++j) sum += sp[((size_t)s_ * 15 + 15 - j) * 512 + col];
              ((LAS unsigned short*)(dT + s_ * PL_STRIDE))[c] = (unsigned short)f2bf(sum / (float)w - uc); } } }
    __syncthreads();
    const int g = F.lane >> 4, c16 = F.lane & 15;
    f32x4 acc[8];
#pragma unroll
    for (int et = 0; et < 8; ++et) acc[et] = (f32x4){0.f, 0.f, 0.f, 0.f};
#pragma unroll
    for (int ks = 0; ks < 4; ++ks) { const bf16x8 df = *(LAS const bf16x8*)(dT + (16 * F.wave + c16) * PL_STRIDE + (32 * ks + 8 * g) * 2);
#pragma unroll
        for (int et = 0; et < 8; ++et) { const bf16x8 wf = *(LAS const bf16x8*)(Wt + (16 * et + c16) * PL_STRIDE + (32 * ks + 8 * g) * 2); acc[et] = MFMA16(wf, df, acc[et]); } }
    const int m = m0 + 16 * F.wave + c16; const float* psc = INP(17) + l * 512 + gi * 128;
    if (m < M) { bf16* op = (bf16*)(F.ws + WS_CAT) + (size_t)m * D + 1024 + gi * 128 + 4 * g;
#pragma unroll
        for (int et = 0; et < 8; ++et) { const f32x4 v = acc[et] * *(const f32x4*)(psc + 16 * et + 4 * g); u32x2 wv; wv.x = cvt_pk_bf16(v.x, v.y); wv.y = cvt_pk_bf16(v.z, v.w); *(u32x2*)(op + 16 * et) = wv; } }
    __syncthreads();
}
__device__ __forceinline__ void state_outs(const Frame& F, int l) {
    const int gt = F.bid * NTHR + F.tid, ngt = F.G * NTHR; const float* U = (const float*)(F.ws + WS_U); const float* PR = (const float*)(F.ws + WS_PR);
    for (int i = gt; i < NB * 15 * 512; i += ngt) { const int b = i / (15 * 512), j = (i >> 9) % 15, c = i & 511; F.out[O_PP + (size_t)l * NB * 15 * 512 + i] = U[((size_t)b * SEQ + SEQ - 15 + j) * 512 + c]; }
    const float* sp = INP(6) + (size_t)l * NS * 15 * 512;
    for (int i = gt; i < NS * 15 * 512; i += ngt) { const int s_ = i / (15 * 512), j = (i >> 9) % 15, c = i & 511; F.out[O_PS + (size_t)l * NS * 15 * 512 + i] = j < 14 ? sp[i + 512] : U[(size_t)(MP + s_) * 512 + c]; }
    for (int i = gt; i < NB * RP; i += ngt) { const int b = i / RP, c = i - b * RP; F.out[O_SP + (size_t)l * NB * RP + i] = PR[((size_t)b * SEQ + SEQ - 1) * 2048 + c]; }
    for (int i = gt; i < NS * RP; i += ngt) { const int s_ = i / RP, c = i - s_ * RP; F.out[O_SS + (size_t)l * NS * RP + i] = PR[(size_t)(MP + s_) * 2048 + c]; }
}

constexpr int RA_STRIDE = 1936;
constexpr int R_T1OFF = 32 * RA_STRIDE, RT_STRIDE = 80;
struct XmRow { const float* p; const float* pv; float pz; };
__device__ __forceinline__ XmRow xm_row(const float* PR, const float* sshift, int m) {
    XmRow r; r.p = PR + (size_t)m * 2048; const bool first = m < MP && (m & (SEQ - 1)) == 0;
    r.pv = m >= MP ? sshift + (size_t)(m - MP) * RP : first ? r.p : r.p - 2048; r.pz = first ? 0.f : 1.f; return r;
}
__device__ __forceinline__ float xm_at(const XmRow& r, const float* mu, int c) { const float p = r.p[c]; return p + (r.pv[c] * r.pz - p) * mu[c]; }
__device__ __forceinline__ f32x4 xm4_at(const XmRow& r, const float* mu, int c) { const f32x4 p = *(const f32x4*)(r.p + c); return p + (*(const f32x4*)(r.pv + c) * r.pz - p) * *(const f32x4*)(mu + c); }
template <int KS> __device__ __forceinline__ void lora_mm(f32x4 (&acc)[4], const bf16* Wt, int ldw, int nbase, LAS const unsigned char* Arow, int acol, int g, int c16) {
#pragma unroll
    for (int nt = 0; nt < 4; ++nt) acc[nt] = (f32x4){0.f, 0.f, 0.f, 0.f};
#pragma unroll 1
    for (int ks = 0; ks < KS; ++ks) { const bf16x8 af = *(LAS const bf16x8*)(Arow + (acol + 32 * ks + 8 * g) * 2);
#pragma unroll
        for (int nt = 0; nt < 4; ++nt) { const bf16x8 wf = *(const bf16x8*)(Wt + (size_t)(nbase + 16 * nt + c16) * ldw + 32 * ks + 8 * g); acc[nt] = MFMA16(wf, af, acc[nt]); } }
}
__device__ __forceinline__ float frcp(float x) { return __builtin_amdgcn_rcpf(x); }
__device__ __forceinline__ f32x4 fsig4(f32x4 v) { f32x4 r; r.x = frcp(1.f + __expf(-v.x)); r.y = frcp(1.f + __expf(-v.y)); r.z = frcp(1.f + __expf(-v.z)); r.w = frcp(1.f + __expf(-v.w)); return r; }
__device__ __forceinline__ void rwkv_prep_unit(const Frame& F, int l, int ti) {
    LAS unsigned char* Aop = F.lds; LAS unsigned char* T1 = F.lds + R_T1OFF;
    const float* PR = (const float*)(F.ws + WS_PR); const float* sshift = INP(7) + (size_t)l * NS * RP; const float* mu = INP(19) + l * RP;
    const int m0 = ti * 32; const bool vres = l > 0;
    const float* a0p = INP(22) + l * 512; const float* w0p = INP(20) + l * 512; const float* vbp = INP(33); const float* kkp = INP(25) + l * 512; const float* kap = INP(26) + l * 512;
    for (int i = F.tid; i < 32 * 448; i += NTHR) { const int r = i / 448, c = i - r * 448; const XmRow xr = xm_row(PR, sshift, m0 + r); const float x = xm_at(xr, mu, 1536 + c);
        const float y = c < 96 ? 1.f - 2.f / (1.f + __expf(2.f * x)) : c < 192 ? x : fsigm(x); ((LAS unsigned short*)(Aop + r * RA_STRIDE))[c] = (unsigned short)f2bf(y); }
    if (vres) for (int i = F.tid; i < 32 * 512; i += NTHR) { const int r = i >> 9, c = i & 511; const XmRow xr = xm_row(PR, sshift, m0 + r); ((LAS unsigned short*)(Aop + r * RA_STRIDE))[448 + c] = (unsigned short)f2bf(xm_at(xr, mu, 1024 + c)); }
    __syncthreads();
    const int g = F.lane >> 4, c16 = F.lane & 15, nb = 64 * F.wave;
    if (vres) {
        if (F.wave < 4) { const int mt = F.wave >> 1, nt = F.wave & 1; f32x4 a = (f32x4){0.f, 0.f, 0.f, 0.f}; const bf16* w1 = (const bf16*)wl(F, 1, WL_V1);
#pragma unroll 2
            for (int ks = 0; ks < 16; ++ks) { const bf16x8 af = *(LAS const bf16x8*)(Aop + (16 * mt + c16) * RA_STRIDE + (448 + 32 * ks + 8 * g) * 2);
                const bf16x8 wf = *(const bf16x8*)(w1 + (size_t)(16 * nt + c16) * 512 + 32 * ks + 8 * g); a = MFMA16(wf, af, a); }
            u32x2 wv; wv.x = cvt_pk_bf16(a.x, a.y); wv.y = cvt_pk_bf16(a.z, a.w); *(LAS u32x2*)(T1 + (16 * mt + c16) * RT_STRIDE + (16 * nt + 4 * g) * 2) = wv;
#if MK_DEBUG
            *(f32x4*)((float*)(F.ws + WS_H) + (size_t)(m0 + 16 * mt + c16) * 32 + 16 * nt + 4 * g) = a;
#endif
            }
        __syncthreads();
    }
    float* Rb = rwbuf(F, RW_R); float* Wb = rwbuf(F, RW_W); float* Kb = rwbuf(F, RW_K); float* Vb = rwbuf(F, RW_V); float* Ab = rwbuf(F, RW_A); float* Bb = rwbuf(F, RW_B); float* Gb = rwbuf(F, RW_G); float* VF = rwbuf(F, RW_VF);
#pragma unroll 1
    for (int mt = 0; mt < 2; ++mt) {
        f32x4 acc[4], av[4]; LAS const unsigned char* Arow = Aop + (16 * mt + c16) * RA_STRIDE;
        int m = m0 + 16 * mt + c16; asm volatile("" : "+v"(m)); const size_t ro = (size_t)m * 512 + nb + 4 * g;
        lora_mm<3>(acc, (const bf16*)wl(F, l, WL_A2), 96, nb, Arow, 96, g, c16);
#pragma unroll
        for (int nt = 0; nt < 4; ++nt) av[nt] = fsig4(acc[nt] + *(const f32x4*)(a0p + nb + 16 * nt + 4 * g));
        lora_mm<3>(acc, (const bf16*)wl(F, l, WL_W2), 96, nb, Arow, 0, g, c16);
#pragma unroll
        for (int nt = 0; nt < 4; ++nt) { const f32x4 z = acc[nt] + *(const f32x4*)(w0p + nb + 16 * nt + 4 * g); f32x4 dec;
#pragma unroll
            for (int e = 0; e < 4; ++e) { const float zz = -z[e]; const float sp = fmaxf(zz, 0.f) + __logf(1.f + __expf(-fabsf(zz))); dec[e] = __expf(-__expf(-sp - 0.5f)); }
            *(f32x4*)(Wb + ro + 16 * nt) = dec; }
        lora_mm<8>(acc, (const bf16*)wl(F, l, WL_G2), 256, nb, Arow, 192, g, c16);
#pragma unroll
        for (int nt = 0; nt < 4; ++nt) *(f32x4*)(Gb + ro + 16 * nt) = acc[nt];
        if (vres) { const bf16x8 tf = *(LAS const bf16x8*)(T1 + (16 * mt + c16) * RT_STRIDE + (8 * g) * 2); const f32x4 z4 = (f32x4){0.f, 0.f, 0.f, 0.f};
#pragma unroll
            for (int nt = 0; nt < 4; ++nt) { const bf16x8 wf = *(const bf16x8*)((const bf16*)wl(F, 1, WL_V2) + (size_t)(nb + 16 * nt + c16) * 32 + 8 * g); acc[nt] = MFMA16(wf, tf, z4);
#if MK_DEBUG
                *(f32x4*)(rwbuf(F, RW_Y) + ro + 16 * nt) = acc[nt];
#endif
            } }
        f32x4 kk[4]; float ss = 0.f; const XmRow xr = xm_row(PR, sshift, m);
#pragma unroll
        for (int nt = 0; nt < 4; ++nt) { const int n = nb + 16 * nt + 4 * g; const f32x4 k = xm4_at(xr, mu, 512 + n);
            kk[nt] = k * *(const f32x4*)(kkp + n); ss += (kk[nt].x * kk[nt].x + kk[nt].y * kk[nt].y) + (kk[nt].z * kk[nt].z + kk[nt].w * kk[nt].w);
            *(f32x4*)(Kb + ro + 16 * nt) = k * ((av[nt] - 1.f) * *(const f32x4*)(kap + n) + 1.f);
            asm volatile("" ::: "memory"); }
#pragma unroll
        for (int nt = 0; nt < 4; ++nt) { const int n = nb + 16 * nt + 4 * g; const f32x4 r = xm4_at(xr, mu, n); f32x4 v = xm4_at(xr, mu, 1024 + n);
            *(f32x4*)(Rb + ro + 16 * nt) = r;
            if (!vres) *(f32x4*)(VF + ro + 16 * nt) = v;
            else { const f32x4 vf = *(const f32x4*)(VF + ro + 16 * nt); v = v + (vf - v) * fsig4(acc[nt] + *(const f32x4*)(vbp + n)); }
            *(f32x4*)(Vb + ro + 16 * nt) = v;
            asm volatile("" ::: "memory"); }
        ss += __shfl_xor(ss, 16); ss += __shfl_xor(ss, 32);
        const float rn = 1.f / fmaxf(sqrtf(ss), 1e-12f);
#pragma unroll
        for (int nt = 0; nt < 4; ++nt) { const f32x4 kn = kk[nt] * rn; *(f32x4*)(Ab + ro + 16 * nt) = -kn; *(f32x4*)(Bb + ro + 16 * nt) = kn * av[nt]; }
    }
    __syncthreads();
}

template <int CTRL> __device__ __forceinline__ float dpp_f(float x) { return __builtin_bit_cast(float, __builtin_amdgcn_mov_dpp(__builtin_bit_cast(int, x), CTRL, 0xf, 0xf, true)); }
__device__ __forceinline__ float row16_sum(float x) {
    x += dpp_f<0xB1>(x); x += dpp_f<0x4E>(x); x += dpp_f<0x141>(x); x += dpp_f<0x128>(x); return x;
}
constexpr int SC_T = 32, SC_ARR = SC_T * 64 * 4, SC_BUF = 5 * SC_ARR + SC_T * 16 * 4, SC_YOFF = 2 * SC_BUF;
__device__ __forceinline__ void scan_prompt_unit(const Frame& F, int l, int b, int h, int qt) {
    const float* src0 = rwbuf(F, RW_W); const float* src1 = rwbuf(F, RW_A); const float* src2 = rwbuf(F, RW_B); const float* src3 = rwbuf(F, RW_K); const float* src4 = rwbuf(F, RW_R);
    const float* Vb = rwbuf(F, RW_V); float* Yb = rwbuf(F, RW_Y);
    const size_t rowb = (size_t)b * SEQ;
    f32x4 st0, st1, st2, st3, st4, st5;
#define SC_ISSUE(t0_) do { const int tt_ = F.tid >> 4, c4_ = F.tid & 15; const size_t ro_ = (rowb + (t0_) + tt_) * 512 + h * 64 + 4 * c4_; \
        st0 = *(const f32x4*)(src0 + ro_); st1 = *(const f32x4*)(src1 + ro_); st2 = *(const f32x4*)(src2 + ro_); st3 = *(const f32x4*)(src3 + ro_); st4 = *(const f32x4*)(src4 + ro_); \
        if (F.tid < 128) { const int tv_ = F.tid >> 2, cv_ = F.tid & 3; st5 = *(const f32x4*)(Vb + (rowb + (t0_) + tv_) * 512 + h * 64 + qt * 16 + 4 * cv_); } } while (0)
#define SC_COMMIT(buf_) do { LAS unsigned char* bp_ = F.lds + (buf_) * SC_BUF + F.tid * 16; \
        *(LAS f32x4*)(bp_ + 0 * SC_ARR) = st0; *(LAS f32x4*)(bp_ + 1 * SC_ARR) = st1; *(LAS f32x4*)(bp_ + 2 * SC_ARR) = st2; *(LAS f32x4*)(bp_ + 3 * SC_ARR) = st3; *(LAS f32x4*)(bp_ + 4 * SC_ARR) = st4; \
        if (F.tid < 128) *(LAS f32x4*)(bp_ + 5 * SC_ARR) = st5; } while (0)
    SC_ISSUE(0); SC_COMMIT(0); __syncthreads();
    const int rg = F.lane >> 4, j4 = F.lane & 15, rloc = F.wave * 4 + rg;
    f32x4 s = (f32x4){0.f, 0.f, 0.f, 0.f};
    constexpr int NCH = SEQ / SC_T;
    for (int ch = 0; ch < NCH; ++ch) {
        if (ch + 1 < NCH) SC_ISSUE((ch + 1) * SC_T);
        if (F.wave < 4) { LAS const unsigned char* bp = F.lds + (ch & 1) * SC_BUF; LAS float* yb = (LAS float*)(F.lds + SC_YOFF + (ch & 1) * (SC_T * 16 * 4));
#pragma unroll 4
            for (int tt = 0; tt < SC_T; ++tt) {
                const f32x4 w = *(LAS const f32x4*)(bp + 0 * SC_ARR + tt * 256 + j4 * 16), a = *(LAS const f32x4*)(bp + 1 * SC_ARR + tt * 256 + j4 * 16), bb = *(LAS const f32x4*)(bp + 2 * SC_ARR + tt * 256 + j4 * 16),
                            k = *(LAS const f32x4*)(bp + 3 * SC_ARR + tt * 256 + j4 * 16), r = *(LAS const f32x4*)(bp + 4 * SC_ARR + tt * 256 + j4 * 16);
                const float v = *(LAS const float*)(bp + 5 * SC_ARR + (tt * 16 + rloc) * 4);
                const float sa = row16_sum((s.x * a.x + s.y * a.y) + (s.z * a.z + s.w * a.w));
                const f32x4 p = s * w + k * v;
                s = bb * sa + p;
                const float y = row16_sum((s.x * r.x + s.y * r.y) + (s.z * r.z + s.w * r.w));
                if (j4 == 0) yb[tt * 16 + rloc] = y;
            } }
        if (ch + 1 < NCH) SC_COMMIT((ch + 1) & 1);
        __syncthreads();
        { LAS const float* yb = (LAS const float*)(F.lds + SC_YOFF + (ch & 1) * (SC_T * 16 * 4)); const int tt = F.tid >> 4, i = F.tid & 15;
          Yb[(rowb + ch * SC_T + tt) * 512 + h * 64 + qt * 16 + i] = yb[F.tid]; }
    }
    if (F.wave < 4) *(f32x4*)(F.out + O_WP + ((((size_t)l * NB + b) * 8 + h) * 64 + qt * 16 + rloc) * 64 + 4 * j4) = s;
    __syncthreads();
}
__device__ __forceinline__ void scan_sample_wave(const Frame& F, int l, int s_, int h) {
    const size_t m = MP + s_; const int rg = F.lane >> 4, j4 = F.lane & 15; const size_t o = m * 512 + h * 64 + 4 * j4;
    const f32x4 w = *(const f32x4*)(rwbuf(F, RW_W) + o), a = *(const f32x4*)(rwbuf(F, RW_A) + o), bb = *(const f32x4*)(rwbuf(F, RW_B) + o), k = *(const f32x4*)(rwbuf(F, RW_K) + o), r = *(const f32x4*)(rwbuf(F, RW_R) + o);
    const float* S0 = INP(8) + (((size_t)l * NS + s_) * 8 + h) * 4096; float* S1 = F.out + O_WS + (((size_t)l * NS + s_) * 8 + h) * 4096;
#pragma unroll 4
    for (int i0 = 0; i0 < 16; ++i0) { const int i = 4 * i0 + rg; f32x4 s = *(const f32x4*)(S0 + i * 64 + 4 * j4); const float v = rwbuf(F, RW_V)[m * 512 + h * 64 + i];
        const float sa = row16_sum((s.x * a.x + s.y * a.y) + (s.z * a.z + s.w * a.w));
        s = s * w + bb * sa + k * v;
        const float y = row16_sum((s.x * r.x + s.y * r.y) + (s.z * r.z + s.w * r.w));
        *(f32x4*)(S1 + i * 64 + 4 * j4) = s; if (j4 == 0) rwbuf(F, RW_Y)[m * 512 + h * 64 + i] = y; }
}
__device__ __forceinline__ void rwkv_post_phase(const Frame& F, int l) {
    const int gw = F.bid * NWAVES + F.wave, NGW = F.G * NWAVES; const float* rkp = INP(27) + l * 512; const float* lgp = INP(28) + l * 512; const float* lbp = INP(29) + l * 512;
    for (int it = gw; it < M * 8; it += NGW) { const int m = it >> 3, h = it & 7, c = h * 64 + F.lane; const size_t o = (size_t)m * 512 + c;
        const float y = rwbuf(F, RW_Y)[o]; const float mu = wave_sum(y) * (1.f / 64.f); const float dv = y - mu; const float var = wave_sum(dv * dv) * (1.f / 64.f);
        const float bon = wave_sum(rwbuf(F, RW_R)[o] * rwbuf(F, RW_K)[o] * rkp[c]);
        const float out = (dv * rsqrtf(var + 64e-5f) * lgp[c] + lbp[c] + bon * rwbuf(F, RW_V)[o]) * rwbuf(F, RW_G)[o];
        ((bf16*)(F.ws + WS_CAT))[(size_t)m * D + 1536 + c] = (bf16)f2bf(out); }
}
}
namespace mk {
namespace cg = cooperative_groups;
constexpr int LDS_BYTES = 135168;
constexpr int PH_PRO = 0, PH_ADA = 1, PH_L0 = 2, PH_PER_L = 10, PH_FINAL = PH_L0 + NL * PH_PER_L, N_PHASES = PH_FINAL + 1;
enum { LP_NORM1 = 0, LP_IN, LP_MIX, LP_SCAN, LP_POST, LP_MG, LP_WO, LP_NORM2, LP_GU, LP_DN };

__device__ __forceinline__ void mix_phase(const Frame& F, int l) {
#ifndef MK_NO_U1
    for (int u = F.bid; u < 260; u += F.G) rwkv_prep_unit(F, l, u);
#endif
#ifndef MK_NO_U2
    for (int a = (F.bid + 252) % F.G; a < 256; a += F.G) attn_prompt_unit(F, l, a >> 7, (a >> 2) & 31, a & 3);
#endif
#ifndef MK_NO_U3
    for (int p = (F.bid + 248) % F.G; p < 260; p += F.G) pool_unit(F, l, p >> 2, p & 3);
#endif
#ifndef MK_NO_U4
    for (int s_ = (F.bid + 244) % F.G; s_ < NS; s_ += F.G) attn_sample_unit(F, l, s_);
#endif
    state_outs(F, l);
}
__device__ __forceinline__ void scan_phase(const Frame& F, int l) {
    if (F.bid < 64) scan_prompt_unit(F, l, F.bid >> 5, (F.bid >> 2) & 7, F.bid & 3);
    else { const int nw = (F.G - 64) * NWAVES; for (int u = (F.bid - 64) * NWAVES + F.wave; u < NS * 8; u += nw) scan_sample_wave(F, l, u >> 3, u & 7); }
}

__global__ void __launch_bounds__(NTHR, 2) mega(Args args) {
    extern __shared__ __attribute__((aligned(16))) unsigned char lds_raw[];
    cg::grid_group grid = cg::this_grid();
    for (int ph = args.ph_lo; ph < args.ph_hi; ++ph) {
        Frame F; { GAS unsigned char* ws_ = (GAS unsigned char*)args.ws; GAS float* out_ = (GAS float*)args.out; int tid_ = threadIdx.x; int bid_ = blockIdx.x; int G_ = gridDim.x;
            asm volatile("" : "+s"(ws_), "+s"(out_), "+v"(tid_), "+s"(bid_), "+s"(G_));
            F.lds = (LAS unsigned char*)lds_raw; F.tid = tid_; F.lane = tid_ & 63; F.wave = __builtin_amdgcn_readfirstlane(tid_ >> 6); F.G = G_; F.bid = bid_; F.out = (float*)out_; F.ws = (unsigned char*)ws_; }
        const int l = ph >= PH_L0 && ph < PH_FINAL ? (ph - PH_L0) / PH_PER_L : 0, lp = ph >= PH_L0 && ph < PH_FINAL ? (ph - PH_L0) % PH_PER_L : -1;
#ifndef MK_NO_PRO
        if (ph == PH_PRO) p0_prologue(F); else
#endif
#ifndef MK_NO_NORM
        if (ph == PH_FINAL || lp == LP_NORM1 || lp == LP_NORM2) norm_phase(F, l, ph == PH_FINAL ? 2 : lp == LP_NORM1 ? 0 : 1); else
#endif
#ifndef MK_NO_MIX
        if (lp == LP_MIX) mix_phase(F, l); else
#endif
#ifndef MK_NO_SCAN
        if (lp == LP_SCAN) scan_phase(F, l); else
#endif
#ifndef MK_NO_POST
        if (lp == LP_POST) rwkv_post_phase(F, l); else
#endif
#ifndef MK_NO_GEMM
        {
            Gemm g; g.layer = l; g.ld = D; g.M = MPAD; g.K = D;
            if (ph == PH_ADA) { g.A = (const bf16*)(F.ws + WS_SILC); g.Bt = (const bf16*)(F.ws + WS_ADAW); g.M = 256; g.N = 2 * NADA; g.mode = G_ADA; }
            else if (lp == LP_IN) { g.A = (const bf16*)(F.ws + WS_H); g.Bt = (const bf16*)wl(F, l, WL_IN); g.N = NIN; g.mode = G_IN; }
            else if (lp == LP_MG) { g.A = (const bf16*)(F.ws + WS_CAT); g.Bt = (const bf16*)wl(F, l, WL_CAT); g.N = D; g.mode = G_MG; }
            else if (lp == LP_WO) { g.A = (const bf16*)(F.ws + WS_MG); g.Bt = (const bf16*)wl(F, l, WL_O); g.N = D; g.mode = G_WO; }
            else if (lp == LP_GU) { g.A = (const bf16*)(F.ws + WS_H); g.Bt = (const bf16*)wl(F, l, WL_GU); g.N = NGU; g.mode = G_GU; }
            else { g.A = (const bf16*)(F.ws + WS_GT); g.Bt = (const bf16*)wl(F, l, WL_DN); g.N = D; g.K = DFF; g.ld = DFF; g.mode = G_DN; }
            Sched S; S.init(g, F.G, F.bid); Epi E; E.F = &F; E.mode = g.mode; E.layer = l;
            gemm_phase(F.lds, g, S, E);
        }
#else
        {}
#endif
        if (ph + 1 < args.ph_hi) grid.sync();
    }
}
}
#ifndef MK_DEBUG
#define MK_DEBUG 0
#endif
extern "C" void kernel_launch(void* const* d_in, const int* in_sizes, int n_in, void* d_out, int out_size, void* d_ws, size_t ws_size, hipStream_t stream) {
    using namespace mk;
    static int grid = 0;
    if (grid == 0) {
        nv::WS wtmp; const size_t need_nv = nv::carve((float*)d_ws, wtmp) * 4; const size_t need = MK_DEBUG ? (need_nv > WS_END ? need_nv : WS_END) + (16u << 20) : WS_END;
        if (n_in != 39 || (size_t)out_size != O_END || ws_size < need) { fprintf(stderr, "kernel_launch: unexpected shapes: n_in %d out %d (want %zu) ws %zu (need %zu)\n", n_in, out_size, (size_t)O_END, ws_size, need); grid = -1; return; }
        int dev = 0, cus = 0, per_cu = 0;
        if (hipGetDevice(&dev) != hipSuccess || hipDeviceGetAttribute(&cus, hipDeviceAttributeMultiprocessorCount, dev) != hipSuccess) { grid = -1; return; }
        if (hipFuncSetAttribute((const void*)mega, hipFuncAttributeMaxDynamicSharedMemorySize, LDS_BYTES) != hipSuccess) { fprintf(stderr, "kernel_launch: hipFuncSetAttribute failed\n"); grid = -1; return; }
        if (hipOccupancyMaxActiveBlocksPerMultiprocessor(&per_cu, (const void*)mega, NTHR, LDS_BYTES) != hipSuccess || per_cu < 1) { fprintf(stderr, "kernel_launch: occupancy query says %d blocks per CU\n", per_cu); per_cu = 1; }
        (void)hipGetLastError();
        grid = cus;
        fprintf(stderr, "kernel_launch: grid %d (cus %d, per_cu %d), ws %zu need %zu\n", grid, cus, per_cu, ws_size, need);
    }
    if (grid < 0) return;
    Args a{};
    for (int i = 0; i < 39; ++i) a.in[i] = (const float*)d_in[i];
    a.out = (float*)d_out; a.ws = (unsigned char*)d_ws;
#if MK_DEBUG
    dbg::Ctx dc; dc.probes = (float*)((unsigned char*)d_ws + ((ws_size - (12u << 20)) & ~(size_t)255)); dc.err = dc.probes + (size_t)dbg::NIDS * dbg::NPROBE; dc.on = 1;
    (void)hipMemsetAsync(dc.err, 0, dbg::NIDS * 4 * sizeof(float), stream);
    unsigned char* ws = (unsigned char*)d_ws;
    for (int ph = 0; ph < N_PHASES; ++ph) {
        a.ph_lo = ph; a.ph_hi = ph + 1;
        hipLaunchKernelGGL(mega, dim3(grid), dim3(NTHR), LDS_BYTES, stream, a);
        using namespace dbg;
        const int l = ph >= PH_L0 && ph < PH_FINAL ? (ph - PH_L0) / PH_PER_L : 0, lp = ph >= PH_L0 && ph < PH_FINAL ? (ph - PH_L0) % PH_PER_L : -1, tb = T_L0 + l * T_PER_L;
        if (ph == PH_ADA) save(&dc, stream, T_MOD, ws + WS_MOD, K_F32, NADA, 0, NL * NMOD, NADA);
        if (lp == LP_NORM1) save(&dc, stream, tb + T_H1, ws + WS_H, K_BF16, D, 0, M, D);
        if (lp == LP_IN) { save(&dc, stream, tb + T_Q, ws + WS_Q, K_QPERM, 1024, 0, M, 1024); save(&dc, stream, tb + T_K, ws + WS_K, K_QPERM, 256, 0, M, 256); save(&dc, stream, tb + T_V, ws + WS_V, K_BF16, 256, 0, M, 256);
            save(&dc, stream, tb + T_U, ws + WS_U, K_F32, 512, 0, M, 512); save(&dc, stream, tb + T_PR, ws + WS_PR, K_F32, 2048, 0, M, RP); save(&dc, stream, tb + T_GT, ws + WS_GT, K_BF16, 6144, 0, M, 6144); }
        if (lp == LP_MIX) { save(&dc, stream, tb + T_OA, ws + WS_CAT, K_BF16, D, 0, M, 1024); save(&dc, stream, tb + T_ZP, ws + WS_CAT, K_BF16, D, 1024, M, 512);
            for (int i = 0; i < 7; ++i) save(&dc, stream, tb + T_R + i, ws + WS_RW + (size_t)i * RW_STRIDE, K_F32, 512, 0, M, 512);
            if (l == 1) { save(&dc, stream, 59, ws + WS_RW + (size_t)RW_Y * RW_STRIDE, K_F32, 512, 0, M, 512); save(&dc, stream, 60, ws + WS_H, K_F32, 32, 0, M, 32); } }
        if (lp == LP_SCAN) save(&dc, stream, tb + T_Y, ws + WS_RW + (size_t)RW_Y * RW_STRIDE, K_F32, 512, 0, M, 512);
        if (lp == LP_POST) save(&dc, stream, tb + T_YR, ws + WS_CAT, K_BF16, D, 1536, M, 512);
        if (lp == LP_MG) save(&dc, stream, tb + T_MG, ws + WS_MG, K_BF16, D, 0, M, D);
        if (lp == LP_WO) save(&dc, stream, tb + T_X1, ws + WS_X, K_F32, D, 0, M, D);
        if (lp == LP_NORM2) save(&dc, stream, tb + T_H2, ws + WS_H, K_BF16, D, 0, M, D);
        if (lp == LP_GU) save(&dc, stream, tb + T_ACT, ws + WS_GT, K_BF16, DFF, 0, M, DFF);
        if (lp == LP_DN) save(&dc, stream, tb + T_X2, ws + WS_X, K_F32, D, 0, M, D);
    }
    const size_t ooff[13] = {O_YP, O_YS, O_KP, O_VP, O_PP, O_SP, O_WP, O_KS, O_VS, O_PS, O_SS, O_WS, O_END}; const int ocol[12] = {2048, 2048, 256, 256, 512, 1984, 64, 256, 256, 512, 1984, 64};
    for (int i = 0; i < 12; ++i) dbg::save(&dc, stream, dbg::T_OUT0 + i, (float*)d_out + ooff[i], dbg::K_F32, ocol[i], 0, (int)((ooff[i + 1] - ooff[i]) / ocol[i]), ocol[i]);
    nv::In in; for (int i = 0; i < 39; ++i) in.p[i] = (const float*)d_in[i];
    nv::forward(in, (float*)d_out, (float*)d_ws, stream, &dc);
    for (int i = 0; i < 12; ++i) dbg::cmp(&dc, stream, dbg::T_OUT0 + i, (float*)d_out + ooff[i], ocol[i], 0, (int)((ooff[i + 1] - ooff[i]) / ocol[i]), ocol[i]);
#ifndef DBG_WANT_ID
#define DBG_WANT_ID -1
#endif
    dbg::inject<<<1, 1, 0, stream>>>(dc.err, (float*)d_out, (float*)d_out + O_YS, DBG_WANT_ID >= 0 ? dbg::NIDS : dbg::T_N, DBG_WANT_ID);
#else
    a.ph_lo = 0; a.ph_hi = N_PHASES;
    void* kargs[] = {&a};
    const hipError_t e = hipLaunchCooperativeKernel((const void*)mega, dim3(grid), dim3(NTHR), kargs, LDS_BYTES, stream);
    if (e != hipSuccess) fprintf(stderr, "kernel_launch: cooperative launch failed: %s (grid %d)\n", hipGetErrorString(e), grid);
#endif
}
```

```cpp
#define MK_DEBUG 0
#include <hip/hip_runtime.h>
#include <hip/hip_cooperative_groups.h>
#include <cstdio>
#include <cstdint>
namespace dbg {
constexpr int NPROBE = 16384, NSPECIAL = 2048, NIDS = 64;
struct Ctx { float* probes; float* err; int on; };
__device__ __forceinline__ unsigned hash32(unsigned x) { x ^= x >> 16; x *= 0x7feb352dU; x ^= x >> 15; x *= 0x846ca68bU; x ^= x >> 16; return x; }
__device__ __forceinline__ void probe_rc(int id, int k, int R, int C, int& r, int& c) {
    const unsigned h1 = hash32((unsigned)(id * 1000003 + k * 2 + 1)), h2 = hash32((unsigned)(id * 7919 + k * 2 + 77777));
    c = (int)(h2 % (unsigned)C);
    if (R == 8320 && k < NSPECIAL) { const int sp[16] = {0, 1, 15, 16, 127, 128, 129, 4095, 4096, 4097, 8190, 8191, 8192, 8193, 8255, 8319}; r = sp[k >> 7]; }
    else r = (int)(h1 % (unsigned)R);
}
enum { K_F32 = 0, K_BF16 = 1, K_QPERM = 2 };
__device__ __forceinline__ float opt_read(const void* p, int kind, size_t ld, int coff, int r, int c) {
    if (kind == K_F32) return ((const float*)p)[(size_t)r * ld + coff + c];
    if (kind == K_QPERM) { const int h = c >> 6, d = c & 63, pp = 32 * ((d >> 4) & 1) + 8 * ((d >> 2) & 3) + 4 * (d >> 5) + (d & 3); c = h * 64 + pp; }
    const unsigned short b = ((const unsigned short*)p)[(size_t)r * ld + coff + c]; return __builtin_bit_cast(float, (unsigned)b << 16);
}
__global__ void probe_save(float* probes, int id, const void* p, int kind, size_t ld, int coff, int R, int C) {
    const int k = blockIdx.x * blockDim.x + threadIdx.x; if (k >= NPROBE) return; int r, c; probe_rc(id, k, R, C, r, c);
    probes[(size_t)id * NPROBE + k] = opt_read(p, kind, ld, coff, r, c);
}
__global__ void probe_cmp(const float* probes, float* err, int id, const float* gold, size_t ld, int coff, int R, int C, int sig) {
    const int k = blockIdx.x * blockDim.x + threadIdx.x; if (k >= NPROBE) return; int r, c; probe_rc(id, k, R, C, r, c);
    float g = gold[(size_t)r * ld + coff + c]; if (sig) g = 1.f / (1.f + expf(-g));
    float o = probes[(size_t)id * NPROBE + k]; float d = o - g; if (!(d == d) || fabsf(d) > 1e18f) d = 1e18f;
    const int sp = (R == 8320 && k < NSPECIAL) ? 0 : 2;
    atomicAdd(&err[id * 4 + sp], d * d); atomicAdd(&err[id * 4 + sp + 1], g * g);
}
__global__ void inject(const float* err, float* out, float* ys, int nids, int want_id) {
    if (threadIdx.x || blockIdx.x) return;
    int rid = 89, which = 0; float rel = 1e-3f;
    for (int id = 0; id < nids; ++id) {
        const float r_rand = sqrtf(err[id * 4 + 2] / fmaxf(err[id * 4 + 3], 1e-30f)), r_sp = err[id * 4 + 1] > 0.f ? sqrtf(err[id * 4 + 0] / fmaxf(err[id * 4 + 1], 1e-30f)) : 0.f;
        if (want_id >= 0) { if (id == want_id) { rid = id; which = 0; rel = r_rand; break; } continue; }
        if (r_rand > 0.05f) { rid = id; which = 0; rel = r_rand; break; } else if (r_sp > 0.10f) { rid = id; which = 1; rel = r_sp; break; } }
    const float c1 = (float)(10 + rid) * (which ? 1e5f : 1e3f); float f = (log10f(fmaxf(rel, 1e-3f)) + 3.f) * 0.25f; f = fminf(fmaxf(f, 0.f), 1.f);
    out[0] = c1; ys[0] = c1 * (0.2f + 0.6f * f);
}
inline void save(const Ctx* c, hipStream_t st, int id, const void* p, int kind, size_t ld, int coff, int R, int C) { if (c && c->on) probe_save<<<NPROBE / 256, 256, 0, st>>>(c->probes, id, p, kind, ld, coff, R, C); }
inline void cmp(const Ctx* c, hipStream_t st, int id, const float* gold, size_t ld, int coff, int R, int C, int sig = 0) { if (c && c->on) probe_cmp<<<NPROBE / 256, 256, 0, st>>>(c->probes, c->err, id, gold, ld, coff, R, C, sig); }
enum { T_MOD = 0, T_L0 = 1, T_PER_L = 23, T_OUT0 = T_L0 + 2 * T_PER_L, T_N = T_OUT0 + 12 };
enum { T_H1 = 0, T_Q, T_K, T_V, T_U, T_PR, T_GT, T_OA, T_ZP, T_R, T_W, T_KK, T_VV, T_A, T_B, T_G, T_Y, T_YR, T_MG, T_X1, T_H2, T_ACT, T_X2 };
}
namespace nv {
constexpr int D = 2048, SEQ = 4096, NB = 2, MP = NB * SEQ, NS = 128, M = MP + NS, NL = 2;
constexpr int INW = 10176, OQ = 0, OK_ = 1024, OV = 1280, OU = 1536, OPR = 2048, OGL = 4032;
constexpr int RP = 1984, DFF = 5632, NMOD = NB + NS;
constexpr int PASTLEN = 8192;

__device__ __forceinline__ float sigm(float x) { return 1.f / (1.f + expf(-x)); }
__device__ __forceinline__ float silu(float x) { return x / (1.f + expf(-x)); }
__device__ __forceinline__ int modrow(int m) { return m < MP ? m / SEQ : NB + (m - MP); }
__device__ __forceinline__ int posof(int m) { return m < MP ? m % SEQ : PASTLEN; }

__global__ void __launch_bounds__(256) gemm(const float* __restrict__ A, int lda, const float* __restrict__ B, int ldb, float* __restrict__ C, int ldc, int Mm, int N, int K) {
    __shared__ float As[16][68], Bs[16][68];
    const int tx = threadIdx.x & 15, ty = threadIdx.x >> 4, m0 = blockIdx.y * 64, n0 = blockIdx.x * 64;
    float acc[4][4];
#pragma unroll
    for (int i = 0; i < 4; ++i)
#pragma unroll
        for (int j = 0; j < 4; ++j) acc[i][j] = 0.f;
    for (int k0 = 0; k0 < K; k0 += 16) {
        for (int i = threadIdx.x; i < 1024; i += 256) { const int r = i >> 4, c = i & 15; As[c][r] = (m0 + r < Mm) ? A[(size_t)(m0 + r) * lda + k0 + c] : 0.f; }
        for (int i = threadIdx.x; i < 1024; i += 256) { const int r = i >> 6, c = i & 63; Bs[r][c] = (n0 + c < N) ? B[(size_t)(k0 + r) * ldb + n0 + c] : 0.f; }
        __syncthreads();
#pragma unroll
        for (int kk = 0; kk < 16; ++kk) {
            float a[4], b[4];
#pragma unroll
            for (int i = 0; i < 4; ++i) { a[i] = As[kk][ty * 4 + i]; b[i] = Bs[kk][tx * 4 + i]; }
#pragma unroll
            for (int i = 0; i < 4; ++i)
#pragma unroll
                for (int j = 0; j < 4; ++j) acc[i][j] += a[i] * b[j];
        }
        __syncthreads();
    }
#pragma unroll
    for (int i = 0; i < 4; ++i)
#pragma unroll
        for (int j = 0; j < 4; ++j) { const int m = m0 + ty * 4 + i, n = n0 + tx * 4 + j; if (m < Mm && n < N) C[(size_t)m * ldc + n] = acc[i][j]; }
}

__global__ void silu_c(const float* cp, const float* cs, float* out) {
    const int i = blockIdx.x * blockDim.x + threadIdx.x; if (i >= NMOD * D) return;
    const int r = i / D, k = i % D; const float c = r < NB ? cp[r * D + k] : cs[(r - NB) * D + k]; out[i] = silu(c);
}
__global__ void add_bias(float* mod, const float* b, int n, int N) { const int i = blockIdx.x * blockDim.x + threadIdx.x; if (i < n) mod[i] += b[i % N]; }

__global__ void __launch_bounds__(256) modnorm(const float* xa, const float* xb, const float* g, const float* mod, int sh_off, int sc_off, float* out, size_t out_split_off) {
    const int m = blockIdx.x; const float* x = m < MP ? xa + (size_t)m * D : xb + (size_t)(m - MP) * D;
    __shared__ float red[256]; float s = 0.f;
    for (int k = threadIdx.x; k < D; k += 256) { const float v = x[k]; s += v * v; }
    red[threadIdx.x] = s; __syncthreads();
    for (int o = 128; o > 0; o >>= 1) { if (threadIdx.x < o) red[threadIdx.x] += red[threadIdx.x + o]; __syncthreads(); }
    const float rs = rsqrtf(red[0] / D + 1e-6f); const int br = modrow(m);
    float* o = m < MP ? out + (size_t)m * D : out + out_split_off + (size_t)(m - MP) * D;
    for (int k = threadIdx.x; k < D; k += 256) { float v = x[k] * rs * g[k]; if (mod) v = v * (1.f + mod[(size_t)br * 6 * D + sc_off + k]) + mod[(size_t)br * 6 * D + sh_off + k]; o[k] = v; }
}

__global__ void rope(float* z) {
    const int i = blockIdx.x * blockDim.x + threadIdx.x; if (i >= M * 20 * 32) return;
    const int m = i / 640, hh = (i / 32) % 20, d = i % 32; const float pos = (float)posof(m);
    const float inv = powf(10000.f, -(float)d * 2.0f / 64.f), ang = pos * inv, c = cosf(ang), s = sinf(ang);
    float* p = z + (size_t)m * INW + hh * 64; const float x1 = p[d], x2 = p[d + 32]; p[d] = x1 * c - x2 * s; p[d + 32] = x2 * c + x1 * s;
}

__global__ void attn_prompt(const float* z, const float* sink, float* oattn) {
    const int i = blockIdx.x * blockDim.x + threadIdx.x; if (i >= MP * 16) return;
    const int m = i / 16, hq = i % 16, hk = hq / 4, t = m % SEQ; const float* q = z + (size_t)m * INW + OQ + hq * 64;
    const int lo = t - 128 < 0 ? 0 : t - 128; const float sk = sink[hq];
    float mx = sk;
    for (int kp = lo; kp <= t; ++kp) { const float* k = z + (size_t)(m - t + kp) * INW + OK_ + hk * 64; float s = 0.f; for (int d = 0; d < 64; ++d) s += q[d] * k[d]; s *= 0.125f; mx = fmaxf(mx, s); }
    float den = expf(sk - mx); float o[64];
#pragma unroll
    for (int d = 0; d < 64; ++d) o[d] = 0.f;
    for (int kp = lo; kp <= t; ++kp) { const float* k = z + (size_t)(m - t + kp) * INW + OK_ + hk * 64; const float* v = z + (size_t)(m - t + kp) * INW + OV + hk * 64; float s = 0.f; for (int d = 0; d < 64; ++d) s += q[d] * k[d]; s *= 0.125f;
        const float p = expf(s - mx); den += p;
#pragma unroll
        for (int d = 0; d < 64; ++d) o[d] += p * v[d]; }
#pragma unroll
    for (int d = 0; d < 64; ++d) oattn[(size_t)m * 1024 + hq * 64 + d] = o[d] / den;
}
__global__ void attn_sample(const float* z, const float* sink, const float* ck, const float* cv, float* oattn) {
    const int i = blockIdx.x * blockDim.x + threadIdx.x; if (i >= NS * 16) return;
    const int s_ = i / 16, hq = i % 16, hk = hq / 4, m = MP + s_; const float* q = z + (size_t)m * INW + OQ + hq * 64; const float sk = sink[hq];
    float mx = sk;
    for (int j = 0; j <= 128; ++j) { const float* k = j < 128 ? ck + ((size_t)(s_ * 128 + j) * 4 + hk) * 64 : z + (size_t)m * INW + OK_ + hk * 64; float s = 0.f; for (int d = 0; d < 64; ++d) s += q[d] * k[d]; s *= 0.125f; mx = fmaxf(mx, s); }
    float den = expf(sk - mx); float o[64];
#pragma unroll
    for (int d = 0; d < 64; ++d) o[d] = 0.f;
    for (int j = 0; j <= 128; ++j) { const float* k = j < 128 ? ck + ((size_t)(s_ * 128 + j) * 4 + hk) * 64 : z + (size_t)m * INW + OK_ + hk * 64;
        const float* v = j < 128 ? cv + ((size_t)(s_ * 128 + j) * 4 + hk) * 64 : z + (size_t)m * INW + OV + hk * 64; float s = 0.f; for (int d = 0; d < 64; ++d) s += q[d] * k[d]; s *= 0.125f;
        const float p = expf(s - mx); den += p;
#pragma unroll
        for (int d = 0; d < 64; ++d) o[d] += p * v[d]; }
#pragma unroll
    for (int d = 0; d < 64; ++d) oattn[(size_t)m * 1024 + hq * 64 + d] = o[d] / den;
}
__global__ void kv_out(const float* z, const float* ck, const float* cv, float* kp, float* vp, float* ks, float* vs) {
    const int i = blockIdx.x * blockDim.x + threadIdx.x;
    if (i < NB * 128 * 256) { const int b = i / (128 * 256), j = (i / 256) % 128, c = i % 256; const size_t m = (size_t)b * SEQ + SEQ - 128 + j; kp[i] = z[m * INW + OK_ + c]; vp[i] = z[m * INW + OV + c]; }
    if (i < NS * 128 * 256) { const int s_ = i / (128 * 256), j = (i / 256) % 128, c = i % 256;
        if (j < 127) { ks[i] = ck[i + 256]; vs[i] = cv[i + 256]; } else { ks[i] = z[(size_t)(MP + s_) * INW + OK_ + c]; vs[i] = z[(size_t)(MP + s_) * INW + OV + c]; } }
}
__global__ void pool_d(const float* z, const float* spool, float* dbuf) {
    const int i = blockIdx.x * blockDim.x + threadIdx.x; if (i >= M * 512) return;
    const int m = i / 512, c = i % 512, gi = c / 128, w = 2 << gi; float sum = 0.f; float cnt;
    if (m < MP) { const int t = m % SEQ; for (int j = 0; j < w; ++j) if (t - j >= 0) sum += z[(size_t)(m - j) * INW + OU + c]; cnt = (float)(t + 1 < w ? t + 1 : w); }
    else { const int s_ = m - MP; sum = z[(size_t)m * INW + OU + c]; for (int j = 1; j < w; ++j) sum += spool[((size_t)s_ * 15 + 15 - j) * 512 + c]; cnt = (float)w; }
    dbuf[i] = sum / cnt - z[(size_t)m * INW + OU + c];
}
__global__ void pool_z(const float* dbuf, const float* pw, const float* pscale, float* zpool) {
    const int i = blockIdx.x * blockDim.x + threadIdx.x; if (i >= M * 512) return;
    const int m = i / 512, c = i % 512, gi = c / 128, e = c % 128; float s = 0.f;
    for (int k = 0; k < 128; ++k) s += dbuf[(size_t)m * 512 + gi * 128 + k] * pw[(gi * 128 + k) * 128 + e];
    zpool[i] = s * pscale[c];
}
__global__ void pool_out(const float* z, const float* spool, float* pp, float* ps) {
    const int i = blockIdx.x * blockDim.x + threadIdx.x;
    if (i < NB * 15 * 512) { const int b = i / (15 * 512), j = (i / 512) % 15, c = i % 512; pp[i] = z[((size_t)b * SEQ + SEQ - 15 + j) * INW + OU + c]; }
    if (i < NS * 15 * 512) { const int s_ = i / (15 * 512), j = (i / 512) % 15, c = i % 512; ps[i] = j < 14 ? spool[i + 512] : z[(size_t)(MP + s_) * INW + OU + c]; }
}
__global__ void rwkv_xm(const float* z, const float* sshift, const float* mu, float* xm) {
    const int i = blockIdx.x * blockDim.x + threadIdx.x; if (i >= M * RP) return;
    const int m = i / RP, c = i % RP; const float p = z[(size_t)m * INW + OPR + c]; float pv;
    if (m < MP) pv = (m % SEQ) ? z[(size_t)(m - 1) * INW + OPR + c] : 0.f; else pv = sshift[(size_t)(m - MP) * RP + c];
    xm[i] = p + (pv - p) * mu[c];
}
__global__ void shift_out(const float* z, float* sp, float* ss) {
    const int i = blockIdx.x * blockDim.x + threadIdx.x;
    if (i < NB * RP) { const int b = i / RP, c = i % RP; sp[i] = z[((size_t)b * SEQ + SEQ - 1) * INW + OPR + c]; }
    if (i < NS * RP) { const int s_ = i / RP, c = i % RP; ss[i] = z[(size_t)(MP + s_) * INW + OPR + c]; }
}
__global__ void __launch_bounds__(64) rwkv_prep(const float* xm, const float* w0, const float* w2, const float* a0, const float* a2, const float* g2, const float* k_k, const float* k_a,
                                                 const float* T2, const float* vb, float* vfirst, int has_vres,
                                                 float* R, float* W, float* Kk, float* V, float* A, float* Bb, float* G) {
    const int m = blockIdx.x / 8, h = blockIdx.x % 8, c = h * 64 + threadIdx.x; const float* x = xm + (size_t)m * RP;
    float s = w0[c]; for (int k = 0; k < 96; ++k) s += tanhf(x[1536 + k]) * w2[k * 512 + c];
    const float z_ = -s; const float sp = z_ > 20.f ? z_ : log1pf(expf(z_)); const float wlog = -sp - 0.5f; const float decay = expf(-expf(wlog));
    float sa = a0[c]; for (int k = 0; k < 96; ++k) sa += x[1632 + k] * a2[k * 512 + c]; const float a = sigm(sa);
    float g = 0.f; for (int k = 0; k < 256; ++k) g += sigm(x[1728 + k]) * g2[k * 512 + c];
    float v = x[1024 + c];
    if (!has_vres) vfirst[(size_t)m * 512 + c] = v;
    else { const float acc = vb[c] + T2[(size_t)m * 512 + c]; v = v + (vfirst[(size_t)m * 512 + c] - v) * sigm(acc); }
    const float r = x[c], k = x[512 + c]; float kk = k * k_k[c];
    __shared__ float red[64]; red[threadIdx.x] = kk * kk; __syncthreads();
    for (int o = 32; o > 0; o >>= 1) { if (threadIdx.x < o) red[threadIdx.x] += red[threadIdx.x + o]; __syncthreads(); }
    kk = kk / fmaxf(sqrtf(red[0]), 1e-12f); const float k2 = k * (1.f + (a - 1.f) * k_a[c]);
    const size_t o = (size_t)m * 512 + c; R[o] = r; W[o] = decay; Kk[o] = k2; V[o] = v; A[o] = -kk; Bb[o] = kk * a; G[o] = g;
}
__global__ void __launch_bounds__(64) rwkv_scan(const float* R, const float* W, const float* Kk, const float* V, const float* A, const float* Bb, const float* S0, float* Sout, float* Y, int row0, int T) {
    const int seq = blockIdx.x / 8, h = blockIdx.x % 8, i = threadIdx.x; float S[64];
#pragma unroll
    for (int j = 0; j < 64; ++j) S[j] = S0 ? S0[(((size_t)seq * 8 + h) * 64 + i) * 64 + j] : 0.f;
    __shared__ float sr[16][64], sw[16][64], sk[16][64], sa[16][64], sb[16][64], sv[16][64];
    for (int t0 = 0; t0 < T; t0 += 16) { const int nt = T - t0 < 16 ? T - t0 : 16;
        __syncthreads();
        for (int tt = 0; tt < nt; ++tt) { const size_t o = ((size_t)row0 + (size_t)seq * T + t0 + tt) * 512 + h * 64 + i; sr[tt][i] = R[o]; sw[tt][i] = W[o]; sk[tt][i] = Kk[o]; sa[tt][i] = A[o]; sb[tt][i] = Bb[o]; sv[tt][i] = V[o]; }
        __syncthreads();
        for (int tt = 0; tt < nt; ++tt) { float dot = 0.f; const float v = sv[tt][i];
#pragma unroll
            for (int j = 0; j < 64; ++j) dot += S[j] * sa[tt][j];
            float y = 0.f;
#pragma unroll
            for (int j = 0; j < 64; ++j) { S[j] = S[j] * sw[tt][j] + dot * sb[tt][j] + v * sk[tt][j]; y += S[j] * sr[tt][j]; }
            Y[((size_t)row0 + (size_t)seq * T + t0 + tt) * 512 + h * 64 + i] = y; } }
#pragma unroll
    for (int j = 0; j < 64; ++j) Sout[(((size_t)seq * 8 + h) * 64 + i) * 64 + j] = S[j];
}
__global__ void __launch_bounds__(64) rwkv_post(const float* Y, const float* R, const float* Kk, const float* V, const float* G, const float* r_k, const float* lg, const float* lb, float* yout) {
    const int m = blockIdx.x / 8, h = blockIdx.x % 8, i = threadIdx.x, c = h * 64 + i; const size_t o = (size_t)m * 512 + c;
    __shared__ float red[64]; const float y = Y[o];
    red[i] = y; __syncthreads(); for (int s = 32; s > 0; s >>= 1) { if (i < s) red[i] += red[i + s]; __syncthreads(); } const float mu = red[0] / 64.f; __syncthreads();
    red[i] = (y - mu) * (y - mu); __syncthreads(); for (int s = 32; s > 0; s >>= 1) { if (i < s) red[i] += red[i + s]; __syncthreads(); } const float var = red[0] / 64.f; __syncthreads();
    red[i] = R[o] * Kk[o] * r_k[c]; __syncthreads(); for (int s = 32; s > 0; s >>= 1) { if (i < s) red[i] += red[i + s]; __syncthreads(); } const float bon = red[0];
    yout[o] = ((y - mu) * rsqrtf(var + 64e-5f) * lg[c] + lb[c] + bon * V[o]) * G[o];
}
__global__ void merge_acc(const float* z, const float* P, int goff, float* merged, int first) {
    const int i = blockIdx.x * blockDim.x + threadIdx.x; if (i >= M * D) return; const int m = i / D, n = i % D;
    const float v = sigm(z[(size_t)m * INW + OGL + goff + n]) * P[i]; merged[i] = first ? v : merged[i] + v;
}
__global__ void resid(const float* xa, const float* xb, const float* P, const float* mod, int gt_off, float* xout) {
    const int i = blockIdx.x * blockDim.x + threadIdx.x; if (i >= M * D) return; const int m = i / D, n = i % D;
    const float x = m < MP ? xa[i] : xb[(size_t)(m - MP) * D + n]; xout[i] = x + (1.f + mod[(size_t)modrow(m) * 6 * D + gt_off + n]) * P[i];
}
__global__ void swiglu(const float* gbuf, const float* ubuf, float* act, int n) { const int i = blockIdx.x * blockDim.x + threadIdx.x; if (i < n) act[i] = silu(gbuf[i]) * ubuf[i]; }

struct In { const float* p[39]; };
inline void G(hipStream_t st, const float* A, int lda, const float* B, int ldb, float* C, int ldc, int Mm, int N, int K) { gemm<<<dim3((N + 63) / 64, (Mm + 63) / 64), 256, 0, st>>>(A, lda, B, ldb, C, ldc, Mm, N, K); }
#define EW(n) ((int)(((size_t)(n) + 255) / 256)), 256, 0, st

struct WS { float *silc, *mod, *h, *z, *xm, *R, *W, *K, *V, *A, *B, *G, *Y, *vfirst, *dbuf, *cat_a, *cat_p, *cat_r, *P, *merged, *x1, *xres, *fg, *fu, *T1; };
inline size_t carve(float* base, WS& w) {
    size_t o = 0; auto take = [&](size_t n) { float* p = base + o; o += (n + 63) & ~(size_t)63; return p; };
    w.silc = take((size_t)NMOD * D); w.mod = take((size_t)NL * NMOD * 6 * D); w.T1 = take((size_t)M * 32);
    w.h = take((size_t)M * D); w.P = w.h;
    w.xm = take((size_t)M * D); w.x1 = w.xm;
    w.cat_a = take((size_t)M * 1024); w.cat_p = take((size_t)M * 512); w.cat_r = take((size_t)M * 512); w.xres = take((size_t)M * D);
    w.z = take((size_t)M * INW);
    w.R = take((size_t)M * 512); w.W = take((size_t)M * 512); w.K = take((size_t)M * 512); w.V = take((size_t)M * 512); w.A = take((size_t)M * 512); w.B = take((size_t)M * 512); w.G = take((size_t)M * 512);
    w.Y = take((size_t)M * 512); w.vfirst = take((size_t)M * 512); w.dbuf = take((size_t)M * 512);
    w.merged = w.R;
    w.fg = w.z; w.fu = w.z + (size_t)M * DFF;
    return o;
}
constexpr size_t O_YP = 0, O_YS = O_YP + (size_t)MP * D, O_KP = O_YS + (size_t)NS * D, O_VP = O_KP + (size_t)NL * NB * 128 * 256, O_PP = O_VP + (size_t)NL * NB * 128 * 256,
                 O_SP = O_PP + (size_t)NL * NB * 15 * 512, O_WP = O_SP + (size_t)NL * NB * RP, O_KS = O_WP + (size_t)NL * NB * 8 * 4096, O_VS = O_KS + (size_t)NL * NS * 128 * 256,
                 O_PS = O_VS + (size_t)NL * NS * 128 * 256, O_SS = O_PS + (size_t)NL * NS * 15 * 512, O_WS = O_SS + (size_t)NL * NS * RP, O_END = O_WS + (size_t)NL * NS * 8 * 4096;

inline void forward(const In& in, float* out, float* wsf, hipStream_t st, const dbg::Ctx* dc = nullptr) {
    using namespace dbg;
    WS w; carve(wsf, w);
    const float *xp = in.p[0], *xs = in.p[1];
    silu_c<<<EW(NMOD * D)>>>(in.p[2], in.p[3], w.silc);
    for (int l = 0; l < NL; ++l) { G(st, w.silc, D, in.p[9] + (size_t)l * D * 6 * D, 6 * D, w.mod + (size_t)l * NMOD * 6 * D, 6 * D, NMOD, 6 * D, D);
        add_bias<<<EW(NMOD * 6 * D)>>>(w.mod + (size_t)l * NMOD * 6 * D, in.p[10] + (size_t)l * 6 * D, NMOD * 6 * D, 6 * D); }
    cmp(dc, st, T_MOD, w.mod, 6 * D, 0, NL * NMOD, 6 * D);
    const float* xa = xp; const float* xb = xs;
    for (int l = 0; l < NL; ++l) {
        const float* mod = w.mod + (size_t)l * NMOD * 6 * D; const int tb = T_L0 + l * T_PER_L;
        modnorm<<<M, 256, 0, st>>>(xa, xb, in.p[11] + l * D, mod, 0, D, w.h, (size_t)MP * D);
        cmp(dc, st, tb + T_H1, w.h, D, 0, M, D);
        G(st, w.h, D, in.p[13] + (size_t)l * D * INW, INW, w.z, INW, M, INW, D);
        rope<<<EW(M * 640)>>>(w.z);
        cmp(dc, st, tb + T_Q, w.z, INW, OQ, M, 1024); cmp(dc, st, tb + T_K, w.z, INW, OK_, M, 256); cmp(dc, st, tb + T_V, w.z, INW, OV, M, 256); cmp(dc, st, tb + T_U, w.z, INW, OU, M, 512);
        cmp(dc, st, tb + T_PR, w.z, INW, OPR, M, RP); cmp(dc, st, tb + T_GT, w.z, INW, OGL, M, 6144, 1);
        const float* ck = in.p[4] + (size_t)l * NS * 128 * 256; const float* cv = in.p[5] + (size_t)l * NS * 128 * 256;
        attn_prompt<<<(MP * 16 + 63) / 64, 64, 0, st>>>(w.z, in.p[14] + l * 16, w.cat_a);
        attn_sample<<<(NS * 16 + 63) / 64, 64, 0, st>>>(w.z, in.p[14] + l * 16, ck, cv, w.cat_a);
        kv_out<<<EW(NS * 128 * 256)>>>(w.z, ck, cv, out + O_KP + (size_t)l * NB * 128 * 256, out + O_VP + (size_t)l * NB * 128 * 256, out + O_KS + (size_t)l * NS * 128 * 256, out + O_VS + (size_t)l * NS * 128 * 256);
        const float* sp = in.p[6] + (size_t)l * NS * 15 * 512;
        pool_d<<<EW(M * 512)>>>(w.z, sp, w.dbuf);
        pool_z<<<EW(M * 512)>>>(w.dbuf, in.p[16] + (size_t)l * 4 * 128 * 128, in.p[17] + l * 512, w.cat_p);
        pool_out<<<EW(NS * 15 * 512)>>>(w.z, sp, out + O_PP + (size_t)l * NB * 15 * 512, out + O_PS + (size_t)l * NS * 15 * 512);
        rwkv_xm<<<EW((size_t)M * RP)>>>(w.z, in.p[7] + (size_t)l * NS * RP, in.p[19] + l * RP, w.xm);
        shift_out<<<EW(NS * RP)>>>(w.z, out + O_SP + (size_t)l * NB * RP, out + O_SS + (size_t)l * NS * RP);
        if (l > 0) { G(st, w.xm + 1024, RP, in.p[31], 32, w.T1, 32, M, 32, 512); G(st, w.T1, 32, in.p[32], 512, w.dbuf, 512, M, 512, 32); }
        if (l > 0) { cmp(dc, st, 59, w.dbuf, 512, 0, M, 512); cmp(dc, st, 60, w.T1, 32, 0, M, 32); }
        rwkv_prep<<<M * 8, 64, 0, st>>>(w.xm, in.p[20] + l * 512, in.p[21] + (size_t)l * 96 * 512, in.p[22] + l * 512, in.p[23] + (size_t)l * 96 * 512, in.p[24] + (size_t)l * 256 * 512, in.p[25] + l * 512, in.p[26] + l * 512,
                                         w.dbuf, in.p[33], w.vfirst, l > 0, w.R, w.W, w.K, w.V, w.A, w.B, w.G);
        cmp(dc, st, tb + T_OA, w.cat_a, 1024, 0, M, 1024); cmp(dc, st, tb + T_ZP, w.cat_p, 512, 0, M, 512);
        cmp(dc, st, tb + T_R, w.R, 512, 0, M, 512); cmp(dc, st, tb + T_W, w.W, 512, 0, M, 512); cmp(dc, st, tb + T_KK, w.K, 512, 0, M, 512); cmp(dc, st, tb + T_VV, w.V, 512, 0, M, 512);
        cmp(dc, st, tb + T_A, w.A, 512, 0, M, 512); cmp(dc, st, tb + T_B, w.B, 512, 0, M, 512); cmp(dc, st, tb + T_G, w.G, 512, 0, M, 512);
        rwkv_scan<<<NB * 8, 64, 0, st>>>(w.R, w.W, w.K, w.V, w.A, w.B, nullptr, out + O_WP + (size_t)l * NB * 8 * 4096, w.Y, 0, SEQ);
        rwkv_scan<<<NS * 8, 64, 0, st>>>(w.R, w.W, w.K, w.V, w.A, w.B, in.p[8] + (size_t)l * NS * 8 * 4096, out + O_WS + (size_t)l * NS * 8 * 4096, w.Y, MP, 1);
        cmp(dc, st, tb + T_Y, w.Y, 512, 0, M, 512);
        rwkv_post<<<M * 8, 64, 0, st>>>(w.Y, w.R, w.K, w.V, w.G, in.p[27] + l * 512, in.p[28] + l * 512, in.p[29] + l * 512, w.cat_r);
        cmp(dc, st, tb + T_YR, w.cat_r, 512, 0, M, 512);
        G(st, w.cat_a, 1024, in.p[15] + (size_t)l * 1024 * D, D, w.P, D, M, D, 1024); merge_acc<<<EW((size_t)M * D)>>>(w.z, w.P, 0, w.merged, 1);
        G(st, w.cat_p, 512, in.p[18] + (size_t)l * 512 * D, D, w.P, D, M, D, 512);   merge_acc<<<EW((size_t)M * D)>>>(w.z, w.P, D, w.merged, 0);
        G(st, w.cat_r, 512, in.p[30] + (size_t)l * 512 * D, D, w.P, D, M, D, 512);   merge_acc<<<EW((size_t)M * D)>>>(w.z, w.P, 2 * D, w.merged, 0);
        cmp(dc, st, tb + T_MG, w.merged, D, 0, M, D);
        G(st, w.merged, D, in.p[34] + (size_t)l * D * D, D, w.P, D, M, D, D);
        resid<<<EW((size_t)M * D)>>>(xa, xb, w.P, mod, 2 * D, w.x1);
        cmp(dc, st, tb + T_X1, w.x1, D, 0, M, D);
        modnorm<<<M, 256, 0, st>>>(w.x1, w.x1 + (size_t)MP * D, in.p[12] + l * D, mod, 3 * D, 4 * D, w.h, (size_t)MP * D);
        cmp(dc, st, tb + T_H2, w.h, D, 0, M, D);
        G(st, w.h, D, in.p[35] + (size_t)l * D * DFF, DFF, w.fg, DFF, M, DFF, D);
        G(st, w.h, D, in.p[36] + (size_t)l * D * DFF, DFF, w.fu, DFF, M, DFF, D);
        swiglu<<<EW((size_t)M * DFF)>>>(w.fg, w.fu, w.fg, M * DFF);
        cmp(dc, st, tb + T_ACT, w.fg, DFF, 0, M, DFF);
        G(st, w.fg, DFF, in.p[37] + (size_t)l * DFF * D, D, w.P, D, M, D, DFF);
        resid<<<EW((size_t)M * D)>>>(w.x1, w.x1 + (size_t)MP * D, w.P, mod, 5 * D, w.xres);
        cmp(dc, st, tb + T_X2, w.xres, D, 0, M, D);
        xa = w.xres; xb = w.xres + (size_t)MP * D;
    }
    modnorm<<<M, 256, 0, st>>>(xa, xb, in.p[38], nullptr, 0, 0, out + O_YP, (size_t)MP * D);
}
#undef EW
}
namespace mk {
#define LAS __attribute__((address_space(3)))
#define GAS __attribute__((address_space(1)))
typedef unsigned short bf16;
typedef short bf16x8 __attribute__((ext_vector_type(8)));
typedef float f32x4 __attribute__((ext_vector_type(4)));
typedef float f32x2 __attribute__((ext_vector_type(2)));
typedef unsigned u32x4 __attribute__((ext_vector_type(4)));
typedef unsigned u32x2 __attribute__((ext_vector_type(2)));

constexpr int D = 2048, SEQ = 4096, NB = 2, MP = NB * SEQ, NS = 128, M = MP + NS, MPAD = 8448, NL = 2, NMOD = NB + NS;
constexpr int NIN = 10240, NGU = 11264, DFF = 5632, NADA = 6 * D, RP = 1984, PASTLEN = 8192;
constexpr int NWAVES = 8, NTHR = 512;

constexpr size_t al(size_t x) { return (x + 255) & ~(size_t)255; }
constexpr size_t WL_IN = 0, WL_CAT = WL_IN + al((size_t)NIN * D * 2), WL_O = WL_CAT + al((size_t)D * D * 2), WL_GU = WL_O + al((size_t)D * D * 2), WL_DN = WL_GU + al((size_t)NGU * D * 2),
                 WL_W2 = WL_DN + al((size_t)D * DFF * 2), WL_A2 = WL_W2 + al(512 * 96 * 2), WL_G2 = WL_A2 + al(512 * 96 * 2), WL_V1 = WL_G2 + al(512 * 256 * 2), WL_V2 = WL_V1 + al(32 * 512 * 2),
                 WL_PW = WL_V2 + al(512 * 32 * 2), WL_SIZE = WL_PW + al(4 * 128 * 128 * 2);
constexpr size_t WS_W = 0;
constexpr size_t WS_ROPE = WS_W + 2 * WL_SIZE;
constexpr size_t WS_SILC = WS_ROPE + al((size_t)4097 * 64 * 4);
constexpr size_t WS_MOD = WS_SILC + al((size_t)256 * D * 2);
constexpr size_t WS_X = WS_MOD + al((size_t)NL * NMOD * NADA * 4);
constexpr size_t WS_H = WS_X + al((size_t)MPAD * D * 4);
constexpr size_t WS_Q = WS_H + al((size_t)MPAD * D * 2);
constexpr size_t WS_K = WS_Q + al((size_t)MPAD * 1024 * 2);
constexpr size_t WS_V = WS_K + al((size_t)MPAD * 256 * 2);
constexpr size_t WS_U = WS_V + al((size_t)MPAD * 256 * 2);
constexpr size_t WS_PR = WS_U + al((size_t)MPAD * 512 * 4);
constexpr size_t WS_MG = WS_PR;
constexpr size_t WS_CAT = WS_PR + al((size_t)MPAD * D * 4);
constexpr size_t WS_RW = WS_CAT + al((size_t)MPAD * D * 2);
constexpr size_t RW_STRIDE = al((size_t)MPAD * 512 * 4);
constexpr size_t WS_GT = WS_RW + 9 * RW_STRIDE;
constexpr size_t WS_ADAW = WS_GT;
constexpr size_t WS_END = WS_GT + al((size_t)MPAD * 6144 * 2);
static_assert((size_t)2 * NADA * D * 2 <= (size_t)MPAD * 6144 * 2, "ada weights fit under the gates");

constexpr size_t O_YP = 0, O_YS = O_YP + (size_t)MP * D, O_KP = O_YS + (size_t)NS * D, O_VP = O_KP + (size_t)NL * NB * 128 * 256, O_PP = O_VP + (size_t)NL * NB * 128 * 256,
                 O_SP = O_PP + (size_t)NL * NB * 15 * 512, O_WP = O_SP + (size_t)NL * NB * RP, O_KS = O_WP + (size_t)NL * NB * 8 * 4096, O_VS = O_KS + (size_t)NL * NS * 128 * 256,
                 O_PS = O_VS + (size_t)NL * NS * 128 * 256, O_SS = O_PS + (size_t)NL * NS * 15 * 512, O_WS = O_SS + (size_t)NL * NS * RP, O_END = O_WS + (size_t)NL * NS * 8 * 4096;

__device__ __forceinline__ unsigned f2bf(float f) { unsigned u = __builtin_bit_cast(unsigned, f); return (u + 0x7fffu + ((u >> 16) & 1u)) >> 16; }
__device__ __forceinline__ unsigned pk2(float lo, float hi) { return f2bf(lo) | (f2bf(hi) << 16); }
__device__ __forceinline__ float bf2f(unsigned short b) { return __builtin_bit_cast(float, (unsigned)b << 16); }
__device__ __forceinline__ float bflo(unsigned w) { return __builtin_bit_cast(float, w << 16); }
__device__ __forceinline__ float bfhi(unsigned w) { return __builtin_bit_cast(float, w & 0xffff0000u); }
__device__ __forceinline__ float fsigm(float x) { return 1.f / (1.f + __expf(-x)); }
__device__ __forceinline__ float wave_sum(float v) {
#pragma unroll
    for (int o = 1; o < 64; o <<= 1) v += __shfl_xor(v, o);
    return v;
}
__device__ __forceinline__ int modrow(int m) { return m < MP ? (m >> 12) : NB + (m - MP); }
__device__ __forceinline__ int posidx(int m) { return m < MP ? (m & (SEQ - 1)) : 4096; }
__device__ __forceinline__ int pi_d(int p) { return 32 * ((p >> 2) & 1) + 16 * (p >> 5) + 4 * ((p >> 3) & 3) + (p & 3); }

struct Args { const float* in[39]; float* out; unsigned char* ws; int ph_lo, ph_hi; };

struct Frame {
    LAS unsigned char* lds;
    int tid, lane, wave, G, bid;
    float* out; unsigned char* ws;
};
template <int K> __device__ __forceinline__ const float* inp() { GAS const float* p; asm volatile("s_load_dwordx2 %0, %1, %2\n\ts_waitcnt lgkmcnt(0)" : "=s"(p) : "s"(__builtin_amdgcn_kernarg_segment_ptr()), "n"(K * 8) : "memory"); return (const float*)p; }
#define INP(k) inp<k>()
__device__ __forceinline__ unsigned char* wl(const Frame& F, int l, size_t off) { return F.ws + WS_W + (size_t)l * WL_SIZE + off; }
__device__ __forceinline__ float* rwbuf(const Frame& F, int i) { return (float*)(F.ws + WS_RW + (size_t)i * RW_STRIDE); }
enum { RW_R = 0, RW_W, RW_K, RW_V, RW_A, RW_B, RW_G, RW_Y, RW_VF };

struct TSrc { const float* w; long long d2; int ld; int mode; };
__device__ __forceinline__ const float* colsrc(const TSrc& s, int n) {
    if (s.mode == 0) return s.w + n;
    if (s.mode == 1) {
        if (n < 1280) { const int h = n >> 6, p = n & 63; return s.w + h * 64 + pi_d(p); }
        if (n < 4032) return s.w + n;
        if (n < 4096) return nullptr;
        return s.w + (n - 64);
    }
      { const int g8 = n >> 3, i = n & 7; return (const float*)((const char*)s.w + (i < 4 ? 0ll : s.d2)) + 4 * g8 + (i & 3); }
}
__device__ __forceinline__ void transpose_item(const TSrc& s, int K, bf16* WT, size_t ldt, int kcol0, LAS float* scr, int kb, int nb, int lane) {
    const int k0 = 64 * kb, n0 = 32 * nb, gq = lane & 7, kr = lane >> 3;
    const float* cp = colsrc(s, n0 + 4 * gq);
#pragma unroll
    for (int i = 0; i < 8; ++i) { const int kk = 8 * i + kr; const f32x4 v = cp ? *(const f32x4*)(cp + (size_t)(k0 + kk) * s.ld) : (f32x4){0.f, 0.f, 0.f, 0.f};
        LAS float* d = scr + kk * 33 + 4 * gq; d[0] = v.x; d[1] = v.y; d[2] = v.z; d[3] = v.w; }
    asm volatile("s_waitcnt lgkmcnt(0)" ::: "memory");
    const int c = lane & 7;
#pragma unroll
    for (int j = 0; j < 4; ++j) { const int n = (lane >> 3) + 8 * j; const LAS float* p = scr + (8 * c) * 33 + n;
        u32x4 o; o.x = pk2(p[0 * 33], p[1 * 33]); o.y = pk2(p[2 * 33], p[3 * 33]); o.z = pk2(p[4 * 33], p[5 * 33]); o.w = pk2(p[6 * 33], p[7 * 33]);
        *(u32x4*)(WT + (size_t)(n0 + n) * ldt + kcol0 + k0 + 8 * c) = o; }
    asm volatile("s_waitcnt lgkmcnt(0)" ::: "memory");
}
__device__ __forceinline__ void small_transpose(const float* src, int K, int N, bf16* dst, int ldt, int gt, int ngt) {
    for (int i = gt; i < N * K; i += ngt) { const int n = i / K, k = i - n * K; dst[(size_t)n * ldt + k] = (bf16)f2bf(src[(size_t)k * N + n]); }
}
__device__ __forceinline__ void p0_prologue(const Frame& F) {
    LAS float* scr = (LAS float*)(F.lds + F.wave * 16384);
    const int gw = F.bid * NWAVES + F.wave, NGW = F.G * NWAVES;
    constexpr int J_ADA = 32 * 384, J_IN = 32 * 320, J_CA = 16 * 64, J_CP = 8 * 64, J_CR = 8 * 64, J_O = 32 * 64, J_GU = 32 * 352, J_DN = 88 * 64;
    constexpr int PER_L = J_ADA + J_IN + J_CA + J_CP + J_CR + J_O + J_GU + J_DN;
    for (int it = gw; it < NL * PER_L; it += NGW) {
        const int l = it / PER_L; int r = it - l * PER_L;
        TSrc s; s.d2 = 0; s.mode = 0; bf16* WT; size_t ldt; int K, nn, kcol0 = 0;
        if (r < J_ADA) { s.w = INP(9) + (size_t)l * D * NADA; s.ld = NADA; WT = (bf16*)(F.ws + WS_ADAW) + (size_t)l * NADA * D; ldt = D; K = D; nn = 384; }
        else if ((r -= J_ADA) < J_IN) { s.w = INP(13) + (size_t)l * D * 10176; s.ld = 10176; s.mode = 1; WT = (bf16*)wl(F, l, WL_IN); ldt = D; K = D; nn = 320; }
        else if ((r -= J_IN) < J_CA) { s.w = INP(15) + (size_t)l * 1024 * D; s.ld = D; WT = (bf16*)wl(F, l, WL_CAT); ldt = D; K = 1024; nn = 64; }
        else if ((r -= J_CA) < J_CP) { s.w = INP(18) + (size_t)l * 512 * D; s.ld = D; WT = (bf16*)wl(F, l, WL_CAT); ldt = D; K = 512; nn = 64; kcol0 = 1024; }
        else if ((r -= J_CP) < J_CR) { s.w = INP(30) + (size_t)l * 512 * D; s.ld = D; WT = (bf16*)wl(F, l, WL_CAT); ldt = D; K = 512; nn = 64; kcol0 = 1536; }
        else if ((r -= J_CR) < J_O) { s.w = INP(34) + (size_t)l * D * D; s.ld = D; WT = (bf16*)wl(F, l, WL_O); ldt = D; K = D; nn = 64; }
        else if ((r -= J_O) < J_GU) { s.w = INP(35) + (size_t)l * D * DFF; s.d2 = (const char*)INP(36) - (const char*)INP(35); s.ld = DFF; s.mode = 2; WT = (bf16*)wl(F, l, WL_GU); ldt = D; K = D; nn = 352; }
        else { r -= J_GU; s.w = INP(37) + (size_t)l * DFF * D; s.ld = D; WT = (bf16*)wl(F, l, WL_DN); ldt = DFF; K = DFF; nn = 64; }
        (void)K;
        transpose_item(s, K, WT, ldt, kcol0, scr, r / nn, r % nn, F.lane);
    }
    const int gt = F.bid * NTHR + F.tid, ngt = F.G * NTHR;
    for (int l = 0; l < NL; ++l) {
        small_transpose(INP(21) + (size_t)l * 96 * 512, 96, 512, (bf16*)wl(F, l, WL_W2), 96, gt, ngt);
        small_transpose(INP(23) + (size_t)l * 96 * 512, 96, 512, (bf16*)wl(F, l, WL_A2), 96, gt, ngt);
        small_transpose(INP(24) + (size_t)l * 256 * 512, 256, 512, (bf16*)wl(F, l, WL_G2), 256, gt, ngt);
        for (int g = 0; g < 4; ++g) small_transpose(INP(16) + ((size_t)l * 4 + g) * 128 * 128, 128, 128, (bf16*)wl(F, l, WL_PW) + g * 128 * 128, 128, gt, ngt);
    }
    small_transpose(INP(31), 512, 32, (bf16*)wl(F, 1, WL_V1), 512, gt, ngt);
    small_transpose(INP(32), 32, 512, (bf16*)wl(F, 1, WL_V2), 32, gt, ngt);
    for (int i = gt; i < 256 * D; i += ngt) { const int r = i >> 11, k = i & (D - 1); float v = 0.f;
        if (r < NMOD) { const float c = r < NB ? INP(2)[r * D + k] : INP(3)[(r - NB) * D + k]; v = c / (1.f + expf(-c)); }
        ((bf16*)(F.ws + WS_SILC))[i] = (bf16)f2bf(v); }
    for (int i = gt; i < 4097 * 32; i += ngt) { const int p = i >> 5, d = i & 31; const float pos = p < 4096 ? (float)p : (float)PASTLEN;
        const float inv = powf(10000.f, -(float)d * (2.0f / 64.f)), ang = pos * inv; float* t = (float*)(F.ws + WS_ROPE) + (size_t)p * 64; t[d] = cosf(ang); t[32 + d] = sinf(ang); }
}

__device__ __forceinline__ void norm_phase(const Frame& F, int l, int which  ) {
    const int gw = F.bid * NWAVES + F.wave, NGW = F.G * NWAVES;
    const float* g = which == 0 ? INP(11) + l * D : which == 1 ? INP(12) + l * D : INP(38); const float* xp0 = INP(0); const float* xp1 = INP(1);
    for (int m = gw; m < M; m += NGW) {
        const float* xr = (which == 0 && l == 0) ? (m < MP ? xp0 + (size_t)m * D : xp1 + (size_t)(m - MP) * D) : (const float*)(F.ws + WS_X) + (size_t)m * D;
        f32x4 v[8]; float s = 0.f;
#pragma unroll
        for (int j = 0; j < 8; ++j) { v[j] = *(const f32x4*)(xr + j * 256 + F.lane * 4); s += (v[j].x * v[j].x + v[j].y * v[j].y) + (v[j].z * v[j].z + v[j].w * v[j].w); }
        const float rs = rsqrtf(wave_sum(s) * (1.f / D) + 1e-6f);
        if (which == 2) { float* o = F.out + O_YP + (size_t)m * D;
#pragma unroll
            for (int j = 0; j < 8; ++j) { const f32x4 gg = *(const f32x4*)(g + j * 256 + F.lane * 4); *(f32x4*)(o + j * 256 + F.lane * 4) = v[j] * rs * gg; } }
        else { const float* mod = (const float*)(F.ws + WS_MOD) + ((size_t)l * NMOD + modrow(m)) * NADA + (which == 0 ? 0 : 3 * D);
            bf16* o = (bf16*)(F.ws + WS_H) + (size_t)m * D;
#pragma unroll
            for (int j = 0; j < 8; ++j) { const int c = j * 256 + F.lane * 4; const f32x4 gg = *(const f32x4*)(g + c), sh = *(const f32x4*)(mod + c), sc = *(const f32x4*)(mod + D + c);
                const f32x4 y = v[j] * rs * gg * (sc + 1.f) + sh; u32x2 w; w.x = pk2(y.x, y.y); w.y = pk2(y.z, y.w); *(u32x2*)(o + c) = w; } }
    }
}
}
namespace mk {
constexpr int BM = 256, BK = 64, HALF = 128, HTB = HALF * BK * 2, STAGE_BYTES = 8 * HTB, NXCD = 8, WGM = 8;
__device__ __forceinline__ int lds_byte(int r, int c) { const int st = (r >> 4) * 2 + (c >> 5), rr = r & 15, cc = c & 31, ob = rr * 64 + cc * 2; return st * 1024 + (ob ^ (((ob >> 9) & 1) << 5)); }
__device__ __forceinline__ void stage_rc(int b, int& R, int& C) { const int st = b / 1024, sb = b % 1024, swz = sb ^ (((sb >> 9) & 1) << 5); R = (st >> 1) * 16 + swz / 64; C = (st & 1) * 32 + (swz % 64) / 2; }
__device__ __forceinline__ int perm32(int rho) { const int n = rho >> 4, i = rho & 15; return 8 * (i >> 2) + 4 * n + (i & 3); }

struct Unit { int pm, pn, seg; };
enum { G_ADA = 0, G_IN, G_MG, G_WO, G_GU, G_DN };
struct Gemm { const bf16* A; const bf16* Bt; int ld, M, N, K, mode, layer; };

struct Sched {
    int nM, nN, G, c, nseg;
    __device__ __forceinline__ void init(const Gemm& g, int G_, int c_) { nM = g.M / BM; nN = g.N / BM; G = G_; c = c_; nseg = g.mode == G_MG ? 3 : 1; }
    __device__ __forceinline__ bool next(int i, Unit& u) const {
        const int ti = i / nseg, seg = i - ti * nseg, nwg = nM * nN;
        const long L = (long)ti * G + c; if (L >= nwg) return false;
        int wgid = (int)L; { const int q = nwg / NXCD, r = nwg % NXCD, xcd = wgid % NXCD, off = wgid / NXCD; wgid = (xcd < r ? xcd * (q + 1) : r * (q + 1) + (xcd - r) * q) + off; }
        const int nig = WGM * nN, gid = wgid / nig, fm = gid * WGM, gsz = (nM - fm) < WGM ? (nM - fm) : WGM;
        u.pm = fm + ((wgid % nig) % gsz); u.pn = (wgid % nig) / gsz; u.seg = seg;
        return true;
    }
};

typedef __bf16 bf16x2_t __attribute__((ext_vector_type(2)));
__device__ __forceinline__ unsigned cvt_pk_bf16(float lo, float hi) { const f32x2 v = {lo, hi}; const bf16x2_t b = __builtin_convertvector(v, bf16x2_t); return __builtin_bit_cast(unsigned, b); }
__device__ __forceinline__ f32x4 sig4(f32x4 v) { f32x4 r; r.x = fsigm(v.x); r.y = fsigm(v.y); r.z = fsigm(v.z); r.w = fsigm(v.w); return r; }

struct Epi {
    const Frame* F; int mode, layer;
    __device__ __forceinline__ void operator()(const f32x4 (&acc)[2][2][4][2], const Unit& u, int wr, int wc, int fr, int fq) const {
        const Frame& Fr = *F; const int l = layer;
        int row0 = u.pm * BM + wr * 64 + fr; const int colb = u.pn * BM + wc * 32 + 8 * fq;
        asm volatile("" : "+v"(row0));
        unsigned char* ws = Fr.ws;
        if (mode == G_ADA) {
            const float* ab = INP(10);
#pragma unroll
            for (int ai = 0; ai < 2; ++ai)
#pragma unroll
                for (int m = 0; m < 4; ++m) { const int r = row0 + ai * HALF + m * 16; if (r < NMOD) {
#pragma unroll
                    for (int bj = 0; bj < 2; ++bj) { const int c = colb + bj * HALF, ll = c / NADA, j = c - ll * NADA; float* o = (float*)(ws + WS_MOD) + ((size_t)ll * NMOD + r) * NADA + j;
                        *(f32x4*)o = acc[ai][bj][m][0] + *(const f32x4*)(ab + c); *(f32x4*)(o + 4) = acc[ai][bj][m][1] + *(const f32x4*)(ab + c + 4); } } }
        } else if (mode == G_IN) {
            const int pn = u.pn;
            if (pn < 5) {
                const int wp = wc & 1; const float* rt = (const float*)(ws + WS_ROPE);
#pragma unroll
                for (int ai = 0; ai < 2; ++ai)
#pragma unroll
                    for (int m = 0; m < 4; ++m) { const int r = row0 + ai * HALF + m * 16; if (r < M) {
                        const float* tp = rt + (size_t)posidx(r) * 64 + 16 * wp + 4 * fq; const f32x4 cs = *(const f32x4*)tp, sn = *(const f32x4*)(tp + 32);
#pragma unroll
                        for (int bj = 0; bj < 2; ++bj) { const f32x4 x1 = acc[ai][bj][m][0], x2 = acc[ai][bj][m][1]; const f32x4 o1 = x1 * cs - x2 * sn, o2 = x2 * cs + x1 * sn;
                            u32x4 w; w.x = cvt_pk_bf16(o1.x, o1.y); w.y = cvt_pk_bf16(o1.z, o1.w); w.z = cvt_pk_bf16(o2.x, o2.y); w.w = cvt_pk_bf16(o2.z, o2.w);
                            const int hc = bj * HALF + wc * 32 + 8 * fq;
                            if (pn < 4) *(u32x4*)((bf16*)(ws + WS_Q) + (size_t)r * 1024 + pn * 256 + hc) = w;
                            else { *(u32x4*)((bf16*)(ws + WS_K) + (size_t)r * 256 + hc) = w;
                                const int hk = hc >> 6, d1 = 16 * wp + 4 * fq; float* ko = nullptr;
                                if (r < MP) { const int t = r & (SEQ - 1); if (t >= SEQ - 128) ko = Fr.out + O_KP + ((((size_t)l * NB + (r >> 12)) * 128 + (t - (SEQ - 128))) * 4 + hk) * 64; }
                                else ko = Fr.out + O_KS + ((((size_t)l * NS + (r - MP)) * 128 + 127) * 4 + hk) * 64;
                                if (ko) { *(f32x4*)(ko + d1) = o1; *(f32x4*)(ko + d1 + 32) = o2; } } } } }
            } else if (pn == 5) {
#pragma unroll
                for (int ai = 0; ai < 2; ++ai)
#pragma unroll
                    for (int m = 0; m < 4; ++m) { const int r = row0 + ai * HALF + m * 16; if (r < M) {
#pragma unroll
                        for (int bj = 0; bj < 2; ++bj) { const f32x4 v0 = acc[ai][bj][m][0], v1 = acc[ai][bj][m][1]; const int hc = bj * HALF + wc * 32 + 8 * fq;
                            u32x4 w; w.x = cvt_pk_bf16(v0.x, v0.y); w.y = cvt_pk_bf16(v0.z, v0.w); w.z = cvt_pk_bf16(v1.x, v1.y); w.w = cvt_pk_bf16(v1.z, v1.w);
                            *(u32x4*)((bf16*)(ws + WS_V) + (size_t)r * 256 + hc) = w;
                            float* vo = nullptr;
                            if (r < MP) { const int t = r & (SEQ - 1); if (t >= SEQ - 128) vo = Fr.out + O_VP + (((size_t)l * NB + (r >> 12)) * 128 + (t - (SEQ - 128))) * 256; }
                            else vo = Fr.out + O_VS + (((size_t)l * NS + (r - MP)) * 128 + 127) * 256;
                            if (vo) { *(f32x4*)(vo + hc) = v0; *(f32x4*)(vo + hc + 4) = v1; } } } }
            } else if (pn < 16) {
                float* base = pn < 8 ? (float*)(ws + WS_U) : (float*)(ws + WS_PR); const int ld = pn < 8 ? 512 : 2048, c0 = (pn < 8 ? (pn - 6) : (pn - 8)) * 256 + wc * 32 + 8 * fq;
#pragma unroll
                for (int ai = 0; ai < 2; ++ai)
#pragma unroll
                    for (int m = 0; m < 4; ++m) { const int r = row0 + ai * HALF + m * 16; if (r < M) {
#pragma unroll
                        for (int bj = 0; bj < 2; ++bj) { float* o = base + (size_t)r * ld + c0 + bj * HALF; *(f32x4*)o = acc[ai][bj][m][0]; *(f32x4*)(o + 4) = acc[ai][bj][m][1]; } } }
            } else {
                const int c0 = (pn - 16) * 256 + wc * 32 + 8 * fq;
#pragma unroll
                for (int ai = 0; ai < 2; ++ai)
#pragma unroll
                    for (int m = 0; m < 4; ++m) { const int r = row0 + ai * HALF + m * 16; if (r < M) {
#pragma unroll
                        for (int bj = 0; bj < 2; ++bj) { const f32x4 v0 = sig4(acc[ai][bj][m][0]), v1 = sig4(acc[ai][bj][m][1]);
                            u32x4 w; w.x = cvt_pk_bf16(v0.x, v0.y); w.y = cvt_pk_bf16(v0.z, v0.w); w.z = cvt_pk_bf16(v1.x, v1.y); w.w = cvt_pk_bf16(v1.z, v1.w);
                            *(u32x4*)((bf16*)(ws + WS_GT) + (size_t)r * 6144 + c0 + bj * HALF) = w; } } }
            }
        } else if (mode == G_MG) {
            const int c0 = u.pn * BM + wc * 32 + 8 * fq;
#pragma unroll
            for (int ai = 0; ai < 2; ++ai)
#pragma unroll
                for (int m = 0; m < 4; ++m) { const int r = row0 + ai * HALF + m * 16; if (r < M) {
#pragma unroll
                    for (int bj = 0; bj < 2; ++bj) { const int c = c0 + bj * HALF; const u32x4 gw = *(const u32x4*)((const bf16*)(ws + WS_GT) + (size_t)r * 6144 + u.seg * D + c);
                        bf16* mp = (bf16*)(ws + WS_MG) + (size_t)r * D + c; f32x4 v0 = acc[ai][bj][m][0], v1 = acc[ai][bj][m][1];
                        v0.x *= bflo(gw.x); v0.y *= bfhi(gw.x); v0.z *= bflo(gw.y); v0.w *= bfhi(gw.y); v1.x *= bflo(gw.z); v1.y *= bfhi(gw.z); v1.z *= bflo(gw.w); v1.w *= bfhi(gw.w);
                        if (u.seg > 0) { const u32x4 ow = *(const u32x4*)mp; v0.x += bflo(ow.x); v0.y += bfhi(ow.x); v0.z += bflo(ow.y); v0.w += bfhi(ow.y); v1.x += bflo(ow.z); v1.y += bfhi(ow.z); v1.z += bflo(ow.w); v1.w += bfhi(ow.w); }
                        u32x4 w; w.x = cvt_pk_bf16(v0.x, v0.y); w.y = cvt_pk_bf16(v0.z, v0.w); w.z = cvt_pk_bf16(v1.x, v1.y); w.w = cvt_pk_bf16(v1.z, v1.w); *(u32x4*)mp = w; } } }
        } else if (mode == G_WO || mode == G_DN) {
            const int c0 = u.pn * BM + wc * 32 + 8 * fq; const int goff = mode == G_WO ? 2 * D : 5 * D;
#pragma unroll
            for (int ai = 0; ai < 2; ++ai)
#pragma unroll
                for (int m = 0; m < 4; ++m) { const int r = row0 + ai * HALF + m * 16; if (r < M) {
                    const float* gp = (const float*)(ws + WS_MOD) + ((size_t)l * NMOD + modrow(r)) * NADA + goff;
                    const float* xin = (mode == G_WO && l == 0) ? (r < MP ? INP(0) + (size_t)r * D : INP(1) + (size_t)(r - MP) * D) : (const float*)(ws + WS_X) + (size_t)r * D;
                    float* xo = (float*)(ws + WS_X) + (size_t)r * D;
#pragma unroll
                    for (int bj = 0; bj < 2; ++bj) { const int c = c0 + bj * HALF;
                        const f32x4 g0 = *(const f32x4*)(gp + c), g1 = *(const f32x4*)(gp + c + 4), x0 = *(const f32x4*)(xin + c), x1 = *(const f32x4*)(xin + c + 4);
                        *(f32x4*)(xo + c) = x0 + (g0 + 1.f) * acc[ai][bj][m][0]; *(f32x4*)(xo + c + 4) = x1 + (g1 + 1.f) * acc[ai][bj][m][1]; } } }
        } else {
            const int c0 = u.pn * 128 + wc * 16 + 4 * fq;
#pragma unroll
            for (int ai = 0; ai < 2; ++ai)
#pragma unroll
                for (int m = 0; m < 4; ++m) { const int r = row0 + ai * HALF + m * 16; if (r < M) {
#pragma unroll
                    for (int bj = 0; bj < 2; ++bj) { const f32x4 g = acc[ai][bj][m][0], up = acc[ai][bj][m][1]; const f32x4 a = g * sig4(g) * up;
                        u32x2 w; w.x = cvt_pk_bf16(a.x, a.y); w.y = cvt_pk_bf16(a.z, a.w); *(u32x2*)((bf16*)(ws + WS_GT) + (size_t)r * DFF + c0 + bj * 64) = w; } } }
        }
    }
};

__device__ __forceinline__ void gemm_phase(LAS unsigned char* lds, const Gemm g, const Sched& S, const Epi& E) {
    const int tid = threadIdx.x, wid = __builtin_amdgcn_readfirstlane(tid >> 6), lane = tid & 63, wr = wid >> 2, wc = wid & 3, fr = lane & 15, fq = lane >> 4;
    unsigned voffA[2], voffB[2];
#pragma unroll
    for (int i = 0; i < 2; ++i) { int R, C; stage_rc(tid * 16 + i * 8192, R, C); const int Rb = (R & ~31) + perm32(R & 31);
        voffA[i] = (unsigned)(R * g.ld + C) * 2u; voffB[i] = (unsigned)(Rb * g.ld + C) * 2u; }
    constexpr unsigned kstep = BK * 2;
    const unsigned hstep = (unsigned)HALF * (unsigned)g.ld * 2u; const bool segd = g.mode == G_MG; const int ntfull = g.K / BK;
#define PG8_KA(u) (segd ? ((u).seg == 0 ? 0u : (u).seg == 1 ? 1024u : 1536u) : 0u)
#define PG8_NT(u) (segd ? ((u).seg == 0 ? 16 : 8) : ntfull)
#define PG8_TILE(p, u) (((unsigned)(p) * (unsigned)BM * (unsigned)g.ld + PG8_KA(u)) * 2u)
    const unsigned ldsw = (unsigned)wid * 1024u;
    const int aoff = lds_byte(wr * 64 + fr, fq * 8), boff = lds_byte(wc * 32 + fr, fq * 8);
#define PG8_SA(b, h) (((b) * 2 + (h)) * HTB)
#define PG8_SB(b, h) ((4 + (b) * 2 + (h)) * HTB)
#define PG8_STAGE(bufoff, gbase, soff, voff) do { _Pragma("unroll") for (int _i = 0; _i < 2; ++_i) \
        __builtin_amdgcn_global_load_lds((const unsigned*)((const char*)(gbase) + (size_t)((voff)[_i] + (unsigned)(soff))), (LAS unsigned*)(lds + (bufoff) + ldsw + _i * 8192), 16, 0, 0); } while (0)
#define PG8_STA(bufoff, soff) PG8_STAGE(bufoff, g.A, soff, voffA)
#define PG8_STB(bufoff, soff) PG8_STAGE(bufoff, g.Bt, soff, voffB)
#define PG8_LDA(dst, b, h) do { _Pragma("unroll") for (int m = 0; m < 4; ++m) _Pragma("unroll") for (int k = 0; k < 2; ++k) dst[m][k] = *(const LAS bf16x8*)(lds + PG8_SA(b, h) + aoff + m * 2048 + k * 1024); } while (0)
#define PG8_LDB(dst, b, h) do { _Pragma("unroll") for (int n = 0; n < 2; ++n) _Pragma("unroll") for (int k = 0; k < 2; ++k) dst[n][k] = *(const LAS bf16x8*)(lds + PG8_SB(b, h) + boff + n * 2048 + k * 1024); } while (0)
#define PG8_MMA(ai, bj, At, Bt) do { __builtin_amdgcn_s_setprio(1); _Pragma("unroll") for (int m = 0; m < 4; ++m) _Pragma("unroll") for (int n = 0; n < 2; ++n) _Pragma("unroll") for (int k = 0; k < 2; ++k) \
        acc[ai][bj][m][n] = __builtin_amdgcn_mfma_f32_16x16x32_bf16(Bt[n][k], At[m][k], acc[ai][bj][m][n], 0, 0, 0); __builtin_amdgcn_s_setprio(0); } while (0)
#define PG8_WAIT_V(n) asm volatile("s_waitcnt vmcnt(" #n ")" ::: "memory")
#define PG8_WAIT_L(n) asm volatile("s_waitcnt lgkmcnt(" #n ")" ::: "memory")
#define PG8_BAR __builtin_amdgcn_s_barrier()
#define PG8_SCHED __builtin_amdgcn_sched_barrier(0)
    Unit cur, nxt; int ui = 0;
    if (!S.next(0, cur)) return;
    f32x4 acc[2][2][4][2];
#pragma unroll
    for (int a = 0; a < 2; ++a)
#pragma unroll
        for (int b = 0; b < 2; ++b)
#pragma unroll
            for (int m = 0; m < 4; ++m)
#pragma unroll
                for (int n = 0; n < 2; ++n) acc[a][b][m][n] = (f32x4){0.f, 0.f, 0.f, 0.f};
    bf16x8 At[4][2], B0[2][2], B1[2][2];
    unsigned cA = PG8_TILE(cur.pm, cur), cB = PG8_TILE(cur.pn, cur);
    PG8_STB(PG8_SB(0, 0), cB); PG8_STB(PG8_SB(0, 1), cB + hstep); PG8_STA(PG8_SA(0, 0), cA); PG8_STA(PG8_SA(0, 1), cA + hstep);
    if (wr == 1) PG8_BAR;
    PG8_WAIT_V(2); PG8_BAR;
    PG8_STB(PG8_SB(1, 0), cB + kstep); PG8_STA(PG8_SA(1, 0), cA + kstep); PG8_STB(PG8_SB(1, 1), cB + hstep + kstep);
    PG8_WAIT_V(6); PG8_BAR;
    for (;;) {
        const bool has_next = S.next(ui + 1, nxt);
        const unsigned nA = has_next ? PG8_TILE(nxt.pm, nxt) : cA, nB = has_next ? PG8_TILE(nxt.pn, nxt) : cB;
        const int nt = PG8_NT(cur);
        for (int t = 0; t < nt; t += 2) {
            const bool last = (t == nt - 2);
            const unsigned a1 = cA + (unsigned)(t + 1) * kstep;
            const unsigned a2 = last ? nA : cA + (unsigned)(t + 2) * kstep, b2 = last ? nB : cB + (unsigned)(t + 2) * kstep;
            const unsigned a3 = a2 + kstep, b3 = b2 + kstep;
            PG8_LDB(B0, 0, 0); PG8_LDB(B1, 0, 1); PG8_SCHED; PG8_LDA(At, 0, 0); PG8_STA(PG8_SA(1, 1), a1 + hstep);
            PG8_WAIT_V(8); PG8_WAIT_L(0); PG8_BAR; PG8_MMA(0, 0, At, B0); PG8_MMA(0, 1, At, B1); PG8_BAR; PG8_SCHED;
            PG8_LDA(At, 0, 1); PG8_STB(PG8_SB(0, 0), b2); PG8_STB(PG8_SB(0, 1), b2 + hstep); PG8_STA(PG8_SA(0, 0), a2);
            PG8_WAIT_V(8); PG8_WAIT_L(0); PG8_BAR; PG8_MMA(1, 0, At, B0); PG8_MMA(1, 1, At, B1); PG8_BAR; PG8_SCHED;
            PG8_LDB(B0, 1, 0); PG8_LDB(B1, 1, 1); PG8_SCHED; PG8_LDA(At, 1, 0); PG8_STA(PG8_SA(0, 1), a2 + hstep);
            PG8_WAIT_V(8); PG8_WAIT_L(0); PG8_BAR; PG8_MMA(0, 0, At, B0); PG8_MMA(0, 1, At, B1); PG8_BAR; PG8_SCHED;
            PG8_LDA(At, 1, 1); PG8_STB(PG8_SB(1, 0), b3); PG8_STB(PG8_SB(1, 1), b3 + hstep); PG8_STA(PG8_SA(1, 0), a3);
            PG8_WAIT_V(8); PG8_WAIT_L(0); PG8_BAR; PG8_MMA(1, 0, At, B0); PG8_MMA(1, 1, At, B1); PG8_BAR; PG8_SCHED;
        }
        if (wr == 0) PG8_BAR;
        E(acc, cur, wr, wc, fr, fq);
        if (!has_next) break;
#pragma unroll
        for (int a = 0; a < 2; ++a)
#pragma unroll
            for (int b = 0; b < 2; ++b)
#pragma unroll
                for (int m = 0; m < 4; ++m)
#pragma unroll
                    for (int n = 0; n < 2; ++n) acc[a][b][m][n] = (f32x4){0.f, 0.f, 0.f, 0.f};
        cur = nxt; cA = nA; cB = nB; ++ui;
        if (wr == 1) PG8_BAR;
    }
    PG8_WAIT_V(0);
    PG8_BAR;
#undef PG8_KA
#undef PG8_NT
#undef PG8_TILE
#undef PG8_STA
#undef PG8_STB
#undef PG8_SA
#undef PG8_SB
#undef PG8_STAGE
#undef PG8_LDA
#undef PG8_LDB
#undef PG8_MMA
#undef PG8_WAIT_V
#undef PG8_WAIT_L
#undef PG8_BAR
#undef PG8_SCHED
}
}
namespace mk {
#define MFMA16(a, b, c) __builtin_amdgcn_mfma_f32_16x16x32_bf16((a), (b), (c), 0, 0, 0)
__device__ __forceinline__ bf16x8 pack8(f32x4 a, f32x4 b) { u32x4 w; w.x = cvt_pk_bf16(a.x, a.y); w.y = cvt_pk_bf16(a.z, a.w); w.z = cvt_pk_bf16(b.x, b.y); w.w = cvt_pk_bf16(b.z, b.w); return __builtin_bit_cast(bf16x8, w); }
typedef short s16x4 __attribute__((ext_vector_type(4)));
__device__ __forceinline__ bf16x8 cat44(s16x4 a, s16x4 b) { return (bf16x8){a[0], a[1], a[2], a[3], b[0], b[1], b[2], b[3]}; }
constexpr float LOG2E = 1.4426950408889634f;

constexpr int AK_STRIDE = 144, AV_STRIDE = 560;
constexpr int A_KOFF = 0, A_VOFF = 256 * AK_STRIDE, A_BYTES = A_VOFF + 64 * AV_STRIDE;
__device__ __forceinline__ void attn_prompt_unit(const Frame& F, int l, int b, int blk, int hk) {
    LAS unsigned char* Ks = F.lds + A_KOFF; LAS unsigned char* Vt = F.lds + A_VOFF;
    const bf16* Kg = (const bf16*)(F.ws + WS_K); const bf16* Vg = (const bf16*)(F.ws + WS_V); const bf16* Qg = (const bf16*)(F.ws + WS_Q);
    const int kp0 = blk * 128 - 128;
    for (int ch = F.tid; ch < 2048; ch += NTHR) { const int i = ch >> 3, dc = ch & 7, kp = kp0 + i;
        u32x4 kv = (u32x4){0u, 0u, 0u, 0u}, vv = kv;
        if (kp >= 0) { const size_t m = (size_t)b * SEQ + kp; kv = *(const u32x4*)(Kg + m * 256 + hk * 64 + dc * 8); vv = *(const u32x4*)(Vg + m * 256 + hk * 64 + dc * 8); }
        *(LAS u32x4*)(Ks + i * AK_STRIDE + dc * 16) = kv;
        LAS unsigned short* vp = (LAS unsigned short*)(Vt + (dc * 8) * AV_STRIDE) + i;
        vp[0 * (AV_STRIDE / 2)] = (unsigned short)(vv.x & 0xffff); vp[1 * (AV_STRIDE / 2)] = (unsigned short)(vv.x >> 16); vp[2 * (AV_STRIDE / 2)] = (unsigned short)(vv.y & 0xffff); vp[3 * (AV_STRIDE / 2)] = (unsigned short)(vv.y >> 16);
        vp[4 * (AV_STRIDE / 2)] = (unsigned short)(vv.z & 0xffff); vp[5 * (AV_STRIDE / 2)] = (unsigned short)(vv.z >> 16); vp[6 * (AV_STRIDE / 2)] = (unsigned short)(vv.w & 0xffff); vp[7 * (AV_STRIDE / 2)] = (unsigned short)(vv.w >> 16); }
    for (int i = F.tid; i < 64 * 24; i += NTHR) { const int d = i / 24, c = i % 24; ((LAS unsigned short*)(Vt + d * AV_STRIDE))[256 + c] = 0; }
    __syncthreads();
    const int g = F.lane >> 4, c16 = F.lane & 15;
    const float* sinkp = INP(14) + l * 16;
    for (int it = 0; it < 4; ++it) {
        const int gi = F.wave * 4 + it, hq = hk * 4 + (gi >> 3), qs = gi & 7;
        const int tqr = 16 * qs + c16;
        const size_t mq = (size_t)b * SEQ + blk * 128 + tqr;
        const bf16x8 q0 = *(const bf16x8*)(Qg + mq * 1024 + hq * 64 + 8 * g), q1 = *(const bf16x8*)(Qg + mq * 1024 + hq * 64 + 32 + 8 * g);
        f32x4 s[10];
#pragma unroll
        for (int j = 0; j < 9; ++j) { LAS const unsigned char* kr = Ks + (16 * (qs + j) + c16) * AK_STRIDE + 16 * g;
            const bf16x8 k0 = *(LAS const bf16x8*)kr, k1 = *(LAS const bf16x8*)(kr + 64);
            f32x4 a = (f32x4){0.f, 0.f, 0.f, 0.f}; a = MFMA16(k0, q0, a); a = MFMA16(k1, q1, a); s[j] = a; }
        const float sk2 = sinkp[hq] * LOG2E; float mx = sk2;
#pragma unroll
        for (int j = 0; j < 9; ++j)
#pragma unroll
            for (int r = 0; r < 4; ++r) { const int i = 16 * (qs + j) + 4 * g + r; const bool ok = (i >= tqr) && (i <= tqr + 128) && (kp0 + i >= 0);
                const float v = ok ? s[j][r] * (0.125f * LOG2E) : -1e30f; s[j][r] = v; mx = fmaxf(mx, v); }
        mx = fmaxf(mx, __shfl_xor(mx, 16)); mx = fmaxf(mx, __shfl_xor(mx, 32));
        float sum = 0.f;
#pragma unroll
        for (int j = 0; j < 9; ++j)
#pragma unroll
            for (int r = 0; r < 4; ++r) { const float p = __builtin_amdgcn_exp2f(s[j][r] - mx); s[j][r] = p; sum += p; }
        s[9] = (f32x4){0.f, 0.f, 0.f, 0.f};
        sum += __shfl_xor(sum, 16); sum += __shfl_xor(sum, 32);
        const float rl = 1.f / (sum + __builtin_amdgcn_exp2f(sk2 - mx));
        f32x4 o[4];
#pragma unroll
        for (int dt = 0; dt < 4; ++dt) o[dt] = (f32x4){0.f, 0.f, 0.f, 0.f};
#pragma unroll
        for (int kk = 0; kk < 5; ++kk) { const bf16x8 pf = pack8(s[2 * kk], s[2 * kk + 1]);
#pragma unroll
            for (int dt = 0; dt < 4; ++dt) { LAS const unsigned char* vr = Vt + (16 * dt + c16) * AV_STRIDE + (16 * (qs + 2 * kk) + 4 * g) * 2;
                const s16x4 v0 = *(LAS const s16x4*)vr, v1 = *(LAS const s16x4*)(vr + 32);
                o[dt] = MFMA16(cat44(v0, v1), pf, o[dt]); } }
        bf16* op = (bf16*)(F.ws + WS_CAT) + mq * D + hq * 64 + 4 * g;
#pragma unroll
        for (int dt = 0; dt < 4; ++dt) { const f32x4 v = o[dt] * rl; u32x2 w; w.x = cvt_pk_bf16(v.x, v.y); w.y = cvt_pk_bf16(v.z, v.w); *(u32x2*)(op + 16 * dt) = w; }
    }
    __syncthreads();
}

__device__ __forceinline__ void attn_sample_unit(const Frame& F, int l, int s_) {
    LAS float* qn = (LAS float*)F.lds;
    LAS float* kn = qn + 1024;
    LAS float* vn = kn + 256;
    LAS float* sc = vn + 256;
    LAS float* rl = sc + 16 * 132;
    const int m = MP + s_; const float* sinkp = INP(14) + l * 16;
    const float* ck = INP(4) + ((size_t)l * NS + s_) * 128 * 256; const float* cv = INP(5) + ((size_t)l * NS + s_) * 128 * 256;
    for (int i = F.tid; i < 1024; i += NTHR) { const int h = i >> 6, p = i & 63; qn[h * 64 + pi_d(p)] = bf2f(((const bf16*)(F.ws + WS_Q))[(size_t)m * 1024 + i]) * (0.125f * LOG2E); }
    if (F.tid < 256) { const int h = F.tid >> 6, p = F.tid & 63; kn[h * 64 + pi_d(p)] = bf2f(((const bf16*)(F.ws + WS_K))[(size_t)m * 256 + F.tid]); vn[F.tid] = bf2f(((const bf16*)(F.ws + WS_V))[(size_t)m * 256 + F.tid]); }
    { float* ko = F.out + O_KS + ((size_t)l * NS + s_) * 128 * 256; float* vo = F.out + O_VS + ((size_t)l * NS + s_) * 128 * 256;
      for (int i = F.tid; i < 127 * 64; i += NTHR) { *(f32x4*)(ko + 4 * i) = *(const f32x4*)(ck + 256 + 4 * i); *(f32x4*)(vo + 4 * i) = *(const f32x4*)(cv + 256 + 4 * i); } }
    __syncthreads();
    for (int idx = F.tid; idx < 16 * 129; idx += NTHR) { const int hq = idx / 129, j = idx - hq * 129, hk = hq >> 2; float a = 0.f;
        if (j < 128) { const float* kr = ck + (size_t)j * 256 + hk * 64;
#pragma unroll
            for (int d = 0; d < 64; d += 4) { const f32x4 kv = *(const f32x4*)(kr + d); a += qn[hq * 64 + d] * kv.x + qn[hq * 64 + d + 1] * kv.y + qn[hq * 64 + d + 2] * kv.z + qn[hq * 64 + d + 3] * kv.w; } }
        else { for (int d = 0; d < 64; ++d) a += qn[hq * 64 + d] * kn[hk * 64 + d]; }
        sc[hq * 132 + j] = a; }
    __syncthreads();
    for (int hh = 0; hh < 2; ++hh) { const int hq = F.wave * 2 + hh; const float sk2 = sinkp[hq] * LOG2E;
        float mx = sk2; for (int j = F.lane; j < 129; j += 64) mx = fmaxf(mx, sc[hq * 132 + j]);
#pragma unroll
        for (int o = 1; o < 64; o <<= 1) mx = fmaxf(mx, __shfl_xor(mx, o));
        float sum = 0.f; for (int j = F.lane; j < 129; j += 64) { const float p = __builtin_amdgcn_exp2f(sc[hq * 132 + j] - mx); sc[hq * 132 + j] = p; sum += p; }
        sum = wave_sum(sum); if (F.lane == 0) rl[hq] = 1.f / (sum + __builtin_amdgcn_exp2f(sk2 - mx)); }
    __syncthreads();
    for (int idx = F.tid; idx < 1024; idx += NTHR) { const int hq = idx >> 6, d = idx & 63, hk = hq >> 2; float a = 0.f;
#pragma unroll 16
        for (int j = 0; j < 128; ++j) a += sc[hq * 132 + j] * cv[(size_t)j * 256 + hk * 64 + d];
        a += sc[hq * 132 + 128] * vn[hk * 64 + d];
        ((bf16*)(F.ws + WS_CAT))[(size_t)m * D + idx] = (bf16)f2bf(a * rl[hq]); }
    __syncthreads();
}

constexpr int PL_STRIDE = 272;
__device__ __forceinline__ void pool_unit(const Frame& F, int l, int rt, int gi) {
    LAS unsigned char* dT = F.lds; LAS unsigned char* Wt = F.lds + 128 * PL_STRIDE;
    const float* U = (const float*)(F.ws + WS_U); const int w = 2 << gi, m0 = rt * 128;
    { const bf16* pw = (const bf16*)wl(F, l, WL_PW) + (size_t)gi * 128 * 128;
      for (int ch = F.tid; ch < 2048; ch += NTHR) { const int e = ch >> 4, cc = ch & 15; *(LAS u32x4*)(Wt + e * PL_STRIDE + cc * 16) = *(const u32x4*)(pw + e * 128 + cc * 8); } }
    { const int c = F.tid & 127, strip = F.tid >> 7, col = gi * 128 + c;
      if (rt < 64) { const int t0 = (m0 & (SEQ - 1)) + 32 * strip; const float* up = U + (size_t)(m0 + 32 * strip) * 512 + col;
          float uv[47];
#pragma unroll
          for (int j = 0; j < 47; ++j) { const int t = t0 - 15 + j; uv[j] = t >= 0 ? up[(ptrdiff_t)(j - 15) * 512] : 0.f; }
          LAS unsigned short* dp = (LAS unsigned short*)(dT + (32 * strip) * PL_STRIDE) + c;
#define POOL_D(W) { float sum = 0.f; _Pragma("unroll") for (int j = 1; j < W; ++j) sum += uv[15 - j]; \
              _Pragma("unroll") for (int k = 0; k < 32; ++k) { const int t = t0 + k; sum += uv[15 + k]; const float cnt = (float)(t + 1 < W ? t + 1 : W); \
                  dp[k * (PL_STRIDE / 2)] = (unsigned short)f2bf(sum / cnt - uv[15 + k]); sum -= uv[15 + k - W + 1]; } }
          if (gi == 0) POOL_D(2) else if (gi == 1) POOL_D(4) else if (gi == 2) POOL_D(8) else POOL_D(16)
#undef POOL_D
      }
      else { const float* sp = INP(6) + (size_t)l * NS * 15 * 512;
          for (int k = 0; k < 32; ++k) { const int s_ = 32 * strip + k; const float uc = U[(size_t)(MP + s_) * 512 + col]; float sum = uc;
              for (int j = 1; j < w; ++j) sum += sp[((size_t)s_ * 15 + 15 - j) * 512 + col];
              ((LAS unsigned short*)(dT + s_ * PL_STRIDE))[c] = (unsigned short)f2bf(sum / (float)w - uc); } } }
    __syncthreads();
    const int g = F.lane >> 4, c16 = F.lane & 15;
    f32x4 acc[8];
#pragma unroll
    for (int et = 0; et < 8; ++et) acc[et] = (f32x4){0.f, 0.f, 0.f, 0.f};
#pragma unroll
    for (int ks = 0; ks < 4; ++ks) { const bf16x8 df = *(LAS const bf16x8*)(dT + (16 * F.wave + c16) * PL_STRIDE + (32 * ks + 8 * g) * 2);
#pragma unroll
        for (int et = 0; et < 8; ++et) { const bf16x8 wf = *(LAS const bf16x8*)(Wt + (16 * et + c16) * PL_STRIDE + (32 * ks + 8 * g) * 2); acc[et] = MFMA16(wf, df, acc[et]); } }
    const int m = m0 + 16 * F.wave + c16; const float* psc = INP(17) + l * 512 + gi * 128;
    if (m < M) { bf16* op = (bf16*)(F.ws + WS_CAT) + (size_t)m * D + 1024 + gi * 128 + 4 * g;
#pragma unroll
        for (int et = 0; et < 8; ++et) { const f32x4 v = acc[et] * *(const f32x4*)(psc + 16 * et + 4 * g); u32x2 wv; wv.x = cvt_pk_bf16(v.x, v.y); wv.y = cvt_pk_bf16(v.z, v.w); *(u32x2*)(op + 16 * et) = wv; } }
    __syncthreads();
}
__device__ __forceinline__ void state_outs(const Frame& F, int l) {
    const int gt = F.bid * NTHR + F.tid, ngt = F.G * NTHR; const float* U = (const float*)(F.ws + WS_U); const float* PR = (const float*)(F.ws + WS_PR);
    for (int i = gt; i < NB * 15 * 512; i += ngt) { const int b = i / (15 * 512), j = (i >> 9) % 15, c = i & 511; F.out[O_PP + (size_t)l * NB * 15 * 512 + i] = U[((size_t)b * SEQ + SEQ - 15 + j) * 512 + c]; }
    const float* sp = INP(6) + (size_t)l * NS * 15 * 512;
    for (int i = gt; i < NS * 15 * 512; i += ngt) { const int s_ = i / (15 * 512), j = (i >> 9) % 15, c = i & 511; F.out[O_PS + (size_t)l * NS * 15 * 512 + i] = j < 14 ? sp[i + 512] : U[(size_t)(MP + s_) * 512 + c]; }
    for (int i = gt; i < NB * RP; i += ngt) { const int b = i / RP, c = i - b * RP; F.out[O_SP + (size_t)l * NB * RP + i] = PR[((size_t)b * SEQ + SEQ - 1) * 2048 + c]; }
    for (int i = gt; i < NS * RP; i += ngt) { const int s_ = i / RP, c = i - s_ * RP; F.out[O_SS + (size_t)l * NS * RP + i] = PR[(size_t)(MP + s_) * 2048 + c]; }
}

constexpr int RA_STRIDE = 1936;
constexpr int R_T1OFF = 32 * RA_STRIDE, RT_STRIDE = 80;
struct XmRow { const float* p; const float* pv; float pz; };
__device__ __forceinline__ XmRow xm_row(const float* PR, const float* sshift, int m) {
    XmRow r; r.p = PR + (size_t)m * 2048; const bool first = m < MP && (m & (SEQ - 1)) == 0;
    r.pv = m >= MP ? sshift + (size_t)(m - MP) * RP : first ? r.p : r.p - 2048; r.pz = first ? 0.f : 1.f; return r;
}
__device__ __forceinline__ float xm_at(const XmRow& r, const float* mu, int c) { const float p = r.p[c]; return p + (r.pv[c] * r.pz - p) * mu[c]; }
__device__ __forceinline__ f32x4 xm4_at(const XmRow& r, const float* mu, int c) { const f32x4 p = *(const f32x4*)(r.p + c); return p + (*(const f32x4*)(r.pv + c) * r.pz - p) * *(const f32x4*)(mu + c); }
template <int KS> __device__ __forceinline__ void lora_mm(f32x4 (&acc)[4], const bf16* Wt, int ldw, int nbase, LAS const unsigned char* Arow, int acol, int g, int c16) {
#pragma unroll
    for (int nt = 0; nt < 4; ++nt) acc[nt] = (f32x4){0.f, 0.f, 0.f, 0.f};
#pragma unroll
    for (int ks = 0; ks < KS; ++ks) { const bf16x8 af = *(LAS const bf16x8*)(Arow + (acol + 32 * ks + 8 * g) * 2);
#pragma unroll
        for (int nt = 0; nt < 4; ++nt) { const bf16x8 wf = *(const bf16x8*)(Wt + (size_t)(nbase + 16 * nt + c16) * ldw + 32 * ks + 8 * g); acc[nt] = MFMA16(wf, af, acc[nt]); } }
}
__device__ __forceinline__ float frcp(float x) { return __builtin_amdgcn_rcpf(x); }
__device__ __forceinline__ f32x4 fsig4(f32x4 v) { f32x4 r; r.x = frcp(1.f + __expf(-v.x)); r.y = frcp(1.f + __expf(-v.y)); r.z = frcp(1.f + __expf(-v.z)); r.w = frcp(1.f + __expf(-v.w)); return r; }
__device__ __forceinline__ void rwkv_prep_unit(const Frame& F, int l, int ti) {
    LAS unsigned char* Aop = F.lds; LAS unsigned char* T1 = F.lds + R_T1OFF;
    const float* PR = (const float*)(F.ws + WS_PR); const float* sshift = INP(7) + (size_t)l * NS * RP; const float* mu = INP(19) + l * RP;
    const int m0 = ti * 32; const bool vres = l > 0;
    const float* a0p = INP(22) + l * 512; const float* w0p = INP(20) + l * 512; const float* vbp = INP(33); const float* kkp = INP(25) + l * 512; const float* kap = INP(26) + l * 512;
    for (int i = F.tid; i < 32 * 448; i += NTHR) { const int r = i / 448, c = i - r * 448; const XmRow xr = xm_row(PR, sshift, m0 + r); const float x = xm_at(xr, mu, 1536 + c);
        const float y = c < 96 ? 1.f - 2.f / (1.f + __expf(2.f * x)) : c < 192 ? x : fsigm(x); ((LAS unsigned short*)(Aop + r * RA_STRIDE))[c] = (unsigned short)f2bf(y); }
    if (vres) for (int i = F.tid; i < 32 * 512; i += NTHR) { const int r = i >> 9, c = i & 511; const XmRow xr = xm_row(PR, sshift, m0 + r); ((LAS unsigned short*)(Aop + r * RA_STRIDE))[448 + c] = (unsigned short)f2bf(xm_at(xr, mu, 1024 + c)); }
    __syncthreads();
    const int g = F.lane >> 4, c16 = F.lane & 15, nb = 64 * F.wave;
    if (vres) {
        if (F.wave < 4) { const int mt = F.wave >> 1, nt = F.wave & 1; f32x4 a = (f32x4){0.f, 0.f, 0.f, 0.f}; const bf16* w1 = (const bf16*)wl(F, 1, WL_V1);
#pragma unroll 2
            for (int ks = 0; ks < 16; ++ks) { const bf16x8 af = *(LAS const bf16x8*)(Aop + (16 * mt + c16) * RA_STRIDE + (448 + 32 * ks + 8 * g) * 2);
                const bf16x8 wf = *(const bf16x8*)(w1 + (size_t)(16 * nt + c16) * 512 + 32 * ks + 8 * g); a = MFMA16(wf, af, a); }
            u32x2 wv; wv.x = cvt_pk_bf16(a.x, a.y); wv.y = cvt_pk_bf16(a.z, a.w); *(LAS u32x2*)(T1 + (16 * mt + c16) * RT_STRIDE + (16 * nt + 4 * g) * 2) = wv;
#if MK_DEBUG
            *(f32x4*)((float*)(F.ws + WS_H) + (size_t)(m0 + 16 * mt + c16) * 32 + 16 * nt + 4 * g) = a;
#endif
            }
        __syncthreads();
    }
    float* Rb = rwbuf(F, RW_R); float* Wb = rwbuf(F, RW_W); float* Kb = rwbuf(F, RW_K); float* Vb = rwbuf(F, RW_V); float* Ab = rwbuf(F, RW_A); float* Bb = rwbuf(F, RW_B); float* Gb = rwbuf(F, RW_G); float* VF = rwbuf(F, RW_VF);
#pragma unroll 1
    for (int mt = 0; mt < 2; ++mt) {
        f32x4 acc[4], av[4]; LAS const unsigned char* Arow = Aop + (16 * mt + c16) * RA_STRIDE;
        int m = m0 + 16 * mt + c16; asm volatile("" : "+v"(m)); const size_t ro = (size_t)m * 512 + nb + 4 * g;
        lora_mm<3>(acc, (const bf16*)wl(F, l, WL_A2), 96, nb, Arow, 96, g, c16);
#pragma unroll
        for (int nt = 0; nt < 4; ++nt) av[nt] = fsig4(acc[nt] + *(const f32x4*)(a0p + nb + 16 * nt + 4 * g));
        lora_mm<3>(acc, (const bf16*)wl(F, l, WL_W2), 96, nb, Arow, 0, g, c16);
#pragma unroll
        for (int nt = 0; nt < 4; ++nt) { const f32x4 z = acc[nt] + *(const f32x4*)(w0p + nb + 16 * nt + 4 * g); f32x4 dec;
#pragma unroll
            for (int e = 0; e < 4; ++e) { const float zz = -z[e]; const float sp = fmaxf(zz, 0.f) + __logf(1.f + __expf(-fabsf(zz))); dec[e] = __expf(-__expf(-sp - 0.5f)); }
            *(f32x4*)(Wb + ro + 16 * nt) = dec; }
        lora_mm<8>(acc, (const bf16*)wl(F, l, WL_G2), 256, nb, Arow, 192, g, c16);
#pragma unroll
        for (int nt = 0; nt < 4; ++nt) *(f32x4*)(Gb + ro + 16 * nt) = acc[nt];
        if (vres) { const bf16x8 tf = *(LAS const bf16x8*)(T1 + (16 * mt + c16) * RT_STRIDE + (8 * g) * 2); const f32x4 z4 = (f32x4){0.f, 0.f, 0.f, 0.f};
#pragma unroll
            for (int nt = 0; nt < 4; ++nt) { const bf16x8 wf = *(const bf16x8*)((const bf16*)wl(F, 1, WL_V2) + (size_t)(nb + 16 * nt + c16) * 32 + 8 * g); acc[nt] = MFMA16(wf, tf, z4);
#if MK_DEBUG
                *(f32x4*)(rwbuf(F, RW_Y) + ro + 16 * nt) = acc[nt];
#endif
            } }
        f32x4 kk[4]; float ss = 0.f; const XmRow xr = xm_row(PR, sshift, m);
#pragma unroll
        for (int nt = 0; nt < 4; ++nt) { const int n = nb + 16 * nt + 4 * g; const f32x4 k = xm4_at(xr, mu, 512 + n);
            kk[nt] = k * *(const f32x4*)(kkp + n); ss += (kk[nt].x * kk[nt].x + kk[nt].y * kk[nt].y) + (kk[nt].z * kk[nt].z + kk[nt].w * kk[nt].w);
            *(f32x4*)(Kb + ro + 16 * nt) = k * ((av[nt] - 1.f) * *(const f32x4*)(kap + n) + 1.f);
            asm volatile("" ::: "memory"); }
#pragma unroll
        for (int nt = 0; nt < 4; ++nt) { const int n = nb + 16 * nt + 4 * g; const f32x4 r = xm4_at(xr, mu, n); f32x4 v = xm4_at(xr, mu, 1024 + n);
            *(f32x4*)(Rb + ro + 16 * nt) = r;
            if (!vres) *(f32x4*)(VF + ro + 16 * nt) = v;
            else { const f32x4 vf = *(const f32x4*)(VF + ro + 16 * nt); v = v + (vf - v) * fsig4(acc[nt] + *(const f32x4*)(vbp + n)); }
            *(f32x4*)(Vb + ro + 16 * nt) = v;
            asm volatile("" ::: "memory"); }
        ss += __shfl_xor(ss, 16); ss += __shfl_xor(ss, 32);
        const float rn = 1.f / fmaxf(sqrtf(ss), 1e-12f);
#pragma unroll
        for (int nt = 0; nt < 4; ++nt) { const f32x4 kn = kk[nt] * rn; *(f32x4*)(Ab + ro + 16 * nt) = -kn; *(f32x4*)(Bb + ro + 16 * nt) = kn * av[nt]; }
    }
    __syncthreads();
}

template <int CTRL> __device__ __forceinline__ float dpp_f(float x) { return __builtin_bit_cast(float, __builtin_amdgcn_mov_dpp(__builtin_bit_cast(int, x), CTRL, 0xf, 0xf, true)); }
__device__ __forceinline__ float row16_sum(float x) {
    x += dpp_f<0xB1>(x); x += dpp_f<0x4E>(x); x += dpp_f<0x141>(x); x += dpp_f<0x128>(x); return x;
}
constexpr int SC_T = 32, SC_ARR = SC_T * 64 * 4, SC_BUF = 5 * SC_ARR + SC_T * 16 * 4;
__device__ __forceinline__ void scan_prompt_unit(const Frame& F, int l, int b, int h, int qt) {
    const float* src0 = rwbuf(F, RW_W); const float* src1 = rwbuf(F, RW_A); const float* src2 = rwbuf(F, RW_B); const float* src3 = rwbuf(F, RW_K); const float* src4 = rwbuf(F, RW_R);
    const float* Vb = rwbuf(F, RW_V); float* Yb = rwbuf(F, RW_Y);
    const size_t rowb = (size_t)b * SEQ;
    f32x4 st0, st1, st2, st3, st4, st5;
#define SC_ISSUE(t0_) do { const int tt_ = F.tid >> 4, c4_ = F.tid & 15; const size_t ro_ = (rowb + (t0_) + tt_) * 512 + h * 64 + 4 * c4_; \
        st0 = *(const f32x4*)(src0 + ro_); st1 = *(const f32x4*)(src1 + ro_); st2 = *(const f32x4*)(src2 + ro_); st3 = *(const f32x4*)(src3 + ro_); st4 = *(const f32x4*)(src4 + ro_); \
        if (F.tid < 128) { const int tv_ = F.tid >> 2, cv_ = F.tid & 3; st5 = *(const f32x4*)(Vb + (rowb + (t0_) + tv_) * 512 + h * 64 + qt * 16 + 4 * cv_); } } while (0)
#define SC_COMMIT(buf_) do { LAS unsigned char* bp_ = F.lds + (buf_) * SC_BUF + F.tid * 16; \
        *(LAS f32x4*)(bp_ + 0 * SC_ARR) = st0; *(LAS f32x4*)(bp_ + 1 * SC_ARR) = st1; *(LAS f32x4*)(bp_ + 2 * SC_ARR) = st2; *(LAS f32x4*)(bp_ + 3 * SC_ARR) = st3; *(LAS f32x4*)(bp_ + 4 * SC_ARR) = st4; \
        if (F.tid < 128) *(LAS f32x4*)(bp_ + 5 * SC_ARR) = st5; } while (0)
    SC_ISSUE(0); SC_COMMIT(0); __syncthreads();
    const int rg = F.lane >> 4, j4 = F.lane & 15, rloc = F.wave * 4 + rg;
    f32x4 s = (f32x4){0.f, 0.f, 0.f, 0.f}; float yk = 0.f;
    float* yp = Yb + (rowb + j4) * 512 + h * 64 + qt * 16 + rloc;
    constexpr int NCH = SEQ / SC_T;
    for (int ch = 0; ch < NCH; ++ch) {
        if (ch + 1 < NCH) SC_ISSUE((ch + 1) * SC_T);
        if (F.wave < 4) { LAS const unsigned char* bp = F.lds + (ch & 1) * SC_BUF + j4 * 16; LAS const float* vp = (LAS const float*)(F.lds + (ch & 1) * SC_BUF + 5 * SC_ARR) + rloc;
#pragma unroll
            for (int tt = 0; tt < SC_T; ++tt) {
                const f32x4 w = *(LAS const f32x4*)(bp + 0 * SC_ARR + tt * 256), a = *(LAS const f32x4*)(bp + 1 * SC_ARR + tt * 256), bb = *(LAS const f32x4*)(bp + 2 * SC_ARR + tt * 256),
                            k = *(LAS const f32x4*)(bp + 3 * SC_ARR + tt * 256), r = *(LAS const f32x4*)(bp + 4 * SC_ARR + tt * 256);
                const float v = vp[tt * 16];
                const f32x4 p = s * w + k * v;
                const float sa = row16_sum((s.x * a.x + s.y * a.y) + (s.z * a.z + s.w * a.w));
                s = bb * sa + p;
                const float y = row16_sum((s.x * r.x + s.y * r.y) + (s.z * r.z + s.w * r.w));
                yk = (j4 == (tt & 15)) ? y : yk;
                if ((tt & 15) == 15) yp[(size_t)(ch * SC_T + (tt & ~15)) * 512] = yk;
            } }
        if (ch + 1 < NCH) SC_COMMIT((ch + 1) & 1);
        __syncthreads();
    }
    if (F.wave < 4) *(f32x4*)(F.out + O_WP + ((((size_t)l * NB + b) * 8 + h) * 64 + qt * 16 + rloc) * 64 + 4 * j4) = s;
    __syncthreads();
}
__device__ __forceinline__ void scan_sample_wave(const Frame& F, int l, int s_, int h) {
    const size_t m = MP + s_; const int rg = F.lane >> 4, j4 = F.lane & 15; const size_t o = m * 512 + h * 64 + 4 * j4;
    const f32x4 w = *(const f32x4*)(rwbuf(F, RW_W) + o), a = *(const f32x4*)(rwbuf(F, RW_A) + o), bb = *(const f32x4*)(rwbuf(F, RW_B) + o), k = *(const f32x4*)(rwbuf(F, RW_K) + o), r = *(const f32x4*)(rwbuf(F, RW_R) + o);
    const float* S0 = INP(8) + (((size_t)l * NS + s_) * 8 + h) * 4096; float* S1 = F.out + O_WS + (((size_t)l * NS + s_) * 8 + h) * 4096;
#pragma unroll 4
    for (int i0 = 0; i0 < 16; ++i0) { const int i = 4 * i0 + rg; f32x4 s = *(const f32x4*)(S0 + i * 64 + 4 * j4); const float v = rwbuf(F, RW_V)[m * 512 + h * 64 + i];
        const float sa = row16_sum((s.x * a.x + s.y * a.y) + (s.z * a.z + s.w * a.w));
        s = s * w + bb * sa + k * v;
        const float y = row16_sum((s.x * r.x + s.y * r.y) + (s.z * r.z + s.w * r.w));
        *(f32x4*)(S1 + i * 64 + 4 * j4) = s; if (j4 == 0) rwbuf(F, RW_Y)[m * 512 + h * 64 + i] = y; }
}
__device__ __forceinline__ void rwkv_post_phase(const Frame& F, int l) {
    const int gw = F.bid * NWAVES + F.wave, NGW = F.G * NWAVES; const float* rkp = INP(27) + l * 512; const float* lgp = INP(28) + l * 512; const float* lbp = INP(29) + l * 512;
    for (int it = gw; it < M * 8; it += NGW) { const int m = it >> 3, h = it & 7, c = h * 64 + F.lane; const size_t o = (size_t)m * 512 + c;
        const float y = rwbuf(F, RW_Y)[o]; const float mu = wave_sum(y) * (1.f / 64.f); const float dv = y - mu; const float var = wave_sum(dv * dv) * (1.f / 64.f);
        const float bon = wave_sum(rwbuf(F, RW_R)[o] * rwbuf(F, RW_K)[o] * rkp[c]);
        const float out = (dv * rsqrtf(var + 64e-5f) * lgp[c] + lbp[c] + bon * rwbuf(F, RW_V)[o]) * rwbuf(F, RW_G)[o];
        ((bf16*)(F.ws + WS_CAT))[(size_t)m * D + 1536 + c] = (bf16)f2bf(out); }
}
}
namespace mk {
namespace cg = cooperative_groups;
constexpr int LDS_BYTES = 135168;
constexpr int PH_PRO = 0, PH_ADA = 1, PH_L0 = 2, PH_PER_L = 10, PH_FINAL = PH_L0 + NL * PH_PER_L, N_PHASES = PH_FINAL + 1;
enum { LP_NORM1 = 0, LP_IN, LP_MIX, LP_SCAN, LP_POST, LP_MG, LP_WO, LP_NORM2, LP_GU, LP_DN };

__device__ __forceinline__ void mix_phase(const Frame& F, int l) {
#ifndef MK_NO_U1
    for (int u = F.bid; u < 260; u += F.G) rwkv_prep_unit(F, l, u);
#endif
#ifndef MK_NO_U2
    for (int a = (F.bid + 252) % F.G; a < 256; a += F.G) attn_prompt_unit(F, l, a >> 7, (a >> 2) & 31, a & 3);
#endif
#ifndef MK_NO_U3
    for (int p = (F.bid + 248) % F.G; p < 260; p += F.G) pool_unit(F, l, p >> 2, p & 3);
#endif
#ifndef MK_NO_U4
    for (int s_ = (F.bid + 244) % F.G; s_ < NS; s_ += F.G) attn_sample_unit(F, l, s_);
#endif
    state_outs(F, l);
}
__device__ __forceinline__ void scan_phase(const Frame& F, int l) {
    if (F.bid < 64) scan_prompt_unit(F, l, F.bid >> 5, (F.bid >> 2) & 7, F.bid & 3);
    else { const int nw = (F.G - 64) * NWAVES; for (int u = (F.bid - 64) * NWAVES + F.wave; u < NS * 8; u += nw) scan_sample_wave(F, l, u >> 3, u & 7); }
}

__global__ void __launch_bounds__(NTHR, 2) mega(Args args) {
    extern __shared__ __attribute__((aligned(16))) unsigned char lds_raw[];
    cg::grid_group grid = cg::this_grid();
    for (int ph = args.ph_lo; ph < args.ph_hi; ++ph) {
        Frame F; { GAS unsigned char* ws_ = (GAS unsigned char*)args.ws; GAS float* out_ = (GAS float*)args.out; int tid_ = threadIdx.x; int bid_ = blockIdx.x; int G_ = gridDim.x;
            asm volatile("" : "+s"(ws_), "+s"(out_), "+v"(tid_), "+s"(bid_), "+s"(G_));
            F.lds = (LAS unsigned char*)lds_raw; F.tid = tid_; F.lane = tid_ & 63; F.wave = __builtin_amdgcn_readfirstlane(tid_ >> 6); F.G = G_; F.bid = bid_; F.out = (float*)out_; F.ws = (unsigned char*)ws_; }
        const int l = ph >= PH_L0 && ph < PH_FINAL ? (ph - PH_L0) / PH_PER_L : 0, lp = ph >= PH_L0 && ph < PH_FINAL ? (ph - PH_L0) % PH_PER_L : -1;
#ifndef MK_NO_PRO
        if (ph == PH_PRO) { p0_prologue(F);
#ifdef MK_DUP_PRO
            __syncthreads(); p0_prologue(F);
#endif
        } else
#endif
#ifndef MK_NO_NORM
        if (ph == PH_FINAL || lp == LP_NORM1 || lp == LP_NORM2) norm_phase(F, l, ph == PH_FINAL ? 2 : lp == LP_NORM1 ? 0 : 1); else
#endif
#ifndef MK_NO_MIX
        if (lp == LP_MIX) { mix_phase(F, l);
#ifdef MK_DUP_MIX
            __syncthreads(); mix_phase(F, l);
#endif
        } else
#endif
#ifndef MK_NO_SCAN
        if (lp == LP_SCAN) { scan_phase(F, l);
#ifdef MK_DUP_SCAN
            __syncthreads(); scan_phase(F, l);
#endif
        } else
#endif
#ifndef MK_NO_POST
        if (lp == LP_POST) rwkv_post_phase(F, l); else
#endif
#ifndef MK_NO_GEMM
        {
            Gemm g; g.layer = l; g.ld = D; g.M = MPAD; g.K = D;
            if (ph == PH_ADA) { g.A = (const bf16*)(F.ws + WS_SILC); g.Bt = (const bf16*)(F.ws + WS_ADAW); g.M = 256; g.N = 2 * NADA; g.mode = G_ADA; }
            else if (lp == LP_IN) { g.A = (const bf16*)(F.ws + WS_H); g.Bt = (const bf16*)wl(F, l, WL_IN); g.N = NIN; g.mode = G_IN; }
            else if (lp == LP_MG) { g.A = (const bf16*)(F.ws + WS_CAT); g.Bt = (const bf16*)wl(F, l, WL_CAT); g.N = D; g.mode = G_MG; }
            else if (lp == LP_WO) { g.A = (const bf16*)(F.ws + WS_MG); g.Bt = (const bf16*)wl(F, l, WL_O); g.N = D; g.mode = G_WO; }
            else if (lp == LP_GU) { g.A = (const bf16*)(F.ws + WS_H); g.Bt = (const bf16*)wl(F, l, WL_GU); g.N = NGU; g.mode = G_GU; }
            else { g.A = (const bf16*)(F.ws + WS_GT); g.Bt = (const bf16*)wl(F, l, WL_DN); g.N = D; g.K = DFF; g.ld = DFF; g.mode = G_DN; }
            Sched S; S.init(g, F.G, F.bid); Epi E; E.F = &F; E.mode = g.mode; E.layer = l;
            gemm_phase(F.lds, g, S, E);
        }
#else
        {}
#endif
        if (ph + 1 < args.ph_hi) grid.sync();
    }
}
}
#ifndef MK_DEBUG
#define MK_DEBUG 0
#endif
extern "C" void kernel_launch(void* const* d_in, const int* in_sizes, int n_in, void* d_out, int out_size, void* d_ws, size_t ws_size, hipStream_t stream) {
    using namespace mk;
    static int grid = 0;
    if (grid == 0) {
        nv::WS wtmp; const size_t need_nv = nv::carve((float*)d_ws, wtmp) * 4; const size_t need = MK_DEBUG ? (need_nv > WS_END ? need_nv : WS_END) + (16u << 20) : WS_END;
        if (n_in != 39 || (size_t)out_size != O_END || ws_size < need) { fprintf(stderr, "kernel_launch: unexpected shapes: n_in %d out %d (want %zu) ws %zu (need %zu)\n", n_in, out_size, (size_t)O_END, ws_size, need); grid = -1; return; }
        int dev = 0, cus = 0, per_cu = 0;
        if (hipGetDevice(&dev) != hipSuccess || hipDeviceGetAttribute(&cus, hipDeviceAttributeMultiprocessorCount, dev) != hipSuccess) { grid = -1; return; }
        if (hipFuncSetAttribute((const void*)mega, hipFuncAttributeMaxDynamicSharedMemorySize, LDS_BYTES) != hipSuccess) { fprintf(stderr, "kernel_launch: hipFuncSetAttribute failed\n"); grid = -1; return; }
        if (hipOccupancyMaxActiveBlocksPerMultiprocessor(&per_cu, (const void*)mega, NTHR, LDS_BYTES) != hipSuccess || per_cu < 1) { fprintf(stderr, "kernel_launch: occupancy query says %d blocks per CU\n", per_cu); per_cu = 1; }
        (void)hipGetLastError();
        grid = cus;
        fprintf(stderr, "kernel_launch: grid %d (cus %d, per_cu %d), ws %zu need %zu\n", grid, cus, per_cu, ws_size, need);
    }
    if (grid < 0) return;
    Args a{};
    for (int i = 0; i < 39; ++i) a.in[i] = (const float*)d_in[i];
    a.out = (float*)d_out; a.ws = (unsigned char*)d_ws;
#if MK_DEBUG
    dbg::Ctx dc; dc.probes = (float*)((unsigned char*)d_ws + ((ws_size - (12u << 20)) & ~(size_t)255)); dc.err = dc.probes + (size_t)dbg::NIDS * dbg::NPROBE; dc.on = 1;
    (void)hipMemsetAsync(dc.err, 0, dbg::NIDS * 4 * sizeof(float), stream);
    unsigned char* ws = (unsigned char*)d_ws;
    for (int ph = 0; ph < N_PHASES; ++ph) {
        a.ph_lo = ph; a.ph_hi = ph + 1;
        hipLaunchKernelGGL(mega, dim3(grid), dim3(NTHR), LDS_BYTES, stream, a);
        using namespace dbg;
        const int l = ph >= PH_L0 && ph < PH_FINAL ? (ph - PH_L0) / PH_PER_L : 0, lp = ph >= PH_L0 && ph < PH_FINAL ? (ph - PH_L0) % PH_PER_L : -1, tb = T_L0 + l * T_PER_L;
        if (ph == PH_ADA) save(&dc, stream, T_MOD, ws + WS_MOD, K_F32, NADA, 0, NL * NMOD, NADA);
        if (lp == LP_NORM1) save(&dc, stream, tb + T_H1, ws + WS_H, K_BF16, D, 0, M, D);
        if (lp == LP_IN) { save(&dc, stream, tb + T_Q, ws + WS_Q, K_QPERM, 1024, 0, M, 1024); save(&dc, stream, tb + T_K, ws + WS_K, K_QPERM, 256, 0, M, 256); save(&dc, stream, tb + T_V, ws + WS_V, K_BF16, 256, 0, M, 256);
            save(&dc, stream, tb + T_U, ws + WS_U, K_F32, 512, 0, M, 512); save(&dc, stream, tb + T_PR, ws + WS_PR, K_F32, 2048, 0, M, RP); save(&dc, stream, tb + T_GT, ws + WS_GT, K_BF16, 6144, 0, M, 6144); }
        if (lp == LP_MIX) { save(&dc, stream, tb + T_OA, ws + WS_CAT, K_BF16, D, 0, M, 1024); save(&dc, stream, tb + T_ZP, ws + WS_CAT, K_BF16, D, 1024, M, 512);
            for (int i = 0; i < 7; ++i) save(&dc, stream, tb + T_R + i, ws + WS_RW + (size_t)i * RW_STRIDE, K_F32, 512, 0, M, 512);
            if (l == 1) { save(&dc, stream, 59, ws + WS_RW + (size_t)RW_Y * RW_STRIDE, K_F32, 512, 0, M, 512); save(&dc, stream, 60, ws + WS_H, K_F32, 32, 0, M, 32); } }
        if (lp == LP_SCAN) save(&dc, stream, tb + T_Y, ws + WS_RW + (size_t)RW_Y * RW_STRIDE, K_F32, 512, 0, M, 512);
        if (lp == LP_POST) save(&dc, stream, tb + T_YR, ws + WS_CAT, K_BF16, D, 1536, M, 512);
        if (lp == LP_MG) save(&dc, stream, tb + T_MG, ws + WS_MG, K_BF16, D, 0, M, D);
        if (lp == LP_WO) save(&dc, stream, tb + T_X1, ws + WS_X, K_F32, D, 0, M, D);
        if (lp == LP_NORM2) save(&dc, stream, tb + T_H2, ws + WS_H, K_BF16, D, 0, M, D);
        if (lp == LP_GU) save(&dc, stream, tb + T_ACT, ws + WS_GT, K_BF16, DFF, 0, M, DFF);
        if (lp == LP_DN) save(&dc, stream, tb + T_X2, ws + WS_X, K_F32, D, 0, M, D);
    }
    const size_t ooff[13] = {O_YP, O_YS, O_KP, O_VP, O_PP, O_SP, O_WP, O_KS, O_VS, O_PS, O_SS, O_WS, O_END}; const int ocol[12] = {2048, 2048, 256, 256, 512, 1984, 64, 256, 256, 512, 1984, 64};
    for (int i = 0; i < 12; ++i) dbg::save(&dc, stream, dbg::T_OUT0 + i, (float*)d_out + ooff[i], dbg::K_F32, ocol[i], 0, (int)((ooff[i + 1] - ooff[i]) / ocol[i]), ocol[i]);
    nv::In in; for (int i = 0; i < 39; ++i) in.p[i] = (const float*)d_in[i];
    nv::forward(in, (float*)d_out, (float*)d_ws, stream, &dc);
    for (int i = 0; i < 12; ++i) dbg::cmp(&dc, stream, dbg::T_OUT0 + i, (float*)d_out + ooff[i], ocol[i], 0, (int)((ooff[i + 1] - ooff[i]) / ocol[i]), ocol[i]);
#ifndef DBG_WANT_ID
#define DBG_WANT_ID -1
#endif
    dbg::inject<<<1, 1, 0, stream>>>(dc.err, (float*)d_out, (float*)d_out + O_YS, DBG_WANT_ID >= 0 ? dbg::NIDS : dbg::T_N, DBG_WANT_ID);
#else
    a.ph_lo = 0; a.ph_hi = N_PHASES;
    void* kargs[] = {&a};
    const hipError_t e = hipLaunchCooperativeKernel((const void*)mega, dim3(grid), dim3(NTHR), kargs, LDS_BYTES, stream);
    if (e != hipSuccess) fprintf(stderr, "kernel_launch: cooperative launch failed: %s (grid %d)\n", hipGetErrorString(e), grid);
#endif
}
```

```cpp
#define MK_DEBUG 0
#include <hip/hip_runtime.h>
#include <hip/hip_cooperative_groups.h>
#include <cstdio>
#include <cstdint>
namespace dbg {
constexpr int NPROBE = 16384, NSPECIAL = 2048, NIDS = 64;
struct Ctx { float* probes; float* err; int on; };
__device__ __forceinline__ unsigned hash32(unsigned x) { x ^= x >> 16; x *= 0x7feb352dU; x ^= x >> 15; x *= 0x846ca68bU; x ^= x >> 16; return x; }
__device__ __forceinline__ void probe_rc(int id, int k, int R, int C, int& r, int& c) {
    const unsigned h1 = hash32((unsigned)(id * 1000003 + k * 2 + 1)), h2 = hash32((unsigned)(id * 7919 + k * 2 + 77777));
    c = (int)(h2 % (unsigned)C);
    if (R == 8320 && k < NSPECIAL) { const int sp[16] = {0, 1, 15, 16, 127, 128, 129, 4095, 4096, 4097, 8190, 8191, 8192, 8193, 8255, 8319}; r = sp[k >> 7]; }
    else r = (int)(h1 % (unsigned)R);
}
enum { K_F32 = 0, K_BF16 = 1, K_QPERM = 2 };
__device__ __forceinline__ float opt_read(const void* p, int kind, size_t ld, int coff, int r, int c) {
    if (kind == K_F32) return ((const float*)p)[(size_t)r * ld + coff + c];
    if (kind == K_QPERM) { const int h = c >> 6, d = c & 63, pp = 32 * ((d >> 4) & 1) + 8 * ((d >> 2) & 3) + 4 * (d >> 5) + (d & 3); c = h * 64 + pp; }
    const unsigned short b = ((const unsigned short*)p)[(size_t)r * ld + coff + c]; return __builtin_bit_cast(float, (unsigned)b << 16);
}
__global__ void probe_save(float* probes, int id, const void* p, int kind, size_t ld, int coff, int R, int C) {
    const int k = blockIdx.x * blockDim.x + threadIdx.x; if (k >= NPROBE) return; int r, c; probe_rc(id, k, R, C, r, c);
    probes[(size_t)id * NPROBE + k] = opt_read(p, kind, ld, coff, r, c);
}
__global__ void probe_cmp(const float* probes, float* err, int id, const float* gold, size_t ld, int coff, int R, int C, int sig) {
    const int k = blockIdx.x * blockDim.x + threadIdx.x; if (k >= NPROBE) return; int r, c; probe_rc(id, k, R, C, r, c);
    float g = gold[(size_t)r * ld + coff + c]; if (sig) g = 1.f / (1.f + expf(-g));
    float o = probes[(size_t)id * NPROBE + k]; float d = o - g; if (!(d == d) || fabsf(d) > 1e18f) d = 1e18f;
    const int sp = (R == 8320 && k < NSPECIAL) ? 0 : 2;
    atomicAdd(&err[id * 4 + sp], d * d); atomicAdd(&err[id * 4 + sp + 1], g * g);
}
__global__ void inject(const float* err, float* out, float* ys, int nids, int want_id) {
    if (threadIdx.x || blockIdx.x) return;
    int rid = 89, which = 0; float rel = 1e-3f;
    for (int id = 0; id < nids; ++id) {
        const float r_rand = sqrtf(err[id * 4 + 2] / fmaxf(err[id * 4 + 3], 1e-30f)), r_sp = err[id * 4 + 1] > 0.f ? sqrtf(err[id * 4 + 0] / fmaxf(err[id * 4 + 1], 1e-30f)) : 0.f;
        if (want_id >= 0) { if (id == want_id) { rid = id; which = 0; rel = r_rand; break; } continue; }
        if (r_rand > 0.05f) { rid = id; which = 0; rel = r_rand; break; } else if (r_sp > 0.10f) { rid = id; which = 1; rel = r_sp; break; } }
    const float c1 = (float)(10 + rid) * (which ? 1e5f : 1e3f); float f = (log10f(fmaxf(rel, 1e-3f)) + 3.f) * 0.25f; f = fminf(fmaxf(f, 0.f), 1.f);
    out[0] = c1; ys[0] = c1 * (0.2f + 0.6f * f);
}
inline void save(const Ctx* c, hipStream_t st, int id, const void* p, int kind, size_t ld, int coff, int R, int C) { if (c && c->on) probe_save<<<NPROBE / 256, 256, 0, st>>>(c->probes, id, p, kind, ld, coff, R, C); }
inline void cmp(const Ctx* c, hipStream_t st, int id, const float* gold, size_t ld, int coff, int R, int C, int sig = 0) { if (c && c->on) probe_cmp<<<NPROBE / 256, 256, 0, st>>>(c->probes, c->err, id, gold, ld, coff, R, C, sig); }
enum { T_MOD = 0, T_L0 = 1, T_PER_L = 23, T_OUT0 = T_L0 + 2 * T_PER_L, T_N = T_OUT0 + 12 };
enum { T_H1 = 0, T_Q, T_K, T_V, T_U, T_PR, T_GT, T_OA, T_ZP, T_R, T_W, T_KK, T_VV, T_A, T_B, T_G, T_Y, T_YR, T_MG, T_X1, T_H2, T_ACT, T_X2 };
}
namespace nv {
constexpr int D = 2048, SEQ = 4096, NB = 2, MP = NB * SEQ, NS = 128, M = MP + NS, NL = 2;
constexpr int INW = 10176, OQ = 0, OK_ = 1024, OV = 1280, OU = 1536, OPR = 2048, OGL = 4032;
constexpr int RP = 1984, DFF = 5632, NMOD = NB + NS;
constexpr int PASTLEN = 8192;

__device__ __forceinline__ float sigm(float x) { return 1.f / (1.f + expf(-x)); }
__device__ __forceinline__ float silu(float x) { return x / (1.f + expf(-x)); }
__device__ __forceinline__ int modrow(int m) { return m < MP ? m / SEQ : NB + (m - MP); }
__device__ __forceinline__ int posof(int m) { return m < MP ? m % SEQ : PASTLEN; }

__global__ void __launch_bounds__(256) gemm(const float* __restrict__ A, int lda, const float* __restrict__ B, int ldb, float* __restrict__ C, int ldc, int Mm, int N, int K) {
    __shared__ float As[16][68], Bs[16][68];
    const int tx = threadIdx.x & 15, ty = threadIdx.x >> 4, m0 = blockIdx.y * 64, n0 = blockIdx.x * 64;
    float acc[4][4];
#pragma unroll
    for (int i = 0; i < 4; ++i)
#pragma unroll
        for (int j = 0; j < 4; ++j) acc[i][j] = 0.f;
    for (int k0 = 0; k0 < K; k0 += 16) {
        for (int i = threadIdx.x; i < 1024; i += 256) { const int r = i >> 4, c = i & 15; As[c][r] = (m0 + r < Mm) ? A[(size_t)(m0 + r) * lda + k0 + c] : 0.f; }
        for (int i = threadIdx.x; i < 1024; i += 256) { const int r = i >> 6, c = i & 63; Bs[r][c] = (n0 + c < N) ? B[(size_t)(k0 + r) * ldb + n0 + c] : 0.f; }
        __syncthreads();
#pragma unroll
        for (int kk = 0; kk < 16; ++kk) {
            float a[4], b[4];
#pragma unroll
            for (int i = 0; i < 4; ++i) { a[i] = As[kk][ty * 4 + i]; b[i] = Bs[kk][tx * 4 + i]; }
#pragma unroll
            for (int i = 0; i < 4; ++i)
#pragma unroll
                for (int j = 0; j < 4; ++j) acc[i][j] += a[i] * b[j];
        }
        __syncthreads();
    }
#pragma unroll
    for (int i = 0; i < 4; ++i)
#pragma unroll
        for (int j = 0; j < 4; ++j) { const int m = m0 + ty * 4 + i, n = n0 + tx * 4 + j; if (m < Mm && n < N) C[(size_t)m * ldc + n] = acc[i][j]; }
}

__global__ void silu_c(const float* cp, const float* cs, float* out) {
    const int i = blockIdx.x * blockDim.x + threadIdx.x; if (i >= NMOD * D) return;
    const int r = i / D, k = i % D; const float c = r < NB ? cp[r * D + k] : cs[(r - NB) * D + k]; out[i] = silu(c);
}
__global__ void add_bias(float* mod, const float* b, int n, int N) { const int i = blockIdx.x * blockDim.x + threadIdx.x; if (i < n) mod[i] += b[i % N]; }

__global__ void __launch_bounds__(256) modnorm(const float* xa, const float* xb, const float* g, const float* mod, int sh_off, int sc_off, float* out, size_t out_split_off) {
    const int m = blockIdx.x; const float* x = m < MP ? xa + (size_t)m * D : xb + (size_t)(m - MP) * D;
    __shared__ float red[256]; float s = 0.f;
    for (int k = threadIdx.x; k < D; k += 256) { const float v = x[k]; s += v * v; }
    red[threadIdx.x] = s; __syncthreads();
    for (int o = 128; o > 0; o >>= 1) { if (threadIdx.x < o) red[threadIdx.x] += red[threadIdx.x + o]; __syncthreads(); }
    const float rs = rsqrtf(red[0] / D + 1e-6f); const int br = modrow(m);
    float* o = m < MP ? out + (size_t)m * D : out + out_split_off + (size_t)(m - MP) * D;
    for (int k = threadIdx.x; k < D; k += 256) { float v = x[k] * rs * g[k]; if (mod) v = v * (1.f + mod[(size_t)br * 6 * D + sc_off + k]) + mod[(size_t)br * 6 * D + sh_off + k]; o[k] = v; }
}

__global__ void rope(float* z) {
    const int i = blockIdx.x * blockDim.x + threadIdx.x; if (i >= M * 20 * 32) return;
    const int m = i / 640, hh = (i / 32) % 20, d = i % 32; const float pos = (float)posof(m);
    const float inv = powf(10000.f, -(float)d * 2.0f / 64.f), ang = pos * inv, c = cosf(ang), s = sinf(ang);
    float* p = z + (size_t)m * INW + hh * 64; const float x1 = p[d], x2 = p[d + 32]; p[d] = x1 * c - x2 * s; p[d + 32] = x2 * c + x1 * s;
}

__global__ void attn_prompt(const float* z, const float* sink, float* oattn) {
    const int i = blockIdx.x * blockDim.x + threadIdx.x; if (i >= MP * 16) return;
    const int m = i / 16, hq = i % 16, hk = hq / 4, t = m % SEQ; const float* q = z + (size_t)m * INW + OQ + hq * 64;
    const int lo = t - 128 < 0 ? 0 : t - 128; const float sk = sink[hq];
    float mx = sk;
    for (int kp = lo; kp <= t; ++kp) { const float* k = z + (size_t)(m - t + kp) * INW + OK_ + hk * 64; float s = 0.f; for (int d = 0; d < 64; ++d) s += q[d] * k[d]; s *= 0.125f; mx = fmaxf(mx, s); }
    float den = expf(sk - mx); float o[64];
#pragma unroll
    for (int d = 0; d < 64; ++d) o[d] = 0.f;
    for (int kp = lo; kp <= t; ++kp) { const float* k = z + (size_t)(m - t + kp) * INW + OK_ + hk * 64; const float* v = z + (size_t)(m - t + kp) * INW + OV + hk * 64; float s = 0.f; for (int d = 0; d < 64; ++d) s += q[d] * k[d]; s *= 0.125f;
        const float p = expf(s - mx); den += p;
#pragma unroll
        for (int d = 0; d < 64; ++d) o[d] += p * v[d]; }
#pragma unroll
    for (int d = 0; d < 64; ++d) oattn[(size_t)m * 1024 + hq * 64 + d] = o[d] / den;
}
__global__ void attn_sample(const float* z, const float* sink, const float* ck, const float* cv, float* oattn) {
    const int i = blockIdx.x * blockDim.x + threadIdx.x; if (i >= NS * 16) return;
    const int s_ = i / 16, hq = i % 16, hk = hq / 4, m = MP + s_; const float* q = z + (size_t)m * INW + OQ + hq * 64; const float sk = sink[hq];
    float mx = sk;
    for (int j = 0; j <= 128; ++j) { const float* k = j < 128 ? ck + ((size_t)(s_ * 128 + j) * 4 + hk) * 64 : z + (size_t)m * INW + OK_ + hk * 64; float s = 0.f; for (int d = 0; d < 64; ++d) s += q[d] * k[d]; s *= 0.125f; mx = fmaxf(mx, s); }
    float den = expf(sk - mx); float o[64];
#pragma unroll
    for (int d = 0; d < 64; ++d) o[d] = 0.f;
    for (int j = 0; j <= 128; ++j) { const float* k = j < 128 ? ck + ((size_t)(s_ * 128 + j) * 4 + hk) * 64 : z + (size_t)m * INW + OK_ + hk * 64;
        const float* v = j < 128 ? cv + ((size_t)(s_ * 128 + j) * 4 + hk) * 64 : z + (size_t)m * INW + OV + hk * 64; float s = 0.f; for (int d = 0; d < 64; ++d) s += q[d] * k[d]; s *= 0.125f;
        const float p = expf(s - mx); den += p;
#pragma unroll
        for (int d = 0; d < 64; ++d) o[d] += p * v[d]; }
#pragma unroll
    for (int d = 0; d < 64; ++d) oattn[(size_t)m * 1024 + hq * 64 + d] = o[d] / den;
}
__global__ void kv_out(const float* z, const float* ck, const float* cv, float* kp, float* vp, float* ks, float* vs) {
    const int i = blockIdx.x * blockDim.x + threadIdx.x;
    if (i < NB * 128 * 256) { const int b = i / (128 * 256), j = (i / 256) % 128, c = i % 256; const size_t m = (size_t)b * SEQ + SEQ - 128 + j; kp[i] = z[m * INW + OK_ + c]; vp[i] = z[m * INW + OV + c]; }
    if (i < NS * 128 * 256) { const int s_ = i / (128 * 256), j = (i / 256) % 128, c = i % 256;
        if (j < 127) { ks[i] = ck[i + 256]; vs[i] = cv[i + 256]; } else { ks[i] = z[(size_t)(MP + s_) * INW + OK_ + c]; vs[i] = z[(size_t)(MP + s_) * INW + OV + c]; } }
}
__global__ void pool_d(const float* z, const float* spool, float* dbuf) {
    const int i = blockIdx.x * blockDim.x + threadIdx.x; if (i >= M * 512) return;
    const int m = i / 512, c = i % 512, gi = c / 128, w = 2 << gi; float sum = 0.f; float cnt;
    if (m < MP) { const int t = m % SEQ; for (int j = 0; j < w; ++j) if (t - j >= 0) sum += z[(size_t)(m - j) * INW + OU + c]; cnt = (float)(t + 1 < w ? t + 1 : w); }
    else { const int s_ = m - MP; sum = z[(size_t)m * INW + OU + c]; for (int j = 1; j < w; ++j) sum += spool[((size_t)s_ * 15 + 15 - j) * 512 + c]; cnt = (float)w; }
    dbuf[i] = sum / cnt - z[(size_t)m * INW + OU + c];
}
__global__ void pool_z(const float* dbuf, const float* pw, const float* pscale, float* zpool) {
    const int i = blockIdx.x * blockDim.x + threadIdx.x; if (i >= M * 512) return;
    const int m = i / 512, c = i % 512, gi = c / 128, e = c % 128; float s = 0.f;
    for (int k = 0; k < 128; ++k) s += dbuf[(size_t)m * 512 + gi * 128 + k] * pw[(gi * 128 + k) * 128 + e];
    zpool[i] = s * pscale[c];
}
__global__ void pool_out(const float* z, const float* spool, float* pp, float* ps) {
    const int i = blockIdx.x * blockDim.x + threadIdx.x;
    if (i < NB * 15 * 512) { const int b = i / (15 * 512), j = (i / 512) % 15, c = i % 512; pp[i] = z[((size_t)b * SEQ + SEQ - 15 + j) * INW + OU + c]; }
    if (i < NS * 15 * 512) { const int s_ = i / (15 * 512), j = (i / 512) % 15, c = i % 512; ps[i] = j < 14 ? spool[i + 512] : z[(size_t)(MP + s_) * INW + OU + c]; }
}
__global__ void rwkv_xm(const float* z, const float* sshift, const float* mu, float* xm) {
    const int i = blockIdx.x * blockDim.x + threadIdx.x; if (i >= M * RP) return;
    const int m = i / RP, c = i % RP; const float p = z[(size_t)m * INW + OPR + c]; float pv;
    if (m < MP) pv = (m % SEQ) ? z[(size_t)(m - 1) * INW + OPR + c] : 0.f; else pv = sshift[(size_t)(m - MP) * RP + c];
    xm[i] = p + (pv - p) * mu[c];
}
__global__ void shift_out(const float* z, float* sp, float* ss) {
    const int i = blockIdx.x * blockDim.x + threadIdx.x;
    if (i < NB * RP) { const int b = i / RP, c = i % RP; sp[i] = z[((size_t)b * SEQ + SEQ - 1) * INW + OPR + c]; }
    if (i < NS * RP) { const int s_ = i / RP, c = i % RP; ss[i] = z[(size_t)(MP + s_) * INW + OPR + c]; }
}
__global__ void __launch_bounds__(64) rwkv_prep(const float* xm, const float* w0, const float* w2, const float* a0, const float* a2, const float* g2, const float* k_k, const float* k_a,
                                                 const float* T2, const float* vb, float* vfirst, int has_vres,
                                                 float* R, float* W, float* Kk, float* V, float* A, float* Bb, float* G) {
    const int m = blockIdx.x / 8, h = blockIdx.x % 8, c = h * 64 + threadIdx.x; const float* x = xm + (size_t)m * RP;
    float s = w0[c]; for (int k = 0; k < 96; ++k) s += tanhf(x[1536 + k]) * w2[k * 512 + c];
    const float z_ = -s; const float sp = z_ > 20.f ? z_ : log1pf(expf(z_)); const float wlog = -sp - 0.5f; const float decay = expf(-expf(wlog));
    float sa = a0[c]; for (int k = 0; k < 96; ++k) sa += x[1632 + k] * a2[k * 512 + c]; const float a = sigm(sa);
    float g = 0.f; for (int k = 0; k < 256; ++k) g += sigm(x[1728 + k]) * g2[k * 512 + c];
    float v = x[1024 + c];
    if (!has_vres) vfirst[(size_t)m * 512 + c] = v;
    else { const float acc = vb[c] + T2[(size_t)m * 512 + c]; v = v + (vfirst[(size_t)m * 512 + c] - v) * sigm(acc); }
    const float r = x[c], k = x[512 + c]; float kk = k * k_k[c];
    __shared__ float red[64]; red[threadIdx.x] = kk * kk; __syncthreads();
    for (int o = 32; o > 0; o >>= 1) { if (threadIdx.x < o) red[threadIdx.x] += red[threadIdx.x + o]; __syncthreads(); }
    kk = kk / fmaxf(sqrtf(red[0]), 1e-12f); const float k2 = k * (1.f + (a - 1.f) * k_a[c]);
    const size_t o = (size_t)m * 512 + c; R[o] = r; W[o] = decay; Kk[o] = k2; V[o] = v; A[o] = -kk; Bb[o] = kk * a; G[o] = g;
}
__global__ void __launch_bounds__(64) rwkv_scan(const float* R, const float* W, const float* Kk, const float* V, const float* A, const float* Bb, const float* S0, float* Sout, float* Y, int row0, int T) {
    const int seq = blockIdx.x / 8, h = blockIdx.x % 8, i = threadIdx.x; float S[64];
#pragma unroll
    for (int j = 0; j < 64; ++j) S[j] = S0 ? S0[(((size_t)seq * 8 + h) * 64 + i) * 64 + j] : 0.f;
    __shared__ float sr[16][64], sw[16][64], sk[16][64], sa[16][64], sb[16][64], sv[16][64];
    for (int t0 = 0; t0 < T; t0 += 16) { const int nt = T - t0 < 16 ? T - t0 : 16;
        __syncthreads();
        for (int tt = 0; tt < nt; ++tt) { const size_t o = ((size_t)row0 + (size_t)seq * T + t0 + tt) * 512 + h * 64 + i; sr[tt][i] = R[o]; sw[tt][i] = W[o]; sk[tt][i] = Kk[o]; sa[tt][i] = A[o]; sb[tt][i] = Bb[o]; sv[tt][i] = V[o]; }
        __syncthreads();
        for (int tt = 0; tt < nt; ++tt) { float dot = 0.f; const float v = sv[tt][i];
#pragma unroll
            for (int j = 0; j < 64; ++j) dot += S[j] * sa[tt][j];
            float y = 0.f;
#pragma unroll
            for (int j = 0; j < 64; ++j) { S[j] = S[j] * sw[tt][j] + dot * sb[tt][j] + v * sk[tt][j]; y += S[j] * sr[tt][j]; }
            Y[((size_t)row0 + (size_t)seq * T + t0 + tt) * 512 + h * 64 + i] = y; } }
#pragma unroll
    for (int j = 0; j < 64; ++j) Sout[(((size_t)seq * 8 + h) * 64 + i) * 64 + j] = S[j];
}
__global__ void __launch_bounds__(64) rwkv_post(const float* Y, const float* R, const float* Kk, const float* V, const float* G, const float* r_k, const float* lg, const float* lb, float* yout) {
    const int m = blockIdx.x / 8, h = blockIdx.x % 8, i = threadIdx.x, c = h * 64 + i; const size_t o = (size_t)m * 512 + c;
    __shared__ float red[64]; const float y = Y[o];
    red[i] = y; __syncthreads(); for (int s = 32; s > 0; s >>= 1) { if (i < s) red[i] += red[i + s]; __syncthreads(); } const float mu = red[0] / 64.f; __syncthreads();
    red[i] = (y - mu) * (y - mu); __syncthreads(); for (int s = 32; s > 0; s >>= 1) { if (i < s) red[i] += red[i + s]; __syncthreads(); } const float var = red[0] / 64.f; __syncthreads();
    red[i] = R[o] * Kk[o] * r_k[c]; __syncthreads(); for (int s = 32; s > 0; s >>= 1) { if (i < s) red[i] += red[i + s]; __syncthreads(); } const float bon = red[0];
    yout[o] = ((y - mu) * rsqrtf(var + 64e-5f) * lg[c] + lb[c] + bon * V[o]) * G[o];
}
__global__ void merge_acc(const float* z, const float* P, int goff, float* merged, int first) {
    const int i = blockIdx.x * blockDim.x + threadIdx.x; if (i >= M * D) return; const int m = i / D, n = i % D;
    const float v = sigm(z[(size_t)m * INW + OGL + goff + n]) * P[i]; merged[i] = first ? v : merged[i] + v;
}
__global__ void resid(const float* xa, const float* xb, const float* P, const float* mod, int gt_off, float* xout) {
    const int i = blockIdx.x * blockDim.x + threadIdx.x; if (i >= M * D) return; const int m = i / D, n = i % D;
    const float x = m < MP ? xa[i] : xb[(size_t)(m - MP) * D + n]; xout[i] = x + (1.f + mod[(size_t)modrow(m) * 6 * D + gt_off + n]) * P[i];
}
__global__ void swiglu(const float* gbuf, const float* ubuf, float* act, int n) { const int i = blockIdx.x * blockDim.x + threadIdx.x; if (i < n) act[i] = silu(gbuf[i]) * ubuf[i]; }

struct In { const float* p[39]; };
inline void G(hipStream_t st, const float* A, int lda, const float* B, int ldb, float* C, int ldc, int Mm, int N, int K) { gemm<<<dim3((N + 63) / 64, (Mm + 63) / 64), 256, 0, st>>>(A, lda, B, ldb, C, ldc, Mm, N, K); }
#define EW(n) ((int)(((size_t)(n) + 255) / 256)), 256, 0, st

struct WS { float *silc, *mod, *h, *z, *xm, *R, *W, *K, *V, *A, *B, *G, *Y, *vfirst, *dbuf, *cat_a, *cat_p, *cat_r, *P, *merged, *x1, *xres, *fg, *fu, *T1; };
inline size_t carve(float* base, WS& w) {
    size_t o = 0; auto take = [&](size_t n) { float* p = base + o; o += (n + 63) & ~(size_t)63; return p; };
    w.silc = take((size_t)NMOD * D); w.mod = take((size_t)NL * NMOD * 6 * D); w.T1 = take((size_t)M * 32);
    w.h = take((size_t)M * D); w.P = w.h;
    w.xm = take((size_t)M * D); w.x1 = w.xm;
    w.cat_a = take((size_t)M * 1024); w.cat_p = take((size_t)M * 512); w.cat_r = take((size_t)M * 512); w.xres = take((size_t)M * D);
    w.z = take((size_t)M * INW);
    w.R = take((size_t)M * 512); w.W = take((size_t)M * 512); w.K = take((size_t)M * 512); w.V = take((size_t)M * 512); w.A = take((size_t)M * 512); w.B = take((size_t)M * 512); w.G = take((size_t)M * 512);
    w.Y = take((size_t)M * 512); w.vfirst = take((size_t)M * 512); w.dbuf = take((size_t)M * 512);
    w.merged = w.R;
    w.fg = w.z; w.fu = w.z + (size_t)M * DFF;
    return o;
}
constexpr size_t O_YP = 0, O_YS = O_YP + (size_t)MP * D, O_KP = O_YS + (size_t)NS * D, O_VP = O_KP + (size_t)NL * NB * 128 * 256, O_PP = O_VP + (size_t)NL * NB * 128 * 256,
                 O_SP = O_PP + (size_t)NL * NB * 15 * 512, O_WP = O_SP + (size_t)NL * NB * RP, O_KS = O_WP + (size_t)NL * NB * 8 * 4096, O_VS = O_KS + (size_t)NL * NS * 128 * 256,
                 O_PS = O_VS + (size_t)NL * NS * 128 * 256, O_SS = O_PS + (size_t)NL * NS * 15 * 512, O_WS = O_SS + (size_t)NL * NS * RP, O_END = O_WS + (size_t)NL * NS * 8 * 4096;

inline void forward(const In& in, float* out, float* wsf, hipStream_t st, const dbg::Ctx* dc = nullptr) {
    using namespace dbg;
    WS w; carve(wsf, w);
    const float *xp = in.p[0], *xs = in.p[1];
    silu_c<<<EW(NMOD * D)>>>(in.p[2], in.p[3], w.silc);
    for (int l = 0; l < NL; ++l) { G(st, w.silc, D, in.p[9] + (size_t)l * D * 6 * D, 6 * D, w.mod + (size_t)l * NMOD * 6 * D, 6 * D, NMOD, 6 * D, D);
        add_bias<<<EW(NMOD * 6 * D)>>>(w.mod + (size_t)l * NMOD * 6 * D, in.p[10] + (size_t)l * 6 * D, NMOD * 6 * D, 6 * D); }
    cmp(dc, st, T_MOD, w.mod, 6 * D, 0, NL * NMOD, 6 * D);
    const float* xa = xp; const float* xb = xs;
    for (int l = 0; l < NL; ++l) {
        const float* mod = w.mod + (size_t)l * NMOD * 6 * D; const int tb = T_L0 + l * T_PER_L;
        modnorm<<<M, 256, 0, st>>>(xa, xb, in.p[11] + l * D, mod, 0, D, w.h, (size_t)MP * D);
        cmp(dc, st, tb + T_H1, w.h, D, 0, M, D);
        G(st, w.h, D, in.p[13] + (size_t)l * D * INW, INW, w.z, INW, M, INW, D);
        rope<<<EW(M * 640)>>>(w.z);
        cmp(dc, st, tb + T_Q, w.z, INW, OQ, M, 1024); cmp(dc, st, tb + T_K, w.z, INW, OK_, M, 256); cmp(dc, st, tb + T_V, w.z, INW, OV, M, 256); cmp(dc, st, tb + T_U, w.z, INW, OU, M, 512);
        cmp(dc, st, tb + T_PR, w.z, INW, OPR, M, RP); cmp(dc, st, tb + T_GT, w.z, INW, OGL, M, 6144, 1);
        const float* ck = in.p[4] + (size_t)l * NS * 128 * 256; const float* cv = in.p[5] + (size_t)l * NS * 128 * 256;
        attn_prompt<<<(MP * 16 + 63) / 64, 64, 0, st>>>(w.z, in.p[14] + l * 16, w.cat_a);
        attn_sample<<<(NS * 16 + 63) / 64, 64, 0, st>>>(w.z, in.p[14] + l * 16, ck, cv, w.cat_a);
        kv_out<<<EW(NS * 128 * 256)>>>(w.z, ck, cv, out + O_KP + (size_t)l * NB * 128 * 256, out + O_VP + (size_t)l * NB * 128 * 256, out + O_KS + (size_t)l * NS * 128 * 256, out + O_VS + (size_t)l * NS * 128 * 256);
        const float* sp = in.p[6] + (size_t)l * NS * 15 * 512;
        pool_d<<<EW(M * 512)>>>(w.z, sp, w.dbuf);
        pool_z<<<EW(M * 512)>>>(w.dbuf, in.p[16] + (size_t)l * 4 * 128 * 128, in.p[17] + l * 512, w.cat_p);
        pool_out<<<EW(NS * 15 * 512)>>>(w.z, sp, out + O_PP + (size_t)l * NB * 15 * 512, out + O_PS + (size_t)l * NS * 15 * 512);
        rwkv_xm<<<EW((size_t)M * RP)>>>(w.z, in.p[7] + (size_t)l * NS * RP, in.p[19] + l * RP, w.xm);
        shift_out<<<EW(NS * RP)>>>(w.z, out + O_SP + (size_t)l * NB * RP, out + O_SS + (size_t)l * NS * RP);
        if (l > 0) { G(st, w.xm + 1024, RP, in.p[31], 32, w.T1, 32, M, 32, 512); G(st, w.T1, 32, in.p[32], 512, w.dbuf, 512, M, 512, 32); }
        if (l > 0) { cmp(dc, st, 59, w.dbuf, 512, 0, M, 512); cmp(dc, st, 60, w.T1, 32, 0, M, 32); }
        rwkv_prep<<<M * 8, 64, 0, st>>>(w.xm, in.p[20] + l * 512, in.p[21] + (size_t)l * 96 * 512, in.p[22] + l * 512, in.p[23] + (size_t)l * 96 * 512, in.p[24] + (size_t)l * 256 * 512, in.p[25] + l * 512, in.p[26] + l * 512,
                                         w.dbuf, in.p[33], w.vfirst, l > 0, w.R, w.W, w.K, w.V, w.A, w.B, w.G);
        cmp(dc, st, tb + T_OA, w.cat_a, 1024, 0, M, 1024); cmp(dc, st, tb + T_ZP, w.cat_p, 512, 0, M, 512);
        cmp(dc, st, tb + T_R, w.R, 512, 0, M, 512); cmp(dc, st, tb + T_W, w.W, 512, 0, M, 512); cmp(dc, st, tb + T_KK, w.K, 512, 0, M, 512); cmp(dc, st, tb + T_VV, w.V, 512, 0, M, 512);
        cmp(dc, st, tb + T_A, w.A, 512, 0, M, 512); cmp(dc, st, tb + T_B, w.B, 512, 0, M, 512); cmp(dc, st, tb + T_G, w.G, 512, 0, M, 512);
        rwkv_scan<<<NB * 8, 64, 0, st>>>(w.R, w.W, w.K, w.V, w.A, w.B, nullptr, out + O_WP + (size_t)l * NB * 8 * 4096, w.Y, 0, SEQ);
        rwkv_scan<<<NS * 8, 64, 0, st>>>(w.R, w.W, w.K, w.V, w.A, w.B, in.p[8] + (size_t)l * NS * 8 * 4096, out + O_WS + (size_t)l * NS * 8 * 4096, w.Y, MP, 1);
        cmp(dc, st, tb + T_Y, w.Y, 512, 0, M, 512);
        rwkv_post<<<M * 8, 64, 0, st>>>(w.Y, w.R, w.K, w.V, w.G, in.p[27] + l * 512, in.p[28] + l * 512, in.p[29] + l * 512, w.cat_r);
        cmp(dc, st, tb + T_YR, w.cat_r, 512, 0, M, 512);
        G(st, w.cat_a, 1024, in.p[15] + (size_t)l * 1024 * D, D, w.P, D, M, D, 1024); merge_acc<<<EW((size_t)M * D)>>>(w.z, w.P, 0, w.merged, 1);
        G(st, w.cat_p, 512, in.p[18] + (size_t)l * 512 * D, D, w.P, D, M, D, 512);   merge_acc<<<EW((size_t)M * D)>>>(w.z, w.P, D, w.merged, 0);
        G(st, w.cat_r, 512, in.p[30] + (size_t)l * 512 * D, D, w.P, D, M, D, 512);   merge_acc<<<EW((size_t)M * D)>>>(w.z, w.P, 2 * D, w.merged, 0);
        cmp(dc, st, tb + T_MG, w.merged, D, 0, M, D);
        G(st, w.merged, D, in.p[34] + (size_t)l * D * D, D, w.P, D, M, D, D);
        resid<<<EW((size_t)M * D)>>>(xa, xb, w.P, mod, 2 * D, w.x1);
        cmp(dc, st, tb + T_X1, w.x1, D, 0, M, D);
        modnorm<<<M, 256, 0, st>>>(w.x1, w.x1 + (size_t)MP * D, in.p[12] + l * D, mod, 3 * D, 4 * D, w.h, (size_t)MP * D);
        cmp(dc, st, tb + T_H2, w.h, D, 0, M, D);
        G(st, w.h, D, in.p[35] + (size_t)l * D * DFF, DFF, w.fg, DFF, M, DFF, D);
        G(st, w.h, D, in.p[36] + (size_t)l * D * DFF, DFF, w.fu, DFF, M, DFF, D);
        swiglu<<<EW((size_t)M * DFF)>>>(w.fg, w.fu, w.fg, M * DFF);
        cmp(dc, st, tb + T_ACT, w.fg, DFF, 0, M, DFF);
        G(st, w.fg, DFF, in.p[37] + (size_t)l * DFF * D, D, w.P, D, M, D, DFF);
        resid<<<EW((size_t)M * D)>>>(w.x1, w.x1 + (size_t)MP * D, w.P, mod, 5 * D, w.xres);
        cmp(dc, st, tb + T_X2, w.xres, D, 0, M, D);
        xa = w.xres; xb = w.xres + (size_t)MP * D;
    }
    modnorm<<<M, 256, 0, st>>>(xa, xb, in.p[38], nullptr, 0, 0, out + O_YP, (size_t)MP * D);
}
#undef EW
}
namespace mk {
#define LAS __attribute__((address_space(3)))
#define GAS __attribute__((address_space(1)))
typedef unsigned short bf16;
typedef short bf16x8 __attribute__((ext_vector_type(8)));
typedef float f32x4 __attribute__((ext_vector_type(4)));
typedef float f32x2 __attribute__((ext_vector_type(2)));
typedef unsigned u32x4 __attribute__((ext_vector_type(4)));
typedef unsigned u32x2 __attribute__((ext_vector_type(2)));

constexpr int D = 2048, SEQ = 4096, NB = 2, MP = NB * SEQ, NS = 128, M = MP + NS, MPAD = 8448, NL = 2, NMOD = NB + NS;
constexpr int NIN = 10240, NGU = 11264, DFF = 5632, NADA = 6 * D, RP = 1984, PASTLEN = 8192;
constexpr int NWAVES = 8, NTHR = 512;

constexpr size_t al(size_t x) { return (x + 255) & ~(size_t)255; }
constexpr size_t WL_IN = 0, WL_CAT = WL_IN + al((size_t)NIN * D * 2), WL_O = WL_CAT + al((size_t)D * D * 2), WL_GU = WL_O + al((size_t)D * D * 2), WL_DN = WL_GU + al((size_t)NGU * D * 2),
                 WL_W2 = WL_DN + al((size_t)D * DFF * 2), WL_A2 = WL_W2 + al(512 * 96 * 2), WL_G2 = WL_A2 + al(512 * 96 * 2), WL_V1 = WL_G2 + al(512 * 256 * 2), WL_V2 = WL_V1 + al(32 * 512 * 2),
                 WL_PW = WL_V2 + al(512 * 32 * 2), WL_SIZE = WL_PW + al(4 * 128 * 128 * 2);
constexpr size_t WS_W = 0;
constexpr size_t WS_ROPE = WS_W + 2 * WL_SIZE;
constexpr size_t WS_SILC = WS_ROPE + al((size_t)4097 * 64 * 4);
constexpr size_t WS_MOD = WS_SILC + al((size_t)256 * D * 2);
constexpr size_t WS_X = WS_MOD + al((size_t)NL * NMOD * NADA * 4);
constexpr size_t WS_H = WS_X + al((size_t)MPAD * D * 4);
constexpr size_t WS_Q = WS_H + al((size_t)MPAD * D * 2);
constexpr size_t WS_K = WS_Q + al((size_t)MPAD * 1024 * 2);
constexpr size_t WS_V = WS_K + al((size_t)MPAD * 256 * 2);
constexpr size_t WS_U = WS_V + al((size_t)MPAD * 256 * 2);
constexpr size_t WS_PR = WS_U + al((size_t)MPAD * 512 * 4);
constexpr size_t WS_MG = WS_PR;
constexpr size_t WS_CAT = WS_PR + al((size_t)MPAD * D * 4);
constexpr size_t WS_RW = WS_CAT + al((size_t)MPAD * D * 2);
constexpr size_t RW_STRIDE = al((size_t)MPAD * 512 * 4);
constexpr size_t WS_GT = WS_RW + 9 * RW_STRIDE;
constexpr size_t WS_ADAW = WS_GT;
constexpr size_t WS_END = WS_GT + al((size_t)MPAD * 6144 * 2);
static_assert((size_t)2 * NADA * D * 2 <= (size_t)MPAD * 6144 * 2, "ada weights fit under the gates");

constexpr size_t O_YP = 0, O_YS = O_YP + (size_t)MP * D, O_KP = O_YS + (size_t)NS * D, O_VP = O_KP + (size_t)NL * NB * 128 * 256, O_PP = O_VP + (size_t)NL * NB * 128 * 256,
                 O_SP = O_PP + (size_t)NL * NB * 15 * 512, O_WP = O_SP + (size_t)NL * NB * RP, O_KS = O_WP + (size_t)NL * NB * 8 * 4096, O_VS = O_KS + (size_t)NL * NS * 128 * 256,
                 O_PS = O_VS + (size_t)NL * NS * 128 * 256, O_SS = O_PS + (size_t)NL * NS * 15 * 512, O_WS = O_SS + (size_t)NL * NS * RP, O_END = O_WS + (size_t)NL * NS * 8 * 4096;

__device__ __forceinline__ unsigned f2bf(float f) { unsigned u = __builtin_bit_cast(unsigned, f); return (u + 0x7fffu + ((u >> 16) & 1u)) >> 16; }
__device__ __forceinline__ unsigned pk2(float lo, float hi) { return f2bf(lo) | (f2bf(hi) << 16); }
__device__ __forceinline__ float bf2f(unsigned short b) { return __builtin_bit_cast(float, (unsigned)b << 16); }
__device__ __forceinline__ float bflo(unsigned w) { return __builtin_bit_cast(float, w << 16); }
__device__ __forceinline__ float bfhi(unsigned w) { return __builtin_bit_cast(float, w & 0xffff0000u); }
__device__ __forceinline__ float fsigm(float x) { return 1.f / (1.f + __expf(-x)); }
__device__ __forceinline__ float wave_sum(float v) {
#pragma unroll
    for (int o = 1; o < 64; o <<= 1) v += __shfl_xor(v, o);
    return v;
}
__device__ __forceinline__ int modrow(int m) { return m < MP ? (m >> 12) : NB + (m - MP); }
__device__ __forceinline__ int posidx(int m) { return m < MP ? (m & (SEQ - 1)) : 4096; }
__device__ __forceinline__ int pi_d(int p) { return 32 * ((p >> 2) & 1) + 16 * (p >> 5) + 4 * ((p >> 3) & 3) + (p & 3); }

struct Args { const float* in[39]; float* out; unsigned char* ws; int ph_lo, ph_hi; };

struct Frame {
    LAS unsigned char* lds;
    int tid, lane, wave, G, bid;
    float* out; unsigned char* ws;
};
template <int K> __device__ __forceinline__ const float* inp() { GAS const float* p; asm volatile("s_load_dwordx2 %0, %1, %2\n\ts_waitcnt lgkmcnt(0)" : "=s"(p) : "s"(__builtin_amdgcn_kernarg_segment_ptr()), "n"(K * 8) : "memory"); return (const float*)p; }
#define INP(k) inp<k>()
__device__ __forceinline__ unsigned char* wl(const Frame& F, int l, size_t off) { return F.ws + WS_W + (size_t)l * WL_SIZE + off; }
__device__ __forceinline__ float* rwbuf(const Frame& F, int i) { return (float*)(F.ws + WS_RW + (size_t)i * RW_STRIDE); }
enum { RW_R = 0, RW_W, RW_K, RW_V, RW_A, RW_B, RW_G, RW_Y, RW_VF };

struct TSrc { const float* w; long long d2; int ld; int mode; };
__device__ __forceinline__ const float* colsrc(const TSrc& s, int n) {
    if (s.mode == 0) return s.w + n;
    if (s.mode == 1) {
        if (n < 1280) { const int h = n >> 6, p = n & 63; return s.w + h * 64 + pi_d(p); }
        if (n < 4032) return s.w + n;
        if (n < 4096) return nullptr;
        return s.w + (n - 64);
    }
      { const int g8 = n >> 3, i = n & 7; return (const float*)((const char*)s.w + (i < 4 ? 0ll : s.d2)) + 4 * g8 + (i & 3); }
}
__device__ __forceinline__ void transpose_item(const TSrc& s, int K, bf16* WT, size_t ldt, int kcol0, LAS float* scr, int kb, int nb, int lane) {
    const int k0 = 64 * kb, n0 = 32 * nb, gq = lane & 7, kr = lane >> 3;
    const float* cp = colsrc(s, n0 + 4 * gq);
#pragma unroll
    for (int i = 0; i < 8; ++i) { const int kk = 8 * i + kr; const f32x4 v = cp ? *(const f32x4*)(cp + (size_t)(k0 + kk) * s.ld) : (f32x4){0.f, 0.f, 0.f, 0.f};
        LAS float* d = scr + kk * 33 + 4 * gq; d[0] = v.x; d[1] = v.y; d[2] = v.z; d[3] = v.w; }
    asm volatile("s_waitcnt lgkmcnt(0)" ::: "memory");
    const int c = lane & 7;
#pragma unroll
    for (int j = 0; j < 4; ++j) { const int n = (lane >> 3) + 8 * j; const LAS float* p = scr + (8 * c) * 33 + n;
        u32x4 o; o.x = pk2(p[0 * 33], p[1 * 33]); o.y = pk2(p[2 * 33], p[3 * 33]); o.z = pk2(p[4 * 33], p[5 * 33]); o.w = pk2(p[6 * 33], p[7 * 33]);
        *(u32x4*)(WT + (size_t)(n0 + n) * ldt + kcol0 + k0 + 8 * c) = o; }
    asm volatile("s_waitcnt lgkmcnt(0)" ::: "memory");
}
__device__ __forceinline__ void small_transpose(const float* src, int K, int N, bf16* dst, int ldt, int gt, int ngt) {
    for (int i = gt; i < N * K; i += ngt) { const int n = i / K, k = i - n * K; dst[(size_t)n * ldt + k] = (bf16)f2bf(src[(size_t)k * N + n]); }
}
__device__ __forceinline__ void p0_prologue(const Frame& F) {
    LAS float* scr = (LAS float*)(F.lds + F.wave * 16384);
    const int gw = F.bid * NWAVES + F.wave, NGW = F.G * NWAVES;
    constexpr int J_ADA = 32 * 384, J_IN = 32 * 320, J_CA = 16 * 64, J_CP = 8 * 64, J_CR = 8 * 64, J_O = 32 * 64, J_GU = 32 * 352, J_DN = 88 * 64;
    constexpr int PER_L = J_ADA + J_IN + J_CA + J_CP + J_CR + J_O + J_GU + J_DN;
    for (int it = gw; it < NL * PER_L; it += NGW) {
        const int l = it / PER_L; int r = it - l * PER_L;
        TSrc s; s.d2 = 0; s.mode = 0; bf16* WT; size_t ldt; int K, nn, kcol0 = 0;
        if (r < J_ADA) { s.w = INP(9) + (size_t)l * D * NADA; s.ld = NADA; WT = (bf16*)(F.ws + WS_ADAW) + (size_t)l * NADA * D; ldt = D; K = D; nn = 384; }
        else if ((r -= J_ADA) < J_IN) { s.w = INP(13) + (size_t)l * D * 10176; s.ld = 10176; s.mode = 1; WT = (bf16*)wl(F, l, WL_IN); ldt = D; K = D; nn = 320; }
        else if ((r -= J_IN) < J_CA) { s.w = INP(15) + (size_t)l * 1024 * D; s.ld = D; WT = (bf16*)wl(F, l, WL_CAT); ldt = D; K = 1024; nn = 64; }
        else if ((r -= J_CA) < J_CP) { s.w = INP(18) + (size_t)l * 512 * D; s.ld = D; WT = (bf16*)wl(F, l, WL_CAT); ldt = D; K = 512; nn = 64; kcol0 = 1024; }
        else if ((r -= J_CP) < J_CR) { s.w = INP(30) + (size_t)l * 512 * D; s.ld = D; WT = (bf16*)wl(F, l, WL_CAT); ldt = D; K = 512; nn = 64; kcol0 = 1536; }
        else if ((r -= J_CR) < J_O) { s.w = INP(34) + (size_t)l * D * D; s.ld = D; WT = (bf16*)wl(F, l, WL_O); ldt = D; K = D; nn = 64; }
        else if ((r -= J_O) < J_GU) { s.w = INP(35) + (size_t)l * D * DFF; s.d2 = (const char*)INP(36) - (const char*)INP(35); s.ld = DFF; s.mode = 2; WT = (bf16*)wl(F, l, WL_GU); ldt = D; K = D; nn = 352; }
        else { r -= J_GU; s.w = INP(37) + (size_t)l * DFF * D; s.ld = D; WT = (bf16*)wl(F, l, WL_DN); ldt = DFF; K = DFF; nn = 64; }
        (void)K;
        transpose_item(s, K, WT, ldt, kcol0, scr, r / nn, r % nn, F.lane);
    }
    const int gt = F.bid * NTHR + F.tid, ngt = F.G * NTHR;
    for (int l = 0; l < NL; ++l) {
        small_transpose(INP(21) + (size_t)l * 96 * 512, 96, 512, (bf16*)wl(F, l, WL_W2), 96, gt, ngt);
        small_transpose(INP(23) + (size_t)l * 96 * 512, 96, 512, (bf16*)wl(F, l, WL_A2), 96, gt, ngt);
        small_transpose(INP(24) + (size_t)l * 256 * 512, 256, 512, (bf16*)wl(F, l, WL_G2), 256, gt, ngt);
        for (int g = 0; g < 4; ++g) small_transpose(INP(16) + ((size_t)l * 4 + g) * 128 * 128, 128, 128, (bf16*)wl(F, l, WL_PW) + g * 128 * 128, 128, gt, ngt);
    }
    small_transpose(INP(31), 512, 32, (bf16*)wl(F, 1, WL_V1), 512, gt, ngt);
    small_transpose(INP(32), 32, 512, (bf16*)wl(F, 1, WL_V2), 32, gt, ngt);
    for (int i = gt; i < 256 * D; i += ngt) { const int r = i >> 11, k = i & (D - 1); float v = 0.f;
        if (r < NMOD) { const float c = r < NB ? INP(2)[r * D + k] : INP(3)[(r - NB) * D + k]; v = c / (1.f + expf(-c)); }
        ((bf16*)(F.ws + WS_SILC))[i] = (bf16)f2bf(v); }
    for (int i = gt; i < 4097 * 32; i += ngt) { const int p = i >> 5, d = i & 31; const float pos = p < 4096 ? (float)p : (float)PASTLEN;
        const float inv = powf(10000.f, -(float)d * (2.0f / 64.f)), ang = pos * inv; float* t = (float*)(F.ws + WS_ROPE) + (size_t)p * 64; t[d] = cosf(ang); t[32 + d] = sinf(ang); }
}

__device__ __forceinline__ void norm_phase(const Frame& F, int l, int which  ) {
    const int gw = F.bid * NWAVES + F.wave, NGW = F.G * NWAVES;
    const float* g = which == 0 ? INP(11) + l * D : which == 1 ? INP(12) + l * D : INP(38); const float* xp0 = INP(0); const float* xp1 = INP(1);
    for (int m = gw; m < M; m += NGW) {
        const float* xr = (which == 0 && l == 0) ? (m < MP ? xp0 + (size_t)m * D : xp1 + (size_t)(m - MP) * D) : (const float*)(F.ws + WS_X) + (size_t)m * D;
        f32x4 v[8]; float s = 0.f;
#pragma unroll
        for (int j = 0; j < 8; ++j) { v[j] = *(const f32x4*)(xr + j * 256 + F.lane * 4); s += (v[j].x * v[j].x + v[j].y * v[j].y) + (v[j].z * v[j].z + v[j].w * v[j].w); }
        const float rs = rsqrtf(wave_sum(s) * (1.f / D) + 1e-6f);
        if (which == 2) { float* o = F.out + O_YP + (size_t)m * D;
#pragma unroll
            for (int j = 0; j < 8; ++j) { const f32x4 gg = *(const f32x4*)(g + j * 256 + F.lane * 4); *(f32x4*)(o + j * 256 + F.lane * 4) = v[j] * rs * gg; } }
        else { const float* mod = (const float*)(F.ws + WS_MOD) + ((size_t)l * NMOD + modrow(m)) * NADA + (which == 0 ? 0 : 3 * D);
            bf16* o = (bf16*)(F.ws + WS_H) + (size_t)m * D;
#pragma unroll
            for (int j = 0; j < 8; ++j) { const int c = j * 256 + F.lane * 4; const f32x4 gg = *(const f32x4*)(g + c), sh = *(const f32x4*)(mod + c), sc = *(const f32x4*)(mod + D + c);
                const f32x4 y = v[j] * rs * gg * (sc + 1.f) + sh; u32x2 w; w.x = pk2(y.x, y.y); w.y = pk2(y.z, y.w); *(u32x2*)(o + c) = w; } }
    }
}
}
namespace mk {
constexpr int BM = 256, BK = 64, HALF = 128, HTB = HALF * BK * 2, STAGE_BYTES = 8 * HTB, NXCD = 8, WGM = 8;
__device__ __forceinline__ int lds_byte(int r, int c) { const int st = (r >> 4) * 2 + (c >> 5), rr = r & 15, cc = c & 31, ob = rr * 64 + cc * 2; return st * 1024 + (ob ^ (((ob >> 9) & 1) << 5)); }
__device__ __forceinline__ void stage_rc(int b, int& R, int& C) { const int st = b / 1024, sb = b % 1024, swz = sb ^ (((sb >> 9) & 1) << 5); R = (st >> 1) * 16 + swz / 64; C = (st & 1) * 32 + (swz % 64) / 2; }
__device__ __forceinline__ int perm32(int rho) { const int n = rho >> 4, i = rho & 15; return 8 * (i >> 2) + 4 * n + (i & 3); }

struct Unit { int pm, pn, seg; };
enum { G_ADA = 0, G_IN, G_MG, G_WO, G_GU, G_DN };
struct Gemm { const bf16* A; const bf16* Bt; int ld, M, N, K, mode, layer; };

struct Rect { int pm0, nM, pn0, nN; };
struct Sched {
    Rect ra, rb; int G, c, nseg;
    __device__ __forceinline__ void init(const Rect& a, const Rect& b, int G_, int c_, int nseg_) { ra = a; rb = b; G = G_; c = c_; nseg = nseg_; }
    __device__ __forceinline__ bool next(int i, Unit& u) const {
        const int ti = i / nseg, seg = i - ti * nseg, nA = ra.nM * ra.nN, nB = rb.nM * rb.nN;
        const long L = (long)ti * G + c; if (L >= nA + nB) return false;
        const bool inA = L < nA; const int pm0 = inA ? ra.pm0 : rb.pm0, nM = inA ? ra.nM : rb.nM, pn0 = inA ? ra.pn0 : rb.pn0, nN = inA ? ra.nN : rb.nN, nwg = nM * nN;
        int wgid = inA ? (int)L : (int)L - nA; { const int q = nwg / NXCD, r = nwg % NXCD, xcd = wgid % NXCD, off = wgid / NXCD; wgid = (xcd < r ? xcd * (q + 1) : r * (q + 1) + (xcd - r) * q) + off; }
        const int nig = WGM * nN, gid = wgid / nig, fm = gid * WGM, gsz = (nM - fm) < WGM ? (nM - fm) : WGM;
        u.pm = pm0 + fm + ((wgid % nig) % gsz); u.pn = pn0 + (wgid % nig) / gsz; u.seg = seg;
        return true;
    }
};

typedef __bf16 bf16x2_t __attribute__((ext_vector_type(2)));
__device__ __forceinline__ unsigned cvt_pk_bf16(float lo, float hi) { const f32x2 v = {lo, hi}; const bf16x2_t b = __builtin_convertvector(v, bf16x2_t); return __builtin_bit_cast(unsigned, b); }
__device__ __forceinline__ f32x4 sig4(f32x4 v) { f32x4 r; r.x = fsigm(v.x); r.y = fsigm(v.y); r.z = fsigm(v.z); r.w = fsigm(v.w); return r; }

struct Epi {
    const Frame* F; int mode, layer;
    __device__ __forceinline__ void operator()(const f32x4 (&acc)[2][2][4][2], const Unit& u, int wr, int wc, int fr, int fq) const {
        const Frame& Fr = *F; const int l = layer;
        int row0 = u.pm * BM + wr * 64 + fr; const int colb = u.pn * BM + wc * 32 + 8 * fq;
        asm volatile("" : "+v"(row0));
        unsigned char* ws = Fr.ws;
        if (mode == G_ADA) {
            const float* ab = INP(10);
#pragma unroll
            for (int ai = 0; ai < 2; ++ai)
#pragma unroll
                for (int m = 0; m < 4; ++m) { const int r = row0 + ai * HALF + m * 16; if (r < NMOD) {
#pragma unroll
                    for (int bj = 0; bj < 2; ++bj) { const int c = colb + bj * HALF, ll = c / NADA, j = c - ll * NADA; float* o = (float*)(ws + WS_MOD) + ((size_t)ll * NMOD + r) * NADA + j;
                        *(f32x4*)o = acc[ai][bj][m][0] + *(const f32x4*)(ab + c); *(f32x4*)(o + 4) = acc[ai][bj][m][1] + *(const f32x4*)(ab + c + 4); } } }
        } else if (mode == G_IN) {
            const int pn = u.pn;
            if (pn < 5) {
                const int wp = wc & 1; const float* rt = (const float*)(ws + WS_ROPE);
#pragma unroll
                for (int ai = 0; ai < 2; ++ai)
#pragma unroll
                    for (int m = 0; m < 4; ++m) { const int r = row0 + ai * HALF + m * 16; if (r < M) {
                        const float* tp = rt + (size_t)posidx(r) * 64 + 16 * wp + 4 * fq; const f32x4 cs = *(const f32x4*)tp, sn = *(const f32x4*)(tp + 32);
#pragma unroll
                        for (int bj = 0; bj < 2; ++bj) { const f32x4 x1 = acc[ai][bj][m][0], x2 = acc[ai][bj][m][1]; const f32x4 o1 = x1 * cs - x2 * sn, o2 = x2 * cs + x1 * sn;
                            u32x4 w; w.x = cvt_pk_bf16(o1.x, o1.y); w.y = cvt_pk_bf16(o1.z, o1.w); w.z = cvt_pk_bf16(o2.x, o2.y); w.w = cvt_pk_bf16(o2.z, o2.w);
                            const int hc = bj * HALF + wc * 32 + 8 * fq;
                            if (pn < 4) *(u32x4*)((bf16*)(ws + WS_Q) + (size_t)r * 1024 + pn * 256 + hc) = w;
                            else { *(u32x4*)((bf16*)(ws + WS_K) + (size_t)r * 256 + hc) = w;
                                const int hk = hc >> 6, d1 = 16 * wp + 4 * fq; float* ko = nullptr;
                                if (r < MP) { const int t = r & (SEQ - 1); if (t >= SEQ - 128) ko = Fr.out + O_KP + ((((size_t)l * NB + (r >> 12)) * 128 + (t - (SEQ - 128))) * 4 + hk) * 64; }
                                else ko = Fr.out + O_KS + ((((size_t)l * NS + (r - MP)) * 128 + 127) * 4 + hk) * 64;
                                if (ko) { *(f32x4*)(ko + d1) = o1; *(f32x4*)(ko + d1 + 32) = o2; } } } } }
            } else if (pn == 5) {
#pragma unroll
                for (int ai = 0; ai < 2; ++ai)
#pragma unroll
                    for (int m = 0; m < 4; ++m) { const int r = row0 + ai * HALF + m * 16; if (r < M) {
#pragma unroll
                        for (int bj = 0; bj < 2; ++bj) { const f32x4 v0 = acc[ai][bj][m][0], v1 = acc[ai][bj][m][1]; const int hc = bj * HALF + wc * 32 + 8 * fq;
                            u32x4 w; w.x = cvt_pk_bf16(v0.x, v0.y); w.y = cvt_pk_bf16(v0.z, v0.w); w.z = cvt_pk_bf16(v1.x, v1.y); w.w = cvt_pk_bf16(v1.z, v1.w);
                            *(u32x4*)((bf16*)(ws + WS_V) + (size_t)r * 256 + hc) = w;
                            float* vo = nullptr;
                            if (r < MP) { const int t = r & (SEQ - 1); if (t >= SEQ - 128) vo = Fr.out + O_VP + (((size_t)l * NB + (r >> 12)) * 128 + (t - (SEQ - 128))) * 256; }
                            else vo = Fr.out + O_VS + (((size_t)l * NS + (r - MP)) * 128 + 127) * 256;
                            if (vo) { *(f32x4*)(vo + hc) = v0; *(f32x4*)(vo + hc + 4) = v1; } } } }
            } else if (pn < 16) {
                float* base = pn < 8 ? (float*)(ws + WS_U) : (float*)(ws + WS_PR); const int ld = pn < 8 ? 512 : 2048, c0 = (pn < 8 ? (pn - 6) : (pn - 8)) * 256 + wc * 32 + 8 * fq;
#pragma unroll
                for (int ai = 0; ai < 2; ++ai)
#pragma unroll
                    for (int m = 0; m < 4; ++m) { const int r = row0 + ai * HALF + m * 16; if (r < M) {
#pragma unroll
                        for (int bj = 0; bj < 2; ++bj) { float* o = base + (size_t)r * ld + c0 + bj * HALF; *(f32x4*)o = acc[ai][bj][m][0]; *(f32x4*)(o + 4) = acc[ai][bj][m][1]; } } }
            } else {
                const int c0 = (pn - 16) * 256 + wc * 32 + 8 * fq;
#pragma unroll
                for (int ai = 0; ai < 2; ++ai)
#pragma unroll
                    for (int m = 0; m < 4; ++m) { const int r = row0 + ai * HALF + m * 16; if (r < M) {
#pragma unroll
                        for (int bj = 0; bj < 2; ++bj) { const f32x4 v0 = sig4(acc[ai][bj][m][0]), v1 = sig4(acc[ai][bj][m][1]);
                            u32x4 w; w.x = cvt_pk_bf16(v0.x, v0.y); w.y = cvt_pk_bf16(v0.z, v0.w); w.z = cvt_pk_bf16(v1.x, v1.y); w.w = cvt_pk_bf16(v1.z, v1.w);
                            *(u32x4*)((bf16*)(ws + WS_GT) + (size_t)r * 6144 + c0 + bj * HALF) = w; } } }
            }
        } else if (mode == G_MG) {
            const int c0 = u.pn * BM + wc * 32 + 8 * fq;
#pragma unroll
            for (int ai = 0; ai < 2; ++ai)
#pragma unroll
                for (int m = 0; m < 4; ++m) { const int r = row0 + ai * HALF + m * 16; if (r < M) {
#pragma unroll
                    for (int bj = 0; bj < 2; ++bj) { const int c = c0 + bj * HALF; const u32x4 gw = *(const u32x4*)((const bf16*)(ws + WS_GT) + (size_t)r * 6144 + u.seg * D + c);
                        bf16* mp = (bf16*)(ws + WS_MG) + (size_t)r * D + c; f32x4 v0 = acc[ai][bj][m][0], v1 = acc[ai][bj][m][1];
                        v0.x *= bflo(gw.x); v0.y *= bfhi(gw.x); v0.z *= bflo(gw.y); v0.w *= bfhi(gw.y); v1.x *= bflo(gw.z); v1.y *= bfhi(gw.z); v1.z *= bflo(gw.w); v1.w *= bfhi(gw.w);
                        if (u.seg > 0) { const u32x4 ow = *(const u32x4*)mp; v0.x += bflo(ow.x); v0.y += bfhi(ow.x); v0.z += bflo(ow.y); v0.w += bfhi(ow.y); v1.x += bflo(ow.z); v1.y += bfhi(ow.z); v1.z += bflo(ow.w); v1.w += bfhi(ow.w); }
                        u32x4 w; w.x = cvt_pk_bf16(v0.x, v0.y); w.y = cvt_pk_bf16(v0.z, v0.w); w.z = cvt_pk_bf16(v1.x, v1.y); w.w = cvt_pk_bf16(v1.z, v1.w); *(u32x4*)mp = w; } } }
        } else if (mode == G_WO || mode == G_DN) {
            const int c0 = u.pn * BM + wc * 32 + 8 * fq; const int goff = mode == G_WO ? 2 * D : 5 * D;
#pragma unroll
            for (int ai = 0; ai < 2; ++ai)
#pragma unroll
                for (int m = 0; m < 4; ++m) { const int r = row0 + ai * HALF + m * 16; if (r < M) {
                    const float* gp = (const float*)(ws + WS_MOD) + ((size_t)l * NMOD + modrow(r)) * NADA + goff;
                    const float* xin = (mode == G_WO && l == 0) ? (r < MP ? INP(0) + (size_t)r * D : INP(1) + (size_t)(r - MP) * D) : (const float*)(ws + WS_X) + (size_t)r * D;
                    float* xo = (float*)(ws + WS_X) + (size_t)r * D;
#pragma unroll
                    for (int bj = 0; bj < 2; ++bj) { const int c = c0 + bj * HALF;
                        const f32x4 g0 = *(const f32x4*)(gp + c), g1 = *(const f32x4*)(gp + c + 4), x0 = *(const f32x4*)(xin + c), x1 = *(const f32x4*)(xin + c + 4);
                        *(f32x4*)(xo + c) = x0 + (g0 + 1.f) * acc[ai][bj][m][0]; *(f32x4*)(xo + c + 4) = x1 + (g1 + 1.f) * acc[ai][bj][m][1]; } } }
        } else {
            const int c0 = u.pn * 128 + wc * 16 + 4 * fq;
#pragma unroll
            for (int ai = 0; ai < 2; ++ai)
#pragma unroll
                for (int m = 0; m < 4; ++m) { const int r = row0 + ai * HALF + m * 16; if (r < M) {
#pragma unroll
                    for (int bj = 0; bj < 2; ++bj) { const f32x4 g = acc[ai][bj][m][0], up = acc[ai][bj][m][1]; const f32x4 a = g * sig4(g) * up;
                        u32x2 w; w.x = cvt_pk_bf16(a.x, a.y); w.y = cvt_pk_bf16(a.z, a.w); *(u32x2*)((bf16*)(ws + WS_GT) + (size_t)r * DFF + c0 + bj * 64) = w; } } }
        }
    }
};

__device__ __forceinline__ void gemm_phase(LAS unsigned char* lds, const Gemm g, const Sched& S, const Epi& E) {
    const int tid = threadIdx.x, wid = __builtin_amdgcn_readfirstlane(tid >> 6), lane = tid & 63, wr = wid >> 2, wc = wid & 3, fr = lane & 15, fq = lane >> 4;
    unsigned voffA[2], voffB[2];
#pragma unroll
    for (int i = 0; i < 2; ++i) { int R, C; stage_rc(tid * 16 + i * 8192, R, C); const int Rb = (R & ~31) + perm32(R & 31);
        voffA[i] = (unsigned)(R * g.ld + C) * 2u; voffB[i] = (unsigned)(Rb * g.ld + C) * 2u; }
    constexpr unsigned kstep = BK * 2;
    const unsigned hstep = (unsigned)HALF * (unsigned)g.ld * 2u; const bool segd = g.mode == G_MG; const int ntfull = g.K / BK;
#define PG8_KA(u) (segd ? ((u).seg == 0 ? 0u : (u).seg == 1 ? 1024u : 1536u) : 0u)
#define PG8_NT(u) (segd ? ((u).seg == 0 ? 16 : 8) : ntfull)
#define PG8_TILE(p, u) (((unsigned)(p) * (unsigned)BM * (unsigned)g.ld + PG8_KA(u)) * 2u)
    const unsigned ldsw = (unsigned)wid * 1024u;
    const int aoff = lds_byte(wr * 64 + fr, fq * 8), boff = lds_byte(wc * 32 + fr, fq * 8);
#define PG8_SA(b, h) (((b) * 2 + (h)) * HTB)
#define PG8_SB(b, h) ((4 + (b) * 2 + (h)) * HTB)
#define PG8_STAGE(bufoff, gbase, soff, voff) do { _Pragma("unroll") for (int _i = 0; _i < 2; ++_i) \
        __builtin_amdgcn_global_load_lds((const unsigned*)((const char*)(gbase) + (size_t)((voff)[_i] + (unsigned)(soff))), (LAS unsigned*)(lds + (bufoff) + ldsw + _i * 8192), 16, 0, 0); } while (0)
#define PG8_STA(bufoff, soff) PG8_STAGE(bufoff, g.A, soff, voffA)
#define PG8_STB(bufoff, soff) PG8_STAGE(bufoff, g.Bt, soff, voffB)
#define PG8_LDA(dst, b, h) do { _Pragma("unroll") for (int m = 0; m < 4; ++m) _Pragma("unroll") for (int k = 0; k < 2; ++k) dst[m][k] = *(const LAS bf16x8*)(lds + PG8_SA(b, h) + aoff + m * 2048 + k * 1024); } while (0)
#define PG8_LDB(dst, b, h) do { _Pragma("unroll") for (int n = 0; n < 2; ++n) _Pragma("unroll") for (int k = 0; k < 2; ++k) dst[n][k] = *(const LAS bf16x8*)(lds + PG8_SB(b, h) + boff + n * 2048 + k * 1024); } while (0)
#define PG8_MMA(ai, bj, At, Bt) do { __builtin_amdgcn_s_setprio(1); _Pragma("unroll") for (int m = 0; m < 4; ++m) _Pragma("unroll") for (int n = 0; n < 2; ++n) _Pragma("unroll") for (int k = 0; k < 2; ++k) \
        acc[ai][bj][m][n] = __builtin_amdgcn_mfma_f32_16x16x32_bf16(Bt[n][k], At[m][k], acc[ai][bj][m][n], 0, 0, 0); __builtin_amdgcn_s_setprio(0); } while (0)
#define PG8_WAIT_V(n) asm volatile("s_waitcnt vmcnt(" #n ")" ::: "memory")
#define PG8_WAIT_L(n) asm volatile("s_waitcnt lgkmcnt(" #n ")" ::: "memory")
#define PG8_BAR __builtin_amdgcn_s_barrier()
#define PG8_SCHED __builtin_amdgcn_sched_barrier(0)
    Unit cur, nxt; int ui = 0;
    if (!S.next(0, cur)) return;
    f32x4 acc[2][2][4][2];
#pragma unroll
    for (int a = 0; a < 2; ++a)
#pragma unroll
        for (int b = 0; b < 2; ++b)
#pragma unroll
            for (int m = 0; m < 4; ++m)
#pragma unroll
                for (int n = 0; n < 2; ++n) acc[a][b][m][n] = (f32x4){0.f, 0.f, 0.f, 0.f};
    bf16x8 At[4][2], B0[2][2], B1[2][2];
    unsigned cA = PG8_TILE(cur.pm, cur), cB = PG8_TILE(cur.pn, cur);
    PG8_STB(PG8_SB(0, 0), cB); PG8_STB(PG8_SB(0, 1), cB + hstep); PG8_STA(PG8_SA(0, 0), cA); PG8_STA(PG8_SA(0, 1), cA + hstep);
    if (wr == 1) PG8_BAR;
    PG8_WAIT_V(2); PG8_BAR;
    PG8_STB(PG8_SB(1, 0), cB + kstep); PG8_STA(PG8_SA(1, 0), cA + kstep); PG8_STB(PG8_SB(1, 1), cB + hstep + kstep);
    PG8_WAIT_V(6); PG8_BAR;
    for (;;) {
        const bool has_next = S.next(ui + 1, nxt);
        const unsigned nA = has_next ? PG8_TILE(nxt.pm, nxt) : cA, nB = has_next ? PG8_TILE(nxt.pn, nxt) : cB;
        const int nt = PG8_NT(cur);
        for (int t = 0; t < nt; t += 2) {
            const bool last = (t == nt - 2);
            const unsigned a1 = cA + (unsigned)(t + 1) * kstep;
            const unsigned a2 = last ? nA : cA + (unsigned)(t + 2) * kstep, b2 = last ? nB : cB + (unsigned)(t + 2) * kstep;
            const unsigned a3 = a2 + kstep, b3 = b2 + kstep;
            PG8_LDB(B0, 0, 0); PG8_LDB(B1, 0, 1); PG8_SCHED; PG8_LDA(At, 0, 0); PG8_STA(PG8_SA(1, 1), a1 + hstep);
            PG8_WAIT_V(8); PG8_WAIT_L(0); PG8_BAR; PG8_MMA(0, 0, At, B0); PG8_MMA(0, 1, At, B1); PG8_BAR; PG8_SCHED;
            PG8_LDA(At, 0, 1); PG8_STB(PG8_SB(0, 0), b2); PG8_STB(PG8_SB(0, 1), b2 + hstep); PG8_STA(PG8_SA(0, 0), a2);
            PG8_WAIT_V(8); PG8_WAIT_L(0); PG8_BAR; PG8_MMA(1, 0, At, B0); PG8_MMA(1, 1, At, B1); PG8_BAR; PG8_SCHED;
            PG8_LDB(B0, 1, 0); PG8_LDB(B1, 1, 1); PG8_SCHED; PG8_LDA(At, 1, 0); PG8_STA(PG8_SA(0, 1), a2 + hstep);
            PG8_WAIT_V(8); PG8_WAIT_L(0); PG8_BAR; PG8_MMA(0, 0, At, B0); PG8_MMA(0, 1, At, B1); PG8_BAR; PG8_SCHED;
            PG8_LDA(At, 1, 1); PG8_STB(PG8_SB(1, 0), b3); PG8_STB(PG8_SB(1, 1), b3 + hstep); PG8_STA(PG8_SA(1, 0), a3);
            PG8_WAIT_V(8); PG8_WAIT_L(0); PG8_BAR; PG8_MMA(1, 0, At, B0); PG8_MMA(1, 1, At, B1); PG8_BAR; PG8_SCHED;
        }
        if (wr == 0) PG8_BAR;
        E(acc, cur, wr, wc, fr, fq);
        if (!has_next) break;
#pragma unroll
        for (int a = 0; a < 2; ++a)
#pragma unroll
            for (int b = 0; b < 2; ++b)
#pragma unroll
                for (int m = 0; m < 4; ++m)
#pragma unroll
                    for (int n = 0; n < 2; ++n) acc[a][b][m][n] = (f32x4){0.f, 0.f, 0.f, 0.f};
        cur = nxt; cA = nA; cB = nB; ++ui;
        if (wr == 1) PG8_BAR;
    }
    PG8_WAIT_V(0);
    PG8_BAR;
#undef PG8_KA
#undef PG8_NT
#undef PG8_TILE
#undef PG8_STA
#undef PG8_STB
#undef PG8_SA
#undef PG8_SB
#undef PG8_STAGE
#undef PG8_LDA
#undef PG8_LDB
#undef PG8_MMA
#undef PG8_WAIT_V
#undef PG8_WAIT_L
#undef PG8_BAR
#undef PG8_SCHED
}
}
namespace mk {
#define MFMA16(a, b, c) __builtin_amdgcn_mfma_f32_16x16x32_bf16((a), (b), (c), 0, 0, 0)
__device__ __forceinline__ bf16x8 pack8(f32x4 a, f32x4 b) { u32x4 w; w.x = cvt_pk_bf16(a.x, a.y); w.y = cvt_pk_bf16(a.z, a.w); w.z = cvt_pk_bf16(b.x, b.y); w.w = cvt_pk_bf16(b.z, b.w); return __builtin_bit_cast(bf16x8, w); }
typedef short s16x4 __attribute__((ext_vector_type(4)));
__device__ __forceinline__ bf16x8 cat44(s16x4 a, s16x4 b) { return (bf16x8){a[0], a[1], a[2], a[3], b[0], b[1], b[2], b[3]}; }
constexpr float LOG2E = 1.4426950408889634f;

constexpr int AK_STRIDE = 144, AV_STRIDE = 560;
constexpr int A_KOFF = 0, A_VOFF = 256 * AK_STRIDE, A_BYTES = A_VOFF + 64 * AV_STRIDE;
__device__ __forceinline__ void attn_prompt_unit(const Frame& F, int l, int b, int blk, int hk) {
    LAS unsigned char* Ks = F.lds + A_KOFF; LAS unsigned char* Vt = F.lds + A_VOFF;
    const bf16* Kg = (const bf16*)(F.ws + WS_K); const bf16* Vg = (const bf16*)(F.ws + WS_V); const bf16* Qg = (const bf16*)(F.ws + WS_Q);
    const int kp0 = blk * 128 - 128;
    for (int ch = F.tid; ch < 2048; ch += NTHR) { const int i = ch >> 3, dc = ch & 7, kp = kp0 + i;
        u32x4 kv = (u32x4){0u, 0u, 0u, 0u}, vv = kv;
        if (kp >= 0) { const size_t m = (size_t)b * SEQ + kp; kv = *(const u32x4*)(Kg + m * 256 + hk * 64 + dc * 8); vv = *(const u32x4*)(Vg + m * 256 + hk * 64 + dc * 8); }
        *(LAS u32x4*)(Ks + i * AK_STRIDE + dc * 16) = kv;
        LAS unsigned short* vp = (LAS unsigned short*)(Vt + (dc * 8) * AV_STRIDE) + i;
        vp[0 * (AV_STRIDE / 2)] = (unsigned short)(vv.x & 0xffff); vp[1 * (AV_STRIDE / 2)] = (unsigned short)(vv.x >> 16); vp[2 * (AV_STRIDE / 2)] = (unsigned short)(vv.y & 0xffff); vp[3 * (AV_STRIDE / 2)] = (unsigned short)(vv.y >> 16);
        vp[4 * (AV_STRIDE / 2)] = (unsigned short)(vv.z & 0xffff); vp[5 * (AV_STRIDE / 2)] = (unsigned short)(vv.z >> 16); vp[6 * (AV_STRIDE / 2)] = (unsigned short)(vv.w & 0xffff); vp[7 * (AV_STRIDE / 2)] = (unsigned short)(vv.w >> 16); }
    for (int i = F.tid; i < 64 * 24; i += NTHR) { const int d = i / 24, c = i % 24; ((LAS unsigned short*)(Vt + d * AV_STRIDE))[256 + c] = 0; }
    __syncthreads();
    const int g = F.lane >> 4, c16 = F.lane & 15;
    const float* sinkp = INP(14) + l * 16;
    for (int it = 0; it < 4; ++it) {
        const int gi = F.wave * 4 + it, hq = hk * 4 + (gi >> 3), qs = gi & 7;
        const int tqr = 16 * qs + c16;
        const size_t mq = (size_t)b * SEQ + blk * 128 + tqr;
        const bf16x8 q0 = *(const bf16x8*)(Qg + mq * 1024 + hq * 64 + 8 * g), q1 = *(const bf16x8*)(Qg + mq * 1024 + hq * 64 + 32 + 8 * g);
        f32x4 s[10];
#pragma unroll
        for (int j = 0; j < 9; ++j) { LAS const unsigned char* kr = Ks + (16 * (qs + j) + c16) * AK_STRIDE + 16 * g;
            const bf16x8 k0 = *(LAS const bf16x8*)kr, k1 = *(LAS const bf16x8*)(kr + 64);
            f32x4 a = (f32x4){0.f, 0.f, 0.f, 0.f}; a = MFMA16(k0, q0, a); a = MFMA16(k1, q1, a); s[j] = a; }
        const float sk2 = sinkp[hq] * LOG2E; float mx = sk2;
#pragma unroll
        for (int j = 0; j < 9; ++j)
#pragma unroll
            for (int r = 0; r < 4; ++r) { const int i = 16 * (qs + j) + 4 * g + r; const bool ok = (i >= tqr) && (i <= tqr + 128) && (kp0 + i >= 0);
                const float v = ok ? s[j][r] * (0.125f * LOG2E) : -1e30f; s[j][r] = v; mx = fmaxf(mx, v); }
        mx = fmaxf(mx, __shfl_xor(mx, 16)); mx = fmaxf(mx, __shfl_xor(mx, 32));
        float sum = 0.f;
#pragma unroll
        for (int j = 0; j < 9; ++j)
#pragma unroll
            for (int r = 0; r < 4; ++r) { const float p = __builtin_amdgcn_exp2f(s[j][r] - mx); s[j][r] = p; sum += p; }
        s[9] = (f32x4){0.f, 0.f, 0.f, 0.f};
        sum += __shfl_xor(sum, 16); sum += __shfl_xor(sum, 32);
        const float rl = 1.f / (sum + __builtin_amdgcn_exp2f(sk2 - mx));
        f32x4 o[4];
#pragma unroll
        for (int dt = 0; dt < 4; ++dt) o[dt] = (f32x4){0.f, 0.f, 0.f, 0.f};
#pragma unroll
        for (int kk = 0; kk < 5; ++kk) { const bf16x8 pf = pack8(s[2 * kk], s[2 * kk + 1]);
#pragma unroll
            for (int dt = 0; dt < 4; ++dt) { LAS const unsigned char* vr = Vt + (16 * dt + c16) * AV_STRIDE + (16 * (qs + 2 * kk) + 4 * g) * 2;
                const s16x4 v0 = *(LAS const s16x4*)vr, v1 = *(LAS const s16x4*)(vr + 32);
                o[dt] = MFMA16(cat44(v0, v1), pf, o[dt]); } }
        bf16* op = (bf16*)(F.ws + WS_CAT) + mq * D + hq * 64 + 4 * g;
#pragma unroll
        for (int dt = 0; dt < 4; ++dt) { const f32x4 v = o[dt] * rl; u32x2 w; w.x = cvt_pk_bf16(v.x, v.y); w.y = cvt_pk_bf16(v.z, v.w); *(u32x2*)(op + 16 * dt) = w; }
    }
    __syncthreads();
}

__device__ __forceinline__ void attn_sample_unit(const Frame& F, int l, int s_) {
    LAS float* qn = (LAS float*)F.lds;
    LAS float* kn = qn + 1024;
    LAS float* vn = kn + 256;
    LAS float* sc = vn + 256;
    LAS float* rl = sc + 16 * 132;
    const int m = MP + s_; const float* sinkp = INP(14) + l * 16;
    const float* ck = INP(4) + ((size_t)l * NS + s_) * 128 * 256; const float* cv = INP(5) + ((size_t)l * NS + s_) * 128 * 256;
    for (int i = F.tid; i < 1024; i += NTHR) { const int h = i >> 6, p = i & 63; qn[h * 64 + pi_d(p)] = bf2f(((const bf16*)(F.ws + WS_Q))[(size_t)m * 1024 + i]) * (0.125f * LOG2E); }
    if (F.tid < 256) { const int h = F.tid >> 6, p = F.tid & 63; kn[h * 64 + pi_d(p)] = bf2f(((const bf16*)(F.ws + WS_K))[(size_t)m * 256 + F.tid]); vn[F.tid] = bf2f(((const bf16*)(F.ws + WS_V))[(size_t)m * 256 + F.tid]); }
    { float* ko = F.out + O_KS + ((size_t)l * NS + s_) * 128 * 256; float* vo = F.out + O_VS + ((size_t)l * NS + s_) * 128 * 256;
      for (int i = F.tid; i < 127 * 64; i += NTHR) { *(f32x4*)(ko + 4 * i) = *(const f32x4*)(ck + 256 + 4 * i); *(f32x4*)(vo + 4 * i) = *(const f32x4*)(cv + 256 + 4 * i); } }
    __syncthreads();
    for (int idx = F.tid; idx < 16 * 129; idx += NTHR) { const int hq = idx / 129, j = idx - hq * 129, hk = hq >> 2; float a = 0.f;
        if (j < 128) { const float* kr = ck + (size_t)j * 256 + hk * 64;
#pragma unroll
            for (int d = 0; d < 64; d += 4) { const f32x4 kv = *(const f32x4*)(kr + d); a += qn[hq * 64 + d] * kv.x + qn[hq * 64 + d + 1] * kv.y + qn[hq * 64 + d + 2] * kv.z + qn[hq * 64 + d + 3] * kv.w; } }
        else { for (int d = 0; d < 64; ++d) a += qn[hq * 64 + d] * kn[hk * 64 + d]; }
        sc[hq * 132 + j] = a; }
    __syncthreads();
    for (int hh = 0; hh < 2; ++hh) { const int hq = F.wave * 2 + hh; const float sk2 = sinkp[hq] * LOG2E;
        float mx = sk2; for (int j = F.lane; j < 129; j += 64) mx = fmaxf(mx, sc[hq * 132 + j]);
#pragma unroll
        for (int o = 1; o < 64; o <<= 1) mx = fmaxf(mx, __shfl_xor(mx, o));
        float sum = 0.f; for (int j = F.lane; j < 129; j += 64) { const float p = __builtin_amdgcn_exp2f(sc[hq * 132 + j] - mx); sc[hq * 132 + j] = p; sum += p; }
        sum = wave_sum(sum); if (F.lane == 0) rl[hq] = 1.f / (sum + __builtin_amdgcn_exp2f(sk2 - mx)); }
    __syncthreads();
    for (int idx = F.tid; idx < 1024; idx += NTHR) { const int hq = idx >> 6, d = idx & 63, hk = hq >> 2; float a = 0.f;
#pragma unroll 16
        for (int j = 0; j < 128; ++j) a += sc[hq * 132 + j] * cv[(size_t)j * 256 + hk * 64 + d];
        a += sc[hq * 132 + 128] * vn[hk * 64 + d];
        ((bf16*)(F.ws + WS_CAT))[(size_t)m * D + idx] = (bf16)f2bf(a * rl[hq]); }
    __syncthreads();
}

constexpr int PL_STRIDE = 272;
__device__ __forceinline__ void pool_unit(const Frame& F, int l, int rt, int gi) {
    LAS unsigned char* dT = F.lds; LAS unsigned char* Wt = F.lds + 128 * PL_STRIDE;
    const float* U = (const float*)(F.ws + WS_U); const int w = 2 << gi, m0 = rt * 128;
    { const bf16* pw = (const bf16*)wl(F, l, WL_PW) + (size_t)gi * 128 * 128;
      for (int ch = F.tid; ch < 2048; ch += NTHR) { const int e = ch >> 4, cc = ch & 15; *(LAS u32x4*)(Wt + e * PL_STRIDE + cc * 16) = *(const u32x4*)(pw + e * 128 + cc * 8); } }
    { const int c = F.tid & 127, strip = F.tid >> 7, col = gi * 128 + c;
      if (rt < 64) { const int t0 = (m0 & (SEQ - 1)) + 32 * strip; const float* up = U + (size_t)(m0 + 32 * strip) * 512 + col;
          float uv[47];
#pragma unroll
          for (int j = 0; j < 47; ++j) { const int t = t0 - 15 + j; uv[j] = t >= 0 ? up[(ptrdiff_t)(j - 15) * 512] : 0.f; }
          LAS unsigned short* dp = (LAS unsigned short*)(dT + (32 * strip) * PL_STRIDE) + c;
#define POOL_D(W) { float sum = 0.f; _Pragma("unroll") for (int j = 1; j < W; ++j) sum += uv[15 - j]; \
              _Pragma("unroll") for (int k = 0; k < 32; ++k) { const int t = t0 + k; sum += uv[15 + k]; const float cnt = (float)(t + 1 < W ? t + 1 : W); \
                  dp[k * (PL_STRIDE / 2)] = (unsigned short)f2bf(sum / cnt - uv[15 + k]); sum -= uv[15 + k - W + 1]; } }
          if (gi == 0) POOL_D(2) else if (gi == 1) POOL_D(4) else if (gi == 2) POOL_D(8) else POOL_D(16)
#undef POOL_D
      }
      else { const float* sp = INP(6) + (size_t)l * NS * 15 * 512;
          for (int k = 0; k < 32; ++k) { const int s_ = 32 * strip + k; const float uc = U[(size_t)(MP + s_) * 512 + col]; float sum = uc;
              for (int j = 1; j < w; ++j) sum += sp[((size_t)s_ * 15 + 15 - j) * 512 + col];
              ((LAS unsigned short*)(dT + s_ * PL_STRIDE))[c] = (unsigned short)f2bf(sum / (float)w - uc); } } }
    __syncthreads();
    const int g = F.lane >> 4, c16 = F.lane & 15;
    f32x4 acc[8];
#pragma unroll
    for (int et = 0; et < 8; ++et) acc[et] = (f32x4){0.f, 0.f, 0.f, 0.f};
#pragma unroll
    for (int ks = 0; ks < 4; ++ks) { const bf16x8 df = *(LAS const bf16x8*)(dT + (16 * F.wave + c16) * PL_STRIDE + (32 * ks + 8 * g) * 2);
#pragma unroll
        for (int et = 0; et < 8; ++et) { const bf16x8 wf = *(LAS const bf16x8*)(Wt + (16 * et + c16) * PL_STRIDE + (32 * ks + 8 * g) * 2); acc[et] = MFMA16(wf, df, acc[et]); } }
    const int m = m0 + 16 * F.wave + c16; const float* psc = INP(17) + l * 512 + gi * 128;
    if (m < M) { bf16* op = (bf16*)(F.ws + WS_CAT) + (size_t)m * D + 1024 + gi * 128 + 4 * g;
#pragma unroll
        for (int et = 0; et < 8; ++et) { const f32x4 v = acc[et] * *(const f32x4*)(psc + 16 * et + 4 * g); u32x2 wv; wv.x = cvt_pk_bf16(v.x, v.y); wv.y = cvt_pk_bf16(v.z, v.w); *(u32x2*)(op + 16 * et) = wv; } }
    __syncthreads();
}
__device__ __forceinline__ void state_outs(const Frame& F, int l) {
    const int gt = F.bid * NTHR + F.tid, ngt = F.G * NTHR; const float* U = (const float*)(F.ws + WS_U); const float* PR = (const float*)(F.ws + WS_PR);
    for (int i = gt; i < NB * 15 * 512; i += ngt) { const int b = i / (15 * 512), j = (i >> 9) % 15, c = i & 511; F.out[O_PP + (size_t)l * NB * 15 * 512 + i] = U[((size_t)b * SEQ + SEQ - 15 + j) * 512 + c]; }
    const float* sp = INP(6) + (size_t)l * NS * 15 * 512;
    for (int i = gt; i < NS * 15 * 512; i += ngt) { const int s_ = i / (15 * 512), j = (i >> 9) % 15, c = i & 511; F.out[O_PS + (size_t)l * NS * 15 * 512 + i] = j < 14 ? sp[i + 512] : U[(size_t)(MP + s_) * 512 + c]; }
    for (int i = gt; i < NB * RP; i += ngt) { const int b = i / RP, c = i - b * RP; F.out[O_SP + (size_t)l * NB * RP + i] = PR[((size_t)b * SEQ + SEQ - 1) * 2048 + c]; }
    for (int i = gt; i < NS * RP; i += ngt) { const int s_ = i / RP, c = i - s_ * RP; F.out[O_SS + (size_t)l * NS * RP + i] = PR[(size_t)(MP + s_) * 2048 + c]; }
}

constexpr int RA_STRIDE = 1936;
constexpr int R_T1OFF = 32 * RA_STRIDE, RT_STRIDE = 80;
struct XmRow { const float* p; const float* pv; float pz; };
__device__ __forceinline__ XmRow xm_row(const float* PR, const float* sshift, int m) {
    XmRow r; r.p = PR + (size_t)m * 2048; const bool first = m < MP && (m & (SEQ - 1)) == 0;
    r.pv = m >= MP ? sshift + (size_t)(m - MP) * RP : first ? r.p : r.p - 2048; r.pz = first ? 0.f : 1.f; return r;
}
__device__ __forceinline__ float xm_at(const XmRow& r, const float* mu, int c) { const float p = r.p[c]; return p + (r.pv[c] * r.pz - p) * mu[c]; }
__device__ __forceinline__ f32x4 xm4_at(const XmRow& r, const float* mu, int c) { const f32x4 p = *(const f32x4*)(r.p + c); return p + (*(const f32x4*)(r.pv + c) * r.pz - p) * *(const f32x4*)(mu + c); }
template <int KS> __device__ __forceinline__ void lora_mm(f32x4 (&acc)[4], const bf16* Wt, int ldw, int nbase, LAS const unsigned char* Arow, int acol, int g, int c16) {
#pragma unroll
    for (int nt = 0; nt < 4; ++nt) acc[nt] = (f32x4){0.f, 0.f, 0.f, 0.f};
#pragma unroll
    for (int ks = 0; ks < KS; ++ks) { const bf16x8 af = *(LAS const bf16x8*)(Arow + (acol + 32 * ks + 8 * g) * 2);
#pragma unroll
        for (int nt = 0; nt < 4; ++nt) { const bf16x8 wf = *(const bf16x8*)(Wt + (size_t)(nbase + 16 * nt + c16) * ldw + 32 * ks + 8 * g); acc[nt] = MFMA16(wf, af, acc[nt]); } }
}
__device__ __forceinline__ float frcp(float x) { return __builtin_amdgcn_rcpf(x); }
__device__ __forceinline__ f32x4 fsig4(f32x4 v) { f32x4 r; r.x = frcp(1.f + __expf(-v.x)); r.y = frcp(1.f + __expf(-v.y)); r.z = frcp(1.f + __expf(-v.z)); r.w = frcp(1.f + __expf(-v.w)); return r; }
__device__ __forceinline__ void rwkv_prep_unit(const Frame& F, int l, int ti) {
    LAS unsigned char* Aop = F.lds; LAS unsigned char* T1 = F.lds + R_T1OFF;
    const float* PR = (const float*)(F.ws + WS_PR); const float* sshift = INP(7) + (size_t)l * NS * RP; const float* mu = INP(19) + l * RP;
    const int m0 = ti * 32; const bool vres = l > 0;
    const float* a0p = INP(22) + l * 512; const float* w0p = INP(20) + l * 512; const float* vbp = INP(33); const float* kkp = INP(25) + l * 512; const float* kap = INP(26) + l * 512;
    for (int i = F.tid; i < 32 * 448; i += NTHR) { const int r = i / 448, c = i - r * 448; const XmRow xr = xm_row(PR, sshift, m0 + r); const float x = xm_at(xr, mu, 1536 + c);
        const float y = c < 96 ? 1.f - 2.f / (1.f + __expf(2.f * x)) : c < 192 ? x : fsigm(x); ((LAS unsigned short*)(Aop + r * RA_STRIDE))[c] = (unsigned short)f2bf(y); }
    if (vres) for (int i = F.tid; i < 32 * 512; i += NTHR) { const int r = i >> 9, c = i & 511; const XmRow xr = xm_row(PR, sshift, m0 + r); ((LAS unsigned short*)(Aop + r * RA_STRIDE))[448 + c] = (unsigned short)f2bf(xm_at(xr, mu, 1024 + c)); }
    __syncthreads();
    const int g = F.lane >> 4, c16 = F.lane & 15, nb = 64 * F.wave;
    if (vres) {
        if (F.wave < 4) { const int mt = F.wave >> 1, nt = F.wave & 1; f32x4 a = (f32x4){0.f, 0.f, 0.f, 0.f}; const bf16* w1 = (const bf16*)wl(F, 1, WL_V1);
#pragma unroll 2
            for (int ks = 0; ks < 16; ++ks) { const bf16x8 af = *(LAS const bf16x8*)(Aop + (16 * mt + c16) * RA_STRIDE + (448 + 32 * ks + 8 * g) * 2);
                const bf16x8 wf = *(const bf16x8*)(w1 + (size_t)(16 * nt + c16) * 512 + 32 * ks + 8 * g); a = MFMA16(wf, af, a); }
            u32x2 wv; wv.x = cvt_pk_bf16(a.x, a.y); wv.y = cvt_pk_bf16(a.z, a.w); *(LAS u32x2*)(T1 + (16 * mt + c16) * RT_STRIDE + (16 * nt + 4 * g) * 2) = wv;
#if MK_DEBUG
            *(f32x4*)((float*)(F.ws + WS_H) + (size_t)(m0 + 16 * mt + c16) * 32 + 16 * nt + 4 * g) = a;
#endif
            }
        __syncthreads();
    }
    float* Rb = rwbuf(F, RW_R); float* Wb = rwbuf(F, RW_W); float* Kb = rwbuf(F, RW_K); float* Vb = rwbuf(F, RW_V); float* Ab = rwbuf(F, RW_A); float* Bb = rwbuf(F, RW_B); float* Gb = rwbuf(F, RW_G); float* VF = rwbuf(F, RW_VF);
#pragma unroll 1
    for (int mt = 0; mt < 2; ++mt) {
        f32x4 acc[4], av[4]; LAS const unsigned char* Arow = Aop + (16 * mt + c16) * RA_STRIDE;
        int m = m0 + 16 * mt + c16; asm volatile("" : "+v"(m)); const size_t ro = (size_t)m * 512 + nb + 4 * g;
        lora_mm<3>(acc, (const bf16*)wl(F, l, WL_A2), 96, nb, Arow, 96, g, c16);
#pragma unroll
        for (int nt = 0; nt < 4; ++nt) av[nt] = fsig4(acc[nt] + *(const f32x4*)(a0p + nb + 16 * nt + 4 * g));
        lora_mm<3>(acc, (const bf16*)wl(F, l, WL_W2), 96, nb, Arow, 0, g, c16);
#pragma unroll
        for (int nt = 0; nt < 4; ++nt) { const f32x4 z = acc[nt] + *(const f32x4*)(w0p + nb + 16 * nt + 4 * g); f32x4 dec;
#pragma unroll
            for (int e = 0; e < 4; ++e) { const float zz = -z[e]; const float sp = fmaxf(zz, 0.f) + __logf(1.f + __expf(-fabsf(zz))); dec[e] = __expf(-__expf(-sp - 0.5f)); }
            *(f32x4*)(Wb + ro + 16 * nt) = dec; }
        lora_mm<8>(acc, (const bf16*)wl(F, l, WL_G2), 256, nb, Arow, 192, g, c16);
#pragma unroll
        for (int nt = 0; nt < 4; ++nt) *(f32x4*)(Gb + ro + 16 * nt) = acc[nt];
        if (vres) { const bf16x8 tf = *(LAS const bf16x8*)(T1 + (16 * mt + c16) * RT_STRIDE + (8 * g) * 2); const f32x4 z4 = (f32x4){0.f, 0.f, 0.f, 0.f};
#pragma unroll
            for (int nt = 0; nt < 4; ++nt) { const bf16x8 wf = *(const bf16x8*)((const bf16*)wl(F, 1, WL_V2) + (size_t)(nb + 16 * nt + c16) * 32 + 8 * g); acc[nt] = MFMA16(wf, tf, z4);
#if MK_DEBUG
                *(f32x4*)(rwbuf(F, RW_Y) + ro + 16 * nt) = acc[nt];
#endif
            } }
        f32x4 kk[4]; float ss = 0.f; const XmRow xr = xm_row(PR, sshift, m);
#pragma unroll
        for (int nt = 0; nt < 4; ++nt) { const int n = nb + 16 * nt + 4 * g; const f32x4 k = xm4_at(xr, mu, 512 + n);
            kk[nt] = k * *(const f32x4*)(kkp + n); ss += (kk[nt].x * kk[nt].x + kk[nt].y * kk[nt].y) + (kk[nt].z * kk[nt].z + kk[nt].w * kk[nt].w);
            *(f32x4*)(Kb + ro + 16 * nt) = k * ((av[nt] - 1.f) * *(const f32x4*)(kap + n) + 1.f);
            asm volatile("" ::: "memory"); }
#pragma unroll
        for (int nt = 0; nt < 4; ++nt) { const int n = nb + 16 * nt + 4 * g; const f32x4 r = xm4_at(xr, mu, n); f32x4 v = xm4_at(xr, mu, 1024 + n);
            *(f32x4*)(Rb + ro + 16 * nt) = r;
            if (!vres) *(f32x4*)(VF + ro + 16 * nt) = v;
            else { const f32x4 vf = *(const f32x4*)(VF + ro + 16 * nt); v = v + (vf - v) * fsig4(acc[nt] + *(const f32x4*)(vbp + n)); }
            *(f32x4*)(Vb + ro + 16 * nt) = v;
            asm volatile("" ::: "memory"); }
        ss += __shfl_xor(ss, 16); ss += __shfl_xor(ss, 32);
        const float rn = 1.f / fmaxf(sqrtf(ss), 1e-12f);
#pragma unroll
        for (int nt = 0; nt < 4; ++nt) { const f32x4 kn = kk[nt] * rn; *(f32x4*)(Ab + ro + 16 * nt) = -kn; *(f32x4*)(Bb + ro + 16 * nt) = kn * av[nt]; }
    }
    __syncthreads();
}

template <int CTRL> __device__ __forceinline__ float dpp_f(float x) { return __builtin_bit_cast(float, __builtin_amdgcn_mov_dpp(__builtin_bit_cast(int, x), CTRL, 0xf, 0xf, true)); }
__device__ __forceinline__ float row16_sum(float x) {
    x += dpp_f<0xB1>(x); x += dpp_f<0x4E>(x); x += dpp_f<0x141>(x); x += dpp_f<0x128>(x); return x;
}
constexpr int SC_T = 32, SC_ARR = SC_T * 64 * 4, SC_BUF = 5 * SC_ARR + SC_T * 16 * 4;
__device__ __forceinline__ void scan_prompt_unit(const Frame& F, int l, int b, int h, int qt) {
    const float* src0 = rwbuf(F, RW_W); const float* src1 = rwbuf(F, RW_A); const float* src2 = rwbuf(F, RW_B); const float* src3 = rwbuf(F, RW_K); const float* src4 = rwbuf(F, RW_R);
    const float* Vb = rwbuf(F, RW_V); float* Yb = rwbuf(F, RW_Y);
    const size_t rowb = (size_t)b * SEQ;
    f32x4 st0, st1, st2, st3, st4, st5;
#define SC_ISSUE(t0_) do { const int tt_ = F.tid >> 4, c4_ = F.tid & 15; const size_t ro_ = (rowb + (t0_) + tt_) * 512 + h * 64 + 4 * c4_; \
        st0 = *(const f32x4*)(src0 + ro_); st1 = *(const f32x4*)(src1 + ro_); st2 = *(const f32x4*)(src2 + ro_); st3 = *(const f32x4*)(src3 + ro_); st4 = *(const f32x4*)(src4 + ro_); \
        if (F.tid < 128) { const int tv_ = F.tid >> 2, cv_ = F.tid & 3; st5 = *(const f32x4*)(Vb + (rowb + (t0_) + tv_) * 512 + h * 64 + qt * 16 + 4 * cv_); } } while (0)
#define SC_COMMIT(buf_) do { LAS unsigned char* bp_ = F.lds + (buf_) * SC_BUF + F.tid * 16; \
        *(LAS f32x4*)(bp_ + 0 * SC_ARR) = st0; *(LAS f32x4*)(bp_ + 1 * SC_ARR) = st1; *(LAS f32x4*)(bp_ + 2 * SC_ARR) = st2; *(LAS f32x4*)(bp_ + 3 * SC_ARR) = st3; *(LAS f32x4*)(bp_ + 4 * SC_ARR) = st4; \
        if (F.tid < 128) *(LAS f32x4*)(bp_ + 5 * SC_ARR) = st5; } while (0)
    SC_ISSUE(0); SC_COMMIT(0); __syncthreads();
    const int rg = F.lane >> 4, j4 = F.lane & 15, rloc = F.wave * 4 + rg;
    f32x4 s = (f32x4){0.f, 0.f, 0.f, 0.f}; float yk = 0.f;
    float* yp = Yb + (rowb + j4) * 512 + h * 64 + qt * 16 + rloc;
    constexpr int NCH = SEQ / SC_T;
    for (int ch = 0; ch < NCH; ++ch) {
        if (ch + 1 < NCH) SC_ISSUE((ch + 1) * SC_T);
        if (F.wave < 4) { LAS const unsigned char* bp = F.lds + (ch & 1) * SC_BUF + j4 * 16; LAS const float* vp = (LAS const float*)(F.lds + (ch & 1) * SC_BUF + 5 * SC_ARR) + rloc;
#pragma unroll
            for (int tt = 0; tt < SC_T; ++tt) {
                const f32x4 w = *(LAS const f32x4*)(bp + 0 * SC_ARR + tt * 256), a = *(LAS const f32x4*)(bp + 1 * SC_ARR + tt * 256), bb = *(LAS const f32x4*)(bp + 2 * SC_ARR + tt * 256),
                            k = *(LAS const f32x4*)(bp + 3 * SC_ARR + tt * 256), r = *(LAS const f32x4*)(bp + 4 * SC_ARR + tt * 256);
                const float v = vp[tt * 16];
                const f32x4 p = s * w + k * v;
                const float sa = row16_sum((s.x * a.x + s.y * a.y) + (s.z * a.z + s.w * a.w));
                s = bb * sa + p;
                const float y = row16_sum((s.x * r.x + s.y * r.y) + (s.z * r.z + s.w * r.w));
                yk = (j4 == (tt & 15)) ? y : yk;
                if ((tt & 15) == 15) yp[(size_t)(ch * SC_T + (tt & ~15)) * 512] = yk;
            } }
        if (ch + 1 < NCH) SC_COMMIT((ch + 1) & 1);
        __syncthreads();
    }
    if (F.wave < 4) *(f32x4*)(F.out + O_WP + ((((size_t)l * NB + b) * 8 + h) * 64 + qt * 16 + rloc) * 64 + 4 * j4) = s;
    __syncthreads();
}
__device__ __forceinline__ void scan_sample_wave(const Frame& F, int l, int s_, int h) {
    const size_t m = MP + s_; const int rg = F.lane >> 4, j4 = F.lane & 15; const size_t o = m * 512 + h * 64 + 4 * j4;
    const f32x4 w = *(const f32x4*)(rwbuf(F, RW_W) + o), a = *(const f32x4*)(rwbuf(F, RW_A) + o), bb = *(const f32x4*)(rwbuf(F, RW_B) + o), k = *(const f32x4*)(rwbuf(F, RW_K) + o), r = *(const f32x4*)(rwbuf(F, RW_R) + o);
    const float* S0 = INP(8) + (((size_t)l * NS + s_) * 8 + h) * 4096; float* S1 = F.out + O_WS + (((size_t)l * NS + s_) * 8 + h) * 4096;
#pragma unroll 4
    for (int i0 = 0; i0 < 16; ++i0) { const int i = 4 * i0 + rg; f32x4 s = *(const f32x4*)(S0 + i * 64 + 4 * j4); const float v = rwbuf(F, RW_V)[m * 512 + h * 64 + i];
        const float sa = row16_sum((s.x * a.x + s.y * a.y) + (s.z * a.z + s.w * a.w));
        s = s * w + bb * sa + k * v;
        const float y = row16_sum((s.x * r.x + s.y * r.y) + (s.z * r.z + s.w * r.w));
        *(f32x4*)(S1 + i * 64 + 4 * j4) = s; if (j4 == 0) rwbuf(F, RW_Y)[m * 512 + h * 64 + i] = y; }
}
__device__ __forceinline__ void rwkv_post_phase(const Frame& F, int l) {
    const int gw = F.bid * NWAVES + F.wave, NGW = F.G * NWAVES; const float* rkp = INP(27) + l * 512; const float* lgp = INP(28) + l * 512; const float* lbp = INP(29) + l * 512;
    for (int it = gw; it < M * 8; it += NGW) { const int m = it >> 3, h = it & 7, c = h * 64 + F.lane; const size_t o = (size_t)m * 512 + c;
        const float y = rwbuf(F, RW_Y)[o]; const float mu = wave_sum(y) * (1.f / 64.f); const float dv = y - mu; const float var = wave_sum(dv * dv) * (1.f / 64.f);
        const float bon = wave_sum(rwbuf(F, RW_R)[o] * rwbuf(F, RW_K)[o] * rkp[c]);
        const float out = (dv * rsqrtf(var + 64e-5f) * lgp[c] + lbp[c] + bon * rwbuf(F, RW_V)[o]) * rwbuf(F, RW_G)[o];
        ((bf16*)(F.ws + WS_CAT))[(size_t)m * D + 1536 + c] = (bf16)f2bf(out); }
}
}
namespace mk {
namespace cg = cooperative_groups;
constexpr int LDS_BYTES = 135168;
constexpr int PH_PRO = 0, PH_ADA = 1, PH_L0 = 2, PH_PER_L = 10, PH_FINAL = PH_L0 + NL * PH_PER_L, N_PHASES = PH_FINAL + 1;
enum { LP_NORM1 = 0, LP_IN, LP_MIX, LP_SCAN, LP_POST, LP_MG, LP_WO, LP_NORM2, LP_GU, LP_DN };

__device__ __forceinline__ void mix_phase(const Frame& F, int l) {
#ifndef MK_NO_U1
    for (int u = F.bid; u < 260; u += F.G) rwkv_prep_unit(F, l, u);
#endif
#ifndef MK_NO_U2
    for (int a = (F.bid + 252) % F.G; a < 256; a += F.G) attn_prompt_unit(F, l, a >> 7, (a >> 2) & 31, a & 3);
#endif
#ifndef MK_NO_U3
    for (int p = (F.bid + 248) % F.G; p < 260; p += F.G) pool_unit(F, l, p >> 2, p & 3);
#endif
#ifndef MK_NO_U4
    for (int s_ = (F.bid + 244) % F.G; s_ < NS; s_ += F.G) attn_sample_unit(F, l, s_);
#endif
    state_outs(F, l);
}
constexpr int GL_PM_SPLIT = 10;
__device__ __forceinline__ void scan_phase(const Frame& F, int l) {
    if (F.bid < 64) scan_prompt_unit(F, l, F.bid >> 5, (F.bid >> 2) & 7, F.bid & 3);
    else { const int nw = (F.G - 64) * NWAVES; for (int u = (F.bid - 64) * NWAVES + F.wave; u < NS * 8; u += nw) scan_sample_wave(F, l, u >> 3, u & 7);
        __syncthreads();
        Gemm g; g.layer = l; g.ld = D; g.M = MPAD; g.K = D; g.N = NIN; g.A = (const bf16*)(F.ws + WS_H); g.Bt = (const bf16*)wl(F, l, WL_IN); g.mode = G_IN;
        Sched S; S.init(Rect{GL_PM_SPLIT, MPAD / BM - GL_PM_SPLIT, 16, 24}, Rect{0, 0, 0, 0}, F.G - 64, F.bid - 64, 1); Epi E; E.F = &F; E.mode = G_IN; E.layer = l;
        gemm_phase(F.lds, g, S, E); }
}

__global__ void __launch_bounds__(NTHR, 2) mega(Args args) {
    extern __shared__ __attribute__((aligned(16))) unsigned char lds_raw[];
    cg::grid_group grid = cg::this_grid();
    for (int ph = args.ph_lo; ph < args.ph_hi; ++ph) {
        Frame F; { GAS unsigned char* ws_ = (GAS unsigned char*)args.ws; GAS float* out_ = (GAS float*)args.out; int tid_ = threadIdx.x; int bid_ = blockIdx.x; int G_ = gridDim.x;
            asm volatile("" : "+s"(ws_), "+s"(out_), "+v"(tid_), "+s"(bid_), "+s"(G_));
            F.lds = (LAS unsigned char*)lds_raw; F.tid = tid_; F.lane = tid_ & 63; F.wave = __builtin_amdgcn_readfirstlane(tid_ >> 6); F.G = G_; F.bid = bid_; F.out = (float*)out_; F.ws = (unsigned char*)ws_; }
        const int l = ph >= PH_L0 && ph < PH_FINAL ? (ph - PH_L0) / PH_PER_L : 0, lp = ph >= PH_L0 && ph < PH_FINAL ? (ph - PH_L0) % PH_PER_L : -1;
#ifndef MK_NO_PRO
        if (ph == PH_PRO) { p0_prologue(F);
#ifdef MK_DUP_PRO
            __syncthreads(); p0_prologue(F);
#endif
        } else
#endif
#ifndef MK_NO_NORM
        if (ph == PH_FINAL || lp == LP_NORM1 || lp == LP_NORM2) norm_phase(F, l, ph == PH_FINAL ? 2 : lp == LP_NORM1 ? 0 : 1); else
#endif
#ifndef MK_NO_MIX
        if (lp == LP_MIX) { mix_phase(F, l);
#ifdef MK_DUP_MIX
            __syncthreads(); mix_phase(F, l);
#endif
        } else
#endif
#ifndef MK_NO_SCAN
        if (lp == LP_SCAN) { scan_phase(F, l);
#ifdef MK_DUP_SCAN
            __syncthreads(); scan_phase(F, l);
#endif
        } else
#endif
#ifndef MK_NO_POST
        if (lp == LP_POST) rwkv_post_phase(F, l); else
#endif
#ifndef MK_NO_GEMM
        {
            Gemm g; g.layer = l; g.ld = D; g.M = MPAD; g.K = D;
            if (ph == PH_ADA) { g.A = (const bf16*)(F.ws + WS_SILC); g.Bt = (const bf16*)(F.ws + WS_ADAW); g.M = 256; g.N = 2 * NADA; g.mode = G_ADA; }
            else if (lp == LP_IN) { g.A = (const bf16*)(F.ws + WS_H); g.Bt = (const bf16*)wl(F, l, WL_IN); g.N = NIN; g.mode = G_IN; }
            else if (lp == LP_MG) { g.A = (const bf16*)(F.ws + WS_CAT); g.Bt = (const bf16*)wl(F, l, WL_CAT); g.N = D; g.mode = G_MG; }
            else if (lp == LP_WO) { g.A = (const bf16*)(F.ws + WS_MG); g.Bt = (const bf16*)wl(F, l, WL_O); g.N = D; g.mode = G_WO; }
            else if (lp == LP_GU) { g.A = (const bf16*)(F.ws + WS_H); g.Bt = (const bf16*)wl(F, l, WL_GU); g.N = NGU; g.mode = G_GU; }
            else { g.A = (const bf16*)(F.ws + WS_GT); g.Bt = (const bf16*)wl(F, l, WL_DN); g.N = D; g.K = DFF; g.ld = DFF; g.mode = G_DN; }
            Sched S; Epi E; E.F = &F; E.mode = g.mode; E.layer = l;
            if (lp == LP_IN && ph != PH_ADA) S.init(Rect{0, MPAD / BM, 0, 16}, Rect{0, GL_PM_SPLIT, 16, 24}, F.G, F.bid, 1);
            else S.init(Rect{0, g.M / BM, 0, g.N / BM}, Rect{0, 0, 0, 0}, F.G, F.bid, g.mode == G_MG ? 3 : 1);
            gemm_phase(F.lds, g, S, E);
        }
#else
        {}
#endif
        if (ph + 1 < args.ph_hi) grid.sync();
    }
}
}
#ifndef MK_DEBUG
#define MK_DEBUG 0
#endif
extern "C" void kernel_launch(void* const* d_in, const int* in_sizes, int n_in, void* d_out, int out_size, void* d_ws, size_t ws_size, hipStream_t stream) {
    using namespace mk;
    static int grid = 0;
    if (grid == 0) {
        nv::WS wtmp; const size_t need_nv = nv::carve((float*)d_ws, wtmp) * 4; const size_t need = MK_DEBUG ? (need_nv > WS_END ? need_nv : WS_END) + (16u << 20) : WS_END;
        if (n_in != 39 || (size_t)out_size != O_END || ws_size < need) { fprintf(stderr, "kernel_launch: unexpected shapes: n_in %d out %d (want %zu) ws %zu (need %zu)\n", n_in, out_size, (size_t)O_END, ws_size, need); grid = -1; return; }
        int dev = 0, cus = 0, per_cu = 0;
        if (hipGetDevice(&dev) != hipSuccess || hipDeviceGetAttribute(&cus, hipDeviceAttributeMultiprocessorCount, dev) != hipSuccess) { grid = -1; return; }
        if (hipFuncSetAttribute((const void*)mega, hipFuncAttributeMaxDynamicSharedMemorySize, LDS_BYTES) != hipSuccess) { fprintf(stderr, "kernel_launch: hipFuncSetAttribute failed\n"); grid = -1; return; }
        if (hipOccupancyMaxActiveBlocksPerMultiprocessor(&per_cu, (const void*)mega, NTHR, LDS_BYTES) != hipSuccess || per_cu < 1) { fprintf(stderr, "kernel_launch: occupancy query says %d blocks per CU\n", per_cu); per_cu = 1; }
        (void)hipGetLastError();
        grid = cus;
        fprintf(stderr, "kernel_launch: grid %d (cus %d, per_cu %d), ws %zu need %zu\n", grid, cus, per_cu, ws_size, need);
    }
    if (grid < 0) return;
    Args a{};
    for (int i = 0; i < 39; ++i) a.in[i] = (const float*)d_in[i];
    a.out = (float*)d_out; a.ws = (unsigned char*)d_ws;
#if MK_DEBUG
    dbg::Ctx dc; dc.probes = (float*)((unsigned char*)d_ws + ((ws_size - (12u << 20)) & ~(size_t)255)); dc.err = dc.probes + (size_t)dbg::NIDS * dbg::NPROBE; dc.on = 1;
    (void)hipMemsetAsync(dc.err, 0, dbg::NIDS * 4 * sizeof(float), stream);
    unsigned char* ws = (unsigned char*)d_ws;
    for (int ph = 0; ph < N_PHASES; ++ph) {
        a.ph_lo = ph; a.ph_hi = ph + 1;
        hipLaunchKernelGGL(mega, dim3(grid), dim3(NTHR), LDS_BYTES, stream, a);
        using namespace dbg;
        const int l = ph >= PH_L0 && ph < PH_FINAL ? (ph - PH_L0) / PH_PER_L : 0, lp = ph >= PH_L0 && ph < PH_FINAL ? (ph - PH_L0) % PH_PER_L : -1, tb = T_L0 + l * T_PER_L;
        if (ph == PH_ADA) save(&dc, stream, T_MOD, ws + WS_MOD, K_F32, NADA, 0, NL * NMOD, NADA);
        if (lp == LP_NORM1) save(&dc, stream, tb + T_H1, ws + WS_H, K_BF16, D, 0, M, D);
        if (lp == LP_IN) { save(&dc, stream, tb + T_Q, ws + WS_Q, K_QPERM, 1024, 0, M, 1024); save(&dc, stream, tb + T_K, ws + WS_K, K_QPERM, 256, 0, M, 256); save(&dc, stream, tb + T_V, ws + WS_V, K_BF16, 256, 0, M, 256);
            save(&dc, stream, tb + T_U, ws + WS_U, K_F32, 512, 0, M, 512); save(&dc, stream, tb + T_PR, ws + WS_PR, K_F32, 2048, 0, M, RP); }
        if (lp == LP_MIX) { save(&dc, stream, tb + T_OA, ws + WS_CAT, K_BF16, D, 0, M, 1024); save(&dc, stream, tb + T_ZP, ws + WS_CAT, K_BF16, D, 1024, M, 512);
            for (int i = 0; i < 7; ++i) save(&dc, stream, tb + T_R + i, ws + WS_RW + (size_t)i * RW_STRIDE, K_F32, 512, 0, M, 512);
            if (l == 1) { save(&dc, stream, 59, ws + WS_RW + (size_t)RW_Y * RW_STRIDE, K_F32, 512, 0, M, 512); save(&dc, stream, 60, ws + WS_H, K_F32, 32, 0, M, 32); } }
        if (lp == LP_SCAN) save(&dc, stream, tb + T_GT, ws + WS_GT, K_BF16, 6144, 0, M, 6144);
        if (lp == LP_SCAN) save(&dc, stream, tb + T_Y, ws + WS_RW + (size_t)RW_Y * RW_STRIDE, K_F32, 512, 0, M, 512);
        if (lp == LP_POST) save(&dc, stream, tb + T_YR, ws + WS_CAT, K_BF16, D, 1536, M, 512);
        if (lp == LP_MG) save(&dc, stream, tb + T_MG, ws + WS_MG, K_BF16, D, 0, M, D);
        if (lp == LP_WO) save(&dc, stream, tb + T_X1, ws + WS_X, K_F32, D, 0, M, D);
        if (lp == LP_NORM2) save(&dc, stream, tb + T_H2, ws + WS_H, K_BF16, D, 0, M, D);
        if (lp == LP_GU) save(&dc, stream, tb + T_ACT, ws + WS_GT, K_BF16, DFF, 0, M, DFF);
        if (lp == LP_DN) save(&dc, stream, tb + T_X2, ws + WS_X, K_F32, D, 0, M, D);
    }
    const size_t ooff[13] = {O_YP, O_YS, O_KP, O_VP, O_PP, O_SP, O_WP, O_KS, O_VS, O_PS, O_SS, O_WS, O_END}; const int ocol[12] = {2048, 2048, 256, 256, 512, 1984, 64, 256, 256, 512, 1984, 64};
    for (int i = 0; i < 12; ++i) dbg::save(&dc, stream, dbg::T_OUT0 + i, (float*)d_out + ooff[i], dbg::K_F32, ocol[i], 0, (int)((ooff[i + 1] - ooff[i]) / ocol[i]), ocol[i]);
    nv::In in; for (int i = 0; i < 39; ++i) in.p[i] = (const float*)d_in[i];
    nv::forward(in, (float*)d_out, (float*)d_ws, stream, &dc);
    for (int i = 0; i < 12; ++i) dbg::cmp(&dc, stream, dbg::T_OUT0 + i, (float*)d_out + ooff[i], ocol[i], 0, (int)((ooff[i + 1] - ooff[i]) / ocol[i]), ocol[i]);
#ifndef DBG_WANT_ID
#define DBG_WANT_ID -1
#endif
    dbg::inject<<<1, 1, 0, stream>>>(dc.err, (float*)d_out, (float*)d_out + O_YS, DBG_WANT_ID >= 0 ? dbg::NIDS : dbg::T_N, DBG_WANT_ID);
#else
    a.ph_lo = 0; a.ph_hi = N_PHASES;
    void* kargs[] = {&a};
    const hipError_t e = hipLaunchCooperativeKernel((const void*)mega, dim3(grid), dim3(NTHR), kargs, LDS_BYTES, stream);
    if (e != hipSuccess) fprintf(stderr, "kernel_launch: cooperative launch failed: %s (grid %d)\n", hipGetErrorString(e), grid);
#endif
}
```

```cpp
#define MK_DEBUG 0
#define SAMPLE_BESIDE_SCAN 0
#include <hip/hip_runtime.h>
#include <hip/hip_cooperative_groups.h>
#include <cstdio>
#include <cstdint>
namespace dbg {
constexpr int NPROBE = 16384, NSPECIAL = 2048, NIDS = 64;
struct Ctx { float* probes; float* err; int on; };
__device__ __forceinline__ unsigned hash32(unsigned x) { x ^= x >> 16; x *= 0x7feb352dU; x ^= x >> 15; x *= 0x846ca68bU; x ^= x >> 16; return x; }
__device__ __forceinline__ void probe_rc(int id, int k, int R, int C, int& r, int& c) {
    const unsigned h1 = hash32((unsigned)(id * 1000003 + k * 2 + 1)), h2 = hash32((unsigned)(id * 7919 + k * 2 + 77777));
    c = (int)(h2 % (unsigned)C);
    if (R == 8320 && k < NSPECIAL) { const int sp[16] = {0, 1, 15, 16, 127, 128, 129, 4095, 4096, 4097, 8190, 8191, 8192, 8193, 8255, 8319}; r = sp[k >> 7]; }
    else r = (int)(h1 % (unsigned)R);
}
enum { K_F32 = 0, K_BF16 = 1, K_QPERM = 2 };
__device__ __forceinline__ float opt_read(const void* p, int kind, size_t ld, int coff, int r, int c) {
    if (kind == K_F32) return ((const float*)p)[(size_t)r * ld + coff + c];
    if (kind == K_QPERM) { const int h = c >> 6, d = c & 63, pp = 32 * ((d >> 4) & 1) + 8 * ((d >> 2) & 3) + 4 * (d >> 5) + (d & 3); c = h * 64 + pp; }
    const unsigned short b = ((const unsigned short*)p)[(size_t)r * ld + coff + c]; return __builtin_bit_cast(float, (unsigned)b << 16);
}
__global__ void probe_save(float* probes, int id, const void* p, int kind, size_t ld, int coff, int R, int C) {
    const int k = blockIdx.x * blockDim.x + threadIdx.x; if (k >= NPROBE) return; int r, c; probe_rc(id, k, R, C, r, c);
    probes[(size_t)id * NPROBE + k] = opt_read(p, kind, ld, coff, r, c);
}
__global__ void probe_cmp(const float* probes, float* err, int id, const float* gold, size_t ld, int coff, int R, int C, int sig) {
    const int k = blockIdx.x * blockDim.x + threadIdx.x; if (k >= NPROBE) return; int r, c; probe_rc(id, k, R, C, r, c);
    float g = gold[(size_t)r * ld + coff + c]; if (sig) g = 1.f / (1.f + expf(-g));
    float o = probes[(size_t)id * NPROBE + k]; float d = o - g; if (!(d == d) || fabsf(d) > 1e18f) d = 1e18f;
    const int sp = (R == 8320 && k < NSPECIAL) ? 0 : 2;
    atomicAdd(&err[id * 4 + sp], d * d); atomicAdd(&err[id * 4 + sp + 1], g * g);
}
__global__ void inject(const float* err, float* out, float* ys, int nids, int want_id) {
    if (threadIdx.x || blockIdx.x) return;
    int rid = 89, which = 0; float rel = 1e-3f;
    for (int id = 0; id < nids; ++id) {
        const float r_rand = sqrtf(err[id * 4 + 2] / fmaxf(err[id * 4 + 3], 1e-30f)), r_sp = err[id * 4 + 1] > 0.f ? sqrtf(err[id * 4 + 0] / fmaxf(err[id * 4 + 1], 1e-30f)) : 0.f;
        if (want_id >= 0) { if (id == want_id) { rid = id; which = 0; rel = r_rand; break; } continue; }
        if (r_rand > 0.05f) { rid = id; which = 0; rel = r_rand; break; } else if (r_sp > 0.10f) { rid = id; which = 1; rel = r_sp; break; } }
    const float c1 = (float)(10 + rid) * (which ? 1e5f : 1e3f); float f = (log10f(fmaxf(rel, 1e-3f)) + 3.f) * 0.25f; f = fminf(fmaxf(f, 0.f), 1.f);
    out[0] = c1; ys[0] = c1 * (0.2f + 0.6f * f);
}
inline void save(const Ctx* c, hipStream_t st, int id, const void* p, int kind, size_t ld, int coff, int R, int C) { if (c && c->on) probe_save<<<NPROBE / 256, 256, 0, st>>>(c->probes, id, p, kind, ld, coff, R, C); }
inline void cmp(const Ctx* c, hipStream_t st, int id, const float* gold, size_t ld, int coff, int R, int C, int sig = 0) { if (c && c->on) probe_cmp<<<NPROBE / 256, 256, 0, st>>>(c->probes, c->err, id, gold, ld, coff, R, C, sig); }
enum { T_MOD = 0, T_L0 = 1, T_PER_L = 23, T_OUT0 = T_L0 + 2 * T_PER_L, T_N = T_OUT0 + 12 };
enum { T_H1 = 0, T_Q, T_K, T_V, T_U, T_PR, T_GT, T_OA, T_ZP, T_R, T_W, T_KK, T_VV, T_A, T_B, T_G, T_Y, T_YR, T_MG, T_X1, T_H2, T_ACT, T_X2 };
}
namespace nv {
constexpr int D = 2048, SEQ = 4096, NB = 2, MP = NB * SEQ, NS = 128, M = MP + NS, NL = 2;
constexpr int INW = 10176, OQ = 0, OK_ = 1024, OV = 1280, OU = 1536, OPR = 2048, OGL = 4032;
constexpr int RP = 1984, DFF = 5632, NMOD = NB + NS;
constexpr int PASTLEN = 8192;

__device__ __forceinline__ float sigm(float x) { return 1.f / (1.f + expf(-x)); }
__device__ __forceinline__ float silu(float x) { return x / (1.f + expf(-x)); }
__device__ __forceinline__ int modrow(int m) { return m < MP ? m / SEQ : NB + (m - MP); }
__device__ __forceinline__ int posof(int m) { return m < MP ? m % SEQ : PASTLEN; }

__global__ void __launch_bounds__(256) gemm(const float* __restrict__ A, int lda, const float* __restrict__ B, int ldb, float* __restrict__ C, int ldc, int Mm, int N, int K) {
    __shared__ float As[16][68], Bs[16][68];
    const int tx = threadIdx.x & 15, ty = threadIdx.x >> 4, m0 = blockIdx.y * 64, n0 = blockIdx.x * 64;
    float acc[4][4];
#pragma unroll
    for (int i = 0; i < 4; ++i)
#pragma unroll
        for (int j = 0; j < 4; ++j) acc[i][j] = 0.f;
    for (int k0 = 0; k0 < K; k0 += 16) {
        for (int i = threadIdx.x; i < 1024; i += 256) { const int r = i >> 4, c = i & 15; As[c][r] = (m0 + r < Mm) ? A[(size_t)(m0 + r) * lda + k0 + c] : 0.f; }
        for (int i = threadIdx.x; i < 1024; i += 256) { const int r = i >> 6, c = i & 63; Bs[r][c] = (n0 + c < N) ? B[(size_t)(k0 + r) * ldb + n0 + c] : 0.f; }
        __syncthreads();
#pragma unroll
        for (int kk = 0; kk < 16; ++kk) {
            float a[4], b[4];
#pragma unroll
            for (int i = 0; i < 4; ++i) { a[i] = As[kk][ty * 4 + i]; b[i] = Bs[kk][tx * 4 + i]; }
#pragma unroll
            for (int i = 0; i < 4; ++i)
#pragma unroll
                for (int j = 0; j < 4; ++j) acc[i][j] += a[i] * b[j];
        }
        __syncthreads();
    }
#pragma unroll
    for (int i = 0; i < 4; ++i)
#pragma unroll
        for (int j = 0; j < 4; ++j) { const int m = m0 + ty * 4 + i, n = n0 + tx * 4 + j; if (m < Mm && n < N) C[(size_t)m * ldc + n] = acc[i][j]; }
}

__global__ void silu_c(const float* cp, const float* cs, float* out) {
    const int i = blockIdx.x * blockDim.x + threadIdx.x; if (i >= NMOD * D) return;
    const int r = i / D, k = i % D; const float c = r < NB ? cp[r * D + k] : cs[(r - NB) * D + k]; out[i] = silu(c);
}
__global__ void add_bias(float* mod, const float* b, int n, int N) { const int i = blockIdx.x * blockDim.x + threadIdx.x; if (i < n) mod[i] += b[i % N]; }

__global__ void __launch_bounds__(256) modnorm(const float* xa, const float* xb, const float* g, const float* mod, int sh_off, int sc_off, float* out, size_t out_split_off) {
    const int m = blockIdx.x; const float* x = m < MP ? xa + (size_t)m * D : xb + (size_t)(m - MP) * D;
    __shared__ float red[256]; float s = 0.f;
    for (int k = threadIdx.x; k < D; k += 256) { const float v = x[k]; s += v * v; }
    red[threadIdx.x] = s; __syncthreads();
    for (int o = 128; o > 0; o >>= 1) { if (threadIdx.x < o) red[threadIdx.x] += red[threadIdx.x + o]; __syncthreads(); }
    const float rs = rsqrtf(red[0] / D + 1e-6f); const int br = modrow(m);
    float* o = m < MP ? out + (size_t)m * D : out + out_split_off + (size_t)(m - MP) * D;
    for (int k = threadIdx.x; k < D; k += 256) { float v = x[k] * rs * g[k]; if (mod) v = v * (1.f + mod[(size_t)br * 6 * D + sc_off + k]) + mod[(size_t)br * 6 * D + sh_off + k]; o[k] = v; }
}

__global__ void rope(float* z) {
    const int i = blockIdx.x * blockDim.x + threadIdx.x; if (i >= M * 20 * 32) return;
    const int m = i / 640, hh = (i / 32) % 20, d = i % 32; const float pos = (float)posof(m);
    const float inv = powf(10000.f, -(float)d * 2.0f / 64.f), ang = pos * inv, c = cosf(ang), s = sinf(ang);
    float* p = z + (size_t)m * INW + hh * 64; const float x1 = p[d], x2 = p[d + 32]; p[d] = x1 * c - x2 * s; p[d + 32] = x2 * c + x1 * s;
}

__global__ void attn_prompt(const float* z, const float* sink, float* oattn) {
    const int i = blockIdx.x * blockDim.x + threadIdx.x; if (i >= MP * 16) return;
    const int m = i / 16, hq = i % 16, hk = hq / 4, t = m % SEQ; const float* q = z + (size_t)m * INW + OQ + hq * 64;
    const int lo = t - 128 < 0 ? 0 : t - 128; const float sk = sink[hq];
    float mx = sk;
    for (int kp = lo; kp <= t; ++kp) { const float* k = z + (size_t)(m - t + kp) * INW + OK_ + hk * 64; float s = 0.f; for (int d = 0; d < 64; ++d) s += q[d] * k[d]; s *= 0.125f; mx = fmaxf(mx, s); }
    float den = expf(sk - mx); float o[64];
#pragma unroll
    for (int d = 0; d < 64; ++d) o[d] = 0.f;
    for (int kp = lo; kp <= t; ++kp) { const float* k = z + (size_t)(m - t + kp) * INW + OK_ + hk * 64; const float* v = z + (size_t)(m - t + kp) * INW + OV + hk * 64; float s = 0.f; for (int d = 0; d < 64; ++d) s += q[d] * k[d]; s *= 0.125f;
        const float p = expf(s - mx); den += p;
#pragma unroll
        for (int d = 0; d < 64; ++d) o[d] += p * v[d]; }
#pragma unroll
    for (int d = 0; d < 64; ++d) oattn[(size_t)m * 1024 + hq * 64 + d] = o[d] / den;
}
__global__ void attn_sample(const float* z, const float* sink, const float* ck, const float* cv, float* oattn) {
    const int i = blockIdx.x * blockDim.x + threadIdx.x; if (i >= NS * 16) return;
    const int s_ = i / 16, hq = i % 16, hk = hq / 4, m = MP + s_; const float* q = z + (size_t)m * INW + OQ + hq * 64; const float sk = sink[hq];
    float mx = sk;
    for (int j = 0; j <= 128; ++j) { const float* k = j < 128 ? ck + ((size_t)(s_ * 128 + j) * 4 + hk) * 64 : z + (size_t)m * INW + OK_ + hk * 64; float s = 0.f; for (int d = 0; d < 64; ++d) s += q[d] * k[d]; s *= 0.125f; mx = fmaxf(mx, s); }
    float den = expf(sk - mx); float o[64];
#pragma unroll
    for (int d = 0; d < 64; ++d) o[d] = 0.f;
    for (int j = 0; j <= 128; ++j) { const float* k = j < 128 ? ck + ((size_t)(s_ * 128 + j) * 4 + hk) * 64 : z + (size_t)m * INW + OK_ + hk * 64;
        const float* v = j < 128 ? cv + ((size_t)(s_ * 128 + j) * 4 + hk) * 64 : z + (size_t)m * INW + OV + hk * 64; float s = 0.f; for (int d = 0; d < 64; ++d) s += q[d] * k[d]; s *= 0.125f;
        const float p = expf(s - mx); den += p;
#pragma unroll
        for (int d = 0; d < 64; ++d) o[d] += p * v[d]; }
#pragma unroll
    for (int d = 0; d < 64; ++d) oattn[(size_t)m * 1024 + hq * 64 + d] = o[d] / den;
}
__global__ void kv_out(const float* z, const float* ck, const float* cv, float* kp, float* vp, float* ks, float* vs) {
    const int i = blockIdx.x * blockDim.x + threadIdx.x;
    if (i < NB * 128 * 256) { const int b = i / (128 * 256), j = (i / 256) % 128, c = i % 256; const size_t m = (size_t)b * SEQ + SEQ - 128 + j; kp[i] = z[m * INW + OK_ + c]; vp[i] = z[m * INW + OV + c]; }
    if (i < NS * 128 * 256) { const int s_ = i / (128 * 256), j = (i / 256) % 128, c = i % 256;
        if (j < 127) { ks[i] = ck[i + 256]; vs[i] = cv[i + 256]; } else { ks[i] = z[(size_t)(MP + s_) * INW + OK_ + c]; vs[i] = z[(size_t)(MP + s_) * INW + OV + c]; } }
}
__global__ void pool_d(const float* z, const float* spool, float* dbuf) {
    const int i = blockIdx.x * blockDim.x + threadIdx.x; if (i >= M * 512) return;
    const int m = i / 512, c = i % 512, gi = c / 128, w = 2 << gi; float sum = 0.f; float cnt;
    if (m < MP) { const int t = m % SEQ; for (int j = 0; j < w; ++j) if (t - j >= 0) sum += z[(size_t)(m - j) * INW + OU + c]; cnt = (float)(t + 1 < w ? t + 1 : w); }
    else { const int s_ = m - MP; sum = z[(size_t)m * INW + OU + c]; for (int j = 1; j < w; ++j) sum += spool[((size_t)s_ * 15 + 15 - j) * 512 + c]; cnt = (float)w; }
    dbuf[i] = sum / cnt - z[(size_t)m * INW + OU + c];
}
__global__ void pool_z(const float* dbuf, const float* pw, const float* pscale, float* zpool) {
    const int i = blockIdx.x * blockDim.x + threadIdx.x; if (i >= M * 512) return;
    const int m = i / 512, c = i % 512, gi = c / 128, e = c % 128; float s = 0.f;
    for (int k = 0; k < 128; ++k) s += dbuf[(size_t)m * 512 + gi * 128 + k] * pw[(gi * 128 + k) * 128 + e];
    zpool[i] = s * pscale[c];
}
__global__ void pool_out(const float* z, const float* spool, float* pp, float* ps) {
    const int i = blockIdx.x * blockDim.x + threadIdx.x;
    if (i < NB * 15 * 512) { const int b = i / (15 * 512), j = (i / 512) % 15, c = i % 512; pp[i] = z[((size_t)b * SEQ + SEQ - 15 + j) * INW + OU + c]; }
    if (i < NS * 15 * 512) { const int s_ = i / (15 * 512), j = (i / 512) % 15, c = i % 512; ps[i] = j < 14 ? spool[i + 512] : z[(size_t)(MP + s_) * INW + OU + c]; }
}
__global__ void rwkv_xm(const float* z, const float* sshift, const float* mu, float* xm) {
    const int i = blockIdx.x * blockDim.x + threadIdx.x; if (i >= M * RP) return;
    const int m = i / RP, c = i % RP; const float p = z[(size_t)m * INW + OPR + c]; float pv;
    if (m < MP) pv = (m % SEQ) ? z[(size_t)(m - 1) * INW + OPR + c] : 0.f; else pv = sshift[(size_t)(m - MP) * RP + c];
    xm[i] = p + (pv - p) * mu[c];
}
__global__ void shift_out(const float* z, float* sp, float* ss) {
    const int i = blockIdx.x * blockDim.x + threadIdx.x;
    if (i < NB * RP) { const int b = i / RP, c = i % RP; sp[i] = z[((size_t)b * SEQ + SEQ - 1) * INW + OPR + c]; }
    if (i < NS * RP) { const int s_ = i / RP, c = i % RP; ss[i] = z[(size_t)(MP + s_) * INW + OPR + c]; }
}
__global__ void __launch_bounds__(64) rwkv_prep(const float* xm, const float* w0, const float* w2, const float* a0, const float* a2, const float* g2, const float* k_k, const float* k_a,
                                                 const float* T2, const float* vb, float* vfirst, int has_vres,
                                                 float* R, float* W, float* Kk, float* V, float* A, float* Bb, float* G) {
    const int m = blockIdx.x / 8, h = blockIdx.x % 8, c = h * 64 + threadIdx.x; const float* x = xm + (size_t)m * RP;
    float s = w0[c]; for (int k = 0; k < 96; ++k) s += tanhf(x[1536 + k]) * w2[k * 512 + c];
    const float z_ = -s; const float sp = z_ > 20.f ? z_ : log1pf(expf(z_)); const float wlog = -sp - 0.5f; const float decay = expf(-expf(wlog));
    float sa = a0[c]; for (int k = 0; k < 96; ++k) sa += x[1632 + k] * a2[k * 512 + c]; const float a = sigm(sa);
    float g = 0.f; for (int k = 0; k < 256; ++k) g += sigm(x[1728 + k]) * g2[k * 512 + c];
    float v = x[1024 + c];
    if (!has_vres) vfirst[(size_t)m * 512 + c] = v;
    else { const float acc = vb[c] + T2[(size_t)m * 512 + c]; v = v + (vfirst[(size_t)m * 512 + c] - v) * sigm(acc); }
    const float r = x[c], k = x[512 + c]; float kk = k * k_k[c];
    __shared__ float red[64]; red[threadIdx.x] = kk * kk; __syncthreads();
    for (int o = 32; o > 0; o >>= 1) { if (threadIdx.x < o) red[threadIdx.x] += red[threadIdx.x + o]; __syncthreads(); }
    kk = kk / fmaxf(sqrtf(red[0]), 1e-12f); const float k2 = k * (1.f + (a - 1.f) * k_a[c]);
    const size_t o = (size_t)m * 512 + c; R[o] = r; W[o] = decay; Kk[o] = k2; V[o] = v; A[o] = -kk; Bb[o] = kk * a; G[o] = g;
}
__global__ void __launch_bounds__(64) rwkv_scan(const float* R, const float* W, const float* Kk, const float* V, const float* A, const float* Bb, const float* S0, float* Sout, float* Y, int row0, int T) {
    const int seq = blockIdx.x / 8, h = blockIdx.x % 8, i = threadIdx.x; float S[64];
#pragma unroll
    for (int j = 0; j < 64; ++j) S[j] = S0 ? S0[(((size_t)seq * 8 + h) * 64 + i) * 64 + j] : 0.f;
    __shared__ float sr[16][64], sw[16][64], sk[16][64], sa[16][64], sb[16][64], sv[16][64];
    for (int t0 = 0; t0 < T; t0 += 16) { const int nt = T - t0 < 16 ? T - t0 : 16;
        __syncthreads();
        for (int tt = 0; tt < nt; ++tt) { const size_t o = ((size_t)row0 + (size_t)seq * T + t0 + tt) * 512 + h * 64 + i; sr[tt][i] = R[o]; sw[tt][i] = W[o]; sk[tt][i] = Kk[o]; sa[tt][i] = A[o]; sb[tt][i] = Bb[o]; sv[tt][i] = V[o]; }
        __syncthreads();
        for (int tt = 0; tt < nt; ++tt) { float dot = 0.f; const float v = sv[tt][i];
#pragma unroll
            for (int j = 0; j < 64; ++j) dot += S[j] * sa[tt][j];
            float y = 0.f;
#pragma unroll
            for (int j = 0; j < 64; ++j) { S[j] = S[j] * sw[tt][j] + dot * sb[tt][j] + v * sk[tt][j]; y += S[j] * sr[tt][j]; }
            Y[((size_t)row0 + (size_t)seq * T + t0 + tt) * 512 + h * 64 + i] = y; } }
#pragma unroll
    for (int j = 0; j < 64; ++j) Sout[(((size_t)seq * 8 + h) * 64 + i) * 64 + j] = S[j];
}
__global__ void __launch_bounds__(64) rwkv_post(const float* Y, const float* R, const float* Kk, const float* V, const float* G, const float* r_k, const float* lg, const float* lb, float* yout) {
    const int m = blockIdx.x / 8, h = blockIdx.x % 8, i = threadIdx.x, c = h * 64 + i; const size_t o = (size_t)m * 512 + c;
    __shared__ float red[64]; const float y = Y[o];
    red[i] = y; __syncthreads(); for (int s = 32; s > 0; s >>= 1) { if (i < s) red[i] += red[i + s]; __syncthreads(); } const float mu = red[0] / 64.f; __syncthreads();
    red[i] = (y - mu) * (y - mu); __syncthreads(); for (int s = 32; s > 0; s >>= 1) { if (i < s) red[i] += red[i + s]; __syncthreads(); } const float var = red[0] / 64.f; __syncthreads();
    red[i] = R[o] * Kk[o] * r_k[c]; __syncthreads(); for (int s = 32; s > 0; s >>= 1) { if (i < s) red[i] += red[i + s]; __syncthreads(); } const float bon = red[0];
    yout[o] = ((y - mu) * rsqrtf(var + 64e-5f) * lg[c] + lb[c] + bon * V[o]) * G[o];
}
__global__ void merge_acc(const float* z, const float* P, int goff, float* merged, int first) {
    const int i = blockIdx.x * blockDim.x + threadIdx.x; if (i >= M * D) return; const int m = i / D, n = i % D;
    const float v = sigm(z[(size_t)m * INW + OGL + goff + n]) * P[i]; merged[i] = first ? v : merged[i] + v;
}
__global__ void resid(const float* xa, const float* xb, const float* P, const float* mod, int gt_off, float* xout) {
    const int i = blockIdx.x * blockDim.x + threadIdx.x; if (i >= M * D) return; const int m = i / D, n = i % D;
    const float x = m < MP ? xa[i] : xb[(size_t)(m - MP) * D + n]; xout[i] = x + (1.f + mod[(size_t)modrow(m) * 6 * D + gt_off + n]) * P[i];
}
__global__ void swiglu(const float* gbuf, const float* ubuf, float* act, int n) { const int i = blockIdx.x * blockDim.x + threadIdx.x; if (i < n) act[i] = silu(gbuf[i]) * ubuf[i]; }

struct In { const float* p[39]; };
inline void G(hipStream_t st, const float* A, int lda, const float* B, int ldb, float* C, int ldc, int Mm, int N, int K) { gemm<<<dim3((N + 63) / 64, (Mm + 63) / 64), 256, 0, st>>>(A, lda, B, ldb, C, ldc, Mm, N, K); }
#define EW(n) ((int)(((size_t)(n) + 255) / 256)), 256, 0, st

struct WS { float *silc, *mod, *h, *z, *xm, *R, *W, *K, *V, *A, *B, *G, *Y, *vfirst, *dbuf, *cat_a, *cat_p, *cat_r, *P, *merged, *x1, *xres, *fg, *fu, *T1; };
inline size_t carve(float* base, WS& w) {
    size_t o = 0; auto take = [&](size_t n) { float* p = base + o; o += (n + 63) & ~(size_t)63; return p; };
    w.silc = take((size_t)NMOD * D); w.mod = take((size_t)NL * NMOD * 6 * D); w.T1 = take((size_t)M * 32);
    w.h = take((size_t)M * D); w.P = w.h;
    w.xm = take((size_t)M * D); w.x1 = w.xm;
    w.cat_a = take((size_t)M * 1024); w.cat_p = take((size_t)M * 512); w.cat_r = take((size_t)M * 512); w.xres = take((size_t)M * D);
    w.z = take((size_t)M * INW);
    w.R = take((size_t)M * 512); w.W = take((size_t)M * 512); w.K = take((size_t)M * 512); w.V = take((size_t)M * 512); w.A = take((size_t)M * 512); w.B = take((size_t)M * 512); w.G = take((size_t)M * 512);
    w.Y = take((size_t)M * 512); w.vfirst = take((size_t)M * 512); w.dbuf = take((size_t)M * 512);
    w.merged = w.R;
    w.fg = w.z; w.fu = w.z + (size_t)M * DFF;
    return o;
}
constexpr size_t O_YP = 0, O_YS = O_YP + (size_t)MP * D, O_KP = O_YS + (size_t)NS * D, O_VP = O_KP + (size_t)NL * NB * 128 * 256, O_PP = O_VP + (size_t)NL * NB * 128 * 256,
                 O_SP = O_PP + (size_t)NL * NB * 15 * 512, O_WP = O_SP + (size_t)NL * NB * RP, O_KS = O_WP + (size_t)NL * NB * 8 * 4096, O_VS = O_KS + (size_t)NL * NS * 128 * 256,
                 O_PS = O_VS + (size_t)NL * NS * 128 * 256, O_SS = O_PS + (size_t)NL * NS * 15 * 512, O_WS = O_SS + (size_t)NL * NS * RP, O_END = O_WS + (size_t)NL * NS * 8 * 4096;

inline void forward(const In& in, float* out, float* wsf, hipStream_t st, const dbg::Ctx* dc = nullptr) {
    using namespace dbg;
    WS w; carve(wsf, w);
    const float *xp = in.p[0], *xs = in.p[1];
    silu_c<<<EW(NMOD * D)>>>(in.p[2], in.p[3], w.silc);
    for (int l = 0; l < NL; ++l) { G(st, w.silc, D, in.p[9] + (size_t)l * D * 6 * D, 6 * D, w.mod + (size_t)l * NMOD * 6 * D, 6 * D, NMOD, 6 * D, D);
        add_bias<<<EW(NMOD * 6 * D)>>>(w.mod + (size_t)l * NMOD * 6 * D, in.p[10] + (size_t)l * 6 * D, NMOD * 6 * D, 6 * D); }
    cmp(dc, st, T_MOD, w.mod, 6 * D, 0, NL * NMOD, 6 * D);
    const float* xa = xp; const float* xb = xs;
    for (int l = 0; l < NL; ++l) {
        const float* mod = w.mod + (size_t)l * NMOD * 6 * D; const int tb = T_L0 + l * T_PER_L;
        modnorm<<<M, 256, 0, st>>>(xa, xb, in.p[11] + l * D, mod, 0, D, w.h, (size_t)MP * D);
        cmp(dc, st, tb + T_H1, w.h, D, 0, M, D);
        G(st, w.h, D, in.p[13] + (size_t)l * D * INW, INW, w.z, INW, M, INW, D);
        rope<<<EW(M * 640)>>>(w.z);
        cmp(dc, st, tb + T_Q, w.z, INW, OQ, M, 1024); cmp(dc, st, tb + T_K, w.z, INW, OK_, M, 256); cmp(dc, st, tb + T_V, w.z, INW, OV, M, 256); cmp(dc, st, tb + T_U, w.z, INW, OU, M, 512);
        cmp(dc, st, tb + T_PR, w.z, INW, OPR, M, RP); cmp(dc, st, tb + T_GT, w.z, INW, OGL, M, 6144, 1);
        const float* ck = in.p[4] + (size_t)l * NS * 128 * 256; const float* cv = in.p[5] + (size_t)l * NS * 128 * 256;
        attn_prompt<<<(MP * 16 + 63) / 64, 64, 0, st>>>(w.z, in.p[14] + l * 16, w.cat_a);
        attn_sample<<<(NS * 16 + 63) / 64, 64, 0, st>>>(w.z, in.p[14] + l * 16, ck, cv, w.cat_a);
        kv_out<<<EW(NS * 128 * 256)>>>(w.z, ck, cv, out + O_KP + (size_t)l * NB * 128 * 256, out + O_VP + (size_t)l * NB * 128 * 256, out + O_KS + (size_t)l * NS * 128 * 256, out + O_VS + (size_t)l * NS * 128 * 256);
        const float* sp = in.p[6] + (size_t)l * NS * 15 * 512;
        pool_d<<<EW(M * 512)>>>(w.z, sp, w.dbuf);
        pool_z<<<EW(M * 512)>>>(w.dbuf, in.p[16] + (size_t)l * 4 * 128 * 128, in.p[17] + l * 512, w.cat_p);
        pool_out<<<EW(NS * 15 * 512)>>>(w.z, sp, out + O_PP + (size_t)l * NB * 15 * 512, out + O_PS + (size_t)l * NS * 15 * 512);
        rwkv_xm<<<EW((size_t)M * RP)>>>(w.z, in.p[7] + (size_t)l * NS * RP, in.p[19] + l * RP, w.xm);
        shift_out<<<EW(NS * RP)>>>(w.z, out + O_SP + (size_t)l * NB * RP, out + O_SS + (size_t)l * NS * RP);
        if (l > 0) { G(st, w.xm + 1024, RP, in.p[31], 32, w.T1, 32, M, 32, 512); G(st, w.T1, 32, in.p[32], 512, w.dbuf, 512, M, 512, 32); }
        if (l > 0) { cmp(dc, st, 59, w.dbuf, 512, 0, M, 512); cmp(dc, st, 60, w.T1, 32, 0, M, 32); }
        rwkv_prep<<<M * 8, 64, 0, st>>>(w.xm, in.p[20] + l * 512, in.p[21] + (size_t)l * 96 * 512, in.p[22] + l * 512, in.p[23] + (size_t)l * 96 * 512, in.p[24] + (size_t)l * 256 * 512, in.p[25] + l * 512, in.p[26] + l * 512,
                                         w.dbuf, in.p[33], w.vfirst, l > 0, w.R, w.W, w.K, w.V, w.A, w.B, w.G);
        cmp(dc, st, tb + T_OA, w.cat_a, 1024, 0, M, 1024); cmp(dc, st, tb + T_ZP, w.cat_p, 512, 0, M, 512);
        cmp(dc, st, tb + T_R, w.R, 512, 0, M, 512); cmp(dc, st, tb + T_W, w.W, 512, 0, M, 512); cmp(dc, st, tb + T_KK, w.K, 512, 0, M, 512); cmp(dc, st, tb + T_VV, w.V, 512, 0, M, 512);
        cmp(dc, st, tb + T_A, w.A, 512, 0, M, 512); cmp(dc, st, tb + T_B, w.B, 512, 0, M, 512); cmp(dc, st, tb + T_G, w.G, 512, 0, M, 512);
        rwkv_scan<<<NB * 8, 64, 0, st>>>(w.R, w.W, w.K, w.V, w.A, w.B, nullptr, out + O_WP + (size_t)l * NB * 8 * 4096, w.Y, 0, SEQ);
        rwkv_scan<<<NS * 8, 64, 0, st>>>(w.R, w.W, w.K, w.V, w.A, w.B, in.p[8] + (size_t)l * NS * 8 * 4096, out + O_WS + (size_t)l * NS * 8 * 4096, w.Y, MP, 1);
        cmp(dc, st, tb + T_Y, w.Y, 512, 0, M, 512);
        rwkv_post<<<M * 8, 64, 0, st>>>(w.Y, w.R, w.K, w.V, w.G, in.p[27] + l * 512, in.p[28] + l * 512, in.p[29] + l * 512, w.cat_r);
        cmp(dc, st, tb + T_YR, w.cat_r, 512, 0, M, 512);
        G(st, w.cat_a, 1024, in.p[15] + (size_t)l * 1024 * D, D, w.P, D, M, D, 1024); merge_acc<<<EW((size_t)M * D)>>>(w.z, w.P, 0, w.merged, 1);
        G(st, w.cat_p, 512, in.p[18] + (size_t)l * 512 * D, D, w.P, D, M, D, 512);   merge_acc<<<EW((size_t)M * D)>>>(w.z, w.P, D, w.merged, 0);
        G(st, w.cat_r, 512, in.p[30] + (size_t)l * 512 * D, D, w.P, D, M, D, 512);   merge_acc<<<EW((size_t)M * D)>>>(w.z, w.P, 2 * D, w.merged, 0);
        cmp(dc, st, tb + T_MG, w.merged, D, 0, M, D);
        G(st, w.merged, D, in.p[34] + (size_t)l * D * D, D, w.P, D, M, D, D);
        resid<<<EW((size_t)M * D)>>>(xa, xb, w.P, mod, 2 * D, w.x1);
        cmp(dc, st, tb + T_X1, w.x1, D, 0, M, D);
        modnorm<<<M, 256, 0, st>>>(w.x1, w.x1 + (size_t)MP * D, in.p[12] + l * D, mod, 3 * D, 4 * D, w.h, (size_t)MP * D);
        cmp(dc, st, tb + T_H2, w.h, D, 0, M, D);
        G(st, w.h, D, in.p[35] + (size_t)l * D * DFF, DFF, w.fg, DFF, M, DFF, D);
        G(st, w.h, D, in.p[36] + (size_t)l * D * DFF, DFF, w.fu, DFF, M, DFF, D);
        swiglu<<<EW((size_t)M * DFF)>>>(w.fg, w.fu, w.fg, M * DFF);
        cmp(dc, st, tb + T_ACT, w.fg, DFF, 0, M, DFF);
        G(st, w.fg, DFF, in.p[37] + (size_t)l * DFF * D, D, w.P, D, M, D, DFF);
        resid<<<EW((size_t)M * D)>>>(w.x1, w.x1 + (size_t)MP * D, w.P, mod, 5 * D, w.xres);
        cmp(dc, st, tb + T_X2, w.xres, D, 0, M, D);
        xa = w.xres; xb = w.xres + (size_t)MP * D;
    }
    modnorm<<<M, 256, 0, st>>>(xa, xb, in.p[38], nullptr, 0, 0, out + O_YP, (size_t)MP * D);
}
#undef EW
}
namespace mk {
#define LAS __attribute__((address_space(3)))
#define GAS __attribute__((address_space(1)))
typedef unsigned short bf16;
typedef short bf16x8 __attribute__((ext_vector_type(8)));
typedef float f32x4 __attribute__((ext_vector_type(4)));
typedef float f32x2 __attribute__((ext_vector_type(2)));
typedef unsigned u32x4 __attribute__((ext_vector_type(4)));
typedef unsigned u32x2 __attribute__((ext_vector_type(2)));

constexpr int D = 2048, SEQ = 4096, NB = 2, MP = NB * SEQ, NS = 128, M = MP + NS, MPAD = 8448, NL = 2, NMOD = NB + NS;
constexpr int NIN = 10240, NGU = 11264, DFF = 5632, NADA = 6 * D, RP = 1984, PASTLEN = 8192;
constexpr int NWAVES = 8, NTHR = 512;

constexpr size_t al(size_t x) { return (x + 255) & ~(size_t)255; }
constexpr size_t WL_IN = 0, WL_CAT = WL_IN + al((size_t)NIN * D * 2), WL_O = WL_CAT + al((size_t)D * D * 2), WL_GU = WL_O + al((size_t)D * D * 2), WL_DN = WL_GU + al((size_t)NGU * D * 2),
                 WL_W2 = WL_DN + al((size_t)D * DFF * 2), WL_A2 = WL_W2 + al(512 * 96 * 2), WL_G2 = WL_A2 + al(512 * 96 * 2), WL_V1 = WL_G2 + al(512 * 256 * 2), WL_V2 = WL_V1 + al(32 * 512 * 2),
                 WL_PW = WL_V2 + al(512 * 32 * 2), WL_SIZE = WL_PW + al(4 * 128 * 128 * 2);
constexpr size_t WS_W = 0;
constexpr size_t WS_ROPE = WS_W + 2 * WL_SIZE;
constexpr size_t WS_SILC = WS_ROPE + al((size_t)4097 * 64 * 4);
constexpr size_t WS_MOD = WS_SILC + al((size_t)256 * D * 2);
constexpr size_t WS_X = WS_MOD + al((size_t)NL * NMOD * NADA * 4);
constexpr size_t WS_H = WS_X + al((size_t)MPAD * D * 4);
constexpr size_t WS_Q = WS_H + al((size_t)MPAD * D * 2);
constexpr size_t WS_K = WS_Q + al((size_t)MPAD * 1024 * 2);
constexpr size_t WS_V = WS_K + al((size_t)MPAD * 256 * 2);
constexpr size_t WS_U = WS_V + al((size_t)MPAD * 256 * 2);
constexpr size_t WS_PR = WS_U + al((size_t)MPAD * 512 * 4);
constexpr size_t WS_MG = WS_PR;
constexpr size_t WS_CAT = WS_PR + al((size_t)MPAD * D * 4);
constexpr size_t WS_RW = WS_CAT + al((size_t)MPAD * D * 2);
constexpr size_t RW_STRIDE = al((size_t)MPAD * 512 * 4);
constexpr size_t WS_GT = WS_RW + 9 * RW_STRIDE;
constexpr size_t WS_ADAW = WS_GT;
constexpr size_t WS_SLAB = WS_GT + al((size_t)MPAD * 6144 * 2);
constexpr size_t WS_SLABM = WS_SLAB + al((size_t)11 * NS * D * 4);
constexpr size_t WS_CTL = WS_SLABM + al((size_t)4 * NS * D * 4);
constexpr size_t WS_CTL_BYTES = 32768;
constexpr size_t WS_END = WS_CTL + WS_CTL_BYTES;
static_assert((size_t)2 * NADA * D * 2 <= (size_t)MPAD * 6144 * 2, "ada weights fit under the gates");

constexpr size_t O_YP = 0, O_YS = O_YP + (size_t)MP * D, O_KP = O_YS + (size_t)NS * D, O_VP = O_KP + (size_t)NL * NB * 128 * 256, O_PP = O_VP + (size_t)NL * NB * 128 * 256,
                 O_SP = O_PP + (size_t)NL * NB * 15 * 512, O_WP = O_SP + (size_t)NL * NB * RP, O_KS = O_WP + (size_t)NL * NB * 8 * 4096, O_VS = O_KS + (size_t)NL * NS * 128 * 256,
                 O_PS = O_VS + (size_t)NL * NS * 128 * 256, O_SS = O_PS + (size_t)NL * NS * 15 * 512, O_WS = O_SS + (size_t)NL * NS * RP, O_END = O_WS + (size_t)NL * NS * 8 * 4096;

__device__ __forceinline__ unsigned f2bf(float f) { unsigned u = __builtin_bit_cast(unsigned, f); return (u + 0x7fffu + ((u >> 16) & 1u)) >> 16; }
__device__ __forceinline__ unsigned pk2(float lo, float hi) { return f2bf(lo) | (f2bf(hi) << 16); }
__device__ __forceinline__ float bf2f(unsigned short b) { return __builtin_bit_cast(float, (unsigned)b << 16); }
__device__ __forceinline__ float bflo(unsigned w) { return __builtin_bit_cast(float, w << 16); }
__device__ __forceinline__ float bfhi(unsigned w) { return __builtin_bit_cast(float, w & 0xffff0000u); }
__device__ __forceinline__ float fsigm(float x) { return __builtin_amdgcn_rcpf(1.f + __expf(-x)); }
__device__ __forceinline__ float wave_sum(float v) {
#pragma unroll
    for (int o = 1; o < 64; o <<= 1) v += __shfl_xor(v, o);
    return v;
}
__device__ __forceinline__ int modrow(int m) { return m < MP ? (m >> 12) : NB + (m - MP); }
__device__ __forceinline__ int posidx(int m) { return m < MP ? (m & (SEQ - 1)) : 4096; }
__device__ __forceinline__ int pi_d(int p) { return 32 * ((p >> 2) & 1) + 16 * (p >> 5) + 4 * ((p >> 3) & 3) + (p & 3); }

struct Args { const float* in[39]; float* out; unsigned char* ws; int ph_lo, ph_hi; };

struct Frame {
    LAS unsigned char* lds;
    int tid, lane, wave, G, bid;
    float* out; unsigned char* ws;
};
template <int K> __device__ __forceinline__ const float* inp() { GAS const float* p; asm volatile("s_load_dwordx2 %0, %1, %2\n\ts_waitcnt lgkmcnt(0)" : "=s"(p) : "s"(__builtin_amdgcn_kernarg_segment_ptr()), "n"(K * 8) : "memory"); return (const float*)p; }
#define INP(k) inp<k>()
__device__ __forceinline__ unsigned char* wl(const Frame& F, int l, size_t off) { return F.ws + WS_W + (size_t)l * WL_SIZE + off; }
__device__ __forceinline__ float* rwbuf(const Frame& F, int i) { return (float*)(F.ws + WS_RW + (size_t)i * RW_STRIDE); }
enum { RW_R = 0, RW_W, RW_K, RW_V, RW_A, RW_B, RW_G, RW_Y, RW_VF };

struct TSrc { const float* w; long long d2; int ld; int mode; };
__device__ __forceinline__ const float* colsrc(const TSrc& s, int n) {
    if (s.mode == 0) return s.w + n;
    if (s.mode == 1) {
        if (n < 1280) { const int h = n >> 6, p = n & 63; return s.w + h * 64 + pi_d(p); }
        if (n < 4032) return s.w + n;
        if (n < 4096) return nullptr;
        return s.w + (n - 64);
    }
      { const int g8 = n >> 3, i = n & 7; return (const float*)((const char*)s.w + (i < 4 ? 0ll : s.d2)) + 4 * g8 + (i & 3); }
}
__device__ __forceinline__ void transpose_item(const TSrc& s, int K, bf16* WT, size_t ldt, int kcol0, LAS float* scr, int kb, int nb, int lane) {
    const int k0 = 64 * kb, n0 = 32 * nb, gq = lane & 7, kr = lane >> 3;
    const float* cp = colsrc(s, n0 + 4 * gq);
#pragma unroll
    for (int i = 0; i < 8; ++i) { const int kk = 8 * i + kr; const f32x4 v = cp ? *(const f32x4*)(cp + (size_t)(k0 + kk) * s.ld) : (f32x4){0.f, 0.f, 0.f, 0.f};
        LAS float* d = scr + kk * 33 + 4 * gq; d[0] = v.x; d[1] = v.y; d[2] = v.z; d[3] = v.w; }
    asm volatile("s_waitcnt lgkmcnt(0)" ::: "memory");
    const int c = lane & 7;
#pragma unroll
    for (int j = 0; j < 4; ++j) { const int n = (lane >> 3) + 8 * j; const LAS float* p = scr + (8 * c) * 33 + n;
        u32x4 o; o.x = pk2(p[0 * 33], p[1 * 33]); o.y = pk2(p[2 * 33], p[3 * 33]); o.z = pk2(p[4 * 33], p[5 * 33]); o.w = pk2(p[6 * 33], p[7 * 33]);
        *(u32x4*)(WT + (size_t)(n0 + n) * ldt + kcol0 + k0 + 8 * c) = o; }
    asm volatile("s_waitcnt lgkmcnt(0)" ::: "memory");
}
__device__ __forceinline__ void small_transpose(const float* src, int K, int N, bf16* dst, int ldt, int gt, int ngt) {
    for (int i = gt; i < N * K; i += ngt) { const int n = i / K, k = i - n * K; dst[(size_t)n * ldt + k] = (bf16)f2bf(src[(size_t)k * N + n]); }
}
__device__ __forceinline__ void p0_prologue(const Frame& F, int lmask, bool common, int wb, int nwb, int cls) {
    LAS float* scr = (LAS float*)(F.lds + F.wave * 16384);
    const int gw = wb * NWAVES + F.wave, NGW = nwb * NWAVES;
    constexpr int J_ADA = 32 * 384, J_IN = 32 * 320, J_CA = 16 * 64, J_CP = 8 * 64, J_CR = 8 * 64, J_O = 32 * 64, J_GU = 32 * 352, J_DN = 88 * 64;
    constexpr int PER_L = J_ADA + J_IN + J_CA + J_CP + J_CR + J_O + J_GU + J_DN;
    constexpr int TOT = NL * PER_L; const int nrk = cls == 0 ? TOT : cls == 1 ? (TOT / 32) * 27 + (TOT % 32 < 27 ? TOT % 32 : 27) : (TOT / 32) * 5 + (TOT % 32 > 27 ? TOT % 32 - 27 : 0);
    for (int rk = gw; rk < nrk; rk += NGW) {
        const int it = cls == 0 ? rk : cls == 1 ? (rk / 27) * 32 + rk % 27 : (rk / 5) * 32 + 27 + rk % 5;
        const int l = it / PER_L; int r = it - l * PER_L;
        if (r < J_ADA ? !common : !((lmask >> l) & 1)) continue;
        TSrc s; s.d2 = 0; s.mode = 0; bf16* WT; size_t ldt; int K, nn, kcol0 = 0;
        if (r < J_ADA) { s.w = INP(9) + (size_t)l * D * NADA; s.ld = NADA; WT = (bf16*)(F.ws + WS_ADAW) + (size_t)l * NADA * D; ldt = D; K = D; nn = 384; }
        else if ((r -= J_ADA) < J_IN) { s.w = INP(13) + (size_t)l * D * 10176; s.ld = 10176; s.mode = 1; WT = (bf16*)wl(F, l, WL_IN); ldt = D; K = D; nn = 320; }
        else if ((r -= J_IN) < J_CA) { s.w = INP(15) + (size_t)l * 1024 * D; s.ld = D; WT = (bf16*)wl(F, l, WL_CAT); ldt = D; K = 1024; nn = 64; }
        else if ((r -= J_CA) < J_CP) { s.w = INP(18) + (size_t)l * 512 * D; s.ld = D; WT = (bf16*)wl(F, l, WL_CAT); ldt = D; K = 512; nn = 64; kcol0 = 1024; }
        else if ((r -= J_CP) < J_CR) { s.w = INP(30) + (size_t)l * 512 * D; s.ld = D; WT = (bf16*)wl(F, l, WL_CAT); ldt = D; K = 512; nn = 64; kcol0 = 1536; }
        else if ((r -= J_CR) < J_O) { s.w = INP(34) + (size_t)l * D * D; s.ld = D; WT = (bf16*)wl(F, l, WL_O); ldt = D; K = D; nn = 64; }
        else if ((r -= J_O) < J_GU) { s.w = INP(35) + (size_t)l * D * DFF; s.d2 = (const char*)INP(36) - (const char*)INP(35); s.ld = DFF; s.mode = 2; WT = (bf16*)wl(F, l, WL_GU); ldt = D; K = D; nn = 352; }
        else { r -= J_GU; s.w = INP(37) + (size_t)l * DFF * D; s.ld = D; WT = (bf16*)wl(F, l, WL_DN); ldt = DFF; K = DFF; nn = 64; }
        (void)K;
        transpose_item(s, K, WT, ldt, kcol0, scr, r / nn, r % nn, F.lane);
    }
    const int gt = wb * NTHR + F.tid, ngt = nwb * NTHR;
    for (int l = 0; l < NL; ++l) { if (!((lmask >> l) & 1)) continue;
        small_transpose(INP(21) + (size_t)l * 96 * 512, 96, 512, (bf16*)wl(F, l, WL_W2), 96, gt, ngt);
        small_transpose(INP(23) + (size_t)l * 96 * 512, 96, 512, (bf16*)wl(F, l, WL_A2), 96, gt, ngt);
        small_transpose(INP(24) + (size_t)l * 256 * 512, 256, 512, (bf16*)wl(F, l, WL_G2), 256, gt, ngt);
        for (int g = 0; g < 4; ++g) small_transpose(INP(16) + ((size_t)l * 4 + g) * 128 * 128, 128, 128, (bf16*)wl(F, l, WL_PW) + g * 128 * 128, 128, gt, ngt);
    }
    if (lmask & 2) { small_transpose(INP(31), 512, 32, (bf16*)wl(F, 1, WL_V1), 512, gt, ngt);
        small_transpose(INP(32), 32, 512, (bf16*)wl(F, 1, WL_V2), 32, gt, ngt); }
    if (!common) return;
    if (wb == 0 && F.tid < 2) ((unsigned*)(F.ws + WS_CTL))[64 * F.tid] = 0u;
    for (int i = gt; i < 256 * D; i += ngt) { const int r = i >> 11, k = i & (D - 1); float v = 0.f;
        if (r < NMOD) { const float c = r < NB ? INP(2)[r * D + k] : INP(3)[(r - NB) * D + k]; v = c / (1.f + expf(-c)); }
        ((bf16*)(F.ws + WS_SILC))[i] = (bf16)f2bf(v); }
    for (int i = gt; i < 4097 * 32; i += ngt) { const int p = i >> 5, d = i & 31; const float pos = p < 4096 ? (float)p : (float)PASTLEN;
        const float inv = powf(10000.f, -(float)d * (2.0f / 64.f)), ang = pos * inv; float* t = (float*)(F.ws + WS_ROPE) + (size_t)p * 64; t[d] = cosf(ang); t[32 + d] = sinf(ang); }
}

__device__ __forceinline__ void norm_phase(const Frame& F, int l, int which  , int nslab  ) {
    const int gw = F.bid * NWAVES + F.wave, NGW = F.G * NWAVES;
    const float* g = which == 0 ? INP(11) + l * D : which == 1 ? INP(12) + l * D : INP(38); const float* xp0 = INP(0); const float* xp1 = INP(1);
    for (int m = gw; m < M; m += NGW) {
        const float* xr = (which == 0 && l == 0) ? (m < MP ? xp0 + (size_t)m * D : xp1 + (size_t)(m - MP) * D) : (const float*)(F.ws + WS_X) + (size_t)m * D;
        f32x4 v[8], gv[8], shv[8], scv[8]; float s = 0.f;
        const float* mod = (const float*)(F.ws + WS_MOD) + ((size_t)l * NMOD + modrow(m)) * NADA + (which == 0 ? 0 : 3 * D);
#pragma unroll
        for (int j = 0; j < 8; ++j) { v[j] = *(const f32x4*)(xr + j * 256 + F.lane * 4); gv[j] = *(const f32x4*)(g + j * 256 + F.lane * 4);
            if (which != 2) { shv[j] = *(const f32x4*)(mod + j * 256 + F.lane * 4); scv[j] = *(const f32x4*)(mod + D + j * 256 + F.lane * 4); } else { shv[j] = gv[j]; scv[j] = gv[j]; } }
        if (nslab && m >= MP) { const float* sl = (const float*)(F.ws + WS_SLAB) + (size_t)(m - MP) * D + F.lane * 4;
            for (int q = 0; q < nslab; ++q) {
#pragma unroll
                for (int j = 0; j < 8; ++j) v[j] += *(const f32x4*)(sl + (size_t)q * NS * D + j * 256); }
            float* xs = (float*)(F.ws + WS_X) + (size_t)m * D;
#pragma unroll
            for (int j = 0; j < 8; ++j) *(f32x4*)(xs + j * 256 + F.lane * 4) = v[j]; }
#pragma unroll
        for (int j = 0; j < 8; ++j) { s += (v[j].x * v[j].x + v[j].y * v[j].y) + (v[j].z * v[j].z + v[j].w * v[j].w); }
        const float rs = rsqrtf(wave_sum(s) * (1.f / D) + 1e-6f);
        if (which == 0 && l == 0 && m >= MP) { float* xs = (float*)(F.ws + WS_X) + (size_t)m * D;
#pragma unroll
            for (int j = 0; j < 8; ++j) *(f32x4*)(xs + j * 256 + F.lane * 4) = v[j]; }
        if (which == 2) { float* o = F.out + O_YP + (size_t)m * D;
#pragma unroll
            for (int j = 0; j < 8; ++j) *(f32x4*)(o + j * 256 + F.lane * 4) = v[j] * rs * gv[j]; }
        else { bf16* o = (bf16*)(F.ws + WS_H) + (size_t)m * D;
#pragma unroll
            for (int j = 0; j < 8; ++j) { const int c = j * 256 + F.lane * 4; const f32x4 y = v[j] * rs * gv[j] * (scv[j] + 1.f) + shv[j]; u32x2 w; w.x = pk2(y.x, y.y); w.y = pk2(y.z, y.w); *(u32x2*)(o + c) = w; } }
    }
}
}
#ifdef MK_TS_ID
#ifndef MK_TS_BLOCK
#define MK_TS_BLOCK 0
#endif
#define TSB2(id, ldsp) do { if ((id) == MK_TS_ID && blockIdx.x == MK_TS_BLOCK && threadIdx.x == 0) *(volatile __attribute__((address_space(3))) unsigned*)((ldsp) + 135168 - 64) -= (unsigned)__builtin_amdgcn_s_memrealtime(); } while (0)
#define TSE2(id, ldsp) do { if ((id) == MK_TS_ID && blockIdx.x == MK_TS_BLOCK && threadIdx.x == 0) *(volatile __attribute__((address_space(3))) unsigned*)((ldsp) + 135168 - 64) += (unsigned)__builtin_amdgcn_s_memrealtime(); } while (0)
#else
#define TSB2(id, ldsp) do {} while (0)
#define TSE2(id, ldsp) do {} while (0)
#endif
namespace mk {
constexpr int BM = 256, BK = 64, HALF = 128, HTB = HALF * BK * 2, STAGE_BYTES = 8 * HTB, NXCD = 8, WGM = 8;
__device__ __forceinline__ int lds_byte(int r, int c) { const int st = (r >> 4) * 2 + (c >> 5), rr = r & 15, cc = c & 31, ob = rr * 64 + cc * 2; return st * 1024 + (ob ^ (((ob >> 9) & 1) << 5)); }
__device__ __forceinline__ void stage_rc(int b, int& R, int& C) { const int st = b / 1024, sb = b % 1024, swz = sb ^ (((sb >> 9) & 1) << 5); R = (st >> 1) * 16 + swz / 64; C = (st & 1) * 32 + (swz % 64) / 2; }
__device__ __forceinline__ int perm32(int rho) { const int n = rho >> 4, i = rho & 15; return 8 * (i >> 2) + 4 * n + (i & 3); }

struct Unit { int pm, pn, seg; };
enum { G_ADA = 0, G_IN, G_MG, G_WO, G_GU, G_DN };
struct Gemm { const bf16* A; const bf16* Bt; int ld, M, N, K, mode, layer; };

struct Rect { int pm0, nM, pn0, nN; };
struct Sched {
    unsigned pa, pb; int G, c, ksb;
    __device__ __forceinline__ static unsigned pack(const Rect& r) { return (unsigned)r.pm0 | ((unsigned)r.nM << 8) | ((unsigned)r.pn0 << 16) | ((unsigned)r.nN << 24); }
    __device__ __forceinline__ void init(const Rect& a, const Rect& b, int G_, int c_, int  , int ksb_ = 0) { pa = pack(a); pb = pack(b); G = G_; c = c_; ksb = ksb_; }
    __device__ __forceinline__ bool next(int i, Unit& u) const {
        const int nA = (int)((pa >> 8) & 255u) * (int)(pa >> 24), nB = (int)((pb >> 8) & 255u) * (int)(pb >> 24);
        const long L = (long)i * G + c; if (L >= nA + nB) return false;
        const bool inA = L < nA; const unsigned pk = inA ? pa : pb; const int pm0 = (int)(pk & 255u), nM = (int)((pk >> 8) & 255u), pn0 = (int)((pk >> 16) & 255u), nN = (int)(pk >> 24), nwg = nM * nN;
        int wgid = inA ? (int)L : (int)L - nA; { const int q = nwg / NXCD, r = nwg % NXCD, xcd = wgid % NXCD, off = wgid / NXCD; wgid = (xcd < r ? xcd * (q + 1) : r * (q + 1) + (xcd - r) * q) + off; }
        const int nig = WGM * nN, gid = wgid / nig, fm = gid * WGM, gsz = (nM - fm) < WGM ? (nM - fm) : WGM;
        u.pm = pm0 + fm + ((wgid % nig) % gsz); u.pn = pn0 + (wgid % nig) / gsz; u.seg = 0;
        if (!inA && ksb > 0) { const int q = u.pn - pn0; u.seg = q / ksb; u.pn = pn0 + q % ksb; }
        return true;
    }
};

typedef __bf16 bf16x2_t __attribute__((ext_vector_type(2)));
__device__ __forceinline__ unsigned cvt_pk_bf16(float lo, float hi) { const f32x2 v = {lo, hi}; const bf16x2_t b = __builtin_convertvector(v, bf16x2_t); return __builtin_bit_cast(unsigned, b); }
__device__ __forceinline__ f32x4 sig4(f32x4 v) { f32x4 r; r.x = fsigm(v.x); r.y = fsigm(v.y); r.z = fsigm(v.z); r.w = fsigm(v.w); return r; }

__device__ __forceinline__ float gclamp(float g) { return fmaxf(g, 1e-18f); }
struct Epi {
    const Frame* F; int mode, layer;
    __device__ __forceinline__ void rescale(f32x4 (&acc)[2][2][4][2], const Unit& u, int sp, int wr, int wc, int fr, int fq) const {
        int row0 = u.pm * BM + wr * 64 + fr; asm volatile("" : "+v"(row0)); const int c0 = u.pn * BM + wc * 32 + 8 * fq; const bf16* gt = (const bf16*)(F->ws + WS_GT) + sp * D + c0;
#pragma unroll
        for (int ai = 0; ai < 2; ++ai)
#pragma unroll
            for (int m = 0; m < 4; ++m) { const int r = row0 + ai * HALF + m * 16; const int rr = r < M ? r : M - 1;
#pragma unroll
                for (int bj = 0; bj < 2; ++bj) { const u32x4 ga = *(const u32x4*)(gt + (size_t)rr * 6144 + bj * HALF), gb = *(const u32x4*)(gt + (size_t)rr * 6144 + D + bj * HALF);
                    f32x4& v0 = acc[ai][bj][m][0]; f32x4& v1 = acc[ai][bj][m][1];
                    v0.x *= gclamp(bflo(ga.x)) * __builtin_amdgcn_rcpf(gclamp(bflo(gb.x))); v0.y *= gclamp(bfhi(ga.x)) * __builtin_amdgcn_rcpf(gclamp(bfhi(gb.x)));
                    v0.z *= gclamp(bflo(ga.y)) * __builtin_amdgcn_rcpf(gclamp(bflo(gb.y))); v0.w *= gclamp(bfhi(ga.y)) * __builtin_amdgcn_rcpf(gclamp(bfhi(gb.y)));
                    v1.x *= gclamp(bflo(ga.z)) * __builtin_amdgcn_rcpf(gclamp(bflo(gb.z))); v1.y *= gclamp(bfhi(ga.z)) * __builtin_amdgcn_rcpf(gclamp(bfhi(gb.z)));
                    v1.z *= gclamp(bflo(ga.w)) * __builtin_amdgcn_rcpf(gclamp(bflo(gb.w))); v1.w *= gclamp(bfhi(ga.w)) * __builtin_amdgcn_rcpf(gclamp(bfhi(gb.w))); }
                if (m & 1) asm volatile("" ::: "memory"); }
    }
    __device__ __forceinline__ void operator()(const f32x4 (&acc)[2][2][4][2], const Unit& u, int wr, int wc, int fr, int fq) const {
        const Frame& Fr = *F; const int l = layer;
        int row0 = u.pm * BM + wr * 64 + fr; const int colb = u.pn * BM + wc * 32 + 8 * fq;
        asm volatile("" : "+v"(row0));
        unsigned char* ws = Fr.ws;
        if (mode == G_ADA) {
            const float* ab = INP(10);
#pragma unroll
            for (int ai = 0; ai < 2; ++ai)
#pragma unroll
                for (int m = 0; m < 4; ++m) { const int r = row0 + ai * HALF + m * 16; if (r < NMOD) {
#pragma unroll
                    for (int bj = 0; bj < 2; ++bj) { const int c = colb + bj * HALF, ll = c / NADA, j = c - ll * NADA; float* o = (float*)(ws + WS_MOD) + ((size_t)ll * NMOD + r) * NADA + j;
                        *(f32x4*)o = acc[ai][bj][m][0] + *(const f32x4*)(ab + c); *(f32x4*)(o + 4) = acc[ai][bj][m][1] + *(const f32x4*)(ab + c + 4); } } }
        } else if (mode == G_IN) {
            const int pn = u.pn;
            if (pn < 5) {
                const int wp = wc & 1; const float* rt = (const float*)(ws + WS_ROPE);
#pragma unroll
                for (int ai = 0; ai < 2; ++ai)
#pragma unroll
                    for (int m = 0; m < 4; ++m) { const int r = row0 + ai * HALF + m * 16; if (r < M) {
                        const float* tp = rt + (size_t)posidx(r) * 64 + 16 * wp + 4 * fq; const f32x4 cs = *(const f32x4*)tp, sn = *(const f32x4*)(tp + 32);
#pragma unroll
                        for (int bj = 0; bj < 2; ++bj) { const f32x4 x1 = acc[ai][bj][m][0], x2 = acc[ai][bj][m][1]; const f32x4 o1 = x1 * cs - x2 * sn, o2 = x2 * cs + x1 * sn;
                            u32x4 w; w.x = cvt_pk_bf16(o1.x, o1.y); w.y = cvt_pk_bf16(o1.z, o1.w); w.z = cvt_pk_bf16(o2.x, o2.y); w.w = cvt_pk_bf16(o2.z, o2.w);
                            const int hc = bj * HALF + wc * 32 + 8 * fq;
                            if (pn < 4) *(u32x4*)((bf16*)(ws + WS_Q) + (size_t)r * 1024 + pn * 256 + hc) = w;
                            else { *(u32x4*)((bf16*)(ws + WS_K) + (size_t)r * 256 + hc) = w;
                                const int hk = hc >> 6, d1 = 16 * wp + 4 * fq; float* ko = nullptr;
                                if (r < MP) { const int t = r & (SEQ - 1); if (t >= SEQ - 128) ko = Fr.out + O_KP + ((((size_t)l * NB + (r >> 12)) * 128 + (t - (SEQ - 128))) * 4 + hk) * 64; }
                                else ko = Fr.out + O_KS + ((((size_t)l * NS + (r - MP)) * 128 + 127) * 4 + hk) * 64;
                                if (ko) { *(f32x4*)(ko + d1) = o1; *(f32x4*)(ko + d1 + 32) = o2; } } } } }
            } else if (pn == 5) {
#pragma unroll
                for (int ai = 0; ai < 2; ++ai)
#pragma unroll
                    for (int m = 0; m < 4; ++m) { const int r = row0 + ai * HALF + m * 16; if (r < M) {
#pragma unroll
                        for (int bj = 0; bj < 2; ++bj) { const f32x4 v0 = acc[ai][bj][m][0], v1 = acc[ai][bj][m][1]; const int hc = bj * HALF + wc * 32 + 8 * fq;
                            u32x4 w; w.x = cvt_pk_bf16(v0.x, v0.y); w.y = cvt_pk_bf16(v0.z, v0.w); w.z = cvt_pk_bf16(v1.x, v1.y); w.w = cvt_pk_bf16(v1.z, v1.w);
                            *(u32x4*)((bf16*)(ws + WS_V) + (size_t)r * 256 + hc) = w;
                            float* vo = nullptr;
                            if (r < MP) { const int t = r & (SEQ - 1); if (t >= SEQ - 128) vo = Fr.out + O_VP + (((size_t)l * NB + (r >> 12)) * 128 + (t - (SEQ - 128))) * 256; }
                            else vo = Fr.out + O_VS + (((size_t)l * NS + (r - MP)) * 128 + 127) * 256;
                            if (vo) { *(f32x4*)(vo + hc) = v0; *(f32x4*)(vo + hc + 4) = v1; } } } }
            } else if (pn < 16) {
                float* base = pn < 8 ? (float*)(ws + WS_U) : (float*)(ws + WS_PR); const int ld = pn < 8 ? 512 : 2048, c0 = (pn < 8 ? (pn - 6) : (pn - 8)) * 256 + wc * 32 + 8 * fq;
#pragma unroll
                for (int ai = 0; ai < 2; ++ai)
#pragma unroll
                    for (int m = 0; m < 4; ++m) { const int r = row0 + ai * HALF + m * 16; if (r < M) {
#pragma unroll
                        for (int bj = 0; bj < 2; ++bj) { float* o = base + (size_t)r * ld + c0 + bj * HALF; *(f32x4*)o = acc[ai][bj][m][0]; *(f32x4*)(o + 4) = acc[ai][bj][m][1]; } } }
            } else {
                const int c0 = (pn - 16) * 256 + wc * 32 + 8 * fq;
#pragma unroll
                for (int ai = 0; ai < 2; ++ai)
#pragma unroll
                    for (int m = 0; m < 4; ++m) { const int r = row0 + ai * HALF + m * 16; if (r < M) {
#pragma unroll
                        for (int bj = 0; bj < 2; ++bj) { const f32x4 v0 = sig4(acc[ai][bj][m][0]), v1 = sig4(acc[ai][bj][m][1]);
                            u32x4 w; w.x = cvt_pk_bf16(v0.x, v0.y); w.y = cvt_pk_bf16(v0.z, v0.w); w.z = cvt_pk_bf16(v1.x, v1.y); w.w = cvt_pk_bf16(v1.z, v1.w);
                            *(u32x4*)((bf16*)(ws + WS_GT) + (size_t)r * 6144 + c0 + bj * HALF) = w; } } }
            }
        } else if (mode == G_MG && u.pm == MPAD / BM - 1) {
            const int c0 = u.pn * BM + wc * 32 + 8 * fq, br = u.seg < 2 ? 0 : u.seg - 1;
#pragma unroll
            for (int m = 0; m < 4; ++m) { const int r = row0 + m * 16; if (r < M) { float* so = (float*)(ws + WS_SLABM) + ((size_t)u.seg * NS + (r - MP)) * D;
#pragma unroll
                for (int bj = 0; bj < 2; ++bj) { const int c = c0 + bj * HALF; const u32x4 gw = *(const u32x4*)((const bf16*)(ws + WS_GT) + (size_t)r * 6144 + br * D + c);
                    f32x4 v0 = acc[0][bj][m][0], v1 = acc[0][bj][m][1];
                    v0.x *= gclamp(bflo(gw.x)); v0.y *= gclamp(bfhi(gw.x)); v0.z *= gclamp(bflo(gw.y)); v0.w *= gclamp(bfhi(gw.y)); v1.x *= gclamp(bflo(gw.z)); v1.y *= gclamp(bfhi(gw.z)); v1.z *= gclamp(bflo(gw.w)); v1.w *= gclamp(bfhi(gw.w));
                    *(f32x4*)(so + c) = v0; *(f32x4*)(so + c + 4) = v1; } } }
        } else if (mode == G_MG) {
            const int c0 = u.pn * BM + wc * 32 + 8 * fq;
#pragma unroll
            for (int ai = 0; ai < 2; ++ai)
#pragma unroll
                for (int m = 0; m < 4; ++m) { const int r = row0 + ai * HALF + m * 16; if (r < M) {
#pragma unroll
                    for (int bj = 0; bj < 2; ++bj) { const int c = c0 + bj * HALF; const u32x4 gw = *(const u32x4*)((const bf16*)(ws + WS_GT) + (size_t)r * 6144 + 2 * D + c);
                        f32x4 v0 = acc[ai][bj][m][0], v1 = acc[ai][bj][m][1];
                        v0.x *= gclamp(bflo(gw.x)); v0.y *= gclamp(bfhi(gw.x)); v0.z *= gclamp(bflo(gw.y)); v0.w *= gclamp(bfhi(gw.y)); v1.x *= gclamp(bflo(gw.z)); v1.y *= gclamp(bfhi(gw.z)); v1.z *= gclamp(bflo(gw.w)); v1.w *= gclamp(bfhi(gw.w));
                        u32x4 w; w.x = cvt_pk_bf16(v0.x, v0.y); w.y = cvt_pk_bf16(v0.z, v0.w); w.z = cvt_pk_bf16(v1.x, v1.y); w.w = cvt_pk_bf16(v1.z, v1.w); *(u32x4*)((bf16*)(ws + WS_MG) + (size_t)r * D + c) = w; } } }
        } else if (mode == G_WO || mode == G_DN) {
            const int c0 = u.pn * BM + wc * 32 + 8 * fq; const int goff = mode == G_WO ? 2 * D : 5 * D;
            if (u.pm == MPAD / BM - 1) {
#pragma unroll
                for (int m = 0; m < 4; ++m) { const int r = row0 + m * 16; if (r < M) {
                    const float* gp = (const float*)(ws + WS_MOD) + ((size_t)l * NMOD + modrow(r)) * NADA + goff; float* so = (float*)(ws + WS_SLAB) + ((size_t)u.seg * NS + (r - MP)) * D;
#pragma unroll
                    for (int bj = 0; bj < 2; ++bj) { const int c = c0 + bj * HALF; const f32x4 g0 = *(const f32x4*)(gp + c), g1 = *(const f32x4*)(gp + c + 4);
                        *(f32x4*)(so + c) = (g0 + 1.f) * acc[0][bj][m][0]; *(f32x4*)(so + c + 4) = (g1 + 1.f) * acc[0][bj][m][1]; } } }
            } else {
                const float* gp = (const float*)(ws + WS_MOD) + ((size_t)l * NMOD + (u.pm >> 4)) * NADA + goff + c0;
                const f32x4 ga0 = *(const f32x4*)gp + 1.f, ga1 = *(const f32x4*)(gp + 4) + 1.f, gb0 = *(const f32x4*)(gp + HALF) + 1.f, gb1 = *(const f32x4*)(gp + HALF + 4) + 1.f;
                const float* xbase = (mode == G_WO && l == 0) ? INP(0) : (const float*)(ws + WS_X); float* xob = (float*)(ws + WS_X);
#pragma unroll
                for (int am = 0; am < 8; am += 2) { f32x4 xv[2][4];
#pragma unroll
                    for (int q = 0; q < 2; ++q) { const int ai = (am + q) >> 2, m = (am + q) & 3; const float* xin = xbase + (size_t)(row0 + ai * HALF + m * 16) * D + c0;
                        xv[q][0] = *(const f32x4*)xin; xv[q][1] = *(const f32x4*)(xin + 4); xv[q][2] = *(const f32x4*)(xin + HALF); xv[q][3] = *(const f32x4*)(xin + HALF + 4); }
#pragma unroll
                    for (int q = 0; q < 2; ++q) { const int ai = (am + q) >> 2, m = (am + q) & 3; float* xo = xob + (size_t)(row0 + ai * HALF + m * 16) * D + c0;
                        *(f32x4*)xo = xv[q][0] + ga0 * acc[ai][0][m][0]; *(f32x4*)(xo + 4) = xv[q][1] + ga1 * acc[ai][0][m][1];
                        *(f32x4*)(xo + HALF) = xv[q][2] + gb0 * acc[ai][1][m][0]; *(f32x4*)(xo + HALF + 4) = xv[q][3] + gb1 * acc[ai][1][m][1]; }
                    asm volatile("" ::: "memory"); }
            }
        } else {
            const int c0 = u.pn * 128 + wc * 16 + 4 * fq;
#pragma unroll
            for (int ai = 0; ai < 2; ++ai)
#pragma unroll
                for (int m = 0; m < 4; ++m) { const int r = row0 + ai * HALF + m * 16; if (r < M) {
#pragma unroll
                    for (int bj = 0; bj < 2; ++bj) { const f32x4 g = acc[ai][bj][m][0], up = acc[ai][bj][m][1]; const f32x4 a = g * sig4(g) * up;
                        u32x2 w; w.x = cvt_pk_bf16(a.x, a.y); w.y = cvt_pk_bf16(a.z, a.w); *(u32x2*)((bf16*)(ws + WS_GT) + (size_t)r * DFF + c0 + bj * 64) = w; } } }
        }
    }
};

__device__ __forceinline__ void gemm_phase(LAS unsigned char* lds, const Gemm g, const Sched& S, const Epi& E, const int tid  ) {
    const int wid = __builtin_amdgcn_readfirstlane(tid >> 6), lane = tid & 63, wr = wid >> 2, wc = wid & 3, fr = lane & 15, fq = lane >> 4;
    unsigned voffA[2], voffB[2];
#pragma unroll
    for (int i = 0; i < 2; ++i) { int R, C; stage_rc(tid * 16 + i * 8192, R, C); const int Rb = (R & ~31) + perm32(R & 31);
        voffA[i] = (unsigned)(R * g.ld + C) * 2u; voffB[i] = (unsigned)(Rb * g.ld + C) * 2u; }
    constexpr unsigned kstep = BK * 2;
    const unsigned hstep = (unsigned)HALF * (unsigned)g.ld * 2u; const bool mgd = g.mode == G_MG; const int ntfull = g.K / BK;
    const bool ksd = g.mode == G_WO || g.mode == G_DN || g.mode == G_MG;
#define PG8_KS(u) (ksd && (u).pm == MPAD / BM - 1)
#define PG8_KA(u) (PG8_KS(u) ? (unsigned)(u).seg * 512u : 0u)
#define PG8_NT(u) (PG8_KS(u) ? 8 : ntfull)
#define PG8_TILE(p, u) (((unsigned)(p) * (unsigned)BM * (unsigned)g.ld + PG8_KA(u)) * 2u)
    const unsigned ldsw = (unsigned)wid * 1024u;
    const int aoff = lds_byte(wr * 64 + fr, fq * 8), boff = lds_byte(wc * 32 + fr, fq * 8);
#define PG8_SA(b, h) (((b) * 2 + (h)) * HTB)
#define PG8_SB(b, h) ((4 + (b) * 2 + (h)) * HTB)
#define PG8_STAGE(bufoff, gbase, soff, voff) do { _Pragma("unroll") for (int _i = 0; _i < 2; ++_i) \
        __builtin_amdgcn_global_load_lds((const unsigned*)((const char*)(gbase) + (size_t)((voff)[_i] + (unsigned)(soff))), (LAS unsigned*)(lds + (bufoff) + ldsw + _i * 8192), 16, 0, 0); } while (0)
#define PG8_STA(bufoff, soff) PG8_STAGE(bufoff, g.A, soff, voffA)
#define PG8_STB(bufoff, soff) PG8_STAGE(bufoff, g.Bt, soff, voffB)
#define PG8_LDA(dst, b, h) do { _Pragma("unroll") for (int m = 0; m < 4; ++m) _Pragma("unroll") for (int k = 0; k < 2; ++k) dst[m][k] = *(const LAS bf16x8*)(lds + PG8_SA(b, h) + aoff + m * 2048 + k * 1024); } while (0)
#define PG8_LDB(dst, b, h) do { _Pragma("unroll") for (int n = 0; n < 2; ++n) _Pragma("unroll") for (int k = 0; k < 2; ++k) dst[n][k] = *(const LAS bf16x8*)(lds + PG8_SB(b, h) + boff + n * 2048 + k * 1024); } while (0)
#define PG8_MMA(ai, bj, At, Bt) do { __builtin_amdgcn_s_setprio(1); _Pragma("unroll") for (int m = 0; m < 4; ++m) _Pragma("unroll") for (int n = 0; n < 2; ++n) _Pragma("unroll") for (int k = 0; k < 2; ++k) \
        acc[ai][bj][m][n] = __builtin_amdgcn_mfma_f32_16x16x32_bf16(Bt[n][k], At[m][k], acc[ai][bj][m][n], 0, 0, 0); __builtin_amdgcn_s_setprio(0); } while (0)
#define PG8_WAIT_V(n) asm volatile("s_waitcnt vmcnt(" #n ")" ::: "memory")
#define PG8_WAIT_L(n) asm volatile("s_waitcnt lgkmcnt(" #n ")" ::: "memory")
#define PG8_BAR __builtin_amdgcn_s_barrier()
#define PG8_SCHED __builtin_amdgcn_sched_barrier(0)
    Unit cur, nxt; int ui = 0;
    if (!S.next(0, cur)) return;
    f32x4 acc[2][2][4][2];
#pragma unroll
    for (int a = 0; a < 2; ++a)
#pragma unroll
        for (int b = 0; b < 2; ++b)
#pragma unroll
            for (int m = 0; m < 4; ++m)
#pragma unroll
                for (int n = 0; n < 2; ++n) acc[a][b][m][n] = (f32x4){0.f, 0.f, 0.f, 0.f};
    bf16x8 At[4][2], B0[2][2], B1[2][2];
    unsigned cA = PG8_TILE(cur.pm, cur), cB = PG8_TILE(cur.pn, cur);
    PG8_STB(PG8_SB(0, 0), cB); PG8_STB(PG8_SB(0, 1), cB + hstep); PG8_STA(PG8_SA(0, 0), cA); PG8_STA(PG8_SA(0, 1), cA + hstep);
    if (wr == 1) PG8_BAR;
    PG8_WAIT_V(2); PG8_BAR;
    PG8_STB(PG8_SB(1, 0), cB + kstep); PG8_STA(PG8_SA(1, 0), cA + kstep); PG8_STB(PG8_SB(1, 1), cB + hstep + kstep);
    PG8_WAIT_V(6); PG8_BAR;
    for (;;) {
        const bool has_next = S.next(ui + 1, nxt);
        const unsigned nA = has_next ? PG8_TILE(nxt.pm, nxt) : cA, nB = has_next ? PG8_TILE(nxt.pn, nxt) : cB;
        const int nt = PG8_NT(cur);
        TSB2(50 + 2 * g.mode, lds);
        for (int t = 0; t < nt; t += 2) {
            const bool last = (t == nt - 2);
            if (mgd && !PG8_KS(cur) && (t == 16 || t == 24)) E.rescale(acc, cur, t == 16 ? 0 : 1, wr, wc, fr, fq);
            const unsigned a1 = cA + (unsigned)(t + 1) * kstep;
            const unsigned a2 = last ? nA : cA + (unsigned)(t + 2) * kstep, b2 = last ? nB : cB + (unsigned)(t + 2) * kstep;
            const unsigned a3 = a2 + kstep, b3 = b2 + kstep;
            PG8_LDB(B0, 0, 0); PG8_LDB(B1, 0, 1); PG8_SCHED; PG8_LDA(At, 0, 0); PG8_STA(PG8_SA(1, 1), a1 + hstep);
            PG8_WAIT_V(8); PG8_WAIT_L(0); PG8_BAR; PG8_MMA(0, 0, At, B0); PG8_MMA(0, 1, At, B1); PG8_BAR; PG8_SCHED;
            PG8_LDA(At, 0, 1); PG8_STB(PG8_SB(0, 0), b2); PG8_STB(PG8_SB(0, 1), b2 + hstep); PG8_STA(PG8_SA(0, 0), a2);
            PG8_WAIT_V(8); PG8_WAIT_L(0); PG8_BAR; PG8_MMA(1, 0, At, B0); PG8_MMA(1, 1, At, B1); PG8_BAR; PG8_SCHED;
            PG8_LDB(B0, 1, 0); PG8_LDB(B1, 1, 1); PG8_SCHED; PG8_LDA(At, 1, 0); PG8_STA(PG8_SA(0, 1), a2 + hstep);
            PG8_WAIT_V(8); PG8_WAIT_L(0); PG8_BAR; PG8_MMA(0, 0, At, B0); PG8_MMA(0, 1, At, B1); PG8_BAR; PG8_SCHED;
            PG8_LDA(At, 1, 1); PG8_STB(PG8_SB(1, 0), b3); PG8_STB(PG8_SB(1, 1), b3 + hstep); PG8_STA(PG8_SA(1, 0), a3);
            PG8_WAIT_V(8); PG8_WAIT_L(0); PG8_BAR; PG8_MMA(1, 0, At, B0); PG8_MMA(1, 1, At, B1); PG8_BAR; PG8_SCHED;
        }
        if (wr == 0) PG8_BAR;
        TSE2(50 + 2 * g.mode, lds);
        TSB2(51 + 2 * g.mode, lds); E(acc, cur, wr, wc, fr, fq); TSE2(51 + 2 * g.mode, lds);
        if (g.mode == G_GU && cur.pm == MPAD / BM - 1) { asm volatile("s_waitcnt vmcnt(0)" ::: "memory"); __builtin_amdgcn_fence(__ATOMIC_RELEASE, "agent"); asm volatile("s_waitcnt vmcnt(0)" ::: "memory");
            if (lane == 0) __hip_atomic_fetch_add((unsigned*)(E.F->ws + WS_CTL) + 64 * (6 + g.layer), 1u, __ATOMIC_RELAXED, __HIP_MEMORY_SCOPE_AGENT); }
        if (!has_next) break;
#pragma unroll
        for (int a = 0; a < 2; ++a)
#pragma unroll
            for (int b = 0; b < 2; ++b)
#pragma unroll
                for (int m = 0; m < 4; ++m)
#pragma unroll
                    for (int n = 0; n < 2; ++n) acc[a][b][m][n] = (f32x4){0.f, 0.f, 0.f, 0.f};
        cur = nxt; cA = nA; cB = nB; ++ui;
        if (wr == 1) PG8_BAR;
    }
    PG8_WAIT_V(0);
    PG8_BAR;
#undef PG8_KS
#undef PG8_KA
#undef PG8_NT
#undef PG8_TILE
#undef PG8_STA
#undef PG8_STB
#undef PG8_SA
#undef PG8_SB
#undef PG8_STAGE
#undef PG8_LDA
#undef PG8_LDB
#undef PG8_MMA
#undef PG8_WAIT_V
#undef PG8_WAIT_L
#undef PG8_BAR
#undef PG8_SCHED
}
}
namespace mk {
#define MFMA16(a, b, c) __builtin_amdgcn_mfma_f32_16x16x32_bf16((a), (b), (c), 0, 0, 0)
__device__ __forceinline__ bf16x8 pack8(f32x4 a, f32x4 b) { u32x4 w; w.x = cvt_pk_bf16(a.x, a.y); w.y = cvt_pk_bf16(a.z, a.w); w.z = cvt_pk_bf16(b.x, b.y); w.w = cvt_pk_bf16(b.z, b.w); return __builtin_bit_cast(bf16x8, w); }
typedef short s16x4 __attribute__((ext_vector_type(4)));
__device__ __forceinline__ bf16x8 cat44(s16x4 a, s16x4 b) { return (bf16x8){a[0], a[1], a[2], a[3], b[0], b[1], b[2], b[3]}; }
constexpr float LOG2E = 1.4426950408889634f;

constexpr int AK_STRIDE = 144, AV_STRIDE = 560;
constexpr int A_KOFF = 0, A_VOFF = 256 * AK_STRIDE, A_BYTES = A_VOFF + 64 * AV_STRIDE;
__device__ __forceinline__ void attn_prompt_unit(const Frame& F, int l, int b, int blk, int hk) {
    LAS unsigned char* Ks = F.lds + A_KOFF; LAS unsigned char* Vt = F.lds + A_VOFF;
    const bf16* Kg = (const bf16*)(F.ws + WS_K); const bf16* Vg = (const bf16*)(F.ws + WS_V); const bf16* Qg = (const bf16*)(F.ws + WS_Q);
    const int kp0 = blk * 128 - 128;
#pragma unroll
    for (int ch = F.tid; ch < 2048; ch += NTHR) { const int i = ch >> 3, dc = ch & 7, kp = kp0 + i;
        u32x4 kv = (u32x4){0u, 0u, 0u, 0u}, vv = kv;
        if (kp >= 0) { const size_t m = (size_t)b * SEQ + kp; kv = *(const u32x4*)(Kg + m * 256 + hk * 64 + dc * 8); vv = *(const u32x4*)(Vg + m * 256 + hk * 64 + dc * 8); }
        *(LAS u32x4*)(Ks + i * AK_STRIDE + dc * 16) = kv;
        LAS unsigned short* vp = (LAS unsigned short*)(Vt + (dc * 8) * AV_STRIDE) + i;
        vp[0 * (AV_STRIDE / 2)] = (unsigned short)(vv.x & 0xffff); vp[1 * (AV_STRIDE / 2)] = (unsigned short)(vv.x >> 16); vp[2 * (AV_STRIDE / 2)] = (unsigned short)(vv.y & 0xffff); vp[3 * (AV_STRIDE / 2)] = (unsigned short)(vv.y >> 16);
        vp[4 * (AV_STRIDE / 2)] = (unsigned short)(vv.z & 0xffff); vp[5 * (AV_STRIDE / 2)] = (unsigned short)(vv.z >> 16); vp[6 * (AV_STRIDE / 2)] = (unsigned short)(vv.w & 0xffff); vp[7 * (AV_STRIDE / 2)] = (unsigned short)(vv.w >> 16); }
    for (int i = F.tid; i < 64 * 24; i += NTHR) { const int d = i / 24, c = i % 24; ((LAS unsigned short*)(Vt + d * AV_STRIDE))[256 + c] = 0; }
    const int g = F.lane >> 4, c16 = F.lane & 15;
    const float* sinkp = INP(14) + l * 16;
    bf16x8 q0n, q1n;
    { const int gi = F.wave * 4, hq = hk * 4 + (gi >> 3), qs = gi & 7; const size_t mq = (size_t)b * SEQ + blk * 128 + 16 * qs + c16;
      q0n = *(const bf16x8*)(Qg + mq * 1024 + hq * 64 + 8 * g); q1n = *(const bf16x8*)(Qg + mq * 1024 + hq * 64 + 32 + 8 * g); }
    __syncthreads();
#pragma unroll 1
    for (int it = 0; it < 4; ++it) {
        const int gi = F.wave * 4 + it, hq = hk * 4 + (gi >> 3), qs = gi & 7;
        const int tqr = 16 * qs + c16;
        const size_t mq = (size_t)b * SEQ + blk * 128 + tqr;
        const bf16x8 q0 = q0n, q1 = q1n;
        if (it < 3) { const int gn = gi + 1, hn = hk * 4 + (gn >> 3), qn_ = gn & 7; const size_t mn = (size_t)b * SEQ + blk * 128 + 16 * qn_ + c16;
            q0n = *(const bf16x8*)(Qg + mn * 1024 + hn * 64 + 8 * g); q1n = *(const bf16x8*)(Qg + mn * 1024 + hn * 64 + 32 + 8 * g); }
        f32x4 s[10];
#pragma unroll
        for (int j = 0; j < 9; ++j) { LAS const unsigned char* kr = Ks + (16 * (qs + j) + c16) * AK_STRIDE + 16 * g;
            const bf16x8 k0 = *(LAS const bf16x8*)kr, k1 = *(LAS const bf16x8*)(kr + 64);
            f32x4 a = (f32x4){0.f, 0.f, 0.f, 0.f}; a = MFMA16(k0, q0, a); a = MFMA16(k1, q1, a); s[j] = a; }
        const float sk2 = sinkp[hq] * LOG2E; float mx = sk2;
#pragma unroll
        for (int j = 0; j < 9; ++j)
#pragma unroll
            for (int r = 0; r < 4; ++r) { const int i = 16 * (qs + j) + 4 * g + r; const bool ok = (i >= tqr) && (i <= tqr + 128) && (kp0 + i >= 0);
                const float v = ok ? s[j][r] * (0.125f * LOG2E) : -1e30f; s[j][r] = v; mx = fmaxf(mx, v); }
        mx = fmaxf(mx, __shfl_xor(mx, 16)); mx = fmaxf(mx, __shfl_xor(mx, 32));
        float sum = 0.f;
#pragma unroll
        for (int j = 0; j < 9; ++j)
#pragma unroll
            for (int r = 0; r < 4; ++r) { const float p = __builtin_amdgcn_exp2f(s[j][r] - mx); s[j][r] = p; sum += p; }
        s[9] = (f32x4){0.f, 0.f, 0.f, 0.f};
        sum += __shfl_xor(sum, 16); sum += __shfl_xor(sum, 32);
        const float rl = 1.f / (sum + __builtin_amdgcn_exp2f(sk2 - mx));
        f32x4 o[4];
#pragma unroll
        for (int dt = 0; dt < 4; ++dt) o[dt] = (f32x4){0.f, 0.f, 0.f, 0.f};
#pragma unroll
        for (int kk = 0; kk < 5; ++kk) { const bf16x8 pf = pack8(s[2 * kk], s[2 * kk + 1]);
#pragma unroll
            for (int dt = 0; dt < 4; ++dt) { LAS const unsigned char* vr = Vt + (16 * dt + c16) * AV_STRIDE + (16 * (qs + 2 * kk) + 4 * g) * 2;
                const s16x4 v0 = *(LAS const s16x4*)vr, v1 = *(LAS const s16x4*)(vr + 32);
                o[dt] = MFMA16(cat44(v0, v1), pf, o[dt]); } }
        bf16* op = (bf16*)(F.ws + WS_CAT) + mq * D + hq * 64 + 4 * g;
#pragma unroll
        for (int dt = 0; dt < 4; ++dt) { const f32x4 v = o[dt] * rl; u32x2 w; w.x = cvt_pk_bf16(v.x, v.y); w.y = cvt_pk_bf16(v.z, v.w); *(u32x2*)(op + 16 * dt) = w; }
    }
    __syncthreads();
}

__device__ __forceinline__ void attn_sample_unit(const Frame& F, int l, int s_, int hf) {
    LAS float* qn = (LAS float*)F.lds;
    LAS float* kn = qn + 512;
    LAS float* vn = kn + 128;
    LAS float* sc = vn + 128;
    LAS float* rl = sc + 8 * 132;
    const int m = MP + s_; const float* sinkp = INP(14) + l * 16 + 8 * hf;
    const float* ck = INP(4) + ((size_t)l * NS + s_) * 128 * 256; const float* cv = INP(5) + ((size_t)l * NS + s_) * 128 * 256;
    { const int h = F.tid >> 6, p = F.tid & 63; qn[h * 64 + pi_d(p)] = bf2f(((const bf16*)(F.ws + WS_Q))[(size_t)m * 1024 + 512 * hf + F.tid]) * (0.125f * LOG2E); }
    if (F.tid < 128) { const int h = F.tid >> 6, p = F.tid & 63; kn[h * 64 + pi_d(p)] = bf2f(((const bf16*)(F.ws + WS_K))[(size_t)m * 256 + 128 * hf + F.tid]); vn[F.tid] = bf2f(((const bf16*)(F.ws + WS_V))[(size_t)m * 256 + 128 * hf + F.tid]); }
    { float* ko = F.out + O_KS + ((size_t)l * NS + s_) * 128 * 256; float* vo = F.out + O_VS + ((size_t)l * NS + s_) * 128 * 256; const int i0_ = 64 * hf * 64, i1_ = hf ? 127 * 64 : 64 * 64;
#pragma unroll 4
      for (int i = i0_ + F.tid; i < i1_; i += NTHR) { const f32x4 a = *(const f32x4*)(ck + 256 + 4 * i), b = *(const f32x4*)(cv + 256 + 4 * i); *(f32x4*)(ko + 4 * i) = a; *(f32x4*)(vo + 4 * i) = b; } }
    __syncthreads();
    for (int idx = F.tid; idx < 8 * 129; idx += NTHR) { const int hq = idx / 129, j = idx - hq * 129, hk = hq >> 2; float a = 0.f;
        if (j < 128) { const float* kr = ck + (size_t)j * 256 + (2 * hf + hk) * 64;
#pragma unroll
            for (int d = 0; d < 64; d += 4) { const f32x4 kv = *(const f32x4*)(kr + d); a += qn[hq * 64 + d] * kv.x + qn[hq * 64 + d + 1] * kv.y + qn[hq * 64 + d + 2] * kv.z + qn[hq * 64 + d + 3] * kv.w; } }
        else { for (int d = 0; d < 64; ++d) a += qn[hq * 64 + d] * kn[hk * 64 + d]; }
        sc[hq * 132 + j] = a; }
    __syncthreads();
    { const int hq = F.wave; const float sk2 = sinkp[hq] * LOG2E;
        float mx = sk2; for (int j = F.lane; j < 129; j += 64) mx = fmaxf(mx, sc[hq * 132 + j]);
#pragma unroll
        for (int o = 1; o < 64; o <<= 1) mx = fmaxf(mx, __shfl_xor(mx, o));
        float sum = 0.f; for (int j = F.lane; j < 129; j += 64) { const float p = __builtin_amdgcn_exp2f(sc[hq * 132 + j] - mx); sc[hq * 132 + j] = p; sum += p; }
        sum = wave_sum(sum); if (F.lane == 0) rl[hq] = 1.f / (sum + __builtin_amdgcn_exp2f(sk2 - mx)); }
    __syncthreads();
    { const int hq = F.tid >> 6, d = F.tid & 63, hk = hq >> 2; float a = 0.f; const float* vc = cv + (2 * hf + hk) * 64 + d;
#pragma unroll 16
        for (int j = 0; j < 128; ++j) a += sc[hq * 132 + j] * vc[(size_t)j * 256];
        a += sc[hq * 132 + 128] * vn[hk * 64 + d];
        ((bf16*)(F.ws + WS_CAT))[(size_t)m * D + 512 * hf + F.tid] = (bf16)f2bf(a * rl[hq]); }
    __syncthreads();
}

constexpr int PL_STRIDE = 272;
__device__ __forceinline__ void pool_unit(const Frame& F, int l, int rt, int gi) {
    LAS unsigned char* dT = F.lds; LAS unsigned char* Wt = F.lds + 128 * PL_STRIDE;
    const float* U = (const float*)(F.ws + WS_U); const int w = 2 << gi, m0 = rt * 128;
    { const bf16* pw = (const bf16*)wl(F, l, WL_PW) + (size_t)gi * 128 * 128;
      for (int ch = F.tid; ch < 2048; ch += NTHR) { const int e = ch >> 4, cc = ch & 15; *(LAS u32x4*)(Wt + e * PL_STRIDE + cc * 16) = *(const u32x4*)(pw + e * 128 + cc * 8); } }
    { const int c = F.tid & 127, strip = F.tid >> 7, col = gi * 128 + c;
      if (rt < 64) { const int t0 = (m0 & (SEQ - 1)) + 32 * strip; const float* up = U + (size_t)(m0 + 32 * strip) * 512 + col;
          float uv[47];
#pragma unroll
          for (int j = 0; j < 47; ++j) { const int t = t0 - 15 + j; uv[j] = t >= 0 ? up[(ptrdiff_t)(j - 15) * 512] : 0.f; }
          LAS unsigned short* dp = (LAS unsigned short*)(dT + (32 * strip) * PL_STRIDE) + c;
#define POOL_D(W) { float sum = 0.f; _Pragma("unroll") for (int j = 1; j < W; ++j) sum += uv[15 - j]; \
              _Pragma("unroll") for (int k = 0; k < 32; ++k) { const int t = t0 + k; sum += uv[15 + k]; const float cnt = (float)(t + 1 < W ? t + 1 : W); \
                  dp[k * (PL_STRIDE / 2)] = (unsigned short)f2bf(sum / cnt - uv[15 + k]); sum -= uv[15 + k - W + 1]; } }
          if (gi == 0) POOL_D(2) else if (gi == 1) POOL_D(4) else if (gi == 2) POOL_D(8) else POOL_D(16)
#undef POOL_D
      }
      else { const float* sp = INP(6) + (size_t)l * NS * 15 * 512;
#pragma unroll 4
          for (int k = 0; k < 32; ++k) { const int s_ = 32 * strip + k; const float uc = U[(size_t)(MP + s_) * 512 + col]; float hv[15];
#pragma unroll
              for (int j = 1; j < 16; ++j) hv[j - 1] = sp[((size_t)s_ * 15 + 15 - j) * 512 + col];
              float sum = uc;
#pragma unroll
              for (int j = 1; j < 16; ++j) sum += j < w ? hv[j - 1] : 0.f;
              ((LAS unsigned short*)(dT + s_ * PL_STRIDE))[c] = (unsigned short)f2bf(sum / (float)w - uc); } } }
    __syncthreads();
    const int g = F.lane >> 4, c16 = F.lane & 15;
    f32x4 acc[8];
#pragma unroll
    for (int et = 0; et < 8; ++et) acc[et] = (f32x4){0.f, 0.f, 0.f, 0.f};
#pragma unroll
    for (int ks = 0; ks < 4; ++ks) { const bf16x8 df = *(LAS const bf16x8*)(dT + (16 * F.wave + c16) * PL_STRIDE + (32 * ks + 8 * g) * 2);
#pragma unroll
        for (int et = 0; et < 8; ++et) { const bf16x8 wf = *(LAS const bf16x8*)(Wt + (16 * et + c16) * PL_STRIDE + (32 * ks + 8 * g) * 2); acc[et] = MFMA16(wf, df, acc[et]); } }
    const int m = m0 + 16 * F.wave + c16; const float* psc = INP(17) + l * 512 + gi * 128;
    if (m < M) { bf16* op = (bf16*)(F.ws + WS_CAT) + (size_t)m * D + 1024 + gi * 128 + 4 * g;
#pragma unroll
        for (int et = 0; et < 8; ++et) { const f32x4 v = acc[et] * *(const f32x4*)(psc + 16 * et + 4 * g); u32x2 wv; wv.x = cvt_pk_bf16(v.x, v.y); wv.y = cvt_pk_bf16(v.z, v.w); *(u32x2*)(op + 16 * et) = wv; } }
    __syncthreads();
}
__device__ __forceinline__ void state_outs(const Frame& F, int l) {
    const int gt = F.bid * NTHR + F.tid, ngt = F.G * NTHR; const float* U = (const float*)(F.ws + WS_U); const float* PR = (const float*)(F.ws + WS_PR);
    for (int i = gt; i < NB * 15 * 512; i += ngt) { const int b = i / (15 * 512), j = (i >> 9) % 15, c = i & 511; F.out[O_PP + (size_t)l * NB * 15 * 512 + i] = U[((size_t)b * SEQ + SEQ - 15 + j) * 512 + c]; }
    const float* sp = INP(6) + (size_t)l * NS * 15 * 512;
    for (int i = gt; i < NS * 15 * 512; i += ngt) { const int s_ = i / (15 * 512), j = (i >> 9) % 15, c = i & 511; F.out[O_PS + (size_t)l * NS * 15 * 512 + i] = j < 14 ? sp[i + 512] : U[(size_t)(MP + s_) * 512 + c]; }
    for (int i = gt; i < NB * RP; i += ngt) { const int b = i / RP, c = i - b * RP; F.out[O_SP + (size_t)l * NB * RP + i] = PR[((size_t)b * SEQ + SEQ - 1) * 2048 + c]; }
    for (int i = gt; i < NS * RP; i += ngt) { const int s_ = i / RP, c = i - s_ * RP; F.out[O_SS + (size_t)l * NS * RP + i] = PR[(size_t)(MP + s_) * 2048 + c]; }
}

template <int CTRL> __device__ __forceinline__ float dpp_f(float x) { return __builtin_bit_cast(float, __builtin_amdgcn_mov_dpp(__builtin_bit_cast(int, x), CTRL, 0xf, 0xf, true)); }
__device__ __forceinline__ float row16_sum(float x) {
    x += dpp_f<0xB1>(x); x += dpp_f<0x4E>(x); x += dpp_f<0x141>(x); x += dpp_f<0x128>(x); return x;
}
constexpr int RA_STRIDE = 1936;
constexpr int R_T1OFF = 32 * RA_STRIDE, RT_STRIDE = 80;
struct XmRow { const float* p; const float* pv; float pz; };
__device__ __forceinline__ XmRow xm_row(const float* PR, const float* sshift, int m) {
    XmRow r; r.p = PR + (size_t)m * 2048; const bool first = m < MP && (m & (SEQ - 1)) == 0;
    r.pv = m >= MP ? sshift + (size_t)(m - MP) * RP : first ? r.p : r.p - 2048; r.pz = first ? 0.f : 1.f; return r;
}
__device__ __forceinline__ float xm_at(const XmRow& r, const float* mu, int c) { const float p = r.p[c]; return p + (r.pv[c] * r.pz - p) * mu[c]; }
__device__ __forceinline__ f32x4 xm4_at(const XmRow& r, const float* mu, int c) { const f32x4 p = *(const f32x4*)(r.p + c); return p + (*(const f32x4*)(r.pv + c) * r.pz - p) * *(const f32x4*)(mu + c); }
template <int KS> __device__ __forceinline__ void lora_mm(f32x4 (&acc)[4], const bf16* Wt, int ldw, int nbase, LAS const unsigned char* Arow, int acol, int g, int c16) {
#pragma unroll
    for (int nt = 0; nt < 4; ++nt) acc[nt] = (f32x4){0.f, 0.f, 0.f, 0.f};
#pragma unroll
    for (int ks = 0; ks < KS; ++ks) { const bf16x8 af = *(LAS const bf16x8*)(Arow + (acol + 32 * ks + 8 * g) * 2);
#pragma unroll
        for (int nt = 0; nt < 4; ++nt) { const bf16x8 wf = *(const bf16x8*)(Wt + (size_t)(nbase + 16 * nt + c16) * ldw + 32 * ks + 8 * g); acc[nt] = MFMA16(wf, af, acc[nt]); } }
}
__device__ __forceinline__ float frcp(float x) { return __builtin_amdgcn_rcpf(x); }
__device__ __forceinline__ f32x4 fsig4(f32x4 v) { f32x4 r; r.x = frcp(1.f + __expf(-v.x)); r.y = frcp(1.f + __expf(-v.y)); r.z = frcp(1.f + __expf(-v.z)); r.w = frcp(1.f + __expf(-v.w)); return r; }
__device__ __forceinline__ void rwkv_prep_unit(const Frame& F, int l, int ti) {
    int tid_l = F.tid; asm volatile("" : "+v"(tid_l)); const int lane_l = tid_l & 63;
    LAS unsigned char* Aop = F.lds; LAS unsigned char* T1 = F.lds + R_T1OFF;
    const float* PR = (const float*)(F.ws + WS_PR); const float* sshift = INP(7) + (size_t)l * NS * RP; const float* mu = INP(19) + l * RP;
    const int m0 = ti * 32; const bool vres = l > 0;
    TSB2(70, F.lds);
#pragma unroll
    for (int q0 = 0; q0 < 8; q0 += 4) { f32x4 xv[4];
#pragma unroll
        for (int q = 0; q < 4; ++q) if (q0 + q < 7) { const int i = tid_l + (q0 + q) * NTHR, r = i / 112, c4 = i - r * 112; const XmRow xr = xm_row(PR, sshift, m0 + r); xv[q] = xm4_at(xr, mu, 1536 + 4 * c4); }
#pragma unroll
        for (int q = 0; q < 4; ++q) if (q0 + q < 7) { const int i = tid_l + (q0 + q) * NTHR, r = i / 112, c4 = i - r * 112, c = 4 * c4; f32x4 y = xv[q];
            if (c < 96) { y.x = 1.f - 2.f * frcp(1.f + __expf(2.f * y.x)); y.y = 1.f - 2.f * frcp(1.f + __expf(2.f * y.y)); y.z = 1.f - 2.f * frcp(1.f + __expf(2.f * y.z)); y.w = 1.f - 2.f * frcp(1.f + __expf(2.f * y.w)); }
            else if (c >= 192) y = fsig4(y);
            u32x2 w; w.x = cvt_pk_bf16(y.x, y.y); w.y = cvt_pk_bf16(y.z, y.w); *(LAS u32x2*)(Aop + r * RA_STRIDE + c * 2) = w; }
        asm volatile("" ::: "memory"); __builtin_amdgcn_sched_barrier(0); }
    if (vres) {
#pragma unroll
        for (int q0 = 0; q0 < 8; q0 += 4) { f32x4 xv[4];
#pragma unroll
            for (int q = 0; q < 4; ++q) { const int i = tid_l + (q0 + q) * NTHR, r = i >> 7, c4 = i & 127; const XmRow xr = xm_row(PR, sshift, m0 + r); xv[q] = xm4_at(xr, mu, 1024 + 4 * c4); }
#pragma unroll
            for (int q = 0; q < 4; ++q) { const int i = tid_l + (q0 + q) * NTHR, r = i >> 7, c4 = i & 127; u32x2 w; w.x = cvt_pk_bf16(xv[q].x, xv[q].y); w.y = cvt_pk_bf16(xv[q].z, xv[q].w); *(LAS u32x2*)(Aop + r * RA_STRIDE + (448 + 4 * c4) * 2) = w; }
            asm volatile("" ::: "memory"); __builtin_amdgcn_sched_barrier(0); } }
    __syncthreads();
    TSE2(70, F.lds); TSB2(71, F.lds);
    const int g = lane_l >> 4, c16 = lane_l & 15, nb = 64 * F.wave;
    if (vres) {
        if (F.wave < 4) { const int mt = F.wave >> 1, nt = F.wave & 1; f32x4 a = (f32x4){0.f, 0.f, 0.f, 0.f}; const bf16* w1 = (const bf16*)wl(F, 1, WL_V1) + (size_t)(16 * nt + c16) * 512 + 8 * g;
#pragma unroll
            for (int kh = 0; kh < 2; ++kh) { bf16x8 wf[8];
#pragma unroll
                for (int ks = 0; ks < 8; ++ks) wf[ks] = *(const bf16x8*)(w1 + 32 * (8 * kh + ks));
#pragma unroll
                for (int ks = 0; ks < 8; ++ks) { const bf16x8 af = *(LAS const bf16x8*)(Aop + (16 * mt + c16) * RA_STRIDE + (448 + 32 * (8 * kh + ks) + 8 * g) * 2); a = MFMA16(wf[ks], af, a); }
                asm volatile("" ::: "memory"); __builtin_amdgcn_sched_barrier(0); }
            u32x2 wv; wv.x = cvt_pk_bf16(a.x, a.y); wv.y = cvt_pk_bf16(a.z, a.w); *(LAS u32x2*)(T1 + (16 * mt + c16) * RT_STRIDE + (16 * nt + 4 * g) * 2) = wv;
#if MK_DEBUG
            *(f32x4*)((float*)(F.ws + WS_H) + (size_t)(m0 + 16 * mt + c16) * 32 + 16 * nt + 4 * g) = a;
#endif
            }
        __syncthreads();
    }
    LAS unsigned char* Aimg = F.lds + 65536; LAS unsigned char* Limg = F.lds + 65536 + 32768;
    size_t ro[2]; int mrow[2];
#pragma unroll
    for (int mt = 0; mt < 2; ++mt) { int m = m0 + 16 * mt + c16; asm volatile("" : "+v"(m)); mrow[mt] = m; ro[mt] = (size_t)m * 512 + nb + 4 * g; }
    TSE2(71, F.lds); TSB2(72, F.lds);
#define LORA_PASS(WT, LDW, ACOL, KS0, NKS, ACC) do { bf16x8 wq_[NKS][4]; const bf16* pw_ = (const bf16*)(WT) + (size_t)(nb + c16) * (LDW) + 8 * g + 32 * (KS0); \
        _Pragma("unroll") for (int ks = 0; ks < NKS; ++ks) _Pragma("unroll") for (int nt = 0; nt < 4; ++nt) wq_[ks][nt] = *(const bf16x8*)(pw_ + (size_t)16 * nt * (LDW) + 32 * ks); \
        _Pragma("unroll") for (int mt = 0; mt < 2; ++mt) { LAS const unsigned char* Arow_ = Aop + (16 * mt + c16) * RA_STRIDE + ((ACOL) + 32 * (KS0) + 8 * g) * 2; \
            _Pragma("unroll") for (int ks = 0; ks < NKS; ++ks) { const bf16x8 af_ = *(LAS const bf16x8*)(Arow_ + 64 * ks); \
                _Pragma("unroll") for (int nt = 0; nt < 4; ++nt) ACC[mt][nt] = MFMA16(wq_[ks][nt], af_, ACC[mt][nt]); } } \
        asm volatile("" ::: "memory"); __builtin_amdgcn_sched_barrier(0); } while (0)
#define LORA_ZERO(ACC) do { _Pragma("unroll") for (int mt = 0; mt < 2; ++mt) _Pragma("unroll") for (int nt = 0; nt < 4; ++nt) ACC[mt][nt] = (f32x4){0.f, 0.f, 0.f, 0.f}; } while (0)
    {
        const float* a0p = INP(22) + l * 512; f32x4 acc[2][4]; LORA_ZERO(acc); LORA_PASS(wl(F, l, WL_A2), 96, 96, 0, 2, acc); LORA_PASS(wl(F, l, WL_A2), 96, 96, 2, 1, acc);
#pragma unroll
        for (int mt = 0; mt < 2; ++mt)
#pragma unroll
            for (int nt = 0; nt < 4; ++nt) { const f32x4 a = fsig4(acc[mt][nt] + *(const f32x4*)(a0p + nb + 16 * nt + 4 * g)); u32x2 w; w.x = cvt_pk_bf16(a.x, a.y); w.y = cvt_pk_bf16(a.z, a.w);
                *(LAS u32x2*)(Aimg + ((16 * mt + c16) * 512 + nb + 16 * nt + 4 * g) * 2) = w; } }
    {
        const float* w0p = INP(20) + l * 512; float* Wb = rwbuf(F, RW_W); f32x4 acc[2][4]; LORA_ZERO(acc); LORA_PASS(wl(F, l, WL_W2), 96, 0, 0, 2, acc); LORA_PASS(wl(F, l, WL_W2), 96, 0, 2, 1, acc);
#pragma unroll
        for (int mt = 0; mt < 2; ++mt)
#pragma unroll
            for (int nt = 0; nt < 4; ++nt) { const f32x4 z = acc[mt][nt] + *(const f32x4*)(w0p + nb + 16 * nt + 4 * g); f32x4 dec;
#pragma unroll
                for (int e = 0; e < 4; ++e) { const float zz = -z[e]; const float sp = fmaxf(zz, 0.f) + __logf(1.f + __expf(-fabsf(zz))); dec[e] = __expf(-__expf(-sp - 0.5f)); }
                *(f32x4*)(Wb + ro[mt] + 16 * nt) = dec; } }
    {
        float* Gb = rwbuf(F, RW_G); f32x4 acc[2][4]; LORA_ZERO(acc); LORA_PASS(wl(F, l, WL_G2), 256, 192, 0, 2, acc); LORA_PASS(wl(F, l, WL_G2), 256, 192, 2, 2, acc); LORA_PASS(wl(F, l, WL_G2), 256, 192, 4, 2, acc); LORA_PASS(wl(F, l, WL_G2), 256, 192, 6, 2, acc);
#pragma unroll
        for (int mt = 0; mt < 2; ++mt)
#pragma unroll
            for (int nt = 0; nt < 4; ++nt) *(f32x4*)(Gb + ro[mt] + 16 * nt) = acc[mt][nt]; }
#undef LORA_PASS
#undef LORA_ZERO
    TSE2(72, F.lds); TSB2(73, F.lds);
    if (vres) {
#pragma unroll
        for (int mt = 0; mt < 2; ++mt) { const bf16x8 tf = *(LAS const bf16x8*)(T1 + (16 * mt + c16) * RT_STRIDE + (8 * g) * 2); const f32x4 z4 = (f32x4){0.f, 0.f, 0.f, 0.f};
#pragma unroll
            for (int nt = 0; nt < 4; ++nt) { const bf16x8 wf = *(const bf16x8*)((const bf16*)wl(F, 1, WL_V2) + (size_t)(nb + 16 * nt + c16) * 32 + 8 * g); const f32x4 lv = MFMA16(wf, tf, z4);
                u32x2 w; w.x = cvt_pk_bf16(lv.x, lv.y); w.y = cvt_pk_bf16(lv.z, lv.w); *(LAS u32x2*)(Limg + ((16 * mt + c16) * 512 + nb + 16 * nt + 4 * g) * 2) = w;
#if MK_DEBUG
                *(f32x4*)(rwbuf(F, RW_Y) + ro[mt] + 16 * nt) = lv;
#endif
            } } }
    __syncthreads();
    {   const float* vbp = INP(33); const float* kkp = INP(25) + l * 512; const float* kap = INP(26) + l * 512;
        float* Rb = rwbuf(F, RW_R); float* Kb = rwbuf(F, RW_K); float* Vb = rwbuf(F, RW_V); float* Ab = rwbuf(F, RW_A); float* Bb = rwbuf(F, RW_B); float* VF = rwbuf(F, RW_VF);
        const int r = tid_l >> 4, j16 = tid_l & 15; int m = m0 + r; asm volatile("" : "+v"(m)); const XmRow xr = xm_row(PR, sshift, m);
#pragma unroll 4
        for (int h = 0; h < 8; ++h) { const int n = 64 * h + 4 * j16; const size_t o = (size_t)m * 512 + n;
            const f32x4 rx = xm4_at(xr, mu, n), k = xm4_at(xr, mu, 512 + n); f32x4 v = xm4_at(xr, mu, 1024 + n);
            const u32x2 aw = *(LAS const u32x2*)(Aimg + (r * 512 + n) * 2); f32x4 a; a.x = bflo(aw.x); a.y = bfhi(aw.x); a.z = bflo(aw.y); a.w = bfhi(aw.y);
            const f32x4 kk = k * *(const f32x4*)(kkp + n);
            const float ss = row16_sum((kk.x * kk.x + kk.y * kk.y) + (kk.z * kk.z + kk.w * kk.w)), rn = 1.f / fmaxf(sqrtf(ss), 1e-12f);
            *(f32x4*)(Rb + o) = rx;
            *(f32x4*)(Kb + o) = k * ((a - 1.f) * *(const f32x4*)(kap + n) + 1.f);
            if (!vres) *(f32x4*)(VF + o) = v;
            else { const u32x2 lw = *(LAS const u32x2*)(Limg + (r * 512 + n) * 2); f32x4 lv; lv.x = bflo(lw.x); lv.y = bfhi(lw.x); lv.z = bflo(lw.y); lv.w = bfhi(lw.y);
                const f32x4 vf = *(const f32x4*)(VF + o); v = v + (vf - v) * fsig4(lv + *(const f32x4*)(vbp + n)); }
            *(f32x4*)(Vb + o) = v;
            const f32x4 kn = kk * rn; *(f32x4*)(Ab + o) = -kn; *(f32x4*)(Bb + o) = kn * a; } }
    TSE2(73, F.lds);
    __syncthreads();
}

constexpr int SC_T = 32, SC_ARR = SC_T * 64 * 4, SC_BUF = 5 * SC_ARR + SC_T * 16 * 4, SC_NSLOT = 3;
static_assert(SC_NSLOT * SC_BUF <= 131072, "scan ring fits the phase LDS");
__device__ __forceinline__ float wave_sum64(float x) { x = row16_sum(x); x += __shfl_xor(x, 16); x += __shfl_xor(x, 32); return x; }
__device__ __forceinline__ void scan_prompt_unit(const Frame& F, int l, int b, int h, int qt) {
    const size_t rowb = (size_t)b * SEQ;
    constexpr int NCH = SEQ / SC_T;
    if (F.wave >= 4) {
        const float* src0 = rwbuf(F, RW_W); const float* src1 = rwbuf(F, RW_A); const float* src2 = rwbuf(F, RW_B); const float* src3 = rwbuf(F, RW_K); const float* src4 = rwbuf(F, RW_R); const float* Vb = rwbuf(F, RW_V);
        const int lt = F.tid - 256, lw = F.wave - 4;
        const size_t g0 = (rowb + (lt >> 4)) * 512 + h * 64 + 4 * (lt & 15), g1 = g0 + (size_t)16 * 512;
        const size_t gv = (rowb + (lt >> 2)) * 512 + h * 64 + qt * 16 + 4 * (lt & 3);
        const unsigned l0 = (unsigned)lw * 1024u, l1 = l0 + 4096u;
#define SC_GL(src, goff, slot, arr, loff) __builtin_amdgcn_global_load_lds((const unsigned*)((src) + (goff)), (LAS unsigned*)(F.lds + (slot) * SC_BUF + (arr) * SC_ARR + (loff)), 16, 0, 0)
#define SC_STAGE(ch_, slot_) do { const size_t co_ = (size_t)(ch_) * SC_T * 512; \
            SC_GL(src0, g0 + co_, slot_, 0, l0); SC_GL(src0, g1 + co_, slot_, 0, l1); SC_GL(src1, g0 + co_, slot_, 1, l0); SC_GL(src1, g1 + co_, slot_, 1, l1); SC_GL(src2, g0 + co_, slot_, 2, l0); SC_GL(src2, g1 + co_, slot_, 2, l1); \
            SC_GL(src3, g0 + co_, slot_, 3, l0); SC_GL(src3, g1 + co_, slot_, 3, l1); SC_GL(src4, g0 + co_, slot_, 4, l0); SC_GL(src4, g1 + co_, slot_, 4, l1); \
            if (lw < 2) SC_GL(Vb, gv + co_, slot_, 5, l0); } while (0)
        SC_STAGE(0, 0); SC_STAGE(1, 1);
        if (lw < 2) asm volatile("s_waitcnt vmcnt(11)" ::: "memory"); else asm volatile("s_waitcnt vmcnt(10)" ::: "memory");
        __builtin_amdgcn_s_barrier();
        int slot = 2;
        for (int ch = 0; ch < NCH; ++ch) {
            if (ch + 2 < NCH) { SC_STAGE(ch + 2, slot);
                if (lw < 2) asm volatile("s_waitcnt vmcnt(11)" ::: "memory"); else asm volatile("s_waitcnt vmcnt(10)" ::: "memory"); }
            else asm volatile("s_waitcnt vmcnt(0)" ::: "memory");
            __builtin_amdgcn_s_barrier();
            slot = slot == 2 ? 0 : slot + 1;
        }
#undef SC_GL
#undef SC_STAGE
    } else {
        float* Yb = rwbuf(F, RW_Y);
        const int rg = F.lane >> 4, j4 = F.lane & 15, rloc = F.wave * 4 + rg;
        f32x4 s = (f32x4){0.f, 0.f, 0.f, 0.f}; float yk = 0.f, ypart = 0.f;
        float* yp = Yb + (rowb + j4) * 512 + h * 64 + qt * 16 + rloc;
        __builtin_amdgcn_s_barrier(); asm volatile("" ::: "memory");
        int slot = 0;
        for (int ch = 0; ch < NCH; ++ch) {
            LAS const unsigned char* bp = F.lds + slot * SC_BUF + j4 * 16; LAS const float* vp = (LAS const float*)(F.lds + slot * SC_BUF + 5 * SC_ARR) + rloc;
            f32x4 w = *(LAS const f32x4*)(bp + 0 * SC_ARR), a = *(LAS const f32x4*)(bp + 1 * SC_ARR), bb = *(LAS const f32x4*)(bp + 2 * SC_ARR), k = *(LAS const f32x4*)(bp + 3 * SC_ARR), r = *(LAS const f32x4*)(bp + 4 * SC_ARR);
            float v = vp[0];
#pragma unroll
            for (int tt = 0; tt < SC_T; ++tt) {
                const f32x4 p = s * w + k * v;
                __builtin_amdgcn_sched_barrier(0);
                f32x4 wn = w, an = a, bn = bb, kn = k, rn = r; float vn = v;
                if (tt + 1 < SC_T) { wn = *(LAS const f32x4*)(bp + 0 * SC_ARR + (tt + 1) * 256); an = *(LAS const f32x4*)(bp + 1 * SC_ARR + (tt + 1) * 256); bn = *(LAS const f32x4*)(bp + 2 * SC_ARR + (tt + 1) * 256);
                    kn = *(LAS const f32x4*)(bp + 3 * SC_ARR + (tt + 1) * 256); rn = *(LAS const f32x4*)(bp + 4 * SC_ARR + (tt + 1) * 256); vn = vp[(tt + 1) * 16]; }
                __builtin_amdgcn_sched_barrier(0);
                const float yprev = row16_sum(ypart);
                const float sa = row16_sum((s.x * a.x + s.y * a.y) + (s.z * a.z + s.w * a.w));
                s = bb * sa + p;
                ypart = (s.x * r.x + s.y * r.y) + (s.z * r.z + s.w * r.w);
                if (tt > 0) { yk = (j4 == ((tt - 1) & 15)) ? yprev : yk; if (((tt - 1) & 15) == 15) yp[(size_t)(ch * SC_T + ((tt - 1) & ~15)) * 512] = yk; }
                else if (ch > 0) { yk = (j4 == 15) ? yprev : yk; yp[(size_t)((ch - 1) * SC_T + 16) * 512] = yk; }
                w = wn; a = an; bb = bn; k = kn; r = rn; v = vn;
            }
            __builtin_amdgcn_s_barrier(); asm volatile("" ::: "memory");
            slot = slot == 2 ? 0 : slot + 1;
        }
        { const float ylast = row16_sum(ypart); yk = (j4 == 15) ? ylast : yk; yp[(size_t)((NCH - 1) * SC_T + 16) * 512] = yk; }
        *(f32x4*)(F.out + O_WP + ((((size_t)l * NB + b) * 8 + h) * 64 + qt * 16 + rloc) * 64 + 4 * j4) = s;
    }
    __syncthreads();
}
__device__ __forceinline__ void scan_sample_wave(const Frame& F, int l, int s_, int h) {
    const size_t m = MP + s_; const int rg = F.lane >> 4, j4 = F.lane & 15; const size_t o = m * 512 + h * 64 + 4 * j4;
    const f32x4 w = *(const f32x4*)(rwbuf(F, RW_W) + o), a = *(const f32x4*)(rwbuf(F, RW_A) + o), bb = *(const f32x4*)(rwbuf(F, RW_B) + o), k = *(const f32x4*)(rwbuf(F, RW_K) + o), r = *(const f32x4*)(rwbuf(F, RW_R) + o);
    const float* S0 = INP(8) + (((size_t)l * NS + s_) * 8 + h) * 4096; float* S1 = F.out + O_WS + (((size_t)l * NS + s_) * 8 + h) * 4096;
    const int row = 4 * j4 + rg; const size_t orow = m * 512 + h * 64 + row;
    const float v_my = rwbuf(F, RW_V)[orow], g_my = rwbuf(F, RW_G)[orow], rk_r = INP(27)[l * 512 + h * 64 + row], lg_r = INP(28)[l * 512 + h * 64 + row], lb_r = INP(29)[l * 512 + h * 64 + row];
    const f32x4 rk4 = *(const f32x4*)(INP(27) + l * 512 + h * 64 + 4 * j4);
    (void)rk_r;
    float yk = 0.f;
#pragma unroll 4
    for (int i0 = 0; i0 < 16; ++i0) { const int i = 4 * i0 + rg; f32x4 s = *(const f32x4*)(S0 + i * 64 + 4 * j4); const float v = rwbuf(F, RW_V)[m * 512 + h * 64 + i];
        const float sa = row16_sum((s.x * a.x + s.y * a.y) + (s.z * a.z + s.w * a.w));
        s = s * w + bb * sa + k * v;
        const float y = row16_sum((s.x * r.x + s.y * r.y) + (s.z * r.z + s.w * r.w));
        *(f32x4*)(S1 + i * 64 + 4 * j4) = s; yk = (j4 == i0) ? y : yk; }
    const float bon = row16_sum((r.x * k.x * rk4.x + r.y * k.y * rk4.y) + (r.z * k.z * rk4.z + r.w * k.w * rk4.w));
    const float mu = wave_sum64(yk) * (1.f / 64.f), dv = yk - mu, var = wave_sum64(dv * dv) * (1.f / 64.f);
    ((bf16*)(F.ws + WS_CAT))[m * D + 1536 + h * 64 + row] = (bf16)f2bf((dv * rsqrtf(var + 64e-5f) * lg_r + lb_r + bon * v_my) * g_my);
#if MK_DEBUG
    rwbuf(F, RW_Y)[orow] = yk;
#endif
}
__device__ __forceinline__ void rwkv_post_phase(const Frame& F, int l) {
    const int gw = F.bid * NWAVES + F.wave, NGW = F.G * NWAVES; const float* rkp = INP(27) + l * 512; const float* lgp = INP(28) + l * 512; const float* lbp = INP(29) + l * 512;
    const float* Yb = rwbuf(F, RW_Y); const float* Rb = rwbuf(F, RW_R); const float* Kb = rwbuf(F, RW_K); const float* Vb = rwbuf(F, RW_V); const float* Gb = rwbuf(F, RW_G);
    for (int it0 = gw * 4; it0 < MP * 8; it0 += NGW * 4) {
        float y[4], r[4], k[4], v[4], g[4];
#pragma unroll
        for (int q = 0; q < 4; ++q) { const int it = it0 + q, m = it >> 3, h = it & 7; const size_t o = (size_t)m * 512 + h * 64 + F.lane; y[q] = Yb[o]; r[q] = Rb[o]; k[q] = Kb[o]; v[q] = Vb[o]; g[q] = Gb[o]; }
#pragma unroll
        for (int q = 0; q < 4; ++q) { const int it = it0 + q, m = it >> 3, h = it & 7, c = h * 64 + F.lane;
            const float mu = wave_sum64(y[q]) * (1.f / 64.f), dv = y[q] - mu, var = wave_sum64(dv * dv) * (1.f / 64.f), bon = wave_sum64(r[q] * k[q] * rkp[c]);
            ((bf16*)(F.ws + WS_CAT))[(size_t)m * D + 1536 + c] = (bf16)f2bf((dv * rsqrtf(var + 64e-5f) * lgp[c] + lbp[c] + bon * v[q]) * g[q]); }
    }
}
}
namespace mk {
namespace cg = cooperative_groups;
constexpr int LDS_BYTES = 135168;
constexpr int TS_OFF = LDS_BYTES - 64;
#ifdef MK_TS_ID
#ifndef MK_TS_BLOCK
#define MK_TS_BLOCK 0
#endif
#ifndef MK_TS_AMP
#define MK_TS_AMP 8
#endif
#define TSB(id, ldsp) do { if ((id) == MK_TS_ID && blockIdx.x == MK_TS_BLOCK && threadIdx.x == 0) *(volatile LAS unsigned*)((ldsp) + TS_OFF) -= (unsigned)__builtin_amdgcn_s_memrealtime(); } while (0)
#define TSE(id, ldsp) do { if ((id) == MK_TS_ID && blockIdx.x == MK_TS_BLOCK && threadIdx.x == 0) *(volatile LAS unsigned*)((ldsp) + TS_OFF) += (unsigned)__builtin_amdgcn_s_memrealtime(); } while (0)
#else
#define TSB(id, ldsp) do {} while (0)
#define TSE(id, ldsp) do {} while (0)
#endif
constexpr int PH_PRO = 0, PH_ADA = 1, PH_L0 = 2, PH_PER_L = 10, PH_FINAL = PH_L0 + NL * PH_PER_L, N_PHASES = PH_FINAL + 1;
enum { LP_NORM1 = 0, LP_IN, LP_MIX, LP_SCAN, LP_POST, LP_MG, LP_WO, LP_NORM2, LP_GU, LP_DN };

__device__ __forceinline__ void mix_phase(const Frame& F, int l) {
    TSB(40, F.lds);
    for (int u = F.bid; u < 256; u += F.G) rwkv_prep_unit(F, l, u);
    TSE(40, F.lds);
    TSB(44, F.lds); state_outs(F, l); TSE(44, F.lds);
}
enum { CT_SPREP = 0, CT_NSB = 2, CT_MGS = 4, CT_GUS = 6 };
__device__ __forceinline__ unsigned* ctl_word(const Frame& F, int which, int l) { return (unsigned*)(F.ws + WS_CTL) + 64 * (which + l); }
__device__ __forceinline__ void ctl_arrive(const Frame& F, unsigned* w) {
    asm volatile("s_waitcnt vmcnt(0)" ::: "memory"); __syncthreads();
    if (F.tid == 0) { __builtin_amdgcn_fence(__ATOMIC_RELEASE, "agent"); asm volatile("s_waitcnt vmcnt(0)" ::: "memory"); __hip_atomic_fetch_add(w, 1u, __ATOMIC_RELAXED, __HIP_MEMORY_SCOPE_AGENT); }
}
__device__ __forceinline__ void ctl_wait(const Frame& F, unsigned* w, unsigned need) {
    if (F.tid == 0) { unsigned sp = 0; while (__hip_atomic_load(w, __ATOMIC_RELAXED, __HIP_MEMORY_SCOPE_AGENT) < need && ++sp < (1u << 26)) __builtin_amdgcn_s_sleep(8);
        __builtin_amdgcn_fence(__ATOMIC_ACQUIRE, "agent"); asm volatile("s_waitcnt vmcnt(0)" ::: "memory"); }
    __syncthreads();
}
#ifndef SAMPLE_BESIDE_SCAN
#define SAMPLE_BESIDE_SCAN 1
#endif
#ifndef DN_SAMPLE_IN_GU
#define DN_SAMPLE_IN_GU 1
#endif
constexpr int SCAN_BLOCKS = 64;
constexpr int GL_PM_SPLIT = 10;
__device__ __forceinline__ void scan_phase(const Frame& F, int l) {
    if (F.bid < SCAN_BLOCKS) scan_prompt_unit(F, l, F.bid >> 5, (F.bid >> 2) & 7, F.bid & 3);
    else { const int nb_ = F.G - SCAN_BLOCKS, wb = F.bid - SCAN_BLOCKS; const int nw = nb_ * NWAVES;
        if (wb < 4) { rwkv_prep_unit(F, l, 256 + wb); ctl_arrive(F, ctl_word(F, CT_SPREP, l)); }
        TSB(41, F.lds);
        for (int a = wb; a < 256; a += nb_) attn_prompt_unit(F, l, a >> 7, (a >> 2) & 31, a & 3);
        TSE(41, F.lds); TSB(42, F.lds);
        for (int p = (wb + 64) % nb_; p < 260; p += nb_) pool_unit(F, l, p >> 2, p & 3);
        TSE(42, F.lds); TSB(43, F.lds);
        for (int s_ = (wb + 132) % nb_; s_ < 2 * NS; s_ += nb_) attn_sample_unit(F, l, s_ >> 1, s_ & 1);
        TSE(43, F.lds);
        for (int job = 0; job < (SAMPLE_BESIDE_SCAN ? 3 : 1); ++job) {
            Frame Fj = F; int tidj = F.tid; { GAS unsigned char* w_ = (GAS unsigned char*)F.ws; GAS float* o_ = (GAS float*)F.out; asm volatile("" : "+v"(tidj), "+s"(w_), "+s"(o_)); Fj.tid = tidj; Fj.lane = tidj & 63; Fj.ws = (unsigned char*)w_; Fj.out = (float*)o_; }
            Gemm g; g.layer = l; g.ld = D; g.M = MPAD; g.K = D; Sched S; Epi E; E.F = &Fj; E.layer = l;
            if (job == 0) { g.N = NIN; g.A = (const bf16*)(Fj.ws + WS_H); g.Bt = (const bf16*)wl(Fj, l, WL_IN); g.mode = G_IN; S.init(Rect{GL_PM_SPLIT, MPAD / BM - GL_PM_SPLIT, 16, 24}, Rect{0, 0, 0, 0}, nb_, wb, 1); }
            else if (job == 1) { g.N = D; g.A = (const bf16*)(Fj.ws + WS_CAT); g.Bt = (const bf16*)wl(Fj, l, WL_CAT); g.mode = G_MG; S.init(Rect{0, 0, 0, 0}, Rect{MPAD / BM - 1, 1, 0, 32}, 32, wb < 32 ? wb : 1 << 20, 1, 8); }
            else { g.N = D; g.A = (const bf16*)(Fj.ws + WS_MG); g.Bt = (const bf16*)wl(Fj, l, WL_O); g.mode = G_WO; S.init(Rect{0, 0, 0, 0}, Rect{MPAD / BM - 1, 1, 0, 32}, 32, wb < 32 ? wb : 1 << 20, 1, 8);
                if (wb < 32) {
                    ctl_wait(Fj, ctl_word(Fj, CT_MGS, l), 32u);
                    const int ks = wb >> 3; const float* sl = (const float*)(Fj.ws + WS_SLABM); bf16* mg = (bf16*)(Fj.ws + WS_MG) + (size_t)MP * D;
                    for (int i = tidj; i < NS * 128; i += NTHR) { const int r = i >> 7, c = ks * 512 + (i & 127) * 4; const size_t o = (size_t)r * D + c;
                        const f32x4 v = *(const f32x4*)(sl + o) + *(const f32x4*)(sl + (size_t)NS * D + o) + *(const f32x4*)(sl + (size_t)2 * NS * D + o) + *(const f32x4*)(sl + (size_t)3 * NS * D + o);
                        u32x2 w; w.x = cvt_pk_bf16(v.x, v.y); w.y = cvt_pk_bf16(v.z, v.w); *(u32x2*)(mg + o) = w; }
                    asm volatile("s_waitcnt vmcnt(0)" ::: "memory"); __syncthreads(); } }
            E.mode = g.mode;
            TSB(45, F.lds); gemm_phase(Fj.lds, g, S, E, tidj); TSE(45, F.lds);
            if (job == 0) {
                Frame Fp = F; { int t_ = F.tid; GAS unsigned char* w_ = (GAS unsigned char*)F.ws; GAS float* o_ = (GAS float*)F.out; asm volatile("" : "+v"(t_), "+s"(w_), "+s"(o_)); Fp.tid = t_; Fp.lane = t_ & 63; Fp.ws = (unsigned char*)w_; Fp.out = (float*)o_; }
                if (l == 0) { TSB(46, F.lds); p0_prologue(Fp, 2, false, wb, nb_, 0); TSE(46, F.lds); }
                ctl_wait(Fp, ctl_word(Fp, CT_SPREP, l), 4u);
                for (int u = wb * NWAVES + Fp.wave; u < NS * 8; u += nw) scan_sample_wave(Fp, l, u >> 3, u & 7);
                ctl_arrive(Fp, ctl_word(Fp, CT_NSB, l));
                if (SAMPLE_BESIDE_SCAN && wb < 32) ctl_wait(Fp, ctl_word(Fp, CT_NSB, l), (unsigned)nb_);
            } else if (job == 1 && wb < 32) ctl_arrive(Fj, ctl_word(Fj, CT_MGS, l));
        } }
}


#define XB_TMO      128
#define XB_XCNT(j)  (256  + 64 * (j))
#define XB_XSUB(j)  (1280 + 64 * (j))
#define XB_XGEN(j)  (2304 + 64 * (j))
#define XB_TOP      3328
#define XB_TOPGEN   3392
#define XCD_BAR_WORDS 3456
#define XB_SPIN_CAP (1u << 18)

__device__ __forceinline__ unsigned xb_ld(unsigned* p)              { return __hip_atomic_load(p, __ATOMIC_RELAXED, __HIP_MEMORY_SCOPE_AGENT); }
__device__ __forceinline__ unsigned xb_add(unsigned* p, unsigned v) { return __hip_atomic_fetch_add(p, v, __ATOMIC_RELAXED, __HIP_MEMORY_SCOPE_AGENT); }
__device__ __forceinline__ unsigned xb_xcc_id() { return (unsigned)__builtin_amdgcn_s_getreg((3 << 11) | 20) & 0xFu; }
#define XB_SPIN(cond, bar) do { unsigned _sp = 0; while (cond) { __builtin_amdgcn_s_sleep(1); \
    if ((++_sp & 255u) == 0u) { if (xb_ld(&(bar)[XB_TMO])) break; if (_sp > XB_SPIN_CAP) { atomicAdd(&(bar)[XB_TMO], 1u); break; } } } } while (0)

struct XcdBarrier {
    unsigned* bar; unsigned x;
    volatile LAS unsigned* st;
};

__device__ __forceinline__ XcdBarrier xcd_barrier_post(unsigned* bar, volatile LAS unsigned* st) {
    XcdBarrier b; b.bar = bar; b.x = xb_xcc_id(); b.st = st;
    if (threadIdx.x == 0) (void)xb_add(&bar[XB_XCNT(b.x)], 1u);
    return b;
}
__device__ __forceinline__ void xcd_barrier_complete(unsigned* bar, unsigned x, unsigned& nloc, unsigned& nx) {
    const unsigned G = gridDim.x * gridDim.y * gridDim.z;
    unsigned sum, cnt, mine, sp = 0u;
    for (;;) {
        sum = 0u; cnt = 0u; mine = 0u;
#pragma unroll
        for (unsigned j = 0; j < 16; ++j) { const unsigned c = xb_ld(&bar[XB_XCNT(j)]); sum += c; cnt += (c > 0u) ? 1u : 0u; mine = (j == x) ? c : mine; }
        if (sum == G) break;
        __builtin_amdgcn_s_sleep(1);
        if ((++sp & 255u) == 0u) { if (xb_ld(&bar[XB_TMO])) break; if (sp > XB_SPIN_CAP) { atomicAdd(&bar[XB_TMO], 1u); break; } }
    }
    nloc = mine > 0u ? mine : 1u; nx = cnt > 0u ? cnt : 1u;
}

__device__ __forceinline__ void xcd_barrier(const XcdBarrier& b) {
    asm volatile("s_waitcnt vmcnt(0)" ::: "memory");
    __syncthreads();
    if (threadIdx.x == 0) {
        unsigned* bar = b.bar;
        __builtin_amdgcn_s_waitcnt(0);
        unsigned nloc = b.st[0], nx = b.st[1];
        if (nloc == 0u) { xcd_barrier_complete(bar, b.x, nloc, nx); b.st[0] = nloc; b.st[1] = nx; }
        const unsigned old = xb_add(&bar[XB_XSUB(b.x)], 1u);
        const unsigned gen = old / nloc;
        if (old + 1u == (gen + 1u) * nloc) {
            __builtin_amdgcn_fence(__ATOMIC_RELEASE, "agent");
            asm volatile("s_waitcnt vmcnt(0)" ::: "memory");
            const unsigned og = xb_add(&bar[XB_TOP], 1u);
            const unsigned tg = og / nx;
            if (og + 1u == (tg + 1u) * nx) xb_add(&bar[XB_TOPGEN], 1u);
            else XB_SPIN(xb_ld(&bar[XB_TOPGEN]) == tg, bar);
            __builtin_amdgcn_fence(__ATOMIC_ACQUIRE, "agent");
            xb_add(&bar[XB_XGEN(b.x)], 1u);
            asm volatile("s_waitcnt vmcnt(0)" ::: "memory");
        } else {
            XB_SPIN(xb_ld(&bar[XB_XGEN(b.x)]) == gen, bar);
            __builtin_amdgcn_fence(__ATOMIC_ACQUIRE, "agent");
            asm volatile("s_waitcnt vmcnt(0)" ::: "memory");
        }
    }
    __syncthreads();
}


#define MKF() Frame F; { GAS unsigned char* ws_ = (GAS unsigned char*)args.ws; GAS float* out_ = (GAS float*)args.out; int bid_ = blockIdx.x; int G_ = gridDim.x; int wv_ = wave_s; unsigned z_ = 0u; \
            asm volatile("" : "+s"(ws_), "+s"(out_), "+s"(bid_), "+s"(G_), "+s"(wv_), "+s"(z_)); \
            const int tid_ = wv_ * 64 + (int)__builtin_amdgcn_mbcnt_hi(~0u, __builtin_amdgcn_mbcnt_lo(~0u, z_));       \
            F.lds = (LAS unsigned char*)lds_raw; F.tid = tid_; F.lane = tid_ & 63; F.wave = wv_; F.G = G_; F.bid = bid_; F.out = (float*)out_; F.ws = (unsigned char*)ws_; }
__global__ void __launch_bounds__(NTHR, 2) __attribute__((target("no-packed-fp32-ops"))) mega(Args args) {
    extern __shared__ __attribute__((aligned(16))) unsigned char lds_raw[];
    cg::grid_group grid = cg::this_grid();
    const int wave_s = __builtin_amdgcn_readfirstlane((int)threadIdx.x >> 6);
    if (threadIdx.x < 2) ((volatile LAS unsigned*)((LAS unsigned char*)lds_raw + TS_OFF - 64))[threadIdx.x] = 0u;
    asm volatile("s_waitcnt lgkmcnt(0)" ::: "memory"); __builtin_amdgcn_s_barrier(); asm volatile("" ::: "memory");
    const XcdBarrier xbar = xcd_barrier_post((unsigned*)(args.ws + WS_CTL + 4096), (volatile LAS unsigned*)((LAS unsigned char*)lds_raw + TS_OFF - 64));
#ifdef MK_TS_ID
    if (threadIdx.x == 0) *(volatile LAS unsigned*)((LAS unsigned char*)lds_raw + TS_OFF) = 0u;
#endif
    for (int ph = args.ph_lo; ph < args.ph_hi; ++ph) {
        MKF();
        const int l = ph >= PH_L0 && ph < PH_FINAL ? (ph - PH_L0) / PH_PER_L : 0, lp = ph >= PH_L0 && ph < PH_FINAL ? (ph - PH_L0) % PH_PER_L : -1;
        TSB(ph == PH_PRO ? 1 : ph == PH_ADA ? 2 : ph == PH_FINAL ? 3 : 10 + lp, (LAS unsigned char*)lds_raw);
#ifndef MK_NO_PRO
        if (ph == PH_PRO) p0_prologue(F, 0, true, F.bid, F.G, 0); else
#endif
#ifndef MK_NO_NORM
        if (ph == PH_FINAL || lp == LP_NORM1 || lp == LP_NORM2) { norm_phase(F, l, ph == PH_FINAL ? 2 : lp == LP_NORM1 ? 0 : 1, ph == PH_FINAL ? 11 : lp == LP_NORM2 ? 4 : (l > 0 ? 11 : 0)); } else
#endif
#ifndef MK_NO_MIX
        if (lp == LP_MIX) { mix_phase(F, l);
#ifdef MK_DUP_MIX
            __syncthreads(); mix_phase(F, l);
#endif
        } else
#endif
#ifndef MK_NO_SCAN
        if (lp == LP_SCAN) { scan_phase(F, l);
#ifdef MK_DUP_SCAN
            __syncthreads(); scan_phase(F, l);
#endif
        } else
#endif
#ifndef MK_NO_POST
        if (lp == LP_POST) { rwkv_post_phase(F, l); } else
#endif
#ifndef MK_NO_GEMM
        {
            Gemm g; g.layer = l; g.ld = D; g.M = MPAD; g.K = D;
            if (ph == PH_ADA) { g.A = (const bf16*)(F.ws + WS_SILC); g.Bt = (const bf16*)(F.ws + WS_ADAW); g.M = 256; g.N = 2 * NADA; g.mode = G_ADA; }
            else if (lp == LP_IN) { g.A = (const bf16*)(F.ws + WS_H); g.Bt = (const bf16*)wl(F, l, WL_IN); g.N = NIN; g.mode = G_IN; }
            else if (lp == LP_MG) { g.A = (const bf16*)(F.ws + WS_CAT); g.Bt = (const bf16*)wl(F, l, WL_CAT); g.N = D; g.mode = G_MG; }
            else if (lp == LP_WO) { g.A = (const bf16*)(F.ws + WS_MG); g.Bt = (const bf16*)wl(F, l, WL_O); g.N = D; g.mode = G_WO; }
            else if (lp == LP_GU) { g.A = (const bf16*)(F.ws + WS_H); g.Bt = (const bf16*)wl(F, l, WL_GU); g.N = NGU; g.mode = G_GU; }
            else { g.A = (const bf16*)(F.ws + WS_GT); g.Bt = (const bf16*)wl(F, l, WL_DN); g.N = D; g.K = DFF; g.ld = DFF; g.mode = G_DN; }
            Sched S; Epi E; E.F = &F; E.mode = g.mode; E.layer = l;
            if (SAMPLE_BESIDE_SCAN == 0 && g.mode == G_WO && F.bid < 32) {
                const int ks = F.bid >> 3; const float* sl = (const float*)(F.ws + WS_SLABM); bf16* mg = (bf16*)(F.ws + WS_MG) + (size_t)MP * D;
                for (int i = F.tid; i < NS * 128; i += NTHR) { const int r = i >> 7, c = ks * 512 + (i & 127) * 4; const size_t o = (size_t)r * D + c;
                    const f32x4 v = *(const f32x4*)(sl + o) + *(const f32x4*)(sl + (size_t)NS * D + o) + *(const f32x4*)(sl + (size_t)2 * NS * D + o) + *(const f32x4*)(sl + (size_t)3 * NS * D + o);
                    u32x2 w; w.x = cvt_pk_bf16(v.x, v.y); w.y = cvt_pk_bf16(v.z, v.w); *(u32x2*)(mg + o) = w; }
                asm volatile("s_waitcnt vmcnt(0)" ::: "memory"); __syncthreads();
            }
            if (lp == LP_IN && ph != PH_ADA) S.init(Rect{0, MPAD / BM, 0, 16}, Rect{0, GL_PM_SPLIT, 16, 24}, F.G, F.bid, 1);
            else if ((g.mode == G_WO || g.mode == G_MG) && SAMPLE_BESIDE_SCAN == 0) S.init(Rect{0, MPAD / BM - 1, 0, 8}, Rect{MPAD / BM - 1, 1, 0, 32}, F.G, F.bid, 1, 8);
            else if (g.mode == G_DN && DN_SAMPLE_IN_GU == 0) S.init(Rect{0, MPAD / BM - 1, 0, 8}, Rect{MPAD / BM - 1, 1, 0, 88}, F.G, F.bid, 1, 8);
            else if (g.mode == G_WO || g.mode == G_DN || g.mode == G_MG) S.init(Rect{0, MPAD / BM - 1, 0, 8}, Rect{0, 0, 0, 0}, F.G, F.bid, 1);
            else if (g.mode == G_GU) S.init(Rect{MPAD / BM - 1, 1, 0, NGU / BM}, Rect{0, MPAD / BM - 1, 0, NGU / BM}, F.G, F.bid, 1);
            else S.init(Rect{0, g.M / BM, 0, g.N / BM}, Rect{0, 0, 0, 0}, F.G, F.bid, 1);
            const bool gu = g.mode == G_GU && DN_SAMPLE_IN_GU != 0;
            for (int sub = 0; sub < (gu ? 2 : 1); ++sub) {
                if (sub == 1) {
                    constexpr int nfree = 256 - (1452 - 5 * 256); const int fb = F.bid - (F.G - nfree); const bool std_grid = F.G == 256;
                    g.ld = DFF; g.K = DFF; g.N = D; g.A = (const bf16*)(F.ws + WS_GT); g.Bt = (const bf16*)wl(F, l, WL_DN); g.mode = G_DN; E.mode = G_DN;
                    if (std_grid) S.init(Rect{0, 0, 0, 0}, Rect{MPAD / BM - 1, 1, 0, 88}, nfree, fb >= 0 ? fb : 1 << 20, 1, 8); else S.init(Rect{0, 0, 0, 0}, Rect{MPAD / BM - 1, 1, 0, 88}, F.G, F.bid, 1, 8);
                    if (!std_grid || fb >= 0) ctl_wait(F, ctl_word(F, CT_GUS, l), 44u * 8u);
                }
                gemm_phase(F.lds, g, S, E, F.tid);
            }
            if (ph == PH_ADA) { if (F.bid < 96) p0_prologue(F, 1, false, F.bid, 96, 2); else p0_prologue(F, 1, false, F.bid - 96, F.G - 96, 1); }
        }
#else
        {}
#endif
        TSE(ph == PH_PRO ? 1 : ph == PH_ADA ? 2 : ph == PH_FINAL ? 3 : 10 + lp, (LAS unsigned char*)lds_raw);
        TSB(30, (LAS unsigned char*)lds_raw);
        if (ph + 1 < args.ph_hi) { if (args.ph_hi < 0) grid.sync();   else xcd_barrier(xbar); }
        TSE(30, (LAS unsigned char*)lds_raw);
    }
#ifdef MK_EXTRA_SYNCS
    for (int i = 0; i < MK_EXTRA_SYNCS; ++i) xcd_barrier(xbar);
#endif
#ifdef MK_TS_ID
    if (blockIdx.x == MK_TS_BLOCK && threadIdx.x == 0) { const unsigned want = *(volatile LAS unsigned*)((LAS unsigned char*)lds_raw + TS_OFF) * (unsigned)MK_TS_AMP; const unsigned t0 = (unsigned)__builtin_amdgcn_s_memrealtime();
        while ((unsigned)__builtin_amdgcn_s_memrealtime() - t0 < want) __builtin_amdgcn_s_sleep(32); }
#endif
}
}
#ifndef MK_DEBUG
#define MK_DEBUG 0
#endif
extern "C" void kernel_launch(void* const* d_in, const int* in_sizes, int n_in, void* d_out, int out_size, void* d_ws, size_t ws_size, hipStream_t stream) {
    using namespace mk;
    static int grid = 0;
    if (grid == 0) {
        nv::WS wtmp; const size_t need_nv = nv::carve((float*)d_ws, wtmp) * 4; const size_t need = MK_DEBUG ? (need_nv > WS_END ? need_nv : WS_END) + (16u << 20) : WS_END;
        if (n_in != 39 || (size_t)out_size != O_END || ws_size < need) { fprintf(stderr, "kernel_launch: unexpected shapes: n_in %d out %d (want %zu) ws %zu (need %zu)\n", n_in, out_size, (size_t)O_END, ws_size, need); grid = -1; return; }
        int dev = 0, cus = 0, per_cu = 0;
        if (hipGetDevice(&dev) != hipSuccess || hipDeviceGetAttribute(&cus, hipDeviceAttributeMultiprocessorCount, dev) != hipSuccess) { grid = -1; return; }
        if (hipFuncSetAttribute((const void*)mega, hipFuncAttributeMaxDynamicSharedMemorySize, LDS_BYTES) != hipSuccess) { fprintf(stderr, "kernel_launch: hipFuncSetAttribute failed\n"); grid = -1; return; }
        if (hipOccupancyMaxActiveBlocksPerMultiprocessor(&per_cu, (const void*)mega, NTHR, LDS_BYTES) != hipSuccess || per_cu < 1) { fprintf(stderr, "kernel_launch: occupancy query says %d blocks per CU\n", per_cu); per_cu = 1; }
        (void)hipGetLastError();
        grid = cus;
        fprintf(stderr, "kernel_launch: grid %d (cus %d, per_cu %d), ws %zu need %zu\n", grid, cus, per_cu, ws_size, need);
    }
    if (grid < 0) return;
    Args a{};
    for (int i = 0; i < 39; ++i) a.in[i] = (const float*)d_in[i];
    a.out = (float*)d_out; a.ws = (unsigned char*)d_ws;
    if (hipMemsetAsync((unsigned char*)d_ws + WS_CTL, 0, WS_CTL_BYTES, stream) != hipSuccess) { fprintf(stderr, "kernel_launch: hipMemsetAsync of the control words failed\n"); return; }
#if MK_DEBUG
    dbg::Ctx dc; dc.probes = (float*)((unsigned char*)d_ws + ((ws_size - (12u << 20)) & ~(size_t)255)); dc.err = dc.probes + (size_t)dbg::NIDS * dbg::NPROBE; dc.on = 1;
    (void)hipMemsetAsync(dc.err, 0, dbg::NIDS * 4 * sizeof(float), stream);
    unsigned char* ws = (unsigned char*)d_ws;
    for (int ph = 0; ph < N_PHASES; ++ph) {
        a.ph_lo = ph; a.ph_hi = ph + 1;
        hipLaunchKernelGGL(mega, dim3(grid), dim3(NTHR), LDS_BYTES, stream, a);
        using namespace dbg;
        const int l = ph >= PH_L0 && ph < PH_FINAL ? (ph - PH_L0) / PH_PER_L : 0, lp = ph >= PH_L0 && ph < PH_FINAL ? (ph - PH_L0) % PH_PER_L : -1, tb = T_L0 + l * T_PER_L;
        if (ph == PH_ADA) save(&dc, stream, T_MOD, ws + WS_MOD, K_F32, NADA, 0, NL * NMOD, NADA);
        if (lp == LP_NORM1) save(&dc, stream, tb + T_H1, ws + WS_H, K_BF16, D, 0, M, D);
        if (lp == LP_IN) { save(&dc, stream, tb + T_Q, ws + WS_Q, K_QPERM, 1024, 0, M, 1024); save(&dc, stream, tb + T_K, ws + WS_K, K_QPERM, 256, 0, M, 256); save(&dc, stream, tb + T_V, ws + WS_V, K_BF16, 256, 0, M, 256);
            save(&dc, stream, tb + T_U, ws + WS_U, K_F32, 512, 0, M, 512); save(&dc, stream, tb + T_PR, ws + WS_PR, K_F32, 2048, 0, M, RP); }
        if (lp == LP_SCAN) { save(&dc, stream, tb + T_OA, ws + WS_CAT, K_BF16, D, 0, M, 1024); save(&dc, stream, tb + T_ZP, ws + WS_CAT, K_BF16, D, 1024, M, 512); }
        if (lp == LP_SCAN) {
            for (int i = 0; i < 7; ++i) save(&dc, stream, tb + T_R + i, ws + WS_RW + (size_t)i * RW_STRIDE, K_F32, 512, 0, M, 512);
            if (l == 1) { save(&dc, stream, 59, ws + WS_RW + (size_t)RW_Y * RW_STRIDE, K_F32, 512, 0, M, 512); save(&dc, stream, 60, ws + WS_H, K_F32, 32, 0, M, 32); } }
        if (lp == LP_SCAN) save(&dc, stream, tb + T_GT, ws + WS_GT, K_BF16, 6144, 0, M, 6144);
        if (lp == LP_SCAN) save(&dc, stream, tb + T_Y, ws + WS_RW + (size_t)RW_Y * RW_STRIDE, K_F32, 512, 0, M, 512);
        if (lp == LP_POST) save(&dc, stream, tb + T_YR, ws + WS_CAT, K_BF16, D, 1536, M, 512);
        if (lp == LP_MG) save(&dc, stream, tb + T_MG, ws + WS_MG, K_BF16, D, 0, M, D);
        if (lp == LP_NORM2) { save(&dc, stream, tb + T_X1, ws + WS_X, K_F32, D, 0, M, D); save(&dc, stream, tb + T_H2, ws + WS_H, K_BF16, D, 0, M, D); }
        if (lp == LP_GU) save(&dc, stream, tb + T_ACT, ws + WS_GT, K_BF16, DFF, 0, M, DFF);
        if ((lp == LP_NORM1 && l > 0) || ph == PH_FINAL) save(&dc, stream, T_L0 + (ph == PH_FINAL ? 1 : l - 1) * T_PER_L + T_X2, ws + WS_X, K_F32, D, 0, M, D);
    }
    const size_t ooff[13] = {O_YP, O_YS, O_KP, O_VP, O_PP, O_SP, O_WP, O_KS, O_VS, O_PS, O_SS, O_WS, O_END}; const int ocol[12] = {2048, 2048, 256, 256, 512, 1984, 64, 256, 256, 512, 1984, 64};
    for (int i = 0; i < 12; ++i) dbg::save(&dc, stream, dbg::T_OUT0 + i, (float*)d_out + ooff[i], dbg::K_F32, ocol[i], 0, (int)((ooff[i + 1] - ooff[i]) / ocol[i]), ocol[i]);
    nv::In in; for (int i = 0; i < 39; ++i) in.p[i] = (const float*)d_in[i];
    nv::forward(in, (float*)d_out, (float*)d_ws, stream, &dc);
    for (int i = 0; i < 12; ++i) dbg::cmp(&dc, stream, dbg::T_OUT0 + i, (float*)d_out + ooff[i], ocol[i], 0, (int)((ooff[i + 1] - ooff[i]) / ocol[i]), ocol[i]);
#ifndef DBG_WANT_ID
#define DBG_WANT_ID -1
#endif
    dbg::inject<<<1, 1, 0, stream>>>(dc.err, (float*)d_out, (float*)d_out + O_YS, DBG_WANT_ID >= 0 ? dbg::NIDS : dbg::T_N, DBG_WANT_ID);
#else
    a.ph_lo = 0; a.ph_hi = N_PHASES;
    void* kargs[] = {&a};
    const hipError_t e = hipLaunchCooperativeKernel((const void*)mega, dim3(grid), dim3(NTHR), kargs, LDS_BYTES, stream);
    if (e != hipSuccess) fprintf(stderr, "kernel_launch: cooperative launch failed: %s (grid %d)\n", hipGetErrorString(e), grid);
#endif
}
```

```cpp
#define MK_DEBUG 0
#define SAMPLE_BESIDE_SCAN 2
#include <hip/hip_runtime.h>
#include <hip/hip_cooperative_groups.h>
#include <cstdio>
#include <cstdint>
namespace dbg {
constexpr int NPROBE = 16384, NSPECIAL = 2048, NIDS = 64;
struct Ctx { float* probes; float* err; int on; };
__device__ __forceinline__ unsigned hash32(unsigned x) { x ^= x >> 16; x *= 0x7feb352dU; x ^= x >> 15; x *= 0x846ca68bU; x ^= x >> 16; return x; }
__device__ __forceinline__ void probe_rc(int id, int k, int R, int C, int& r, int& c) {
    const unsigned h1 = hash32((unsigned)(id * 1000003 + k * 2 + 1)), h2 = hash32((unsigned)(id * 7919 + k * 2 + 77777));
    c = (int)(h2 % (unsigned)C);
    if (R == 8320 && k < NSPECIAL) { const int sp[16] = {0, 1, 15, 16, 127, 128, 129, 4095, 4096, 4097, 8190, 8191, 8192, 8193, 8255, 8319}; r = sp[k >> 7]; }
    else r = (int)(h1 % (unsigned)R);
}
enum { K_F32 = 0, K_BF16 = 1, K_QPERM = 2 };
__device__ __forceinline__ float opt_read(const void* p, int kind, size_t ld, int coff, int r, int c) {
    if (kind == K_F32) return ((const float*)p)[(size_t)r * ld + coff + c];
    if (kind == K_QPERM) { const int h = c >> 6, d = c & 63, pp = 32 * ((d >> 4) & 1) + 8 * ((d >> 2) & 3) + 4 * (d >> 5) + (d & 3); c = h * 64 + pp; }
    const unsigned short b = ((const unsigned short*)p)[(size_t)r * ld + coff + c]; return __builtin_bit_cast(float, (unsigned)b << 16);
}
__global__ void probe_save(float* probes, int id, const void* p, int kind, size_t ld, int coff, int R, int C) {
    const int k = blockIdx.x * blockDim.x + threadIdx.x; if (k >= NPROBE) return; int r, c; probe_rc(id, k, R, C, r, c);
    probes[(size_t)id * NPROBE + k] = opt_read(p, kind, ld, coff, r, c);
}
__global__ void probe_cmp(const float* probes, float* err, int id, const float* gold, size_t ld, int coff, int R, int C, int sig) {
    const int k = blockIdx.x * blockDim.x + threadIdx.x; if (k >= NPROBE) return; int r, c; probe_rc(id, k, R, C, r, c);
    float g = gold[(size_t)r * ld + coff + c]; if (sig) g = 1.f / (1.f + expf(-g));
    float o = probes[(size_t)id * NPROBE + k]; float d = o - g; if (!(d == d) || fabsf(d) > 1e18f) d = 1e18f;
    const int sp = (R == 8320 && k < NSPECIAL) ? 0 : 2;
    atomicAdd(&err[id * 4 + sp], d * d); atomicAdd(&err[id * 4 + sp + 1], g * g);
}
__global__ void inject(const float* err, float* out, float* ys, int nids, int want_id) {
    if (threadIdx.x || blockIdx.x) return;
    int rid = 89, which = 0; float rel = 1e-3f;
    for (int id = 0; id < nids; ++id) {
        const float r_rand = sqrtf(err[id * 4 + 2] / fmaxf(err[id * 4 + 3], 1e-30f)), r_sp = err[id * 4 + 1] > 0.f ? sqrtf(err[id * 4 + 0] / fmaxf(err[id * 4 + 1], 1e-30f)) : 0.f;
        if (want_id >= 0) { if (id == want_id) { rid = id; which = 0; rel = r_rand; break; } continue; }
        if (r_rand > 0.05f) { rid = id; which = 0; rel = r_rand; break; } else if (r_sp > 0.10f) { rid = id; which = 1; rel = r_sp; break; } }
    const float c1 = (float)(10 + rid) * (which ? 1e5f : 1e3f); float f = (log10f(fmaxf(rel, 1e-3f)) + 3.f) * 0.25f; f = fminf(fmaxf(f, 0.f), 1.f);
    out[0] = c1; ys[0] = c1 * (0.2f + 0.6f * f);
}
inline void save(const Ctx* c, hipStream_t st, int id, const void* p, int kind, size_t ld, int coff, int R, int C) { if (c && c->on) probe_save<<<NPROBE / 256, 256, 0, st>>>(c->probes, id, p, kind, ld, coff, R, C); }
inline void cmp(const Ctx* c, hipStream_t st, int id, const float* gold, size_t ld, int coff, int R, int C, int sig = 0) { if (c && c->on) probe_cmp<<<NPROBE / 256, 256, 0, st>>>(c->probes, c->err, id, gold, ld, coff, R, C, sig); }
enum { T_MOD = 0, T_L0 = 1, T_PER_L = 23, T_OUT0 = T_L0 + 2 * T_PER_L, T_N = T_OUT0 + 12 };
enum { T_H1 = 0, T_Q, T_K, T_V, T_U, T_PR, T_GT, T_OA, T_ZP, T_R, T_W, T_KK, T_VV, T_A, T_B, T_G, T_Y, T_YR, T_MG, T_X1, T_H2, T_ACT, T_X2 };
}
namespace nv {
constexpr int D = 2048, SEQ = 4096, NB = 2, MP = NB * SEQ, NS = 128, M = MP + NS, NL = 2;
constexpr int INW = 10176, OQ = 0, OK_ = 1024, OV = 1280, OU = 1536, OPR = 2048, OGL = 4032;
constexpr int RP = 1984, DFF = 5632, NMOD = NB + NS;
constexpr int PASTLEN = 8192;

__device__ __forceinline__ float sigm(float x) { return 1.f / (1.f + expf(-x)); }
__device__ __forceinline__ float silu(float x) { return x / (1.f + expf(-x)); }
__device__ __forceinline__ int modrow(int m) { return m < MP ? m / SEQ : NB + (m - MP); }
__device__ __forceinline__ int posof(int m) { return m < MP ? m % SEQ : PASTLEN; }

__global__ void __launch_bounds__(256) gemm(const float* __restrict__ A, int lda, const float* __restrict__ B, int ldb, float* __restrict__ C, int ldc, int Mm, int N, int K) {
    __shared__ float As[16][68], Bs[16][68];
    const int tx = threadIdx.x & 15, ty = threadIdx.x >> 4, m0 = blockIdx.y * 64, n0 = blockIdx.x * 64;
    float acc[4][4];
#pragma unroll
    for (int i = 0; i < 4; ++i)
#pragma unroll
        for (int j = 0; j < 4; ++j) acc[i][j] = 0.f;
    for (int k0 = 0; k0 < K; k0 += 16) {
        for (int i = threadIdx.x; i < 1024; i += 256) { const int r = i >> 4, c = i & 15; As[c][r] = (m0 + r < Mm) ? A[(size_t)(m0 + r) * lda + k0 + c] : 0.f; }
        for (int i = threadIdx.x; i < 1024; i += 256) { const int r = i >> 6, c = i & 63; Bs[r][c] = (n0 + c < N) ? B[(size_t)(k0 + r) * ldb + n0 + c] : 0.f; }
        __syncthreads();
#pragma unroll
        for (int kk = 0; kk < 16; ++kk) {
            float a[4], b[4];
#pragma unroll
            for (int i = 0; i < 4; ++i) { a[i] = As[kk][ty * 4 + i]; b[i] = Bs[kk][tx * 4 + i]; }
#pragma unroll
            for (int i = 0; i < 4; ++i)
#pragma unroll
                for (int j = 0; j < 4; ++j) acc[i][j] += a[i] * b[j];
        }
        __syncthreads();
    }
#pragma unroll
    for (int i = 0; i < 4; ++i)
#pragma unroll
        for (int j = 0; j < 4; ++j) { const int m = m0 + ty * 4 + i, n = n0 + tx * 4 + j; if (m < Mm && n < N) C[(size_t)m * ldc + n] = acc[i][j]; }
}

__global__ void silu_c(const float* cp, const float* cs, float* out) {
    const int i = blockIdx.x * blockDim.x + threadIdx.x; if (i >= NMOD * D) return;
    const int r = i / D, k = i % D; const float c = r < NB ? cp[r * D + k] : cs[(r - NB) * D + k]; out[i] = silu(c);
}
__global__ void add_bias(float* mod, const float* b, int n, int N) { const int i = blockIdx.x * blockDim.x + threadIdx.x; if (i < n) mod[i] += b[i % N]; }

__global__ void __launch_bounds__(256) modnorm(const float* xa, const float* xb, const float* g, const float* mod, int sh_off, int sc_off, float* out, size_t out_split_off) {
    const int m = blockIdx.x; const float* x = m < MP ? xa + (size_t)m * D : xb + (size_t)(m - MP) * D;
    __shared__ float red[256]; float s = 0.f;
    for (int k = threadIdx.x; k < D; k += 256) { const float v = x[k]; s += v * v; }
    red[threadIdx.x] = s; __syncthreads();
    for (int o = 128; o > 0; o >>= 1) { if (threadIdx.x < o) red[threadIdx.x] += red[threadIdx.x + o]; __syncthreads(); }
    const float rs = rsqrtf(red[0] / D + 1e-6f); const int br = modrow(m);
    float* o = m < MP ? out + (size_t)m * D : out + out_split_off + (size_t)(m - MP) * D;
    for (int k = threadIdx.x; k < D; k += 256) { float v = x[k] * rs * g[k]; if (mod) v = v * (1.f + mod[(size_t)br * 6 * D + sc_off + k]) + mod[(size_t)br * 6 * D + sh_off + k]; o[k] = v; }
}

__global__ void rope(float* z) {
    const int i = blockIdx.x * blockDim.x + threadIdx.x; if (i >= M * 20 * 32) return;
    const int m = i / 640, hh = (i / 32) % 20, d = i % 32; const float pos = (float)posof(m);
    const float inv = powf(10000.f, -(float)d * 2.0f / 64.f), ang = pos * inv, c = cosf(ang), s = sinf(ang);
    float* p = z + (size_t)m * INW + hh * 64; const float x1 = p[d], x2 = p[d + 32]; p[d] = x1 * c - x2 * s; p[d + 32] = x2 * c + x1 * s;
}

__global__ void attn_prompt(const float* z, const float* sink, float* oattn) {
    const int i = blockIdx.x * blockDim.x + threadIdx.x; if (i >= MP * 16) return;
    const int m = i / 16, hq = i % 16, hk = hq / 4, t = m % SEQ; const float* q = z + (size_t)m * INW + OQ + hq * 64;
    const int lo = t - 128 < 0 ? 0 : t - 128; const float sk = sink[hq];
    float mx = sk;
    for (int kp = lo; kp <= t; ++kp) { const float* k = z + (size_t)(m - t + kp) * INW + OK_ + hk * 64; float s = 0.f; for (int d = 0; d < 64; ++d) s += q[d] * k[d]; s *= 0.125f; mx = fmaxf(mx, s); }
    float den = expf(sk - mx); float o[64];
#pragma unroll
    for (int d = 0; d < 64; ++d) o[d] = 0.f;
    for (int kp = lo; kp <= t; ++kp) { const float* k = z + (size_t)(m - t + kp) * INW + OK_ + hk * 64; const float* v = z + (size_t)(m - t + kp) * INW + OV + hk * 64; float s = 0.f; for (int d = 0; d < 64; ++d) s += q[d] * k[d]; s *= 0.125f;
        const float p = expf(s - mx); den += p;
#pragma unroll
        for (int d = 0; d < 64; ++d) o[d] += p * v[d]; }
#pragma unroll
    for (int d = 0; d < 64; ++d) oattn[(size_t)m * 1024 + hq * 64 + d] = o[d] / den;
}
__global__ void attn_sample(const float* z, const float* sink, const float* ck, const float* cv, float* oattn) {
    const int i = blockIdx.x * blockDim.x + threadIdx.x; if (i >= NS * 16) return;
    const int s_ = i / 16, hq = i % 16, hk = hq / 4, m = MP + s_; const float* q = z + (size_t)m * INW + OQ + hq * 64; const float sk = sink[hq];
    float mx = sk;
    for (int j = 0; j <= 128; ++j) { const float* k = j < 128 ? ck + ((size_t)(s_ * 128 + j) * 4 + hk) * 64 : z + (size_t)m * INW + OK_ + hk * 64; float s = 0.f; for (int d = 0; d < 64; ++d) s += q[d] * k[d]; s *= 0.125f; mx = fmaxf(mx, s); }
    float den = expf(sk - mx); float o[64];
#pragma unroll
    for (int d = 0; d < 64; ++d) o[d] = 0.f;
    for (int j = 0; j <= 128; ++j) { const float* k = j < 128 ? ck + ((size_t)(s_ * 128 + j) * 4 + hk) * 64 : z + (size_t)m * INW + OK_ + hk * 64;
        const float* v = j < 128 ? cv + ((size_t)(s_ * 128 + j) * 4 + hk) * 64 : z + (size_t)m * INW + OV + hk * 64; float s = 0.f; for (int d = 0; d < 64; ++d) s += q[d] * k[d]; s *= 0.125f;
        const float p = expf(s - mx); den += p;
#pragma unroll
        for (int d = 0; d < 64; ++d) o[d] += p * v[d]; }
#pragma unroll
    for (int d = 0; d < 64; ++d) oattn[(size_t)m * 1024 + hq * 64 + d] = o[d] / den;
}
__global__ void kv_out(const float* z, const float* ck, const float* cv, float* kp, float* vp, float* ks, float* vs) {
    const int i = blockIdx.x * blockDim.x + threadIdx.x;
    if (i < NB * 128 * 256) { const int b = i / (128 * 256), j = (i / 256) % 128, c = i % 256; const size_t m = (size_t)b * SEQ + SEQ - 128 + j; kp[i] = z[m * INW + OK_ + c]; vp[i] = z[m * INW + OV + c]; }
    if (i < NS * 128 * 256) { const int s_ = i / (128 * 256), j = (i / 256) % 128, c = i % 256;
        if (j < 127) { ks[i] = ck[i + 256]; vs[i] = cv[i + 256]; } else { ks[i] = z[(size_t)(MP + s_) * INW + OK_ + c]; vs[i] = z[(size_t)(MP + s_) * INW + OV + c]; } }
}
__global__ void pool_d(const float* z, const float* spool, float* dbuf) {
    const int i = blockIdx.x * blockDim.x + threadIdx.x; if (i >= M * 512) return;
    const int m = i / 512, c = i % 512, gi = c / 128, w = 2 << gi; float sum = 0.f; float cnt;
    if (m < MP) { const int t = m % SEQ; for (int j = 0; j < w; ++j) if (t - j >= 0) sum += z[(size_t)(m - j) * INW + OU + c]; cnt = (float)(t + 1 < w ? t + 1 : w); }
    else { const int s_ = m - MP; sum = z[(size_t)m * INW + OU + c]; for (int j = 1; j < w; ++j) sum += spool[((size_t)s_ * 15 + 15 - j) * 512 + c]; cnt = (float)w; }
    dbuf[i] = sum / cnt - z[(size_t)m * INW + OU + c];
}
__global__ void pool_z(const float* dbuf, const float* pw, const float* pscale, float* zpool) {
    const int i = blockIdx.x * blockDim.x + threadIdx.x; if (i >= M * 512) return;
    const int m = i / 512, c = i % 512, gi = c / 128, e = c % 128; float s = 0.f;
    for (int k = 0; k < 128; ++k) s += dbuf[(size_t)m * 512 + gi * 128 + k] * pw[(gi * 128 + k) * 128 + e];
    zpool[i] = s * pscale[c];
}
__global__ void pool_out(const float* z, const float* spool, float* pp, float* ps) {
    const int i = blockIdx.x * blockDim.x + threadIdx.x;
    if (i < NB * 15 * 512) { const int b = i / (15 * 512), j = (i / 512) % 15, c = i % 512; pp[i] = z[((size_t)b * SEQ + SEQ - 15 + j) * INW + OU + c]; }
    if (i < NS * 15 * 512) { const int s_ = i / (15 * 512), j = (i / 512) % 15, c = i % 512; ps[i] = j < 14 ? spool[i + 512] : z[(size_t)(MP + s_) * INW + OU + c]; }
}
__global__ void rwkv_xm(const float* z, const float* sshift, const float* mu, float* xm) {
    const int i = blockIdx.x * blockDim.x + threadIdx.x; if (i >= M * RP) return;
    const int m = i / RP, c = i % RP; const float p = z[(size_t)m * INW + OPR + c]; float pv;
    if (m < MP) pv = (m % SEQ) ? z[(size_t)(m - 1) * INW + OPR + c] : 0.f; else pv = sshift[(size_t)(m - MP) * RP + c];
    xm[i] = p + (pv - p) * mu[c];
}
__global__ void shift_out(const float* z, float* sp, float* ss) {
    const int i = blockIdx.x * blockDim.x + threadIdx.x;
    if (i < NB * RP) { const int b = i / RP, c = i % RP; sp[i] = z[((size_t)b * SEQ + SEQ - 1) * INW + OPR + c]; }
    if (i < NS * RP) { const int s_ = i / RP, c = i % RP; ss[i] = z[(size_t)(MP + s_) * INW + OPR + c]; }
}
__global__ void __launch_bounds__(64) rwkv_prep(const float* xm, const float* w0, const float* w2, const float* a0, const float* a2, const float* g2, const float* k_k, const float* k_a,
                                                 const float* T2, const float* vb, float* vfirst, int has_vres,
                                                 float* R, float* W, float* Kk, float* V, float* A, float* Bb, float* G) {
    const int m = blockIdx.x / 8, h = blockIdx.x % 8, c = h * 64 + threadIdx.x; const float* x = xm + (size_t)m * RP;
    float s = w0[c]; for (int k = 0; k < 96; ++k) s += tanhf(x[1536 + k]) * w2[k * 512 + c];
    const float z_ = -s; const float sp = z_ > 20.f ? z_ : log1pf(expf(z_)); const float wlog = -sp - 0.5f; const float decay = expf(-expf(wlog));
    float sa = a0[c]; for (int k = 0; k < 96; ++k) sa += x[1632 + k] * a2[k * 512 + c]; const float a = sigm(sa);
    float g = 0.f; for (int k = 0; k < 256; ++k) g += sigm(x[1728 + k]) * g2[k * 512 + c];
    float v = x[1024 + c];
    if (!has_vres) vfirst[(size_t)m * 512 + c] = v;
    else { const float acc = vb[c] + T2[(size_t)m * 512 + c]; v = v + (vfirst[(size_t)m * 512 + c] - v) * sigm(acc); }
    const float r = x[c], k = x[512 + c]; float kk = k * k_k[c];
    __shared__ float red[64]; red[threadIdx.x] = kk * kk; __syncthreads();
    for (int o = 32; o > 0; o >>= 1) { if (threadIdx.x < o) red[threadIdx.x] += red[threadIdx.x + o]; __syncthreads(); }
    kk = kk / fmaxf(sqrtf(red[0]), 1e-12f); const float k2 = k * (1.f + (a - 1.f) * k_a[c]);
    const size_t o = (size_t)m * 512 + c; R[o] = r; W[o] = decay; Kk[o] = k2; V[o] = v; A[o] = -kk; Bb[o] = kk * a; G[o] = g;
}
__global__ void __launch_bounds__(64) rwkv_scan(const float* R, const float* W, const float* Kk, const float* V, const float* A, const float* Bb, const float* S0, float* Sout, float* Y, int row0, int T) {
    const int seq = blockIdx.x / 8, h = blockIdx.x % 8, i = threadIdx.x; float S[64];
#pragma unroll
    for (int j = 0; j < 64; ++j) S[j] = S0 ? S0[(((size_t)seq * 8 + h) * 64 + i) * 64 + j] : 0.f;
    __shared__ float sr[16][64], sw[16][64], sk[16][64], sa[16][64], sb[16][64], sv[16][64];
    for (int t0 = 0; t0 < T; t0 += 16) { const int nt = T - t0 < 16 ? T - t0 : 16;
        __syncthreads();
        for (int tt = 0; tt < nt; ++tt) { const size_t o = ((size_t)row0 + (size_t)seq * T + t0 + tt) * 512 + h * 64 + i; sr[tt][i] = R[o]; sw[tt][i] = W[o]; sk[tt][i] = Kk[o]; sa[tt][i] = A[o]; sb[tt][i] = Bb[o]; sv[tt][i] = V[o]; }
        __syncthreads();
        for (int tt = 0; tt < nt; ++tt) { float dot = 0.f; const float v = sv[tt][i];
#pragma unroll
            for (int j = 0; j < 64; ++j) dot += S[j] * sa[tt][j];
            float y = 0.f;
#pragma unroll
            for (int j = 0; j < 64; ++j) { S[j] = S[j] * sw[tt][j] + dot * sb[tt][j] + v * sk[tt][j]; y += S[j] * sr[tt][j]; }
            Y[((size_t)row0 + (size_t)seq * T + t0 + tt) * 512 + h * 64 + i] = y; } }
#pragma unroll
    for (int j = 0; j < 64; ++j) Sout[(((size_t)seq * 8 + h) * 64 + i) * 64 + j] = S[j];
}
__global__ void __launch_bounds__(64) rwkv_post(const float* Y, const float* R, const float* Kk, const float* V, const float* G, const float* r_k, const float* lg, const float* lb, float* yout) {
    const int m = blockIdx.x / 8, h = blockIdx.x % 8, i = threadIdx.x, c = h * 64 + i; const size_t o = (size_t)m * 512 + c;
    __shared__ float red[64]; const float y = Y[o];
    red[i] = y; __syncthreads(); for (int s = 32; s > 0; s >>= 1) { if (i < s) red[i] += red[i + s]; __syncthreads(); } const float mu = red[0] / 64.f; __syncthreads();
    red[i] = (y - mu) * (y - mu); __syncthreads(); for (int s = 32; s > 0; s >>= 1) { if (i < s) red[i] += red[i + s]; __syncthreads(); } const float var = red[0] / 64.f; __syncthreads();
    red[i] = R[o] * Kk[o] * r_k[c]; __syncthreads(); for (int s = 32; s > 0; s >>= 1) { if (i < s) red[i] += red[i + s]; __syncthreads(); } const float bon = red[0];
    yout[o] = ((y - mu) * rsqrtf(var + 64e-5f) * lg[c] + lb[c] + bon * V[o]) * G[o];
}
__global__ void merge_acc(const float* z, const float* P, int goff, float* merged, int first) {
    const int i = blockIdx.x * blockDim.x + threadIdx.x; if (i >= M * D) return; const int m = i / D, n = i % D;
    const float v = sigm(z[(size_t)m * INW + OGL + goff + n]) * P[i]; merged[i] = first ? v : merged[i] + v;
}
__global__ void resid(const float* xa, const float* xb, const float* P, const float* mod, int gt_off, float* xout) {
    const int i = blockIdx.x * blockDim.x + threadIdx.x; if (i >= M * D) return; const int m = i / D, n = i % D;
    const float x = m < MP ? xa[i] : xb[(size_t)(m - MP) * D + n]; xout[i] = x + (1.f + mod[(size_t)modrow(m) * 6 * D + gt_off + n]) * P[i];
}
__global__ void swiglu(const float* gbuf, const float* ubuf, float* act, int n) { const int i = blockIdx.x * blockDim.x + threadIdx.x; if (i < n) act[i] = silu(gbuf[i]) * ubuf[i]; }

struct In { const float* p[39]; };
inline void G(hipStream_t st, const float* A, int lda, const float* B, int ldb, float* C, int ldc, int Mm, int N, int K) { gemm<<<dim3((N + 63) / 64, (Mm + 63) / 64), 256, 0, st>>>(A, lda, B, ldb, C, ldc, Mm, N, K); }
#define EW(n) ((int)(((size_t)(n) + 255) / 256)), 256, 0, st

struct WS { float *silc, *mod, *h, *z, *xm, *R, *W, *K, *V, *A, *B, *G, *Y, *vfirst, *dbuf, *cat_a, *cat_p, *cat_r, *P, *merged, *x1, *xres, *fg, *fu, *T1; };
inline size_t carve(float* base, WS& w) {
    size_t o = 0; auto take = [&](size_t n) { float* p = base + o; o += (n + 63) & ~(size_t)63; return p; };
    w.silc = take((size_t)NMOD * D); w.mod = take((size_t)NL * NMOD * 6 * D); w.T1 = take((size_t)M * 32);
    w.h = take((size_t)M * D); w.P = w.h;
    w.xm = take((size_t)M * D); w.x1 = w.xm;
    w.cat_a = take((size_t)M * 1024); w.cat_p = take((size_t)M * 512); w.cat_r = take((size_t)M * 512); w.xres = take((size_t)M * D);
    w.z = take((size_t)M * INW);
    w.R = take((size_t)M * 512); w.W = take((size_t)M * 512); w.K = take((size_t)M * 512); w.V = take((size_t)M * 512); w.A = take((size_t)M * 512); w.B = take((size_t)M * 512); w.G = take((size_t)M * 512);
    w.Y = take((size_t)M * 512); w.vfirst = take((size_t)M * 512); w.dbuf = take((size_t)M * 512);
    w.merged = w.R;
    w.fg = w.z; w.fu = w.z + (size_t)M * DFF;
    return o;
}
constexpr size_t O_YP = 0, O_YS = O_YP + (size_t)MP * D, O_KP = O_YS + (size_t)NS * D, O_VP = O_KP + (size_t)NL * NB * 128 * 256, O_PP = O_VP + (size_t)NL * NB * 128 * 256,
                 O_SP = O_PP + (size_t)NL * NB * 15 * 512, O_WP = O_SP + (size_t)NL * NB * RP, O_KS = O_WP + (size_t)NL * NB * 8 * 4096, O_VS = O_KS + (size_t)NL * NS * 128 * 256,
                 O_PS = O_VS + (size_t)NL * NS * 128 * 256, O_SS = O_PS + (size_t)NL * NS * 15 * 512, O_WS = O_SS + (size_t)NL * NS * RP, O_END = O_WS + (size_t)NL * NS * 8 * 4096;

inline void forward(const In& in, float* out, float* wsf, hipStream_t st, const dbg::Ctx* dc = nullptr) {
    using namespace dbg;
    WS w; carve(wsf, w);
    const float *xp = in.p[0], *xs = in.p[1];
    silu_c<<<EW(NMOD * D)>>>(in.p[2], in.p[3], w.silc);
    for (int l = 0; l < NL; ++l) { G(st, w.silc, D, in.p[9] + (size_t)l * D * 6 * D, 6 * D, w.mod + (size_t)l * NMOD * 6 * D, 6 * D, NMOD, 6 * D, D);
        add_bias<<<EW(NMOD * 6 * D)>>>(w.mod + (size_t)l * NMOD * 6 * D, in.p[10] + (size_t)l * 6 * D, NMOD * 6 * D, 6 * D); }
    cmp(dc, st, T_MOD, w.mod, 6 * D, 0, NL * NMOD, 6 * D);
    const float* xa = xp; const float* xb = xs;
    for (int l = 0; l < NL; ++l) {
        const float* mod = w.mod + (size_t)l * NMOD * 6 * D; const int tb = T_L0 + l * T_PER_L;
        modnorm<<<M, 256, 0, st>>>(xa, xb, in.p[11] + l * D, mod, 0, D, w.h, (size_t)MP * D);
        cmp(dc, st, tb + T_H1, w.h, D, 0, M, D);
        G(st, w.h, D, in.p[13] + (size_t)l * D * INW, INW, w.z, INW, M, INW, D);
        rope<<<EW(M * 640)>>>(w.z);
        cmp(dc, st, tb + T_Q, w.z, INW, OQ, M, 1024); cmp(dc, st, tb + T_K, w.z, INW, OK_, M, 256); cmp(dc, st, tb + T_V, w.z, INW, OV, M, 256); cmp(dc, st, tb + T_U, w.z, INW, OU, M, 512);
        cmp(dc, st, tb + T_PR, w.z, INW, OPR, M, RP); cmp(dc, st, tb + T_GT, w.z, INW, OGL, M, 6144, 1);
        const float* ck = in.p[4] + (size_t)l * NS * 128 * 256; const float* cv = in.p[5] + (size_t)l * NS * 128 * 256;
        attn_prompt<<<(MP * 16 + 63) / 64, 64, 0, st>>>(w.z, in.p[14] + l * 16, w.cat_a);
        attn_sample<<<(NS * 16 + 63) / 64, 64, 0, st>>>(w.z, in.p[14] + l * 16, ck, cv, w.cat_a);
        kv_out<<<EW(NS * 128 * 256)>>>(w.z, ck, cv, out + O_KP + (size_t)l * NB * 128 * 256, out + O_VP + (size_t)l * NB * 128 * 256, out + O_KS + (size_t)l * NS * 128 * 256, out + O_VS + (size_t)l * NS * 128 * 256);
        const float* sp = in.p[6] + (size_t)l * NS * 15 * 512;
        pool_d<<<EW(M * 512)>>>(w.z, sp, w.dbuf);
        pool_z<<<EW(M * 512)>>>(w.dbuf, in.p[16] + (size_t)l * 4 * 128 * 128, in.p[17] + l * 512, w.cat_p);
        pool_out<<<EW(NS * 15 * 512)>>>(w.z, sp, out + O_PP + (size_t)l * NB * 15 * 512, out + O_PS + (size_t)l * NS * 15 * 512);
        rwkv_xm<<<EW((size_t)M * RP)>>>(w.z, in.p[7] + (size_t)l * NS * RP, in.p[19] + l * RP, w.xm);
        shift_out<<<EW(NS * RP)>>>(w.z, out + O_SP + (size_t)l * NB * RP, out + O_SS + (size_t)l * NS * RP);
        if (l > 0) { G(st, w.xm + 1024, RP, in.p[31], 32, w.T1, 32, M, 32, 512); G(st, w.T1, 32, in.p[32], 512, w.dbuf, 512, M, 512, 32); }
        if (l > 0) { cmp(dc, st, 59, w.dbuf, 512, 0, M, 512); cmp(dc, st, 60, w.T1, 32, 0, M, 32); }
        rwkv_prep<<<M * 8, 64, 0, st>>>(w.xm, in.p[20] + l * 512, in.p[21] + (size_t)l * 96 * 512, in.p[22] + l * 512, in.p[23] + (size_t)l * 96 * 512, in.p[24] + (size_t)l * 256 * 512, in.p[25] + l * 512, in.p[26] + l * 512,
                                         w.dbuf, in.p[33], w.vfirst, l > 0, w.R, w.W, w.K, w.V, w.A, w.B, w.G);
        cmp(dc, st, tb + T_OA, w.cat_a, 1024, 0, M, 1024); cmp(dc, st, tb + T_ZP, w.cat_p, 512, 0, M, 512);
        cmp(dc, st, tb + T_R, w.R, 512, 0, M, 512); cmp(dc, st, tb + T_W, w.W, 512, 0, M, 512); cmp(dc, st, tb + T_KK, w.K, 512, 0, M, 512); cmp(dc, st, tb + T_VV, w.V, 512, 0, M, 512);
        cmp(dc, st, tb + T_A, w.A, 512, 0, M, 512); cmp(dc, st, tb + T_B, w.B, 512, 0, M, 512); cmp(dc, st, tb + T_G, w.G, 512, 0, M, 512);
        rwkv_scan<<<NB * 8, 64, 0, st>>>(w.R, w.W, w.K, w.V, w.A, w.B, nullptr, out + O_WP + (size_t)l * NB * 8 * 4096, w.Y, 0, SEQ);
        rwkv_scan<<<NS * 8, 64, 0, st>>>(w.R, w.W, w.K, w.V, w.A, w.B, in.p[8] + (size_t)l * NS * 8 * 4096, out + O_WS + (size_t)l * NS * 8 * 4096, w.Y, MP, 1);
        cmp(dc, st, tb + T_Y, w.Y, 512, 0, M, 512);
        rwkv_post<<<M * 8, 64, 0, st>>>(w.Y, w.R, w.K, w.V, w.G, in.p[27] + l * 512, in.p[28] + l * 512, in.p[29] + l * 512, w.cat_r);
        cmp(dc, st, tb + T_YR, w.cat_r, 512, 0, M, 512);
        G(st, w.cat_a, 1024, in.p[15] + (size_t)l * 1024 * D, D, w.P, D, M, D, 1024); merge_acc<<<EW((size_t)M * D)>>>(w.z, w.P, 0, w.merged, 1);
        G(st, w.cat_p, 512, in.p[18] + (size_t)l * 512 * D, D, w.P, D, M, D, 512);   merge_acc<<<EW((size_t)M * D)>>>(w.z, w.P, D, w.merged, 0);
        G(st, w.cat_r, 512, in.p[30] + (size_t)l * 512 * D, D, w.P, D, M, D, 512);   merge_acc<<<EW((size_t)M * D)>>>(w.z, w.P, 2 * D, w.merged, 0);
        cmp(dc, st, tb + T_MG, w.merged, D, 0, M, D);
        G(st, w.merged, D, in.p[34] + (size_t)l * D * D, D, w.P, D, M, D, D);
        resid<<<EW((size_t)M * D)>>>(xa, xb, w.P, mod, 2 * D, w.x1);
        cmp(dc, st, tb + T_X1, w.x1, D, 0, M, D);
        modnorm<<<M, 256, 0, st>>>(w.x1, w.x1 + (size_t)MP * D, in.p[12] + l * D, mod, 3 * D, 4 * D, w.h, (size_t)MP * D);
        cmp(dc, st, tb + T_H2, w.h, D, 0, M, D);
        G(st, w.h, D, in.p[35] + (size_t)l * D * DFF, DFF, w.fg, DFF, M, DFF, D);
        G(st, w.h, D, in.p[36] + (size_t)l * D * DFF, DFF, w.fu, DFF, M, DFF, D);
        swiglu<<<EW((size_t)M * DFF)>>>(w.fg, w.fu, w.fg, M * DFF);
        cmp(dc, st, tb + T_ACT, w.fg, DFF, 0, M, DFF);
        G(st, w.fg, DFF, in.p[37] + (size_t)l * DFF * D, D, w.P, D, M, D, DFF);
        resid<<<EW((size_t)M * D)>>>(w.x1, w.x1 + (size_t)MP * D, w.P, mod, 5 * D, w.xres);
        cmp(dc, st, tb + T_X2, w.xres, D, 0, M, D);
        xa = w.xres; xb = w.xres + (size_t)MP * D;
    }
    modnorm<<<M, 256, 0, st>>>(xa, xb, in.p[38], nullptr, 0, 0, out + O_YP, (size_t)MP * D);
}
#undef EW
}
namespace mk {
#define LAS __attribute__((address_space(3)))
#define GAS __attribute__((address_space(1)))
typedef unsigned short bf16;
typedef short bf16x8 __attribute__((ext_vector_type(8)));
typedef float f32x4 __attribute__((ext_vector_type(4)));
typedef float f32x2 __attribute__((ext_vector_type(2)));
typedef unsigned u32x4 __attribute__((ext_vector_type(4)));
typedef unsigned u32x2 __attribute__((ext_vector_type(2)));

constexpr int D = 2048, SEQ = 4096, NB = 2, MP = NB * SEQ, NS = 128, M = MP + NS, MPAD = 8448, NL = 2, NMOD = NB + NS;
constexpr int NIN = 10240, NGU = 11264, DFF = 5632, NADA = 6 * D, RP = 1984, PASTLEN = 8192;
constexpr int NWAVES = 8, NTHR = 512;

constexpr size_t al(size_t x) { return (x + 255) & ~(size_t)255; }
constexpr size_t WL_IN = 0, WL_CAT = WL_IN + al((size_t)NIN * D * 2), WL_O = WL_CAT + al((size_t)D * D * 2), WL_GU = WL_O + al((size_t)D * D * 2), WL_DN = WL_GU + al((size_t)NGU * D * 2),
                 WL_W2 = WL_DN + al((size_t)D * DFF * 2), WL_A2 = WL_W2 + al(512 * 96 * 2), WL_G2 = WL_A2 + al(512 * 96 * 2), WL_V1 = WL_G2 + al(512 * 256 * 2), WL_V2 = WL_V1 + al(32 * 512 * 2),
                 WL_PW = WL_V2 + al(512 * 32 * 2), WL_SIZE = WL_PW + al(4 * 128 * 128 * 2);
constexpr size_t WS_W = 0;
constexpr size_t WS_ROPE = WS_W + 2 * WL_SIZE;
constexpr size_t WS_SILC = WS_ROPE + al((size_t)4097 * 64 * 4);
constexpr size_t WS_MOD = WS_SILC + al((size_t)256 * D * 2);
constexpr size_t WS_X = WS_MOD + al((size_t)NL * NMOD * NADA * 4);
constexpr size_t WS_H = WS_X + al((size_t)MPAD * D * 4);
constexpr size_t WS_Q = WS_H + al((size_t)MPAD * D * 2);
constexpr size_t WS_K = WS_Q + al((size_t)MPAD * 1024 * 2);
constexpr size_t WS_V = WS_K + al((size_t)MPAD * 256 * 2);
constexpr size_t WS_U = WS_V + al((size_t)MPAD * 256 * 2);
constexpr size_t WS_PR = WS_U + al((size_t)MPAD * 512 * 4);
constexpr size_t WS_MG = WS_PR;
constexpr size_t WS_CAT = WS_PR + al((size_t)MPAD * D * 4);
constexpr size_t WS_RW = WS_CAT + al((size_t)MPAD * D * 2);
constexpr size_t RW_STRIDE = al((size_t)MPAD * 512 * 4);
constexpr size_t WS_GT = WS_RW + 9 * RW_STRIDE;
constexpr size_t WS_ADAW = WS_GT;
constexpr size_t WS_SLAB = WS_GT + al((size_t)MPAD * 6144 * 2);
constexpr size_t WS_SLABM = WS_SLAB + al((size_t)11 * NS * D * 4);
constexpr size_t WS_CTL = WS_SLABM + al((size_t)4 * NS * D * 4);
constexpr size_t WS_CTL_BYTES = 32768;
constexpr size_t WS_END = WS_CTL + WS_CTL_BYTES;
static_assert((size_t)2 * NADA * D * 2 <= (size_t)MPAD * 6144 * 2, "ada weights fit under the gates");

constexpr size_t O_YP = 0, O_YS = O_YP + (size_t)MP * D, O_KP = O_YS + (size_t)NS * D, O_VP = O_KP + (size_t)NL * NB * 128 * 256, O_PP = O_VP + (size_t)NL * NB * 128 * 256,
                 O_SP = O_PP + (size_t)NL * NB * 15 * 512, O_WP = O_SP + (size_t)NL * NB * RP, O_KS = O_WP + (size_t)NL * NB * 8 * 4096, O_VS = O_KS + (size_t)NL * NS * 128 * 256,
                 O_PS = O_VS + (size_t)NL * NS * 128 * 256, O_SS = O_PS + (size_t)NL * NS * 15 * 512, O_WS = O_SS + (size_t)NL * NS * RP, O_END = O_WS + (size_t)NL * NS * 8 * 4096;

__device__ __forceinline__ unsigned f2bf(float f) { unsigned u = __builtin_bit_cast(unsigned, f); return (u + 0x7fffu + ((u >> 16) & 1u)) >> 16; }
__device__ __forceinline__ unsigned pk2(float lo, float hi) { return f2bf(lo) | (f2bf(hi) << 16); }
__device__ __forceinline__ float bf2f(unsigned short b) { return __builtin_bit_cast(float, (unsigned)b << 16); }
__device__ __forceinline__ float bflo(unsigned w) { return __builtin_bit_cast(float, w << 16); }
__device__ __forceinline__ float bfhi(unsigned w) { return __builtin_bit_cast(float, w & 0xffff0000u); }
__device__ __forceinline__ float fsigm(float x) { return __builtin_amdgcn_rcpf(1.f + __expf(-x)); }
__device__ __forceinline__ float wave_sum(float v) {
#pragma unroll
    for (int o = 1; o < 64; o <<= 1) v += __shfl_xor(v, o);
    return v;
}
__device__ __forceinline__ int modrow(int m) { return m < MP ? (m >> 12) : NB + (m - MP); }
__device__ __forceinline__ int posidx(int m) { return m < MP ? (m & (SEQ - 1)) : 4096; }
__device__ __forceinline__ int pi_d(int p) { return 32 * ((p >> 2) & 1) + 16 * (p >> 5) + 4 * ((p >> 3) & 3) + (p & 3); }

struct Args { const float* in[39]; float* out; unsigned char* ws; int ph_lo, ph_hi; };

struct Frame {
    LAS unsigned char* lds;
    int tid, lane, wave, G, bid;
    float* out; unsigned char* ws;
};
template <int K> __device__ __forceinline__ const float* inp() { GAS const float* p; asm volatile("s_load_dwordx2 %0, %1, %2\n\ts_waitcnt lgkmcnt(0)" : "=s"(p) : "s"(__builtin_amdgcn_kernarg_segment_ptr()), "n"(K * 8) : "memory"); return (const float*)p; }
#define INP(k) inp<k>()
__device__ __forceinline__ unsigned char* wl(const Frame& F, int l, size_t off) { return F.ws + WS_W + (size_t)l * WL_SIZE + off; }
__device__ __forceinline__ float* rwbuf(const Frame& F, int i) { return (float*)(F.ws + WS_RW + (size_t)i * RW_STRIDE); }
enum { RW_R = 0, RW_W, RW_K, RW_V, RW_A, RW_B, RW_G, RW_Y, RW_VF };

struct TSrc { const float* w; long long d2; int ld; int mode; };
__device__ __forceinline__ const float* colsrc(const TSrc& s, int n) {
    if (s.mode == 0) return s.w + n;
    if (s.mode == 1) {
        if (n < 1280) { const int h = n >> 6, p = n & 63; return s.w + h * 64 + pi_d(p); }
        if (n < 4032) return s.w + n;
        if (n < 4096) return nullptr;
        return s.w + (n - 64);
    }
      { const int g8 = n >> 3, i = n & 7; return (const float*)((const char*)s.w + (i < 4 ? 0ll : s.d2)) + 4 * g8 + (i & 3); }
}
__device__ __forceinline__ void transpose_item(const TSrc& s, int K, bf16* WT, size_t ldt, int kcol0, LAS float* scr, int kb, int nb, int lane) {
    const int k0 = 64 * kb, n0 = 32 * nb, gq = lane & 7, kr = lane >> 3;
    const float* cp = colsrc(s, n0 + 4 * gq);
#pragma unroll
    for (int i = 0; i < 8; ++i) { const int kk = 8 * i + kr; const f32x4 v = cp ? *(const f32x4*)(cp + (size_t)(k0 + kk) * s.ld) : (f32x4){0.f, 0.f, 0.f, 0.f};
        LAS float* d = scr + kk * 33 + 4 * gq; d[0] = v.x; d[1] = v.y; d[2] = v.z; d[3] = v.w; }
    asm volatile("s_waitcnt lgkmcnt(0)" ::: "memory");
    const int c = lane & 7;
#pragma unroll
    for (int j = 0; j < 4; ++j) { const int n = (lane >> 3) + 8 * j; const LAS float* p = scr + (8 * c) * 33 + n;
        u32x4 o; o.x = pk2(p[0 * 33], p[1 * 33]); o.y = pk2(p[2 * 33], p[3 * 33]); o.z = pk2(p[4 * 33], p[5 * 33]); o.w = pk2(p[6 * 33], p[7 * 33]);
        *(u32x4*)(WT + (size_t)(n0 + n) * ldt + kcol0 + k0 + 8 * c) = o; }
    asm volatile("s_waitcnt lgkmcnt(0)" ::: "memory");
}
__device__ __forceinline__ void small_transpose(const float* src, int K, int N, bf16* dst, int ldt, int gt, int ngt) {
    for (int i = gt; i < N * K; i += ngt) { const int n = i / K, k = i - n * K; dst[(size_t)n * ldt + k] = (bf16)f2bf(src[(size_t)k * N + n]); }
}
__device__ __forceinline__ void p0_prologue(const Frame& F, int lmask, bool common, int wb, int nwb, int cls) {
    LAS float* scr = (LAS float*)(F.lds + F.wave * 16384);
    const int gw = wb * NWAVES + F.wave, NGW = nwb * NWAVES;
    constexpr int J_ADA = 32 * 384, J_IN = 32 * 320, J_CA = 16 * 64, J_CP = 8 * 64, J_CR = 8 * 64, J_O = 32 * 64, J_GU = 32 * 352, J_DN = 88 * 64;
    constexpr int PER_L = J_ADA + J_IN + J_CA + J_CP + J_CR + J_O + J_GU + J_DN;
    constexpr int TOT = NL * PER_L; const int nrk = cls == 0 ? TOT : cls == 1 ? (TOT / 32) * 27 + (TOT % 32 < 27 ? TOT % 32 : 27) : (TOT / 32) * 5 + (TOT % 32 > 27 ? TOT % 32 - 27 : 0);
    for (int rk = gw; rk < nrk; rk += NGW) {
        const int it = cls == 0 ? rk : cls == 1 ? (rk / 27) * 32 + rk % 27 : (rk / 5) * 32 + 27 + rk % 5;
        const int l = it / PER_L; int r = it - l * PER_L;
        if (r < J_ADA ? !common : !((lmask >> l) & 1)) continue;
        TSrc s; s.d2 = 0; s.mode = 0; bf16* WT; size_t ldt; int K, nn, kcol0 = 0;
        if (r < J_ADA) { s.w = INP(9) + (size_t)l * D * NADA; s.ld = NADA; WT = (bf16*)(F.ws + WS_ADAW) + (size_t)l * NADA * D; ldt = D; K = D; nn = 384; }
        else if ((r -= J_ADA) < J_IN) { s.w = INP(13) + (size_t)l * D * 10176; s.ld = 10176; s.mode = 1; WT = (bf16*)wl(F, l, WL_IN); ldt = D; K = D; nn = 320; }
        else if ((r -= J_IN) < J_CA) { s.w = INP(15) + (size_t)l * 1024 * D; s.ld = D; WT = (bf16*)wl(F, l, WL_CAT); ldt = D; K = 1024; nn = 64; }
        else if ((r -= J_CA) < J_CP) { s.w = INP(18) + (size_t)l * 512 * D; s.ld = D; WT = (bf16*)wl(F, l, WL_CAT); ldt = D; K = 512; nn = 64; kcol0 = 1024; }
        else if ((r -= J_CP) < J_CR) { s.w = INP(30) + (size_t)l * 512 * D; s.ld = D; WT = (bf16*)wl(F, l, WL_CAT); ldt = D; K = 512; nn = 64; kcol0 = 1536; }
        else if ((r -= J_CR) < J_O) { s.w = INP(34) + (size_t)l * D * D; s.ld = D; WT = (bf16*)wl(F, l, WL_O); ldt = D; K = D; nn = 64; }
        else if ((r -= J_O) < J_GU) { s.w = INP(35) + (size_t)l * D * DFF; s.d2 = (const char*)INP(36) - (const char*)INP(35); s.ld = DFF; s.mode = 2; WT = (bf16*)wl(F, l, WL_GU); ldt = D; K = D; nn = 352; }
        else { r -= J_GU; s.w = INP(37) + (size_t)l * DFF * D; s.ld = D; WT = (bf16*)wl(F, l, WL_DN); ldt = DFF; K = DFF; nn = 64; }
        (void)K;
        transpose_item(s, K, WT, ldt, kcol0, scr, r / nn, r % nn, F.lane);
    }
    const int gt = wb * NTHR + F.tid, ngt = nwb * NTHR;
    for (int l = 0; l < NL; ++l) { if (!((lmask >> l) & 1)) continue;
        small_transpose(INP(21) + (size_t)l * 96 * 512, 96, 512, (bf16*)wl(F, l, WL_W2), 96, gt, ngt);
        small_transpose(INP(23) + (size_t)l * 96 * 512, 96, 512, (bf16*)wl(F, l, WL_A2), 96, gt, ngt);
        small_transpose(INP(24) + (size_t)l * 256 * 512, 256, 512, (bf16*)wl(F, l, WL_G2), 256, gt, ngt);
        for (int g = 0; g < 4; ++g) small_transpose(INP(16) + ((size_t)l * 4 + g) * 128 * 128, 128, 128, (bf16*)wl(F, l, WL_PW) + g * 128 * 128, 128, gt, ngt);
    }
    if (lmask & 2) { small_transpose(INP(31), 512, 32, (bf16*)wl(F, 1, WL_V1), 512, gt, ngt);
        small_transpose(INP(32), 32, 512, (bf16*)wl(F, 1, WL_V2), 32, gt, ngt); }
    if (!common) return;
    if (wb == 0 && F.tid < 2) ((unsigned*)(F.ws + WS_CTL))[64 * F.tid] = 0u;
    for (int i = gt; i < 256 * D; i += ngt) { const int r = i >> 11, k = i & (D - 1); float v = 0.f;
        if (r < NMOD) { const float c = r < NB ? INP(2)[r * D + k] : INP(3)[(r - NB) * D + k]; v = c / (1.f + expf(-c)); }
        ((bf16*)(F.ws + WS_SILC))[i] = (bf16)f2bf(v); }
    for (int i = gt; i < 4097 * 32; i += ngt) { const int p = i >> 5, d = i & 31; const float pos = p < 4096 ? (float)p : (float)PASTLEN;
        const float inv = powf(10000.f, -(float)d * (2.0f / 64.f)), ang = pos * inv; float* t = (float*)(F.ws + WS_ROPE) + (size_t)p * 64; t[d] = cosf(ang); t[32 + d] = sinf(ang); }
}

__device__ __forceinline__ void norm_phase(const Frame& F, int l, int which  , int nslab  ) {
    const int gw = F.bid * NWAVES + F.wave, NGW = F.G * NWAVES;
    const float* g = which == 0 ? INP(11) + l * D : which == 1 ? INP(12) + l * D : INP(38); const float* xp0 = INP(0); const float* xp1 = INP(1);
    for (int m = gw; m < M; m += NGW) {
        const float* xr = (which == 0 && l == 0) ? (m < MP ? xp0 + (size_t)m * D : xp1 + (size_t)(m - MP) * D) : (const float*)(F.ws + WS_X) + (size_t)m * D;
        f32x4 v[8], gv[8], shv[8], scv[8]; float s = 0.f;
        const float* mod = (const float*)(F.ws + WS_MOD) + ((size_t)l * NMOD + modrow(m)) * NADA + (which == 0 ? 0 : 3 * D);
#pragma unroll
        for (int j = 0; j < 8; ++j) { v[j] = *(const f32x4*)(xr + j * 256 + F.lane * 4); gv[j] = *(const f32x4*)(g + j * 256 + F.lane * 4);
            if (which != 2) { shv[j] = *(const f32x4*)(mod + j * 256 + F.lane * 4); scv[j] = *(const f32x4*)(mod + D + j * 256 + F.lane * 4); } else { shv[j] = gv[j]; scv[j] = gv[j]; } }
        if (nslab && m >= MP) { const float* sl = (const float*)(F.ws + WS_SLAB) + (size_t)(m - MP) * D + F.lane * 4;
            for (int q = 0; q < nslab; ++q) {
#pragma unroll
                for (int j = 0; j < 8; ++j) v[j] += *(const f32x4*)(sl + (size_t)q * NS * D + j * 256); }
            float* xs = (float*)(F.ws + WS_X) + (size_t)m * D;
#pragma unroll
            for (int j = 0; j < 8; ++j) *(f32x4*)(xs + j * 256 + F.lane * 4) = v[j]; }
#pragma unroll
        for (int j = 0; j < 8; ++j) { s += (v[j].x * v[j].x + v[j].y * v[j].y) + (v[j].z * v[j].z + v[j].w * v[j].w); }
        const float rs = rsqrtf(wave_sum(s) * (1.f / D) + 1e-6f);
        if (which == 0 && l == 0 && m >= MP) { float* xs = (float*)(F.ws + WS_X) + (size_t)m * D;
#pragma unroll
            for (int j = 0; j < 8; ++j) *(f32x4*)(xs + j * 256 + F.lane * 4) = v[j]; }
        if (which == 2) { float* o = F.out + O_YP + (size_t)m * D;
#pragma unroll
            for (int j = 0; j < 8; ++j) *(f32x4*)(o + j * 256 + F.lane * 4) = v[j] * rs * gv[j]; }
        else { bf16* o = (bf16*)(F.ws + WS_H) + (size_t)m * D;
#pragma unroll
            for (int j = 0; j < 8; ++j) { const int c = j * 256 + F.lane * 4; const f32x4 y = v[j] * rs * gv[j] * (scv[j] + 1.f) + shv[j]; u32x2 w; w.x = pk2(y.x, y.y); w.y = pk2(y.z, y.w); *(u32x2*)(o + c) = w; } }
    }
}
}
#ifdef MK_TS_ID
#ifndef MK_TS_BLOCK
#define MK_TS_BLOCK 0
#endif
#define TSB2(id, ldsp) do { if ((id) == MK_TS_ID && blockIdx.x == MK_TS_BLOCK && threadIdx.x == 0) *(volatile __attribute__((address_space(3))) unsigned*)((ldsp) + 135168 - 64) -= (unsigned)__builtin_amdgcn_s_memrealtime(); } while (0)
#define TSE2(id, ldsp) do { if ((id) == MK_TS_ID && blockIdx.x == MK_TS_BLOCK && threadIdx.x == 0) *(volatile __attribute__((address_space(3))) unsigned*)((ldsp) + 135168 - 64) += (unsigned)__builtin_amdgcn_s_memrealtime(); } while (0)
#else
#define TSB2(id, ldsp) do {} while (0)
#define TSE2(id, ldsp) do {} while (0)
#endif
namespace mk {
constexpr int BM = 256, BK = 64, HALF = 128, HTB = HALF * BK * 2, STAGE_BYTES = 8 * HTB, NXCD = 8, WGM = 8;
__device__ __forceinline__ int lds_byte(int r, int c) { const int st = (r >> 4) * 2 + (c >> 5), rr = r & 15, cc = c & 31, ob = rr * 64 + cc * 2; return st * 1024 + (ob ^ (((ob >> 9) & 1) << 5)); }
__device__ __forceinline__ void stage_rc(int b, int& R, int& C) { const int st = b / 1024, sb = b % 1024, swz = sb ^ (((sb >> 9) & 1) << 5); R = (st >> 1) * 16 + swz / 64; C = (st & 1) * 32 + (swz % 64) / 2; }
__device__ __forceinline__ int perm32(int rho) { const int n = rho >> 4, i = rho & 15; return 8 * (i >> 2) + 4 * n + (i & 3); }

struct Unit { int pm, pn, seg; };
enum { G_ADA = 0, G_IN, G_MG, G_WO, G_GU, G_DN };
struct Gemm { const bf16* A; const bf16* Bt; int ld, M, N, K, mode, layer; };

struct Rect { int pm0, nM, pn0, nN; };
struct Sched {
    unsigned pa, pb; int G, c, ksb;
    __device__ __forceinline__ static unsigned pack(const Rect& r) { return (unsigned)r.pm0 | ((unsigned)r.nM << 8) | ((unsigned)r.pn0 << 16) | ((unsigned)r.nN << 24); }
    __device__ __forceinline__ void init(const Rect& a, const Rect& b, int G_, int c_, int  , int ksb_ = 0) { pa = pack(a); pb = pack(b); G = G_; c = c_; ksb = ksb_; }
    __device__ __forceinline__ bool next(int i, Unit& u) const {
        const int nA = (int)((pa >> 8) & 255u) * (int)(pa >> 24), nB = (int)((pb >> 8) & 255u) * (int)(pb >> 24);
        const long L = (long)i * G + c; if (L >= nA + nB) return false;
        const bool inA = L < nA; const unsigned pk = inA ? pa : pb; const int pm0 = (int)(pk & 255u), nM = (int)((pk >> 8) & 255u), pn0 = (int)((pk >> 16) & 255u), nN = (int)(pk >> 24), nwg = nM * nN;
        int wgid = inA ? (int)L : (int)L - nA; { const int q = nwg / NXCD, r = nwg % NXCD, xcd = wgid % NXCD, off = wgid / NXCD; wgid = (xcd < r ? xcd * (q + 1) : r * (q + 1) + (xcd - r) * q) + off; }
        const int nig = WGM * nN, gid = wgid / nig, fm = gid * WGM, gsz = (nM - fm) < WGM ? (nM - fm) : WGM;
        u.pm = pm0 + fm + ((wgid % nig) % gsz); u.pn = pn0 + (wgid % nig) / gsz; u.seg = 0;
        if (!inA && ksb > 0) { const int q = u.pn - pn0; u.seg = q / ksb; u.pn = pn0 + q % ksb; }
        return true;
    }
};

typedef __bf16 bf16x2_t __attribute__((ext_vector_type(2)));
__device__ __forceinline__ unsigned cvt_pk_bf16(float lo, float hi) { const f32x2 v = {lo, hi}; const bf16x2_t b = __builtin_convertvector(v, bf16x2_t); return __builtin_bit_cast(unsigned, b); }
__device__ __forceinline__ f32x4 sig4(f32x4 v) { f32x4 r; r.x = fsigm(v.x); r.y = fsigm(v.y); r.z = fsigm(v.z); r.w = fsigm(v.w); return r; }

__device__ __forceinline__ float gclamp(float g) { return fmaxf(g, 1e-18f); }
struct Epi {
    const Frame* F; int mode, layer;
    __device__ __forceinline__ void rescale(f32x4 (&acc)[2][2][4][2], const Unit& u, int sp, int wr, int wc, int fr, int fq) const {
        int row0 = u.pm * BM + wr * 64 + fr; asm volatile("" : "+v"(row0)); const int c0 = u.pn * BM + wc * 32 + 8 * fq; const bf16* gt = (const bf16*)(F->ws + WS_GT) + sp * D + c0;
#pragma unroll
        for (int ai = 0; ai < 2; ++ai)
#pragma unroll
            for (int m = 0; m < 4; ++m) { const int r = row0 + ai * HALF + m * 16; const int rr = r < M ? r : M - 1;
#pragma unroll
                for (int bj = 0; bj < 2; ++bj) { const u32x4 ga = *(const u32x4*)(gt + (size_t)rr * 6144 + bj * HALF), gb = *(const u32x4*)(gt + (size_t)rr * 6144 + D + bj * HALF);
                    f32x4& v0 = acc[ai][bj][m][0]; f32x4& v1 = acc[ai][bj][m][1];
                    v0.x *= gclamp(bflo(ga.x)) * __builtin_amdgcn_rcpf(gclamp(bflo(gb.x))); v0.y *= gclamp(bfhi(ga.x)) * __builtin_amdgcn_rcpf(gclamp(bfhi(gb.x)));
                    v0.z *= gclamp(bflo(ga.y)) * __builtin_amdgcn_rcpf(gclamp(bflo(gb.y))); v0.w *= gclamp(bfhi(ga.y)) * __builtin_amdgcn_rcpf(gclamp(bfhi(gb.y)));
                    v1.x *= gclamp(bflo(ga.z)) * __builtin_amdgcn_rcpf(gclamp(bflo(gb.z))); v1.y *= gclamp(bfhi(ga.z)) * __builtin_amdgcn_rcpf(gclamp(bfhi(gb.z)));
                    v1.z *= gclamp(bflo(ga.w)) * __builtin_amdgcn_rcpf(gclamp(bflo(gb.w))); v1.w *= gclamp(bfhi(ga.w)) * __builtin_amdgcn_rcpf(gclamp(bfhi(gb.w))); }
                if (m & 1) asm volatile("" ::: "memory"); }
    }
    __device__ __forceinline__ void operator()(const f32x4 (&acc)[2][2][4][2], const Unit& u, int wr, int wc, int fr, int fq) const {
        const Frame& Fr = *F; const int l = layer;
        int row0 = u.pm * BM + wr * 64 + fr; const int colb = u.pn * BM + wc * 32 + 8 * fq;
        asm volatile("" : "+v"(row0));
        unsigned char* ws = Fr.ws;
        if (mode == G_ADA) {
            const float* ab = INP(10);
#pragma unroll
            for (int ai = 0; ai < 2; ++ai)
#pragma unroll
                for (int m = 0; m < 4; ++m) { const int r = row0 + ai * HALF + m * 16; if (r < NMOD) {
#pragma unroll
                    for (int bj = 0; bj < 2; ++bj) { const int c = colb + bj * HALF, ll = c / NADA, j = c - ll * NADA; float* o = (float*)(ws + WS_MOD) + ((size_t)ll * NMOD + r) * NADA + j;
                        *(f32x4*)o = acc[ai][bj][m][0] + *(const f32x4*)(ab + c); *(f32x4*)(o + 4) = acc[ai][bj][m][1] + *(const f32x4*)(ab + c + 4); } } }
        } else if (mode == G_IN) {
            const int pn = u.pn;
            if (pn < 5) {
                const int wp = wc & 1; const float* rt = (const float*)(ws + WS_ROPE);
#pragma unroll
                for (int ai = 0; ai < 2; ++ai)
#pragma unroll
                    for (int m = 0; m < 4; ++m) { const int r = row0 + ai * HALF + m * 16; if (r < M) {
                        const float* tp = rt + (size_t)posidx(r) * 64 + 16 * wp + 4 * fq; const f32x4 cs = *(const f32x4*)tp, sn = *(const f32x4*)(tp + 32);
#pragma unroll
                        for (int bj = 0; bj < 2; ++bj) { const f32x4 x1 = acc[ai][bj][m][0], x2 = acc[ai][bj][m][1]; const f32x4 o1 = x1 * cs - x2 * sn, o2 = x2 * cs + x1 * sn;
                            u32x4 w; w.x = cvt_pk_bf16(o1.x, o1.y); w.y = cvt_pk_bf16(o1.z, o1.w); w.z = cvt_pk_bf16(o2.x, o2.y); w.w = cvt_pk_bf16(o2.z, o2.w);
                            const int hc = bj * HALF + wc * 32 + 8 * fq;
                            if (pn < 4) *(u32x4*)((bf16*)(ws + WS_Q) + (size_t)r * 1024 + pn * 256 + hc) = w;
                            else { *(u32x4*)((bf16*)(ws + WS_K) + (size_t)r * 256 + hc) = w;
                                const int hk = hc >> 6, d1 = 16 * wp + 4 * fq; float* ko = nullptr;
                                if (r < MP) { const int t = r & (SEQ - 1); if (t >= SEQ - 128) ko = Fr.out + O_KP + ((((size_t)l * NB + (r >> 12)) * 128 + (t - (SEQ - 128))) * 4 + hk) * 64; }
                                else ko = Fr.out + O_KS + ((((size_t)l * NS + (r - MP)) * 128 + 127) * 4 + hk) * 64;
                                if (ko) { *(f32x4*)(ko + d1) = o1; *(f32x4*)(ko + d1 + 32) = o2; } } } } }
            } else if (pn == 5) {
#pragma unroll
                for (int ai = 0; ai < 2; ++ai)
#pragma unroll
                    for (int m = 0; m < 4; ++m) { const int r = row0 + ai * HALF + m * 16; if (r < M) {
#pragma unroll
                        for (int bj = 0; bj < 2; ++bj) { const f32x4 v0 = acc[ai][bj][m][0], v1 = acc[ai][bj][m][1]; const int hc = bj * HALF + wc * 32 + 8 * fq;
                            u32x4 w; w.x = cvt_pk_bf16(v0.x, v0.y); w.y = cvt_pk_bf16(v0.z, v0.w); w.z = cvt_pk_bf16(v1.x, v1.y); w.w = cvt_pk_bf16(v1.z, v1.w);
                            *(u32x4*)((bf16*)(ws + WS_V) + (size_t)r * 256 + hc) = w;
                            float* vo = nullptr;
                            if (r < MP) { const int t = r & (SEQ - 1); if (t >= SEQ - 128) vo = Fr.out + O_VP + (((size_t)l * NB + (r >> 12)) * 128 + (t - (SEQ - 128))) * 256; }
                            else vo = Fr.out + O_VS + (((size_t)l * NS + (r - MP)) * 128 + 127) * 256;
                            if (vo) { *(f32x4*)(vo + hc) = v0; *(f32x4*)(vo + hc + 4) = v1; } } } }
            } else if (pn < 16) {
                float* base = pn < 8 ? (float*)(ws + WS_U) : (float*)(ws + WS_PR); const int ld = pn < 8 ? 512 : 2048, c0 = (pn < 8 ? (pn - 6) : (pn - 8)) * 256 + wc * 32 + 8 * fq;
#pragma unroll
                for (int ai = 0; ai < 2; ++ai)
#pragma unroll
                    for (int m = 0; m < 4; ++m) { const int r = row0 + ai * HALF + m * 16; if (r < M) {
#pragma unroll
                        for (int bj = 0; bj < 2; ++bj) { float* o = base + (size_t)r * ld + c0 + bj * HALF; *(f32x4*)o = acc[ai][bj][m][0]; *(f32x4*)(o + 4) = acc[ai][bj][m][1]; } } }
            } else {
                const int c0 = (pn - 16) * 256 + wc * 32 + 8 * fq;
#pragma unroll
                for (int ai = 0; ai < 2; ++ai)
#pragma unroll
                    for (int m = 0; m < 4; ++m) { const int r = row0 + ai * HALF + m * 16; if (r < M) {
#pragma unroll
                        for (int bj = 0; bj < 2; ++bj) { const f32x4 v0 = sig4(acc[ai][bj][m][0]), v1 = sig4(acc[ai][bj][m][1]);
                            u32x4 w; w.x = cvt_pk_bf16(v0.x, v0.y); w.y = cvt_pk_bf16(v0.z, v0.w); w.z = cvt_pk_bf16(v1.x, v1.y); w.w = cvt_pk_bf16(v1.z, v1.w);
                            *(u32x4*)((bf16*)(ws + WS_GT) + (size_t)r * 6144 + c0 + bj * HALF) = w; } } }
            }
        } else if (mode == G_MG && u.pm == MPAD / BM - 1) {
            const int c0 = u.pn * BM + wc * 32 + 8 * fq, br = u.seg < 2 ? 0 : u.seg - 1;
#pragma unroll
            for (int m = 0; m < 4; ++m) { const int r = row0 + m * 16; if (r < M) { float* so = (float*)(ws + WS_SLABM) + ((size_t)u.seg * NS + (r - MP)) * D;
#pragma unroll
                for (int bj = 0; bj < 2; ++bj) { const int c = c0 + bj * HALF; const u32x4 gw = *(const u32x4*)((const bf16*)(ws + WS_GT) + (size_t)r * 6144 + br * D + c);
                    f32x4 v0 = acc[0][bj][m][0], v1 = acc[0][bj][m][1];
                    v0.x *= gclamp(bflo(gw.x)); v0.y *= gclamp(bfhi(gw.x)); v0.z *= gclamp(bflo(gw.y)); v0.w *= gclamp(bfhi(gw.y)); v1.x *= gclamp(bflo(gw.z)); v1.y *= gclamp(bfhi(gw.z)); v1.z *= gclamp(bflo(gw.w)); v1.w *= gclamp(bfhi(gw.w));
                    *(f32x4*)(so + c) = v0; *(f32x4*)(so + c + 4) = v1; } } }
        } else if (mode == G_MG) {
            const int c0 = u.pn * BM + wc * 32 + 8 * fq;
#pragma unroll
            for (int ai = 0; ai < 2; ++ai)
#pragma unroll
                for (int m = 0; m < 4; ++m) { const int r = row0 + ai * HALF + m * 16; if (r < M) {
#pragma unroll
                    for (int bj = 0; bj < 2; ++bj) { const int c = c0 + bj * HALF; const u32x4 gw = *(const u32x4*)((const bf16*)(ws + WS_GT) + (size_t)r * 6144 + 2 * D + c);
                        f32x4 v0 = acc[ai][bj][m][0], v1 = acc[ai][bj][m][1];
                        v0.x *= gclamp(bflo(gw.x)); v0.y *= gclamp(bfhi(gw.x)); v0.z *= gclamp(bflo(gw.y)); v0.w *= gclamp(bfhi(gw.y)); v1.x *= gclamp(bflo(gw.z)); v1.y *= gclamp(bfhi(gw.z)); v1.z *= gclamp(bflo(gw.w)); v1.w *= gclamp(bfhi(gw.w));
                        u32x4 w; w.x = cvt_pk_bf16(v0.x, v0.y); w.y = cvt_pk_bf16(v0.z, v0.w); w.z = cvt_pk_bf16(v1.x, v1.y); w.w = cvt_pk_bf16(v1.z, v1.w); *(u32x4*)((bf16*)(ws + WS_MG) + (size_t)r * D + c) = w; } } }
        } else if (mode == G_WO || mode == G_DN) {
            const int c0 = u.pn * BM + wc * 32 + 8 * fq; const int goff = mode == G_WO ? 2 * D : 5 * D;
            if (u.pm == MPAD / BM - 1) {
#pragma unroll
                for (int m = 0; m < 4; ++m) { const int r = row0 + m * 16; if (r < M) {
                    const float* gp = (const float*)(ws + WS_MOD) + ((size_t)l * NMOD + modrow(r)) * NADA + goff; float* so = (float*)(ws + WS_SLAB) + ((size_t)u.seg * NS + (r - MP)) * D;
#pragma unroll
                    for (int bj = 0; bj < 2; ++bj) { const int c = c0 + bj * HALF; const f32x4 g0 = *(const f32x4*)(gp + c), g1 = *(const f32x4*)(gp + c + 4);
                        *(f32x4*)(so + c) = (g0 + 1.f) * acc[0][bj][m][0]; *(f32x4*)(so + c + 4) = (g1 + 1.f) * acc[0][bj][m][1]; } } }
            } else {
                const float* gp = (const float*)(ws + WS_MOD) + ((size_t)l * NMOD + (u.pm >> 4)) * NADA + goff + c0;
                const f32x4 ga0 = *(const f32x4*)gp + 1.f, ga1 = *(const f32x4*)(gp + 4) + 1.f, gb0 = *(const f32x4*)(gp + HALF) + 1.f, gb1 = *(const f32x4*)(gp + HALF + 4) + 1.f;
                const float* xbase = (mode == G_WO && l == 0) ? INP(0) : (const float*)(ws + WS_X); float* xob = (float*)(ws + WS_X);
#pragma unroll
                for (int am = 0; am < 8; am += 2) { f32x4 xv[2][4];
#pragma unroll
                    for (int q = 0; q < 2; ++q) { const int ai = (am + q) >> 2, m = (am + q) & 3; const float* xin = xbase + (size_t)(row0 + ai * HALF + m * 16) * D + c0;
                        xv[q][0] = *(const f32x4*)xin; xv[q][1] = *(const f32x4*)(xin + 4); xv[q][2] = *(const f32x4*)(xin + HALF); xv[q][3] = *(const f32x4*)(xin + HALF + 4); }
#pragma unroll
                    for (int q = 0; q < 2; ++q) { const int ai = (am + q) >> 2, m = (am + q) & 3; float* xo = xob + (size_t)(row0 + ai * HALF + m * 16) * D + c0;
                        *(f32x4*)xo = xv[q][0] + ga0 * acc[ai][0][m][0]; *(f32x4*)(xo + 4) = xv[q][1] + ga1 * acc[ai][0][m][1];
                        *(f32x4*)(xo + HALF) = xv[q][2] + gb0 * acc[ai][1][m][0]; *(f32x4*)(xo + HALF + 4) = xv[q][3] + gb1 * acc[ai][1][m][1]; }
                    asm volatile("" ::: "memory"); }
            }
        } else {
            const int c0 = u.pn * 128 + wc * 16 + 4 * fq;
#pragma unroll
            for (int ai = 0; ai < 2; ++ai)
#pragma unroll
                for (int m = 0; m < 4; ++m) { const int r = row0 + ai * HALF + m * 16; if (r < M) {
#pragma unroll
                    for (int bj = 0; bj < 2; ++bj) { const f32x4 g = acc[ai][bj][m][0], up = acc[ai][bj][m][1]; const f32x4 a = g * sig4(g) * up;
                        u32x2 w; w.x = cvt_pk_bf16(a.x, a.y); w.y = cvt_pk_bf16(a.z, a.w); *(u32x2*)((bf16*)(ws + WS_GT) + (size_t)r * DFF + c0 + bj * 64) = w; } } }
        }
    }
};

__device__ __forceinline__ void gemm_phase(LAS unsigned char* lds, const Gemm g, const Sched& S, const Epi& E, const int tid  ) {
    const int wid = __builtin_amdgcn_readfirstlane(tid >> 6), lane = tid & 63, wr = wid >> 2, wc = wid & 3, fr = lane & 15, fq = lane >> 4;
    unsigned voffA[2], voffB[2];
#pragma unroll
    for (int i = 0; i < 2; ++i) { int R, C; stage_rc(tid * 16 + i * 8192, R, C); const int Rb = (R & ~31) + perm32(R & 31);
        voffA[i] = (unsigned)(R * g.ld + C) * 2u; voffB[i] = (unsigned)(Rb * g.ld + C) * 2u; }
    constexpr unsigned kstep = BK * 2;
    const unsigned hstep = (unsigned)HALF * (unsigned)g.ld * 2u; const bool mgd = g.mode == G_MG; const int ntfull = g.K / BK;
    const bool ksd = g.mode == G_WO || g.mode == G_DN || g.mode == G_MG;
#define PG8_KS(u) (ksd && (u).pm == MPAD / BM - 1)
#define PG8_KA(u) (PG8_KS(u) ? (unsigned)(u).seg * 512u : 0u)
#define PG8_NT(u) (PG8_KS(u) ? 8 : ntfull)
#define PG8_TILE(p, u) (((unsigned)(p) * (unsigned)BM * (unsigned)g.ld + PG8_KA(u)) * 2u)
    const unsigned ldsw = (unsigned)wid * 1024u;
    const int aoff = lds_byte(wr * 64 + fr, fq * 8), boff = lds_byte(wc * 32 + fr, fq * 8);
#define PG8_SA(b, h) (((b) * 2 + (h)) * HTB)
#define PG8_SB(b, h) ((4 + (b) * 2 + (h)) * HTB)
#define PG8_STAGE(bufoff, gbase, soff, voff) do { _Pragma("unroll") for (int _i = 0; _i < 2; ++_i) \
        __builtin_amdgcn_global_load_lds((const unsigned*)((const char*)(gbase) + (size_t)((voff)[_i] + (unsigned)(soff))), (LAS unsigned*)(lds + (bufoff) + ldsw + _i * 8192), 16, 0, 0); } while (0)
#define PG8_STA(bufoff, soff) PG8_STAGE(bufoff, g.A, soff, voffA)
#define PG8_STB(bufoff, soff) PG8_STAGE(bufoff, g.Bt, soff, voffB)
#define PG8_LDA(dst, b, h) do { _Pragma("unroll") for (int m = 0; m < 4; ++m) _Pragma("unroll") for (int k = 0; k < 2; ++k) dst[m][k] = *(const LAS bf16x8*)(lds + PG8_SA(b, h) + aoff + m * 2048 + k * 1024); } while (0)
#define PG8_LDB(dst, b, h) do { _Pragma("unroll") for (int n = 0; n < 2; ++n) _Pragma("unroll") for (int k = 0; k < 2; ++k) dst[n][k] = *(const LAS bf16x8*)(lds + PG8_SB(b, h) + boff + n * 2048 + k * 1024); } while (0)
#define PG8_MMA(ai, bj, At, Bt) do { __builtin_amdgcn_s_setprio(1); _Pragma("unroll") for (int m = 0; m < 4; ++m) _Pragma("unroll") for (int n = 0; n < 2; ++n) _Pragma("unroll") for (int k = 0; k < 2; ++k) \
        acc[ai][bj][m][n] = __builtin_amdgcn_mfma_f32_16x16x32_bf16(Bt[n][k], At[m][k], acc[ai][bj][m][n], 0, 0, 0); __builtin_amdgcn_s_setprio(0); } while (0)
#define PG8_WAIT_V(n) asm volatile("s_waitcnt vmcnt(" #n ")" ::: "memory")
#define PG8_WAIT_L(n) asm volatile("s_waitcnt lgkmcnt(" #n ")" ::: "memory")
#define PG8_BAR __builtin_amdgcn_s_barrier()
#define PG8_SCHED __builtin_amdgcn_sched_barrier(0)
    Unit cur, nxt; int ui = 0;
    if (!S.next(0, cur)) return;
    f32x4 acc[2][2][4][2];
#pragma unroll
    for (int a = 0; a < 2; ++a)
#pragma unroll
        for (int b = 0; b < 2; ++b)
#pragma unroll
            for (int m = 0; m < 4; ++m)
#pragma unroll
                for (int n = 0; n < 2; ++n) acc[a][b][m][n] = (f32x4){0.f, 0.f, 0.f, 0.f};
    bf16x8 At[4][2], B0[2][2], B1[2][2];
    unsigned cA = PG8_TILE(cur.pm, cur), cB = PG8_TILE(cur.pn, cur);
    PG8_STB(PG8_SB(0, 0), cB); PG8_STB(PG8_SB(0, 1), cB + hstep); PG8_STA(PG8_SA(0, 0), cA); PG8_STA(PG8_SA(0, 1), cA + hstep);
    if (wr == 1) PG8_BAR;
    PG8_WAIT_V(2); PG8_BAR;
    PG8_STB(PG8_SB(1, 0), cB + kstep); PG8_STA(PG8_SA(1, 0), cA + kstep); PG8_STB(PG8_SB(1, 1), cB + hstep + kstep);
    PG8_WAIT_V(6); PG8_BAR;
    for (;;) {
        const bool has_next = S.next(ui + 1, nxt);
        const unsigned nA = has_next ? PG8_TILE(nxt.pm, nxt) : cA, nB = has_next ? PG8_TILE(nxt.pn, nxt) : cB;
        const int nt = PG8_NT(cur);
        TSB2(50 + 2 * g.mode, lds);
        for (int t = 0; t < nt; t += 2) {
            const bool last = (t == nt - 2);
            if (mgd && !PG8_KS(cur) && (t == 16 || t == 24)) E.rescale(acc, cur, t == 16 ? 0 : 1, wr, wc, fr, fq);
            const unsigned a1 = cA + (unsigned)(t + 1) * kstep;
            const unsigned a2 = last ? nA : cA + (unsigned)(t + 2) * kstep, b2 = last ? nB : cB + (unsigned)(t + 2) * kstep;
            const unsigned a3 = a2 + kstep, b3 = b2 + kstep;
            PG8_LDB(B0, 0, 0); PG8_LDB(B1, 0, 1); PG8_SCHED; PG8_LDA(At, 0, 0); PG8_STA(PG8_SA(1, 1), a1 + hstep);
            PG8_WAIT_V(8); PG8_WAIT_L(0); PG8_BAR; PG8_MMA(0, 0, At, B0); PG8_MMA(0, 1, At, B1); PG8_BAR; PG8_SCHED;
            PG8_LDA(At, 0, 1); PG8_STB(PG8_SB(0, 0), b2); PG8_STB(PG8_SB(0, 1), b2 + hstep); PG8_STA(PG8_SA(0, 0), a2);
            PG8_WAIT_V(8); PG8_WAIT_L(0); PG8_BAR; PG8_MMA(1, 0, At, B0); PG8_MMA(1, 1, At, B1); PG8_BAR; PG8_SCHED;
            PG8_LDB(B0, 1, 0); PG8_LDB(B1, 1, 1); PG8_SCHED; PG8_LDA(At, 1, 0); PG8_STA(PG8_SA(0, 1), a2 + hstep);
            PG8_WAIT_V(8); PG8_WAIT_L(0); PG8_BAR; PG8_MMA(0, 0, At, B0); PG8_MMA(0, 1, At, B1); PG8_BAR; PG8_SCHED;
            PG8_LDA(At, 1, 1); PG8_STB(PG8_SB(1, 0), b3); PG8_STB(PG8_SB(1, 1), b3 + hstep); PG8_STA(PG8_SA(1, 0), a3);
            PG8_WAIT_V(8); PG8_WAIT_L(0); PG8_BAR; PG8_MMA(1, 0, At, B0); PG8_MMA(1, 1, At, B1); PG8_BAR; PG8_SCHED;
        }
        if (wr == 0) PG8_BAR;
        TSE2(50 + 2 * g.mode, lds);
        TSB2(51 + 2 * g.mode, lds); E(acc, cur, wr, wc, fr, fq); TSE2(51 + 2 * g.mode, lds);
        if (g.mode == G_GU && cur.pm == MPAD / BM - 1) { asm volatile("s_waitcnt vmcnt(0)" ::: "memory"); __builtin_amdgcn_fence(__ATOMIC_RELEASE, "agent"); asm volatile("s_waitcnt vmcnt(0)" ::: "memory");
            if (lane == 0) __hip_atomic_fetch_add((unsigned*)(E.F->ws + WS_CTL) + 64 * (6 + g.layer), 1u, __ATOMIC_RELAXED, __HIP_MEMORY_SCOPE_AGENT); }
        if (!has_next) break;
#pragma unroll
        for (int a = 0; a < 2; ++a)
#pragma unroll
            for (int b = 0; b < 2; ++b)
#pragma unroll
                for (int m = 0; m < 4; ++m)
#pragma unroll
                    for (int n = 0; n < 2; ++n) acc[a][b][m][n] = (f32x4){0.f, 0.f, 0.f, 0.f};
        cur = nxt; cA = nA; cB = nB; ++ui;
        if (wr == 1) PG8_BAR;
    }
    PG8_WAIT_V(0);
    PG8_BAR;
#undef PG8_KS
#undef PG8_KA
#undef PG8_NT
#undef PG8_TILE
#undef PG8_STA
#undef PG8_STB
#undef PG8_SA
#undef PG8_SB
#undef PG8_STAGE
#undef PG8_LDA
#undef PG8_LDB
#undef PG8_MMA
#undef PG8_WAIT_V
#undef PG8_WAIT_L
#undef PG8_BAR
#undef PG8_SCHED
}
}
namespace mk {
#define MFMA16(a, b, c) __builtin_amdgcn_mfma_f32_16x16x32_bf16((a), (b), (c), 0, 0, 0)
__device__ __forceinline__ bf16x8 pack8(f32x4 a, f32x4 b) { u32x4 w; w.x = cvt_pk_bf16(a.x, a.y); w.y = cvt_pk_bf16(a.z, a.w); w.z = cvt_pk_bf16(b.x, b.y); w.w = cvt_pk_bf16(b.z, b.w); return __builtin_bit_cast(bf16x8, w); }
typedef short s16x4 __attribute__((ext_vector_type(4)));
__device__ __forceinline__ bf16x8 cat44(s16x4 a, s16x4 b) { return (bf16x8){a[0], a[1], a[2], a[3], b[0], b[1], b[2], b[3]}; }
constexpr float LOG2E = 1.4426950408889634f;

constexpr int AK_STRIDE = 144, AV_STRIDE = 560;
constexpr int A_KOFF = 0, A_VOFF = 256 * AK_STRIDE, A_BYTES = A_VOFF + 64 * AV_STRIDE;
__device__ __forceinline__ void attn_prompt_unit(const Frame& F, int l, int b, int blk, int hk) {
    LAS unsigned char* Ks = F.lds + A_KOFF; LAS unsigned char* Vt = F.lds + A_VOFF;
    const bf16* Kg = (const bf16*)(F.ws + WS_K); const bf16* Vg = (const bf16*)(F.ws + WS_V); const bf16* Qg = (const bf16*)(F.ws + WS_Q);
    const int kp0 = blk * 128 - 128;
#pragma unroll
    for (int ch = F.tid; ch < 2048; ch += NTHR) { const int i = ch >> 3, dc = ch & 7, kp = kp0 + i;
        u32x4 kv = (u32x4){0u, 0u, 0u, 0u}, vv = kv;
        if (kp >= 0) { const size_t m = (size_t)b * SEQ + kp; kv = *(const u32x4*)(Kg + m * 256 + hk * 64 + dc * 8); vv = *(const u32x4*)(Vg + m * 256 + hk * 64 + dc * 8); }
        *(LAS u32x4*)(Ks + i * AK_STRIDE + dc * 16) = kv;
        LAS unsigned short* vp = (LAS unsigned short*)(Vt + (dc * 8) * AV_STRIDE) + i;
        vp[0 * (AV_STRIDE / 2)] = (unsigned short)(vv.x & 0xffff); vp[1 * (AV_STRIDE / 2)] = (unsigned short)(vv.x >> 16); vp[2 * (AV_STRIDE / 2)] = (unsigned short)(vv.y & 0xffff); vp[3 * (AV_STRIDE / 2)] = (unsigned short)(vv.y >> 16);
        vp[4 * (AV_STRIDE / 2)] = (unsigned short)(vv.z & 0xffff); vp[5 * (AV_STRIDE / 2)] = (unsigned short)(vv.z >> 16); vp[6 * (AV_STRIDE / 2)] = (unsigned short)(vv.w & 0xffff); vp[7 * (AV_STRIDE / 2)] = (unsigned short)(vv.w >> 16); }
    for (int i = F.tid; i < 64 * 24; i += NTHR) { const int d = i / 24, c = i % 24; ((LAS unsigned short*)(Vt + d * AV_STRIDE))[256 + c] = 0; }
    const int g = F.lane >> 4, c16 = F.lane & 15;
    const float* sinkp = INP(14) + l * 16;
    bf16x8 q0n, q1n;
    { const int gi = F.wave * 4, hq = hk * 4 + (gi >> 3), qs = gi & 7; const size_t mq = (size_t)b * SEQ + blk * 128 + 16 * qs + c16;
      q0n = *(const bf16x8*)(Qg + mq * 1024 + hq * 64 + 8 * g); q1n = *(const bf16x8*)(Qg + mq * 1024 + hq * 64 + 32 + 8 * g); }
    __syncthreads();
#pragma unroll 1
    for (int it = 0; it < 4; ++it) {
        const int gi = F.wave * 4 + it, hq = hk * 4 + (gi >> 3), qs = gi & 7;
        const int tqr = 16 * qs + c16;
        const size_t mq = (size_t)b * SEQ + blk * 128 + tqr;
        const bf16x8 q0 = q0n, q1 = q1n;
        if (it < 3) { const int gn = gi + 1, hn = hk * 4 + (gn >> 3), qn_ = gn & 7; const size_t mn = (size_t)b * SEQ + blk * 128 + 16 * qn_ + c16;
            q0n = *(const bf16x8*)(Qg + mn * 1024 + hn * 64 + 8 * g); q1n = *(const bf16x8*)(Qg + mn * 1024 + hn * 64 + 32 + 8 * g); }
        f32x4 s[10];
#pragma unroll
        for (int j = 0; j < 9; ++j) { LAS const unsigned char* kr = Ks + (16 * (qs + j) + c16) * AK_STRIDE + 16 * g;
            const bf16x8 k0 = *(LAS const bf16x8*)kr, k1 = *(LAS const bf16x8*)(kr + 64);
            f32x4 a = (f32x4){0.f, 0.f, 0.f, 0.f}; a = MFMA16(k0, q0, a); a = MFMA16(k1, q1, a); s[j] = a; }
        const float sk2 = sinkp[hq] * LOG2E; float mx = sk2;
#pragma unroll
        for (int j = 0; j < 9; ++j)
#pragma unroll
            for (int r = 0; r < 4; ++r) { const int i = 16 * (qs + j) + 4 * g + r; const bool ok = (i >= tqr) && (i <= tqr + 128) && (kp0 + i >= 0);
                const float v = ok ? s[j][r] * (0.125f * LOG2E) : -1e30f; s[j][r] = v; mx = fmaxf(mx, v); }
        mx = fmaxf(mx, __shfl_xor(mx, 16)); mx = fmaxf(mx, __shfl_xor(mx, 32));
        float sum = 0.f;
#pragma unroll
        for (int j = 0; j < 9; ++j)
#pragma unroll
            for (int r = 0; r < 4; ++r) { const float p = __builtin_amdgcn_exp2f(s[j][r] - mx); s[j][r] = p; sum += p; }
        s[9] = (f32x4){0.f, 0.f, 0.f, 0.f};
        sum += __shfl_xor(sum, 16); sum += __shfl_xor(sum, 32);
        const float rl = 1.f / (sum + __builtin_amdgcn_exp2f(sk2 - mx));
        f32x4 o[4];
#pragma unroll
        for (int dt = 0; dt < 4; ++dt) o[dt] = (f32x4){0.f, 0.f, 0.f, 0.f};
#pragma unroll
        for (int kk = 0; kk < 5; ++kk) { const bf16x8 pf = pack8(s[2 * kk], s[2 * kk + 1]);
#pragma unroll
            for (int dt = 0; dt < 4; ++dt) { LAS const unsigned char* vr = Vt + (16 * dt + c16) * AV_STRIDE + (16 * (qs + 2 * kk) + 4 * g) * 2;
                const s16x4 v0 = *(LAS const s16x4*)vr, v1 = *(LAS const s16x4*)(vr + 32);
                o[dt] = MFMA16(cat44(v0, v1), pf, o[dt]); } }
        bf16* op = (bf16*)(F.ws + WS_CAT) + mq * D + hq * 64 + 4 * g;
#pragma unroll
        for (int dt = 0; dt < 4; ++dt) { const f32x4 v = o[dt] * rl; u32x2 w; w.x = cvt_pk_bf16(v.x, v.y); w.y = cvt_pk_bf16(v.z, v.w); *(u32x2*)(op + 16 * dt) = w; }
    }
    __syncthreads();
}

__device__ __forceinline__ void attn_sample_unit(const Frame& F, int l, int s_, int hf) {
    LAS float* qn = (LAS float*)F.lds;
    LAS float* kn = qn + 512;
    LAS float* vn = kn + 128;
    LAS float* sc = vn + 128;
    LAS float* rl = sc + 8 * 132;
    const int m = MP + s_; const float* sinkp = INP(14) + l * 16 + 8 * hf;
    const float* ck = INP(4) + ((size_t)l * NS + s_) * 128 * 256; const float* cv = INP(5) + ((size_t)l * NS + s_) * 128 * 256;
    { const int h = F.tid >> 6, p = F.tid & 63; qn[h * 64 + pi_d(p)] = bf2f(((const bf16*)(F.ws + WS_Q))[(size_t)m * 1024 + 512 * hf + F.tid]) * (0.125f * LOG2E); }
    if (F.tid < 128) { const int h = F.tid >> 6, p = F.tid & 63; kn[h * 64 + pi_d(p)] = bf2f(((const bf16*)(F.ws + WS_K))[(size_t)m * 256 + 128 * hf + F.tid]); vn[F.tid] = bf2f(((const bf16*)(F.ws + WS_V))[(size_t)m * 256 + 128 * hf + F.tid]); }
    { float* ko = F.out + O_KS + ((size_t)l * NS + s_) * 128 * 256; float* vo = F.out + O_VS + ((size_t)l * NS + s_) * 128 * 256; const int i0_ = 64 * hf * 64, i1_ = hf ? 127 * 64 : 64 * 64;
#pragma unroll 4
      for (int i = i0_ + F.tid; i < i1_; i += NTHR) { const f32x4 a = *(const f32x4*)(ck + 256 + 4 * i), b = *(const f32x4*)(cv + 256 + 4 * i); *(f32x4*)(ko + 4 * i) = a; *(f32x4*)(vo + 4 * i) = b; } }
    __syncthreads();
    for (int idx = F.tid; idx < 8 * 129; idx += NTHR) { const int hq = idx / 129, j = idx - hq * 129, hk = hq >> 2; float a = 0.f;
        if (j < 128) { const float* kr = ck + (size_t)j * 256 + (2 * hf + hk) * 64;
#pragma unroll
            for (int d = 0; d < 64; d += 4) { const f32x4 kv = *(const f32x4*)(kr + d); a += qn[hq * 64 + d] * kv.x + qn[hq * 64 + d + 1] * kv.y + qn[hq * 64 + d + 2] * kv.z + qn[hq * 64 + d + 3] * kv.w; } }
        else { for (int d = 0; d < 64; ++d) a += qn[hq * 64 + d] * kn[hk * 64 + d]; }
        sc[hq * 132 + j] = a; }
    __syncthreads();
    { const int hq = F.wave; const float sk2 = sinkp[hq] * LOG2E;
        float mx = sk2; for (int j = F.lane; j < 129; j += 64) mx = fmaxf(mx, sc[hq * 132 + j]);
#pragma unroll
        for (int o = 1; o < 64; o <<= 1) mx = fmaxf(mx, __shfl_xor(mx, o));
        float sum = 0.f; for (int j = F.lane; j < 129; j += 64) { const float p = __builtin_amdgcn_exp2f(sc[hq * 132 + j] - mx); sc[hq * 132 + j] = p; sum += p; }
        sum = wave_sum(sum); if (F.lane == 0) rl[hq] = 1.f / (sum + __builtin_amdgcn_exp2f(sk2 - mx)); }
    __syncthreads();
    { const int hq = F.tid >> 6, d = F.tid & 63, hk = hq >> 2; float a = 0.f; const float* vc = cv + (2 * hf + hk) * 64 + d;
#pragma unroll 16
        for (int j = 0; j < 128; ++j) a += sc[hq * 132 + j] * vc[(size_t)j * 256];
        a += sc[hq * 132 + 128] * vn[hk * 64 + d];
        ((bf16*)(F.ws + WS_CAT))[(size_t)m * D + 512 * hf + F.tid] = (bf16)f2bf(a * rl[hq]); }
    __syncthreads();
}

constexpr int PL_STRIDE = 272;
__device__ __forceinline__ void pool_unit(const Frame& F, int l, int rt, int gi) {
    LAS unsigned char* dT = F.lds; LAS unsigned char* Wt = F.lds + 128 * PL_STRIDE;
    const float* U = (const float*)(F.ws + WS_U); const int w = 2 << gi, m0 = rt * 128;
    { const bf16* pw = (const bf16*)wl(F, l, WL_PW) + (size_t)gi * 128 * 128;
      for (int ch = F.tid; ch < 2048; ch += NTHR) { const int e = ch >> 4, cc = ch & 15; *(LAS u32x4*)(Wt + e * PL_STRIDE + cc * 16) = *(const u32x4*)(pw + e * 128 + cc * 8); } }
    { const int c = F.tid & 127, strip = F.tid >> 7, col = gi * 128 + c;
      if (rt < 64) { const int t0 = (m0 & (SEQ - 1)) + 32 * strip; const float* up = U + (size_t)(m0 + 32 * strip) * 512 + col;
          float uv[47];
#pragma unroll
          for (int j = 0; j < 47; ++j) { const int t = t0 - 15 + j; uv[j] = t >= 0 ? up[(ptrdiff_t)(j - 15) * 512] : 0.f; }
          LAS unsigned short* dp = (LAS unsigned short*)(dT + (32 * strip) * PL_STRIDE) + c;
#define POOL_D(W) { float sum = 0.f; _Pragma("unroll") for (int j = 1; j < W; ++j) sum += uv[15 - j]; \
              _Pragma("unroll") for (int k = 0; k < 32; ++k) { const int t = t0 + k; sum += uv[15 + k]; const float cnt = (float)(t + 1 < W ? t + 1 : W); \
                  dp[k * (PL_STRIDE / 2)] = (unsigned short)f2bf(sum / cnt - uv[15 + k]); sum -= uv[15 + k - W + 1]; } }
          if (gi == 0) POOL_D(2) else if (gi == 1) POOL_D(4) else if (gi == 2) POOL_D(8) else POOL_D(16)
#undef POOL_D
      }
      else { const float* sp = INP(6) + (size_t)l * NS * 15 * 512;
#pragma unroll 4
          for (int k = 0; k < 32; ++k) { const int s_ = 32 * strip + k; const float uc = U[(size_t)(MP + s_) * 512 + col]; float hv[15];
#pragma unroll
              for (int j = 1; j < 16; ++j) hv[j - 1] = sp[((size_t)s_ * 15 + 15 - j) * 512 + col];
              float sum = uc;
#pragma unroll
              for (int j = 1; j < 16; ++j) sum += j < w ? hv[j - 1] : 0.f;
              ((LAS unsigned short*)(dT + s_ * PL_STRIDE))[c] = (unsigned short)f2bf(sum / (float)w - uc); } } }
    __syncthreads();
    const int g = F.lane >> 4, c16 = F.lane & 15;
    f32x4 acc[8];
#pragma unroll
    for (int et = 0; et < 8; ++et) acc[et] = (f32x4){0.f, 0.f, 0.f, 0.f};
#pragma unroll
    for (int ks = 0; ks < 4; ++ks) { const bf16x8 df = *(LAS const bf16x8*)(dT + (16 * F.wave + c16) * PL_STRIDE + (32 * ks + 8 * g) * 2);
#pragma unroll
        for (int et = 0; et < 8; ++et) { const bf16x8 wf = *(LAS const bf16x8*)(Wt + (16 * et + c16) * PL_STRIDE + (32 * ks + 8 * g) * 2); acc[et] = MFMA16(wf, df, acc[et]); } }
    const int m = m0 + 16 * F.wave + c16; const float* psc = INP(17) + l * 512 + gi * 128;
    if (m < M) { bf16* op = (bf16*)(F.ws + WS_CAT) + (size_t)m * D + 1024 + gi * 128 + 4 * g;
#pragma unroll
        for (int et = 0; et < 8; ++et) { const f32x4 v = acc[et] * *(const f32x4*)(psc + 16 * et + 4 * g); u32x2 wv; wv.x = cvt_pk_bf16(v.x, v.y); wv.y = cvt_pk_bf16(v.z, v.w); *(u32x2*)(op + 16 * et) = wv; } }
    __syncthreads();
}
__device__ __forceinline__ void state_outs(const Frame& F, int l) {
    const int gt = F.bid * NTHR + F.tid, ngt = F.G * NTHR; const float* U = (const float*)(F.ws + WS_U); const float* PR = (const float*)(F.ws + WS_PR);
    for (int i = gt; i < NB * 15 * 512; i += ngt) { const int b = i / (15 * 512), j = (i >> 9) % 15, c = i & 511; F.out[O_PP + (size_t)l * NB * 15 * 512 + i] = U[((size_t)b * SEQ + SEQ - 15 + j) * 512 + c]; }
    const float* sp = INP(6) + (size_t)l * NS * 15 * 512;
    for (int i = gt; i < NS * 15 * 512; i += ngt) { const int s_ = i / (15 * 512), j = (i >> 9) % 15, c = i & 511; F.out[O_PS + (size_t)l * NS * 15 * 512 + i] = j < 14 ? sp[i + 512] : U[(size_t)(MP + s_) * 512 + c]; }
    for (int i = gt; i < NB * RP; i += ngt) { const int b = i / RP, c = i - b * RP; F.out[O_SP + (size_t)l * NB * RP + i] = PR[((size_t)b * SEQ + SEQ - 1) * 2048 + c]; }
    for (int i = gt; i < NS * RP; i += ngt) { const int s_ = i / RP, c = i - s_ * RP; F.out[O_SS + (size_t)l * NS * RP + i] = PR[(size_t)(MP + s_) * 2048 + c]; }
}

template <int CTRL> __device__ __forceinline__ float dpp_f(float x) { return __builtin_bit_cast(float, __builtin_amdgcn_mov_dpp(__builtin_bit_cast(int, x), CTRL, 0xf, 0xf, true)); }
__device__ __forceinline__ float row16_sum(float x) {
    x += dpp_f<0xB1>(x); x += dpp_f<0x4E>(x); x += dpp_f<0x141>(x); x += dpp_f<0x128>(x); return x;
}
constexpr int RA_STRIDE = 1936;
constexpr int R_T1OFF = 32 * RA_STRIDE, RT_STRIDE = 80;
struct XmRow { const float* p; const float* pv; float pz; };
__device__ __forceinline__ XmRow xm_row(const float* PR, const float* sshift, int m) {
    XmRow r; r.p = PR + (size_t)m * 2048; const bool first = m < MP && (m & (SEQ - 1)) == 0;
    r.pv = m >= MP ? sshift + (size_t)(m - MP) * RP : first ? r.p : r.p - 2048; r.pz = first ? 0.f : 1.f; return r;
}
__device__ __forceinline__ float xm_at(const XmRow& r, const float* mu, int c) { const float p = r.p[c]; return p + (r.pv[c] * r.pz - p) * mu[c]; }
__device__ __forceinline__ f32x4 xm4_at(const XmRow& r, const float* mu, int c) { const f32x4 p = *(const f32x4*)(r.p + c); return p + (*(const f32x4*)(r.pv + c) * r.pz - p) * *(const f32x4*)(mu + c); }
template <int KS> __device__ __forceinline__ void lora_mm(f32x4 (&acc)[4], const bf16* Wt, int ldw, int nbase, LAS const unsigned char* Arow, int acol, int g, int c16) {
#pragma unroll
    for (int nt = 0; nt < 4; ++nt) acc[nt] = (f32x4){0.f, 0.f, 0.f, 0.f};
#pragma unroll
    for (int ks = 0; ks < KS; ++ks) { const bf16x8 af = *(LAS const bf16x8*)(Arow + (acol + 32 * ks + 8 * g) * 2);
#pragma unroll
        for (int nt = 0; nt < 4; ++nt) { const bf16x8 wf = *(const bf16x8*)(Wt + (size_t)(nbase + 16 * nt + c16) * ldw + 32 * ks + 8 * g); acc[nt] = MFMA16(wf, af, acc[nt]); } }
}
__device__ __forceinline__ float frcp(float x) { return __builtin_amdgcn_rcpf(x); }
__device__ __forceinline__ f32x4 fsig4(f32x4 v) { f32x4 r; r.x = frcp(1.f + __expf(-v.x)); r.y = frcp(1.f + __expf(-v.y)); r.z = frcp(1.f + __expf(-v.z)); r.w = frcp(1.f + __expf(-v.w)); return r; }
__device__ __forceinline__ void rwkv_prep_unit(const Frame& F, int l, int ti) {
    int tid_l = F.tid; asm volatile("" : "+v"(tid_l)); const int lane_l = tid_l & 63;
    LAS unsigned char* Aop = F.lds; LAS unsigned char* T1 = F.lds + R_T1OFF;
    const float* PR = (const float*)(F.ws + WS_PR); const float* sshift = INP(7) + (size_t)l * NS * RP; const float* mu = INP(19) + l * RP;
    const int m0 = ti * 32; const bool vres = l > 0;
    TSB2(70, F.lds);
#pragma unroll
    for (int q0 = 0; q0 < 8; q0 += 4) { f32x4 xv[4];
#pragma unroll
        for (int q = 0; q < 4; ++q) if (q0 + q < 7) { const int i = tid_l + (q0 + q) * NTHR, r = i / 112, c4 = i - r * 112; const XmRow xr = xm_row(PR, sshift, m0 + r); xv[q] = xm4_at(xr, mu, 1536 + 4 * c4); }
#pragma unroll
        for (int q = 0; q < 4; ++q) if (q0 + q < 7) { const int i = tid_l + (q0 + q) * NTHR, r = i / 112, c4 = i - r * 112, c = 4 * c4; f32x4 y = xv[q];
            if (c < 96) { y.x = 1.f - 2.f * frcp(1.f + __expf(2.f * y.x)); y.y = 1.f - 2.f * frcp(1.f + __expf(2.f * y.y)); y.z = 1.f - 2.f * frcp(1.f + __expf(2.f * y.z)); y.w = 1.f - 2.f * frcp(1.f + __expf(2.f * y.w)); }
            else if (c >= 192) y = fsig4(y);
            u32x2 w; w.x = cvt_pk_bf16(y.x, y.y); w.y = cvt_pk_bf16(y.z, y.w); *(LAS u32x2*)(Aop + r * RA_STRIDE + c * 2) = w; }
        asm volatile("" ::: "memory"); __builtin_amdgcn_sched_barrier(0); }
    if (vres) {
#pragma unroll
        for (int q0 = 0; q0 < 8; q0 += 4) { f32x4 xv[4];
#pragma unroll
            for (int q = 0; q < 4; ++q) { const int i = tid_l + (q0 + q) * NTHR, r = i >> 7, c4 = i & 127; const XmRow xr = xm_row(PR, sshift, m0 + r); xv[q] = xm4_at(xr, mu, 1024 + 4 * c4); }
#pragma unroll
            for (int q = 0; q < 4; ++q) { const int i = tid_l + (q0 + q) * NTHR, r = i >> 7, c4 = i & 127; u32x2 w; w.x = cvt_pk_bf16(xv[q].x, xv[q].y); w.y = cvt_pk_bf16(xv[q].z, xv[q].w); *(LAS u32x2*)(Aop + r * RA_STRIDE + (448 + 4 * c4) * 2) = w; }
            asm volatile("" ::: "memory"); __builtin_amdgcn_sched_barrier(0); } }
    __syncthreads();
    TSE2(70, F.lds); TSB2(71, F.lds);
    const int g = lane_l >> 4, c16 = lane_l & 15, nb = 64 * F.wave;
    if (vres) {
        if (F.wave < 4) { const int mt = F.wave >> 1, nt = F.wave & 1; f32x4 a = (f32x4){0.f, 0.f, 0.f, 0.f}; const bf16* w1 = (const bf16*)wl(F, 1, WL_V1) + (size_t)(16 * nt + c16) * 512 + 8 * g;
#pragma unroll
            for (int kh = 0; kh < 2; ++kh) { bf16x8 wf[8];
#pragma unroll
                for (int ks = 0; ks < 8; ++ks) wf[ks] = *(const bf16x8*)(w1 + 32 * (8 * kh + ks));
#pragma unroll
                for (int ks = 0; ks < 8; ++ks) { const bf16x8 af = *(LAS const bf16x8*)(Aop + (16 * mt + c16) * RA_STRIDE + (448 + 32 * (8 * kh + ks) + 8 * g) * 2); a = MFMA16(wf[ks], af, a); }
                asm volatile("" ::: "memory"); __builtin_amdgcn_sched_barrier(0); }
            u32x2 wv; wv.x = cvt_pk_bf16(a.x, a.y); wv.y = cvt_pk_bf16(a.z, a.w); *(LAS u32x2*)(T1 + (16 * mt + c16) * RT_STRIDE + (16 * nt + 4 * g) * 2) = wv;
#if MK_DEBUG
            *(f32x4*)((float*)(F.ws + WS_H) + (size_t)(m0 + 16 * mt + c16) * 32 + 16 * nt + 4 * g) = a;
#endif
            }
        __syncthreads();
    }
    LAS unsigned char* Aimg = F.lds + 65536; LAS unsigned char* Limg = F.lds + 65536 + 32768;
    size_t ro[2]; int mrow[2];
#pragma unroll
    for (int mt = 0; mt < 2; ++mt) { int m = m0 + 16 * mt + c16; asm volatile("" : "+v"(m)); mrow[mt] = m; ro[mt] = (size_t)m * 512 + nb + 4 * g; }
    TSE2(71, F.lds); TSB2(72, F.lds);
#define LORA_PASS(WT, LDW, ACOL, KS0, NKS, ACC) do { bf16x8 wq_[NKS][4]; const bf16* pw_ = (const bf16*)(WT) + (size_t)(nb + c16) * (LDW) + 8 * g + 32 * (KS0); \
        _Pragma("unroll") for (int ks = 0; ks < NKS; ++ks) _Pragma("unroll") for (int nt = 0; nt < 4; ++nt) wq_[ks][nt] = *(const bf16x8*)(pw_ + (size_t)16 * nt * (LDW) + 32 * ks); \
        _Pragma("unroll") for (int mt = 0; mt < 2; ++mt) { LAS const unsigned char* Arow_ = Aop + (16 * mt + c16) * RA_STRIDE + ((ACOL) + 32 * (KS0) + 8 * g) * 2; \
            _Pragma("unroll") for (int ks = 0; ks < NKS; ++ks) { const bf16x8 af_ = *(LAS const bf16x8*)(Arow_ + 64 * ks); \
                _Pragma("unroll") for (int nt = 0; nt < 4; ++nt) ACC[mt][nt] = MFMA16(wq_[ks][nt], af_, ACC[mt][nt]); } } \
        asm volatile("" ::: "memory"); __builtin_amdgcn_sched_barrier(0); } while (0)
#define LORA_ZERO(ACC) do { _Pragma("unroll") for (int mt = 0; mt < 2; ++mt) _Pragma("unroll") for (int nt = 0; nt < 4; ++nt) ACC[mt][nt] = (f32x4){0.f, 0.f, 0.f, 0.f}; } while (0)
    {
        const float* a0p = INP(22) + l * 512; f32x4 acc[2][4]; LORA_ZERO(acc); LORA_PASS(wl(F, l, WL_A2), 96, 96, 0, 2, acc); LORA_PASS(wl(F, l, WL_A2), 96, 96, 2, 1, acc);
#pragma unroll
        for (int mt = 0; mt < 2; ++mt)
#pragma unroll
            for (int nt = 0; nt < 4; ++nt) { const f32x4 a = fsig4(acc[mt][nt] + *(const f32x4*)(a0p + nb + 16 * nt + 4 * g)); u32x2 w; w.x = cvt_pk_bf16(a.x, a.y); w.y = cvt_pk_bf16(a.z, a.w);
                *(LAS u32x2*)(Aimg + ((16 * mt + c16) * 512 + nb + 16 * nt + 4 * g) * 2) = w; } }
    {
        const float* w0p = INP(20) + l * 512; float* Wb = rwbuf(F, RW_W); f32x4 acc[2][4]; LORA_ZERO(acc); LORA_PASS(wl(F, l, WL_W2), 96, 0, 0, 2, acc); LORA_PASS(wl(F, l, WL_W2), 96, 0, 2, 1, acc);
#pragma unroll
        for (int mt = 0; mt < 2; ++mt)
#pragma unroll
            for (int nt = 0; nt < 4; ++nt) { const f32x4 z = acc[mt][nt] + *(const f32x4*)(w0p + nb + 16 * nt + 4 * g); f32x4 dec;
#pragma unroll
                for (int e = 0; e < 4; ++e) { const float zz = -z[e]; const float sp = fmaxf(zz, 0.f) + __logf(1.f + __expf(-fabsf(zz))); dec[e] = __expf(-__expf(-sp - 0.5f)); }
                *(f32x4*)(Wb + ro[mt] + 16 * nt) = dec; } }
    {
        float* Gb = rwbuf(F, RW_G); f32x4 acc[2][4]; LORA_ZERO(acc); LORA_PASS(wl(F, l, WL_G2), 256, 192, 0, 2, acc); LORA_PASS(wl(F, l, WL_G2), 256, 192, 2, 2, acc); LORA_PASS(wl(F, l, WL_G2), 256, 192, 4, 2, acc); LORA_PASS(wl(F, l, WL_G2), 256, 192, 6, 2, acc);
#pragma unroll
        for (int mt = 0; mt < 2; ++mt)
#pragma unroll
            for (int nt = 0; nt < 4; ++nt) *(f32x4*)(Gb + ro[mt] + 16 * nt) = acc[mt][nt]; }
#undef LORA_PASS
#undef LORA_ZERO
    TSE2(72, F.lds); TSB2(73, F.lds);
    if (vres) {
#pragma unroll
        for (int mt = 0; mt < 2; ++mt) { const bf16x8 tf = *(LAS const bf16x8*)(T1 + (16 * mt + c16) * RT_STRIDE + (8 * g) * 2); const f32x4 z4 = (f32x4){0.f, 0.f, 0.f, 0.f};
#pragma unroll
            for (int nt = 0; nt < 4; ++nt) { const bf16x8 wf = *(const bf16x8*)((const bf16*)wl(F, 1, WL_V2) + (size_t)(nb + 16 * nt + c16) * 32 + 8 * g); const f32x4 lv = MFMA16(wf, tf, z4);
                u32x2 w; w.x = cvt_pk_bf16(lv.x, lv.y); w.y = cvt_pk_bf16(lv.z, lv.w); *(LAS u32x2*)(Limg + ((16 * mt + c16) * 512 + nb + 16 * nt + 4 * g) * 2) = w;
#if MK_DEBUG
                *(f32x4*)(rwbuf(F, RW_Y) + ro[mt] + 16 * nt) = lv;
#endif
            } } }
    __syncthreads();
    {   const float* vbp = INP(33); const float* kkp = INP(25) + l * 512; const float* kap = INP(26) + l * 512;
        float* Rb = rwbuf(F, RW_R); float* Kb = rwbuf(F, RW_K); float* Vb = rwbuf(F, RW_V); float* Ab = rwbuf(F, RW_A); float* Bb = rwbuf(F, RW_B); float* VF = rwbuf(F, RW_VF);
        const int r = tid_l >> 4, j16 = tid_l & 15; int m = m0 + r; asm volatile("" : "+v"(m)); const XmRow xr = xm_row(PR, sshift, m);
#pragma unroll 4
        for (int h = 0; h < 8; ++h) { const int n = 64 * h + 4 * j16; const size_t o = (size_t)m * 512 + n;
            const f32x4 rx = xm4_at(xr, mu, n), k = xm4_at(xr, mu, 512 + n); f32x4 v = xm4_at(xr, mu, 1024 + n);
            const u32x2 aw = *(LAS const u32x2*)(Aimg + (r * 512 + n) * 2); f32x4 a; a.x = bflo(aw.x); a.y = bfhi(aw.x); a.z = bflo(aw.y); a.w = bfhi(aw.y);
            const f32x4 kk = k * *(const f32x4*)(kkp + n);
            const float ss = row16_sum((kk.x * kk.x + kk.y * kk.y) + (kk.z * kk.z + kk.w * kk.w)), rn = 1.f / fmaxf(sqrtf(ss), 1e-12f);
            *(f32x4*)(Rb + o) = rx;
            *(f32x4*)(Kb + o) = k * ((a - 1.f) * *(const f32x4*)(kap + n) + 1.f);
            if (!vres) *(f32x4*)(VF + o) = v;
            else { const u32x2 lw = *(LAS const u32x2*)(Limg + (r * 512 + n) * 2); f32x4 lv; lv.x = bflo(lw.x); lv.y = bfhi(lw.x); lv.z = bflo(lw.y); lv.w = bfhi(lw.y);
                const f32x4 vf = *(const f32x4*)(VF + o); v = v + (vf - v) * fsig4(lv + *(const f32x4*)(vbp + n)); }
            *(f32x4*)(Vb + o) = v;
            const f32x4 kn = kk * rn; *(f32x4*)(Ab + o) = -kn; *(f32x4*)(Bb + o) = kn * a; } }
    TSE2(73, F.lds);
    __syncthreads();
}

constexpr int SC_T = 32, SC_ARR = SC_T * 64 * 4, SC_BUF = 5 * SC_ARR + SC_T * 16 * 4, SC_NSLOT = 3;
static_assert(SC_NSLOT * SC_BUF <= 131072, "scan ring fits the phase LDS");
__device__ __forceinline__ float wave_sum64(float x) { x = row16_sum(x); x += __shfl_xor(x, 16); x += __shfl_xor(x, 32); return x; }
__device__ __forceinline__ void scan_prompt_unit(const Frame& F, int l, int b, int h, int qt) {
    const size_t rowb = (size_t)b * SEQ;
    constexpr int NCH = SEQ / SC_T;
    if (F.wave >= 4) {
        const float* src0 = rwbuf(F, RW_W); const float* src1 = rwbuf(F, RW_A); const float* src2 = rwbuf(F, RW_B); const float* src3 = rwbuf(F, RW_K); const float* src4 = rwbuf(F, RW_R); const float* Vb = rwbuf(F, RW_V);
        const int lt = F.tid - 256, lw = F.wave - 4;
        const size_t g0 = (rowb + (lt >> 4)) * 512 + h * 64 + 4 * (lt & 15), g1 = g0 + (size_t)16 * 512;
        const size_t gv = (rowb + (lt >> 2)) * 512 + h * 64 + qt * 16 + 4 * (lt & 3);
        const unsigned l0 = (unsigned)lw * 1024u, l1 = l0 + 4096u;
#define SC_GL(src, goff, slot, arr, loff) __builtin_amdgcn_global_load_lds((const unsigned*)((src) + (goff)), (LAS unsigned*)(F.lds + (slot) * SC_BUF + (arr) * SC_ARR + (loff)), 16, 0, 0)
#define SC_STAGE(ch_, slot_) do { const size_t co_ = (size_t)(ch_) * SC_T * 512; \
            SC_GL(src0, g0 + co_, slot_, 0, l0); SC_GL(src0, g1 + co_, slot_, 0, l1); SC_GL(src1, g0 + co_, slot_, 1, l0); SC_GL(src1, g1 + co_, slot_, 1, l1); SC_GL(src2, g0 + co_, slot_, 2, l0); SC_GL(src2, g1 + co_, slot_, 2, l1); \
            SC_GL(src3, g0 + co_, slot_, 3, l0); SC_GL(src3, g1 + co_, slot_, 3, l1); SC_GL(src4, g0 + co_, slot_, 4, l0); SC_GL(src4, g1 + co_, slot_, 4, l1); \
            if (lw < 2) SC_GL(Vb, gv + co_, slot_, 5, l0); } while (0)
        SC_STAGE(0, 0); SC_STAGE(1, 1);
        if (lw < 2) asm volatile("s_waitcnt vmcnt(11)" ::: "memory"); else asm volatile("s_waitcnt vmcnt(10)" ::: "memory");
        __builtin_amdgcn_s_barrier();
        int slot = 2;
        for (int ch = 0; ch < NCH; ++ch) {
            if (ch + 2 < NCH) { SC_STAGE(ch + 2, slot);
                if (lw < 2) asm volatile("s_waitcnt vmcnt(11)" ::: "memory"); else asm volatile("s_waitcnt vmcnt(10)" ::: "memory"); }
            else asm volatile("s_waitcnt vmcnt(0)" ::: "memory");
            __builtin_amdgcn_s_barrier();
            slot = slot == 2 ? 0 : slot + 1;
        }
#undef SC_GL
#undef SC_STAGE
    } else {
        float* Yb = rwbuf(F, RW_Y);
        const int rg = F.lane >> 4, j4 = F.lane & 15, rloc = F.wave * 4 + rg;
        f32x4 s = (f32x4){0.f, 0.f, 0.f, 0.f}; float yk = 0.f, ypart = 0.f;
        float* yp = Yb + (rowb + j4) * 512 + h * 64 + qt * 16 + rloc;
        __builtin_amdgcn_s_barrier(); asm volatile("" ::: "memory");
        int slot = 0;
        for (int ch = 0; ch < NCH; ++ch) {
            LAS const unsigned char* bp = F.lds + slot * SC_BUF + j4 * 16; LAS const float* vp = (LAS const float*)(F.lds + slot * SC_BUF + 5 * SC_ARR) + rloc;
            f32x4 w = *(LAS const f32x4*)(bp + 0 * SC_ARR), a = *(LAS const f32x4*)(bp + 1 * SC_ARR), bb = *(LAS const f32x4*)(bp + 2 * SC_ARR), k = *(LAS const f32x4*)(bp + 3 * SC_ARR), r = *(LAS const f32x4*)(bp + 4 * SC_ARR);
            float v = vp[0];
#pragma unroll
            for (int tt = 0; tt < SC_T; ++tt) {
                const f32x4 p = s * w + k * v;
                __builtin_amdgcn_sched_barrier(0);
                f32x4 wn = w, an = a, bn = bb, kn = k, rn = r; float vn = v;
                if (tt + 1 < SC_T) { wn = *(LAS const f32x4*)(bp + 0 * SC_ARR + (tt + 1) * 256); an = *(LAS const f32x4*)(bp + 1 * SC_ARR + (tt + 1) * 256); bn = *(LAS const f32x4*)(bp + 2 * SC_ARR + (tt + 1) * 256);
                    kn = *(LAS const f32x4*)(bp + 3 * SC_ARR + (tt + 1) * 256); rn = *(LAS const f32x4*)(bp + 4 * SC_ARR + (tt + 1) * 256); vn = vp[(tt + 1) * 16]; }
                __builtin_amdgcn_sched_barrier(0);
                const float yprev = row16_sum(ypart);
                const float sa = row16_sum((s.x * a.x + s.y * a.y) + (s.z * a.z + s.w * a.w));
                s = bb * sa + p;
                ypart = (s.x * r.x + s.y * r.y) + (s.z * r.z + s.w * r.w);
                if (tt > 0) { yk = (j4 == ((tt - 1) & 15)) ? yprev : yk; if (((tt - 1) & 15) == 15) yp[(size_t)(ch * SC_T + ((tt - 1) & ~15)) * 512] = yk; }
                else if (ch > 0) { yk = (j4 == 15) ? yprev : yk; yp[(size_t)((ch - 1) * SC_T + 16) * 512] = yk; }
                w = wn; a = an; bb = bn; k = kn; r = rn; v = vn;
            }
            __builtin_amdgcn_s_barrier(); asm volatile("" ::: "memory");
            slot = slot == 2 ? 0 : slot + 1;
        }
        { const float ylast = row16_sum(ypart); yk = (j4 == 15) ? ylast : yk; yp[(size_t)((NCH - 1) * SC_T + 16) * 512] = yk; }
        *(f32x4*)(F.out + O_WP + ((((size_t)l * NB + b) * 8 + h) * 64 + qt * 16 + rloc) * 64 + 4 * j4) = s;
    }
    __syncthreads();
}
__device__ __forceinline__ void scan_sample_wave(const Frame& F, int l, int s_, int h) {
    const size_t m = MP + s_; const int rg = F.lane >> 4, j4 = F.lane & 15; const size_t o = m * 512 + h * 64 + 4 * j4;
    const f32x4 w = *(const f32x4*)(rwbuf(F, RW_W) + o), a = *(const f32x4*)(rwbuf(F, RW_A) + o), bb = *(const f32x4*)(rwbuf(F, RW_B) + o), k = *(const f32x4*)(rwbuf(F, RW_K) + o), r = *(const f32x4*)(rwbuf(F, RW_R) + o);
    const float* S0 = INP(8) + (((size_t)l * NS + s_) * 8 + h) * 4096; float* S1 = F.out + O_WS + (((size_t)l * NS + s_) * 8 + h) * 4096;
    const int row = 4 * j4 + rg; const size_t orow = m * 512 + h * 64 + row;
    const float v_my = rwbuf(F, RW_V)[orow], g_my = rwbuf(F, RW_G)[orow], rk_r = INP(27)[l * 512 + h * 64 + row], lg_r = INP(28)[l * 512 + h * 64 + row], lb_r = INP(29)[l * 512 + h * 64 + row];
    const f32x4 rk4 = *(const f32x4*)(INP(27) + l * 512 + h * 64 + 4 * j4);
    (void)rk_r;
    float yk = 0.f;
#pragma unroll 4
    for (int i0 = 0; i0 < 16; ++i0) { const int i = 4 * i0 + rg; f32x4 s = *(const f32x4*)(S0 + i * 64 + 4 * j4); const float v = rwbuf(F, RW_V)[m * 512 + h * 64 + i];
        const float sa = row16_sum((s.x * a.x + s.y * a.y) + (s.z * a.z + s.w * a.w));
        s = s * w + bb * sa + k * v;
        const float y = row16_sum((s.x * r.x + s.y * r.y) + (s.z * r.z + s.w * r.w));
        *(f32x4*)(S1 + i * 64 + 4 * j4) = s; yk = (j4 == i0) ? y : yk; }
    const float bon = row16_sum((r.x * k.x * rk4.x + r.y * k.y * rk4.y) + (r.z * k.z * rk4.z + r.w * k.w * rk4.w));
    const float mu = wave_sum64(yk) * (1.f / 64.f), dv = yk - mu, var = wave_sum64(dv * dv) * (1.f / 64.f);
    ((bf16*)(F.ws + WS_CAT))[m * D + 1536 + h * 64 + row] = (bf16)f2bf((dv * rsqrtf(var + 64e-5f) * lg_r + lb_r + bon * v_my) * g_my);
#if MK_DEBUG
    rwbuf(F, RW_Y)[orow] = yk;
#endif
}
__device__ __forceinline__ void rwkv_post_phase(const Frame& F, int l) {
    const int gw = F.bid * NWAVES + F.wave, NGW = F.G * NWAVES; const float* rkp = INP(27) + l * 512; const float* lgp = INP(28) + l * 512; const float* lbp = INP(29) + l * 512;
    const float* Yb = rwbuf(F, RW_Y); const float* Rb = rwbuf(F, RW_R); const float* Kb = rwbuf(F, RW_K); const float* Vb = rwbuf(F, RW_V); const float* Gb = rwbuf(F, RW_G);
    for (int it0 = gw * 4; it0 < MP * 8; it0 += NGW * 4) {
        float y[4], r[4], k[4], v[4], g[4];
#pragma unroll
        for (int q = 0; q < 4; ++q) { const int it = it0 + q, m = it >> 3, h = it & 7; const size_t o = (size_t)m * 512 + h * 64 + F.lane; y[q] = Yb[o]; r[q] = Rb[o]; k[q] = Kb[o]; v[q] = Vb[o]; g[q] = Gb[o]; }
#pragma unroll
        for (int q = 0; q < 4; ++q) { const int it = it0 + q, m = it >> 3, h = it & 7, c = h * 64 + F.lane;
            const float mu = wave_sum64(y[q]) * (1.f / 64.f), dv = y[q] - mu, var = wave_sum64(dv * dv) * (1.f / 64.f), bon = wave_sum64(r[q] * k[q] * rkp[c]);
            ((bf16*)(F.ws + WS_CAT))[(size_t)m * D + 1536 + c] = (bf16)f2bf((dv * rsqrtf(var + 64e-5f) * lgp[c] + lbp[c] + bon * v[q]) * g[q]); }
    }
}
}
namespace mk {
namespace cg = cooperative_groups;
constexpr int LDS_BYTES = 135168;
constexpr int TS_OFF = LDS_BYTES - 64;
#ifdef MK_TS_ID
#ifndef MK_TS_BLOCK
#define MK_TS_BLOCK 0
#endif
#ifndef MK_TS_AMP
#define MK_TS_AMP 8
#endif
#define TSB(id, ldsp) do { if ((id) == MK_TS_ID && blockIdx.x == MK_TS_BLOCK && threadIdx.x == 0) *(volatile LAS unsigned*)((ldsp) + TS_OFF) -= (unsigned)__builtin_amdgcn_s_memrealtime(); } while (0)
#define TSE(id, ldsp) do { if ((id) == MK_TS_ID && blockIdx.x == MK_TS_BLOCK && threadIdx.x == 0) *(volatile LAS unsigned*)((ldsp) + TS_OFF) += (unsigned)__builtin_amdgcn_s_memrealtime(); } while (0)
#else
#define TSB(id, ldsp) do {} while (0)
#define TSE(id, ldsp) do {} while (0)
#endif
constexpr int PH_PRO = 0, PH_ADA = 1, PH_L0 = 2, PH_PER_L = 10, PH_FINAL = PH_L0 + NL * PH_PER_L, N_PHASES = PH_FINAL + 1;
enum { LP_NORM1 = 0, LP_IN, LP_MIX, LP_SCAN, LP_POST, LP_MG, LP_WO, LP_NORM2, LP_GU, LP_DN };

__device__ __forceinline__ void mix_phase(const Frame& F, int l) {
    TSB(40, F.lds);
    for (int u = F.bid; u < 256; u += F.G) rwkv_prep_unit(F, l, u);
    TSE(40, F.lds);
    TSB(44, F.lds); state_outs(F, l); TSE(44, F.lds);
}
enum { CT_SPREP = 0, CT_NSB = 2, CT_MGS = 4, CT_GUS = 6 };
__device__ __forceinline__ unsigned* ctl_word(const Frame& F, int which, int l) { return (unsigned*)(F.ws + WS_CTL) + 64 * (which + l); }
__device__ __forceinline__ void ctl_arrive(const Frame& F, unsigned* w) {
    asm volatile("s_waitcnt vmcnt(0)" ::: "memory"); __syncthreads();
    if (F.tid == 0) { __builtin_amdgcn_fence(__ATOMIC_RELEASE, "agent"); asm volatile("s_waitcnt vmcnt(0)" ::: "memory"); __hip_atomic_fetch_add(w, 1u, __ATOMIC_RELAXED, __HIP_MEMORY_SCOPE_AGENT); }
}
__device__ __forceinline__ void ctl_wait(const Frame& F, unsigned* w, unsigned need) {
    if (F.tid == 0) { unsigned sp = 0; while (__hip_atomic_load(w, __ATOMIC_RELAXED, __HIP_MEMORY_SCOPE_AGENT) < need && ++sp < (1u << 26)) __builtin_amdgcn_s_sleep(8);
        __builtin_amdgcn_fence(__ATOMIC_ACQUIRE, "agent"); asm volatile("s_waitcnt vmcnt(0)" ::: "memory"); }
    __syncthreads();
}
#ifndef SAMPLE_BESIDE_SCAN
#define SAMPLE_BESIDE_SCAN 1
#endif
#ifndef DN_SAMPLE_IN_GU
#define DN_SAMPLE_IN_GU 1
#endif
constexpr int SCAN_BLOCKS = 64;
constexpr int GL_PM_SPLIT = 10;
__device__ __forceinline__ void scan_phase(const Frame& F, int l) {
    if (F.bid < SCAN_BLOCKS) scan_prompt_unit(F, l, F.bid >> 5, (F.bid >> 2) & 7, F.bid & 3);
    else { const int nb_ = F.G - SCAN_BLOCKS, wb = F.bid - SCAN_BLOCKS; const int nw = nb_ * NWAVES;
        if (wb < 4) { rwkv_prep_unit(F, l, 256 + wb); ctl_arrive(F, ctl_word(F, CT_SPREP, l)); }
        TSB(41, F.lds);
        for (int a = wb; a < 256; a += nb_) attn_prompt_unit(F, l, a >> 7, (a >> 2) & 31, a & 3);
        TSE(41, F.lds); TSB(42, F.lds);
        for (int p = (wb + 64) % nb_; p < 260; p += nb_) pool_unit(F, l, p >> 2, p & 3);
        TSE(42, F.lds); TSB(43, F.lds);
        for (int s_ = (wb + 132) % nb_; s_ < 2 * NS; s_ += nb_) attn_sample_unit(F, l, s_ >> 1, s_ & 1);
        TSE(43, F.lds);
        for (int job = 0; job < (SAMPLE_BESIDE_SCAN == 1 ? 3 : SAMPLE_BESIDE_SCAN == 2 ? 2 : 1); ++job) {
            Frame Fj = F; int tidj = F.tid; { GAS unsigned char* w_ = (GAS unsigned char*)F.ws; GAS float* o_ = (GAS float*)F.out; asm volatile("" : "+v"(tidj), "+s"(w_), "+s"(o_)); Fj.tid = tidj; Fj.lane = tidj & 63; Fj.ws = (unsigned char*)w_; Fj.out = (float*)o_; }
            Gemm g; g.layer = l; g.ld = D; g.M = MPAD; g.K = D; Sched S; Epi E; E.F = &Fj; E.layer = l;
            if (job == 0) { g.N = NIN; g.A = (const bf16*)(Fj.ws + WS_H); g.Bt = (const bf16*)wl(Fj, l, WL_IN); g.mode = G_IN; S.init(Rect{GL_PM_SPLIT, MPAD / BM - GL_PM_SPLIT, 16, 24}, Rect{0, 0, 0, 0}, nb_, wb, 1); }
            else if (job == 1) { g.N = D; g.A = (const bf16*)(Fj.ws + WS_CAT); g.Bt = (const bf16*)wl(Fj, l, WL_CAT); g.mode = G_MG; S.init(Rect{0, 0, 0, 0}, Rect{MPAD / BM - 1, 1, 0, 32}, 32, wb < 32 ? wb : 1 << 20, 1, 8); }
            else { g.N = D; g.A = (const bf16*)(Fj.ws + WS_MG); g.Bt = (const bf16*)wl(Fj, l, WL_O); g.mode = G_WO; S.init(Rect{0, 0, 0, 0}, Rect{MPAD / BM - 1, 1, 0, 32}, 32, wb < 32 ? wb : 1 << 20, 1, 8);
                if (wb < 32) {
                    ctl_wait(Fj, ctl_word(Fj, CT_MGS, l), 32u);
                    const int ks = wb >> 3; const float* sl = (const float*)(Fj.ws + WS_SLABM); bf16* mg = (bf16*)(Fj.ws + WS_MG) + (size_t)MP * D;
                    for (int i = tidj; i < NS * 128; i += NTHR) { const int r = i >> 7, c = ks * 512 + (i & 127) * 4; const size_t o = (size_t)r * D + c;
                        const f32x4 v = *(const f32x4*)(sl + o) + *(const f32x4*)(sl + (size_t)NS * D + o) + *(const f32x4*)(sl + (size_t)2 * NS * D + o) + *(const f32x4*)(sl + (size_t)3 * NS * D + o);
                        u32x2 w; w.x = cvt_pk_bf16(v.x, v.y); w.y = cvt_pk_bf16(v.z, v.w); *(u32x2*)(mg + o) = w; }
                    asm volatile("s_waitcnt vmcnt(0)" ::: "memory"); __syncthreads(); } }
            E.mode = g.mode;
            TSB(45, F.lds); gemm_phase(Fj.lds, g, S, E, tidj); TSE(45, F.lds);
            if (job == 0) {
                Frame Fp = F; { int t_ = F.tid; GAS unsigned char* w_ = (GAS unsigned char*)F.ws; GAS float* o_ = (GAS float*)F.out; asm volatile("" : "+v"(t_), "+s"(w_), "+s"(o_)); Fp.tid = t_; Fp.lane = t_ & 63; Fp.ws = (unsigned char*)w_; Fp.out = (float*)o_; }
                if (l == 0) { TSB(46, F.lds); p0_prologue(Fp, 2, false, wb, nb_, 0); TSE(46, F.lds); }
                ctl_wait(Fp, ctl_word(Fp, CT_SPREP, l), 4u);
                for (int u = wb * NWAVES + Fp.wave; u < NS * 8; u += nw) scan_sample_wave(Fp, l, u >> 3, u & 7);
                ctl_arrive(Fp, ctl_word(Fp, CT_NSB, l));
                if (SAMPLE_BESIDE_SCAN && wb < 32) ctl_wait(Fp, ctl_word(Fp, CT_NSB, l), (unsigned)nb_);
            } else if (job == 1 && wb < 32) ctl_arrive(Fj, ctl_word(Fj, CT_MGS, l));
        } }
}


#define XB_TMO      128
#define XB_XCNT(j)  (256  + 64 * (j))
#define XB_XSUB(j)  (1280 + 64 * (j))
#define XB_XGEN(j)  (2304 + 64 * (j))
#define XB_TOP      3328
#define XB_TOPGEN   3392
#define XCD_BAR_WORDS 3456
#define XB_SPIN_CAP (1u << 18)

__device__ __forceinline__ unsigned xb_ld(unsigned* p)              { return __hip_atomic_load(p, __ATOMIC_RELAXED, __HIP_MEMORY_SCOPE_AGENT); }
__device__ __forceinline__ unsigned xb_add(unsigned* p, unsigned v) { return __hip_atomic_fetch_add(p, v, __ATOMIC_RELAXED, __HIP_MEMORY_SCOPE_AGENT); }
__device__ __forceinline__ unsigned xb_xcc_id() { return (unsigned)__builtin_amdgcn_s_getreg((3 << 11) | 20) & 0xFu; }
#define XB_SPIN(cond, bar) do { unsigned _sp = 0; while (cond) { __builtin_amdgcn_s_sleep(1); \
    if ((++_sp & 255u) == 0u) { if (xb_ld(&(bar)[XB_TMO])) break; if (_sp > XB_SPIN_CAP) { atomicAdd(&(bar)[XB_TMO], 1u); break; } } } } while (0)

struct XcdBarrier {
    unsigned* bar; unsigned x;
    volatile LAS unsigned* st;
};

__device__ __forceinline__ XcdBarrier xcd_barrier_post(unsigned* bar, volatile LAS unsigned* st) {
    XcdBarrier b; b.bar = bar; b.x = xb_xcc_id(); b.st = st;
    if (threadIdx.x == 0) (void)xb_add(&bar[XB_XCNT(b.x)], 1u);
    return b;
}
__device__ __forceinline__ void xcd_barrier_complete(unsigned* bar, unsigned x, unsigned& nloc, unsigned& nx) {
    const unsigned G = gridDim.x * gridDim.y * gridDim.z;
    unsigned sum, cnt, mine, sp = 0u;
    for (;;) {
        sum = 0u; cnt = 0u; mine = 0u;
#pragma unroll
        for (unsigned j = 0; j < 16; ++j) { const unsigned c = xb_ld(&bar[XB_XCNT(j)]); sum += c; cnt += (c > 0u) ? 1u : 0u; mine = (j == x) ? c : mine; }
        if (sum == G) break;
        __builtin_amdgcn_s_sleep(1);
        if ((++sp & 255u) == 0u) { if (xb_ld(&bar[XB_TMO])) break; if (sp > XB_SPIN_CAP) { atomicAdd(&bar[XB_TMO], 1u); break; } }
    }
    nloc = mine > 0u ? mine : 1u; nx = cnt > 0u ? cnt : 1u;
}

__device__ __forceinline__ void xcd_barrier(const XcdBarrier& b) {
    asm volatile("s_waitcnt vmcnt(0)" ::: "memory");
    __syncthreads();
    if (threadIdx.x == 0) {
        unsigned* bar = b.bar;
        __builtin_amdgcn_s_waitcnt(0);
        unsigned nloc = b.st[0], nx = b.st[1];
        if (nloc == 0u) { xcd_barrier_complete(bar, b.x, nloc, nx); b.st[0] = nloc; b.st[1] = nx; }
        const unsigned old = xb_add(&bar[XB_XSUB(b.x)], 1u);
        const unsigned gen = old / nloc;
        if (old + 1u == (gen + 1u) * nloc) {
            __builtin_amdgcn_fence(__ATOMIC_RELEASE, "agent");
            asm volatile("s_waitcnt vmcnt(0)" ::: "memory");
            const unsigned og = xb_add(&bar[XB_TOP], 1u);
            const unsigned tg = og / nx;
            if (og + 1u == (tg + 1u) * nx) xb_add(&bar[XB_TOPGEN], 1u);
            else XB_SPIN(xb_ld(&bar[XB_TOPGEN]) == tg, bar);
            __builtin_amdgcn_fence(__ATOMIC_ACQUIRE, "agent");
            xb_add(&bar[XB_XGEN(b.x)], 1u);
            asm volatile("s_waitcnt vmcnt(0)" ::: "memory");
        } else {
            XB_SPIN(xb_ld(&bar[XB_XGEN(b.x)]) == gen, bar);
            __builtin_amdgcn_fence(__ATOMIC_ACQUIRE, "agent");
            asm volatile("s_waitcnt vmcnt(0)" ::: "memory");
        }
    }
    __syncthreads();
}


#define MKF() Frame F; { GAS unsigned char* ws_ = (GAS unsigned char*)args.ws; GAS float* out_ = (GAS float*)args.out; int bid_ = blockIdx.x; int G_ = gridDim.x; int wv_ = wave_s; unsigned z_ = 0u; \
            asm volatile("" : "+s"(ws_), "+s"(out_), "+s"(bid_), "+s"(G_), "+s"(wv_), "+s"(z_)); \
            const int tid_ = wv_ * 64 + (int)__builtin_amdgcn_mbcnt_hi(~0u, __builtin_amdgcn_mbcnt_lo(~0u, z_));       \
            F.lds = (LAS unsigned char*)lds_raw; F.tid = tid_; F.lane = tid_ & 63; F.wave = wv_; F.G = G_; F.bid = bid_; F.out = (float*)out_; F.ws = (unsigned char*)ws_; }
__global__ void __launch_bounds__(NTHR, 2) __attribute__((target("no-packed-fp32-ops"))) mega(Args args) {
    extern __shared__ __attribute__((aligned(16))) unsigned char lds_raw[];
    cg::grid_group grid = cg::this_grid();
    const int wave_s = __builtin_amdgcn_readfirstlane((int)threadIdx.x >> 6);
    if (threadIdx.x < 2) ((volatile LAS unsigned*)((LAS unsigned char*)lds_raw + TS_OFF - 64))[threadIdx.x] = 0u;
    asm volatile("s_waitcnt lgkmcnt(0)" ::: "memory"); __builtin_amdgcn_s_barrier(); asm volatile("" ::: "memory");
    const XcdBarrier xbar = xcd_barrier_post((unsigned*)(args.ws + WS_CTL + 4096), (volatile LAS unsigned*)((LAS unsigned char*)lds_raw + TS_OFF - 64));
#ifdef MK_TS_ID
    if (threadIdx.x == 0) *(volatile LAS unsigned*)((LAS unsigned char*)lds_raw + TS_OFF) = 0u;
#endif
    for (int ph = args.ph_lo; ph < args.ph_hi; ++ph) {
        MKF();
        const int l = ph >= PH_L0 && ph < PH_FINAL ? (ph - PH_L0) / PH_PER_L : 0, lp = ph >= PH_L0 && ph < PH_FINAL ? (ph - PH_L0) % PH_PER_L : -1;
        TSB(ph == PH_PRO ? 1 : ph == PH_ADA ? 2 : ph == PH_FINAL ? 3 : 10 + lp, (LAS unsigned char*)lds_raw);
#ifndef MK_NO_PRO
        if (ph == PH_PRO) p0_prologue(F, 0, true, F.bid, F.G, 0); else
#endif
#ifndef MK_NO_NORM
        if (ph == PH_FINAL || lp == LP_NORM1 || lp == LP_NORM2) { norm_phase(F, l, ph == PH_FINAL ? 2 : lp == LP_NORM1 ? 0 : 1, ph == PH_FINAL ? 11 : lp == LP_NORM2 ? 4 : (l > 0 ? 11 : 0)); } else
#endif
#ifndef MK_NO_MIX
        if (lp == LP_MIX) { mix_phase(F, l);
#ifdef MK_DUP_MIX
            __syncthreads(); mix_phase(F, l);
#endif
        } else
#endif
#ifndef MK_NO_SCAN
        if (lp == LP_SCAN) { scan_phase(F, l);
#ifdef MK_DUP_SCAN
            __syncthreads(); scan_phase(F, l);
#endif
        } else
#endif
#ifndef MK_NO_POST
        if (lp == LP_POST) { rwkv_post_phase(F, l); } else
#endif
#ifndef MK_NO_GEMM
        {
            Gemm g; g.layer = l; g.ld = D; g.M = MPAD; g.K = D;
            if (ph == PH_ADA) { g.A = (const bf16*)(F.ws + WS_SILC); g.Bt = (const bf16*)(F.ws + WS_ADAW); g.M = 256; g.N = 2 * NADA; g.mode = G_ADA; }
            else if (lp == LP_IN) { g.A = (const bf16*)(F.ws + WS_H); g.Bt = (const bf16*)wl(F, l, WL_IN); g.N = NIN; g.mode = G_IN; }
            else if (lp == LP_MG) { g.A = (const bf16*)(F.ws + WS_CAT); g.Bt = (const bf16*)wl(F, l, WL_CAT); g.N = D; g.mode = G_MG; }
            else if (lp == LP_WO) { g.A = (const bf16*)(F.ws + WS_MG); g.Bt = (const bf16*)wl(F, l, WL_O); g.N = D; g.mode = G_WO; }
            else if (lp == LP_GU) { g.A = (const bf16*)(F.ws + WS_H); g.Bt = (const bf16*)wl(F, l, WL_GU); g.N = NGU; g.mode = G_GU; }
            else { g.A = (const bf16*)(F.ws + WS_GT); g.Bt = (const bf16*)wl(F, l, WL_DN); g.N = D; g.K = DFF; g.ld = DFF; g.mode = G_DN; }
            Sched S; Epi E; E.F = &F; E.mode = g.mode; E.layer = l;
            if (SAMPLE_BESIDE_SCAN != 1 && g.mode == G_WO && F.bid < 32) {
                const int ks = F.bid >> 3; const float* sl = (const float*)(F.ws + WS_SLABM); bf16* mg = (bf16*)(F.ws + WS_MG) + (size_t)MP * D;
                for (int i = F.tid; i < NS * 128; i += NTHR) { const int r = i >> 7, c = ks * 512 + (i & 127) * 4; const size_t o = (size_t)r * D + c;
                    const f32x4 v = *(const f32x4*)(sl + o) + *(const f32x4*)(sl + (size_t)NS * D + o) + *(const f32x4*)(sl + (size_t)2 * NS * D + o) + *(const f32x4*)(sl + (size_t)3 * NS * D + o);
                    u32x2 w; w.x = cvt_pk_bf16(v.x, v.y); w.y = cvt_pk_bf16(v.z, v.w); *(u32x2*)(mg + o) = w; }
                asm volatile("s_waitcnt vmcnt(0)" ::: "memory"); __syncthreads();
            }
            if (lp == LP_IN && ph != PH_ADA) S.init(Rect{0, MPAD / BM, 0, 16}, Rect{0, GL_PM_SPLIT, 16, 24}, F.G, F.bid, 1);
            else if ((g.mode == G_WO && SAMPLE_BESIDE_SCAN != 1) || (g.mode == G_MG && SAMPLE_BESIDE_SCAN == 0)) S.init(Rect{0, MPAD / BM - 1, 0, 8}, Rect{MPAD / BM - 1, 1, 0, 32}, F.G, F.bid, 1, 8);
            else if (g.mode == G_DN && DN_SAMPLE_IN_GU == 0) S.init(Rect{0, MPAD / BM - 1, 0, 8}, Rect{MPAD / BM - 1, 1, 0, 88}, F.G, F.bid, 1, 8);
            else if (g.mode == G_WO || g.mode == G_DN || g.mode == G_MG) S.init(Rect{0, MPAD / BM - 1, 0, 8}, Rect{0, 0, 0, 0}, F.G, F.bid, 1);
            else if (g.mode == G_GU) S.init(Rect{MPAD / BM - 1, 1, 0, NGU / BM}, Rect{0, MPAD / BM - 1, 0, NGU / BM}, F.G, F.bid, 1);
            else S.init(Rect{0, g.M / BM, 0, g.N / BM}, Rect{0, 0, 0, 0}, F.G, F.bid, 1);
            const bool gu = g.mode == G_GU && DN_SAMPLE_IN_GU != 0;
            for (int sub = 0; sub < (gu ? 2 : 1); ++sub) {
                if (sub == 1) {
                    constexpr int nfree = 256 - (1452 - 5 * 256); const int fb = F.bid - (F.G - nfree); const bool std_grid = F.G == 256;
                    g.ld = DFF; g.K = DFF; g.N = D; g.A = (const bf16*)(F.ws + WS_GT); g.Bt = (const bf16*)wl(F, l, WL_DN); g.mode = G_DN; E.mode = G_DN;
                    if (std_grid) S.init(Rect{0, 0, 0, 0}, Rect{MPAD / BM - 1, 1, 0, 88}, nfree, fb >= 0 ? fb : 1 << 20, 1, 8); else S.init(Rect{0, 0, 0, 0}, Rect{MPAD / BM - 1, 1, 0, 88}, F.G, F.bid, 1, 8);
                    if (!std_grid || fb >= 0) ctl_wait(F, ctl_word(F, CT_GUS, l), 44u * 8u);
                }
                gemm_phase(F.lds, g, S, E, F.tid);
            }
            if (ph == PH_ADA) { if (F.bid < 96) p0_prologue(F, 1, false, F.bid, 96, 2); else p0_prologue(F, 1, false, F.bid - 96, F.G - 96, 1); }
        }
#else
        {}
#endif
        TSE(ph == PH_PRO ? 1 : ph == PH_ADA ? 2 : ph == PH_FINAL ? 3 : 10 + lp, (LAS unsigned char*)lds_raw);
        TSB(30, (LAS unsigned char*)lds_raw);
        if (ph + 1 < args.ph_hi) { if (args.ph_hi < 0) grid.sync();   else xcd_barrier(xbar); }
        TSE(30, (LAS unsigned char*)lds_raw);
    }
#ifdef MK_EXTRA_SYNCS
    for (int i = 0; i < MK_EXTRA_SYNCS; ++i) xcd_barrier(xbar);
#endif
#ifdef MK_TS_ID
    if (blockIdx.x == MK_TS_BLOCK && threadIdx.x == 0) { const unsigned want = *(volatile LAS unsigned*)((LAS unsigned char*)lds_raw + TS_OFF) * (unsigned)MK_TS_AMP; const unsigned t0 = (unsigned)__builtin_amdgcn_s_memrealtime();
        while ((unsigned)__builtin_amdgcn_s_memrealtime() - t0 < want) __builtin_amdgcn_s_sleep(32); }
#endif
}
}
#ifndef MK_DEBUG
#define MK_DEBUG 0
#endif
extern "C" void kernel_launch(void* const* d_in, const int* in_sizes, int n_in, void* d_out, int out_size, void* d_ws, size_t ws_size, hipStream_t stream) {
    using namespace mk;
    static int grid = 0;
    if (grid == 0) {
        nv::WS wtmp; const size_t need_nv = nv::carve((float*)d_ws, wtmp) * 4; const size_t need = MK_DEBUG ? (need_nv > WS_END ? need_nv : WS_END) + (16u << 20) : WS_END;
        if (n_in != 39 || (size_t)out_size != O_END || ws_size < need) { fprintf(stderr, "kernel_launch: unexpected shapes: n_in %d out %d (want %zu) ws %zu (need %zu)\n", n_in, out_size, (size_t)O_END, ws_size, need); grid = -1; return; }
        int dev = 0, cus = 0, per_cu = 0;
        if (hipGetDevice(&dev) != hipSuccess || hipDeviceGetAttribute(&cus, hipDeviceAttributeMultiprocessorCount, dev) != hipSuccess) { grid = -1; return; }
        if (hipFuncSetAttribute((const void*)mega, hipFuncAttributeMaxDynamicSharedMemorySize, LDS_BYTES) != hipSuccess) { fprintf(stderr, "kernel_launch: hipFuncSetAttribute failed\n"); grid = -1; return; }
        if (hipOccupancyMaxActiveBlocksPerMultiprocessor(&per_cu, (const void*)mega, NTHR, LDS_BYTES) != hipSuccess || per_cu < 1) { fprintf(stderr, "kernel_launch: occupancy query says %d blocks per CU\n", per_cu); per_cu = 1; }
        (void)hipGetLastError();
        grid = cus;
        fprintf(stderr, "kernel_launch: grid %d (cus %d, per_cu %d), ws %zu need %zu\n", grid, cus, per_cu, ws_size, need);
    }
    if (grid < 0) return;
    Args a{};
    for (int i = 0; i < 39; ++i) a.in[i] = (const float*)d_in[i];
    a.out = (float*)d_out; a.ws = (unsigned char*)d_ws;
    if (hipMemsetAsync((unsigned char*)d_ws + WS_CTL, 0, WS_CTL_BYTES, stream) != hipSuccess) { fprintf(stderr, "kernel_launch: hipMemsetAsync of the control words failed\n"); return; }
#if MK_DEBUG
    dbg::Ctx dc; dc.probes = (float*)((unsigned char*)d_ws + ((ws_size - (12u << 20)) & ~(size_t)255)); dc.err = dc.probes + (size_t)dbg::NIDS * dbg::NPROBE; dc.on = 1;
    (void)hipMemsetAsync(dc.err, 0, dbg::NIDS * 4 * sizeof(float), stream);
    unsigned char* ws = (unsigned char*)d_ws;
    for (int ph = 0; ph < N_PHASES; ++ph) {
        a.ph_lo = ph; a.ph_hi = ph + 1;
        hipLaunchKernelGGL(mega, dim3(grid), dim3(NTHR), LDS_BYTES, stream, a);
        using namespace dbg;
        const int l = ph >= PH_L0 && ph < PH_FINAL ? (ph - PH_L0) / PH_PER_L : 0, lp = ph >= PH_L0 && ph < PH_FINAL ? (ph - PH_L0) % PH_PER_L : -1, tb = T_L0 + l * T_PER_L;
        if (ph == PH_ADA) save(&dc, stream, T_MOD, ws + WS_MOD, K_F32, NADA, 0, NL * NMOD, NADA);
        if (lp == LP_NORM1) save(&dc, stream, tb + T_H1, ws + WS_H, K_BF16, D, 0, M, D);
        if (lp == LP_IN) { save(&dc, stream, tb + T_Q, ws + WS_Q, K_QPERM, 1024, 0, M, 1024); save(&dc, stream, tb + T_K, ws + WS_K, K_QPERM, 256, 0, M, 256); save(&dc, stream, tb + T_V, ws + WS_V, K_BF16, 256, 0, M, 256);
            save(&dc, stream, tb + T_U, ws + WS_U, K_F32, 512, 0, M, 512); save(&dc, stream, tb + T_PR, ws + WS_PR, K_F32, 2048, 0, M, RP); }
        if (lp == LP_SCAN) { save(&dc, stream, tb + T_OA, ws + WS_CAT, K_BF16, D, 0, M, 1024); save(&dc, stream, tb + T_ZP, ws + WS_CAT, K_BF16, D, 1024, M, 512); }
        if (lp == LP_SCAN) {
            for (int i = 0; i < 7; ++i) save(&dc, stream, tb + T_R + i, ws + WS_RW + (size_t)i * RW_STRIDE, K_F32, 512, 0, M, 512);
            if (l == 1) { save(&dc, stream, 59, ws + WS_RW + (size_t)RW_Y * RW_STRIDE, K_F32, 512, 0, M, 512); save(&dc, stream, 60, ws + WS_H, K_F32, 32, 0, M, 32); } }
        if (lp == LP_SCAN) save(&dc, stream, tb + T_GT, ws + WS_GT, K_BF16, 6144, 0, M, 6144);
        if (lp == LP_SCAN) save(&dc, stream, tb + T_Y, ws + WS_RW + (size_t)RW_Y * RW_STRIDE, K_F32, 512, 0, M, 512);
        if (lp == LP_POST) save(&dc, stream, tb + T_YR, ws + WS_CAT, K_BF16, D, 1536, M, 512);
        if (lp == LP_MG) save(&dc, stream, tb + T_MG, ws + WS_MG, K_BF16, D, 0, M, D);
        if (lp == LP_NORM2) { save(&dc, stream, tb + T_X1, ws + WS_X, K_F32, D, 0, M, D); save(&dc, stream, tb + T_H2, ws + WS_H, K_BF16, D, 0, M, D); }
        if (lp == LP_GU) save(&dc, stream, tb + T_ACT, ws + WS_GT, K_BF16, DFF, 0, M, DFF);
        if ((lp == LP_NORM1 && l > 0) || ph == PH_FINAL) save(&dc, stream, T_L0 + (ph == PH_FINAL ? 1 : l - 1) * T_PER_L + T_X2, ws + WS_X, K_F32, D, 0, M, D);
    }
    const size_t ooff[13] = {O_YP, O_YS, O_KP, O_VP, O_PP, O_SP, O_WP, O_KS, O_VS, O_PS, O_SS, O_WS, O_END}; const int ocol[12] = {2048, 2048, 256, 256, 512, 1984, 64, 256, 256, 512, 1984, 64};
    for (int i = 0; i < 12; ++i) dbg::save(&dc, stream, dbg::T_OUT0 + i, (float*)d_out + ooff[i], dbg::K_F32, ocol[i], 0, (int)((ooff[i + 1] - ooff[i]) / ocol[i]), ocol[i]);
    nv::In in; for (int i = 0; i < 39; ++i) in.p[i] = (const float*)d_in[i];
    nv::forward(in, (float*)d_out, (float*)d_ws, stream, &dc);
    for (int i = 0; i < 12; ++i) dbg::cmp(&dc, stream, dbg::T_OUT0 + i, (float*)d_out + ooff[i], ocol[i], 0, (int)((ooff[i + 1] - ooff[i]) / ocol[i]), ocol[i]);
#ifndef DBG_WANT_ID
#define DBG_WANT_ID -1
#endif
    dbg::inject<<<1, 1, 0, stream>>>(dc.err, (float*)d_out, (float*)d_out + O_YS, DBG_WANT_ID >= 0 ? dbg::NIDS : dbg::T_N, DBG_WANT_ID);
#else
    a.ph_lo = 0; a.ph_hi = N_PHASES;
    void* kargs[] = {&a};
    const hipError_t e = hipLaunchCooperativeKernel((const void*)mega, dim3(grid), dim3(NTHR), kargs, LDS_BYTES, stream);
    if (e != hipSuccess) fprintf(stderr, "kernel_launch: cooperative launch failed: %s (grid %d)\n", hipGetErrorString(e), grid);
#endif
}
```

```cpp
#define MK_DEBUG 0
#include <hip/hip_runtime.h>
#include <hip/hip_cooperative_groups.h>
#include <cstdio>
#include <cstdint>
namespace dbg {
constexpr int NPROBE = 16384, NSPECIAL = 2048, NIDS = 64;
struct Ctx { float* probes; float* err; int on; };
__device__ __forceinline__ unsigned hash32(unsigned x) { x ^= x >> 16; x *= 0x7feb352dU; x ^= x >> 15; x *= 0x846ca68bU; x ^= x >> 16; return x; }
__device__ __forceinline__ void probe_rc(int id, int k, int R, int C, int& r, int& c) {
    const unsigned h1 = hash32((unsigned)(id * 1000003 + k * 2 + 1)), h2 = hash32((unsigned)(id * 7919 + k * 2 + 77777));
    c = (int)(h2 % (unsigned)C);
    if (R == 8320 && k < NSPECIAL) { const int sp[16] = {0, 1, 15, 16, 127, 128, 129, 4095, 4096, 4097, 8190, 8191, 8192, 8193, 8255, 8319}; r = sp[k >> 7]; }
    else r = (int)(h1 % (unsigned)R);
}
enum { K_F32 = 0, K_BF16 = 1, K_QPERM = 2 };
__device__ __forceinline__ float opt_read(const void* p, int kind, size_t ld, int coff, int r, int c) {
    if (kind == K_F32) return ((const float*)p)[(size_t)r * ld + coff + c];
    if (kind == K_QPERM) { const int h = c >> 6, d = c & 63, pp = 32 * ((d >> 4) & 1) + 8 * ((d >> 2) & 3) + 4 * (d >> 5) + (d & 3); c = h * 64 + pp; }
    const unsigned short b = ((const unsigned short*)p)[(size_t)r * ld + coff + c]; return __builtin_bit_cast(float, (unsigned)b << 16);
}
__global__ void probe_save(float* probes, int id, const void* p, int kind, size_t ld, int coff, int R, int C) {
    const int k = blockIdx.x * blockDim.x + threadIdx.x; if (k >= NPROBE) return; int r, c; probe_rc(id, k, R, C, r, c);
    probes[(size_t)id * NPROBE + k] = opt_read(p, kind, ld, coff, r, c);
}
__global__ void probe_cmp(const float* probes, float* err, int id, const float* gold, size_t ld, int coff, int R, int C, int sig) {
    const int k = blockIdx.x * blockDim.x + threadIdx.x; if (k >= NPROBE) return; int r, c; probe_rc(id, k, R, C, r, c);
    float g = gold[(size_t)r * ld + coff + c]; if (sig) g = 1.f / (1.f + expf(-g));
    float o = probes[(size_t)id * NPROBE + k]; float d = o - g; if (!(d == d) || fabsf(d) > 1e18f) d = 1e18f;
    const int sp = (R == 8320 && k < NSPECIAL) ? 0 : 2;
    atomicAdd(&err[id * 4 + sp], d * d); atomicAdd(&err[id * 4 + sp + 1], g * g);
}
__global__ void inject(const float* err, float* out, float* ys, int nids, int want_id) {
    if (threadIdx.x || blockIdx.x) return;
    int rid = 89, which = 0; float rel = 1e-3f;
    for (int id = 0; id < nids; ++id) {
        const float r_rand = sqrtf(err[id * 4 + 2] / fmaxf(err[id * 4 + 3], 1e-30f)), r_sp = err[id * 4 + 1] > 0.f ? sqrtf(err[id * 4 + 0] / fmaxf(err[id * 4 + 1], 1e-30f)) : 0.f;
        if (want_id >= 0) { if (id == want_id) { rid = id; which = 0; rel = r_rand; break; } continue; }
        if (r_rand > 0.05f) { rid = id; which = 0; rel = r_rand; break; } else if (r_sp > 0.10f) { rid = id; which = 1; rel = r_sp; break; } }
    const float c1 = (float)(10 + rid) * (which ? 1e5f : 1e3f); float f = (log10f(fmaxf(rel, 1e-3f)) + 3.f) * 0.25f; f = fminf(fmaxf(f, 0.f), 1.f);
    out[0] = c1; ys[0] = c1 * (0.2f + 0.6f * f);
}
inline void save(const Ctx* c, hipStream_t st, int id, const void* p, int kind, size_t ld, int coff, int R, int C) { if (c && c->on) probe_save<<<NPROBE / 256, 256, 0, st>>>(c->probes, id, p, kind, ld, coff, R, C); }
inline void cmp(const Ctx* c, hipStream_t st, int id, const float* gold, size_t ld, int coff, int R, int C, int sig = 0) { if (c && c->on) probe_cmp<<<NPROBE / 256, 256, 0, st>>>(c->probes, c->err, id, gold, ld, coff, R, C, sig); }
enum { T_MOD = 0, T_L0 = 1, T_PER_L = 23, T_OUT0 = T_L0 + 2 * T_PER_L, T_N = T_OUT0 + 12 };
enum { T_H1 = 0, T_Q, T_K, T_V, T_U, T_PR, T_GT, T_OA, T_ZP, T_R, T_W, T_KK, T_VV, T_A, T_B, T_G, T_Y, T_YR, T_MG, T_X1, T_H2, T_ACT, T_X2 };
}
namespace nv {
constexpr int D = 2048, SEQ = 4096, NB = 2, MP = NB * SEQ, NS = 128, M = MP + NS, NL = 2;
constexpr int INW = 10176, OQ = 0, OK_ = 1024, OV = 1280, OU = 1536, OPR = 2048, OGL = 4032;
constexpr int RP = 1984, DFF = 5632, NMOD = NB + NS;
constexpr int PASTLEN = 8192;

__device__ __forceinline__ float sigm(float x) { return 1.f / (1.f + expf(-x)); }
__device__ __forceinline__ float silu(float x) { return x / (1.f + expf(-x)); }
__device__ __forceinline__ int modrow(int m) { return m < MP ? m / SEQ : NB + (m - MP); }
__device__ __forceinline__ int posof(int m) { return m < MP ? m % SEQ : PASTLEN; }

__global__ void __launch_bounds__(256) gemm(const float* __restrict__ A, int lda, const float* __restrict__ B, int ldb, float* __restrict__ C, int ldc, int Mm, int N, int K) {
    __shared__ float As[16][68], Bs[16][68];
    const int tx = threadIdx.x & 15, ty = threadIdx.x >> 4, m0 = blockIdx.y * 64, n0 = blockIdx.x * 64;
    float acc[4][4];
#pragma unroll
    for (int i = 0; i < 4; ++i)
#pragma unroll
        for (int j = 0; j < 4; ++j) acc[i][j] = 0.f;
    for (int k0 = 0; k0 < K; k0 += 16) {
        for (int i = threadIdx.x; i < 1024; i += 256) { const int r = i >> 4, c = i & 15; As[c][r] = (m0 + r < Mm) ? A[(size_t)(m0 + r) * lda + k0 + c] : 0.f; }
        for (int i = threadIdx.x; i < 1024; i += 256) { const int r = i >> 6, c = i & 63; Bs[r][c] = (n0 + c < N) ? B[(size_t)(k0 + r) * ldb + n0 + c] : 0.f; }
        __syncthreads();
#pragma unroll
        for (int kk = 0; kk < 16; ++kk) {
            float a[4], b[4];
#pragma unroll
            for (int i = 0; i < 4; ++i) { a[i] = As[kk][ty * 4 + i]; b[i] = Bs[kk][tx * 4 + i]; }
#pragma unroll
            for (int i = 0; i < 4; ++i)
#pragma unroll
                for (int j = 0; j < 4; ++j) acc[i][j] += a[i] * b[j];
        }
        __syncthreads();
    }
#pragma unroll
    for (int i = 0; i < 4; ++i)
#pragma unroll
        for (int j = 0; j < 4; ++j) { const int m = m0 + ty * 4 + i, n = n0 + tx * 4 + j; if (m < Mm && n < N) C[(size_t)m * ldc + n] = acc[i][j]; }
}

__global__ void silu_c(const float* cp, const float* cs, float* out) {
    const int i = blockIdx.x * blockDim.x + threadIdx.x; if (i >= NMOD * D) return;
    const int r = i / D, k = i % D; const float c = r < NB ? cp[r * D + k] : cs[(r - NB) * D + k]; out[i] = silu(c);
}
__global__ void add_bias(float* mod, const float* b, int n, int N) { const int i = blockIdx.x * blockDim.x + threadIdx.x; if (i < n) mod[i] += b[i % N]; }

__global__ void __launch_bounds__(256) modnorm(const float* xa, const float* xb, const float* g, const float* mod, int sh_off, int sc_off, float* out, size_t out_split_off) {
    const int m = blockIdx.x; const float* x = m < MP ? xa + (size_t)m * D : xb + (size_t)(m - MP) * D;
    __shared__ float red[256]; float s = 0.f;
    for (int k = threadIdx.x; k < D; k += 256) { const float v = x[k]; s += v * v; }
    red[threadIdx.x] = s; __syncthreads();
    for (int o = 128; o > 0; o >>= 1) { if (threadIdx.x < o) red[threadIdx.x] += red[threadIdx.x + o]; __syncthreads(); }
    const float rs = rsqrtf(red[0] / D + 1e-6f); const int br = modrow(m);
    float* o = m < MP ? out + (size_t)m * D : out + out_split_off + (size_t)(m - MP) * D;
    for (int k = threadIdx.x; k < D; k += 256) { float v = x[k] * rs * g[k]; if (mod) v = v * (1.f + mod[(size_t)br * 6 * D + sc_off + k]) + mod[(size_t)br * 6 * D + sh_off + k]; o[k] = v; }
}

__global__ void rope(float* z) {
    const int i = blockIdx.x * blockDim.x + threadIdx.x; if (i >= M * 20 * 32) return;
    const int m = i / 640, hh = (i / 32) % 20, d = i % 32; const float pos = (float)posof(m);
    const float inv = powf(10000.f, -(float)d * 2.0f / 64.f), ang = pos * inv, c = cosf(ang), s = sinf(ang);
    float* p = z + (size_t)m * INW + hh * 64; const float x1 = p[d], x2 = p[d + 32]; p[d] = x1 * c - x2 * s; p[d + 32] = x2 * c + x1 * s;
}

__global__ void attn_prompt(const float* z, const float* sink, float* oattn) {
    const int i = blockIdx.x * blockDim.x + threadIdx.x; if (i >= MP * 16) return;
    const int m = i / 16, hq = i % 16, hk = hq / 4, t = m % SEQ; const float* q = z + (size_t)m * INW + OQ + hq * 64;
    const int lo = t - 128 < 0 ? 0 : t - 128; const float sk = sink[hq];
    float mx = sk;
    for (int kp = lo; kp <= t; ++kp) { const float* k = z + (size_t)(m - t + kp) * INW + OK_ + hk * 64; float s = 0.f; for (int d = 0; d < 64; ++d) s += q[d] * k[d]; s *= 0.125f; mx = fmaxf(mx, s); }
    float den = expf(sk - mx); float o[64];
#pragma unroll
    for (int d = 0; d < 64; ++d) o[d] = 0.f;
    for (int kp = lo; kp <= t; ++kp) { const float* k = z + (size_t)(m - t + kp) * INW + OK_ + hk * 64; const float* v = z + (size_t)(m - t + kp) * INW + OV + hk * 64; float s = 0.f; for (int d = 0; d < 64; ++d) s += q[d] * k[d]; s *= 0.125f;
        const float p = expf(s - mx); den += p;
#pragma unroll
        for (int d = 0; d < 64; ++d) o[d] += p * v[d]; }
#pragma unroll
    for (int d = 0; d < 64; ++d) oattn[(size_t)m * 1024 + hq * 64 + d] = o[d] / den;
}
__global__ void attn_sample(const float* z, const float* sink, const float* ck, const float* cv, float* oattn) {
    const int i = blockIdx.x * blockDim.x + threadIdx.x; if (i >= NS * 16) return;
    const int s_ = i / 16, hq = i % 16, hk = hq / 4, m = MP + s_; const float* q = z + (size_t)m * INW + OQ + hq * 64; const float sk = sink[hq];
    float mx = sk;
    for (int j = 0; j <= 128; ++j) { const float* k = j < 128 ? ck + ((size_t)(s_ * 128 + j) * 4 + hk) * 64 : z + (size_t)m * INW + OK_ + hk * 64; float s = 0.f; for (int d = 0; d < 64; ++d) s += q[d] * k[d]; s *= 0.125f; mx = fmaxf(mx, s); }
    float den = expf(sk - mx); float o[64];
#pragma unroll
    for (int d = 0; d < 64; ++d) o[d] = 0.f;
    for (int j = 0; j <= 128; ++j) { const float* k = j < 128 ? ck + ((size_t)(s_ * 128 + j) * 4 + hk) * 64 : z + (size_t)m * INW + OK_ + hk * 64;
        const float* v = j < 128 ? cv + ((size_t)(s_ * 128 + j) * 4 + hk) * 64 : z + (size_t)m * INW + OV + hk * 64; float s = 0.f; for (int d = 0; d < 64; ++d) s += q[d] * k[d]; s *= 0.125f;
        const float p = expf(s - mx); den += p;
#pragma unroll
        for (int d = 0; d < 64; ++d) o[d] += p * v[d]; }
#pragma unroll
    for (int d = 0; d < 64; ++d) oattn[(size_t)m * 1024 + hq * 64 + d] = o[d] / den;
}
__global__ void kv_out(const float* z, const float* ck, const float* cv, float* kp, float* vp, float* ks, float* vs) {
    const int i = blockIdx.x * blockDim.x + threadIdx.x;
    if (i < NB * 128 * 256) { const int b = i / (128 * 256), j = (i / 256) % 128, c = i % 256; const size_t m = (size_t)b * SEQ + SEQ - 128 + j; kp[i] = z[m * INW + OK_ + c]; vp[i] = z[m * INW + OV + c]; }
    if (i < NS * 128 * 256) { const int s_ = i / (128 * 256), j = (i / 256) % 128, c = i % 256;
        if (j < 127) { ks[i] = ck[i + 256]; vs[i] = cv[i + 256]; } else { ks[i] = z[(size_t)(MP + s_) * INW + OK_ + c]; vs[i] = z[(size_t)(MP + s_) * INW + OV + c]; } }
}
__global__ void pool_d(const float* z, const float* spool, float* dbuf) {
    const int i = blockIdx.x * blockDim.x + threadIdx.x; if (i >= M * 512) return;
    const int m = i / 512, c = i % 512, gi = c / 128, w = 2 << gi; float sum = 0.f; float cnt;
    if (m < MP) { const int t = m % SEQ; for (int j = 0; j < w; ++j) if (t - j >= 0) sum += z[(size_t)(m - j) * INW + OU + c]; cnt = (float)(t + 1 < w ? t + 1 : w); }
    else { const int s_ = m - MP; sum = z[(size_t)m * INW + OU + c]; for (int j = 1; j < w; ++j) sum += spool[((size_t)s_ * 15 + 15 - j) * 512 + c]; cnt = (float)w; }
    dbuf[i] = sum / cnt - z[(size_t)m * INW + OU + c];
}
__global__ void pool_z(const float* dbuf, const float* pw, const float* pscale, float* zpool) {
    const int i = blockIdx.x * blockDim.x + threadIdx.x; if (i >= M * 512) return;
    const int m = i / 512, c = i % 512, gi = c / 128, e = c % 128; float s = 0.f;
    for (int k = 0; k < 128; ++k) s += dbuf[(size_t)m * 512 + gi * 128 + k] * pw[(gi * 128 + k) * 128 + e];
    zpool[i] = s * pscale[c];
}
__global__ void pool_out(const float* z, const float* spool, float* pp, float* ps) {
    const int i = blockIdx.x * blockDim.x + threadIdx.x;
    if (i < NB * 15 * 512) { const int b = i / (15 * 512), j = (i / 512) % 15, c = i % 512; pp[i] = z[((size_t)b * SEQ + SEQ - 15 + j) * INW + OU + c]; }
    if (i < NS * 15 * 512) { const int s_ = i / (15 * 512), j = (i / 512) % 15, c = i % 512; ps[i] = j < 14 ? spool[i + 512] : z[(size_t)(MP + s_) * INW + OU + c]; }
}
__global__ void rwkv_xm(const float* z, const float* sshift, const float* mu, float* xm) {
    const int i = blockIdx.x * blockDim.x + threadIdx.x; if (i >= M * RP) return;
    const int m = i / RP, c = i % RP; const float p = z[(size_t)m * INW + OPR + c]; float pv;
    if (m < MP) pv = (m % SEQ) ? z[(size_t)(m - 1) * INW + OPR + c] : 0.f; else pv = sshift[(size_t)(m - MP) * RP + c];
    xm[i] = p + (pv - p) * mu[c];
}
__global__ void shift_out(const float* z, float* sp, float* ss) {
    const int i = blockIdx.x * blockDim.x + threadIdx.x;
    if (i < NB * RP) { const int b = i / RP, c = i % RP; sp[i] = z[((size_t)b * SEQ + SEQ - 1) * INW + OPR + c]; }
    if (i < NS * RP) { const int s_ = i / RP, c = i % RP; ss[i] = z[(size_t)(MP + s_) * INW + OPR + c]; }
}
__global__ void __launch_bounds__(64) rwkv_prep(const float* xm, const float* w0, const float* w2, const float* a0, const float* a2, const float* g2, const float* k_k, const float* k_a,
                                                 const float* T2, const float* vb, float* vfirst, int has_vres,
                                                 float* R, float* W, float* Kk, float* V, float* A, float* Bb, float* G) {
    const int m = blockIdx.x / 8, h = blockIdx.x % 8, c = h * 64 + threadIdx.x; const float* x = xm + (size_t)m * RP;
    float s = w0[c]; for (int k = 0; k < 96; ++k) s += tanhf(x[1536 + k]) * w2[k * 512 + c];
    const float z_ = -s; const float sp = z_ > 20.f ? z_ : log1pf(expf(z_)); const float wlog = -sp - 0.5f; const float decay = expf(-expf(wlog));
    float sa = a0[c]; for (int k = 0; k < 96; ++k) sa += x[1632 + k] * a2[k * 512 + c]; const float a = sigm(sa);
    float g = 0.f; for (int k = 0; k < 256; ++k) g += sigm(x[1728 + k]) * g2[k * 512 + c];
    float v = x[1024 + c];
    if (!has_vres) vfirst[(size_t)m * 512 + c] = v;
    else { const float acc = vb[c] + T2[(size_t)m * 512 + c]; v = v + (vfirst[(size_t)m * 512 + c] - v) * sigm(acc); }
    const float r = x[c], k = x[512 + c]; float kk = k * k_k[c];
    __shared__ float red[64]; red[threadIdx.x] = kk * kk; __syncthreads();
    for (int o = 32; o > 0; o >>= 1) { if (threadIdx.x < o) red[threadIdx.x] += red[threadIdx.x + o]; __syncthreads(); }
    kk = kk / fmaxf(sqrtf(red[0]), 1e-12f); const float k2 = k * (1.f + (a - 1.f) * k_a[c]);
    const size_t o = (size_t)m * 512 + c; R[o] = r; W[o] = decay; Kk[o] = k2; V[o] = v; A[o] = -kk; Bb[o] = kk * a; G[o] = g;
}
__global__ void __launch_bounds__(64) rwkv_scan(const float* R, const float* W, const float* Kk, const float* V, const float* A, const float* Bb, const float* S0, float* Sout, float* Y, int row0, int T) {
    const int seq = blockIdx.x / 8, h = blockIdx.x % 8, i = threadIdx.x; float S[64];
#pragma unroll
    for (int j = 0; j < 64; ++j) S[j] = S0 ? S0[(((size_t)seq * 8 + h) * 64 + i) * 64 + j] : 0.f;
    __shared__ float sr[16][64], sw[16][64], sk[16][64], sa[16][64], sb[16][64], sv[16][64];
    for (int t0 = 0; t0 < T; t0 += 16) { const int nt = T - t0 < 16 ? T - t0 : 16;
        __syncthreads();
        for (int tt = 0; tt < nt; ++tt) { const size_t o = ((size_t)row0 + (size_t)seq * T + t0 + tt) * 512 + h * 64 + i; sr[tt][i] = R[o]; sw[tt][i] = W[o]; sk[tt][i] = Kk[o]; sa[tt][i] = A[o]; sb[tt][i] = Bb[o]; sv[tt][i] = V[o]; }
        __syncthreads();
        for (int tt = 0; tt < nt; ++tt) { float dot = 0.f; const float v = sv[tt][i];
#pragma unroll
            for (int j = 0; j < 64; ++j) dot += S[j] * sa[tt][j];
            float y = 0.f;
#pragma unroll
            for (int j = 0; j < 64; ++j) { S[j] = S[j] * sw[tt][j] + dot * sb[tt][j] + v * sk[tt][j]; y += S[j] * sr[tt][j]; }
            Y[((size_t)row0 + (size_t)seq * T + t0 + tt) * 512 + h * 64 + i] = y; } }
#pragma unroll
    for (int j = 0; j < 64; ++j) Sout[(((size_t)seq * 8 + h) * 64 + i) * 64 + j] = S[j];
}
__global__ void __launch_bounds__(64) rwkv_post(const float* Y, const float* R, const float* Kk, const float* V, const float* G, const float* r_k, const float* lg, const float* lb, float* yout) {
    const int m = blockIdx.x / 8, h = blockIdx.x % 8, i = threadIdx.x, c = h * 64 + i; const size_t o = (size_t)m * 512 + c;
    __shared__ float red[64]; const float y = Y[o];
    red[i] = y; __syncthreads(); for (int s = 32; s > 0; s >>= 1) { if (i < s) red[i] += red[i + s]; __syncthreads(); } const float mu = red[0] / 64.f; __syncthreads();
    red[i] = (y - mu) * (y - mu); __syncthreads(); for (int s = 32; s > 0; s >>= 1) { if (i < s) red[i] += red[i + s]; __syncthreads(); } const float var = red[0] / 64.f; __syncthreads();
    red[i] = R[o] * Kk[o] * r_k[c]; __syncthreads(); for (int s = 32; s > 0; s >>= 1) { if (i < s) red[i] += red[i + s]; __syncthreads(); } const float bon = red[0];
    yout[o] = ((y - mu) * rsqrtf(var + 64e-5f) * lg[c] + lb[c] + bon * V[o]) * G[o];
}
__global__ void merge_acc(const float* z, const float* P, int goff, float* merged, int first) {
    const int i = blockIdx.x * blockDim.x + threadIdx.x; if (i >= M * D) return; const int m = i / D, n = i % D;
    const float v = sigm(z[(size_t)m * INW + OGL + goff + n]) * P[i]; merged[i] = first ? v : merged[i] + v;
}
__global__ void resid(const float* xa, const float* xb, const float* P, const float* mod, int gt_off, float* xout) {
    const int i = blockIdx.x * blockDim.x + threadIdx.x; if (i >= M * D) return; const int m = i / D, n = i % D;
    const float x = m < MP ? xa[i] : xb[(size_t)(m - MP) * D + n]; xout[i] = x + (1.f + mod[(size_t)modrow(m) * 6 * D + gt_off + n]) * P[i];
}
__global__ void swiglu(const float* gbuf, const float* ubuf, float* act, int n) { const int i = blockIdx.x * blockDim.x + threadIdx.x; if (i < n) act[i] = silu(gbuf[i]) * ubuf[i]; }

struct In { const float* p[39]; };
inline void G(hipStream_t st, const float* A, int lda, const float* B, int ldb, float* C, int ldc, int Mm, int N, int K) { gemm<<<dim3((N + 63) / 64, (Mm + 63) / 64), 256, 0, st>>>(A, lda, B, ldb, C, ldc, Mm, N, K); }
#define EW(n) ((int)(((size_t)(n) + 255) / 256)), 256, 0, st

struct WS { float *silc, *mod, *h, *z, *xm, *R, *W, *K, *V, *A, *B, *G, *Y, *vfirst, *dbuf, *cat_a, *cat_p, *cat_r, *P, *merged, *x1, *xres, *fg, *fu, *T1; };
inline size_t carve(float* base, WS& w) {
    size_t o = 0; auto take = [&](size_t n) { float* p = base + o; o += (n + 63) & ~(size_t)63; return p; };
    w.silc = take((size_t)NMOD * D); w.mod = take((size_t)NL * NMOD * 6 * D); w.T1 = take((size_t)M * 32);
    w.h = take((size_t)M * D); w.P = w.h;
    w.xm = take((size_t)M * D); w.x1 = w.xm;
    w.cat_a = take((size_t)M * 1024); w.cat_p = take((size_t)M * 512); w.cat_r = take((size_t)M * 512); w.xres = take((size_t)M * D);
    w.z = take((size_t)M * INW);
    w.R = take((size_t)M * 512); w.W = take((size_t)M * 512); w.K = take((size_t)M * 512); w.V = take((size_t)M * 512); w.A = take((size_t)M * 512); w.B = take((size_t)M * 512); w.G = take((size_t)M * 512);
    w.Y = take((size_t)M * 512); w.vfirst = take((size_t)M * 512); w.dbuf = take((size_t)M * 512);
    w.merged = w.R;
    w.fg = w.z; w.fu = w.z + (size_t)M * DFF;
    return o;
}
constexpr size_t O_YP = 0, O_YS = O_YP + (size_t)MP * D, O_KP = O_YS + (size_t)NS * D, O_VP = O_KP + (size_t)NL * NB * 128 * 256, O_PP = O_VP + (size_t)NL * NB * 128 * 256,
                 O_SP = O_PP + (size_t)NL * NB * 15 * 512, O_WP = O_SP + (size_t)NL * NB * RP, O_KS = O_WP + (size_t)NL * NB * 8 * 4096, O_VS = O_KS + (size_t)NL * NS * 128 * 256,
                 O_PS = O_VS + (size_t)NL * NS * 128 * 256, O_SS = O_PS + (size_t)NL * NS * 15 * 512, O_WS = O_SS + (size_t)NL * NS * RP, O_END = O_WS + (size_t)NL * NS * 8 * 4096;

inline void forward(const In& in, float* out, float* wsf, hipStream_t st, const dbg::Ctx* dc = nullptr) {
    using namespace dbg;
    WS w; carve(wsf, w);
    const float *xp = in.p[0], *xs = in.p[1];
    silu_c<<<EW(NMOD * D)>>>(in.p[2], in.p[3], w.silc);
    for (int l = 0; l < NL; ++l) { G(st, w.silc, D, in.p[9] + (size_t)l * D * 6 * D, 6 * D, w.mod + (size_t)l * NMOD * 6 * D, 6 * D, NMOD, 6 * D, D);
        add_bias<<<EW(NMOD * 6 * D)>>>(w.mod + (size_t)l * NMOD * 6 * D, in.p[10] + (size_t)l * 6 * D, NMOD * 6 * D, 6 * D); }
    cmp(dc, st, T_MOD, w.mod, 6 * D, 0, NL * NMOD, 6 * D);
    const float* xa = xp; const float* xb = xs;
    for (int l = 0; l < NL; ++l) {
        const float* mod = w.mod + (size_t)l * NMOD * 6 * D; const int tb = T_L0 + l * T_PER_L;
        modnorm<<<M, 256, 0, st>>>(xa, xb, in.p[11] + l * D, mod, 0, D, w.h, (size_t)MP * D);
        cmp(dc, st, tb + T_H1, w.h, D, 0, M, D);
        G(st, w.h, D, in.p[13] + (size_t)l * D * INW, INW, w.z, INW, M, INW, D);
        rope<<<EW(M * 640)>>>(w.z);
        cmp(dc, st, tb + T_Q, w.z, INW, OQ, M, 1024); cmp(dc, st, tb + T_K, w.z, INW, OK_, M, 256); cmp(dc, st, tb + T_V, w.z, INW, OV, M, 256); cmp(dc, st, tb + T_U, w.z, INW, OU, M, 512);
        cmp(dc, st, tb + T_PR, w.z, INW, OPR, M, RP); cmp(dc, st, tb + T_GT, w.z, INW, OGL, M, 6144, 1);
        const float* ck = in.p[4] + (size_t)l * NS * 128 * 256; const float* cv = in.p[5] + (size_t)l * NS * 128 * 256;
        attn_prompt<<<(MP * 16 + 63) / 64, 64, 0, st>>>(w.z, in.p[14] + l * 16, w.cat_a);
        attn_sample<<<(NS * 16 + 63) / 64, 64, 0, st>>>(w.z, in.p[14] + l * 16, ck, cv, w.cat_a);
        kv_out<<<EW(NS * 128 * 256)>>>(w.z, ck, cv, out + O_KP + (size_t)l * NB * 128 * 256, out + O_VP + (size_t)l * NB * 128 * 256, out + O_KS + (size_t)l * NS * 128 * 256, out + O_VS + (size_t)l * NS * 128 * 256);
        const float* sp = in.p[6] + (size_t)l * NS * 15 * 512;
        pool_d<<<EW(M * 512)>>>(w.z, sp, w.dbuf);
        pool_z<<<EW(M * 512)>>>(w.dbuf, in.p[16] + (size_t)l * 4 * 128 * 128, in.p[17] + l * 512, w.cat_p);
        pool_out<<<EW(NS * 15 * 512)>>>(w.z, sp, out + O_PP + (size_t)l * NB * 15 * 512, out + O_PS + (size_t)l * NS * 15 * 512);
        rwkv_xm<<<EW((size_t)M * RP)>>>(w.z, in.p[7] + (size_t)l * NS * RP, in.p[19] + l * RP, w.xm);
        shift_out<<<EW(NS * RP)>>>(w.z, out + O_SP + (size_t)l * NB * RP, out + O_SS + (size_t)l * NS * RP);
        if (l > 0) { G(st, w.xm + 1024, RP, in.p[31], 32, w.T1, 32, M, 32, 512); G(st, w.T1, 32, in.p[32], 512, w.dbuf, 512, M, 512, 32); }
        if (l > 0) { cmp(dc, st, 59, w.dbuf, 512, 0, M, 512); cmp(dc, st, 60, w.T1, 32, 0, M, 32); }
        rwkv_prep<<<M * 8, 64, 0, st>>>(w.xm, in.p[20] + l * 512, in.p[21] + (size_t)l * 96 * 512, in.p[22] + l * 512, in.p[23] + (size_t)l * 96 * 512, in.p[24] + (size_t)l * 256 * 512, in.p[25] + l * 512, in.p[26] + l * 512,
                                         w.dbuf, in.p[33], w.vfirst, l > 0, w.R, w.W, w.K, w.V, w.A, w.B, w.G);
        cmp(dc, st, tb + T_OA, w.cat_a, 1024, 0, M, 1024); cmp(dc, st, tb + T_ZP, w.cat_p, 512, 0, M, 512);
        cmp(dc, st, tb + T_R, w.R, 512, 0, M, 512); cmp(dc, st, tb + T_W, w.W, 512, 0, M, 512); cmp(dc, st, tb + T_KK, w.K, 512, 0, M, 512); cmp(dc, st, tb + T_VV, w.V, 512, 0, M, 512);
        cmp(dc, st, tb + T_A, w.A, 512, 0, M, 512); cmp(dc, st, tb + T_B, w.B, 512, 0, M, 512); cmp(dc, st, tb + T_G, w.G, 512, 0, M, 512);
        rwkv_scan<<<NB * 8, 64, 0, st>>>(w.R, w.W, w.K, w.V, w.A, w.B, nullptr, out + O_WP + (size_t)l * NB * 8 * 4096, w.Y, 0, SEQ);
        rwkv_scan<<<NS * 8, 64, 0, st>>>(w.R, w.W, w.K, w.V, w.A, w.B, in.p[8] + (size_t)l * NS * 8 * 4096, out + O_WS + (size_t)l * NS * 8 * 4096, w.Y, MP, 1);
        cmp(dc, st, tb + T_Y, w.Y, 512, 0, M, 512);
        rwkv_post<<<M * 8, 64, 0, st>>>(w.Y, w.R, w.K, w.V, w.G, in.p[27] + l * 512, in.p[28] + l * 512, in.p[29] + l * 512, w.cat_r);
        cmp(dc, st, tb + T_YR, w.cat_r, 512, 0, M, 512);
        G(st, w.cat_a, 1024, in.p[15] + (size_t)l * 1024 * D, D, w.P, D, M, D, 1024); merge_acc<<<EW((size_t)M * D)>>>(w.z, w.P, 0, w.merged, 1);
        G(st, w.cat_p, 512, in.p[18] + (size_t)l * 512 * D, D, w.P, D, M, D, 512);   merge_acc<<<EW((size_t)M * D)>>>(w.z, w.P, D, w.merged, 0);
        G(st, w.cat_r, 512, in.p[30] + (size_t)l * 512 * D, D, w.P, D, M, D, 512);   merge_acc<<<EW((size_t)M * D)>>>(w.z, w.P, 2 * D, w.merged, 0);
        cmp(dc, st, tb + T_MG, w.merged, D, 0, M, D);
        G(st, w.merged, D, in.p[34] + (size_t)l * D * D, D, w.P, D, M, D, D);
        resid<<<EW((size_t)M * D)>>>(xa, xb, w.P, mod, 2 * D, w.x1);
        cmp(dc, st, tb + T_X1, w.x1, D, 0, M, D);
        modnorm<<<M, 256, 0, st>>>(w.x1, w.x1 + (size_t)MP * D, in.p[12] + l * D, mod, 3 * D, 4 * D, w.h, (size_t)MP * D);
        cmp(dc, st, tb + T_H2, w.h, D, 0, M, D);
        G(st, w.h, D, in.p[35] + (size_t)l * D * DFF, DFF, w.fg, DFF, M, DFF, D);
        G(st, w.h, D, in.p[36] + (size_t)l * D * DFF, DFF, w.fu, DFF, M, DFF, D);
        swiglu<<<EW((size_t)M * DFF)>>>(w.fg, w.fu, w.fg, M * DFF);
        cmp(dc, st, tb + T_ACT, w.fg, DFF, 0, M, DFF);
        G(st, w.fg, DFF, in.p[37] + (size_t)l * DFF * D, D, w.P, D, M, D, DFF);
        resid<<<EW((size_t)M * D)>>>(w.x1, w.x1 + (size_t)MP * D, w.P, mod, 5 * D, w.xres);
        cmp(dc, st, tb + T_X2, w.xres, D, 0, M, D);
        xa = w.xres; xb = w.xres + (size_t)MP * D;
    }
    modnorm<<<M, 256, 0, st>>>(xa, xb, in.p[38], nullptr, 0, 0, out + O_YP, (size_t)MP * D);
}
#undef EW
}
namespace mk {
#define LAS __attribute__((address_space(3)))
#define GAS __attribute__((address_space(1)))
typedef unsigned short bf16;
typedef short bf16x8 __attribute__((ext_vector_type(8)));
typedef float f32x4 __attribute__((ext_vector_type(4)));
typedef float f32x2 __attribute__((ext_vector_type(2)));
typedef unsigned u32x4 __attribute__((ext_vector_type(4)));
typedef unsigned u32x2 __attribute__((ext_vector_type(2)));

constexpr int D = 2048, SEQ = 4096, NB = 2, MP = NB * SEQ, NS = 128, M = MP + NS, MPAD = 8448, NL = 2, NMOD = NB + NS;
constexpr int NIN = 10240, NGU = 11264, DFF = 5632, NADA = 6 * D, RP = 1984, PASTLEN = 8192;
constexpr int NWAVES = 8, NTHR = 512;

constexpr size_t al(size_t x) { return (x + 255) & ~(size_t)255; }
constexpr size_t WL_IN = 0, WL_CAT = WL_IN + al((size_t)NIN * D * 2), WL_O = WL_CAT + al((size_t)D * D * 2), WL_GU = WL_O + al((size_t)D * D * 2), WL_DN = WL_GU + al((size_t)NGU * D * 2),
                 WL_W2 = WL_DN + al((size_t)D * DFF * 2), WL_A2 = WL_W2 + al(512 * 96 * 2), WL_G2 = WL_A2 + al(512 * 96 * 2), WL_V1 = WL_G2 + al(512 * 256 * 2), WL_V2 = WL_V1 + al(32 * 512 * 2),
                 WL_PW = WL_V2 + al(512 * 32 * 2), WL_SIZE = WL_PW + al(4 * 128 * 128 * 2);
constexpr size_t WS_W = 0;
constexpr size_t WS_ROPE = WS_W + 2 * WL_SIZE;
constexpr size_t WS_SILC = WS_ROPE + al((size_t)4097 * 64 * 4);
constexpr size_t WS_MOD = WS_SILC + al((size_t)256 * D * 2);
constexpr size_t WS_X = WS_MOD + al((size_t)NL * NMOD * NADA * 4);
constexpr size_t WS_H = WS_X + al((size_t)MPAD * D * 4);
constexpr size_t WS_Q = WS_H + al((size_t)MPAD * D * 2);
constexpr size_t WS_K = WS_Q + al((size_t)MPAD * 1024 * 2);
constexpr size_t WS_V = WS_K + al((size_t)MPAD * 256 * 2);
constexpr size_t WS_U = WS_V + al((size_t)MPAD * 256 * 2);
constexpr size_t WS_PR = WS_U + al((size_t)MPAD * 512 * 4);
constexpr size_t WS_MG = WS_PR;
constexpr size_t WS_CAT = WS_PR + al((size_t)MPAD * D * 4);
constexpr size_t WS_RW = WS_CAT + al((size_t)MPAD * D * 2);
constexpr size_t RW_STRIDE = al((size_t)MPAD * 512 * 4);
constexpr size_t WS_GT = WS_RW + 9 * RW_STRIDE;
constexpr size_t WS_ADAW = WS_GT;
constexpr size_t WS_SLAB = WS_GT + al((size_t)MPAD * 6144 * 2);
constexpr size_t WS_SLABM = WS_SLAB + al((size_t)11 * NS * D * 4);
constexpr size_t WS_CTL = WS_SLABM + al((size_t)4 * NS * D * 4);
constexpr size_t WS_CTL_BYTES = 32768;
constexpr size_t WS_END = WS_CTL + WS_CTL_BYTES;
static_assert((size_t)2 * NADA * D * 2 <= (size_t)MPAD * 6144 * 2, "ada weights fit under the gates");

constexpr size_t O_YP = 0, O_YS = O_YP + (size_t)MP * D, O_KP = O_YS + (size_t)NS * D, O_VP = O_KP + (size_t)NL * NB * 128 * 256, O_PP = O_VP + (size_t)NL * NB * 128 * 256,
                 O_SP = O_PP + (size_t)NL * NB * 15 * 512, O_WP = O_SP + (size_t)NL * NB * RP, O_KS = O_WP + (size_t)NL * NB * 8 * 4096, O_VS = O_KS + (size_t)NL * NS * 128 * 256,
                 O_PS = O_VS + (size_t)NL * NS * 128 * 256, O_SS = O_PS + (size_t)NL * NS * 15 * 512, O_WS = O_SS + (size_t)NL * NS * RP, O_END = O_WS + (size_t)NL * NS * 8 * 4096;

__device__ __forceinline__ unsigned f2bf(float f) { unsigned u = __builtin_bit_cast(unsigned, f); return (u + 0x7fffu + ((u >> 16) & 1u)) >> 16; }
__device__ __forceinline__ unsigned pk2(float lo, float hi) { return f2bf(lo) | (f2bf(hi) << 16); }
__device__ __forceinline__ float bf2f(unsigned short b) { return __builtin_bit_cast(float, (unsigned)b << 16); }
__device__ __forceinline__ float bflo(unsigned w) { return __builtin_bit_cast(float, w << 16); }
__device__ __forceinline__ float bfhi(unsigned w) { return __builtin_bit_cast(float, w & 0xffff0000u); }
__device__ __forceinline__ float fsigm(float x) { return __builtin_amdgcn_rcpf(1.f + __expf(-x)); }
__device__ __forceinline__ float wave_sum(float v) {
#pragma unroll
    for (int o = 1; o < 64; o <<= 1) v += __shfl_xor(v, o);
    return v;
}
__device__ __forceinline__ int modrow(int m) { return m < MP ? (m >> 12) : NB + (m - MP); }
__device__ __forceinline__ int posidx(int m) { return m < MP ? (m & (SEQ - 1)) : 4096; }
__device__ __forceinline__ int pi_d(int p) { return 32 * ((p >> 2) & 1) + 16 * (p >> 5) + 4 * ((p >> 3) & 3) + (p & 3); }

struct Args { const float* in[39]; float* out; unsigned char* ws; int ph_lo, ph_hi; };

struct Frame {
    LAS unsigned char* lds;
    int tid, lane, wave, G, bid;
    float* out; unsigned char* ws;
};
template <int K> __device__ __forceinline__ const float* inp() { GAS const float* p; asm volatile("s_load_dwordx2 %0, %1, %2\n\ts_waitcnt lgkmcnt(0)" : "=s"(p) : "s"(__builtin_amdgcn_kernarg_segment_ptr()), "n"(K * 8) : "memory"); return (const float*)p; }
#define INP(k) inp<k>()
__device__ __forceinline__ unsigned char* wl(const Frame& F, int l, size_t off) { return F.ws + WS_W + (size_t)l * WL_SIZE + off; }
__device__ __forceinline__ float* rwbuf(const Frame& F, int i) { return (float*)(F.ws + WS_RW + (size_t)i * RW_STRIDE); }
enum { RW_R = 0, RW_W, RW_K, RW_V, RW_A, RW_B, RW_G, RW_Y, RW_VF };

struct TSrc { const float* w; long long d2; int ld; int mode; };
__device__ __forceinline__ const float* colsrc(const TSrc& s, int n) {
    if (s.mode == 0) return s.w + n;
    if (s.mode == 1) {
        if (n < 1280) { const int h = n >> 6, p = n & 63; return s.w + h * 64 + pi_d(p); }
        if (n < 4032) return s.w + n;
        if (n < 4096) return nullptr;
        return s.w + (n - 64);
    }
      { const int g8 = n >> 3, i = n & 7; return (const float*)((const char*)s.w + (i < 4 ? 0ll : s.d2)) + 4 * g8 + (i & 3); }
}
__device__ __forceinline__ void transpose_item(const TSrc& s, int K, bf16* WT, size_t ldt, int kcol0, LAS float* scr, int kb, int nb, int lane) {
    const int k0 = 64 * kb, n0 = 32 * nb, gq = lane & 7, kr = lane >> 3;
    const float* cp = colsrc(s, n0 + 4 * gq);
#pragma unroll
    for (int i = 0; i < 8; ++i) { const int kk = 8 * i + kr; const f32x4 v = cp ? *(const f32x4*)(cp + (size_t)(k0 + kk) * s.ld) : (f32x4){0.f, 0.f, 0.f, 0.f};
        LAS float* d = scr + kk * 33 + 4 * gq; d[0] = v.x; d[1] = v.y; d[2] = v.z; d[3] = v.w; }
    asm volatile("s_waitcnt lgkmcnt(0)" ::: "memory");
    const int c = lane & 7;
#pragma unroll
    for (int j = 0; j < 4; ++j) { const int n = (lane >> 3) + 8 * j; const LAS float* p = scr + (8 * c) * 33 + n;
        u32x4 o; o.x = pk2(p[0 * 33], p[1 * 33]); o.y = pk2(p[2 * 33], p[3 * 33]); o.z = pk2(p[4 * 33], p[5 * 33]); o.w = pk2(p[6 * 33], p[7 * 33]);
        *(u32x4*)(WT + (size_t)(n0 + n) * ldt + kcol0 + k0 + 8 * c) = o; }
    asm volatile("s_waitcnt lgkmcnt(0)" ::: "memory");
}
__device__ __forceinline__ void small_transpose(const float* src, int K, int N, bf16* dst, int ldt, int gt, int ngt) {
    for (int i = gt; i < N * K; i += ngt) { const int n = i / K, k = i - n * K; dst[(size_t)n * ldt + k] = (bf16)f2bf(src[(size_t)k * N + n]); }
}
__device__ __forceinline__ void p0_prologue(const Frame& F, int lmask, bool common, int wb, int nwb, int cls) {
    LAS float* scr = (LAS float*)(F.lds + F.wave * 16384);
    const int gw = wb * NWAVES + F.wave, NGW = nwb * NWAVES;
    constexpr int J_ADA = 32 * 384, J_IN = 32 * 320, J_CA = 16 * 64, J_CP = 8 * 64, J_CR = 8 * 64, J_O = 32 * 64, J_GU = 32 * 352, J_DN = 88 * 64;
    constexpr int PER_L = J_ADA + J_IN + J_CA + J_CP + J_CR + J_O + J_GU + J_DN;
    constexpr int TOT = NL * PER_L; const int nrk = cls == 0 ? TOT : cls == 1 ? (TOT / 32) * 27 + (TOT % 32 < 27 ? TOT % 32 : 27) : (TOT / 32) * 5 + (TOT % 32 > 27 ? TOT % 32 - 27 : 0);
    for (int rk = gw; rk < nrk; rk += NGW) {
        const int it = cls == 0 ? rk : cls == 1 ? (rk / 27) * 32 + rk % 27 : (rk / 5) * 32 + 27 + rk % 5;
        const int l = it / PER_L; int r = it - l * PER_L;
        if (r < J_ADA ? !common : !((lmask >> l) & 1)) continue;
        TSrc s; s.d2 = 0; s.mode = 0; bf16* WT; size_t ldt; int K, nn, kcol0 = 0;
        if (r < J_ADA) { s.w = INP(9) + (size_t)l * D * NADA; s.ld = NADA; WT = (bf16*)(F.ws + WS_ADAW) + (size_t)l * NADA * D; ldt = D; K = D; nn = 384; }
        else if ((r -= J_ADA) < J_IN) { s.w = INP(13) + (size_t)l * D * 10176; s.ld = 10176; s.mode = 1; WT = (bf16*)wl(F, l, WL_IN); ldt = D; K = D; nn = 320; }
        else if ((r -= J_IN) < J_CA) { s.w = INP(15) + (size_t)l * 1024 * D; s.ld = D; WT = (bf16*)wl(F, l, WL_CAT); ldt = D; K = 1024; nn = 64; }
        else if ((r -= J_CA) < J_CP) { s.w = INP(18) + (size_t)l * 512 * D; s.ld = D; WT = (bf16*)wl(F, l, WL_CAT); ldt = D; K = 512; nn = 64; kcol0 = 1024; }
        else if ((r -= J_CP) < J_CR) { s.w = INP(30) + (size_t)l * 512 * D; s.ld = D; WT = (bf16*)wl(F, l, WL_CAT); ldt = D; K = 512; nn = 64; kcol0 = 1536; }
        else if ((r -= J_CR) < J_O) { s.w = INP(34) + (size_t)l * D * D; s.ld = D; WT = (bf16*)wl(F, l, WL_O); ldt = D; K = D; nn = 64; }
        else if ((r -= J_O) < J_GU) { s.w = INP(35) + (size_t)l * D * DFF; s.d2 = (const char*)INP(36) - (const char*)INP(35); s.ld = DFF; s.mode = 2; WT = (bf16*)wl(F, l, WL_GU); ldt = D; K = D; nn = 352; }
        else { r -= J_GU; s.w = INP(37) + (size_t)l * DFF * D; s.ld = D; WT = (bf16*)wl(F, l, WL_DN); ldt = DFF; K = DFF; nn = 64; }
        (void)K;
        transpose_item(s, K, WT, ldt, kcol0, scr, r / nn, r % nn, F.lane);
    }
    const int gt = wb * NTHR + F.tid, ngt = nwb * NTHR;
    for (int l = 0; l < NL; ++l) { if (!((lmask >> l) & 1)) continue;
        small_transpose(INP(21) + (size_t)l * 96 * 512, 96, 512, (bf16*)wl(F, l, WL_W2), 96, gt, ngt);
        small_transpose(INP(23) + (size_t)l * 96 * 512, 96, 512, (bf16*)wl(F, l, WL_A2), 96, gt, ngt);
        small_transpose(INP(24) + (size_t)l * 256 * 512, 256, 512, (bf16*)wl(F, l, WL_G2), 256, gt, ngt);
        for (int g = 0; g < 4; ++g) small_transpose(INP(16) + ((size_t)l * 4 + g) * 128 * 128, 128, 128, (bf16*)wl(F, l, WL_PW) + g * 128 * 128, 128, gt, ngt);
    }
    if (lmask & 2) { small_transpose(INP(31), 512, 32, (bf16*)wl(F, 1, WL_V1), 512, gt, ngt);
        small_transpose(INP(32), 32, 512, (bf16*)wl(F, 1, WL_V2), 32, gt, ngt); }
    if (!common) return;
    if (wb == 0 && F.tid < 2) ((unsigned*)(F.ws + WS_CTL))[64 * F.tid] = 0u;
    for (int i = gt; i < 256 * D; i += ngt) { const int r = i >> 11, k = i & (D - 1); float v = 0.f;
        if (r < NMOD) { const float c = r < NB ? INP(2)[r * D + k] : INP(3)[(r - NB) * D + k]; v = c / (1.f + expf(-c)); }
        ((bf16*)(F.ws + WS_SILC))[i] = (bf16)f2bf(v); }
    for (int i = gt; i < 4097 * 32; i += ngt) { const int p = i >> 5, d = i & 31; const float pos = p < 4096 ? (float)p : (float)PASTLEN;
        const float inv = powf(10000.f, -(float)d * (2.0f / 64.f)), ang = pos * inv; float* t = (float*)(F.ws + WS_ROPE) + (size_t)p * 64; t[d] = cosf(ang); t[32 + d] = sinf(ang); }
}

__device__ __forceinline__ void norm_phase(const Frame& F, int l, int which  , int nslab  ) {
    const int gw = F.bid * NWAVES + F.wave, NGW = F.G * NWAVES;
    const float* g = which == 0 ? INP(11) + l * D : which == 1 ? INP(12) + l * D : INP(38); const float* xp0 = INP(0); const float* xp1 = INP(1);
    for (int m = gw; m < M; m += NGW) {
        const float* xr = (which == 0 && l == 0) ? (m < MP ? xp0 + (size_t)m * D : xp1 + (size_t)(m - MP) * D) : (const float*)(F.ws + WS_X) + (size_t)m * D;
        f32x4 v[8], gv[8], shv[8], scv[8]; float s = 0.f;
        const float* mod = (const float*)(F.ws + WS_MOD) + ((size_t)l * NMOD + modrow(m)) * NADA + (which == 0 ? 0 : 3 * D);
#pragma unroll
        for (int j = 0; j < 8; ++j) { v[j] = *(const f32x4*)(xr + j * 256 + F.lane * 4); gv[j] = *(const f32x4*)(g + j * 256 + F.lane * 4);
            if (which != 2) { shv[j] = *(const f32x4*)(mod + j * 256 + F.lane * 4); scv[j] = *(const f32x4*)(mod + D + j * 256 + F.lane * 4); } else { shv[j] = gv[j]; scv[j] = gv[j]; } }
        if (nslab && m >= MP) { const float* sl = (const float*)(F.ws + WS_SLAB) + (size_t)(m - MP) * D + F.lane * 4;
            for (int q = 0; q < nslab; ++q) {
#pragma unroll
                for (int j = 0; j < 8; ++j) v[j] += *(const f32x4*)(sl + (size_t)q * NS * D + j * 256); }
            float* xs = (float*)(F.ws + WS_X) + (size_t)m * D;
#pragma unroll
            for (int j = 0; j < 8; ++j) *(f32x4*)(xs + j * 256 + F.lane * 4) = v[j]; }
#pragma unroll
        for (int j = 0; j < 8; ++j) { s += (v[j].x * v[j].x + v[j].y * v[j].y) + (v[j].z * v[j].z + v[j].w * v[j].w); }
        const float rs = rsqrtf(wave_sum(s) * (1.f / D) + 1e-6f);
        if (which == 0 && l == 0 && m >= MP) { float* xs = (float*)(F.ws + WS_X) + (size_t)m * D;
#pragma unroll
            for (int j = 0; j < 8; ++j) *(f32x4*)(xs + j * 256 + F.lane * 4) = v[j]; }
        if (which == 2) { float* o = F.out + O_YP + (size_t)m * D;
#pragma unroll
            for (int j = 0; j < 8; ++j) *(f32x4*)(o + j * 256 + F.lane * 4) = v[j] * rs * gv[j]; }
        else { bf16* o = (bf16*)(F.ws + WS_H) + (size_t)m * D;
#pragma unroll
            for (int j = 0; j < 8; ++j) { const int c = j * 256 + F.lane * 4; const f32x4 y = v[j] * rs * gv[j] * (scv[j] + 1.f) + shv[j]; u32x2 w; w.x = pk2(y.x, y.y); w.y = pk2(y.z, y.w); *(u32x2*)(o + c) = w; } }
    }
}
}
#ifdef MK_TS_ID
#ifndef MK_TS_BLOCK
#define MK_TS_BLOCK 0
#endif
#define TSB2(id, ldsp) do { if ((id) == MK_TS_ID && blockIdx.x == MK_TS_BLOCK && threadIdx.x == 0) *(volatile __attribute__((address_space(3))) unsigned*)((ldsp) + 135168 - 64) -= (unsigned)__builtin_amdgcn_s_memrealtime(); } while (0)
#define TSE2(id, ldsp) do { if ((id) == MK_TS_ID && blockIdx.x == MK_TS_BLOCK && threadIdx.x == 0) *(volatile __attribute__((address_space(3))) unsigned*)((ldsp) + 135168 - 64) += (unsigned)__builtin_amdgcn_s_memrealtime(); } while (0)
#else
#define TSB2(id, ldsp) do {} while (0)
#define TSE2(id, ldsp) do {} while (0)
#endif
namespace mk {
constexpr int BM = 256, BK = 64, HALF = 128, HTB = HALF * BK * 2, STAGE_BYTES = 8 * HTB, NXCD = 8, WGM = 8;
__device__ __forceinline__ int lds_byte(int r, int c) { const int st = (r >> 4) * 2 + (c >> 5), rr = r & 15, cc = c & 31, ob = rr * 64 + cc * 2; return st * 1024 + (ob ^ (((ob >> 9) & 1) << 5)); }
__device__ __forceinline__ void stage_rc(int b, int& R, int& C) { const int st = b / 1024, sb = b % 1024, swz = sb ^ (((sb >> 9) & 1) << 5); R = (st >> 1) * 16 + swz / 64; C = (st & 1) * 32 + (swz % 64) / 2; }
__device__ __forceinline__ int perm32(int rho) { const int n = rho >> 4, i = rho & 15; return 8 * (i >> 2) + 4 * n + (i & 3); }

struct Unit { int pm, pn, seg; };
enum { G_ADA = 0, G_IN, G_MG, G_WO, G_GU, G_DN };
struct Gemm { const bf16* A; const bf16* Bt; int ld, M, N, K, mode, layer; };

struct Rect { int pm0, nM, pn0, nN; };
struct Sched {
    Rect ra, rb; int G, c, nseg, ksb;
    __device__ __forceinline__ void init(const Rect& a, const Rect& b, int G_, int c_, int nseg_, int ksb_ = 0) { ra = a; rb = b; G = G_; c = c_; nseg = nseg_; ksb = ksb_; }
    __device__ __forceinline__ bool next(int i, Unit& u) const {
        const int ti = i / nseg, seg = i - ti * nseg, nA = ra.nM * ra.nN, nB = rb.nM * rb.nN;
        const long L = (long)ti * G + c; if (L >= nA + nB) return false;
        const bool inA = L < nA; const int pm0 = inA ? ra.pm0 : rb.pm0, nM = inA ? ra.nM : rb.nM, pn0 = inA ? ra.pn0 : rb.pn0, nN = inA ? ra.nN : rb.nN, nwg = nM * nN;
        int wgid = inA ? (int)L : (int)L - nA; { const int q = nwg / NXCD, r = nwg % NXCD, xcd = wgid % NXCD, off = wgid / NXCD; wgid = (xcd < r ? xcd * (q + 1) : r * (q + 1) + (xcd - r) * q) + off; }
        const int nig = WGM * nN, gid = wgid / nig, fm = gid * WGM, gsz = (nM - fm) < WGM ? (nM - fm) : WGM;
        u.pm = pm0 + fm + ((wgid % nig) % gsz); u.pn = pn0 + (wgid % nig) / gsz; u.seg = seg;
        if (!inA && ksb > 0) { const int q = u.pn - pn0; u.seg = q / ksb; u.pn = pn0 + q % ksb; }
        return true;
    }
};

typedef __bf16 bf16x2_t __attribute__((ext_vector_type(2)));
__device__ __forceinline__ unsigned cvt_pk_bf16(float lo, float hi) { const f32x2 v = {lo, hi}; const bf16x2_t b = __builtin_convertvector(v, bf16x2_t); return __builtin_bit_cast(unsigned, b); }
__device__ __forceinline__ f32x4 sig4(f32x4 v) { f32x4 r; r.x = fsigm(v.x); r.y = fsigm(v.y); r.z = fsigm(v.z); r.w = fsigm(v.w); return r; }

__device__ __forceinline__ float gclamp(float g) { return fmaxf(g, 1e-18f); }
struct Epi {
    const Frame* F; int mode, layer;
    __device__ __forceinline__ void rescale(f32x4 (&acc)[2][2][4][2], const Unit& u, int sp, int wr, int wc, int fr, int fq) const {
        int row0 = u.pm * BM + wr * 64 + fr; asm volatile("" : "+v"(row0)); const int c0 = u.pn * BM + wc * 32 + 8 * fq; const bf16* gt = (const bf16*)(F->ws + WS_GT) + sp * D + c0;
#pragma unroll
        for (int ai = 0; ai < 2; ++ai)
#pragma unroll
            for (int m = 0; m < 4; ++m) { const int r = row0 + ai * HALF + m * 16; const int rr = r < M ? r : M - 1;
#pragma unroll
                for (int bj = 0; bj < 2; ++bj) { const u32x4 ga = *(const u32x4*)(gt + (size_t)rr * 6144 + bj * HALF), gb = *(const u32x4*)(gt + (size_t)rr * 6144 + D + bj * HALF);
                    f32x4& v0 = acc[ai][bj][m][0]; f32x4& v1 = acc[ai][bj][m][1];
                    v0.x *= gclamp(bflo(ga.x)) * __builtin_amdgcn_rcpf(gclamp(bflo(gb.x))); v0.y *= gclamp(bfhi(ga.x)) * __builtin_amdgcn_rcpf(gclamp(bfhi(gb.x)));
                    v0.z *= gclamp(bflo(ga.y)) * __builtin_amdgcn_rcpf(gclamp(bflo(gb.y))); v0.w *= gclamp(bfhi(ga.y)) * __builtin_amdgcn_rcpf(gclamp(bfhi(gb.y)));
                    v1.x *= gclamp(bflo(ga.z)) * __builtin_amdgcn_rcpf(gclamp(bflo(gb.z))); v1.y *= gclamp(bfhi(ga.z)) * __builtin_amdgcn_rcpf(gclamp(bfhi(gb.z)));
                    v1.z *= gclamp(bflo(ga.w)) * __builtin_amdgcn_rcpf(gclamp(bflo(gb.w))); v1.w *= gclamp(bfhi(ga.w)) * __builtin_amdgcn_rcpf(gclamp(bfhi(gb.w))); }
                if (m & 1) asm volatile("" ::: "memory"); }
    }
    __device__ __forceinline__ void operator()(const f32x4 (&acc)[2][2][4][2], const Unit& u, int wr, int wc, int fr, int fq) const {
        const Frame& Fr = *F; const int l = layer;
        int row0 = u.pm * BM + wr * 64 + fr; const int colb = u.pn * BM + wc * 32 + 8 * fq;
        asm volatile("" : "+v"(row0));
        unsigned char* ws = Fr.ws;
        if (mode == G_ADA) {
            const float* ab = INP(10);
#pragma unroll
            for (int ai = 0; ai < 2; ++ai)
#pragma unroll
                for (int m = 0; m < 4; ++m) { const int r = row0 + ai * HALF + m * 16; if (r < NMOD) {
#pragma unroll
                    for (int bj = 0; bj < 2; ++bj) { const int c = colb + bj * HALF, ll = c / NADA, j = c - ll * NADA; float* o = (float*)(ws + WS_MOD) + ((size_t)ll * NMOD + r) * NADA + j;
                        *(f32x4*)o = acc[ai][bj][m][0] + *(const f32x4*)(ab + c); *(f32x4*)(o + 4) = acc[ai][bj][m][1] + *(const f32x4*)(ab + c + 4); } } }
        } else if (mode == G_IN) {
            const int pn = u.pn;
            if (pn < 5) {
                const int wp = wc & 1; const float* rt = (const float*)(ws + WS_ROPE);
#pragma unroll
                for (int ai = 0; ai < 2; ++ai)
#pragma unroll
                    for (int m = 0; m < 4; ++m) { const int r = row0 + ai * HALF + m * 16; if (r < M) {
                        const float* tp = rt + (size_t)posidx(r) * 64 + 16 * wp + 4 * fq; const f32x4 cs = *(const f32x4*)tp, sn = *(const f32x4*)(tp + 32);
#pragma unroll
                        for (int bj = 0; bj < 2; ++bj) { const f32x4 x1 = acc[ai][bj][m][0], x2 = acc[ai][bj][m][1]; const f32x4 o1 = x1 * cs - x2 * sn, o2 = x2 * cs + x1 * sn;
                            u32x4 w; w.x = cvt_pk_bf16(o1.x, o1.y); w.y = cvt_pk_bf16(o1.z, o1.w); w.z = cvt_pk_bf16(o2.x, o2.y); w.w = cvt_pk_bf16(o2.z, o2.w);
                            const int hc = bj * HALF + wc * 32 + 8 * fq;
                            if (pn < 4) *(u32x4*)((bf16*)(ws + WS_Q) + (size_t)r * 1024 + pn * 256 + hc) = w;
                            else { *(u32x4*)((bf16*)(ws + WS_K) + (size_t)r * 256 + hc) = w;
                                const int hk = hc >> 6, d1 = 16 * wp + 4 * fq; float* ko = nullptr;
                                if (r < MP) { const int t = r & (SEQ - 1); if (t >= SEQ - 128) ko = Fr.out + O_KP + ((((size_t)l * NB + (r >> 12)) * 128 + (t - (SEQ - 128))) * 4 + hk) * 64; }
                                else ko = Fr.out + O_KS + ((((size_t)l * NS + (r - MP)) * 128 + 127) * 4 + hk) * 64;
                                if (ko) { *(f32x4*)(ko + d1) = o1; *(f32x4*)(ko + d1 + 32) = o2; } } } } }
            } else if (pn == 5) {
#pragma unroll
                for (int ai = 0; ai < 2; ++ai)
#pragma unroll
                    for (int m = 0; m < 4; ++m) { const int r = row0 + ai * HALF + m * 16; if (r < M) {
#pragma unroll
                        for (int bj = 0; bj < 2; ++bj) { const f32x4 v0 = acc[ai][bj][m][0], v1 = acc[ai][bj][m][1]; const int hc = bj * HALF + wc * 32 + 8 * fq;
                            u32x4 w; w.x = cvt_pk_bf16(v0.x, v0.y); w.y = cvt_pk_bf16(v0.z, v0.w); w.z = cvt_pk_bf16(v1.x, v1.y); w.w = cvt_pk_bf16(v1.z, v1.w);
                            *(u32x4*)((bf16*)(ws + WS_V) + (size_t)r * 256 + hc) = w;
                            float* vo = nullptr;
                            if (r < MP) { const int t = r & (SEQ - 1); if (t >= SEQ - 128) vo = Fr.out + O_VP + (((size_t)l * NB + (r >> 12)) * 128 + (t - (SEQ - 128))) * 256; }
                            else vo = Fr.out + O_VS + (((size_t)l * NS + (r - MP)) * 128 + 127) * 256;
                            if (vo) { *(f32x4*)(vo + hc) = v0; *(f32x4*)(vo + hc + 4) = v1; } } } }
            } else if (pn < 16) {
                float* base = pn < 8 ? (float*)(ws + WS_U) : (float*)(ws + WS_PR); const int ld = pn < 8 ? 512 : 2048, c0 = (pn < 8 ? (pn - 6) : (pn - 8)) * 256 + wc * 32 + 8 * fq;
#pragma unroll
                for (int ai = 0; ai < 2; ++ai)
#pragma unroll
                    for (int m = 0; m < 4; ++m) { const int r = row0 + ai * HALF + m * 16; if (r < M) {
#pragma unroll
                        for (int bj = 0; bj < 2; ++bj) { float* o = base + (size_t)r * ld + c0 + bj * HALF; *(f32x4*)o = acc[ai][bj][m][0]; *(f32x4*)(o + 4) = acc[ai][bj][m][1]; } } }
            } else {
                const int c0 = (pn - 16) * 256 + wc * 32 + 8 * fq;
#pragma unroll
                for (int ai = 0; ai < 2; ++ai)
#pragma unroll
                    for (int m = 0; m < 4; ++m) { const int r = row0 + ai * HALF + m * 16; if (r < M) {
#pragma unroll
                        for (int bj = 0; bj < 2; ++bj) { const f32x4 v0 = sig4(acc[ai][bj][m][0]), v1 = sig4(acc[ai][bj][m][1]);
                            u32x4 w; w.x = cvt_pk_bf16(v0.x, v0.y); w.y = cvt_pk_bf16(v0.z, v0.w); w.z = cvt_pk_bf16(v1.x, v1.y); w.w = cvt_pk_bf16(v1.z, v1.w);
                            *(u32x4*)((bf16*)(ws + WS_GT) + (size_t)r * 6144 + c0 + bj * HALF) = w; } } }
            }
        } else if (mode == G_MG && u.pm == MPAD / BM - 1) {
            const int c0 = u.pn * BM + wc * 32 + 8 * fq, br = u.seg < 2 ? 0 : u.seg - 1;
#pragma unroll
            for (int m = 0; m < 4; ++m) { const int r = row0 + m * 16; if (r < M) { float* so = (float*)(ws + WS_SLABM) + ((size_t)u.seg * NS + (r - MP)) * D;
#pragma unroll
                for (int bj = 0; bj < 2; ++bj) { const int c = c0 + bj * HALF; const u32x4 gw = *(const u32x4*)((const bf16*)(ws + WS_GT) + (size_t)r * 6144 + br * D + c);
                    f32x4 v0 = acc[0][bj][m][0], v1 = acc[0][bj][m][1];
                    v0.x *= gclamp(bflo(gw.x)); v0.y *= gclamp(bfhi(gw.x)); v0.z *= gclamp(bflo(gw.y)); v0.w *= gclamp(bfhi(gw.y)); v1.x *= gclamp(bflo(gw.z)); v1.y *= gclamp(bfhi(gw.z)); v1.z *= gclamp(bflo(gw.w)); v1.w *= gclamp(bfhi(gw.w));
                    *(f32x4*)(so + c) = v0; *(f32x4*)(so + c + 4) = v1; } } }
        } else if (mode == G_MG) {
            const int c0 = u.pn * BM + wc * 32 + 8 * fq;
#pragma unroll
            for (int ai = 0; ai < 2; ++ai)
#pragma unroll
                for (int m = 0; m < 4; ++m) { const int r = row0 + ai * HALF + m * 16; if (r < M) {
#pragma unroll
                    for (int bj = 0; bj < 2; ++bj) { const int c = c0 + bj * HALF; const u32x4 gw = *(const u32x4*)((const bf16*)(ws + WS_GT) + (size_t)r * 6144 + 2 * D + c);
                        f32x4 v0 = acc[ai][bj][m][0], v1 = acc[ai][bj][m][1];
                        v0.x *= gclamp(bflo(gw.x)); v0.y *= gclamp(bfhi(gw.x)); v0.z *= gclamp(bflo(gw.y)); v0.w *= gclamp(bfhi(gw.y)); v1.x *= gclamp(bflo(gw.z)); v1.y *= gclamp(bfhi(gw.z)); v1.z *= gclamp(bflo(gw.w)); v1.w *= gclamp(bfhi(gw.w));
                        u32x4 w; w.x = cvt_pk_bf16(v0.x, v0.y); w.y = cvt_pk_bf16(v0.z, v0.w); w.z = cvt_pk_bf16(v1.x, v1.y); w.w = cvt_pk_bf16(v1.z, v1.w); *(u32x4*)((bf16*)(ws + WS_MG) + (size_t)r * D + c) = w; } } }
        } else if (mode == G_WO || mode == G_DN) {
            const int c0 = u.pn * BM + wc * 32 + 8 * fq; const int goff = mode == G_WO ? 2 * D : 5 * D;
            if (u.pm == MPAD / BM - 1) {
#pragma unroll
                for (int m = 0; m < 4; ++m) { const int r = row0 + m * 16; if (r < M) {
                    const float* gp = (const float*)(ws + WS_MOD) + ((size_t)l * NMOD + modrow(r)) * NADA + goff; float* so = (float*)(ws + WS_SLAB) + ((size_t)u.seg * NS + (r - MP)) * D;
#pragma unroll
                    for (int bj = 0; bj < 2; ++bj) { const int c = c0 + bj * HALF; const f32x4 g0 = *(const f32x4*)(gp + c), g1 = *(const f32x4*)(gp + c + 4);
                        *(f32x4*)(so + c) = (g0 + 1.f) * acc[0][bj][m][0]; *(f32x4*)(so + c + 4) = (g1 + 1.f) * acc[0][bj][m][1]; } } }
            } else {
                const float* gp = (const float*)(ws + WS_MOD) + ((size_t)l * NMOD + (u.pm >> 4)) * NADA + goff + c0;
                const f32x4 ga0 = *(const f32x4*)gp + 1.f, ga1 = *(const f32x4*)(gp + 4) + 1.f, gb0 = *(const f32x4*)(gp + HALF) + 1.f, gb1 = *(const f32x4*)(gp + HALF + 4) + 1.f;
                const float* xbase = (mode == G_WO && l == 0) ? INP(0) : (const float*)(ws + WS_X); float* xob = (float*)(ws + WS_X);
#pragma unroll
                for (int am = 0; am < 8; am += 2) { f32x4 xv[2][4];
#pragma unroll
                    for (int q = 0; q < 2; ++q) { const int ai = (am + q) >> 2, m = (am + q) & 3; const float* xin = xbase + (size_t)(row0 + ai * HALF + m * 16) * D + c0;
                        xv[q][0] = *(const f32x4*)xin; xv[q][1] = *(const f32x4*)(xin + 4); xv[q][2] = *(const f32x4*)(xin + HALF); xv[q][3] = *(const f32x4*)(xin + HALF + 4); }
#pragma unroll
                    for (int q = 0; q < 2; ++q) { const int ai = (am + q) >> 2, m = (am + q) & 3; float* xo = xob + (size_t)(row0 + ai * HALF + m * 16) * D + c0;
                        *(f32x4*)xo = xv[q][0] + ga0 * acc[ai][0][m][0]; *(f32x4*)(xo + 4) = xv[q][1] + ga1 * acc[ai][0][m][1];
                        *(f32x4*)(xo + HALF) = xv[q][2] + gb0 * acc[ai][1][m][0]; *(f32x4*)(xo + HALF + 4) = xv[q][3] + gb1 * acc[ai][1][m][1]; }
                    asm volatile("" ::: "memory"); }
            }
        } else {
            const int c0 = u.pn * 128 + wc * 16 + 4 * fq;
#pragma unroll
            for (int ai = 0; ai < 2; ++ai)
#pragma unroll
                for (int m = 0; m < 4; ++m) { const int r = row0 + ai * HALF + m * 16; if (r < M) {
#pragma unroll
                    for (int bj = 0; bj < 2; ++bj) { const f32x4 g = acc[ai][bj][m][0], up = acc[ai][bj][m][1]; const f32x4 a = g * sig4(g) * up;
                        u32x2 w; w.x = cvt_pk_bf16(a.x, a.y); w.y = cvt_pk_bf16(a.z, a.w); *(u32x2*)((bf16*)(ws + WS_GT) + (size_t)r * DFF + c0 + bj * 64) = w; } } }
        }
    }
};

__device__ __forceinline__ void gemm_phase(LAS unsigned char* lds, const Gemm g, const Sched& S, const Epi& E, const int tid  ) {
    const int wid = __builtin_amdgcn_readfirstlane(tid >> 6), lane = tid & 63, wr = wid >> 2, wc = wid & 3, fr = lane & 15, fq = lane >> 4;
    unsigned voffA[2], voffB[2];
#pragma unroll
    for (int i = 0; i < 2; ++i) { int R, C; stage_rc(tid * 16 + i * 8192, R, C); const int Rb = (R & ~31) + perm32(R & 31);
        voffA[i] = (unsigned)(R * g.ld + C) * 2u; voffB[i] = (unsigned)(Rb * g.ld + C) * 2u; }
    constexpr unsigned kstep = BK * 2;
    const unsigned hstep = (unsigned)HALF * (unsigned)g.ld * 2u; const bool mgd = g.mode == G_MG; const int ntfull = g.K / BK;
    const bool ksd = g.mode == G_WO || g.mode == G_DN || g.mode == G_MG;
#define PG8_KS(u) (ksd && (u).pm == MPAD / BM - 1)
#define PG8_KA(u) (PG8_KS(u) ? (unsigned)(u).seg * 512u : 0u)
#define PG8_NT(u) (PG8_KS(u) ? 8 : ntfull)
#define PG8_TILE(p, u) (((unsigned)(p) * (unsigned)BM * (unsigned)g.ld + PG8_KA(u)) * 2u)
    const unsigned ldsw = (unsigned)wid * 1024u;
    const int aoff = lds_byte(wr * 64 + fr, fq * 8), boff = lds_byte(wc * 32 + fr, fq * 8);
#define PG8_SA(b, h) (((b) * 2 + (h)) * HTB)
#define PG8_SB(b, h) ((4 + (b) * 2 + (h)) * HTB)
#define PG8_STAGE(bufoff, gbase, soff, voff) do { _Pragma("unroll") for (int _i = 0; _i < 2; ++_i) \
        __builtin_amdgcn_global_load_lds((const unsigned*)((const char*)(gbase) + (size_t)((voff)[_i] + (unsigned)(soff))), (LAS unsigned*)(lds + (bufoff) + ldsw + _i * 8192), 16, 0, 0); } while (0)
#define PG8_STA(bufoff, soff) PG8_STAGE(bufoff, g.A, soff, voffA)
#define PG8_STB(bufoff, soff) PG8_STAGE(bufoff, g.Bt, soff, voffB)
#define PG8_LDA(dst, b, h) do { _Pragma("unroll") for (int m = 0; m < 4; ++m) _Pragma("unroll") for (int k = 0; k < 2; ++k) dst[m][k] = *(const LAS bf16x8*)(lds + PG8_SA(b, h) + aoff + m * 2048 + k * 1024); } while (0)
#define PG8_LDB(dst, b, h) do { _Pragma("unroll") for (int n = 0; n < 2; ++n) _Pragma("unroll") for (int k = 0; k < 2; ++k) dst[n][k] = *(const LAS bf16x8*)(lds + PG8_SB(b, h) + boff + n * 2048 + k * 1024); } while (0)
#define PG8_MMA(ai, bj, At, Bt) do { __builtin_amdgcn_s_setprio(1); _Pragma("unroll") for (int m = 0; m < 4; ++m) _Pragma("unroll") for (int n = 0; n < 2; ++n) _Pragma("unroll") for (int k = 0; k < 2; ++k) \
        acc[ai][bj][m][n] = __builtin_amdgcn_mfma_f32_16x16x32_bf16(Bt[n][k], At[m][k], acc[ai][bj][m][n], 0, 0, 0); __builtin_amdgcn_s_setprio(0); } while (0)
#define PG8_WAIT_V(n) asm volatile("s_waitcnt vmcnt(" #n ")" ::: "memory")
#define PG8_WAIT_L(n) asm volatile("s_waitcnt lgkmcnt(" #n ")" ::: "memory")
#define PG8_BAR __builtin_amdgcn_s_barrier()
#define PG8_SCHED __builtin_amdgcn_sched_barrier(0)
    Unit cur, nxt; int ui = 0;
    if (!S.next(0, cur)) return;
    f32x4 acc[2][2][4][2];
#pragma unroll
    for (int a = 0; a < 2; ++a)
#pragma unroll
        for (int b = 0; b < 2; ++b)
#pragma unroll
            for (int m = 0; m < 4; ++m)
#pragma unroll
                for (int n = 0; n < 2; ++n) acc[a][b][m][n] = (f32x4){0.f, 0.f, 0.f, 0.f};
    bf16x8 At[4][2], B0[2][2], B1[2][2];
    unsigned cA = PG8_TILE(cur.pm, cur), cB = PG8_TILE(cur.pn, cur);
    PG8_STB(PG8_SB(0, 0), cB); PG8_STB(PG8_SB(0, 1), cB + hstep); PG8_STA(PG8_SA(0, 0), cA); PG8_STA(PG8_SA(0, 1), cA + hstep);
    if (wr == 1) PG8_BAR;
    PG8_WAIT_V(2); PG8_BAR;
    PG8_STB(PG8_SB(1, 0), cB + kstep); PG8_STA(PG8_SA(1, 0), cA + kstep); PG8_STB(PG8_SB(1, 1), cB + hstep + kstep);
    PG8_WAIT_V(6); PG8_BAR;
    for (;;) {
        const bool has_next = S.next(ui + 1, nxt);
        const unsigned nA = has_next ? PG8_TILE(nxt.pm, nxt) : cA, nB = has_next ? PG8_TILE(nxt.pn, nxt) : cB;
        const int nt = PG8_NT(cur);
        TSB2(50 + 2 * g.mode, lds);
        for (int t = 0; t < nt; t += 2) {
            const bool last = (t == nt - 2);
            if (mgd && !PG8_KS(cur) && (t == 16 || t == 24)) E.rescale(acc, cur, t == 16 ? 0 : 1, wr, wc, fr, fq);
            const unsigned a1 = cA + (unsigned)(t + 1) * kstep;
            const unsigned a2 = last ? nA : cA + (unsigned)(t + 2) * kstep, b2 = last ? nB : cB + (unsigned)(t + 2) * kstep;
            const unsigned a3 = a2 + kstep, b3 = b2 + kstep;
            PG8_LDB(B0, 0, 0); PG8_LDB(B1, 0, 1); PG8_SCHED; PG8_LDA(At, 0, 0); PG8_STA(PG8_SA(1, 1), a1 + hstep);
            PG8_WAIT_V(8); PG8_WAIT_L(0); PG8_BAR; PG8_MMA(0, 0, At, B0); PG8_MMA(0, 1, At, B1); PG8_BAR; PG8_SCHED;
            PG8_LDA(At, 0, 1); PG8_STB(PG8_SB(0, 0), b2); PG8_STB(PG8_SB(0, 1), b2 + hstep); PG8_STA(PG8_SA(0, 0), a2);
            PG8_WAIT_V(8); PG8_WAIT_L(0); PG8_BAR; PG8_MMA(1, 0, At, B0); PG8_MMA(1, 1, At, B1); PG8_BAR; PG8_SCHED;
            PG8_LDB(B0, 1, 0); PG8_LDB(B1, 1, 1); PG8_SCHED; PG8_LDA(At, 1, 0); PG8_STA(PG8_SA(0, 1), a2 + hstep);
            PG8_WAIT_V(8); PG8_WAIT_L(0); PG8_BAR; PG8_MMA(0, 0, At, B0); PG8_MMA(0, 1, At, B1); PG8_BAR; PG8_SCHED;
            PG8_LDA(At, 1, 1); PG8_STB(PG8_SB(1, 0), b3); PG8_STB(PG8_SB(1, 1), b3 + hstep); PG8_STA(PG8_SA(1, 0), a3);
            PG8_WAIT_V(8); PG8_WAIT_L(0); PG8_BAR; PG8_MMA(1, 0, At, B0); PG8_MMA(1, 1, At, B1); PG8_BAR; PG8_SCHED;
        }
        if (wr == 0) PG8_BAR;
        TSE2(50 + 2 * g.mode, lds);
        TSB2(51 + 2 * g.mode, lds); E(acc, cur, wr, wc, fr, fq); TSE2(51 + 2 * g.mode, lds);
        if (!has_next) break;
#pragma unroll
        for (int a = 0; a < 2; ++a)
#pragma unroll
            for (int b = 0; b < 2; ++b)
#pragma unroll
                for (int m = 0; m < 4; ++m)
#pragma unroll
                    for (int n = 0; n < 2; ++n) acc[a][b][m][n] = (f32x4){0.f, 0.f, 0.f, 0.f};
        cur = nxt; cA = nA; cB = nB; ++ui;
        if (wr == 1) PG8_BAR;
    }
    PG8_WAIT_V(0);
    PG8_BAR;
#undef PG8_KS
#undef PG8_KA
#undef PG8_NT
#undef PG8_TILE
#undef PG8_STA
#undef PG8_STB
#undef PG8_SA
#undef PG8_SB
#undef PG8_STAGE
#undef PG8_LDA
#undef PG8_LDB
#undef PG8_MMA
#undef PG8_WAIT_V
#undef PG8_WAIT_L
#undef PG8_BAR
#undef PG8_SCHED
}
}
namespace mk {
#define MFMA16(a, b, c) __builtin_amdgcn_mfma_f32_16x16x32_bf16((a), (b), (c), 0, 0, 0)
__device__ __forceinline__ bf16x8 pack8(f32x4 a, f32x4 b) { u32x4 w; w.x = cvt_pk_bf16(a.x, a.y); w.y = cvt_pk_bf16(a.z, a.w); w.z = cvt_pk_bf16(b.x, b.y); w.w = cvt_pk_bf16(b.z, b.w); return __builtin_bit_cast(bf16x8, w); }
typedef short s16x4 __attribute__((ext_vector_type(4)));
__device__ __forceinline__ bf16x8 cat44(s16x4 a, s16x4 b) { return (bf16x8){a[0], a[1], a[2], a[3], b[0], b[1], b[2], b[3]}; }
constexpr float LOG2E = 1.4426950408889634f;

constexpr int AK_STRIDE = 144, AV_STRIDE = 560;
constexpr int A_KOFF = 0, A_VOFF = 256 * AK_STRIDE, A_BYTES = A_VOFF + 64 * AV_STRIDE;
__device__ __forceinline__ void attn_prompt_unit(const Frame& F, int l, int b, int blk, int hk) {
    LAS unsigned char* Ks = F.lds + A_KOFF; LAS unsigned char* Vt = F.lds + A_VOFF;
    const bf16* Kg = (const bf16*)(F.ws + WS_K); const bf16* Vg = (const bf16*)(F.ws + WS_V); const bf16* Qg = (const bf16*)(F.ws + WS_Q);
    const int kp0 = blk * 128 - 128;
#pragma unroll
    for (int ch = F.tid; ch < 2048; ch += NTHR) { const int i = ch >> 3, dc = ch & 7, kp = kp0 + i;
        u32x4 kv = (u32x4){0u, 0u, 0u, 0u}, vv = kv;
        if (kp >= 0) { const size_t m = (size_t)b * SEQ + kp; kv = *(const u32x4*)(Kg + m * 256 + hk * 64 + dc * 8); vv = *(const u32x4*)(Vg + m * 256 + hk * 64 + dc * 8); }
        *(LAS u32x4*)(Ks + i * AK_STRIDE + dc * 16) = kv;
        LAS unsigned short* vp = (LAS unsigned short*)(Vt + (dc * 8) * AV_STRIDE) + i;
        vp[0 * (AV_STRIDE / 2)] = (unsigned short)(vv.x & 0xffff); vp[1 * (AV_STRIDE / 2)] = (unsigned short)(vv.x >> 16); vp[2 * (AV_STRIDE / 2)] = (unsigned short)(vv.y & 0xffff); vp[3 * (AV_STRIDE / 2)] = (unsigned short)(vv.y >> 16);
        vp[4 * (AV_STRIDE / 2)] = (unsigned short)(vv.z & 0xffff); vp[5 * (AV_STRIDE / 2)] = (unsigned short)(vv.z >> 16); vp[6 * (AV_STRIDE / 2)] = (unsigned short)(vv.w & 0xffff); vp[7 * (AV_STRIDE / 2)] = (unsigned short)(vv.w >> 16); }
    for (int i = F.tid; i < 64 * 24; i += NTHR) { const int d = i / 24, c = i % 24; ((LAS unsigned short*)(Vt + d * AV_STRIDE))[256 + c] = 0; }
    const int g = F.lane >> 4, c16 = F.lane & 15;
    const float* sinkp = INP(14) + l * 16;
    bf16x8 q0n, q1n;
    { const int gi = F.wave * 4, hq = hk * 4 + (gi >> 3), qs = gi & 7; const size_t mq = (size_t)b * SEQ + blk * 128 + 16 * qs + c16;
      q0n = *(const bf16x8*)(Qg + mq * 1024 + hq * 64 + 8 * g); q1n = *(const bf16x8*)(Qg + mq * 1024 + hq * 64 + 32 + 8 * g); }
    __syncthreads();
#pragma unroll 1
    for (int it = 0; it < 4; ++it) {
        const int gi = F.wave * 4 + it, hq = hk * 4 + (gi >> 3), qs = gi & 7;
        const int tqr = 16 * qs + c16;
        const size_t mq = (size_t)b * SEQ + blk * 128 + tqr;
        const bf16x8 q0 = q0n, q1 = q1n;
        if (it < 3) { const int gn = gi + 1, hn = hk * 4 + (gn >> 3), qn_ = gn & 7; const size_t mn = (size_t)b * SEQ + blk * 128 + 16 * qn_ + c16;
            q0n = *(const bf16x8*)(Qg + mn * 1024 + hn * 64 + 8 * g); q1n = *(const bf16x8*)(Qg + mn * 1024 + hn * 64 + 32 + 8 * g); }
        f32x4 s[10];
#pragma unroll
        for (int j = 0; j < 9; ++j) { LAS const unsigned char* kr = Ks + (16 * (qs + j) + c16) * AK_STRIDE + 16 * g;
            const bf16x8 k0 = *(LAS const bf16x8*)kr, k1 = *(LAS const bf16x8*)(kr + 64);
            f32x4 a = (f32x4){0.f, 0.f, 0.f, 0.f}; a = MFMA16(k0, q0, a); a = MFMA16(k1, q1, a); s[j] = a; }
        const float sk2 = sinkp[hq] * LOG2E; float mx = sk2;
#pragma unroll
        for (int j = 0; j < 9; ++j)
#pragma unroll
            for (int r = 0; r < 4; ++r) { const int i = 16 * (qs + j) + 4 * g + r; const bool ok = (i >= tqr) && (i <= tqr + 128) && (kp0 + i >= 0);
                const float v = ok ? s[j][r] * (0.125f * LOG2E) : -1e30f; s[j][r] = v; mx = fmaxf(mx, v); }
        mx = fmaxf(mx, __shfl_xor(mx, 16)); mx = fmaxf(mx, __shfl_xor(mx, 32));
        float sum = 0.f;
#pragma unroll
        for (int j = 0; j < 9; ++j)
#pragma unroll
            for (int r = 0; r < 4; ++r) { const float p = __builtin_amdgcn_exp2f(s[j][r] - mx); s[j][r] = p; sum += p; }
        s[9] = (f32x4){0.f, 0.f, 0.f, 0.f};
        sum += __shfl_xor(sum, 16); sum += __shfl_xor(sum, 32);
        const float rl = 1.f / (sum + __builtin_amdgcn_exp2f(sk2 - mx));
        f32x4 o[4];
#pragma unroll
        for (int dt = 0; dt < 4; ++dt) o[dt] = (f32x4){0.f, 0.f, 0.f, 0.f};
#pragma unroll
        for (int kk = 0; kk < 5; ++kk) { const bf16x8 pf = pack8(s[2 * kk], s[2 * kk + 1]);
#pragma unroll
            for (int dt = 0; dt < 4; ++dt) { LAS const unsigned char* vr = Vt + (16 * dt + c16) * AV_STRIDE + (16 * (qs + 2 * kk) + 4 * g) * 2;
                const s16x4 v0 = *(LAS const s16x4*)vr, v1 = *(LAS const s16x4*)(vr + 32);
                o[dt] = MFMA16(cat44(v0, v1), pf, o[dt]); } }
        bf16* op = (bf16*)(F.ws + WS_CAT) + mq * D + hq * 64 + 4 * g;
#pragma unroll
        for (int dt = 0; dt < 4; ++dt) { const f32x4 v = o[dt] * rl; u32x2 w; w.x = cvt_pk_bf16(v.x, v.y); w.y = cvt_pk_bf16(v.z, v.w); *(u32x2*)(op + 16 * dt) = w; }
    }
    __syncthreads();
}

__device__ __forceinline__ void attn_sample_unit(const Frame& F, int l, int s_, int hf) {
    LAS float* qn = (LAS float*)F.lds;
    LAS float* kn = qn + 512;
    LAS float* vn = kn + 128;
    LAS float* sc = vn + 128;
    LAS float* rl = sc + 8 * 132;
    const int m = MP + s_; const float* sinkp = INP(14) + l * 16 + 8 * hf;
    const float* ck = INP(4) + ((size_t)l * NS + s_) * 128 * 256; const float* cv = INP(5) + ((size_t)l * NS + s_) * 128 * 256;
    { const int h = F.tid >> 6, p = F.tid & 63; qn[h * 64 + pi_d(p)] = bf2f(((const bf16*)(F.ws + WS_Q))[(size_t)m * 1024 + 512 * hf + F.tid]) * (0.125f * LOG2E); }
    if (F.tid < 128) { const int h = F.tid >> 6, p = F.tid & 63; kn[h * 64 + pi_d(p)] = bf2f(((const bf16*)(F.ws + WS_K))[(size_t)m * 256 + 128 * hf + F.tid]); vn[F.tid] = bf2f(((const bf16*)(F.ws + WS_V))[(size_t)m * 256 + 128 * hf + F.tid]); }
    { float* ko = F.out + O_KS + ((size_t)l * NS + s_) * 128 * 256; float* vo = F.out + O_VS + ((size_t)l * NS + s_) * 128 * 256; const int i0_ = 64 * hf * 64, i1_ = hf ? 127 * 64 : 64 * 64;
#pragma unroll 4
      for (int i = i0_ + F.tid; i < i1_; i += NTHR) { const f32x4 a = *(const f32x4*)(ck + 256 + 4 * i), b = *(const f32x4*)(cv + 256 + 4 * i); *(f32x4*)(ko + 4 * i) = a; *(f32x4*)(vo + 4 * i) = b; } }
    __syncthreads();
    for (int idx = F.tid; idx < 8 * 129; idx += NTHR) { const int hq = idx / 129, j = idx - hq * 129, hk = hq >> 2; float a = 0.f;
        if (j < 128) { const float* kr = ck + (size_t)j * 256 + (2 * hf + hk) * 64;
#pragma unroll
            for (int d = 0; d < 64; d += 4) { const f32x4 kv = *(const f32x4*)(kr + d); a += qn[hq * 64 + d] * kv.x + qn[hq * 64 + d + 1] * kv.y + qn[hq * 64 + d + 2] * kv.z + qn[hq * 64 + d + 3] * kv.w; } }
        else { for (int d = 0; d < 64; ++d) a += qn[hq * 64 + d] * kn[hk * 64 + d]; }
        sc[hq * 132 + j] = a; }
    __syncthreads();
    { const int hq = F.wave; const float sk2 = sinkp[hq] * LOG2E;
        float mx = sk2; for (int j = F.lane; j < 129; j += 64) mx = fmaxf(mx, sc[hq * 132 + j]);
#pragma unroll
        for (int o = 1; o < 64; o <<= 1) mx = fmaxf(mx, __shfl_xor(mx, o));
        float sum = 0.f; for (int j = F.lane; j < 129; j += 64) { const float p = __builtin_amdgcn_exp2f(sc[hq * 132 + j] - mx); sc[hq * 132 + j] = p; sum += p; }
        sum = wave_sum(sum); if (F.lane == 0) rl[hq] = 1.f / (sum + __builtin_amdgcn_exp2f(sk2 - mx)); }
    __syncthreads();
    { const int hq = F.tid >> 6, d = F.tid & 63, hk = hq >> 2; float a = 0.f; const float* vc = cv + (2 * hf + hk) * 64 + d;
#pragma unroll 16
        for (int j = 0; j < 128; ++j) a += sc[hq * 132 + j] * vc[(size_t)j * 256];
        a += sc[hq * 132 + 128] * vn[hk * 64 + d];
        ((bf16*)(F.ws + WS_CAT))[(size_t)m * D + 512 * hf + F.tid] = (bf16)f2bf(a * rl[hq]); }
    __syncthreads();
}

constexpr int PL_STRIDE = 272;
__device__ __forceinline__ void pool_unit(const Frame& F, int l, int rt, int gi) {
    LAS unsigned char* dT = F.lds; LAS unsigned char* Wt = F.lds + 128 * PL_STRIDE;
    const float* U = (const float*)(F.ws + WS_U); const int w = 2 << gi, m0 = rt * 128;
    { const bf16* pw = (const bf16*)wl(F, l, WL_PW) + (size_t)gi * 128 * 128;
      for (int ch = F.tid; ch < 2048; ch += NTHR) { const int e = ch >> 4, cc = ch & 15; *(LAS u32x4*)(Wt + e * PL_STRIDE + cc * 16) = *(const u32x4*)(pw + e * 128 + cc * 8); } }
    { const int c = F.tid & 127, strip = F.tid >> 7, col = gi * 128 + c;
      if (rt < 64) { const int t0 = (m0 & (SEQ - 1)) + 32 * strip; const float* up = U + (size_t)(m0 + 32 * strip) * 512 + col;
          float uv[47];
#pragma unroll
          for (int j = 0; j < 47; ++j) { const int t = t0 - 15 + j; uv[j] = t >= 0 ? up[(ptrdiff_t)(j - 15) * 512] : 0.f; }
          LAS unsigned short* dp = (LAS unsigned short*)(dT + (32 * strip) * PL_STRIDE) + c;
#define POOL_D(W) { float sum = 0.f; _Pragma("unroll") for (int j = 1; j < W; ++j) sum += uv[15 - j]; \
              _Pragma("unroll") for (int k = 0; k < 32; ++k) { const int t = t0 + k; sum += uv[15 + k]; const float cnt = (float)(t + 1 < W ? t + 1 : W); \
                  dp[k * (PL_STRIDE / 2)] = (unsigned short)f2bf(sum / cnt - uv[15 + k]); sum -= uv[15 + k - W + 1]; } }
          if (gi == 0) POOL_D(2) else if (gi == 1) POOL_D(4) else if (gi == 2) POOL_D(8) else POOL_D(16)
#undef POOL_D
      }
      else { const float* sp = INP(6) + (size_t)l * NS * 15 * 512;
#pragma unroll 4
          for (int k = 0; k < 32; ++k) { const int s_ = 32 * strip + k; const float uc = U[(size_t)(MP + s_) * 512 + col]; float hv[15];
#pragma unroll
              for (int j = 1; j < 16; ++j) hv[j - 1] = sp[((size_t)s_ * 15 + 15 - j) * 512 + col];
              float sum = uc;
#pragma unroll
              for (int j = 1; j < 16; ++j) sum += j < w ? hv[j - 1] : 0.f;
              ((LAS unsigned short*)(dT + s_ * PL_STRIDE))[c] = (unsigned short)f2bf(sum / (float)w - uc); } } }
    __syncthreads();
    const int g = F.lane >> 4, c16 = F.lane & 15;
    f32x4 acc[8];
#pragma unroll
    for (int et = 0; et < 8; ++et) acc[et] = (f32x4){0.f, 0.f, 0.f, 0.f};
#pragma unroll
    for (int ks = 0; ks < 4; ++ks) { const bf16x8 df = *(LAS const bf16x8*)(dT + (16 * F.wave + c16) * PL_STRIDE + (32 * ks + 8 * g) * 2);
#pragma unroll
        for (int et = 0; et < 8; ++et) { const bf16x8 wf = *(LAS const bf16x8*)(Wt + (16 * et + c16) * PL_STRIDE + (32 * ks + 8 * g) * 2); acc[et] = MFMA16(wf, df, acc[et]); } }
    const int m = m0 + 16 * F.wave + c16; const float* psc = INP(17) + l * 512 + gi * 128;
    if (m < M) { bf16* op = (bf16*)(F.ws + WS_CAT) + (size_t)m * D + 1024 + gi * 128 + 4 * g;
#pragma unroll
        for (int et = 0; et < 8; ++et) { const f32x4 v = acc[et] * *(const f32x4*)(psc + 16 * et + 4 * g); u32x2 wv; wv.x = cvt_pk_bf16(v.x, v.y); wv.y = cvt_pk_bf16(v.z, v.w); *(u32x2*)(op + 16 * et) = wv; } }
    __syncthreads();
}
__device__ __forceinline__ void state_outs(const Frame& F, int l) {
    const int gt = F.bid * NTHR + F.tid, ngt = F.G * NTHR; const float* U = (const float*)(F.ws + WS_U); const float* PR = (const float*)(F.ws + WS_PR);
    for (int i = gt; i < NB * 15 * 512; i += ngt) { const int b = i / (15 * 512), j = (i >> 9) % 15, c = i & 511; F.out[O_PP + (size_t)l * NB * 15 * 512 + i] = U[((size_t)b * SEQ + SEQ - 15 + j) * 512 + c]; }
    const float* sp = INP(6) + (size_t)l * NS * 15 * 512;
    for (int i = gt; i < NS * 15 * 512; i += ngt) { const int s_ = i / (15 * 512), j = (i >> 9) % 15, c = i & 511; F.out[O_PS + (size_t)l * NS * 15 * 512 + i] = j < 14 ? sp[i + 512] : U[(size_t)(MP + s_) * 512 + c]; }
    for (int i = gt; i < NB * RP; i += ngt) { const int b = i / RP, c = i - b * RP; F.out[O_SP + (size_t)l * NB * RP + i] = PR[((size_t)b * SEQ + SEQ - 1) * 2048 + c]; }
    for (int i = gt; i < NS * RP; i += ngt) { const int s_ = i / RP, c = i - s_ * RP; F.out[O_SS + (size_t)l * NS * RP + i] = PR[(size_t)(MP + s_) * 2048 + c]; }
}

template <int CTRL> __device__ __forceinline__ float dpp_f(float x) { return __builtin_bit_cast(float, __builtin_amdgcn_mov_dpp(__builtin_bit_cast(int, x), CTRL, 0xf, 0xf, true)); }
__device__ __forceinline__ float row16_sum(float x) {
    x += dpp_f<0xB1>(x); x += dpp_f<0x4E>(x); x += dpp_f<0x141>(x); x += dpp_f<0x128>(x); return x;
}
constexpr int RA_STRIDE = 1936;
constexpr int R_T1OFF = 32 * RA_STRIDE, RT_STRIDE = 80;
struct XmRow { const float* p; const float* pv; float pz; };
__device__ __forceinline__ XmRow xm_row(const float* PR, const float* sshift, int m) {
    XmRow r; r.p = PR + (size_t)m * 2048; const bool first = m < MP && (m & (SEQ - 1)) == 0;
    r.pv = m >= MP ? sshift + (size_t)(m - MP) * RP : first ? r.p : r.p - 2048; r.pz = first ? 0.f : 1.f; return r;
}
__device__ __forceinline__ float xm_at(const XmRow& r, const float* mu, int c) { const float p = r.p[c]; return p + (r.pv[c] * r.pz - p) * mu[c]; }
__device__ __forceinline__ f32x4 xm4_at(const XmRow& r, const float* mu, int c) { const f32x4 p = *(const f32x4*)(r.p + c); return p + (*(const f32x4*)(r.pv + c) * r.pz - p) * *(const f32x4*)(mu + c); }
template <int KS> __device__ __forceinline__ void lora_mm(f32x4 (&acc)[4], const bf16* Wt, int ldw, int nbase, LAS const unsigned char* Arow, int acol, int g, int c16) {
#pragma unroll
    for (int nt = 0; nt < 4; ++nt) acc[nt] = (f32x4){0.f, 0.f, 0.f, 0.f};
#pragma unroll
    for (int ks = 0; ks < KS; ++ks) { const bf16x8 af = *(LAS const bf16x8*)(Arow + (acol + 32 * ks + 8 * g) * 2);
#pragma unroll
        for (int nt = 0; nt < 4; ++nt) { const bf16x8 wf = *(const bf16x8*)(Wt + (size_t)(nbase + 16 * nt + c16) * ldw + 32 * ks + 8 * g); acc[nt] = MFMA16(wf, af, acc[nt]); } }
}
__device__ __forceinline__ float frcp(float x) { return __builtin_amdgcn_rcpf(x); }
__device__ __forceinline__ f32x4 fsig4(f32x4 v) { f32x4 r; r.x = frcp(1.f + __expf(-v.x)); r.y = frcp(1.f + __expf(-v.y)); r.z = frcp(1.f + __expf(-v.z)); r.w = frcp(1.f + __expf(-v.w)); return r; }
__device__ __forceinline__ void rwkv_prep_unit(const Frame& F, int l, int ti) {
    int tid_l = F.tid; asm volatile("" : "+v"(tid_l)); const int lane_l = tid_l & 63;
    LAS unsigned char* Aop = F.lds; LAS unsigned char* T1 = F.lds + R_T1OFF;
    const float* PR = (const float*)(F.ws + WS_PR); const float* sshift = INP(7) + (size_t)l * NS * RP; const float* mu = INP(19) + l * RP;
    const int m0 = ti * 32; const bool vres = l > 0;
    TSB2(70, F.lds);
#pragma unroll
    for (int q0 = 0; q0 < 8; q0 += 4) { f32x4 xv[4];
#pragma unroll
        for (int q = 0; q < 4; ++q) if (q0 + q < 7) { const int i = tid_l + (q0 + q) * NTHR, r = i / 112, c4 = i - r * 112; const XmRow xr = xm_row(PR, sshift, m0 + r); xv[q] = xm4_at(xr, mu, 1536 + 4 * c4); }
#pragma unroll
        for (int q = 0; q < 4; ++q) if (q0 + q < 7) { const int i = tid_l + (q0 + q) * NTHR, r = i / 112, c4 = i - r * 112, c = 4 * c4; f32x4 y = xv[q];
            if (c < 96) { y.x = 1.f - 2.f * frcp(1.f + __expf(2.f * y.x)); y.y = 1.f - 2.f * frcp(1.f + __expf(2.f * y.y)); y.z = 1.f - 2.f * frcp(1.f + __expf(2.f * y.z)); y.w = 1.f - 2.f * frcp(1.f + __expf(2.f * y.w)); }
            else if (c >= 192) y = fsig4(y);
            u32x2 w; w.x = cvt_pk_bf16(y.x, y.y); w.y = cvt_pk_bf16(y.z, y.w); *(LAS u32x2*)(Aop + r * RA_STRIDE + c * 2) = w; }
        asm volatile("" ::: "memory"); __builtin_amdgcn_sched_barrier(0); }
    if (vres) {
#pragma unroll
        for (int q0 = 0; q0 < 8; q0 += 4) { f32x4 xv[4];
#pragma unroll
            for (int q = 0; q < 4; ++q) { const int i = tid_l + (q0 + q) * NTHR, r = i >> 7, c4 = i & 127; const XmRow xr = xm_row(PR, sshift, m0 + r); xv[q] = xm4_at(xr, mu, 1024 + 4 * c4); }
#pragma unroll
            for (int q = 0; q < 4; ++q) { const int i = tid_l + (q0 + q) * NTHR, r = i >> 7, c4 = i & 127; u32x2 w; w.x = cvt_pk_bf16(xv[q].x, xv[q].y); w.y = cvt_pk_bf16(xv[q].z, xv[q].w); *(LAS u32x2*)(Aop + r * RA_STRIDE + (448 + 4 * c4) * 2) = w; }
            asm volatile("" ::: "memory"); __builtin_amdgcn_sched_barrier(0); } }
    __syncthreads();
    TSE2(70, F.lds); TSB2(71, F.lds);
    const int g = lane_l >> 4, c16 = lane_l & 15, nb = 64 * F.wave;
    if (vres) {
        if (F.wave < 4) { const int mt = F.wave >> 1, nt = F.wave & 1; f32x4 a = (f32x4){0.f, 0.f, 0.f, 0.f}; const bf16* w1 = (const bf16*)wl(F, 1, WL_V1) + (size_t)(16 * nt + c16) * 512 + 8 * g;
#pragma unroll
            for (int kh = 0; kh < 2; ++kh) { bf16x8 wf[8];
#pragma unroll
                for (int ks = 0; ks < 8; ++ks) wf[ks] = *(const bf16x8*)(w1 + 32 * (8 * kh + ks));
#pragma unroll
                for (int ks = 0; ks < 8; ++ks) { const bf16x8 af = *(LAS const bf16x8*)(Aop + (16 * mt + c16) * RA_STRIDE + (448 + 32 * (8 * kh + ks) + 8 * g) * 2); a = MFMA16(wf[ks], af, a); }
                asm volatile("" ::: "memory"); __builtin_amdgcn_sched_barrier(0); }
            u32x2 wv; wv.x = cvt_pk_bf16(a.x, a.y); wv.y = cvt_pk_bf16(a.z, a.w); *(LAS u32x2*)(T1 + (16 * mt + c16) * RT_STRIDE + (16 * nt + 4 * g) * 2) = wv;
#if MK_DEBUG
            *(f32x4*)((float*)(F.ws + WS_H) + (size_t)(m0 + 16 * mt + c16) * 32 + 16 * nt + 4 * g) = a;
#endif
            }
        __syncthreads();
    }
    LAS unsigned char* Aimg = F.lds + 65536; LAS unsigned char* Limg = F.lds + 65536 + 32768;
    size_t ro[2]; int mrow[2];
#pragma unroll
    for (int mt = 0; mt < 2; ++mt) { int m = m0 + 16 * mt + c16; asm volatile("" : "+v"(m)); mrow[mt] = m; ro[mt] = (size_t)m * 512 + nb + 4 * g; }
    TSE2(71, F.lds); TSB2(72, F.lds);
#define LORA_PASS(WT, LDW, ACOL, KS0, NKS, ACC) do { bf16x8 wq_[NKS][4]; const bf16* pw_ = (const bf16*)(WT) + (size_t)(nb + c16) * (LDW) + 8 * g + 32 * (KS0); \
        _Pragma("unroll") for (int ks = 0; ks < NKS; ++ks) _Pragma("unroll") for (int nt = 0; nt < 4; ++nt) wq_[ks][nt] = *(const bf16x8*)(pw_ + (size_t)16 * nt * (LDW) + 32 * ks); \
        _Pragma("unroll") for (int mt = 0; mt < 2; ++mt) { LAS const unsigned char* Arow_ = Aop + (16 * mt + c16) * RA_STRIDE + ((ACOL) + 32 * (KS0) + 8 * g) * 2; \
            _Pragma("unroll") for (int ks = 0; ks < NKS; ++ks) { const bf16x8 af_ = *(LAS const bf16x8*)(Arow_ + 64 * ks); \
                _Pragma("unroll") for (int nt = 0; nt < 4; ++nt) ACC[mt][nt] = MFMA16(wq_[ks][nt], af_, ACC[mt][nt]); } } \
        asm volatile("" ::: "memory"); __builtin_amdgcn_sched_barrier(0); } while (0)
#define LORA_ZERO(ACC) do { _Pragma("unroll") for (int mt = 0; mt < 2; ++mt) _Pragma("unroll") for (int nt = 0; nt < 4; ++nt) ACC[mt][nt] = (f32x4){0.f, 0.f, 0.f, 0.f}; } while (0)
    {
        const float* a0p = INP(22) + l * 512; f32x4 acc[2][4]; LORA_ZERO(acc); LORA_PASS(wl(F, l, WL_A2), 96, 96, 0, 2, acc); LORA_PASS(wl(F, l, WL_A2), 96, 96, 2, 1, acc);
#pragma unroll
        for (int mt = 0; mt < 2; ++mt)
#pragma unroll
            for (int nt = 0; nt < 4; ++nt) { const f32x4 a = fsig4(acc[mt][nt] + *(const f32x4*)(a0p + nb + 16 * nt + 4 * g)); u32x2 w; w.x = cvt_pk_bf16(a.x, a.y); w.y = cvt_pk_bf16(a.z, a.w);
                *(LAS u32x2*)(Aimg + ((16 * mt + c16) * 512 + nb + 16 * nt + 4 * g) * 2) = w; } }
    {
        const float* w0p = INP(20) + l * 512; float* Wb = rwbuf(F, RW_W); f32x4 acc[2][4]; LORA_ZERO(acc); LORA_PASS(wl(F, l, WL_W2), 96, 0, 0, 2, acc); LORA_PASS(wl(F, l, WL_W2), 96, 0, 2, 1, acc);
#pragma unroll
        for (int mt = 0; mt < 2; ++mt)
#pragma unroll
            for (int nt = 0; nt < 4; ++nt) { const f32x4 z = acc[mt][nt] + *(const f32x4*)(w0p + nb + 16 * nt + 4 * g); f32x4 dec;
#pragma unroll
                for (int e = 0; e < 4; ++e) { const float zz = -z[e]; const float sp = fmaxf(zz, 0.f) + __logf(1.f + __expf(-fabsf(zz))); dec[e] = __expf(-__expf(-sp - 0.5f)); }
                *(f32x4*)(Wb + ro[mt] + 16 * nt) = dec; } }
    {
        float* Gb = rwbuf(F, RW_G); f32x4 acc[2][4]; LORA_ZERO(acc); LORA_PASS(wl(F, l, WL_G2), 256, 192, 0, 2, acc); LORA_PASS(wl(F, l, WL_G2), 256, 192, 2, 2, acc); LORA_PASS(wl(F, l, WL_G2), 256, 192, 4, 2, acc); LORA_PASS(wl(F, l, WL_G2), 256, 192, 6, 2, acc);
#pragma unroll
        for (int mt = 0; mt < 2; ++mt)
#pragma unroll
            for (int nt = 0; nt < 4; ++nt) *(f32x4*)(Gb + ro[mt] + 16 * nt) = acc[mt][nt]; }
#undef LORA_PASS
#undef LORA_ZERO
    TSE2(72, F.lds); TSB2(73, F.lds);
    if (vres) {
#pragma unroll
        for (int mt = 0; mt < 2; ++mt) { const bf16x8 tf = *(LAS const bf16x8*)(T1 + (16 * mt + c16) * RT_STRIDE + (8 * g) * 2); const f32x4 z4 = (f32x4){0.f, 0.f, 0.f, 0.f};
#pragma unroll
            for (int nt = 0; nt < 4; ++nt) { const bf16x8 wf = *(const bf16x8*)((const bf16*)wl(F, 1, WL_V2) + (size_t)(nb + 16 * nt + c16) * 32 + 8 * g); const f32x4 lv = MFMA16(wf, tf, z4);
                u32x2 w; w.x = cvt_pk_bf16(lv.x, lv.y); w.y = cvt_pk_bf16(lv.z, lv.w); *(LAS u32x2*)(Limg + ((16 * mt + c16) * 512 + nb + 16 * nt + 4 * g) * 2) = w;
#if MK_DEBUG
                *(f32x4*)(rwbuf(F, RW_Y) + ro[mt] + 16 * nt) = lv;
#endif
            } } }
    __syncthreads();
    {   const float* vbp = INP(33); const float* kkp = INP(25) + l * 512; const float* kap = INP(26) + l * 512;
        float* Rb = rwbuf(F, RW_R); float* Kb = rwbuf(F, RW_K); float* Vb = rwbuf(F, RW_V); float* Ab = rwbuf(F, RW_A); float* Bb = rwbuf(F, RW_B); float* VF = rwbuf(F, RW_VF);
        const int r = tid_l >> 4, j16 = tid_l & 15; int m = m0 + r; asm volatile("" : "+v"(m)); const XmRow xr = xm_row(PR, sshift, m);
#pragma unroll 4
        for (int h = 0; h < 8; ++h) { const int n = 64 * h + 4 * j16; const size_t o = (size_t)m * 512 + n;
            const f32x4 rx = xm4_at(xr, mu, n), k = xm4_at(xr, mu, 512 + n); f32x4 v = xm4_at(xr, mu, 1024 + n);
            const u32x2 aw = *(LAS const u32x2*)(Aimg + (r * 512 + n) * 2); f32x4 a; a.x = bflo(aw.x); a.y = bfhi(aw.x); a.z = bflo(aw.y); a.w = bfhi(aw.y);
            const f32x4 kk = k * *(const f32x4*)(kkp + n);
            const float ss = row16_sum((kk.x * kk.x + kk.y * kk.y) + (kk.z * kk.z + kk.w * kk.w)), rn = 1.f / fmaxf(sqrtf(ss), 1e-12f);
            *(f32x4*)(Rb + o) = rx;
            *(f32x4*)(Kb + o) = k * ((a - 1.f) * *(const f32x4*)(kap + n) + 1.f);
            if (!vres) *(f32x4*)(VF + o) = v;
            else { const u32x2 lw = *(LAS const u32x2*)(Limg + (r * 512 + n) * 2); f32x4 lv; lv.x = bflo(lw.x); lv.y = bfhi(lw.x); lv.z = bflo(lw.y); lv.w = bfhi(lw.y);
                const f32x4 vf = *(const f32x4*)(VF + o); v = v + (vf - v) * fsig4(lv + *(const f32x4*)(vbp + n)); }
            *(f32x4*)(Vb + o) = v;
            const f32x4 kn = kk * rn; *(f32x4*)(Ab + o) = -kn; *(f32x4*)(Bb + o) = kn * a; } }
    TSE2(73, F.lds);
    __syncthreads();
}

constexpr int SC_T = 32, SC_ARR = SC_T * 64 * 4, SC_BUF = 5 * SC_ARR + SC_T * 16 * 4, SC_NSLOT = 3;
static_assert(SC_NSLOT * SC_BUF <= 131072, "scan ring fits the phase LDS");
__device__ __forceinline__ float wave_sum64(float x) { x = row16_sum(x); x += __shfl_xor(x, 16); x += __shfl_xor(x, 32); return x; }
__device__ __forceinline__ void scan_prompt_unit(const Frame& F, int l, int b, int h, int qt) {
    const size_t rowb = (size_t)b * SEQ;
    constexpr int NCH = SEQ / SC_T;
    if (F.wave >= 4) {
        const float* src0 = rwbuf(F, RW_W); const float* src1 = rwbuf(F, RW_A); const float* src2 = rwbuf(F, RW_B); const float* src3 = rwbuf(F, RW_K); const float* src4 = rwbuf(F, RW_R); const float* Vb = rwbuf(F, RW_V);
        const int lt = F.tid - 256, lw = F.wave - 4;
        const size_t g0 = (rowb + (lt >> 4)) * 512 + h * 64 + 4 * (lt & 15), g1 = g0 + (size_t)16 * 512;
        const size_t gv0 = (rowb + (lt & 31)) * 512 + h * 64 + qt * 16 + (lt >> 5), gv1 = gv0 + 8;
        const unsigned l0 = (unsigned)lw * 1024u, l1 = l0 + 4096u;
#define SC_GL(src, goff, slot, arr, loff) __builtin_amdgcn_global_load_lds((const unsigned*)((src) + (goff)), (LAS unsigned*)(F.lds + (slot) * SC_BUF + (arr) * SC_ARR + (loff)), 16, 0, 0)
#define SC_STAGE(ch_, slot_) do { const size_t co_ = (size_t)(ch_) * SC_T * 512; \
            SC_GL(src0, g0 + co_, slot_, 0, l0); SC_GL(src0, g1 + co_, slot_, 0, l1); SC_GL(src1, g0 + co_, slot_, 1, l0); SC_GL(src1, g1 + co_, slot_, 1, l1); SC_GL(src2, g0 + co_, slot_, 2, l0); SC_GL(src2, g1 + co_, slot_, 2, l1); \
            SC_GL(src3, g0 + co_, slot_, 3, l0); SC_GL(src3, g1 + co_, slot_, 3, l1); SC_GL(src4, g0 + co_, slot_, 4, l0); SC_GL(src4, g1 + co_, slot_, 4, l1); \
            __builtin_amdgcn_global_load_lds((const unsigned*)(Vb + gv0 + co_), (LAS unsigned*)(F.lds + (slot_) * SC_BUF + 5 * SC_ARR + lw * 256), 4, 0, 0); \
            __builtin_amdgcn_global_load_lds((const unsigned*)(Vb + gv1 + co_), (LAS unsigned*)(F.lds + (slot_) * SC_BUF + 5 * SC_ARR + 1024 + lw * 256), 4, 0, 0); } while (0)
        SC_STAGE(0, 0); SC_STAGE(1, 1);
        asm volatile("s_waitcnt vmcnt(12)" ::: "memory");
        __builtin_amdgcn_s_barrier();
        int slot = 2;
        for (int ch = 0; ch < NCH; ++ch) {
            if (ch + 2 < NCH) { SC_STAGE(ch + 2, slot);
                asm volatile("s_waitcnt vmcnt(12)" ::: "memory"); }
            else asm volatile("s_waitcnt vmcnt(0)" ::: "memory");
            __builtin_amdgcn_s_barrier();
            slot = slot == 2 ? 0 : slot + 1;
        }
#undef SC_GL
#undef SC_STAGE
    } else {
        float* Yb = rwbuf(F, RW_Y);
        const int rg = F.lane >> 4, j4 = F.lane & 15, rloc = F.wave * 4 + rg;
        f32x4 s = (f32x4){0.f, 0.f, 0.f, 0.f}; float yk = 0.f, ypart = 0.f;
        float* yp = Yb + (rowb + j4) * 512 + h * 64 + qt * 16 + rloc;
        __builtin_amdgcn_s_barrier(); asm volatile("" ::: "memory");
        int slot = 0;
        for (int ch = 0; ch < NCH; ++ch) {
            LAS const unsigned char* bp = F.lds + slot * SC_BUF + j4 * 16; LAS const f32x4* vp = (LAS const f32x4*)(F.lds + slot * SC_BUF + 5 * SC_ARR + rloc * 128);
            f32x4 w = *(LAS const f32x4*)(bp + 0 * SC_ARR), a = *(LAS const f32x4*)(bp + 1 * SC_ARR), bb = *(LAS const f32x4*)(bp + 2 * SC_ARR), k = *(LAS const f32x4*)(bp + 3 * SC_ARR), r = *(LAS const f32x4*)(bp + 4 * SC_ARR);
            f32x4 vq = vp[0];
#pragma unroll
            for (int tt = 0; tt < SC_T; ++tt) {
                const float v = vq[tt & 3];
                const f32x4 p = s * w + k * v;
                __builtin_amdgcn_sched_barrier(0);
                f32x4 wn = w, an = a, bn = bb, kn = k, rn = r, vqn = vq;
                if (tt + 1 < SC_T) { wn = *(LAS const f32x4*)(bp + 0 * SC_ARR + (tt + 1) * 256); an = *(LAS const f32x4*)(bp + 1 * SC_ARR + (tt + 1) * 256); bn = *(LAS const f32x4*)(bp + 2 * SC_ARR + (tt + 1) * 256);
                    kn = *(LAS const f32x4*)(bp + 3 * SC_ARR + (tt + 1) * 256); rn = *(LAS const f32x4*)(bp + 4 * SC_ARR + (tt + 1) * 256); if ((tt & 3) == 3) vqn = vp[(tt + 1) >> 2]; }
                __builtin_amdgcn_sched_barrier(0);
                const float yprev = row16_sum(ypart);
                const float sa = row16_sum(fmaf(s.w, a.w, fmaf(s.z, a.z, fmaf(s.y, a.y, s.x * a.x))));
                s = bb * sa + p;
                ypart = fmaf(s.w, r.w, fmaf(s.z, r.z, fmaf(s.y, r.y, s.x * r.x)));
                if (tt > 0) { yk = (j4 == ((tt - 1) & 15)) ? yprev : yk; if (((tt - 1) & 15) == 15) yp[(size_t)(ch * SC_T + ((tt - 1) & ~15)) * 512] = yk; }
                else if (ch > 0) { yk = (j4 == 15) ? yprev : yk; yp[(size_t)((ch - 1) * SC_T + 16) * 512] = yk; }
                w = wn; a = an; bb = bn; k = kn; r = rn; vq = vqn;
            }
            __builtin_amdgcn_s_barrier(); asm volatile("" ::: "memory");
            slot = slot == 2 ? 0 : slot + 1;
        }
        { const float ylast = row16_sum(ypart); yk = (j4 == 15) ? ylast : yk; yp[(size_t)((NCH - 1) * SC_T + 16) * 512] = yk; }
        *(f32x4*)(F.out + O_WP + ((((size_t)l * NB + b) * 8 + h) * 64 + qt * 16 + rloc) * 64 + 4 * j4) = s;
    }
    __syncthreads();
}
__device__ __forceinline__ void scan_sample_wave(const Frame& F, int l, int s_, int h) {
    const size_t m = MP + s_; const int rg = F.lane >> 4, j4 = F.lane & 15; const size_t o = m * 512 + h * 64 + 4 * j4;
    const f32x4 w = *(const f32x4*)(rwbuf(F, RW_W) + o), a = *(const f32x4*)(rwbuf(F, RW_A) + o), bb = *(const f32x4*)(rwbuf(F, RW_B) + o), k = *(const f32x4*)(rwbuf(F, RW_K) + o), r = *(const f32x4*)(rwbuf(F, RW_R) + o);
    const float* S0 = INP(8) + (((size_t)l * NS + s_) * 8 + h) * 4096; float* S1 = F.out + O_WS + (((size_t)l * NS + s_) * 8 + h) * 4096;
    const int row = 4 * j4 + rg; const size_t orow = m * 512 + h * 64 + row;
    const float v_my = rwbuf(F, RW_V)[orow], g_my = rwbuf(F, RW_G)[orow], rk_r = INP(27)[l * 512 + h * 64 + row], lg_r = INP(28)[l * 512 + h * 64 + row], lb_r = INP(29)[l * 512 + h * 64 + row];
    const f32x4 rk4 = *(const f32x4*)(INP(27) + l * 512 + h * 64 + 4 * j4);
    (void)rk_r;
    float yk = 0.f;
#pragma unroll 4
    for (int i0 = 0; i0 < 16; ++i0) { const int i = 4 * i0 + rg; f32x4 s = *(const f32x4*)(S0 + i * 64 + 4 * j4); const float v = rwbuf(F, RW_V)[m * 512 + h * 64 + i];
        const float sa = row16_sum((s.x * a.x + s.y * a.y) + (s.z * a.z + s.w * a.w));
        s = s * w + bb * sa + k * v;
        const float y = row16_sum((s.x * r.x + s.y * r.y) + (s.z * r.z + s.w * r.w));
        *(f32x4*)(S1 + i * 64 + 4 * j4) = s; yk = (j4 == i0) ? y : yk; }
    const float bon = row16_sum((r.x * k.x * rk4.x + r.y * k.y * rk4.y) + (r.z * k.z * rk4.z + r.w * k.w * rk4.w));
    const float mu = wave_sum64(yk) * (1.f / 64.f), dv = yk - mu, var = wave_sum64(dv * dv) * (1.f / 64.f);
    ((bf16*)(F.ws + WS_CAT))[m * D + 1536 + h * 64 + row] = (bf16)f2bf((dv * rsqrtf(var + 64e-5f) * lg_r + lb_r + bon * v_my) * g_my);
#if MK_DEBUG
    rwbuf(F, RW_Y)[orow] = yk;
#endif
}
__device__ __forceinline__ void rwkv_post_phase(const Frame& F, int l) {
    const int gw = F.bid * NWAVES + F.wave, NGW = F.G * NWAVES; const float* rkp = INP(27) + l * 512; const float* lgp = INP(28) + l * 512; const float* lbp = INP(29) + l * 512;
    const float* Yb = rwbuf(F, RW_Y); const float* Rb = rwbuf(F, RW_R); const float* Kb = rwbuf(F, RW_K); const float* Vb = rwbuf(F, RW_V); const float* Gb = rwbuf(F, RW_G);
    for (int it0 = gw * 4; it0 < MP * 8; it0 += NGW * 4) {
        float y[4], r[4], k[4], v[4], g[4];
#pragma unroll
        for (int q = 0; q < 4; ++q) { const int it = it0 + q, m = it >> 3, h = it & 7; const size_t o = (size_t)m * 512 + h * 64 + F.lane; y[q] = Yb[o]; r[q] = Rb[o]; k[q] = Kb[o]; v[q] = Vb[o]; g[q] = Gb[o]; }
#pragma unroll
        for (int q = 0; q < 4; ++q) { const int it = it0 + q, m = it >> 3, h = it & 7, c = h * 64 + F.lane;
            const float mu = wave_sum64(y[q]) * (1.f / 64.f), dv = y[q] - mu, var = wave_sum64(dv * dv) * (1.f / 64.f), bon = wave_sum64(r[q] * k[q] * rkp[c]);
            ((bf16*)(F.ws + WS_CAT))[(size_t)m * D + 1536 + c] = (bf16)f2bf((dv * rsqrtf(var + 64e-5f) * lgp[c] + lbp[c] + bon * v[q]) * g[q]); }
    }
}
}
namespace mk {
namespace cg = cooperative_groups;
constexpr int LDS_BYTES = 135168;
constexpr int TS_OFF = LDS_BYTES - 64;
#ifdef MK_TS_ID
#ifndef MK_TS_BLOCK
#define MK_TS_BLOCK 0
#endif
#ifndef MK_TS_AMP
#define MK_TS_AMP 8
#endif
#define TSB(id, ldsp) do { if ((id) == MK_TS_ID && blockIdx.x == MK_TS_BLOCK && threadIdx.x == 0) *(volatile LAS unsigned*)((ldsp) + TS_OFF) -= (unsigned)__builtin_amdgcn_s_memrealtime(); } while (0)
#define TSE(id, ldsp) do { if ((id) == MK_TS_ID && blockIdx.x == MK_TS_BLOCK && threadIdx.x == 0) *(volatile LAS unsigned*)((ldsp) + TS_OFF) += (unsigned)__builtin_amdgcn_s_memrealtime(); } while (0)
#else
#define TSB(id, ldsp) do {} while (0)
#define TSE(id, ldsp) do {} while (0)
#endif
constexpr int PH_PRO = 0, PH_ADA = 1, PH_L0 = 2, PH_PER_L = 10, PH_FINAL = PH_L0 + NL * PH_PER_L, N_PHASES = PH_FINAL + 1;
enum { LP_NORM1 = 0, LP_IN, LP_MIX, LP_SCAN, LP_POST, LP_MG, LP_WO, LP_NORM2, LP_GU, LP_DN };

__device__ __forceinline__ void mix_phase(const Frame& F, int l) {
    TSB(40, F.lds);
    for (int u = F.bid; u < 256; u += F.G) rwkv_prep_unit(F, l, u);
    TSE(40, F.lds);
    TSB(44, F.lds); state_outs(F, l); TSE(44, F.lds);
}
constexpr int SCAN_BLOCKS = 64;
constexpr int GL_PM_SPLIT = 10;
__device__ __forceinline__ void scan_phase(const Frame& F, int l) {
    if (F.bid < SCAN_BLOCKS) scan_prompt_unit(F, l, F.bid >> 5, (F.bid >> 2) & 7, F.bid & 3);
    else { const int nb_ = F.G - SCAN_BLOCKS, wb = F.bid - SCAN_BLOCKS; const int nw = nb_ * NWAVES; unsigned* ctl = (unsigned*)(F.ws + WS_CTL) + 64 * l;
        if (wb < 4) { rwkv_prep_unit(F, l, 256 + wb); asm volatile("s_waitcnt vmcnt(0)" ::: "memory"); __syncthreads();
            if (F.tid == 0) { __builtin_amdgcn_fence(__ATOMIC_RELEASE, "agent"); asm volatile("s_waitcnt vmcnt(0)" ::: "memory"); __hip_atomic_fetch_add(ctl, 1u, __ATOMIC_RELAXED, __HIP_MEMORY_SCOPE_AGENT); } }
        TSB(41, F.lds);
        for (int a = wb; a < 256; a += nb_) attn_prompt_unit(F, l, a >> 7, (a >> 2) & 31, a & 3);
        TSE(41, F.lds); TSB(42, F.lds);
        for (int p = (wb + 64) % nb_; p < 260; p += nb_) pool_unit(F, l, p >> 2, p & 3);
        TSE(42, F.lds); TSB(43, F.lds);
        for (int s_ = (wb + 132) % nb_; s_ < 2 * NS; s_ += nb_) attn_sample_unit(F, l, s_ >> 1, s_ & 1);
        TSE(43, F.lds);
        __syncthreads();
        Gemm g; g.layer = l; g.ld = D; g.M = MPAD; g.K = D; g.N = NIN; g.A = (const bf16*)(F.ws + WS_H); g.Bt = (const bf16*)wl(F, l, WL_IN); g.mode = G_IN;
        Sched S; S.init(Rect{GL_PM_SPLIT, MPAD / BM - GL_PM_SPLIT, 16, 24}, Rect{0, 0, 0, 0}, F.G - SCAN_BLOCKS, F.bid - SCAN_BLOCKS, 1); Epi E; E.F = &F; E.mode = G_IN; E.layer = l;
        TSB(45, F.lds); gemm_phase(F.lds, g, S, E, F.tid); TSE(45, F.lds);
        if (l == 0) { TSB(46, F.lds); p0_prologue(F, 2, false, wb, nb_, 0); TSE(46, F.lds); }
        if (F.tid == 0) { unsigned sp = 0; while (__hip_atomic_load(ctl, __ATOMIC_RELAXED, __HIP_MEMORY_SCOPE_AGENT) < 4u && ++sp < (1u << 26)) __builtin_amdgcn_s_sleep(8);
            __builtin_amdgcn_fence(__ATOMIC_ACQUIRE, "agent"); asm volatile("s_waitcnt vmcnt(0)" ::: "memory"); }
        __syncthreads();
        for (int u = wb * NWAVES + F.wave; u < NS * 8; u += nw) scan_sample_wave(F, l, u >> 3, u & 7); }
}

#define XB_TMO      128
#define XB_XCNT(j)  (256  + 64 * (j))
#define XB_XSUB(j)  (1280 + 64 * (j))
#define XB_XGEN(j)  (2304 + 64 * (j))
#define XB_TOP      3328
#define XB_TOPGEN   3392
#define XCD_BAR_WORDS 3456
#define XB_SPIN_CAP (1u << 18)

__device__ __forceinline__ unsigned xb_ld(unsigned* p)              { return __hip_atomic_load(p, __ATOMIC_RELAXED, __HIP_MEMORY_SCOPE_AGENT); }
__device__ __forceinline__ unsigned xb_add(unsigned* p, unsigned v) { return __hip_atomic_fetch_add(p, v, __ATOMIC_RELAXED, __HIP_MEMORY_SCOPE_AGENT); }
__device__ __forceinline__ unsigned xb_xcc_id() { return (unsigned)__builtin_amdgcn_s_getreg((3 << 11) | 20) & 0xFu; }
#define XB_SPIN(cond, bar) do { unsigned _sp = 0; while (cond) { __builtin_amdgcn_s_sleep(1); \
    if ((++_sp & 255u) == 0u) { if (xb_ld(&(bar)[XB_TMO])) break; if (_sp > XB_SPIN_CAP) { atomicAdd(&(bar)[XB_TMO], 1u); break; } } } } while (0)

struct XcdBarrier {
    unsigned* bar; unsigned x;
    volatile LAS unsigned* st;
};

__device__ __forceinline__ XcdBarrier xcd_barrier_post(unsigned* bar, volatile LAS unsigned* st) {
    XcdBarrier b; b.bar = bar; b.x = xb_xcc_id(); b.st = st;
    if (threadIdx.x == 0) (void)xb_add(&bar[XB_XCNT(b.x)], 1u);
    return b;
}
__device__ __forceinline__ void xcd_barrier_complete(unsigned* bar, unsigned x, unsigned& nloc, unsigned& nx) {
    const unsigned G = gridDim.x * gridDim.y * gridDim.z;
    unsigned sum, cnt, mine, sp = 0u;
    for (;;) {
        sum = 0u; cnt = 0u; mine = 0u;
#pragma unroll
        for (unsigned j = 0; j < 16; ++j) { const unsigned c = xb_ld(&bar[XB_XCNT(j)]); sum += c; cnt += (c > 0u) ? 1u : 0u; mine = (j == x) ? c : mine; }
        if (sum == G) break;
        __builtin_amdgcn_s_sleep(1);
        if ((++sp & 255u) == 0u) { if (xb_ld(&bar[XB_TMO])) break; if (sp > XB_SPIN_CAP) { atomicAdd(&bar[XB_TMO], 1u); break; } }
    }
    nloc = mine > 0u ? mine : 1u; nx = cnt > 0u ? cnt : 1u;
}

__device__ __forceinline__ void xcd_barrier(const XcdBarrier& b) {
    asm volatile("s_waitcnt vmcnt(0)" ::: "memory");
    __syncthreads();
    if (threadIdx.x == 0) {
        unsigned* bar = b.bar;
        __builtin_amdgcn_s_waitcnt(0);
        unsigned nloc = b.st[0], nx = b.st[1];
        if (nloc == 0u) { xcd_barrier_complete(bar, b.x, nloc, nx); b.st[0] = nloc; b.st[1] = nx; }
        const unsigned old = xb_add(&bar[XB_XSUB(b.x)], 1u);
        const unsigned gen = old / nloc;
        if (old + 1u == (gen + 1u) * nloc) {
            __builtin_amdgcn_fence(__ATOMIC_RELEASE, "agent");
            asm volatile("s_waitcnt vmcnt(0)" ::: "memory");
            const unsigned og = xb_add(&bar[XB_TOP], 1u);
            const unsigned tg = og / nx;
            if (og + 1u == (tg + 1u) * nx) xb_add(&bar[XB_TOPGEN], 1u);
            else XB_SPIN(xb_ld(&bar[XB_TOPGEN]) == tg, bar);
            __builtin_amdgcn_fence(__ATOMIC_ACQUIRE, "agent");
            xb_add(&bar[XB_XGEN(b.x)], 1u);
            asm volatile("s_waitcnt vmcnt(0)" ::: "memory");
        } else {
            XB_SPIN(xb_ld(&bar[XB_XGEN(b.x)]) == gen, bar);
            __builtin_amdgcn_fence(__ATOMIC_ACQUIRE, "agent");
            asm volatile("s_waitcnt vmcnt(0)" ::: "memory");
        }
    }
    __syncthreads();
}


__global__ void __launch_bounds__(NTHR, 2) __attribute__((target("no-packed-fp32-ops"))) mega(Args args) {
    extern __shared__ __attribute__((aligned(16))) unsigned char lds_raw[];
    cg::grid_group grid = cg::this_grid();
    if (threadIdx.x < 2) ((volatile LAS unsigned*)((LAS unsigned char*)lds_raw + TS_OFF - 64))[threadIdx.x] = 0u;
    __syncthreads();
    const XcdBarrier xbar = xcd_barrier_post((unsigned*)(args.ws + WS_CTL + 4096), (volatile LAS unsigned*)((LAS unsigned char*)lds_raw + TS_OFF - 64));
#ifdef MK_TS_ID
    if (threadIdx.x == 0) *(volatile LAS unsigned*)((LAS unsigned char*)lds_raw + TS_OFF) = 0u;
#endif
    for (int ph = args.ph_lo; ph < args.ph_hi; ++ph) {
        Frame F; { GAS unsigned char* ws_ = (GAS unsigned char*)args.ws; GAS float* out_ = (GAS float*)args.out; int tid_ = threadIdx.x; int bid_ = blockIdx.x; int G_ = gridDim.x;
            asm volatile("" : "+s"(ws_), "+s"(out_), "+v"(tid_), "+s"(bid_), "+s"(G_));
            F.lds = (LAS unsigned char*)lds_raw; F.tid = tid_; F.lane = tid_ & 63; F.wave = __builtin_amdgcn_readfirstlane(tid_ >> 6); F.G = G_; F.bid = bid_; F.out = (float*)out_; F.ws = (unsigned char*)ws_; }
        const int l = ph >= PH_L0 && ph < PH_FINAL ? (ph - PH_L0) / PH_PER_L : 0, lp = ph >= PH_L0 && ph < PH_FINAL ? (ph - PH_L0) % PH_PER_L : -1;
        TSB(ph == PH_PRO ? 1 : ph == PH_ADA ? 2 : ph == PH_FINAL ? 3 : 10 + lp, F.lds);
#ifndef MK_NO_PRO
        if (ph == PH_PRO) p0_prologue(F, 0, true, F.bid, F.G, 0); else
#endif
#ifndef MK_NO_NORM
        if (ph == PH_FINAL || lp == LP_NORM1 || lp == LP_NORM2) norm_phase(F, l, ph == PH_FINAL ? 2 : lp == LP_NORM1 ? 0 : 1, ph == PH_FINAL ? 11 : lp == LP_NORM2 ? 4 : (l > 0 ? 11 : 0)); else
#endif
#ifndef MK_NO_MIX
        if (lp == LP_MIX) { mix_phase(F, l);
#ifdef MK_DUP_MIX
            __syncthreads(); mix_phase(F, l);
#endif
        } else
#endif
#ifndef MK_NO_SCAN
        if (lp == LP_SCAN) { scan_phase(F, l);
#ifdef MK_DUP_SCAN
            __syncthreads(); scan_phase(F, l);
#endif
        } else
#endif
#ifndef MK_NO_POST
        if (lp == LP_POST) rwkv_post_phase(F, l); else
#endif
#ifndef MK_NO_GEMM
        {
            Gemm g; g.layer = l; g.ld = D; g.M = MPAD; g.K = D;
            if (ph == PH_ADA) { g.A = (const bf16*)(F.ws + WS_SILC); g.Bt = (const bf16*)(F.ws + WS_ADAW); g.M = 256; g.N = 2 * NADA; g.mode = G_ADA; }
            else if (lp == LP_IN) { g.A = (const bf16*)(F.ws + WS_H); g.Bt = (const bf16*)wl(F, l, WL_IN); g.N = NIN; g.mode = G_IN; }
            else if (lp == LP_MG) { g.A = (const bf16*)(F.ws + WS_CAT); g.Bt = (const bf16*)wl(F, l, WL_CAT); g.N = D; g.mode = G_MG; }
            else if (lp == LP_WO) { g.A = (const bf16*)(F.ws + WS_MG); g.Bt = (const bf16*)wl(F, l, WL_O); g.N = D; g.mode = G_WO; }
            else if (lp == LP_GU) { g.A = (const bf16*)(F.ws + WS_H); g.Bt = (const bf16*)wl(F, l, WL_GU); g.N = NGU; g.mode = G_GU; }
            else { g.A = (const bf16*)(F.ws + WS_GT); g.Bt = (const bf16*)wl(F, l, WL_DN); g.N = D; g.K = DFF; g.ld = DFF; g.mode = G_DN; }
            Sched S; Epi E; E.F = &F; E.mode = g.mode; E.layer = l;
            if (g.mode == G_WO && F.bid < 32) {
                const int ks = F.bid >> 3;
                const float* sl = (const float*)(F.ws + WS_SLABM); bf16* mg = (bf16*)(F.ws + WS_MG) + (size_t)MP * D;
                for (int i = F.tid; i < NS * 128; i += NTHR) { const int r = i >> 7, c = ks * 512 + (i & 127) * 4; const size_t o = (size_t)r * D + c;
                    const f32x4 v = *(const f32x4*)(sl + o) + *(const f32x4*)(sl + (size_t)NS * D + o) + *(const f32x4*)(sl + (size_t)2 * NS * D + o) + *(const f32x4*)(sl + (size_t)3 * NS * D + o);
                    u32x2 w; w.x = cvt_pk_bf16(v.x, v.y); w.y = cvt_pk_bf16(v.z, v.w); *(u32x2*)(mg + o) = w; }
                asm volatile("s_waitcnt vmcnt(0)" ::: "memory"); __syncthreads();
            }
            if (lp == LP_IN && ph != PH_ADA) S.init(Rect{0, MPAD / BM, 0, 16}, Rect{0, GL_PM_SPLIT, 16, 24}, F.G, F.bid, 1);
            else if (g.mode == G_WO || g.mode == G_DN || g.mode == G_MG) S.init(Rect{0, MPAD / BM - 1, 0, 8}, Rect{MPAD / BM - 1, 1, 0, 8 * (g.K / 512)}, F.G, F.bid, 1, 8);
            else S.init(Rect{0, g.M / BM, 0, g.N / BM}, Rect{0, 0, 0, 0}, F.G, F.bid, 1);
            gemm_phase(F.lds, g, S, E, F.tid);
            if (ph == PH_ADA) { if (F.bid < 96) p0_prologue(F, 1, false, F.bid, 96, 2); else p0_prologue(F, 1, false, F.bid - 96, F.G - 96, 1); }
        }
#else
        {}
#endif
        TSE(ph == PH_PRO ? 1 : ph == PH_ADA ? 2 : ph == PH_FINAL ? 3 : 10 + lp, F.lds);
        TSB(30, F.lds);
        if (ph + 1 < args.ph_hi) { if (args.ph_hi < 0) grid.sync();   else xcd_barrier(xbar); }
        TSE(30, F.lds);
    }
#ifdef MK_EXTRA_SYNCS
    for (int i = 0; i < MK_EXTRA_SYNCS; ++i) xcd_barrier(xbar);
#endif
#ifdef MK_TS_ID
    if (blockIdx.x == MK_TS_BLOCK && threadIdx.x == 0) { const unsigned want = *(volatile LAS unsigned*)((LAS unsigned char*)lds_raw + TS_OFF) * (unsigned)MK_TS_AMP; const unsigned t0 = (unsigned)__builtin_amdgcn_s_memrealtime();
        while ((unsigned)__builtin_amdgcn_s_memrealtime() - t0 < want) __builtin_amdgcn_s_sleep(32); }
#endif
}
}
#ifndef MK_DEBUG
#define MK_DEBUG 0
#endif
extern "C" void kernel_launch(void* const* d_in, const int* in_sizes, int n_in, void* d_out, int out_size, void* d_ws, size_t ws_size, hipStream_t stream) {
    using namespace mk;
    static int grid = 0;
    if (grid == 0) {
        nv::WS wtmp; const size_t need_nv = nv::carve((float*)d_ws, wtmp) * 4; const size_t need = MK_DEBUG ? (need_nv > WS_END ? need_nv : WS_END) + (16u << 20) : WS_END;
        if (n_in != 39 || (size_t)out_size != O_END || ws_size < need) { fprintf(stderr, "kernel_launch: unexpected shapes: n_in %d out %d (want %zu) ws %zu (need %zu)\n", n_in, out_size, (size_t)O_END, ws_size, need); grid = -1; return; }
        int dev = 0, cus = 0, per_cu = 0;
        if (hipGetDevice(&dev) != hipSuccess || hipDeviceGetAttribute(&cus, hipDeviceAttributeMultiprocessorCount, dev) != hipSuccess) { grid = -1; return; }
        if (hipFuncSetAttribute((const void*)mega, hipFuncAttributeMaxDynamicSharedMemorySize, LDS_BYTES) != hipSuccess) { fprintf(stderr, "kernel_launch: hipFuncSetAttribute failed\n"); grid = -1; return; }
        if (hipOccupancyMaxActiveBlocksPerMultiprocessor(&per_cu, (const void*)mega, NTHR, LDS_BYTES) != hipSuccess || per_cu < 1) { fprintf(stderr, "kernel_launch: occupancy query says %d blocks per CU\n", per_cu); per_cu = 1; }
        (void)hipGetLastError();
        grid = cus;
        fprintf(stderr, "kernel_launch: grid %d (cus %d, per_cu %d), ws %zu need %zu\n", grid, cus, per_cu, ws_size, need);
    }
    if (grid < 0) return;
    Args a{};
    for (int i = 0; i < 39; ++i) a.in[i] = (const float*)d_in[i];
    a.out = (float*)d_out; a.ws = (unsigned char*)d_ws;
    if (hipMemsetAsync((unsigned char*)d_ws + WS_CTL, 0, WS_CTL_BYTES, stream) != hipSuccess) { fprintf(stderr, "kernel_launch: hipMemsetAsync of the control words failed\n"); return; }
#if MK_DEBUG
    dbg::Ctx dc; dc.probes = (float*)((unsigned char*)d_ws + ((ws_size - (12u << 20)) & ~(size_t)255)); dc.err = dc.probes + (size_t)dbg::NIDS * dbg::NPROBE; dc.on = 1;
    (void)hipMemsetAsync(dc.err, 0, dbg::NIDS * 4 * sizeof(float), stream);
    unsigned char* ws = (unsigned char*)d_ws;
    for (int ph = 0; ph < N_PHASES; ++ph) {
        a.ph_lo = ph; a.ph_hi = ph + 1;
        hipLaunchKernelGGL(mega, dim3(grid), dim3(NTHR), LDS_BYTES, stream, a);
        using namespace dbg;
        const int l = ph >= PH_L0 && ph < PH_FINAL ? (ph - PH_L0) / PH_PER_L : 0, lp = ph >= PH_L0 && ph < PH_FINAL ? (ph - PH_L0) % PH_PER_L : -1, tb = T_L0 + l * T_PER_L;
        if (ph == PH_ADA) save(&dc, stream, T_MOD, ws + WS_MOD, K_F32, NADA, 0, NL * NMOD, NADA);
        if (lp == LP_NORM1) save(&dc, stream, tb + T_H1, ws + WS_H, K_BF16, D, 0, M, D);
        if (lp == LP_IN) { save(&dc, stream, tb + T_Q, ws + WS_Q, K_QPERM, 1024, 0, M, 1024); save(&dc, stream, tb + T_K, ws + WS_K, K_QPERM, 256, 0, M, 256); save(&dc, stream, tb + T_V, ws + WS_V, K_BF16, 256, 0, M, 256);
            save(&dc, stream, tb + T_U, ws + WS_U, K_F32, 512, 0, M, 512); save(&dc, stream, tb + T_PR, ws + WS_PR, K_F32, 2048, 0, M, RP); }
        if (lp == LP_SCAN) { save(&dc, stream, tb + T_OA, ws + WS_CAT, K_BF16, D, 0, M, 1024); save(&dc, stream, tb + T_ZP, ws + WS_CAT, K_BF16, D, 1024, M, 512); }
        if (lp == LP_SCAN) {
            for (int i = 0; i < 7; ++i) save(&dc, stream, tb + T_R + i, ws + WS_RW + (size_t)i * RW_STRIDE, K_F32, 512, 0, M, 512);
            if (l == 1) { save(&dc, stream, 59, ws + WS_RW + (size_t)RW_Y * RW_STRIDE, K_F32, 512, 0, M, 512); save(&dc, stream, 60, ws + WS_H, K_F32, 32, 0, M, 32); } }
        if (lp == LP_SCAN) save(&dc, stream, tb + T_GT, ws + WS_GT, K_BF16, 6144, 0, M, 6144);
        if (lp == LP_SCAN) save(&dc, stream, tb + T_Y, ws + WS_RW + (size_t)RW_Y * RW_STRIDE, K_F32, 512, 0, M, 512);
        if (lp == LP_POST) save(&dc, stream, tb + T_YR, ws + WS_CAT, K_BF16, D, 1536, M, 512);
        if (lp == LP_MG) save(&dc, stream, tb + T_MG, ws + WS_MG, K_BF16, D, 0, M, D);
        if (lp == LP_NORM2) { save(&dc, stream, tb + T_X1, ws + WS_X, K_F32, D, 0, M, D); save(&dc, stream, tb + T_H2, ws + WS_H, K_BF16, D, 0, M, D); }
        if (lp == LP_GU) save(&dc, stream, tb + T_ACT, ws + WS_GT, K_BF16, DFF, 0, M, DFF);
        if ((lp == LP_NORM1 && l > 0) || ph == PH_FINAL) save(&dc, stream, T_L0 + (ph == PH_FINAL ? 1 : l - 1) * T_PER_L + T_X2, ws + WS_X, K_F32, D, 0, M, D);
    }
    const size_t ooff[13] = {O_YP, O_YS, O_KP, O_VP, O_PP, O_SP, O_WP, O_KS, O_VS, O_PS, O_SS, O_WS, O_END}; const int ocol[12] = {2048, 2048, 256, 256, 512, 1984, 64, 256, 256, 512, 1984, 64};
    for (int i = 0; i < 12; ++i) dbg::save(&dc, stream, dbg::T_OUT0 + i, (float*)d_out + ooff[i], dbg::K_F32, ocol[i], 0, (int)((ooff[i + 1] - ooff[i]) / ocol[i]), ocol[i]);
    nv::In in; for (int i = 0; i < 39; ++i) in.p[i] = (const float*)d_in[i];
    nv::forward(in, (float*)d_out, (float*)d_ws, stream, &dc);
    for (int i = 0; i < 12; ++i) dbg::cmp(&dc, stream, dbg::T_OUT0 + i, (float*)d_out + ooff[i], ocol[i], 0, (int)((ooff[i + 1] - ooff[i]) / ocol[i]), ocol[i]);
#ifndef DBG_WANT_ID
#define DBG_WANT_ID -1
#endif
    dbg::inject<<<1, 1, 0, stream>>>(dc.err, (float*)d_out, (float*)d_out + O_YS, DBG_WANT_ID >= 0 ? dbg::NIDS : dbg::T_N, DBG_WANT_ID);
#else
    a.ph_lo = 0; a.ph_hi = N_PHASES;
    void* kargs[] = {&a};
    const hipError_t e = hipLaunchCooperativeKernel((const void*)mega, dim3(grid), dim3(NTHR), kargs, LDS_BYTES, stream);
    if (e != hipSuccess) fprintf(stderr, "kernel_launch: cooperative launch failed: %s (grid %d)\n", hipGetErrorString(e), grid);
#endif
}
```

```cpp
#define MK_DEBUG 0
#include <hip/hip_runtime.h>
#include <hip/hip_cooperative_groups.h>
#include <cstdio>
#include <cstdint>
namespace dbg {
constexpr int NPROBE = 16384, NSPECIAL = 2048, NIDS = 64;
struct Ctx { float* probes; float* err; int on; };
__device__ __forceinline__ unsigned hash32(unsigned x) { x ^= x >> 16; x *= 0x7feb352dU; x ^= x >> 15; x *= 0x846ca68bU; x ^= x >> 16; return x; }
__device__ __forceinline__ void probe_rc(int id, int k, int R, int C, int& r, int& c) {
    const unsigned h1 = hash32((unsigned)(id * 1000003 + k * 2 + 1)), h2 = hash32((unsigned)(id * 7919 + k * 2 + 77777));
    c = (int)(h2 % (unsigned)C);
    if (R == 8320 && k < NSPECIAL) { const int sp[16] = {0, 1, 15, 16, 127, 128, 129, 4095, 4096, 4097, 8190, 8191, 8192, 8193, 8255, 8319}; r = sp[k >> 7]; }
    else r = (int)(h1 % (unsigned)R);
}
enum { K_F32 = 0, K_BF16 = 1, K_QPERM = 2 };
__device__ __forceinline__ float opt_read(const void* p, int kind, size_t ld, int coff, int r, int c) {
    if (kind == K_F32) return ((const float*)p)[(size_t)r * ld + coff + c];
    if (kind == K_QPERM) { const int h = c >> 6, d = c & 63, pp = 32 * ((d >> 4) & 1) + 8 * ((d >> 2) & 3) + 4 * (d >> 5) + (d & 3); c = h * 64 + pp; }
    const unsigned short b = ((const unsigned short*)p)[(size_t)r * ld + coff + c]; return __builtin_bit_cast(float, (unsigned)b << 16);
}
__global__ void probe_save(float* probes, int id, const void* p, int kind, size_t ld, int coff, int R, int C) {
    const int k = blockIdx.x * blockDim.x + threadIdx.x; if (k >= NPROBE) return; int r, c; probe_rc(id, k, R, C, r, c);
    probes[(size_t)id * NPROBE + k] = opt_read(p, kind, ld, coff, r, c);
}
__global__ void probe_cmp(const float* probes, float* err, int id, const float* gold, size_t ld, int coff, int R, int C, int sig) {
    const int k = blockIdx.x * blockDim.x + threadIdx.x; if (k >= NPROBE) return; int r, c; probe_rc(id, k, R, C, r, c);
    float g = gold[(size_t)r * ld + coff + c]; if (sig) g = 1.f / (1.f + expf(-g));
    float o = probes[(size_t)id * NPROBE + k]; float d = o - g; if (!(d == d) || fabsf(d) > 1e18f) d = 1e18f;
    const int sp = (R == 8320 && k < NSPECIAL) ? 0 : 2;
    atomicAdd(&err[id * 4 + sp], d * d); atomicAdd(&err[id * 4 + sp + 1], g * g);
}
__global__ void inject(const float* err, float* out, float* ys, int nids, int want_id) {
    if (threadIdx.x || blockIdx.x) return;
    int rid = 89, which = 0; float rel = 1e-3f;
    for (int id = 0; id < nids; ++id) {
        const float r_rand = sqrtf(err[id * 4 + 2] / fmaxf(err[id * 4 + 3], 1e-30f)), r_sp = err[id * 4 + 1] > 0.f ? sqrtf(err[id * 4 + 0] / fmaxf(err[id * 4 + 1], 1e-30f)) : 0.f;
        if (want_id >= 0) { if (id == want_id) { rid = id; which = 0; rel = r_rand; break; } continue; }
        if (r_rand > 0.05f) { rid = id; which = 0; rel = r_rand; break; } else if (r_sp > 0.10f) { rid = id; which = 1; rel = r_sp; break; } }
    const float c1 = (float)(10 + rid) * (which ? 1e5f : 1e3f); float f = (log10f(fmaxf(rel, 1e-3f)) + 3.f) * 0.25f; f = fminf(fmaxf(f, 0.f), 1.f);
    out[0] = c1; ys[0] = c1 * (0.2f + 0.6f * f);
}
inline void save(const Ctx* c, hipStream_t st, int id, const void* p, int kind, size_t ld, int coff, int R, int C) { if (c && c->on) probe_save<<<NPROBE / 256, 256, 0, st>>>(c->probes, id, p, kind, ld, coff, R, C); }
inline void cmp(const Ctx* c, hipStream_t st, int id, const float* gold, size_t ld, int coff, int R, int C, int sig = 0) { if (c && c->on) probe_cmp<<<NPROBE / 256, 256, 0, st>>>(c->probes, c->err, id, gold, ld, coff, R, C, sig); }
enum { T_MOD = 0, T_L0 = 1, T_PER_L = 23, T_OUT0 = T_L0 + 2 * T_PER_L, T_N = T_OUT0 + 12 };
enum { T_H1 = 0, T_Q, T_K, T_V, T_U, T_PR, T_GT, T_OA, T_ZP, T_R, T_W, T_KK, T_VV, T_A, T_B, T_G, T_Y, T_YR, T_MG, T_X1, T_H2, T_ACT, T_X2 };
}
namespace nv {
constexpr int D = 2048, SEQ = 4096, NB = 2, MP = NB * SEQ, NS = 128, M = MP + NS, NL = 2;
constexpr int INW = 10176, OQ = 0, OK_ = 1024, OV = 1280, OU = 1536, OPR = 2048, OGL = 4032;
constexpr int RP = 1984, DFF = 5632, NMOD = NB + NS;
constexpr int PASTLEN = 8192;

__device__ __forceinline__ float sigm(float x) { return 1.f / (1.f + expf(-x)); }
__device__ __forceinline__ float silu(float x) { return x / (1.f + expf(-x)); }
__device__ __forceinline__ int modrow(int m) { return m < MP ? m / SEQ : NB + (m - MP); }
__device__ __forceinline__ int posof(int m) { return m < MP ? m % SEQ : PASTLEN; }

__global__ void __launch_bounds__(256) gemm(const float* __restrict__ A, int lda, const float* __restrict__ B, int ldb, float* __restrict__ C, int ldc, int Mm, int N, int K) {
    __shared__ float As[16][68], Bs[16][68];
    const int tx = threadIdx.x & 15, ty = threadIdx.x >> 4, m0 = blockIdx.y * 64, n0 = blockIdx.x * 64;
    float acc[4][4];
#pragma unroll
    for (int i = 0; i < 4; ++i)
#pragma unroll
        for (int j = 0; j < 4; ++j) acc[i][j] = 0.f;
    for (int k0 = 0; k0 < K; k0 += 16) {
        for (int i = threadIdx.x; i < 1024; i += 256) { const int r = i >> 4, c = i & 15; As[c][r] = (m0 + r < Mm) ? A[(size_t)(m0 + r) * lda + k0 + c] : 0.f; }
        for (int i = threadIdx.x; i < 1024; i += 256) { const int r = i >> 6, c = i & 63; Bs[r][c] = (n0 + c < N) ? B[(size_t)(k0 + r) * ldb + n0 + c] : 0.f; }
        __syncthreads();
#pragma unroll
        for (int kk = 0; kk < 16; ++kk) {
            float a[4], b[4];
#pragma unroll
            for (int i = 0; i < 4; ++i) { a[i] = As[kk][ty * 4 + i]; b[i] = Bs[kk][tx * 4 + i]; }
#pragma unroll
            for (int i = 0; i < 4; ++i)
#pragma unroll
                for (int j = 0; j < 4; ++j) acc[i][j] += a[i] * b[j];
        }
        __syncthreads();
    }
#pragma unroll
    for (int i = 0; i < 4; ++i)
#pragma unroll
        for (int j = 0; j < 4; ++j) { const int m = m0 + ty * 4 + i, n = n0 + tx * 4 + j; if (m < Mm && n < N) C[(size_t)m * ldc + n] = acc[i][j]; }
}

__global__ void silu_c(const float* cp, const float* cs, float* out) {
    const int i = blockIdx.x * blockDim.x + threadIdx.x; if (i >= NMOD * D) return;
    const int r = i / D, k = i % D; const float c = r < NB ? cp[r * D + k] : cs[(r - NB) * D + k]; out[i] = silu(c);
}
__global__ void add_bias(float* mod, const float* b, int n, int N) { const int i = blockIdx.x * blockDim.x + threadIdx.x; if (i < n) mod[i] += b[i % N]; }

__global__ void __launch_bounds__(256) modnorm(const float* xa, const float* xb, const float* g, const float* mod, int sh_off, int sc_off, float* out, size_t out_split_off) {
    const int m = blockIdx.x; const float* x = m < MP ? xa + (size_t)m * D : xb + (size_t)(m - MP) * D;
    __shared__ float red[256]; float s = 0.f;
    for (int k = threadIdx.x; k < D; k += 256) { const float v = x[k]; s += v * v; }
    red[threadIdx.x] = s; __syncthreads();
    for (int o = 128; o > 0; o >>= 1) { if (threadIdx.x < o) red[threadIdx.x] += red[threadIdx.x + o]; __syncthreads(); }
    const float rs = rsqrtf(red[0] / D + 1e-6f); const int br = modrow(m);
    float* o = m < MP ? out + (size_t)m * D : out + out_split_off + (size_t)(m - MP) * D;
    for (int k = threadIdx.x; k < D; k += 256) { float v = x[k] * rs * g[k]; if (mod) v = v * (1.f + mod[(size_t)br * 6 * D + sc_off + k]) + mod[(size_t)br * 6 * D + sh_off + k]; o[k] = v; }
}

__global__ void rope(float* z) {
    const int i = blockIdx.x * blockDim.x + threadIdx.x; if (i >= M * 20 * 32) return;
    const int m = i / 640, hh = (i / 32) % 20, d = i % 32; const float pos = (float)posof(m);
    const float inv = powf(10000.f, -(float)d * 2.0f / 64.f), ang = pos * inv, c = cosf(ang), s = sinf(ang);
    float* p = z + (size_t)m * INW + hh * 64; const float x1 = p[d], x2 = p[d + 32]; p[d] = x1 * c - x2 * s; p[d + 32] = x2 * c + x1 * s;
}

__global__ void attn_prompt(const float* z, const float* sink, float* oattn) {
    const int i = blockIdx.x * blockDim.x + threadIdx.x; if (i >= MP * 16) return;
    const int m = i / 16, hq = i % 16, hk = hq / 4, t = m % SEQ; const float* q = z + (size_t)m * INW + OQ + hq * 64;
    const int lo = t - 128 < 0 ? 0 : t - 128; const float sk = sink[hq];
    float mx = sk;
    for (int kp = lo; kp <= t; ++kp) { const float* k = z + (size_t)(m - t + kp) * INW + OK_ + hk * 64; float s = 0.f; for (int d = 0; d < 64; ++d) s += q[d] * k[d]; s *= 0.125f; mx = fmaxf(mx, s); }
    float den = expf(sk - mx); float o[64];
#pragma unroll
    for (int d = 0; d < 64; ++d) o[d] = 0.f;
    for (int kp = lo; kp <= t; ++kp) { const float* k = z + (size_t)(m - t + kp) * INW + OK_ + hk * 64; const float* v = z + (size_t)(m - t + kp) * INW + OV + hk * 64; float s = 0.f; for (int d = 0; d < 64; ++d) s += q[d] * k[d]; s *= 0.125f;
        const float p = expf(s - mx); den += p;
#pragma unroll
        for (int d = 0; d < 64; ++d) o[d] += p * v[d]; }
#pragma unroll
    for (int d = 0; d < 64; ++d) oattn[(size_t)m * 1024 + hq * 64 + d] = o[d] / den;
}
__global__ void attn_sample(const float* z, const float* sink, const float* ck, const float* cv, float* oattn) {
    const int i = blockIdx.x * blockDim.x + threadIdx.x; if (i >= NS * 16) return;
    const int s_ = i / 16, hq = i % 16, hk = hq / 4, m = MP + s_; const float* q = z + (size_t)m * INW + OQ + hq * 64; const float sk = sink[hq];
    float mx = sk;
    for (int j = 0; j <= 128; ++j) { const float* k = j < 128 ? ck + ((size_t)(s_ * 128 + j) * 4 + hk) * 64 : z + (size_t)m * INW + OK_ + hk * 64; float s = 0.f; for (int d = 0; d < 64; ++d) s += q[d] * k[d]; s *= 0.125f; mx = fmaxf(mx, s); }
    float den = expf(sk - mx); float o[64];
#pragma unroll
    for (int d = 0; d < 64; ++d) o[d] = 0.f;
    for (int j = 0; j <= 128; ++j) { const float* k = j < 128 ? ck + ((size_t)(s_ * 128 + j) * 4 + hk) * 64 : z + (size_t)m * INW + OK_ + hk * 64;
        const float* v = j < 128 ? cv + ((size_t)(s_ * 128 + j) * 4 + hk) * 64 : z + (size_t)m * INW + OV + hk * 64; float s = 0.f; for (int d = 0; d < 64; ++d) s += q[d] * k[d]; s *= 0.125f;
        const float p = expf(s - mx); den += p;
#pragma unroll
        for (int d = 0; d < 64; ++d) o[d] += p * v[d]; }
#pragma unroll
    for (int d = 0; d < 64; ++d) oattn[(size_t)m * 1024 + hq * 64 + d] = o[d] / den;
}
__global__ void kv_out(const float* z, const float* ck, const float* cv, float* kp, float* vp, float* ks, float* vs) {
    const int i = blockIdx.x * blockDim.x + threadIdx.x;
    if (i < NB * 128 * 256) { const int b = i / (128 * 256), j = (i / 256) % 128, c = i % 256; const size_t m = (size_t)b * SEQ + SEQ - 128 + j; kp[i] = z[m * INW + OK_ + c]; vp[i] = z[m * INW + OV + c]; }
    if (i < NS * 128 * 256) { const int s_ = i / (128 * 256), j = (i / 256) % 128, c = i % 256;
        if (j < 127) { ks[i] = ck[i + 256]; vs[i] = cv[i + 256]; } else { ks[i] = z[(size_t)(MP + s_) * INW + OK_ + c]; vs[i] = z[(size_t)(MP + s_) * INW + OV + c]; } }
}
__global__ void pool_d(const float* z, const float* spool, float* dbuf) {
    const int i = blockIdx.x * blockDim.x + threadIdx.x; if (i >= M * 512) return;
    const int m = i / 512, c = i % 512, gi = c / 128, w = 2 << gi; float sum = 0.f; float cnt;
    if (m < MP) { const int t = m % SEQ; for (int j = 0; j < w; ++j) if (t - j >= 0) sum += z[(size_t)(m - j) * INW + OU + c]; cnt = (float)(t + 1 < w ? t + 1 : w); }
    else { const int s_ = m - MP; sum = z[(size_t)m * INW + OU + c]; for (int j = 1; j < w; ++j) sum += spool[((size_t)s_ * 15 + 15 - j) * 512 + c]; cnt = (float)w; }
    dbuf[i] = sum / cnt - z[(size_t)m * INW + OU + c];
}
__global__ void pool_z(const float* dbuf, const float* pw, const float* pscale, float* zpool) {
    const int i = blockIdx.x * blockDim.x + threadIdx.x; if (i >= M * 512) return;
    const int m = i / 512, c = i % 512, gi = c / 128, e = c % 128; float s = 0.f;
    for (int k = 0; k < 128; ++k) s += dbuf[(size_t)m * 512 + gi * 128 + k] * pw[(gi * 128 + k) * 128 + e];
    zpool[i] = s * pscale[c];
}
__global__ void pool_out(const float* z, const float* spool, float* pp, float* ps) {
    const int i = blockIdx.x * blockDim.x + threadIdx.x;
    if (i < NB * 15 * 512) { const int b = i / (15 * 512), j = (i / 512) % 15, c = i % 512; pp[i] = z[((size_t)b * SEQ + SEQ - 15 + j) * INW + OU + c]; }
    if (i < NS * 15 * 512) { const int s_ = i / (15 * 512), j = (i / 512) % 15, c = i % 512; ps[i] = j < 14 ? spool[i + 512] : z[(size_t)(MP + s_) * INW + OU + c]; }
}
__global__ void rwkv_xm(const float* z, const float* sshift, const float* mu, float* xm) {
    const int i = blockIdx.x * blockDim.x + threadIdx.x; if (i >= M * RP) return;
    const int m = i / RP, c = i % RP; const float p = z[(size_t)m * INW + OPR + c]; float pv;
    if (m < MP) pv = (m % SEQ) ? z[(size_t)(m - 1) * INW + OPR + c] : 0.f; else pv = sshift[(size_t)(m - MP) * RP + c];
    xm[i] = p + (pv - p) * mu[c];
}
__global__ void shift_out(const float* z, float* sp, float* ss) {
    const int i = blockIdx.x * blockDim.x + threadIdx.x;
    if (i < NB * RP) { const int b = i / RP, c = i % RP; sp[i] = z[((size_t)b * SEQ + SEQ - 1) * INW + OPR + c]; }
    if (i < NS * RP) { const int s_ = i / RP, c = i % RP; ss[i] = z[(size_t)(MP + s_) * INW + OPR + c]; }
}
__global__ void __launch_bounds__(64) rwkv_prep(const float* xm, const float* w0, const float* w2, const float* a0, const float* a2, const float* g2, const float* k_k, const float* k_a,
                                                 const float* T2, const float* vb, float* vfirst, int has_vres,
                                                 float* R, float* W, float* Kk, float* V, float* A, float* Bb, float* G) {
    const int m = blockIdx.x / 8, h = blockIdx.x % 8, c = h * 64 + threadIdx.x; const float* x = xm + (size_t)m * RP;
    float s = w0[c]; for (int k = 0; k < 96; ++k) s += tanhf(x[1536 + k]) * w2[k * 512 + c];
    const float z_ = -s; const float sp = z_ > 20.f ? z_ : log1pf(expf(z_)); const float wlog = -sp - 0.5f; const float decay = expf(-expf(wlog));
    float sa = a0[c]; for (int k = 0; k < 96; ++k) sa += x[1632 + k] * a2[k * 512 + c]; const float a = sigm(sa);
    float g = 0.f; for (int k = 0; k < 256; ++k) g += sigm(x[1728 + k]) * g2[k * 512 + c];
    float v = x[1024 + c];
    if (!has_vres) vfirst[(size_t)m * 512 + c] = v;
    else { const float acc = vb[c] + T2[(size_t)m * 512 + c]; v = v + (vfirst[(size_t)m * 512 + c] - v) * sigm(acc); }
    const float r = x[c], k = x[512 + c]; float kk = k * k_k[c];
    __shared__ float red[64]; red[threadIdx.x] = kk * kk; __syncthreads();
    for (int o = 32; o > 0; o >>= 1) { if (threadIdx.x < o) red[threadIdx.x] += red[threadIdx.x + o]; __syncthreads(); }
    kk = kk / fmaxf(sqrtf(red[0]), 1e-12f); const float k2 = k * (1.f + (a - 1.f) * k_a[c]);
    const size_t o = (size_t)m * 512 + c; R[o] = r; W[o] = decay; Kk[o] = k2; V[o] = v; A[o] = -kk; Bb[o] = kk * a; G[o] = g;
}
__global__ void __launch_bounds__(64) rwkv_scan(const float* R, const float* W, const float* Kk, const float* V, const float* A, const float* Bb, const float* S0, float* Sout, float* Y, int row0, int T) {
    const int seq = blockIdx.x / 8, h = blockIdx.x % 8, i = threadIdx.x; float S[64];
#pragma unroll
    for (int j = 0; j < 64; ++j) S[j] = S0 ? S0[(((size_t)seq * 8 + h) * 64 + i) * 64 + j] : 0.f;
    __shared__ float sr[16][64], sw[16][64], sk[16][64], sa[16][64], sb[16][64], sv[16][64];
    for (int t0 = 0; t0 < T; t0 += 16) { const int nt = T - t0 < 16 ? T - t0 : 16;
        __syncthreads();
        for (int tt = 0; tt < nt; ++tt) { const size_t o = ((size_t)row0 + (size_t)seq * T + t0 + tt) * 512 + h * 64 + i; sr[tt][i] = R[o]; sw[tt][i] = W[o]; sk[tt][i] = Kk[o]; sa[tt][i] = A[o]; sb[tt][i] = Bb[o]; sv[tt][i] = V[o]; }
        __syncthreads();
        for (int tt = 0; tt < nt; ++tt) { float dot = 0.f; const float v = sv[tt][i];
#pragma unroll
            for (int j = 0; j < 64; ++j) dot += S[j] * sa[tt][j];
            float y = 0.f;
#pragma unroll
            for (int j = 0; j < 64; ++j) { S[j] = S[j] * sw[tt][j] + dot * sb[tt][j] + v * sk[tt][j]; y += S[j] * sr[tt][j]; }
            Y[((size_t)row0 + (size_t)seq * T + t0 + tt) * 512 + h * 64 + i] = y; } }
#pragma unroll
    for (int j = 0; j < 64; ++j) Sout[(((size_t)seq * 8 + h) * 64 + i) * 64 + j] = S[j];
}
__global__ void __launch_bounds__(64) rwkv_post(const float* Y, const float* R, const float* Kk, const float* V, const float* G, const float* r_k, const float* lg, const float* lb, float* yout) {
    const int m = blockIdx.x / 8, h = blockIdx.x % 8, i = threadIdx.x, c = h * 64 + i; const size_t o = (size_t)m * 512 + c;
    __shared__ float red[64]; const float y = Y[o];
    red[i] = y; __syncthreads(); for (int s = 32; s > 0; s >>= 1) { if (i < s) red[i] += red[i + s]; __syncthreads(); } const float mu = red[0] / 64.f; __syncthreads();
    red[i] = (y - mu) * (y - mu); __syncthreads(); for (int s = 32; s > 0; s >>= 1) { if (i < s) red[i] += red[i + s]; __syncthreads(); } const float var = red[0] / 64.f; __syncthreads();
    red[i] = R[o] * Kk[o] * r_k[c]; __syncthreads(); for (int s = 32; s > 0; s >>= 1) { if (i < s) red[i] += red[i + s]; __syncthreads(); } const float bon = red[0];
    yout[o] = ((y - mu) * rsqrtf(var + 64e-5f) * lg[c] + lb[c] + bon * V[o]) * G[o];
}
__global__ void merge_acc(const float* z, const float* P, int goff, float* merged, int first) {
    const int i = blockIdx.x * blockDim.x + threadIdx.x; if (i >= M * D) return; const int m = i / D, n = i % D;
    const float v = sigm(z[(size_t)m * INW + OGL + goff + n]) * P[i]; merged[i] = first ? v : merged[i] + v;
}
__global__ void resid(const float* xa, const float* xb, const float* P, const float* mod, int gt_off, float* xout) {
    const int i = blockIdx.x * blockDim.x + threadIdx.x; if (i >= M * D) return; const int m = i / D, n = i % D;
    const float x = m < MP ? xa[i] : xb[(size_t)(m - MP) * D + n]; xout[i] = x + (1.f + mod[(size_t)modrow(m) * 6 * D + gt_off + n]) * P[i];
}
__global__ void swiglu(const float* gbuf, const float* ubuf, float* act, int n) { const int i = blockIdx.x * blockDim.x + threadIdx.x; if (i < n) act[i] = silu(gbuf[i]) * ubuf[i]; }

struct In { const float* p[39]; };
inline void G(hipStream_t st, const float* A, int lda, const float* B, int ldb, float* C, int ldc, int Mm, int N, int K) { gemm<<<dim3((N + 63) / 64, (Mm + 63) / 64), 256, 0, st>>>(A, lda, B, ldb, C, ldc, Mm, N, K); }
#define EW(n) ((int)(((size_t)(n) + 255) / 256)), 256, 0, st

struct WS { float *silc, *mod, *h, *z, *xm, *R, *W, *K, *V, *A, *B, *G, *Y, *vfirst, *dbuf, *cat_a, *cat_p, *cat_r, *P, *merged, *x1, *xres, *fg, *fu, *T1; };
inline size_t carve(float* base, WS& w) {
    size_t o = 0; auto take = [&](size_t n) { float* p = base + o; o += (n + 63) & ~(size_t)63; return p; };
    w.silc = take((size_t)NMOD * D); w.mod = take((size_t)NL * NMOD * 6 * D); w.T1 = take((size_t)M * 32);
    w.h = take((size_t)M * D); w.P = w.h;
    w.xm = take((size_t)M * D); w.x1 = w.xm;
    w.cat_a = take((size_t)M * 1024); w.cat_p = take((size_t)M * 512); w.cat_r = take((size_t)M * 512); w.xres = take((size_t)M * D);
    w.z = take((size_t)M * INW);
    w.R = take((size_t)M * 512); w.W = take((size_t)M * 512); w.K = take((size_t)M * 512); w.V = take((size_t)M * 512); w.A = take((size_t)M * 512); w.B = take((size_t)M * 512); w.G = take((size_t)M * 512);
    w.Y = take((size_t)M * 512); w.vfirst = take((size_t)M * 512); w.dbuf = take((size_t)M * 512);
    w.merged = w.R;
    w.fg = w.z; w.fu = w.z + (size_t)M * DFF;
    return o;
}
constexpr size_t O_YP = 0, O_YS = O_YP + (size_t)MP * D, O_KP = O_YS + (size_t)NS * D, O_VP = O_KP + (size_t)NL * NB * 128 * 256, O_PP = O_VP + (size_t)NL * NB * 128 * 256,
                 O_SP = O_PP + (size_t)NL * NB * 15 * 512, O_WP = O_SP + (size_t)NL * NB * RP, O_KS = O_WP + (size_t)NL * NB * 8 * 4096, O_VS = O_KS + (size_t)NL * NS * 128 * 256,
                 O_PS = O_VS + (size_t)NL * NS * 128 * 256, O_SS = O_PS + (size_t)NL * NS * 15 * 512, O_WS = O_SS + (size_t)NL * NS * RP, O_END = O_WS + (size_t)NL * NS * 8 * 4096;

inline void forward(const In& in, float* out, float* wsf, hipStream_t st, const dbg::Ctx* dc = nullptr) {
    using namespace dbg;
    WS w; carve(wsf, w);
    const float *xp = in.p[0], *xs = in.p[1];
    silu_c<<<EW(NMOD * D)>>>(in.p[2], in.p[3], w.silc);
    for (int l = 0; l < NL; ++l) { G(st, w.silc, D, in.p[9] + (size_t)l * D * 6 * D, 6 * D, w.mod + (size_t)l * NMOD * 6 * D, 6 * D, NMOD, 6 * D, D);
        add_bias<<<EW(NMOD * 6 * D)>>>(w.mod + (size_t)l * NMOD * 6 * D, in.p[10] + (size_t)l * 6 * D, NMOD * 6 * D, 6 * D); }
    cmp(dc, st, T_MOD, w.mod, 6 * D, 0, NL * NMOD, 6 * D);
    const float* xa = xp; const float* xb = xs;
    for (int l = 0; l < NL; ++l) {
        const float* mod = w.mod + (size_t)l * NMOD * 6 * D; const int tb = T_L0 + l * T_PER_L;
        modnorm<<<M, 256, 0, st>>>(xa, xb, in.p[11] + l * D, mod, 0, D, w.h, (size_t)MP * D);
        cmp(dc, st, tb + T_H1, w.h, D, 0, M, D);
        G(st, w.h, D, in.p[13] + (size_t)l * D * INW, INW, w.z, INW, M, INW, D);
        rope<<<EW(M * 640)>>>(w.z);
        cmp(dc, st, tb + T_Q, w.z, INW, OQ, M, 1024); cmp(dc, st, tb + T_K, w.z, INW, OK_, M, 256); cmp(dc, st, tb + T_V, w.z, INW, OV, M, 256); cmp(dc, st, tb + T_U, w.z, INW, OU, M, 512);
        cmp(dc, st, tb + T_PR, w.z, INW, OPR, M, RP); cmp(dc, st, tb + T_GT, w.z, INW, OGL, M, 6144, 1);
        const float* ck = in.p[4] + (size_t)l * NS * 128 * 256; const float* cv = in.p[5] + (size_t)l * NS * 128 * 256;
        attn_prompt<<<(MP * 16 + 63) / 64, 64, 0, st>>>(w.z, in.p[14] + l * 16, w.cat_a);
        attn_sample<<<(NS * 16 + 63) / 64, 64, 0, st>>>(w.z, in.p[14] + l * 16, ck, cv, w.cat_a);
        kv_out<<<EW(NS * 128 * 256)>>>(w.z, ck, cv, out + O_KP + (size_t)l * NB * 128 * 256, out + O_VP + (size_t)l * NB * 128 * 256, out + O_KS + (size_t)l * NS * 128 * 256, out + O_VS + (size_t)l * NS * 128 * 256);
        const float* sp = in.p[6] + (size_t)l * NS * 15 * 512;
        pool_d<<<EW(M * 512)>>>(w.z, sp, w.dbuf);
        pool_z<<<EW(M * 512)>>>(w.dbuf, in.p[16] + (size_t)l * 4 * 128 * 128, in.p[17] + l * 512, w.cat_p);
        pool_out<<<EW(NS * 15 * 512)>>>(w.z, sp, out + O_PP + (size_t)l * NB * 15 * 512, out + O_PS + (size_t)l * NS * 15 * 512);
        rwkv_xm<<<EW((size_t)M * RP)>>>(w.z, in.p[7] + (size_t)l * NS * RP, in.p[19] + l * RP, w.xm);
        shift_out<<<EW(NS * RP)>>>(w.z, out + O_SP + (size_t)l * NB * RP, out + O_SS + (size_t)l * NS * RP);
        if (l > 0) { G(st, w.xm + 1024, RP, in.p[31], 32, w.T1, 32, M, 32, 512); G(st, w.T1, 32, in.p[32], 512, w.dbuf, 512, M, 512, 32); }
        if (l > 0) { cmp(dc, st, 59, w.dbuf, 512, 0, M, 512); cmp(dc, st, 60, w.T1, 32, 0, M, 32); }
        rwkv_prep<<<M * 8, 64, 0, st>>>(w.xm, in.p[20] + l * 512, in.p[21] + (size_t)l * 96 * 512, in.p[22] + l * 512, in.p[23] + (size_t)l * 96 * 512, in.p[24] + (size_t)l * 256 * 512, in.p[25] + l * 512, in.p[26] + l * 512,
                                         w.dbuf, in.p[33], w.vfirst, l > 0, w.R, w.W, w.K, w.V, w.A, w.B, w.G);
        cmp(dc, st, tb + T_OA, w.cat_a, 1024, 0, M, 1024); cmp(dc, st, tb + T_ZP, w.cat_p, 512, 0, M, 512);
        cmp(dc, st, tb + T_R, w.R, 512, 0, M, 512); cmp(dc, st, tb + T_W, w.W, 512, 0, M, 512); cmp(dc, st, tb + T_KK, w.K, 512, 0, M, 512); cmp(dc, st, tb + T_VV, w.V, 512, 0, M, 512);
        cmp(dc, st, tb + T_A, w.A, 512, 0, M, 512); cmp(dc, st, tb + T_B, w.B, 512, 0, M, 512); cmp(dc, st, tb + T_G, w.G, 512, 0, M, 512);
        rwkv_scan<<<NB * 8, 64, 0, st>>>(w.R, w.W, w.K, w.V, w.A, w.B, nullptr, out + O_WP + (size_t)l * NB * 8 * 4096, w.Y, 0, SEQ);
        rwkv_scan<<<NS * 8, 64, 0, st>>>(w.R, w.W, w.K, w.V, w.A, w.B, in.p[8] + (size_t)l * NS * 8 * 4096, out + O_WS + (size_t)l * NS * 8 * 4096, w.Y, MP, 1);
        cmp(dc, st, tb + T_Y, w.Y, 512, 0, M, 512);
        rwkv_post<<<M * 8, 64, 0, st>>>(w.Y, w.R, w.K, w.V, w.G, in.p[27] + l * 512, in.p[28] + l * 512, in.p[29] + l * 512, w.cat_r);
        cmp(dc, st, tb + T_YR, w.cat_r, 512, 0, M, 512);
        G(st, w.cat_a, 1024, in.p[15] + (size_t)l * 1024 * D, D, w.P, D, M, D, 1024); merge_acc<<<EW((size_t)M * D)>>>(w.z, w.P, 0, w.merged, 1);
        G(st, w.cat_p, 512, in.p[18] + (size_t)l * 512 * D, D, w.P, D, M, D, 512);   merge_acc<<<EW((size_t)M * D)>>>(w.z, w.P, D, w.merged, 0);
        G(st, w.cat_r, 512, in.p[30] + (size_t)l * 512 * D, D, w.P, D, M, D, 512);   merge_acc<<<EW((size_t)M * D)>>>(w.z, w.P, 2 * D, w.merged, 0);
        cmp(dc, st, tb + T_MG, w.merged, D, 0, M, D);
        G(st, w.merged, D, in.p[34] + (size_t)l * D * D, D, w.P, D, M, D, D);
        resid<<<EW((size_t)M * D)>>>(xa, xb, w.P, mod, 2 * D, w.x1);
        cmp(dc, st, tb + T_X1, w.x1, D, 0, M, D);
        modnorm<<<M, 256, 0, st>>>(w.x1, w.x1 + (size_t)MP * D, in.p[12] + l * D, mod, 3 * D, 4 * D, w.h, (size_t)MP * D);
        cmp(dc, st, tb + T_H2, w.h, D, 0, M, D);
        G(st, w.h, D, in.p[35] + (size_t)l * D * DFF, DFF, w.fg, DFF, M, DFF, D);
        G(st, w.h, D, in.p[36] + (size_t)l * D * DFF, DFF, w.fu, DFF, M, DFF, D);
        swiglu<<<EW((size_t)M * DFF)>>>(w.fg, w.fu, w.fg, M * DFF);
        cmp(dc, st, tb + T_ACT, w.fg, DFF, 0, M, DFF);
        G(st, w.fg, DFF, in.p[37] + (size_t)l * DFF * D, D, w.P, D, M, D, DFF);
        resid<<<EW((size_t)M * D)>>>(w.x1, w.x1 + (size_t)MP * D, w.P, mod, 5 * D, w.xres);
        cmp(dc, st, tb + T_X2, w.xres, D, 0, M, D);
        xa = w.xres; xb = w.xres + (size_t)MP * D;
    }
    modnorm<<<M, 256, 0, st>>>(xa, xb, in.p[38], nullptr, 0, 0, out + O_YP, (size_t)MP * D);
}
#undef EW
}
namespace mk {
#define LAS __attribute__((address_space(3)))
#define GAS __attribute__((address_space(1)))
typedef unsigned short bf16;
typedef short bf16x8 __attribute__((ext_vector_type(8)));
typedef float f32x4 __attribute__((ext_vector_type(4)));
typedef float f32x2 __attribute__((ext_vector_type(2)));
typedef unsigned u32x4 __attribute__((ext_vector_type(4)));
typedef unsigned u32x2 __attribute__((ext_vector_type(2)));

constexpr int D = 2048, SEQ = 4096, NB = 2, MP = NB * SEQ, NS = 128, M = MP + NS, MPAD = 8448, NL = 2, NMOD = NB + NS;
constexpr int NIN = 10240, NGU = 11264, DFF = 5632, NADA = 6 * D, RP = 1984, PASTLEN = 8192;
constexpr int NWAVES = 8, NTHR = 512;

constexpr size_t al(size_t x) { return (x + 255) & ~(size_t)255; }
constexpr size_t WL_IN = 0, WL_CAT = WL_IN + al((size_t)NIN * D * 2), WL_O = WL_CAT + al((size_t)D * D * 2), WL_GU = WL_O + al((size_t)D * D * 2), WL_DN = WL_GU + al((size_t)NGU * D * 2),
                 WL_W2 = WL_DN + al((size_t)D * DFF * 2), WL_A2 = WL_W2 + al(512 * 96 * 2), WL_G2 = WL_A2 + al(512 * 96 * 2), WL_V1 = WL_G2 + al(512 * 256 * 2), WL_V2 = WL_V1 + al(32 * 512 * 2),
                 WL_PW = WL_V2 + al(512 * 32 * 2), WL_SIZE = WL_PW + al(4 * 128 * 128 * 2);
constexpr size_t WS_W = 0;
constexpr size_t WS_ROPE = WS_W + 2 * WL_SIZE;
constexpr size_t WS_SILC = WS_ROPE + al((size_t)4097 * 64 * 4);
constexpr size_t WS_MOD = WS_SILC + al((size_t)256 * D * 2);
constexpr size_t WS_X = WS_MOD + al((size_t)NL * NMOD * NADA * 4);
constexpr size_t WS_H = WS_X + al((size_t)MPAD * D * 4);
constexpr size_t WS_Q = WS_H + al((size_t)MPAD * D * 2);
constexpr size_t WS_K = WS_Q + al((size_t)MPAD * 1024 * 2);
constexpr size_t WS_V = WS_K + al((size_t)MPAD * 256 * 2);
constexpr size_t WS_U = WS_V + al((size_t)MPAD * 256 * 2);
constexpr size_t WS_PR = WS_U + al((size_t)MPAD * 512 * 4);
constexpr size_t WS_MG = WS_PR;
constexpr size_t WS_CAT = WS_PR + al((size_t)MPAD * D * 4);
constexpr size_t WS_RW = WS_CAT + al((size_t)MPAD * D * 2);
constexpr size_t RW_STRIDE = al((size_t)MPAD * 512 * 4);
constexpr size_t WS_GT = WS_RW + 9 * RW_STRIDE;
constexpr size_t WS_ADAW = WS_GT;
constexpr size_t WS_SLAB = WS_GT + al((size_t)MPAD * 6144 * 2);
constexpr size_t WS_SLABM = WS_SLAB + al((size_t)11 * NS * D * 4);
constexpr size_t WS_CTL = WS_SLABM + al((size_t)4 * NS * D * 4);
constexpr size_t WS_CTL_BYTES = 32768;
constexpr size_t WS_END = WS_CTL + WS_CTL_BYTES;
static_assert((size_t)2 * NADA * D * 2 <= (size_t)MPAD * 6144 * 2, "ada weights fit under the gates");

constexpr size_t O_YP = 0, O_YS = O_YP + (size_t)MP * D, O_KP = O_YS + (size_t)NS * D, O_VP = O_KP + (size_t)NL * NB * 128 * 256, O_PP = O_VP + (size_t)NL * NB * 128 * 256,
                 O_SP = O_PP + (size_t)NL * NB * 15 * 512, O_WP = O_SP + (size_t)NL * NB * RP, O_KS = O_WP + (size_t)NL * NB * 8 * 4096, O_VS = O_KS + (size_t)NL * NS * 128 * 256,
                 O_PS = O_VS + (size_t)NL * NS * 128 * 256, O_SS = O_PS + (size_t)NL * NS * 15 * 512, O_WS = O_SS + (size_t)NL * NS * RP, O_END = O_WS + (size_t)NL * NS * 8 * 4096;

__device__ __forceinline__ unsigned f2bf(float f) { unsigned u = __builtin_bit_cast(unsigned, f); return (u + 0x7fffu + ((u >> 16) & 1u)) >> 16; }
__device__ __forceinline__ unsigned pk2(float lo, float hi) { return f2bf(lo) | (f2bf(hi) << 16); }
__device__ __forceinline__ float bf2f(unsigned short b) { return __builtin_bit_cast(float, (unsigned)b << 16); }
__device__ __forceinline__ float bflo(unsigned w) { return __builtin_bit_cast(float, w << 16); }
__device__ __forceinline__ float bfhi(unsigned w) { return __builtin_bit_cast(float, w & 0xffff0000u); }
__device__ __forceinline__ float fsigm(float x) { return __builtin_amdgcn_rcpf(1.f + __expf(-x)); }
__device__ __forceinline__ float wave_sum(float v) {
#pragma unroll
    for (int o = 1; o < 64; o <<= 1) v += __shfl_xor(v, o);
    return v;
}
__device__ __forceinline__ int modrow(int m) { return m < MP ? (m >> 12) : NB + (m - MP); }
__device__ __forceinline__ int posidx(int m) { return m < MP ? (m & (SEQ - 1)) : 4096; }
__device__ __forceinline__ int pi_d(int p) { return 32 * ((p >> 2) & 1) + 16 * (p >> 5) + 4 * ((p >> 3) & 3) + (p & 3); }

struct Args { const float* in[39]; float* out; unsigned char* ws; int ph_lo, ph_hi; };

struct Frame {
    LAS unsigned char* lds;
    int tid, lane, wave, G, bid;
    float* out; unsigned char* ws;
};
template <int K> __device__ __forceinline__ const float* inp() { GAS const float* p; asm volatile("s_load_dwordx2 %0, %1, %2\n\ts_waitcnt lgkmcnt(0)" : "=s"(p) : "s"(__builtin_amdgcn_kernarg_segment_ptr()), "n"(K * 8) : "memory"); return (const float*)p; }
#define INP(k) inp<k>()
__device__ __forceinline__ unsigned char* wl(const Frame& F, int l, size_t off) { return F.ws + WS_W + (size_t)l * WL_SIZE + off; }
__device__ __forceinline__ float* rwbuf(const Frame& F, int i) { return (float*)(F.ws + WS_RW + (size_t)i * RW_STRIDE); }
enum { RW_R = 0, RW_W, RW_K, RW_V, RW_A, RW_B, RW_G, RW_Y, RW_VF };

struct TSrc { const float* w; long long d2; int ld; int mode; };
__device__ __forceinline__ const float* colsrc(const TSrc& s, int n) {
    if (s.mode == 0) return s.w + n;
    if (s.mode == 1) {
        if (n < 1280) { const int h = n >> 6, p = n & 63; return s.w + h * 64 + pi_d(p); }
        if (n < 4032) return s.w + n;
        if (n < 4096) return nullptr;
        return s.w + (n - 64);
    }
      { const int g8 = n >> 3, i = n & 7; return (const float*)((const char*)s.w + (i < 4 ? 0ll : s.d2)) + 4 * g8 + (i & 3); }
}
__device__ __forceinline__ void transpose_item(const TSrc& s, int K, bf16* WT, size_t ldt, int kcol0, LAS float* scr, int kb, int nb, int lane) {
    const int k0 = 64 * kb, n0 = 32 * nb, gq = lane & 7, kr = lane >> 3;
    const float* cp = colsrc(s, n0 + 4 * gq);
#pragma unroll
    for (int i = 0; i < 8; ++i) { const int kk = 8 * i + kr; const f32x4 v = cp ? *(const f32x4*)(cp + (size_t)(k0 + kk) * s.ld) : (f32x4){0.f, 0.f, 0.f, 0.f};
        LAS float* d = scr + kk * 33 + 4 * gq; d[0] = v.x; d[1] = v.y; d[2] = v.z; d[3] = v.w; }
    asm volatile("s_waitcnt lgkmcnt(0)" ::: "memory");
    const int c = lane & 7;
#pragma unroll
    for (int j = 0; j < 4; ++j) { const int n = (lane >> 3) + 8 * j; const LAS float* p = scr + (8 * c) * 33 + n;
        u32x4 o; o.x = pk2(p[0 * 33], p[1 * 33]); o.y = pk2(p[2 * 33], p[3 * 33]); o.z = pk2(p[4 * 33], p[5 * 33]); o.w = pk2(p[6 * 33], p[7 * 33]);
        *(u32x4*)(WT + (size_t)(n0 + n) * ldt + kcol0 + k0 + 8 * c) = o; }
    asm volatile("s_waitcnt lgkmcnt(0)" ::: "memory");
}
__device__ __forceinline__ void small_transpose(const float* src, int K, int N, bf16* dst, int ldt, int gt, int ngt) {
    for (int i = gt; i < N * K; i += ngt) { const int n = i / K, k = i - n * K; dst[(size_t)n * ldt + k] = (bf16)f2bf(src[(size_t)k * N + n]); }
}
__device__ __forceinline__ void p0_prologue(const Frame& F, int lmask, bool common, int wb, int nwb, int cls) {
    LAS float* scr = (LAS float*)(F.lds + F.wave * 16384);
    const int gw = wb * NWAVES + F.wave, NGW = nwb * NWAVES;
    constexpr int J_ADA = 32 * 384, J_IN = 32 * 320, J_CA = 16 * 64, J_CP = 8 * 64, J_CR = 8 * 64, J_O = 32 * 64, J_GU = 32 * 352, J_DN = 88 * 64;
    constexpr int PER_L = J_ADA + J_IN + J_CA + J_CP + J_CR + J_O + J_GU + J_DN;
    constexpr int TOT = NL * PER_L; const int nrk = cls == 0 ? TOT : cls == 1 ? (TOT / 32) * 27 + (TOT % 32 < 27 ? TOT % 32 : 27) : (TOT / 32) * 5 + (TOT % 32 > 27 ? TOT % 32 - 27 : 0);
    for (int rk = gw; rk < nrk; rk += NGW) {
        const int it = cls == 0 ? rk : cls == 1 ? (rk / 27) * 32 + rk % 27 : (rk / 5) * 32 + 27 + rk % 5;
        const int l = it / PER_L; int r = it - l * PER_L;
        if (r < J_ADA ? !common : !((lmask >> l) & 1)) continue;
        TSrc s; s.d2 = 0; s.mode = 0; bf16* WT; size_t ldt; int K, nn, kcol0 = 0;
        if (r < J_ADA) { s.w = INP(9) + (size_t)l * D * NADA; s.ld = NADA; WT = (bf16*)(F.ws + WS_ADAW) + (size_t)l * NADA * D; ldt = D; K = D; nn = 384; }
        else if ((r -= J_ADA) < J_IN) { s.w = INP(13) + (size_t)l * D * 10176; s.ld = 10176; s.mode = 1; WT = (bf16*)wl(F, l, WL_IN); ldt = D; K = D; nn = 320; }
        else if ((r -= J_IN) < J_CA) { s.w = INP(15) + (size_t)l * 1024 * D; s.ld = D; WT = (bf16*)wl(F, l, WL_CAT); ldt = D; K = 1024; nn = 64; }
        else if ((r -= J_CA) < J_CP) { s.w = INP(18) + (size_t)l * 512 * D; s.ld = D; WT = (bf16*)wl(F, l, WL_CAT); ldt = D; K = 512; nn = 64; kcol0 = 1024; }
        else if ((r -= J_CP) < J_CR) { s.w = INP(30) + (size_t)l * 512 * D; s.ld = D; WT = (bf16*)wl(F, l, WL_CAT); ldt = D; K = 512; nn = 64; kcol0 = 1536; }
        else if ((r -= J_CR) < J_O) { s.w = INP(34) + (size_t)l * D * D; s.ld = D; WT = (bf16*)wl(F, l, WL_O); ldt = D; K = D; nn = 64; }
        else if ((r -= J_O) < J_GU) { s.w = INP(35) + (size_t)l * D * DFF; s.d2 = (const char*)INP(36) - (const char*)INP(35); s.ld = DFF; s.mode = 2; WT = (bf16*)wl(F, l, WL_GU); ldt = D; K = D; nn = 352; }
        else { r -= J_GU; s.w = INP(37) + (size_t)l * DFF * D; s.ld = D; WT = (bf16*)wl(F, l, WL_DN); ldt = DFF; K = DFF; nn = 64; }
        (void)K;
        transpose_item(s, K, WT, ldt, kcol0, scr, r / nn, r % nn, F.lane);
    }
    const int gt = wb * NTHR + F.tid, ngt = nwb * NTHR;
    for (int l = 0; l < NL; ++l) { if (!((lmask >> l) & 1)) continue;
        small_transpose(INP(21) + (size_t)l * 96 * 512, 96, 512, (bf16*)wl(F, l, WL_W2), 96, gt, ngt);
        small_transpose(INP(23) + (size_t)l * 96 * 512, 96, 512, (bf16*)wl(F, l, WL_A2), 96, gt, ngt);
        small_transpose(INP(24) + (size_t)l * 256 * 512, 256, 512, (bf16*)wl(F, l, WL_G2), 256, gt, ngt);
        for (int g = 0; g < 4; ++g) small_transpose(INP(16) + ((size_t)l * 4 + g) * 128 * 128, 128, 128, (bf16*)wl(F, l, WL_PW) + g * 128 * 128, 128, gt, ngt);
    }
    if (lmask & 2) { small_transpose(INP(31), 512, 32, (bf16*)wl(F, 1, WL_V1), 512, gt, ngt);
        small_transpose(INP(32), 32, 512, (bf16*)wl(F, 1, WL_V2), 32, gt, ngt); }
    if (!common) return;
    if (wb == 0 && F.tid < 2) ((unsigned*)(F.ws + WS_CTL))[64 * F.tid] = 0u;
    for (int i = gt; i < 256 * D; i += ngt) { const int r = i >> 11, k = i & (D - 1); float v = 0.f;
        if (r < NMOD) { const float c = r < NB ? INP(2)[r * D + k] : INP(3)[(r - NB) * D + k]; v = c / (1.f + expf(-c)); }
        ((bf16*)(F.ws + WS_SILC))[i] = (bf16)f2bf(v); }
    for (int i = gt; i < 4097 * 32; i += ngt) { const int p = i >> 5, d = i & 31; const float pos = p < 4096 ? (float)p : (float)PASTLEN;
        const float inv = powf(10000.f, -(float)d * (2.0f / 64.f)), ang = pos * inv; float* t = (float*)(F.ws + WS_ROPE) + (size_t)p * 64; t[d] = cosf(ang); t[32 + d] = sinf(ang); }
}

__device__ __forceinline__ void norm_phase(const Frame& F, int l, int which  , int nslab  ) {
    const int gw = F.bid * NWAVES + F.wave, NGW = F.G * NWAVES;
    const float* g = which == 0 ? INP(11) + l * D : which == 1 ? INP(12) + l * D : INP(38); const float* xp0 = INP(0); const float* xp1 = INP(1);
    for (int m = gw; m < M; m += NGW) {
        const float* xr = (which == 0 && l == 0) ? (m < MP ? xp0 + (size_t)m * D : xp1 + (size_t)(m - MP) * D) : (const float*)(F.ws + WS_X) + (size_t)m * D;
        f32x4 v[8], gv[8], shv[8], scv[8]; float s = 0.f;
        const float* mod = (const float*)(F.ws + WS_MOD) + ((size_t)l * NMOD + modrow(m)) * NADA + (which == 0 ? 0 : 3 * D);
#pragma unroll
        for (int j = 0; j < 8; ++j) { v[j] = *(const f32x4*)(xr + j * 256 + F.lane * 4); gv[j] = *(const f32x4*)(g + j * 256 + F.lane * 4);
            if (which != 2) { shv[j] = *(const f32x4*)(mod + j * 256 + F.lane * 4); scv[j] = *(const f32x4*)(mod + D + j * 256 + F.lane * 4); } else { shv[j] = gv[j]; scv[j] = gv[j]; } }
        if (nslab && m >= MP) { const float* sl = (const float*)(F.ws + WS_SLAB) + (size_t)(m - MP) * D + F.lane * 4;
            for (int q = 0; q < nslab; ++q) {
#pragma unroll
                for (int j = 0; j < 8; ++j) v[j] += *(const f32x4*)(sl + (size_t)q * NS * D + j * 256); }
            float* xs = (float*)(F.ws + WS_X) + (size_t)m * D;
#pragma unroll
            for (int j = 0; j < 8; ++j) *(f32x4*)(xs + j * 256 + F.lane * 4) = v[j]; }
#pragma unroll
        for (int j = 0; j < 8; ++j) { s += (v[j].x * v[j].x + v[j].y * v[j].y) + (v[j].z * v[j].z + v[j].w * v[j].w); }
        const float rs = rsqrtf(wave_sum(s) * (1.f / D) + 1e-6f);
        if (which == 0 && l == 0 && m >= MP) { float* xs = (float*)(F.ws + WS_X) + (size_t)m * D;
#pragma unroll
            for (int j = 0; j < 8; ++j) *(f32x4*)(xs + j * 256 + F.lane * 4) = v[j]; }
        if (which == 2) { float* o = F.out + O_YP + (size_t)m * D;
#pragma unroll
            for (int j = 0; j < 8; ++j) *(f32x4*)(o + j * 256 + F.lane * 4) = v[j] * rs * gv[j]; }
        else { bf16* o = (bf16*)(F.ws + WS_H) + (size_t)m * D;
#pragma unroll
            for (int j = 0; j < 8; ++j) { const int c = j * 256 + F.lane * 4; const f32x4 y = v[j] * rs * gv[j] * (scv[j] + 1.f) + shv[j]; u32x2 w; w.x = pk2(y.x, y.y); w.y = pk2(y.z, y.w); *(u32x2*)(o + c) = w; } }
    }
}
}
#ifdef MK_TS_ID
#ifndef MK_TS_BLOCK
#define MK_TS_BLOCK 0
#endif
#define TSB2(id, ldsp) do { if ((id) == MK_TS_ID && blockIdx.x == MK_TS_BLOCK && threadIdx.x == 0) *(volatile __attribute__((address_space(3))) unsigned*)((ldsp) + 135168 - 64) -= (unsigned)__builtin_amdgcn_s_memrealtime(); } while (0)
#define TSE2(id, ldsp) do { if ((id) == MK_TS_ID && blockIdx.x == MK_TS_BLOCK && threadIdx.x == 0) *(volatile __attribute__((address_space(3))) unsigned*)((ldsp) + 135168 - 64) += (unsigned)__builtin_amdgcn_s_memrealtime(); } while (0)
#else
#define TSB2(id, ldsp) do {} while (0)
#define TSE2(id, ldsp) do {} while (0)
#endif
namespace mk {
constexpr int BM = 256, BK = 64, HALF = 128, HTB = HALF * BK * 2, STAGE_BYTES = 8 * HTB, NXCD = 8, WGM = 8;
__device__ __forceinline__ int lds_byte(int r, int c) { const int st = (r >> 4) * 2 + (c >> 5), rr = r & 15, cc = c & 31, ob = rr * 64 + cc * 2; return st * 1024 + (ob ^ (((ob >> 9) & 1) << 5)); }
__device__ __forceinline__ void stage_rc(int b, int& R, int& C) { const int st = b / 1024, sb = b % 1024, swz = sb ^ (((sb >> 9) & 1) << 5); R = (st >> 1) * 16 + swz / 64; C = (st & 1) * 32 + (swz % 64) / 2; }
__device__ __forceinline__ int perm32(int rho) { const int n = rho >> 4, i = rho & 15; return 8 * (i >> 2) + 4 * n + (i & 3); }

struct Unit { int pm, pn, seg; };
enum { G_ADA = 0, G_IN, G_MG, G_WO, G_GU, G_DN };
struct Gemm { const bf16* A; const bf16* Bt; int ld, M, N, K, mode, layer; };

struct Rect { int pm0, nM, pn0, nN; };
struct Sched {
    Rect ra, rb; int G, c, nseg, ksb;
    __device__ __forceinline__ void init(const Rect& a, const Rect& b, int G_, int c_, int nseg_, int ksb_ = 0) { ra = a; rb = b; G = G_; c = c_; nseg = nseg_; ksb = ksb_; }
    __device__ __forceinline__ bool next(int i, Unit& u) const {
        const int ti = i / nseg, seg = i - ti * nseg, nA = ra.nM * ra.nN, nB = rb.nM * rb.nN;
        const long L = (long)ti * G + c; if (L >= nA + nB) return false;
        const bool inA = L < nA; const int pm0 = inA ? ra.pm0 : rb.pm0, nM = inA ? ra.nM : rb.nM, pn0 = inA ? ra.pn0 : rb.pn0, nN = inA ? ra.nN : rb.nN, nwg = nM * nN;
        int wgid = inA ? (int)L : (int)L - nA; { const int q = nwg / NXCD, r = nwg % NXCD, xcd = wgid % NXCD, off = wgid / NXCD; wgid = (xcd < r ? xcd * (q + 1) : r * (q + 1) + (xcd - r) * q) + off; }
        const int nig = WGM * nN, gid = wgid / nig, fm = gid * WGM, gsz = (nM - fm) < WGM ? (nM - fm) : WGM;
        u.pm = pm0 + fm + ((wgid % nig) % gsz); u.pn = pn0 + (wgid % nig) / gsz; u.seg = seg;
        if (!inA && ksb > 0) { const int q = u.pn - pn0; u.seg = q / ksb; u.pn = pn0 + q % ksb; }
        return true;
    }
};

typedef __bf16 bf16x2_t __attribute__((ext_vector_type(2)));
__device__ __forceinline__ unsigned cvt_pk_bf16(float lo, float hi) { const f32x2 v = {lo, hi}; const bf16x2_t b = __builtin_convertvector(v, bf16x2_t); return __builtin_bit_cast(unsigned, b); }
__device__ __forceinline__ f32x4 sig4(f32x4 v) { f32x4 r; r.x = fsigm(v.x); r.y = fsigm(v.y); r.z = fsigm(v.z); r.w = fsigm(v.w); return r; }

__device__ __forceinline__ float gclamp(float g) { return fmaxf(g, 1e-18f); }
struct Epi {
    const Frame* F; int mode, layer;
    __device__ __forceinline__ void rescale(f32x4 (&acc)[2][2][4][2], const Unit& u, int sp, int wr, int wc, int fr, int fq) const {
        int row0 = u.pm * BM + wr * 64 + fr; asm volatile("" : "+v"(row0)); const int c0 = u.pn * BM + wc * 32 + 8 * fq; const bf16* gt = (const bf16*)(F->ws + WS_GT) + sp * D + c0;
#pragma unroll
        for (int ai = 0; ai < 2; ++ai)
#pragma unroll
            for (int m = 0; m < 4; ++m) { const int r = row0 + ai * HALF + m * 16; const int rr = r < M ? r : M - 1;
#pragma unroll
                for (int bj = 0; bj < 2; ++bj) { const u32x4 ga = *(const u32x4*)(gt + (size_t)rr * 6144 + bj * HALF), gb = *(const u32x4*)(gt + (size_t)rr * 6144 + D + bj * HALF);
                    f32x4& v0 = acc[ai][bj][m][0]; f32x4& v1 = acc[ai][bj][m][1];
                    v0.x *= gclamp(bflo(ga.x)) * __builtin_amdgcn_rcpf(gclamp(bflo(gb.x))); v0.y *= gclamp(bfhi(ga.x)) * __builtin_amdgcn_rcpf(gclamp(bfhi(gb.x)));
                    v0.z *= gclamp(bflo(ga.y)) * __builtin_amdgcn_rcpf(gclamp(bflo(gb.y))); v0.w *= gclamp(bfhi(ga.y)) * __builtin_amdgcn_rcpf(gclamp(bfhi(gb.y)));
                    v1.x *= gclamp(bflo(ga.z)) * __builtin_amdgcn_rcpf(gclamp(bflo(gb.z))); v1.y *= gclamp(bfhi(ga.z)) * __builtin_amdgcn_rcpf(gclamp(bfhi(gb.z)));
                    v1.z *= gclamp(bflo(ga.w)) * __builtin_amdgcn_rcpf(gclamp(bflo(gb.w))); v1.w *= gclamp(bfhi(ga.w)) * __builtin_amdgcn_rcpf(gclamp(bfhi(gb.w))); }
                if (m & 1) asm volatile("" ::: "memory"); }
    }
    __device__ __forceinline__ void operator()(const f32x4 (&acc)[2][2][4][2], const Unit& u, int wr, int wc, int fr, int fq) const {
        const Frame& Fr = *F; const int l = layer;
        int row0 = u.pm * BM + wr * 64 + fr; const int colb = u.pn * BM + wc * 32 + 8 * fq;
        asm volatile("" : "+v"(row0));
        unsigned char* ws = Fr.ws;
        if (mode == G_ADA) {
            const float* ab = INP(10);
#pragma unroll
            for (int ai = 0; ai < 2; ++ai)
#pragma unroll
                for (int m = 0; m < 4; ++m) { const int r = row0 + ai * HALF + m * 16; if (r < NMOD) {
#pragma unroll
                    for (int bj = 0; bj < 2; ++bj) { const int c = colb + bj * HALF, ll = c / NADA, j = c - ll * NADA; float* o = (float*)(ws + WS_MOD) + ((size_t)ll * NMOD + r) * NADA + j;
                        *(f32x4*)o = acc[ai][bj][m][0] + *(const f32x4*)(ab + c); *(f32x4*)(o + 4) = acc[ai][bj][m][1] + *(const f32x4*)(ab + c + 4); } } }
        } else if (mode == G_IN) {
            const int pn = u.pn;
            if (pn < 5) {
                const int wp = wc & 1; const float* rt = (const float*)(ws + WS_ROPE);
#pragma unroll
                for (int ai = 0; ai < 2; ++ai)
#pragma unroll
                    for (int m = 0; m < 4; ++m) { const int r = row0 + ai * HALF + m * 16; if (r < M) {
                        const float* tp = rt + (size_t)posidx(r) * 64 + 16 * wp + 4 * fq; const f32x4 cs = *(const f32x4*)tp, sn = *(const f32x4*)(tp + 32);
#pragma unroll
                        for (int bj = 0; bj < 2; ++bj) { const f32x4 x1 = acc[ai][bj][m][0], x2 = acc[ai][bj][m][1]; const f32x4 o1 = x1 * cs - x2 * sn, o2 = x2 * cs + x1 * sn;
                            u32x4 w; w.x = cvt_pk_bf16(o1.x, o1.y); w.y = cvt_pk_bf16(o1.z, o1.w); w.z = cvt_pk_bf16(o2.x, o2.y); w.w = cvt_pk_bf16(o2.z, o2.w);
                            const int hc = bj * HALF + wc * 32 + 8 * fq;
                            if (pn < 4) *(u32x4*)((bf16*)(ws + WS_Q) + (size_t)r * 1024 + pn * 256 + hc) = w;
                            else { *(u32x4*)((bf16*)(ws + WS_K) + (size_t)r * 256 + hc) = w;
                                const int hk = hc >> 6, d1 = 16 * wp + 4 * fq; float* ko = nullptr;
                                if (r < MP) { const int t = r & (SEQ - 1); if (t >= SEQ - 128) ko = Fr.out + O_KP + ((((size_t)l * NB + (r >> 12)) * 128 + (t - (SEQ - 128))) * 4 + hk) * 64; }
                                else ko = Fr.out + O_KS + ((((size_t)l * NS + (r - MP)) * 128 + 127) * 4 + hk) * 64;
                                if (ko) { *(f32x4*)(ko + d1) = o1; *(f32x4*)(ko + d1 + 32) = o2; } } } } }
            } else if (pn == 5) {
#pragma unroll
                for (int ai = 0; ai < 2; ++ai)
#pragma unroll
                    for (int m = 0; m < 4; ++m) { const int r = row0 + ai * HALF + m * 16; if (r < M) {
#pragma unroll
                        for (int bj = 0; bj < 2; ++bj) { const f32x4 v0 = acc[ai][bj][m][0], v1 = acc[ai][bj][m][1]; const int hc = bj * HALF + wc * 32 + 8 * fq;
                            u32x4 w; w.x = cvt_pk_bf16(v0.x, v0.y); w.y = cvt_pk_bf16(v0.z, v0.w); w.z = cvt_pk_bf16(v1.x, v1.y); w.w = cvt_pk_bf16(v1.z, v1.w);
                            *(u32x4*)((bf16*)(ws + WS_V) + (size_t)r * 256 + hc) = w;
                            float* vo = nullptr;
                            if (r < MP) { const int t = r & (SEQ - 1); if (t >= SEQ - 128) vo = Fr.out + O_VP + (((size_t)l * NB + (r >> 12)) * 128 + (t - (SEQ - 128))) * 256; }
                            else vo = Fr.out + O_VS + (((size_t)l * NS + (r - MP)) * 128 + 127) * 256;
                            if (vo) { *(f32x4*)(vo + hc) = v0; *(f32x4*)(vo + hc + 4) = v1; } } } }
            } else if (pn < 16) {
                float* base = pn < 8 ? (float*)(ws + WS_U) : (float*)(ws + WS_PR); const int ld = pn < 8 ? 512 : 2048, c0 = (pn < 8 ? (pn - 6) : (pn - 8)) * 256 + wc * 32 + 8 * fq;
#pragma unroll
                for (int ai = 0; ai < 2; ++ai)
#pragma unroll
                    for (int m = 0; m < 4; ++m) { const int r = row0 + ai * HALF + m * 16; if (r < M) {
#pragma unroll
                        for (int bj = 0; bj < 2; ++bj) { float* o = base + (size_t)r * ld + c0 + bj * HALF; *(f32x4*)o = acc[ai][bj][m][0]; *(f32x4*)(o + 4) = acc[ai][bj][m][1]; } } }
            } else {
                const int c0 = (pn - 16) * 256 + wc * 32 + 8 * fq;
#pragma unroll
                for (int ai = 0; ai < 2; ++ai)
#pragma unroll
                    for (int m = 0; m < 4; ++m) { const int r = row0 + ai * HALF + m * 16; if (r < M) {
#pragma unroll
                        for (int bj = 0; bj < 2; ++bj) { const f32x4 v0 = sig4(acc[ai][bj][m][0]), v1 = sig4(acc[ai][bj][m][1]);
                            u32x4 w; w.x = cvt_pk_bf16(v0.x, v0.y); w.y = cvt_pk_bf16(v0.z, v0.w); w.z = cvt_pk_bf16(v1.x, v1.y); w.w = cvt_pk_bf16(v1.z, v1.w);
                            *(u32x4*)((bf16*)(ws + WS_GT) + (size_t)r * 6144 + c0 + bj * HALF) = w; } } }
            }
        } else if (mode == G_MG && u.pm == MPAD / BM - 1) {
            const int c0 = u.pn * BM + wc * 32 + 8 * fq, br = u.seg < 2 ? 0 : u.seg - 1;
#pragma unroll
            for (int m = 0; m < 4; ++m) { const int r = row0 + m * 16; if (r < M) { float* so = (float*)(ws + WS_SLABM) + ((size_t)u.seg * NS + (r - MP)) * D;
#pragma unroll
                for (int bj = 0; bj < 2; ++bj) { const int c = c0 + bj * HALF; const u32x4 gw = *(const u32x4*)((const bf16*)(ws + WS_GT) + (size_t)r * 6144 + br * D + c);
                    f32x4 v0 = acc[0][bj][m][0], v1 = acc[0][bj][m][1];
                    v0.x *= gclamp(bflo(gw.x)); v0.y *= gclamp(bfhi(gw.x)); v0.z *= gclamp(bflo(gw.y)); v0.w *= gclamp(bfhi(gw.y)); v1.x *= gclamp(bflo(gw.z)); v1.y *= gclamp(bfhi(gw.z)); v1.z *= gclamp(bflo(gw.w)); v1.w *= gclamp(bfhi(gw.w));
                    *(f32x4*)(so + c) = v0; *(f32x4*)(so + c + 4) = v1; } } }
        } else if (mode == G_MG) {
            const int c0 = u.pn * BM + wc * 32 + 8 * fq;
#pragma unroll
            for (int ai = 0; ai < 2; ++ai)
#pragma unroll
                for (int m = 0; m < 4; ++m) { const int r = row0 + ai * HALF + m * 16; if (r < M) {
#pragma unroll
                    for (int bj = 0; bj < 2; ++bj) { const int c = c0 + bj * HALF; const u32x4 gw = *(const u32x4*)((const bf16*)(ws + WS_GT) + (size_t)r * 6144 + 2 * D + c);
                        f32x4 v0 = acc[ai][bj][m][0], v1 = acc[ai][bj][m][1];
                        v0.x *= gclamp(bflo(gw.x)); v0.y *= gclamp(bfhi(gw.x)); v0.z *= gclamp(bflo(gw.y)); v0.w *= gclamp(bfhi(gw.y)); v1.x *= gclamp(bflo(gw.z)); v1.y *= gclamp(bfhi(gw.z)); v1.z *= gclamp(bflo(gw.w)); v1.w *= gclamp(bfhi(gw.w));
                        u32x4 w; w.x = cvt_pk_bf16(v0.x, v0.y); w.y = cvt_pk_bf16(v0.z, v0.w); w.z = cvt_pk_bf16(v1.x, v1.y); w.w = cvt_pk_bf16(v1.z, v1.w); *(u32x4*)((bf16*)(ws + WS_MG) + (size_t)r * D + c) = w; } } }
        } else if (mode == G_WO || mode == G_DN) {
            const int c0 = u.pn * BM + wc * 32 + 8 * fq; const int goff = mode == G_WO ? 2 * D : 5 * D;
            if (u.pm == MPAD / BM - 1) {
#pragma unroll
                for (int m = 0; m < 4; ++m) { const int r = row0 + m * 16; if (r < M) {
                    const float* gp = (const float*)(ws + WS_MOD) + ((size_t)l * NMOD + modrow(r)) * NADA + goff; float* so = (float*)(ws + WS_SLAB) + ((size_t)u.seg * NS + (r - MP)) * D;
#pragma unroll
                    for (int bj = 0; bj < 2; ++bj) { const int c = c0 + bj * HALF; const f32x4 g0 = *(const f32x4*)(gp + c), g1 = *(const f32x4*)(gp + c + 4);
                        *(f32x4*)(so + c) = (g0 + 1.f) * acc[0][bj][m][0]; *(f32x4*)(so + c + 4) = (g1 + 1.f) * acc[0][bj][m][1]; } } }
            } else {
                const float* gp = (const float*)(ws + WS_MOD) + ((size_t)l * NMOD + (u.pm >> 4)) * NADA + goff + c0;
                const f32x4 ga0 = *(const f32x4*)gp + 1.f, ga1 = *(const f32x4*)(gp + 4) + 1.f, gb0 = *(const f32x4*)(gp + HALF) + 1.f, gb1 = *(const f32x4*)(gp + HALF + 4) + 1.f;
                const float* xbase = (mode == G_WO && l == 0) ? INP(0) : (const float*)(ws + WS_X); float* xob = (float*)(ws + WS_X);
#pragma unroll
                for (int am = 0; am < 8; am += 2) { f32x4 xv[2][4];
#pragma unroll
                    for (int q = 0; q < 2; ++q) { const int ai = (am + q) >> 2, m = (am + q) & 3; const float* xin = xbase + (size_t)(row0 + ai * HALF + m * 16) * D + c0;
                        xv[q][0] = *(const f32x4*)xin; xv[q][1] = *(const f32x4*)(xin + 4); xv[q][2] = *(const f32x4*)(xin + HALF); xv[q][3] = *(const f32x4*)(xin + HALF + 4); }
#pragma unroll
                    for (int q = 0; q < 2; ++q) { const int ai = (am + q) >> 2, m = (am + q) & 3; float* xo = xob + (size_t)(row0 + ai * HALF + m * 16) * D + c0;
                        *(f32x4*)xo = xv[q][0] + ga0 * acc[ai][0][m][0]; *(f32x4*)(xo + 4) = xv[q][1] + ga1 * acc[ai][0][m][1];
                        *(f32x4*)(xo + HALF) = xv[q][2] + gb0 * acc[ai][1][m][0]; *(f32x4*)(xo + HALF + 4) = xv[q][3] + gb1 * acc[ai][1][m][1]; }
                    asm volatile("" ::: "memory"); }
            }
        } else {
            const int c0 = u.pn * 128 + wc * 16 + 4 * fq;
#pragma unroll
            for (int ai = 0; ai < 2; ++ai)
#pragma unroll
                for (int m = 0; m < 4; ++m) { const int r = row0 + ai * HALF + m * 16; if (r < M) {
#pragma unroll
                    for (int bj = 0; bj < 2; ++bj) { const f32x4 g = acc[ai][bj][m][0], up = acc[ai][bj][m][1]; const f32x4 a = g * sig4(g) * up;
                        u32x2 w; w.x = cvt_pk_bf16(a.x, a.y); w.y = cvt_pk_bf16(a.z, a.w); *(u32x2*)((bf16*)(ws + WS_GT) + (size_t)r * DFF + c0 + bj * 64) = w; } } }
        }
    }
};

__device__ __forceinline__ void gemm_phase(LAS unsigned char* lds, const Gemm g, const Sched& S, const Epi& E, const int tid  ) {
    const int wid = __builtin_amdgcn_readfirstlane(tid >> 6), lane = tid & 63, wr = wid >> 2, wc = wid & 3, fr = lane & 15, fq = lane >> 4;
    unsigned voffA[2], voffB[2];
#pragma unroll
    for (int i = 0; i < 2; ++i) { int R, C; stage_rc(tid * 16 + i * 8192, R, C); const int Rb = (R & ~31) + perm32(R & 31);
        voffA[i] = (unsigned)(R * g.ld + C) * 2u; voffB[i] = (unsigned)(Rb * g.ld + C) * 2u; }
    constexpr unsigned kstep = BK * 2;
    const unsigned hstep = (unsigned)HALF * (unsigned)g.ld * 2u; const bool mgd = g.mode == G_MG; const int ntfull = g.K / BK;
    const bool ksd = g.mode == G_WO || g.mode == G_DN || g.mode == G_MG;
#define PG8_KS(u) (ksd && (u).pm == MPAD / BM - 1)
#define PG8_KA(u) (PG8_KS(u) ? (unsigned)(u).seg * 512u : 0u)
#define PG8_NT(u) (PG8_KS(u) ? 8 : ntfull)
#define PG8_TILE(p, u) (((unsigned)(p) * (unsigned)BM * (unsigned)g.ld + PG8_KA(u)) * 2u)
    const unsigned ldsw = (unsigned)wid * 1024u;
    const int aoff = lds_byte(wr * 64 + fr, fq * 8), boff = lds_byte(wc * 32 + fr, fq * 8);
#define PG8_SA(b, h) (((b) * 2 + (h)) * HTB)
#define PG8_SB(b, h) ((4 + (b) * 2 + (h)) * HTB)
#define PG8_STAGE(bufoff, gbase, soff, voff) do { _Pragma("unroll") for (int _i = 0; _i < 2; ++_i) \
        __builtin_amdgcn_global_load_lds((const unsigned*)((const char*)(gbase) + (size_t)((voff)[_i] + (unsigned)(soff))), (LAS unsigned*)(lds + (bufoff) + ldsw + _i * 8192), 16, 0, 0); } while (0)
#define PG8_STA(bufoff, soff) PG8_STAGE(bufoff, g.A, soff, voffA)
#define PG8_STB(bufoff, soff) PG8_STAGE(bufoff, g.Bt, soff, voffB)
#define PG8_LDA(dst, b, h) do { _Pragma("unroll") for (int m = 0; m < 4; ++m) _Pragma("unroll") for (int k = 0; k < 2; ++k) dst[m][k] = *(const LAS bf16x8*)(lds + PG8_SA(b, h) + aoff + m * 2048 + k * 1024); } while (0)
#define PG8_LDB(dst, b, h) do { _Pragma("unroll") for (int n = 0; n < 2; ++n) _Pragma("unroll") for (int k = 0; k < 2; ++k) dst[n][k] = *(const LAS bf16x8*)(lds + PG8_SB(b, h) + boff + n * 2048 + k * 1024); } while (0)
#define PG8_MMA(ai, bj, At, Bt) do { __builtin_amdgcn_s_setprio(1); _Pragma("unroll") for (int m = 0; m < 4; ++m) _Pragma("unroll") for (int n = 0; n < 2; ++n) _Pragma("unroll") for (int k = 0; k < 2; ++k) \
        acc[ai][bj][m][n] = __builtin_amdgcn_mfma_f32_16x16x32_bf16(Bt[n][k], At[m][k], acc[ai][bj][m][n], 0, 0, 0); __builtin_amdgcn_s_setprio(0); } while (0)
#define PG8_WAIT_V(n) asm volatile("s_waitcnt vmcnt(" #n ")" ::: "memory")
#define PG8_WAIT_L(n) asm volatile("s_waitcnt lgkmcnt(" #n ")" ::: "memory")
#define PG8_BAR __builtin_amdgcn_s_barrier()
#define PG8_SCHED __builtin_amdgcn_sched_barrier(0)
    Unit cur, nxt; int ui = 0;
    if (!S.next(0, cur)) return;
    f32x4 acc[2][2][4][2];
#pragma unroll
    for (int a = 0; a < 2; ++a)
#pragma unroll
        for (int b = 0; b < 2; ++b)
#pragma unroll
            for (int m = 0; m < 4; ++m)
#pragma unroll
                for (int n = 0; n < 2; ++n) acc[a][b][m][n] = (f32x4){0.f, 0.f, 0.f, 0.f};
    bf16x8 At[4][2], B0[2][2], B1[2][2];
    unsigned cA = PG8_TILE(cur.pm, cur), cB = PG8_TILE(cur.pn, cur);
    PG8_STB(PG8_SB(0, 0), cB); PG8_STB(PG8_SB(0, 1), cB + hstep); PG8_STA(PG8_SA(0, 0), cA); PG8_STA(PG8_SA(0, 1), cA + hstep);
    if (wr == 1) PG8_BAR;
    PG8_WAIT_V(2); PG8_BAR;
    PG8_STB(PG8_SB(1, 0), cB + kstep); PG8_STA(PG8_SA(1, 0), cA + kstep); PG8_STB(PG8_SB(1, 1), cB + hstep + kstep);
    PG8_WAIT_V(6); PG8_BAR;
    for (;;) {
        const bool has_next = S.next(ui + 1, nxt);
        const unsigned nA = has_next ? PG8_TILE(nxt.pm, nxt) : cA, nB = has_next ? PG8_TILE(nxt.pn, nxt) : cB;
        const int nt = PG8_NT(cur);
        TSB2(50 + 2 * g.mode, lds);
        for (int t = 0; t < nt; t += 2) {
            const bool last = (t == nt - 2);
            if (mgd && !PG8_KS(cur) && (t == 16 || t == 24)) E.rescale(acc, cur, t == 16 ? 0 : 1, wr, wc, fr, fq);
            const unsigned a1 = cA + (unsigned)(t + 1) * kstep;
            const unsigned a2 = last ? nA : cA + (unsigned)(t + 2) * kstep, b2 = last ? nB : cB + (unsigned)(t + 2) * kstep;
            const unsigned a3 = a2 + kstep, b3 = b2 + kstep;
            PG8_LDB(B0, 0, 0); PG8_LDB(B1, 0, 1); PG8_SCHED; PG8_LDA(At, 0, 0); PG8_STA(PG8_SA(1, 1), a1 + hstep);
            PG8_WAIT_V(8); PG8_WAIT_L(0); PG8_BAR; PG8_MMA(0, 0, At, B0); PG8_MMA(0, 1, At, B1); PG8_BAR; PG8_SCHED;
            PG8_LDA(At, 0, 1); PG8_STB(PG8_SB(0, 0), b2); PG8_STB(PG8_SB(0, 1), b2 + hstep); PG8_STA(PG8_SA(0, 0), a2);
            PG8_WAIT_V(8); PG8_WAIT_L(0); PG8_BAR; PG8_MMA(1, 0, At, B0); PG8_MMA(1, 1, At, B1); PG8_BAR; PG8_SCHED;
            PG8_LDB(B0, 1, 0); PG8_LDB(B1, 1, 1); PG8_SCHED; PG8_LDA(At, 1, 0); PG8_STA(PG8_SA(0, 1), a2 + hstep);
            PG8_WAIT_V(8); PG8_WAIT_L(0); PG8_BAR; PG8_MMA(0, 0, At, B0); PG8_MMA(0, 1, At, B1); PG8_BAR; PG8_SCHED;
            PG8_LDA(At, 1, 1); PG8_STB(PG8_SB(1, 0), b3); PG8_STB(PG8_SB(1, 1), b3 + hstep); PG8_STA(PG8_SA(1, 0), a3);
            PG8_WAIT_V(8); PG8_WAIT_L(0); PG8_BAR; PG8_MMA(1, 0, At, B0); PG8_MMA(1, 1, At, B1); PG8_BAR; PG8_SCHED;
        }
        if (wr == 0) PG8_BAR;
        TSE2(50 + 2 * g.mode, lds);
        TSB2(51 + 2 * g.mode, lds); E(acc, cur, wr, wc, fr, fq); TSE2(51 + 2 * g.mode, lds);
        if (!has_next) break;
#pragma unroll
        for (int a = 0; a < 2; ++a)
#pragma unroll
            for (int b = 0; b < 2; ++b)
#pragma unroll
                for (int m = 0; m < 4; ++m)
#pragma unroll
                    for (int n = 0; n < 2; ++n) acc[a][b][m][n] = (f32x4){0.f, 0.f, 0.f, 0.f};
        cur = nxt; cA = nA; cB = nB; ++ui;
        if (wr == 1) PG8_BAR;
    }
    PG8_WAIT_V(0);
    PG8_BAR;
#undef PG8_KS
#undef PG8_KA
#undef PG8_NT
#undef PG8_TILE
#undef PG8_STA
#undef PG8_STB
#undef PG8_SA
#undef PG8_SB
#undef PG8_STAGE
#undef PG8_LDA
#undef PG8_LDB
#undef PG8_MMA
#undef PG8_WAIT_V
#undef PG8_WAIT_L
#undef PG8_BAR
#undef PG8_SCHED
}
}
namespace mk {
#define MFMA16(a, b, c) __builtin_amdgcn_mfma_f32_16x16x32_bf16((a), (b), (c), 0, 0, 0)
__device__ __forceinline__ bf16x8 pack8(f32x4 a, f32x4 b) { u32x4 w; w.x = cvt_pk_bf16(a.x, a.y); w.y = cvt_pk_bf16(a.z, a.w); w.z = cvt_pk_bf16(b.x, b.y); w.w = cvt_pk_bf16(b.z, b.w); return __builtin_bit_cast(bf16x8, w); }
typedef short s16x4 __attribute__((ext_vector_type(4)));
__device__ __forceinline__ bf16x8 cat44(s16x4 a, s16x4 b) { return (bf16x8){a[0], a[1], a[2], a[3], b[0], b[1], b[2], b[3]}; }
constexpr float LOG2E = 1.4426950408889634f;

constexpr int AK_STRIDE = 144, AV_STRIDE = 560;
constexpr int A_KOFF = 0, A_VOFF = 256 * AK_STRIDE, A_BYTES = A_VOFF + 64 * AV_STRIDE;
__device__ __forceinline__ void attn_prompt_unit(const Frame& F, int l, int b, int blk, int hk) {
    LAS unsigned char* Ks = F.lds + A_KOFF; LAS unsigned char* Vt = F.lds + A_VOFF;
    const bf16* Kg = (const bf16*)(F.ws + WS_K); const bf16* Vg = (const bf16*)(F.ws + WS_V); const bf16* Qg = (const bf16*)(F.ws + WS_Q);
    const int kp0 = blk * 128 - 128;
#pragma unroll
    for (int ch = F.tid; ch < 2048; ch += NTHR) { const int i = ch >> 3, dc = ch & 7, kp = kp0 + i;
        u32x4 kv = (u32x4){0u, 0u, 0u, 0u}, vv = kv;
        if (kp >= 0) { const size_t m = (size_t)b * SEQ + kp; kv = *(const u32x4*)(Kg + m * 256 + hk * 64 + dc * 8); vv = *(const u32x4*)(Vg + m * 256 + hk * 64 + dc * 8); }
        *(LAS u32x4*)(Ks + i * AK_STRIDE + dc * 16) = kv;
        LAS unsigned short* vp = (LAS unsigned short*)(Vt + (dc * 8) * AV_STRIDE) + i;
        vp[0 * (AV_STRIDE / 2)] = (unsigned short)(vv.x & 0xffff); vp[1 * (AV_STRIDE / 2)] = (unsigned short)(vv.x >> 16); vp[2 * (AV_STRIDE / 2)] = (unsigned short)(vv.y & 0xffff); vp[3 * (AV_STRIDE / 2)] = (unsigned short)(vv.y >> 16);
        vp[4 * (AV_STRIDE / 2)] = (unsigned short)(vv.z & 0xffff); vp[5 * (AV_STRIDE / 2)] = (unsigned short)(vv.z >> 16); vp[6 * (AV_STRIDE / 2)] = (unsigned short)(vv.w & 0xffff); vp[7 * (AV_STRIDE / 2)] = (unsigned short)(vv.w >> 16); }
    for (int i = F.tid; i < 64 * 24; i += NTHR) { const int d = i / 24, c = i % 24; ((LAS unsigned short*)(Vt + d * AV_STRIDE))[256 + c] = 0; }
    const int g = F.lane >> 4, c16 = F.lane & 15;
    const float* sinkp = INP(14) + l * 16;
    bf16x8 q0n, q1n;
    { const int gi = F.wave * 4, hq = hk * 4 + (gi >> 3), qs = gi & 7; const size_t mq = (size_t)b * SEQ + blk * 128 + 16 * qs + c16;
      q0n = *(const bf16x8*)(Qg + mq * 1024 + hq * 64 + 8 * g); q1n = *(const bf16x8*)(Qg + mq * 1024 + hq * 64 + 32 + 8 * g); }
    __syncthreads();
#pragma unroll 1
    for (int it = 0; it < 4; ++it) {
        const int gi = F.wave * 4 + it, hq = hk * 4 + (gi >> 3), qs = gi & 7;
        const int tqr = 16 * qs + c16;
        const size_t mq = (size_t)b * SEQ + blk * 128 + tqr;
        const bf16x8 q0 = q0n, q1 = q1n;
        if (it < 3) { const int gn = gi + 1, hn = hk * 4 + (gn >> 3), qn_ = gn & 7; const size_t mn = (size_t)b * SEQ + blk * 128 + 16 * qn_ + c16;
            q0n = *(const bf16x8*)(Qg + mn * 1024 + hn * 64 + 8 * g); q1n = *(const bf16x8*)(Qg + mn * 1024 + hn * 64 + 32 + 8 * g); }
        f32x4 s[10];
#pragma unroll
        for (int j = 0; j < 9; ++j) { LAS const unsigned char* kr = Ks + (16 * (qs + j) + c16) * AK_STRIDE + 16 * g;
            const bf16x8 k0 = *(LAS const bf16x8*)kr, k1 = *(LAS const bf16x8*)(kr + 64);
            f32x4 a = (f32x4){0.f, 0.f, 0.f, 0.f}; a = MFMA16(k0, q0, a); a = MFMA16(k1, q1, a); s[j] = a; }
        const float sk2 = sinkp[hq] * LOG2E; float mx = sk2;
#pragma unroll
        for (int j = 0; j < 9; ++j)
#pragma unroll
            for (int r = 0; r < 4; ++r) { const int i = 16 * (qs + j) + 4 * g + r; const bool ok = (i >= tqr) && (i <= tqr + 128) && (kp0 + i >= 0);
                const float v = ok ? s[j][r] * (0.125f * LOG2E) : -1e30f; s[j][r] = v; mx = fmaxf(mx, v); }
        mx = fmaxf(mx, __shfl_xor(mx, 16)); mx = fmaxf(mx, __shfl_xor(mx, 32));
        float sum = 0.f;
#pragma unroll
        for (int j = 0; j < 9; ++j)
#pragma unroll
            for (int r = 0; r < 4; ++r) { const float p = __builtin_amdgcn_exp2f(s[j][r] - mx); s[j][r] = p; sum += p; }
        s[9] = (f32x4){0.f, 0.f, 0.f, 0.f};
        sum += __shfl_xor(sum, 16); sum += __shfl_xor(sum, 32);
        const float rl = 1.f / (sum + __builtin_amdgcn_exp2f(sk2 - mx));
        f32x4 o[4];
#pragma unroll
        for (int dt = 0; dt < 4; ++dt) o[dt] = (f32x4){0.f, 0.f, 0.f, 0.f};
#pragma unroll
        for (int kk = 0; kk < 5; ++kk) { const bf16x8 pf = pack8(s[2 * kk], s[2 * kk + 1]);
#pragma unroll
            for (int dt = 0; dt < 4; ++dt) { LAS const unsigned char* vr = Vt + (16 * dt + c16) * AV_STRIDE + (16 * (qs + 2 * kk) + 4 * g) * 2;
                const s16x4 v0 = *(LAS const s16x4*)vr, v1 = *(LAS const s16x4*)(vr + 32);
                o[dt] = MFMA16(cat44(v0, v1), pf, o[dt]); } }
        bf16* op = (bf16*)(F.ws + WS_CAT) + mq * D + hq * 64 + 4 * g;
#pragma unroll
        for (int dt = 0; dt < 4; ++dt) { const f32x4 v = o[dt] * rl; u32x2 w; w.x = cvt_pk_bf16(v.x, v.y); w.y = cvt_pk_bf16(v.z, v.w); *(u32x2*)(op + 16 * dt) = w; }
    }
    __syncthreads();
}

__device__ __forceinline__ void attn_sample_unit(const Frame& F, int l, int s_, int hf) {
    LAS float* qn = (LAS float*)F.lds;
    LAS float* kn = qn + 512;
    LAS float* vn = kn + 128;
    LAS float* sc = vn + 128;
    LAS float* rl = sc + 8 * 132;
    const int m = MP + s_; const float* sinkp = INP(14) + l * 16 + 8 * hf;
    const float* ck = INP(4) + ((size_t)l * NS + s_) * 128 * 256; const float* cv = INP(5) + ((size_t)l * NS + s_) * 128 * 256;
    { const int h = F.tid >> 6, p = F.tid & 63; qn[h * 64 + pi_d(p)] = bf2f(((const bf16*)(F.ws + WS_Q))[(size_t)m * 1024 + 512 * hf + F.tid]) * (0.125f * LOG2E); }
    if (F.tid < 128) { const int h = F.tid >> 6, p = F.tid & 63; kn[h * 64 + pi_d(p)] = bf2f(((const bf16*)(F.ws + WS_K))[(size_t)m * 256 + 128 * hf + F.tid]); vn[F.tid] = bf2f(((const bf16*)(F.ws + WS_V))[(size_t)m * 256 + 128 * hf + F.tid]); }
    { float* ko = F.out + O_KS + ((size_t)l * NS + s_) * 128 * 256; float* vo = F.out + O_VS + ((size_t)l * NS + s_) * 128 * 256; const int i0_ = 64 * hf * 64, i1_ = hf ? 127 * 64 : 64 * 64;
#pragma unroll 4
      for (int i = i0_ + F.tid; i < i1_; i += NTHR) { const f32x4 a = *(const f32x4*)(ck + 256 + 4 * i), b = *(const f32x4*)(cv + 256 + 4 * i); *(f32x4*)(ko + 4 * i) = a; *(f32x4*)(vo + 4 * i) = b; } }
    __syncthreads();
    for (int idx = F.tid; idx < 8 * 129; idx += NTHR) { const int hq = idx / 129, j = idx - hq * 129, hk = hq >> 2; float a = 0.f;
        if (j < 128) { const float* kr = ck + (size_t)j * 256 + (2 * hf + hk) * 64;
#pragma unroll
            for (int d = 0; d < 64; d += 4) { const f32x4 kv = *(const f32x4*)(kr + d); a += qn[hq * 64 + d] * kv.x + qn[hq * 64 + d + 1] * kv.y + qn[hq * 64 + d + 2] * kv.z + qn[hq * 64 + d + 3] * kv.w; } }
        else { for (int d = 0; d < 64; ++d) a += qn[hq * 64 + d] * kn[hk * 64 + d]; }
        sc[hq * 132 + j] = a; }
    __syncthreads();
    { const int hq = F.wave; const float sk2 = sinkp[hq] * LOG2E;
        float mx = sk2; for (int j = F.lane; j < 129; j += 64) mx = fmaxf(mx, sc[hq * 132 + j]);
#pragma unroll
        for (int o = 1; o < 64; o <<= 1) mx = fmaxf(mx, __shfl_xor(mx, o));
        float sum = 0.f; for (int j = F.lane; j < 129; j += 64) { const float p = __builtin_amdgcn_exp2f(sc[hq * 132 + j] - mx); sc[hq * 132 + j] = p; sum += p; }
        sum = wave_sum(sum); if (F.lane == 0) rl[hq] = 1.f / (sum + __builtin_amdgcn_exp2f(sk2 - mx)); }
    __syncthreads();
    { const int hq = F.tid >> 6, d = F.tid & 63, hk = hq >> 2; float a = 0.f; const float* vc = cv + (2 * hf + hk) * 64 + d;
#pragma unroll 16
        for (int j = 0; j < 128; ++j) a += sc[hq * 132 + j] * vc[(size_t)j * 256];
        a += sc[hq * 132 + 128] * vn[hk * 64 + d];
        ((bf16*)(F.ws + WS_CAT))[(size_t)m * D + 512 * hf + F.tid] = (bf16)f2bf(a * rl[hq]); }
    __syncthreads();
}

constexpr int PL_STRIDE = 272;
__device__ __forceinline__ void pool_unit(const Frame& F, int l, int rt, int gi) {
    LAS unsigned char* dT = F.lds; LAS unsigned char* Wt = F.lds + 128 * PL_STRIDE;
    const float* U = (const float*)(F.ws + WS_U); const int w = 2 << gi, m0 = rt * 128;
    { const bf16* pw = (const bf16*)wl(F, l, WL_PW) + (size_t)gi * 128 * 128;
      for (int ch = F.tid; ch < 2048; ch += NTHR) { const int e = ch >> 4, cc = ch & 15; *(LAS u32x4*)(Wt + e * PL_STRIDE + cc * 16) = *(const u32x4*)(pw + e * 128 + cc * 8); } }
    { const int c = F.tid & 127, strip = F.tid >> 7, col = gi * 128 + c;
      if (rt < 64) { const int t0 = (m0 & (SEQ - 1)) + 32 * strip; const float* up = U + (size_t)(m0 + 32 * strip) * 512 + col;
          float uv[47];
#pragma unroll
          for (int j = 0; j < 47; ++j) { const int t = t0 - 15 + j; uv[j] = t >= 0 ? up[(ptrdiff_t)(j - 15) * 512] : 0.f; }
          LAS unsigned short* dp = (LAS unsigned short*)(dT + (32 * strip) * PL_STRIDE) + c;
#define POOL_D(W) { float sum = 0.f; _Pragma("unroll") for (int j = 1; j < W; ++j) sum += uv[15 - j]; \
              _Pragma("unroll") for (int k = 0; k < 32; ++k) { const int t = t0 + k; sum += uv[15 + k]; const float cnt = (float)(t + 1 < W ? t + 1 : W); \
                  dp[k * (PL_STRIDE / 2)] = (unsigned short)f2bf(sum / cnt - uv[15 + k]); sum -= uv[15 + k - W + 1]; } }
          if (gi == 0) POOL_D(2) else if (gi == 1) POOL_D(4) else if (gi == 2) POOL_D(8) else POOL_D(16)
#undef POOL_D
      }
      else { const float* sp = INP(6) + (size_t)l * NS * 15 * 512;
#pragma unroll 4
          for (int k = 0; k < 32; ++k) { const int s_ = 32 * strip + k; const float uc = U[(size_t)(MP + s_) * 512 + col]; float hv[15];
#pragma unroll
              for (int j = 1; j < 16; ++j) hv[j - 1] = sp[((size_t)s_ * 15 + 15 - j) * 512 + col];
              float sum = uc;
#pragma unroll
              for (int j = 1; j < 16; ++j) sum += j < w ? hv[j - 1] : 0.f;
              ((LAS unsigned short*)(dT + s_ * PL_STRIDE))[c] = (unsigned short)f2bf(sum / (float)w - uc); } } }
    __syncthreads();
    const int g = F.lane >> 4, c16 = F.lane & 15;
    f32x4 acc[8];
#pragma unroll
    for (int et = 0; et < 8; ++et) acc[et] = (f32x4){0.f, 0.f, 0.f, 0.f};
#pragma unroll
    for (int ks = 0; ks < 4; ++ks) { const bf16x8 df = *(LAS const bf16x8*)(dT + (16 * F.wave + c16) * PL_STRIDE + (32 * ks + 8 * g) * 2);
#pragma unroll
        for (int et = 0; et < 8; ++et) { const bf16x8 wf = *(LAS const bf16x8*)(Wt + (16 * et + c16) * PL_STRIDE + (32 * ks + 8 * g) * 2); acc[et] = MFMA16(wf, df, acc[et]); } }
    const int m = m0 + 16 * F.wave + c16; const float* psc = INP(17) + l * 512 + gi * 128;
    if (m < M) { bf16* op = (bf16*)(F.ws + WS_CAT) + (size_t)m * D + 1024 + gi * 128 + 4 * g;
#pragma unroll
        for (int et = 0; et < 8; ++et) { const f32x4 v = acc[et] * *(const f32x4*)(psc + 16 * et + 4 * g); u32x2 wv; wv.x = cvt_pk_bf16(v.x, v.y); wv.y = cvt_pk_bf16(v.z, v.w); *(u32x2*)(op + 16 * et) = wv; } }
    __syncthreads();
}
__device__ __forceinline__ void state_outs(const Frame& F, int l) {
    const int gt = F.bid * NTHR + F.tid, ngt = F.G * NTHR; const float* U = (const float*)(F.ws + WS_U); const float* PR = (const float*)(F.ws + WS_PR);
    for (int i = gt; i < NB * 15 * 512; i += ngt) { const int b = i / (15 * 512), j = (i >> 9) % 15, c = i & 511; F.out[O_PP + (size_t)l * NB * 15 * 512 + i] = U[((size_t)b * SEQ + SEQ - 15 + j) * 512 + c]; }
    const float* sp = INP(6) + (size_t)l * NS * 15 * 512;
    for (int i = gt; i < NS * 15 * 512; i += ngt) { const int s_ = i / (15 * 512), j = (i >> 9) % 15, c = i & 511; F.out[O_PS + (size_t)l * NS * 15 * 512 + i] = j < 14 ? sp[i + 512] : U[(size_t)(MP + s_) * 512 + c]; }
    for (int i = gt; i < NB * RP; i += ngt) { const int b = i / RP, c = i - b * RP; F.out[O_SP + (size_t)l * NB * RP + i] = PR[((size_t)b * SEQ + SEQ - 1) * 2048 + c]; }
    for (int i = gt; i < NS * RP; i += ngt) { const int s_ = i / RP, c = i - s_ * RP; F.out[O_SS + (size_t)l * NS * RP + i] = PR[(size_t)(MP + s_) * 2048 + c]; }
}

template <int CTRL> __device__ __forceinline__ float dpp_f(float x) { return __builtin_bit_cast(float, __builtin_amdgcn_mov_dpp(__builtin_bit_cast(int, x), CTRL, 0xf, 0xf, true)); }
__device__ __forceinline__ float row16_sum(float x) {
    x += dpp_f<0xB1>(x); x += dpp_f<0x4E>(x); x += dpp_f<0x141>(x); x += dpp_f<0x128>(x); return x;
}
constexpr int RA_STRIDE = 1936;
constexpr int R_T1OFF = 32 * RA_STRIDE, RT_STRIDE = 80;
struct XmRow { const float* p; const float* pv; float pz; };
__device__ __forceinline__ XmRow xm_row(const float* PR, const float* sshift, int m) {
    XmRow r; r.p = PR + (size_t)m * 2048; const bool first = m < MP && (m & (SEQ - 1)) == 0;
    r.pv = m >= MP ? sshift + (size_t)(m - MP) * RP : first ? r.p : r.p - 2048; r.pz = first ? 0.f : 1.f; return r;
}
__device__ __forceinline__ float xm_at(const XmRow& r, const float* mu, int c) { const float p = r.p[c]; return p + (r.pv[c] * r.pz - p) * mu[c]; }
__device__ __forceinline__ f32x4 xm4_at(const XmRow& r, const float* mu, int c) { const f32x4 p = *(const f32x4*)(r.p + c); return p + (*(const f32x4*)(r.pv + c) * r.pz - p) * *(const f32x4*)(mu + c); }
template <int KS> __device__ __forceinline__ void lora_mm(f32x4 (&acc)[4], const bf16* Wt, int ldw, int nbase, LAS const unsigned char* Arow, int acol, int g, int c16) {
#pragma unroll
    for (int nt = 0; nt < 4; ++nt) acc[nt] = (f32x4){0.f, 0.f, 0.f, 0.f};
#pragma unroll
    for (int ks = 0; ks < KS; ++ks) { const bf16x8 af = *(LAS const bf16x8*)(Arow + (acol + 32 * ks + 8 * g) * 2);
#pragma unroll
        for (int nt = 0; nt < 4; ++nt) { const bf16x8 wf = *(const bf16x8*)(Wt + (size_t)(nbase + 16 * nt + c16) * ldw + 32 * ks + 8 * g); acc[nt] = MFMA16(wf, af, acc[nt]); } }
}
__device__ __forceinline__ float frcp(float x) { return __builtin_amdgcn_rcpf(x); }
__device__ __forceinline__ f32x4 fsig4(f32x4 v) { f32x4 r; r.x = frcp(1.f + __expf(-v.x)); r.y = frcp(1.f + __expf(-v.y)); r.z = frcp(1.f + __expf(-v.z)); r.w = frcp(1.f + __expf(-v.w)); return r; }
__device__ __forceinline__ void rwkv_prep_unit(const Frame& F, int l, int ti) {
    int tid_l = F.tid; asm volatile("" : "+v"(tid_l)); const int lane_l = tid_l & 63;
    LAS unsigned char* Aop = F.lds; LAS unsigned char* T1 = F.lds + R_T1OFF;
    const float* PR = (const float*)(F.ws + WS_PR); const float* sshift = INP(7) + (size_t)l * NS * RP; const float* mu = INP(19) + l * RP;
    const int m0 = ti * 32; const bool vres = l > 0;
    TSB2(70, F.lds);
#pragma unroll
    for (int q0 = 0; q0 < 8; q0 += 4) { f32x4 xv[4];
#pragma unroll
        for (int q = 0; q < 4; ++q) if (q0 + q < 7) { const int i = tid_l + (q0 + q) * NTHR, r = i / 112, c4 = i - r * 112; const XmRow xr = xm_row(PR, sshift, m0 + r); xv[q] = xm4_at(xr, mu, 1536 + 4 * c4); }
#pragma unroll
        for (int q = 0; q < 4; ++q) if (q0 + q < 7) { const int i = tid_l + (q0 + q) * NTHR, r = i / 112, c4 = i - r * 112, c = 4 * c4; f32x4 y = xv[q];
            if (c < 96) { y.x = 1.f - 2.f * frcp(1.f + __expf(2.f * y.x)); y.y = 1.f - 2.f * frcp(1.f + __expf(2.f * y.y)); y.z = 1.f - 2.f * frcp(1.f + __expf(2.f * y.z)); y.w = 1.f - 2.f * frcp(1.f + __expf(2.f * y.w)); }
            else if (c >= 192) y = fsig4(y);
            u32x2 w; w.x = cvt_pk_bf16(y.x, y.y); w.y = cvt_pk_bf16(y.z, y.w); *(LAS u32x2*)(Aop + r * RA_STRIDE + c * 2) = w; }
        asm volatile("" ::: "memory"); __builtin_amdgcn_sched_barrier(0); }
    if (vres) {
#pragma unroll
        for (int q0 = 0; q0 < 8; q0 += 4) { f32x4 xv[4];
#pragma unroll
            for (int q = 0; q < 4; ++q) { const int i = tid_l + (q0 + q) * NTHR, r = i >> 7, c4 = i & 127; const XmRow xr = xm_row(PR, sshift, m0 + r); xv[q] = xm4_at(xr, mu, 1024 + 4 * c4); }
#pragma unroll
            for (int q = 0; q < 4; ++q) { const int i = tid_l + (q0 + q) * NTHR, r = i >> 7, c4 = i & 127; u32x2 w; w.x = cvt_pk_bf16(xv[q].x, xv[q].y); w.y = cvt_pk_bf16(xv[q].z, xv[q].w); *(LAS u32x2*)(Aop + r * RA_STRIDE + (448 + 4 * c4) * 2) = w; }
            asm volatile("" ::: "memory"); __builtin_amdgcn_sched_barrier(0); } }
    __syncthreads();
    TSE2(70, F.lds); TSB2(71, F.lds);
    const int g = lane_l >> 4, c16 = lane_l & 15, nb = 64 * F.wave;
    if (vres) {
        if (F.wave < 4) { const int mt = F.wave >> 1, nt = F.wave & 1; f32x4 a = (f32x4){0.f, 0.f, 0.f, 0.f}; const bf16* w1 = (const bf16*)wl(F, 1, WL_V1) + (size_t)(16 * nt + c16) * 512 + 8 * g;
#pragma unroll
            for (int kh = 0; kh < 2; ++kh) { bf16x8 wf[8];
#pragma unroll
                for (int ks = 0; ks < 8; ++ks) wf[ks] = *(const bf16x8*)(w1 + 32 * (8 * kh + ks));
#pragma unroll
                for (int ks = 0; ks < 8; ++ks) { const bf16x8 af = *(LAS const bf16x8*)(Aop + (16 * mt + c16) * RA_STRIDE + (448 + 32 * (8 * kh + ks) + 8 * g) * 2); a = MFMA16(wf[ks], af, a); }
                asm volatile("" ::: "memory"); __builtin_amdgcn_sched_barrier(0); }
            u32x2 wv; wv.x = cvt_pk_bf16(a.x, a.y); wv.y = cvt_pk_bf16(a.z, a.w); *(LAS u32x2*)(T1 + (16 * mt + c16) * RT_STRIDE + (16 * nt + 4 * g) * 2) = wv;
#if MK_DEBUG
            *(f32x4*)((float*)(F.ws + WS_H) + (size_t)(m0 + 16 * mt + c16) * 32 + 16 * nt + 4 * g) = a;
#endif
            }
        __syncthreads();
    }
    LAS unsigned char* Aimg = F.lds + 65536; LAS unsigned char* Limg = F.lds + 65536 + 32768;
    size_t ro[2]; int mrow[2];
#pragma unroll
    for (int mt = 0; mt < 2; ++mt) { int m = m0 + 16 * mt + c16; asm volatile("" : "+v"(m)); mrow[mt] = m; ro[mt] = (size_t)m * 512 + nb + 4 * g; }
    TSE2(71, F.lds); TSB2(72, F.lds);
#define LORA_PASS(WT, LDW, ACOL, KS0, NKS, ACC) do { bf16x8 wq_[NKS][4]; const bf16* pw_ = (const bf16*)(WT) + (size_t)(nb + c16) * (LDW) + 8 * g + 32 * (KS0); \
        _Pragma("unroll") for (int ks = 0; ks < NKS; ++ks) _Pragma("unroll") for (int nt = 0; nt < 4; ++nt) wq_[ks][nt] = *(const bf16x8*)(pw_ + (size_t)16 * nt * (LDW) + 32 * ks); \
        _Pragma("unroll") for (int mt = 0; mt < 2; ++mt) { LAS const unsigned char* Arow_ = Aop + (16 * mt + c16) * RA_STRIDE + ((ACOL) + 32 * (KS0) + 8 * g) * 2; \
            _Pragma("unroll") for (int ks = 0; ks < NKS; ++ks) { const bf16x8 af_ = *(LAS const bf16x8*)(Arow_ + 64 * ks); \
                _Pragma("unroll") for (int nt = 0; nt < 4; ++nt) ACC[mt][nt] = MFMA16(wq_[ks][nt], af_, ACC[mt][nt]); } } \
        asm volatile("" ::: "memory"); __builtin_amdgcn_sched_barrier(0); } while (0)
#define LORA_ZERO(ACC) do { _Pragma("unroll") for (int mt = 0; mt < 2; ++mt) _Pragma("unroll") for (int nt = 0; nt < 4; ++nt) ACC[mt][nt] = (f32x4){0.f, 0.f, 0.f, 0.f}; } while (0)
    {
        const float* a0p = INP(22) + l * 512; f32x4 acc[2][4]; LORA_ZERO(acc); LORA_PASS(wl(F, l, WL_A2), 96, 96, 0, 2, acc); LORA_PASS(wl(F, l, WL_A2), 96, 96, 2, 1, acc);
#pragma unroll
        for (int mt = 0; mt < 2; ++mt)
#pragma unroll
            for (int nt = 0; nt < 4; ++nt) { const f32x4 a = fsig4(acc[mt][nt] + *(const f32x4*)(a0p + nb + 16 * nt + 4 * g)); u32x2 w; w.x = cvt_pk_bf16(a.x, a.y); w.y = cvt_pk_bf16(a.z, a.w);
                *(LAS u32x2*)(Aimg + ((16 * mt + c16) * 512 + nb + 16 * nt + 4 * g) * 2) = w; } }
    {
        const float* w0p = INP(20) + l * 512; float* Wb = rwbuf(F, RW_W); f32x4 acc[2][4]; LORA_ZERO(acc); LORA_PASS(wl(F, l, WL_W2), 96, 0, 0, 2, acc); LORA_PASS(wl(F, l, WL_W2), 96, 0, 2, 1, acc);
#pragma unroll
        for (int mt = 0; mt < 2; ++mt)
#pragma unroll
            for (int nt = 0; nt < 4; ++nt) { const f32x4 z = acc[mt][nt] + *(const f32x4*)(w0p + nb + 16 * nt + 4 * g); f32x4 dec;
#pragma unroll
                for (int e = 0; e < 4; ++e) { const float zz = -z[e]; const float sp = fmaxf(zz, 0.f) + __logf(1.f + __expf(-fabsf(zz))); dec[e] = __expf(-__expf(-sp - 0.5f)); }
                *(f32x4*)(Wb + ro[mt] + 16 * nt) = dec; } }
    {
        float* Gb = rwbuf(F, RW_G); f32x4 acc[2][4]; LORA_ZERO(acc); LORA_PASS(wl(F, l, WL_G2), 256, 192, 0, 2, acc); LORA_PASS(wl(F, l, WL_G2), 256, 192, 2, 2, acc); LORA_PASS(wl(F, l, WL_G2), 256, 192, 4, 2, acc); LORA_PASS(wl(F, l, WL_G2), 256, 192, 6, 2, acc);
#pragma unroll
        for (int mt = 0; mt < 2; ++mt)
#pragma unroll
            for (int nt = 0; nt < 4; ++nt) *(f32x4*)(Gb + ro[mt] + 16 * nt) = acc[mt][nt]; }
#undef LORA_PASS
#undef LORA_ZERO
    TSE2(72, F.lds); TSB2(73, F.lds);
    if (vres) {
#pragma unroll
        for (int mt = 0; mt < 2; ++mt) { const bf16x8 tf = *(LAS const bf16x8*)(T1 + (16 * mt + c16) * RT_STRIDE + (8 * g) * 2); const f32x4 z4 = (f32x4){0.f, 0.f, 0.f, 0.f};
#pragma unroll
            for (int nt = 0; nt < 4; ++nt) { const bf16x8 wf = *(const bf16x8*)((const bf16*)wl(F, 1, WL_V2) + (size_t)(nb + 16 * nt + c16) * 32 + 8 * g); const f32x4 lv = MFMA16(wf, tf, z4);
                u32x2 w; w.x = cvt_pk_bf16(lv.x, lv.y); w.y = cvt_pk_bf16(lv.z, lv.w); *(LAS u32x2*)(Limg + ((16 * mt + c16) * 512 + nb + 16 * nt + 4 * g) * 2) = w;
#if MK_DEBUG
                *(f32x4*)(rwbuf(F, RW_Y) + ro[mt] + 16 * nt) = lv;
#endif
            } } }
    __syncthreads();
    {   const float* vbp = INP(33); const float* kkp = INP(25) + l * 512; const float* kap = INP(26) + l * 512;
        float* Rb = rwbuf(F, RW_R); float* Kb = rwbuf(F, RW_K); float* Vb = rwbuf(F, RW_V); float* Ab = rwbuf(F, RW_A); float* Bb = rwbuf(F, RW_B); float* VF = rwbuf(F, RW_VF);
        const int r = tid_l >> 4, j16 = tid_l & 15; int m = m0 + r; asm volatile("" : "+v"(m)); const XmRow xr = xm_row(PR, sshift, m);
#pragma unroll 4
        for (int h = 0; h < 8; ++h) { const int n = 64 * h + 4 * j16; const size_t o = (size_t)m * 512 + n;
            const f32x4 rx = xm4_at(xr, mu, n), k = xm4_at(xr, mu, 512 + n); f32x4 v = xm4_at(xr, mu, 1024 + n);
            const u32x2 aw = *(LAS const u32x2*)(Aimg + (r * 512 + n) * 2); f32x4 a; a.x = bflo(aw.x); a.y = bfhi(aw.x); a.z = bflo(aw.y); a.w = bfhi(aw.y);
            const f32x4 kk = k * *(const f32x4*)(kkp + n);
            const float ss = row16_sum((kk.x * kk.x + kk.y * kk.y) + (kk.z * kk.z + kk.w * kk.w)), rn = 1.f / fmaxf(sqrtf(ss), 1e-12f);
            *(f32x4*)(Rb + o) = rx;
            *(f32x4*)(Kb + o) = k * ((a - 1.f) * *(const f32x4*)(kap + n) + 1.f);
            if (!vres) *(f32x4*)(VF + o) = v;
            else { const u32x2 lw = *(LAS const u32x2*)(Limg + (r * 512 + n) * 2); f32x4 lv; lv.x = bflo(lw.x); lv.y = bfhi(lw.x); lv.z = bflo(lw.y); lv.w = bfhi(lw.y);
                const f32x4 vf = *(const f32x4*)(VF + o); v = v + (vf - v) * fsig4(lv + *(const f32x4*)(vbp + n)); }
            *(f32x4*)(Vb + o) = v;
            const f32x4 kn = kk * rn; *(f32x4*)(Ab + o) = -kn; *(f32x4*)(Bb + o) = kn * a; } }
    TSE2(73, F.lds);
    __syncthreads();
}

constexpr int SC_T = 32, SC_ARR = SC_T * 64 * 4, SC_BUF = 5 * SC_ARR + SC_T * 16 * 4, SC_NSLOT = 3;
static_assert(SC_NSLOT * SC_BUF <= 131072, "scan ring fits the phase LDS");
__device__ __forceinline__ float wave_sum64(float x) { x = row16_sum(x); x += __shfl_xor(x, 16); x += __shfl_xor(x, 32); return x; }
__device__ __forceinline__ void scan_prompt_unit(const Frame& F, int l, int b, int h, int qt) {
    const size_t rowb = (size_t)b * SEQ;
    constexpr int NCH = SEQ / SC_T;
    if (F.wave >= 4) {
        const float* src0 = rwbuf(F, RW_W); const float* src1 = rwbuf(F, RW_A); const float* src2 = rwbuf(F, RW_B); const float* src3 = rwbuf(F, RW_K); const float* src4 = rwbuf(F, RW_R); const float* Vb = rwbuf(F, RW_V);
        const int lt = F.tid - 256, lw = F.wave - 4;
        const size_t g0 = (rowb + (lt >> 4)) * 512 + h * 64 + 4 * (lt & 15), g1 = g0 + (size_t)16 * 512;
        const size_t gv0 = (rowb + (lt & 31)) * 512 + h * 64 + qt * 16 + (lt >> 5), gv1 = gv0 + 8;
        const unsigned l0 = (unsigned)lw * 1024u, l1 = l0 + 4096u;
#define SC_GL(src, goff, slot, arr, loff) __builtin_amdgcn_global_load_lds((const unsigned*)((src) + (goff)), (LAS unsigned*)(F.lds + (slot) * SC_BUF + (arr) * SC_ARR + (loff)), 16, 0, 0)
#define SC_STAGE(ch_, slot_) do { const size_t co_ = (size_t)(ch_) * SC_T * 512; \
            SC_GL(src0, g0 + co_, slot_, 0, l0); SC_GL(src0, g1 + co_, slot_, 0, l1); SC_GL(src1, g0 + co_, slot_, 1, l0); SC_GL(src1, g1 + co_, slot_, 1, l1); SC_GL(src2, g0 + co_, slot_, 2, l0); SC_GL(src2, g1 + co_, slot_, 2, l1); \
            SC_GL(src3, g0 + co_, slot_, 3, l0); SC_GL(src3, g1 + co_, slot_, 3, l1); SC_GL(src4, g0 + co_, slot_, 4, l0); SC_GL(src4, g1 + co_, slot_, 4, l1); \
            __builtin_amdgcn_global_load_lds((const unsigned*)(Vb + gv0 + co_), (LAS unsigned*)(F.lds + (slot_) * SC_BUF + 5 * SC_ARR + lw * 256), 4, 0, 0); \
            __builtin_amdgcn_global_load_lds((const unsigned*)(Vb + gv1 + co_), (LAS unsigned*)(F.lds + (slot_) * SC_BUF + 5 * SC_ARR + 1024 + lw * 256), 4, 0, 0); } while (0)
        SC_STAGE(0, 0); SC_STAGE(1, 1);
        asm volatile("s_waitcnt vmcnt(12)" ::: "memory");
        __builtin_amdgcn_s_barrier();
        int slot = 2;
        for (int ch = 0; ch < NCH; ++ch) {
            if (ch + 2 < NCH) { SC_STAGE(ch + 2, slot);
                asm volatile("s_waitcnt vmcnt(12)" ::: "memory"); }
            else asm volatile("s_waitcnt vmcnt(0)" ::: "memory");
            __builtin_amdgcn_s_barrier();
            slot = slot == 2 ? 0 : slot + 1;
        }
#undef SC_GL
#undef SC_STAGE
    } else {
        float* Yb = rwbuf(F, RW_Y);
        const int rg = F.lane >> 4, j4 = F.lane & 15, rloc = F.wave * 4 + rg;
        f32x4 s = (f32x4){0.f, 0.f, 0.f, 0.f}; float ypv[16]; const bool b8 = (j4 & 8) != 0, b4 = (j4 & 4) != 0, b2 = (j4 & 2) != 0, b1 = (j4 & 1) != 0;
        float* yp = Yb + (rowb + j4) * 512 + h * 64 + qt * 16 + rloc;
        __builtin_amdgcn_s_barrier(); asm volatile("" ::: "memory");
        int slot = 0;
        for (int ch = 0; ch < NCH; ++ch) {
            LAS const unsigned char* bp = F.lds + slot * SC_BUF + j4 * 16; LAS const f32x4* vp = (LAS const f32x4*)(F.lds + slot * SC_BUF + 5 * SC_ARR + rloc * 128);
            f32x4 w = *(LAS const f32x4*)(bp + 0 * SC_ARR), a = *(LAS const f32x4*)(bp + 1 * SC_ARR), bb = *(LAS const f32x4*)(bp + 2 * SC_ARR), k = *(LAS const f32x4*)(bp + 3 * SC_ARR), r = *(LAS const f32x4*)(bp + 4 * SC_ARR);
            f32x4 vq = vp[0];
#pragma unroll
            for (int tt = 0; tt < SC_T; ++tt) {
                const float v = vq[tt & 3];
                const f32x4 p = s * w + k * v;
                __builtin_amdgcn_sched_barrier(0);
                f32x4 wn = w, an = a, bn = bb, kn = k, rn = r, vqn = vq;
                if (tt + 1 < SC_T) { wn = *(LAS const f32x4*)(bp + 0 * SC_ARR + (tt + 1) * 256); an = *(LAS const f32x4*)(bp + 1 * SC_ARR + (tt + 1) * 256); bn = *(LAS const f32x4*)(bp + 2 * SC_ARR + (tt + 1) * 256);
                    kn = *(LAS const f32x4*)(bp + 3 * SC_ARR + (tt + 1) * 256); rn = *(LAS const f32x4*)(bp + 4 * SC_ARR + (tt + 1) * 256); if ((tt & 3) == 3) vqn = vp[(tt + 1) >> 2]; }
                __builtin_amdgcn_sched_barrier(0);
                const float sa = row16_sum(fmaf(s.w, a.w, fmaf(s.z, a.z, fmaf(s.y, a.y, s.x * a.x))));
                s = bb * sa + p;
                ypv[tt & 15] = fmaf(s.w, r.w, fmaf(s.z, r.z, fmaf(s.y, r.y, s.x * r.x)));
                if ((tt & 15) == 15) {
                    float q8[8], q4[4], q2[2];
#pragma unroll
                    for (int kq = 0; kq < 8; ++kq) { const float keep = b8 ? ypv[kq + 8] : ypv[kq], send = b8 ? ypv[kq] : ypv[kq + 8]; q8[kq] = keep + dpp_f<0x128>(send); }
#pragma unroll
                    for (int kq = 0; kq < 4; ++kq) { const float keep = b4 ? q8[kq + 4] : q8[kq], send = b4 ? q8[kq] : q8[kq + 4]; q4[kq] = keep + dpp_f<0x141>(send); }
#pragma unroll
                    for (int kq = 0; kq < 2; ++kq) { const float keep = b2 ? q4[kq + 2] : q4[kq], send = b2 ? q4[kq] : q4[kq + 2]; q2[kq] = keep + dpp_f<0x4E>(send); }
                    { const float keep = b1 ? q2[1] : q2[0], send = b1 ? q2[0] : q2[1]; yp[(size_t)(ch * SC_T + (tt & ~15)) * 512] = keep + dpp_f<0xB1>(send); }
                }
                w = wn; a = an; bb = bn; k = kn; r = rn; vq = vqn;
            }
            __builtin_amdgcn_s_barrier(); asm volatile("" ::: "memory");
            slot = slot == 2 ? 0 : slot + 1;
        }
        *(f32x4*)(F.out + O_WP + ((((size_t)l * NB + b) * 8 + h) * 64 + qt * 16 + rloc) * 64 + 4 * j4) = s;
    }
    __syncthreads();
}
__device__ __forceinline__ void scan_sample_wave(const Frame& F, int l, int s_, int h) {
    const size_t m = MP + s_; const int rg = F.lane >> 4, j4 = F.lane & 15; const size_t o = m * 512 + h * 64 + 4 * j4;
    const f32x4 w = *(const f32x4*)(rwbuf(F, RW_W) + o), a = *(const f32x4*)(rwbuf(F, RW_A) + o), bb = *(const f32x4*)(rwbuf(F, RW_B) + o), k = *(const f32x4*)(rwbuf(F, RW_K) + o), r = *(const f32x4*)(rwbuf(F, RW_R) + o);
    const float* S0 = INP(8) + (((size_t)l * NS + s_) * 8 + h) * 4096; float* S1 = F.out + O_WS + (((size_t)l * NS + s_) * 8 + h) * 4096;
    const int row = 4 * j4 + rg; const size_t orow = m * 512 + h * 64 + row;
    const float v_my = rwbuf(F, RW_V)[orow], g_my = rwbuf(F, RW_G)[orow], rk_r = INP(27)[l * 512 + h * 64 + row], lg_r = INP(28)[l * 512 + h * 64 + row], lb_r = INP(29)[l * 512 + h * 64 + row];
    const f32x4 rk4 = *(const f32x4*)(INP(27) + l * 512 + h * 64 + 4 * j4);
    (void)rk_r;
    float yk = 0.f;
#pragma unroll 4
    for (int i0 = 0; i0 < 16; ++i0) { const int i = 4 * i0 + rg; f32x4 s = *(const f32x4*)(S0 + i * 64 + 4 * j4); const float v = rwbuf(F, RW_V)[m * 512 + h * 64 + i];
        const float sa = row16_sum((s.x * a.x + s.y * a.y) + (s.z * a.z + s.w * a.w));
        s = s * w + bb * sa + k * v;
        const float y = row16_sum((s.x * r.x + s.y * r.y) + (s.z * r.z + s.w * r.w));
        *(f32x4*)(S1 + i * 64 + 4 * j4) = s; yk = (j4 == i0) ? y : yk; }
    const float bon = row16_sum((r.x * k.x * rk4.x + r.y * k.y * rk4.y) + (r.z * k.z * rk4.z + r.w * k.w * rk4.w));
    const float mu = wave_sum64(yk) * (1.f / 64.f), dv = yk - mu, var = wave_sum64(dv * dv) * (1.f / 64.f);
    ((bf16*)(F.ws + WS_CAT))[m * D + 1536 + h * 64 + row] = (bf16)f2bf((dv * rsqrtf(var + 64e-5f) * lg_r + lb_r + bon * v_my) * g_my);
#if MK_DEBUG
    rwbuf(F, RW_Y)[orow] = yk;
#endif
}
__device__ __forceinline__ void rwkv_post_phase(const Frame& F, int l) {
    const int gw = F.bid * NWAVES + F.wave, NGW = F.G * NWAVES; const float* rkp = INP(27) + l * 512; const float* lgp = INP(28) + l * 512; const float* lbp = INP(29) + l * 512;
    const float* Yb = rwbuf(F, RW_Y); const float* Rb = rwbuf(F, RW_R); const float* Kb = rwbuf(F, RW_K); const float* Vb = rwbuf(F, RW_V); const float* Gb = rwbuf(F, RW_G);
    for (int it0 = gw * 4; it0 < MP * 8; it0 += NGW * 4) {
        float y[4], r[4], k[4], v[4], g[4];
#pragma unroll
        for (int q = 0; q < 4; ++q) { const int it = it0 + q, m = it >> 3, h = it & 7; const size_t o = (size_t)m * 512 + h * 64 + F.lane; y[q] = Yb[o]; r[q] = Rb[o]; k[q] = Kb[o]; v[q] = Vb[o]; g[q] = Gb[o]; }
#pragma unroll
        for (int q = 0; q < 4; ++q) { const int it = it0 + q, m = it >> 3, h = it & 7, c = h * 64 + F.lane;
            const float mu = wave_sum64(y[q]) * (1.f / 64.f), dv = y[q] - mu, var = wave_sum64(dv * dv) * (1.f / 64.f), bon = wave_sum64(r[q] * k[q] * rkp[c]);
            ((bf16*)(F.ws + WS_CAT))[(size_t)m * D + 1536 + c] = (bf16)f2bf((dv * rsqrtf(var + 64e-5f) * lgp[c] + lbp[c] + bon * v[q]) * g[q]); }
    }
}
}
namespace mk {
namespace cg = cooperative_groups;
constexpr int LDS_BYTES = 135168;
constexpr int TS_OFF = LDS_BYTES - 64;
#ifdef MK_TS_ID
#ifndef MK_TS_BLOCK
#define MK_TS_BLOCK 0
#endif
#ifndef MK_TS_AMP
#define MK_TS_AMP 8
#endif
#define TSB(id, ldsp) do { if ((id) == MK_TS_ID && blockIdx.x == MK_TS_BLOCK && threadIdx.x == 0) *(volatile LAS unsigned*)((ldsp) + TS_OFF) -= (unsigned)__builtin_amdgcn_s_memrealtime(); } while (0)
#define TSE(id, ldsp) do { if ((id) == MK_TS_ID && blockIdx.x == MK_TS_BLOCK && threadIdx.x == 0) *(volatile LAS unsigned*)((ldsp) + TS_OFF) += (unsigned)__builtin_amdgcn_s_memrealtime(); } while (0)
#else
#define TSB(id, ldsp) do {} while (0)
#define TSE(id, ldsp) do {} while (0)
#endif
constexpr int PH_PRO = 0, PH_ADA = 1, PH_L0 = 2, PH_PER_L = 10, PH_FINAL = PH_L0 + NL * PH_PER_L, N_PHASES = PH_FINAL + 1;
enum { LP_NORM1 = 0, LP_IN, LP_MIX, LP_SCAN, LP_POST, LP_MG, LP_WO, LP_NORM2, LP_GU, LP_DN };

__device__ __forceinline__ void mix_phase(const Frame& F, int l) {
    TSB(40, F.lds);
    for (int u = F.bid; u < 256; u += F.G) rwkv_prep_unit(F, l, u);
    TSE(40, F.lds);
    TSB(44, F.lds); state_outs(F, l); TSE(44, F.lds);
}
constexpr int SCAN_BLOCKS = 64;
constexpr int GL_PM_SPLIT = 10;
__device__ __forceinline__ void scan_phase(const Frame& F, int l) {
    if (F.bid < SCAN_BLOCKS) scan_prompt_unit(F, l, F.bid >> 5, (F.bid >> 2) & 7, F.bid & 3);
    else { const int nb_ = F.G - SCAN_BLOCKS, wb = F.bid - SCAN_BLOCKS; const int nw = nb_ * NWAVES; unsigned* ctl = (unsigned*)(F.ws + WS_CTL) + 64 * l;
        if (wb < 4) { rwkv_prep_unit(F, l, 256 + wb); asm volatile("s_waitcnt vmcnt(0)" ::: "memory"); __syncthreads();
            if (F.tid == 0) { __builtin_amdgcn_fence(__ATOMIC_RELEASE, "agent"); asm volatile("s_waitcnt vmcnt(0)" ::: "memory"); __hip_atomic_fetch_add(ctl, 1u, __ATOMIC_RELAXED, __HIP_MEMORY_SCOPE_AGENT); } }
        TSB(41, F.lds);
        for (int a = wb; a < 256; a += nb_) attn_prompt_unit(F, l, a >> 7, (a >> 2) & 31, a & 3);
        TSE(41, F.lds); TSB(42, F.lds);
        for (int p = (wb + 64) % nb_; p < 260; p += nb_) pool_unit(F, l, p >> 2, p & 3);
        TSE(42, F.lds); TSB(43, F.lds);
        for (int s_ = (wb + 132) % nb_; s_ < 2 * NS; s_ += nb_) attn_sample_unit(F, l, s_ >> 1, s_ & 1);
        TSE(43, F.lds);
        __syncthreads();
        Gemm g; g.layer = l; g.ld = D; g.M = MPAD; g.K = D; g.N = NIN; g.A = (const bf16*)(F.ws + WS_H); g.Bt = (const bf16*)wl(F, l, WL_IN); g.mode = G_IN;
        Sched S; S.init(Rect{GL_PM_SPLIT, MPAD / BM - GL_PM_SPLIT, 16, 24}, Rect{0, 0, 0, 0}, F.G - SCAN_BLOCKS, F.bid - SCAN_BLOCKS, 1); Epi E; E.F = &F; E.mode = G_IN; E.layer = l;
        TSB(45, F.lds); gemm_phase(F.lds, g, S, E, F.tid); TSE(45, F.lds);
        if (l == 0) { TSB(46, F.lds); p0_prologue(F, 2, false, wb, nb_, 0); TSE(46, F.lds); }
        if (F.tid == 0) { unsigned sp = 0; while (__hip_atomic_load(ctl, __ATOMIC_RELAXED, __HIP_MEMORY_SCOPE_AGENT) < 4u && ++sp < (1u << 26)) __builtin_amdgcn_s_sleep(8);
            __builtin_amdgcn_fence(__ATOMIC_ACQUIRE, "agent"); asm volatile("s_waitcnt vmcnt(0)" ::: "memory"); }
        __syncthreads();
        for (int u = wb * NWAVES + F.wave; u < NS * 8; u += nw) scan_sample_wave(F, l, u >> 3, u & 7); }
}

#define XB_TMO      128
#define XB_XCNT(j)  (256  + 64 * (j))
#define XB_XSUB(j)  (1280 + 64 * (j))
#define XB_XGEN(j)  (2304 + 64 * (j))
#define XB_TOP      3328
#define XB_TOPGEN   3392
#define XCD_BAR_WORDS 3456
#define XB_SPIN_CAP (1u << 18)

__device__ __forceinline__ unsigned xb_ld(unsigned* p)              { return __hip_atomic_load(p, __ATOMIC_RELAXED, __HIP_MEMORY_SCOPE_AGENT); }
__device__ __forceinline__ unsigned xb_add(unsigned* p, unsigned v) { return __hip_atomic_fetch_add(p, v, __ATOMIC_RELAXED, __HIP_MEMORY_SCOPE_AGENT); }
__device__ __forceinline__ unsigned xb_xcc_id() { return (unsigned)__builtin_amdgcn_s_getreg((3 << 11) | 20) & 0xFu; }
#define XB_SPIN(cond, bar) do { unsigned _sp = 0; while (cond) { __builtin_amdgcn_s_sleep(1); \
    if ((++_sp & 255u) == 0u) { if (xb_ld(&(bar)[XB_TMO])) break; if (_sp > XB_SPIN_CAP) { atomicAdd(&(bar)[XB_TMO], 1u); break; } } } } while (0)

struct XcdBarrier {
    unsigned* bar; unsigned x;
    volatile LAS unsigned* st;
};

__device__ __forceinline__ XcdBarrier xcd_barrier_post(unsigned* bar, volatile LAS unsigned* st) {
    XcdBarrier b; b.bar = bar; b.x = xb_xcc_id(); b.st = st;
    if (threadIdx.x == 0) (void)xb_add(&bar[XB_XCNT(b.x)], 1u);
    return b;
}
__device__ __forceinline__ void xcd_barrier_complete(unsigned* bar, unsigned x, unsigned& nloc, unsigned& nx) {
    const unsigned G = gridDim.x * gridDim.y * gridDim.z;
    unsigned sum, cnt, mine, sp = 0u;
    for (;;) {
        sum = 0u; cnt = 0u; mine = 0u;
#pragma unroll
        for (unsigned j = 0; j < 16; ++j) { const unsigned c = xb_ld(&bar[XB_XCNT(j)]); sum += c; cnt += (c > 0u) ? 1u : 0u; mine = (j == x) ? c : mine; }
        if (sum == G) break;
        __builtin_amdgcn_s_sleep(1);
        if ((++sp & 255u) == 0u) { if (xb_ld(&bar[XB_TMO])) break; if (sp > XB_SPIN_CAP) { atomicAdd(&bar[XB_TMO], 1u); break; } }
    }
    nloc = mine > 0u ? mine : 1u; nx = cnt > 0u ? cnt : 1u;
}

__device__ __forceinline__ void xcd_barrier(const XcdBarrier& b) {
    asm volatile("s_waitcnt vmcnt(0)" ::: "memory");
    __syncthreads();
    if (threadIdx.x == 0) {
        unsigned* bar = b.bar;
        __builtin_amdgcn_s_waitcnt(0);
        unsigned nloc = b.st[0], nx = b.st[1];
        if (nloc == 0u) { xcd_barrier_complete(bar, b.x, nloc, nx); b.st[0] = nloc; b.st[1] = nx; }
        const unsigned old = xb_add(&bar[XB_XSUB(b.x)], 1u);
        const unsigned gen = old / nloc;
        if (old + 1u == (gen + 1u) * nloc) {
            __builtin_amdgcn_fence(__ATOMIC_RELEASE, "agent");
            asm volatile("s_waitcnt vmcnt(0)" ::: "memory");
            const unsigned og = xb_add(&bar[XB_TOP], 1u);
            const unsigned tg = og / nx;
            if (og + 1u == (tg + 1u) * nx) xb_add(&bar[XB_TOPGEN], 1u);
            else XB_SPIN(xb_ld(&bar[XB_TOPGEN]) == tg, bar);
            __builtin_amdgcn_fence(__ATOMIC_ACQUIRE, "agent");
            xb_add(&bar[XB_XGEN(b.x)], 1u);
            asm volatile("s_waitcnt vmcnt(0)" ::: "memory");
        } else {
            XB_SPIN(xb_ld(&bar[XB_XGEN(b.x)]) == gen, bar);
            __builtin_amdgcn_fence(__ATOMIC_ACQUIRE, "agent");
            asm volatile("s_waitcnt vmcnt(0)" ::: "memory");
        }
    }
    __syncthreads();
}


__global__ void __launch_bounds__(NTHR, 2) __attribute__((target("no-packed-fp32-ops"))) mega(Args args) {
    extern __shared__ __attribute__((aligned(16))) unsigned char lds_raw[];
    cg::grid_group grid = cg::this_grid();
    if (threadIdx.x < 2) ((volatile LAS unsigned*)((LAS unsigned char*)lds_raw + TS_OFF - 64))[threadIdx.x] = 0u;
    __syncthreads();
    const XcdBarrier xbar = xcd_barrier_post((unsigned*)(args.ws + WS_CTL + 4096), (volatile LAS unsigned*)((LAS unsigned char*)lds_raw + TS_OFF - 64));
#ifdef MK_TS_ID
    if (threadIdx.x == 0) *(volatile LAS unsigned*)((LAS unsigned char*)lds_raw + TS_OFF) = 0u;
#endif
    for (int ph = args.ph_lo; ph < args.ph_hi; ++ph) {
        Frame F; { GAS unsigned char* ws_ = (GAS unsigned char*)args.ws; GAS float* out_ = (GAS float*)args.out; int tid_ = threadIdx.x; int bid_ = blockIdx.x; int G_ = gridDim.x;
            asm volatile("" : "+s"(ws_), "+s"(out_), "+v"(tid_), "+s"(bid_), "+s"(G_));
            F.lds = (LAS unsigned char*)lds_raw; F.tid = tid_; F.lane = tid_ & 63; F.wave = __builtin_amdgcn_readfirstlane(tid_ >> 6); F.G = G_; F.bid = bid_; F.out = (float*)out_; F.ws = (unsigned char*)ws_; }
        const int l = ph >= PH_L0 && ph < PH_FINAL ? (ph - PH_L0) / PH_PER_L : 0, lp = ph >= PH_L0 && ph < PH_FINAL ? (ph - PH_L0) % PH_PER_L : -1;
        TSB(ph == PH_PRO ? 1 : ph == PH_ADA ? 2 : ph == PH_FINAL ? 3 : 10 + lp, F.lds);
#ifndef MK_NO_PRO
        if (ph == PH_PRO) p0_prologue(F, 0, true, F.bid, F.G, 0); else
#endif
#ifndef MK_NO_NORM
        if (ph == PH_FINAL || lp == LP_NORM1 || lp == LP_NORM2) norm_phase(F, l, ph == PH_FINAL ? 2 : lp == LP_NORM1 ? 0 : 1, ph == PH_FINAL ? 11 : lp == LP_NORM2 ? 4 : (l > 0 ? 11 : 0)); else
#endif
#ifndef MK_NO_MIX
        if (lp == LP_MIX) { mix_phase(F, l);
#ifdef MK_DUP_MIX
            __syncthreads(); mix_phase(F, l);
#endif
        } else
#endif
#ifndef MK_NO_SCAN
        if (lp == LP_SCAN) { scan_phase(F, l);
#ifdef MK_DUP_SCAN
            __syncthreads(); scan_phase(F, l);
#endif
        } else
#endif
#ifndef MK_NO_POST
        if (lp == LP_POST) rwkv_post_phase(F, l); else
#endif
#ifndef MK_NO_GEMM
        {
            Gemm g; g.layer = l; g.ld = D; g.M = MPAD; g.K = D;
            if (ph == PH_ADA) { g.A = (const bf16*)(F.ws + WS_SILC); g.Bt = (const bf16*)(F.ws + WS_ADAW); g.M = 256; g.N = 2 * NADA; g.mode = G_ADA; }
            else if (lp == LP_IN) { g.A = (const bf16*)(F.ws + WS_H); g.Bt = (const bf16*)wl(F, l, WL_IN); g.N = NIN; g.mode = G_IN; }
            else if (lp == LP_MG) { g.A = (const bf16*)(F.ws + WS_CAT); g.Bt = (const bf16*)wl(F, l, WL_CAT); g.N = D; g.mode = G_MG; }
            else if (lp == LP_WO) { g.A = (const bf16*)(F.ws + WS_MG); g.Bt = (const bf16*)wl(F, l, WL_O); g.N = D; g.mode = G_WO; }
            else if (lp == LP_GU) { g.A = (const bf16*)(F.ws + WS_H); g.Bt = (const bf16*)wl(F, l, WL_GU); g.N = NGU; g.mode = G_GU; }
            else { g.A = (const bf16*)(F.ws + WS_GT); g.Bt = (const bf16*)wl(F, l, WL_DN); g.N = D; g.K = DFF; g.ld = DFF; g.mode = G_DN; }
            Sched S; Epi E; E.F = &F; E.mode = g.mode; E.layer = l;
            if (g.mode == G_WO && F.bid < 32) {
                const int ks = F.bid >> 3;
                const float* sl = (const float*)(F.ws + WS_SLABM); bf16* mg = (bf16*)(F.ws + WS_MG) + (size_t)MP * D;
                for (int i = F.tid; i < NS * 128; i += NTHR) { const int r = i >> 7, c = ks * 512 + (i & 127) * 4; const size_t o = (size_t)r * D + c;
                    const f32x4 v = *(const f32x4*)(sl + o) + *(const f32x4*)(sl + (size_t)NS * D + o) + *(const f32x4*)(sl + (size_t)2 * NS * D + o) + *(const f32x4*)(sl + (size_t)3 * NS * D + o);
                    u32x2 w; w.x = cvt_pk_bf16(v.x, v.y); w.y = cvt_pk_bf16(v.z, v.w); *(u32x2*)(mg + o) = w; }
                asm volatile("s_waitcnt vmcnt(0)" ::: "memory"); __syncthreads();
            }
            if (lp == LP_IN && ph != PH_ADA) S.init(Rect{0, MPAD / BM, 0, 16}, Rect{0, GL_PM_SPLIT, 16, 24}, F.G, F.bid, 1);
            else if (g.mode == G_WO || g.mode == G_DN || g.mode == G_MG) S.init(Rect{0, MPAD / BM - 1, 0, 8}, Rect{MPAD / BM - 1, 1, 0, 8 * (g.K / 512)}, F.G, F.bid, 1, 8);
            else S.init(Rect{0, g.M / BM, 0, g.N / BM}, Rect{0, 0, 0, 0}, F.G, F.bid, 1);
            gemm_phase(F.lds, g, S, E, F.tid);
            if (ph == PH_ADA) { if (F.bid < 96) p0_prologue(F, 1, false, F.bid, 96, 2); else p0_prologue(F, 1, false, F.bid - 96, F.G - 96, 1); }
        }
#else
        {}
#endif
        TSE(ph == PH_PRO ? 1 : ph == PH_ADA ? 2 : ph == PH_FINAL ? 3 : 10 + lp, F.lds);
        TSB(30, F.lds);
        if (ph + 1 < args.ph_hi) { if (args.ph_hi < 0) grid.sync();   else xcd_barrier(xbar); }
        TSE(30, F.lds);
    }
#ifdef MK_EXTRA_SYNCS
    for (int i = 0; i < MK_EXTRA_SYNCS; ++i) xcd_barrier(xbar);
#endif
#ifdef MK_TS_ID
    if (blockIdx.x == MK_TS_BLOCK && threadIdx.x == 0) { const unsigned want = *(volatile LAS unsigned*)((LAS unsigned char*)lds_raw + TS_OFF) * (unsigned)MK_TS_AMP; const unsigned t0 = (unsigned)__builtin_amdgcn_s_memrealtime();
        while ((unsigned)__builtin_amdgcn_s_memrealtime() - t0 < want) __builtin_amdgcn_s_sleep(32); }
#endif
}
}
#ifndef MK_DEBUG
#define MK_DEBUG 0
#endif
extern "C" void kernel_launch(void* const* d_in, const int* in_sizes, int n_in, void* d_out, int out_size, void* d_ws, size_t ws_size, hipStream_t stream) {
    using namespace mk;
    static int grid = 0;
    if (grid == 0) {
        nv::WS wtmp; const size_t need_nv = nv::carve((float*)d_ws, wtmp) * 4; const size_t need = MK_DEBUG ? (need_nv > WS_END ? need_nv : WS_END) + (16u << 20) : WS_END;
        if (n_in != 39 || (size_t)out_size != O_END || ws_size < need) { fprintf(stderr, "kernel_launch: unexpected shapes: n_in %d out %d (want %zu) ws %zu (need %zu)\n", n_in, out_size, (size_t)O_END, ws_size, need); grid = -1; return; }
        int dev = 0, cus = 0, per_cu = 0;
        if (hipGetDevice(&dev) != hipSuccess || hipDeviceGetAttribute(&cus, hipDeviceAttributeMultiprocessorCount, dev) != hipSuccess) { grid = -1; return; }
        if (hipFuncSetAttribute((const void*)mega, hipFuncAttributeMaxDynamicSharedMemorySize, LDS_BYTES) != hipSuccess) { fprintf(stderr, "kernel_launch: hipFuncSetAttribute failed\n"); grid = -1; return; }
        if (hipOccupancyMaxActiveBlocksPerMultiprocessor(&per_cu, (const void*)mega, NTHR, LDS_BYTES) != hipSuccess || per_cu < 1) { fprintf(stderr, "kernel_launch: occupancy query says %d blocks per CU\n", per_cu); per_cu = 1; }
        (void)hipGetLastError();
        grid = cus;
        fprintf(stderr, "kernel_launch: grid %d (cus %d, per_cu %d), ws %zu need %zu\n", grid, cus, per_cu, ws_size, need);
    }
    if (grid < 0) return;
    Args a{};
    for (int i = 0; i < 39; ++i) a.in[i] = (const float*)d_in[i];
    a.out = (float*)d_out; a.ws = (unsigned char*)d_ws;
    if (hipMemsetAsync((unsigned char*)d_ws + WS_CTL, 0, WS_CTL_BYTES, stream) != hipSuccess) { fprintf(stderr, "kernel_launch: hipMemsetAsync of the control words failed\n"); return; }
#if MK_DEBUG
    dbg::Ctx dc; dc.probes = (float*)((unsigned char*)d_ws + ((ws_size - (12u << 20)) & ~(size_t)255)); dc.err = dc.probes + (size_t)dbg::NIDS * dbg::NPROBE; dc.on = 1;
    (void)hipMemsetAsync(dc.err, 0, dbg::NIDS * 4 * sizeof(float), stream);
    unsigned char* ws = (unsigned char*)d_ws;
    for (int ph = 0; ph < N_PHASES; ++ph) {
        a.ph_lo = ph; a.ph_hi = ph + 1;
        hipLaunchKernelGGL(mega, dim3(grid), dim3(NTHR), LDS_BYTES, stream, a);
        using namespace dbg;
        const int l = ph >= PH_L0 && ph < PH_FINAL ? (ph - PH_L0) / PH_PER_L : 0, lp = ph >= PH_L0 && ph < PH_FINAL ? (ph - PH_L0) % PH_PER_L : -1, tb = T_L0 + l * T_PER_L;
        if (ph == PH_ADA) save(&dc, stream, T_MOD, ws + WS_MOD, K_F32, NADA, 0, NL * NMOD, NADA);
        if (lp == LP_NORM1) save(&dc, stream, tb + T_H1, ws + WS_H, K_BF16, D, 0, M, D);
        if (lp == LP_IN) { save(&dc, stream, tb + T_Q, ws + WS_Q, K_QPERM, 1024, 0, M, 1024); save(&dc, stream, tb + T_K, ws + WS_K, K_QPERM, 256, 0, M, 256); save(&dc, stream, tb + T_V, ws + WS_V, K_BF16, 256, 0, M, 256);
            save(&dc, stream, tb + T_U, ws + WS_U, K_F32, 512, 0, M, 512); save(&dc, stream, tb + T_PR, ws + WS_PR, K_F32, 2048, 0, M, RP); }
        if (lp == LP_SCAN) { save(&dc, stream, tb + T_OA, ws + WS_CAT, K_BF16, D, 0, M, 1024); save(&dc, stream, tb + T_ZP, ws + WS_CAT, K_BF16, D, 1024, M, 512); }
        if (lp == LP_SCAN) {
            for (int i = 0; i < 7; ++i) save(&dc, stream, tb + T_R + i, ws + WS_RW + (size_t)i * RW_STRIDE, K_F32, 512, 0, M, 512);
            if (l == 1) { save(&dc, stream, 59, ws + WS_RW + (size_t)RW_Y * RW_STRIDE, K_F32, 512, 0, M, 512); save(&dc, stream, 60, ws + WS_H, K_F32, 32, 0, M, 32); } }
        if (lp == LP_SCAN) save(&dc, stream, tb + T_GT, ws + WS_GT, K_BF16, 6144, 0, M, 6144);
        if (lp == LP_SCAN) save(&dc, stream, tb + T_Y, ws + WS_RW + (size_t)RW_Y * RW_STRIDE, K_F32, 512, 0, M, 512);
        if (lp == LP_POST) save(&dc, stream, tb + T_YR, ws + WS_CAT, K_BF16, D, 1536, M, 512);
        if (lp == LP_MG) save(&dc, stream, tb + T_MG, ws + WS_MG, K_BF16, D, 0, M, D);
        if (lp == LP_NORM2) { save(&dc, stream, tb + T_X1, ws + WS_X, K_F32, D, 0, M, D); save(&dc, stream, tb + T_H2, ws + WS_H, K_BF16, D, 0, M, D); }
        if (lp == LP_GU) save(&dc, stream, tb + T_ACT, ws + WS_GT, K_BF16, DFF, 0, M, DFF);
        if ((lp == LP_NORM1 && l > 0) || ph == PH_FINAL) save(&dc, stream, T_L0 + (ph == PH_FINAL ? 1 : l - 1) * T_PER_L + T_X2, ws + WS_X, K_F32, D, 0, M, D);
    }
    const size_t ooff[13] = {O_YP, O_YS, O_KP, O_VP, O_PP, O_SP, O_WP, O_KS, O_VS, O_PS, O_SS, O_WS, O_END}; const int ocol[12] = {2048, 2048, 256, 256, 512, 1984, 64, 256, 256, 512, 1984, 64};
    for (int i = 0; i < 12; ++i) dbg::save(&dc, stream, dbg::T_OUT0 + i, (float*)d_out + ooff[i], dbg::K_F32, ocol[i], 0, (int)((ooff[i + 1] - ooff[i]) / ocol[i]), ocol[i]);
    nv::In in; for (int i = 0; i < 39; ++i) in.p[i] = (const float*)d_in[i];
    nv::forward(in, (float*)d_out, (float*)d_ws, stream, &dc);
    for (int i = 0; i < 12; ++i) dbg::cmp(&dc, stream, dbg::T_OUT0 + i, (float*)d_out + ooff[i], ocol[i], 0, (int)((ooff[i + 1] - ooff[i]) / ocol[i]), ocol[i]);
#ifndef DBG_WANT_ID
#define DBG_WANT_ID -1
#endif
    dbg::inject<<<1, 1, 0, stream>>>(dc.err, (float*)d_out, (float*)d_out + O_YS, DBG_WANT_ID >= 0 ? dbg::NIDS : dbg::T_N, DBG_WANT_ID);
#else
    a.ph_lo = 0; a.ph_hi = N_PHASES;
    void* kargs[] = {&a};
    const hipError_t e = hipLaunchCooperativeKernel((const void*)mega, dim3(grid), dim3(NTHR), kargs, LDS_BYTES, stream);
    if (e != hipSuccess) fprintf(stderr, "kernel_launch: cooperative launch failed: %s (grid %d)\n", hipGetErrorString(e), grid);
#endif
}
```

```cpp
#define MK_DEBUG 0
#include <hip/hip_runtime.h>
#include <hip/hip_cooperative_groups.h>
#include <cstdio>
#include <cstdint>
namespace dbg {
constexpr int NPROBE = 16384, NSPECIAL = 2048, NIDS = 64;
struct Ctx { float* probes; float* err; int on; };
__device__ __forceinline__ unsigned hash32(unsigned x) { x ^= x >> 16; x *= 0x7feb352dU; x ^= x >> 15; x *= 0x846ca68bU; x ^= x >> 16; return x; }
__device__ __forceinline__ void probe_rc(int id, int k, int R, int C, int& r, int& c) {
    const unsigned h1 = hash32((unsigned)(id * 1000003 + k * 2 + 1)), h2 = hash32((unsigned)(id * 7919 + k * 2 + 77777));
    c = (int)(h2 % (unsigned)C);
    if (R == 8320 && k < NSPECIAL) { const int sp[16] = {0, 1, 15, 16, 127, 128, 129, 4095, 4096, 4097, 8190, 8191, 8192, 8193, 8255, 8319}; r = sp[k >> 7]; }
    else r = (int)(h1 % (unsigned)R);
}
enum { K_F32 = 0, K_BF16 = 1, K_QPERM = 2 };
__device__ __forceinline__ float opt_read(const void* p, int kind, size_t ld, int coff, int r, int c) {
    if (kind == K_F32) return ((const float*)p)[(size_t)r * ld + coff + c];
    if (kind == K_QPERM) { const int h = c >> 6, d = c & 63, pp = 32 * ((d >> 4) & 1) + 8 * ((d >> 2) & 3) + 4 * (d >> 5) + (d & 3); c = h * 64 + pp; }
    const unsigned short b = ((const unsigned short*)p)[(size_t)r * ld + coff + c]; return __builtin_bit_cast(float, (unsigned)b << 16);
}
__global__ void probe_save(float* probes, int id, const void* p, int kind, size_t ld, int coff, int R, int C) {
    const int k = blockIdx.x * blockDim.x + threadIdx.x; if (k >= NPROBE) return; int r, c; probe_rc(id, k, R, C, r, c);
    probes[(size_t)id * NPROBE + k] = opt_read(p, kind, ld, coff, r, c);
}
__global__ void probe_cmp(const float* probes, float* err, int id, const float* gold, size_t ld, int coff, int R, int C, int sig) {
    const int k = blockIdx.x * blockDim.x + threadIdx.x; if (k >= NPROBE) return; int r, c; probe_rc(id, k, R, C, r, c);
    float g = gold[(size_t)r * ld + coff + c]; if (sig) g = 1.f / (1.f + expf(-g));
    float o = probes[(size_t)id * NPROBE + k]; float d = o - g; if (!(d == d) || fabsf(d) > 1e18f) d = 1e18f;
    const int sp = (R == 8320 && k < NSPECIAL) ? 0 : 2;
    atomicAdd(&err[id * 4 + sp], d * d); atomicAdd(&err[id * 4 + sp + 1], g * g);
}
__global__ void inject(const float* err, float* out, float* ys, int nids, int want_id) {
    if (threadIdx.x || blockIdx.x) return;
    int rid = 89, which = 0; float rel = 1e-3f;
    for (int id = 0; id < nids; ++id) {
        const float r_rand = sqrtf(err[id * 4 + 2] / fmaxf(err[id * 4 + 3], 1e-30f)), r_sp = err[id * 4 + 1] > 0.f ? sqrtf(err[id * 4 + 0] / fmaxf(err[id * 4 + 1], 1e-30f)) : 0.f;
        if (want_id >= 0) { if (id == want_id) { rid = id; which = 0; rel = r_rand; break; } continue; }
        if (r_rand > 0.05f) { rid = id; which = 0; rel = r_rand; break; } else if (r_sp > 0.10f) { rid = id; which = 1; rel = r_sp; break; } }
    const float c1 = (float)(10 + rid) * (which ? 1e5f : 1e3f); float f = (log10f(fmaxf(rel, 1e-3f)) + 3.f) * 0.25f; f = fminf(fmaxf(f, 0.f), 1.f);
    out[0] = c1; ys[0] = c1 * (0.2f + 0.6f * f);
}
inline void save(const Ctx* c, hipStream_t st, int id, const void* p, int kind, size_t ld, int coff, int R, int C) { if (c && c->on) probe_save<<<NPROBE / 256, 256, 0, st>>>(c->probes, id, p, kind, ld, coff, R, C); }
inline void cmp(const Ctx* c, hipStream_t st, int id, const float* gold, size_t ld, int coff, int R, int C, int sig = 0) { if (c && c->on) probe_cmp<<<NPROBE / 256, 256, 0, st>>>(c->probes, c->err, id, gold, ld, coff, R, C, sig); }
enum { T_MOD = 0, T_L0 = 1, T_PER_L = 23, T_OUT0 = T_L0 + 2 * T_PER_L, T_N = T_OUT0 + 12 };
enum { T_H1 = 0, T_Q, T_K, T_V, T_U, T_PR, T_GT, T_OA, T_ZP, T_R, T_W, T_KK, T_VV, T_A, T_B, T_G, T_Y, T_YR, T_MG, T_X1, T_H2, T_ACT, T_X2 };
}
namespace nv {
constexpr int D = 2048, SEQ = 4096, NB = 2, MP = NB * SEQ, NS = 128, M = MP + NS, NL = 2;
constexpr int INW = 10176, OQ = 0, OK_ = 1024, OV = 1280, OU = 1536, OPR = 2048, OGL = 4032;
constexpr int RP = 1984, DFF = 5632, NMOD = NB + NS;
constexpr int PASTLEN = 8192;

__device__ __forceinline__ float sigm(float x) { return 1.f / (1.f + expf(-x)); }
__device__ __forceinline__ float silu(float x) { return x / (1.f + expf(-x)); }
__device__ __forceinline__ int modrow(int m) { return m < MP ? m / SEQ : NB + (m - MP); }
__device__ __forceinline__ int posof(int m) { return m < MP ? m % SEQ : PASTLEN; }

__global__ void __launch_bounds__(256) gemm(const float* __restrict__ A, int lda, const float* __restrict__ B, int ldb, float* __restrict__ C, int ldc, int Mm, int N, int K) {
    __shared__ float As[16][68], Bs[16][68];
    const int tx = threadIdx.x & 15, ty = threadIdx.x >> 4, m0 = blockIdx.y * 64, n0 = blockIdx.x * 64;
    float acc[4][4];
#pragma unroll
    for (int i = 0; i < 4; ++i)
#pragma unroll
        for (int j = 0; j < 4; ++j) acc[i][j] = 0.f;
    for (int k0 = 0; k0 < K; k0 += 16) {
        for (int i = threadIdx.x; i < 1024; i += 256) { const int r = i >> 4, c = i & 15; As[c][r] = (m0 + r < Mm) ? A[(size_t)(m0 + r) * lda + k0 + c] : 0.f; }
        for (int i = threadIdx.x; i < 1024; i += 256) { const int r = i >> 6, c = i & 63; Bs[r][c] = (n0 + c < N) ? B[(size_t)(k0 + r) * ldb + n0 + c] : 0.f; }
        __syncthreads();
#pragma unroll
        for (int kk = 0; kk < 16; ++kk) {
            float a[4], b[4];
#pragma unroll
            for (int i = 0; i < 4; ++i) { a[i] = As[kk][ty * 4 + i]; b[i] = Bs[kk][tx * 4 + i]; }
#pragma unroll
            for (int i = 0; i < 4; ++i)
#pragma unroll
                for (int j = 0; j < 4; ++j) acc[i][j] += a[i] * b[j];
        }
        __syncthreads();
    }
#pragma unroll
    for (int i = 0; i < 4; ++i)
#pragma unroll
        for (int j = 0; j < 4; ++j) { const int m = m0 + ty * 4 + i, n = n0 + tx * 4 + j; if (m < Mm && n < N) C[(size_t)m * ldc + n] = acc[i][j]; }
}

__global__ void silu_c(const float* cp, const float* cs, float* out) {
    const int i = blockIdx.x * blockDim.x + threadIdx.x; if (i >= NMOD * D) return;
    const int r = i / D, k = i % D; const float c = r < NB ? cp[r * D + k] : cs[(r - NB) * D + k]; out[i] = silu(c);
}
__global__ void add_bias(float* mod, const float* b, int n, int N) { const int i = blockIdx.x * blockDim.x + threadIdx.x; if (i < n) mod[i] += b[i % N]; }

__global__ void __launch_bounds__(256) modnorm(const float* xa, const float* xb, const float* g, const float* mod, int sh_off, int sc_off, float* out, size_t out_split_off) {
    const int m = blockIdx.x; const float* x = m < MP ? xa + (size_t)m * D : xb + (size_t)(m - MP) * D;
    __shared__ float red[256]; float s = 0.f;
    for (int k = threadIdx.x; k < D; k += 256) { const float v = x[k]; s += v * v; }
    red[threadIdx.x] = s; __syncthreads();
    for (int o = 128; o > 0; o >>= 1) { if (threadIdx.x < o) red[threadIdx.x] += red[threadIdx.x + o]; __syncthreads(); }
    const float rs = rsqrtf(red[0] / D + 1e-6f); const int br = modrow(m);
    float* o = m < MP ? out + (size_t)m * D : out + out_split_off + (size_t)(m - MP) * D;
    for (int k = threadIdx.x; k < D; k += 256) { float v = x[k] * rs * g[k]; if (mod) v = v * (1.f + mod[(size_t)br * 6 * D + sc_off + k]) + mod[(size_t)br * 6 * D + sh_off + k]; o[k] = v; }
}

__global__ void rope(float* z) {
    const int i = blockIdx.x * blockDim.x + threadIdx.x; if (i >= M * 20 * 32) return;
    const int m = i / 640, hh = (i / 32) % 20, d = i % 32; const float pos = (float)posof(m);
    const float inv = powf(10000.f, -(float)d * 2.0f / 64.f), ang = pos * inv, c = cosf(ang), s = sinf(ang);
    float* p = z + (size_t)m * INW + hh * 64; const float x1 = p[d], x2 = p[d + 32]; p[d] = x1 * c - x2 * s; p[d + 32] = x2 * c + x1 * s;
}

__global__ void attn_prompt(const float* z, const float* sink, float* oattn) {
    const int i = blockIdx.x * blockDim.x + threadIdx.x; if (i >= MP * 16) return;
    const int m = i / 16, hq = i % 16, hk = hq / 4, t = m % SEQ; const float* q = z + (size_t)m * INW + OQ + hq * 64;
    const int lo = t - 128 < 0 ? 0 : t - 128; const float sk = sink[hq];
    float mx = sk;
    for (int kp = lo; kp <= t; ++kp) { const float* k = z + (size_t)(m - t + kp) * INW + OK_ + hk * 64; float s = 0.f; for (int d = 0; d < 64; ++d) s += q[d] * k[d]; s *= 0.125f; mx = fmaxf(mx, s); }
    float den = expf(sk - mx); float o[64];
#pragma unroll
    for (int d = 0; d < 64; ++d) o[d] = 0.f;
    for (int kp = lo; kp <= t; ++kp) { const float* k = z + (size_t)(m - t + kp) * INW + OK_ + hk * 64; const float* v = z + (size_t)(m - t + kp) * INW + OV + hk * 64; float s = 0.f; for (int d = 0; d < 64; ++d) s += q[d] * k[d]; s *= 0.125f;
        const float p = expf(s - mx); den += p;
#pragma unroll
        for (int d = 0; d < 64; ++d) o[d] += p * v[d]; }
#pragma unroll
    for (int d = 0; d < 64; ++d) oattn[(size_t)m * 1024 + hq * 64 + d] = o[d] / den;
}
__global__ void attn_sample(const float* z, const float* sink, const float* ck, const float* cv, float* oattn) {
    const int i = blockIdx.x * blockDim.x + threadIdx.x; if (i >= NS * 16) return;
    const int s_ = i / 16, hq = i % 16, hk = hq / 4, m = MP + s_; const float* q = z + (size_t)m * INW + OQ + hq * 64; const float sk = sink[hq];
    float mx = sk;
    for (int j = 0; j <= 128; ++j) { const float* k = j < 128 ? ck + ((size_t)(s_ * 128 + j) * 4 + hk) * 64 : z + (size_t)m * INW + OK_ + hk * 64; float s = 0.f; for (int d = 0; d < 64; ++d) s += q[d] * k[d]; s *= 0.125f; mx = fmaxf(mx, s); }
    float den = expf(sk - mx); float o[64];
#pragma unroll
    for (int d = 0; d < 64; ++d) o[d] = 0.f;
    for (int j = 0; j <= 128; ++j) { const float* k = j < 128 ? ck + ((size_t)(s_ * 128 + j) * 4 + hk) * 64 : z + (size_t)m * INW + OK_ + hk * 64;
        const float* v = j < 128 ? cv + ((size_t)(s_ * 128 + j) * 4 + hk) * 64 : z + (size_t)m * INW + OV + hk * 64; float s = 0.f; for (int d = 0; d < 64; ++d) s += q[d] * k[d]; s *= 0.125f;
        const float p = expf(s - mx); den += p;
#pragma unroll
        for (int d = 0; d < 64; ++d) o[d] += p * v[d]; }
#pragma unroll
    for (int d = 0; d < 64; ++d) oattn[(size_t)m * 1024 + hq * 64 + d] = o[d] / den;
}
__global__ void kv_out(const float* z, const float* ck, const float* cv, float* kp, float* vp, float* ks, float* vs) {
    const int i = blockIdx.x * blockDim.x + threadIdx.x;
    if (i < NB * 128 * 256) { const int b = i / (128 * 256), j = (i / 256) % 128, c = i % 256; const size_t m = (size_t)b * SEQ + SEQ - 128 + j; kp[i] = z[m * INW + OK_ + c]; vp[i] = z[m * INW + OV + c]; }
    if (i < NS * 128 * 256) { const int s_ = i / (128 * 256), j = (i / 256) % 128, c = i % 256;
        if (j < 127) { ks[i] = ck[i + 256]; vs[i] = cv[i + 256]; } else { ks[i] = z[(size_t)(MP + s_) * INW + OK_ + c]; vs[i] = z[(size_t)(MP + s_) * INW + OV + c]; } }
}
__global__ void pool_d(const float* z, const float* spool, float* dbuf) {
    const int i = blockIdx.x * blockDim.x + threadIdx.x; if (i >= M * 512) return;
    const int m = i / 512, c = i % 512, gi = c / 128, w = 2 << gi; float sum = 0.f; float cnt;
    if (m < MP) { const int t = m % SEQ; for (int j = 0; j < w; ++j) if (t - j >= 0) sum += z[(size_t)(m - j) * INW + OU + c]; cnt = (float)(t + 1 < w ? t + 1 : w); }
    else { const int s_ = m - MP; sum = z[(size_t)m * INW + OU + c]; for (int j = 1; j < w; ++j) sum += spool[((size_t)s_ * 15 + 15 - j) * 512 + c]; cnt = (float)w; }
    dbuf[i] = sum / cnt - z[(size_t)m * INW + OU + c];
}
__global__ void pool_z(const float* dbuf, const float* pw, const float* pscale, float* zpool) {
    const int i = blockIdx.x * blockDim.x + threadIdx.x; if (i >= M * 512) return;
    const int m = i / 512, c = i % 512, gi = c / 128, e = c % 128; float s = 0.f;
    for (int k = 0; k < 128; ++k) s += dbuf[(size_t)m * 512 + gi * 128 + k] * pw[(gi * 128 + k) * 128 + e];
    zpool[i] = s * pscale[c];
}
__global__ void pool_out(const float* z, const float* spool, float* pp, float* ps) {
    const int i = blockIdx.x * blockDim.x + threadIdx.x;
    if (i < NB * 15 * 512) { const int b = i / (15 * 512), j = (i / 512) % 15, c = i % 512; pp[i] = z[((size_t)b * SEQ + SEQ - 15 + j) * INW + OU + c]; }
    if (i < NS * 15 * 512) { const int s_ = i / (15 * 512), j = (i / 512) % 15, c = i % 512; ps[i] = j < 14 ? spool[i + 512] : z[(size_t)(MP + s_) * INW + OU + c]; }
}
__global__ void rwkv_xm(const float* z, const float* sshift, const float* mu, float* xm) {
    const int i = blockIdx.x * blockDim.x + threadIdx.x; if (i >= M * RP) return;
    const int m = i / RP, c = i % RP; const float p = z[(size_t)m * INW + OPR + c]; float pv;
    if (m < MP) pv = (m % SEQ) ? z[(size_t)(m - 1) * INW + OPR + c] : 0.f; else pv = sshift[(size_t)(m - MP) * RP + c];
    xm[i] = p + (pv - p) * mu[c];
}
__global__ void shift_out(const float* z, float* sp, float* ss) {
    const int i = blockIdx.x * blockDim.x + threadIdx.x;
    if (i < NB * RP) { const int b = i / RP, c = i % RP; sp[i] = z[((size_t)b * SEQ + SEQ - 1) * INW + OPR + c]; }
    if (i < NS * RP) { const int s_ = i / RP, c = i % RP; ss[i] = z[(size_t)(MP + s_) * INW + OPR + c]; }
}
__global__ void __launch_bounds__(64) rwkv_prep(const float* xm, const float* w0, const float* w2, const float* a0, const float* a2, const float* g2, const float* k_k, const float* k_a,
                                                 const float* T2, const float* vb, float* vfirst, int has_vres,
                                                 float* R, float* W, float* Kk, float* V, float* A, float* Bb, float* G) {
    const int m = blockIdx.x / 8, h = blockIdx.x % 8, c = h * 64 + threadIdx.x; const float* x = xm + (size_t)m * RP;
    float s = w0[c]; for (int k = 0; k < 96; ++k) s += tanhf(x[1536 + k]) * w2[k * 512 + c];
    const float z_ = -s; const float sp = z_ > 20.f ? z_ : log1pf(expf(z_)); const float wlog = -sp - 0.5f; const float decay = expf(-expf(wlog));
    float sa = a0[c]; for (int k = 0; k < 96; ++k) sa += x[1632 + k] * a2[k * 512 + c]; const float a = sigm(sa);
    float g = 0.f; for (int k = 0; k < 256; ++k) g += sigm(x[1728 + k]) * g2[k * 512 + c];
    float v = x[1024 + c];
    if (!has_vres) vfirst[(size_t)m * 512 + c] = v;
    else { const float acc = vb[c] + T2[(size_t)m * 512 + c]; v = v + (vfirst[(size_t)m * 512 + c] - v) * sigm(acc); }
    const float r = x[c], k = x[512 + c]; float kk = k * k_k[c];
    __shared__ float red[64]; red[threadIdx.x] = kk * kk; __syncthreads();
    for (int o = 32; o > 0; o >>= 1) { if (threadIdx.x < o) red[threadIdx.x] += red[threadIdx.x + o]; __syncthreads(); }
    kk = kk / fmaxf(sqrtf(red[0]), 1e-12f); const float k2 = k * (1.f + (a - 1.f) * k_a[c]);
    const size_t o = (size_t)m * 512 + c; R[o] = r; W[o] = decay; Kk[o] = k2; V[o] = v; A[o] = -kk; Bb[o] = kk * a; G[o] = g;
}
__global__ void __launch_bounds__(64) rwkv_scan(const float* R, const float* W, const float* Kk, const float* V, const float* A, const float* Bb, const float* S0, float* Sout, float* Y, int row0, int T) {
    const int seq = blockIdx.x / 8, h = blockIdx.x % 8, i = threadIdx.x; float S[64];
#pragma unroll
    for (int j = 0; j < 64; ++j) S[j] = S0 ? S0[(((size_t)seq * 8 + h) * 64 + i) * 64 + j] : 0.f;
    __shared__ float sr[16][64], sw[16][64], sk[16][64], sa[16][64], sb[16][64], sv[16][64];
    for (int t0 = 0; t0 < T; t0 += 16) { const int nt = T - t0 < 16 ? T - t0 : 16;
        __syncthreads();
        for (int tt = 0; tt < nt; ++tt) { const size_t o = ((size_t)row0 + (size_t)seq * T + t0 + tt) * 512 + h * 64 + i; sr[tt][i] = R[o]; sw[tt][i] = W[o]; sk[tt][i] = Kk[o]; sa[tt][i] = A[o]; sb[tt][i] = Bb[o]; sv[tt][i] = V[o]; }
        __syncthreads();
        for (int tt = 0; tt < nt; ++tt) { float dot = 0.f; const float v = sv[tt][i];
#pragma unroll
            for (int j = 0; j < 64; ++j) dot += S[j] * sa[tt][j];
            float y = 0.f;
#pragma unroll
            for (int j = 0; j < 64; ++j) { S[j] = S[j] * sw[tt][j] + dot * sb[tt][j] + v * sk[tt][j]; y += S[j] * sr[tt][j]; }
            Y[((size_t)row0 + (size_t)seq * T + t0 + tt) * 512 + h * 64 + i] = y; } }
#pragma unroll
    for (int j = 0; j < 64; ++j) Sout[(((size_t)seq * 8 + h) * 64 + i) * 64 + j] = S[j];
}
__global__ void __launch_bounds__(64) rwkv_post(const float* Y, const float* R, const float* Kk, const float* V, const float* G, const float* r_k, const float* lg, const float* lb, float* yout) {
    const int m = blockIdx.x / 8, h = blockIdx.x % 8, i = threadIdx.x, c = h * 64 + i; const size_t o = (size_t)m * 512 + c;
    __shared__ float red[64]; const float y = Y[o];
    red[i] = y; __syncthreads(); for (int s = 32; s > 0; s >>= 1) { if (i < s) red[i] += red[i + s]; __syncthreads(); } const float mu = red[0] / 64.f; __syncthreads();
    red[i] = (y - mu) * (y - mu); __syncthreads(); for (int s = 32; s > 0; s >>= 1) { if (i < s) red[i] += red[i + s]; __syncthreads(); } const float var = red[0] / 64.f; __syncthreads();
    red[i] = R[o] * Kk[o] * r_k[c]; __syncthreads(); for (int s = 32; s > 0; s >>= 1) { if (i < s) red[i] += red[i + s]; __syncthreads(); } const float bon = red[0];
    yout[o] = ((y - mu) * rsqrtf(var + 64e-5f) * lg[c] + lb[c] + bon * V[o]) * G[o];
}
__global__ void merge_acc(const float* z, const float* P, int goff, float* merged, int first) {
    const int i = blockIdx.x * blockDim.x + threadIdx.x; if (i >= M * D) return; const int m = i / D, n = i % D;
    const float v = sigm(z[(size_t)m * INW + OGL + goff + n]) * P[i]; merged[i] = first ? v : merged[i] + v;
}
__global__ void resid(const float* xa, const float* xb, const float* P, const float* mod, int gt_off, float* xout) {
    const int i = blockIdx.x * blockDim.x + threadIdx.x; if (i >= M * D) return; const int m = i / D, n = i % D;
    const float x = m < MP ? xa[i] : xb[(size_t)(m - MP) * D + n]; xout[i] = x + (1.f + mod[(size_t)modrow(m) * 6 * D + gt_off + n]) * P[i];
}
__global__ void swiglu(const float* gbuf, const float* ubuf, float* act, int n) { const int i = blockIdx.x * blockDim.x + threadIdx.x; if (i < n) act[i] = silu(gbuf[i]) * ubuf[i]; }

struct In { const float* p[39]; };
inline void G(hipStream_t st, const float* A, int lda, const float* B, int ldb, float* C, int ldc, int Mm, int N, int K) { gemm<<<dim3((N + 63) / 64, (Mm + 63) / 64), 256, 0, st>>>(A, lda, B, ldb, C, ldc, Mm, N, K); }
#define EW(n) ((int)(((size_t)(n) + 255) / 256)), 256, 0, st

struct WS { float *silc, *mod, *h, *z, *xm, *R, *W, *K, *V, *A, *B, *G, *Y, *vfirst, *dbuf, *cat_a, *cat_p, *cat_r, *P, *merged, *x1, *xres, *fg, *fu, *T1; };
inline size_t carve(float* base, WS& w) {
    size_t o = 0; auto take = [&](size_t n) { float* p = base + o; o += (n + 63) & ~(size_t)63; return p; };
    w.silc = take((size_t)NMOD * D); w.mod = take((size_t)NL * NMOD * 6 * D); w.T1 = take((size_t)M * 32);
    w.h = take((size_t)M * D); w.P = w.h;
    w.xm = take((size_t)M * D); w.x1 = w.xm;
    w.cat_a = take((size_t)M * 1024); w.cat_p = take((size_t)M * 512); w.cat_r = take((size_t)M * 512); w.xres = take((size_t)M * D);
    w.z = take((size_t)M * INW);
    w.R = take((size_t)M * 512); w.W = take((size_t)M * 512); w.K = take((size_t)M * 512); w.V = take((size_t)M * 512); w.A = take((size_t)M * 512); w.B = take((size_t)M * 512); w.G = take((size_t)M * 512);
    w.Y = take((size_t)M * 512); w.vfirst = take((size_t)M * 512); w.dbuf = take((size_t)M * 512);
    w.merged = w.R;
    w.fg = w.z; w.fu = w.z + (size_t)M * DFF;
    return o;
}
constexpr size_t O_YP = 0, O_YS = O_YP + (size_t)MP * D, O_KP = O_YS + (size_t)NS * D, O_VP = O_KP + (size_t)NL * NB * 128 * 256, O_PP = O_VP + (size_t)NL * NB * 128 * 256,
                 O_SP = O_PP + (size_t)NL * NB * 15 * 512, O_WP = O_SP + (size_t)NL * NB * RP, O_KS = O_WP + (size_t)NL * NB * 8 * 4096, O_VS = O_KS + (size_t)NL * NS * 128 * 256,
                 O_PS = O_VS + (size_t)NL * NS * 128 * 256, O_SS = O_PS + (size_t)NL * NS * 15 * 512, O_WS = O_SS + (size_t)NL * NS * RP, O_END = O_WS + (size_t)NL * NS * 8 * 4096;

inline void forward(const In& in, float* out, float* wsf, hipStream_t st, const dbg::Ctx* dc = nullptr) {
    using namespace dbg;
    WS w; carve(wsf, w);
    const float *xp = in.p[0], *xs = in.p[1];
    silu_c<<<EW(NMOD * D)>>>(in.p[2], in.p[3], w.silc);
    for (int l = 0; l < NL; ++l) { G(st, w.silc, D, in.p[9] + (size_t)l * D * 6 * D, 6 * D, w.mod + (size_t)l * NMOD * 6 * D, 6 * D, NMOD, 6 * D, D);
        add_bias<<<EW(NMOD * 6 * D)>>>(w.mod + (size_t)l * NMOD * 6 * D, in.p[10] + (size_t)l * 6 * D, NMOD * 6 * D, 6 * D); }
    cmp(dc, st, T_MOD, w.mod, 6 * D, 0, NL * NMOD, 6 * D);
    const float* xa = xp; const float* xb = xs;
    for (int l = 0; l < NL; ++l) {
        const float* mod = w.mod + (size_t)l * NMOD * 6 * D; const int tb = T_L0 + l * T_PER_L;
        modnorm<<<M, 256, 0, st>>>(xa, xb, in.p[11] + l * D, mod, 0, D, w.h, (size_t)MP * D);
        cmp(dc, st, tb + T_H1, w.h, D, 0, M, D);
        G(st, w.h, D, in.p[13] + (size_t)l * D * INW, INW, w.z, INW, M, INW, D);
        rope<<<EW(M * 640)>>>(w.z);
        cmp(dc, st, tb + T_Q, w.z, INW, OQ, M, 1024); cmp(dc, st, tb + T_K, w.z, INW, OK_, M, 256); cmp(dc, st, tb + T_V, w.z, INW, OV, M, 256); cmp(dc, st, tb + T_U, w.z, INW, OU, M, 512);
        cmp(dc, st, tb + T_PR, w.z, INW, OPR, M, RP); cmp(dc, st, tb + T_GT, w.z, INW, OGL, M, 6144, 1);
        const float* ck = in.p[4] + (size_t)l * NS * 128 * 256; const float* cv = in.p[5] + (size_t)l * NS * 128 * 256;
        attn_prompt<<<(MP * 16 + 63) / 64, 64, 0, st>>>(w.z, in.p[14] + l * 16, w.cat_a);
        attn_sample<<<(NS * 16 + 63) / 64, 64, 0, st>>>(w.z, in.p[14] + l * 16, ck, cv, w.cat_a);
        kv_out<<<EW(NS * 128 * 256)>>>(w.z, ck, cv, out + O_KP + (size_t)l * NB * 128 * 256, out + O_VP + (size_t)l * NB * 128 * 256, out + O_KS + (size_t)l * NS * 128 * 256, out + O_VS + (size_t)l * NS * 128 * 256);
        const float* sp = in.p[6] + (size_t)l * NS * 15 * 512;
        pool_d<<<EW(M * 512)>>>(w.z, sp, w.dbuf);
        pool_z<<<EW(M * 512)>>>(w.dbuf, in.p[16] + (size_t)l * 4 * 128 * 128, in.p[17] + l * 512, w.cat_p);
        pool_out<<<EW(NS * 15 * 512)>>>(w.z, sp, out + O_PP + (size_t)l * NB * 15 * 512, out + O_PS + (size_t)l * NS * 15 * 512);
        rwkv_xm<<<EW((size_t)M * RP)>>>(w.z, in.p[7] + (size_t)l * NS * RP, in.p[19] + l * RP, w.xm);
        shift_out<<<EW(NS * RP)>>>(w.z, out + O_SP + (size_t)l * NB * RP, out + O_SS + (size_t)l * NS * RP);
        if (l > 0) { G(st, w.xm + 1024, RP, in.p[31], 32, w.T1, 32, M, 32, 512); G(st, w.T1, 32, in.p[32], 512, w.dbuf, 512, M, 512, 32); }
        if (l > 0) { cmp(dc, st, 59, w.dbuf, 512, 0, M, 512); cmp(dc, st, 60, w.T1, 32, 0, M, 32); }
        rwkv_prep<<<M * 8, 64, 0, st>>>(w.xm, in.p[20] + l * 512, in.p[21] + (size_t)l * 96 * 512, in.p[22] + l * 512, in.p[23] + (size_t)l * 96 * 512, in.p[24] + (size_t)l * 256 * 512, in.p[25] + l * 512, in.p[26] + l * 512,
                                         w.dbuf, in.p[33], w.vfirst, l > 0, w.R, w.W, w.K, w.V, w.A, w.B, w.G);
        cmp(dc, st, tb + T_OA, w.cat_a, 1024, 0, M, 1024); cmp(dc, st, tb + T_ZP, w.cat_p, 512, 0, M, 512);
        cmp(dc, st, tb + T_R, w.R, 512, 0, M, 512); cmp(dc, st, tb + T_W, w.W, 512, 0, M, 512); cmp(dc, st, tb + T_KK, w.K, 512, 0, M, 512); cmp(dc, st, tb + T_VV, w.V, 512, 0, M, 512);
        cmp(dc, st, tb + T_A, w.A, 512, 0, M, 512); cmp(dc, st, tb + T_B, w.B, 512, 0, M, 512); cmp(dc, st, tb + T_G, w.G, 512, 0, M, 512);
        rwkv_scan<<<NB * 8, 64, 0, st>>>(w.R, w.W, w.K, w.V, w.A, w.B, nullptr, out + O_WP + (size_t)l * NB * 8 * 4096, w.Y, 0, SEQ);
        rwkv_scan<<<NS * 8, 64, 0, st>>>(w.R, w.W, w.K, w.V, w.A, w.B, in.p[8] + (size_t)l * NS * 8 * 4096, out + O_WS + (size_t)l * NS * 8 * 4096, w.Y, MP, 1);
        cmp(dc, st, tb + T_Y, w.Y, 512, 0, M, 512);
        rwkv_post<<<M * 8, 64, 0, st>>>(w.Y, w.R, w.K, w.V, w.G, in.p[27] + l * 512, in.p[28] + l * 512, in.p[29] + l * 512, w.cat_r);
        cmp(dc, st, tb + T_YR, w.cat_r, 512, 0, M, 512);
        G(st, w.cat_a, 1024, in.p[15] + (size_t)l * 1024 * D, D, w.P, D, M, D, 1024); merge_acc<<<EW((size_t)M * D)>>>(w.z, w.P, 0, w.merged, 1);
        G(st, w.cat_p, 512, in.p[18] + (size_t)l * 512 * D, D, w.P, D, M, D, 512);   merge_acc<<<EW((size_t)M * D)>>>(w.z, w.P, D, w.merged, 0);
        G(st, w.cat_r, 512, in.p[30] + (size_t)l * 512 * D, D, w.P, D, M, D, 512);   merge_acc<<<EW((size_t)M * D)>>>(w.z, w.P, 2 * D, w.merged, 0);
        cmp(dc, st, tb + T_MG, w.merged, D, 0, M, D);
        G(st, w.merged, D, in.p[34] + (size_t)l * D * D, D, w.P, D, M, D, D);
        resid<<<EW((size_t)M * D)>>>(xa, xb, w.P, mod, 2 * D, w.x1);
        cmp(dc, st, tb + T_X1, w.x1, D, 0, M, D);
        modnorm<<<M, 256, 0, st>>>(w.x1, w.x1 + (size_t)MP * D, in.p[12] + l * D, mod, 3 * D, 4 * D, w.h, (size_t)MP * D);
        cmp(dc, st, tb + T_H2, w.h, D, 0, M, D);
        G(st, w.h, D, in.p[35] + (size_t)l * D * DFF, DFF, w.fg, DFF, M, DFF, D);
        G(st, w.h, D, in.p[36] + (size_t)l * D * DFF, DFF, w.fu, DFF, M, DFF, D);
        swiglu<<<EW((size_t)M * DFF)>>>(w.fg, w.fu, w.fg, M * DFF);
        cmp(dc, st, tb + T_ACT, w.fg, DFF, 0, M, DFF);
        G(st, w.fg, DFF, in.p[37] + (size_t)l * DFF * D, D, w.P, D, M, D, DFF);
        resid<<<EW((size_t)M * D)>>>(w.x1, w.x1 + (size_t)MP * D, w.P, mod, 5 * D, w.xres);
        cmp(dc, st, tb + T_X2, w.xres, D, 0, M, D);
        xa = w.xres; xb = w.xres + (size_t)MP * D;
    }
    modnorm<<<M, 256, 0, st>>>(xa, xb, in.p[38], nullptr, 0, 0, out + O_YP, (size_t)MP * D);
}
#undef EW
}
namespace mk {
#define LAS __attribute__((address_space(3)))
#define GAS __attribute__((address_space(1)))
typedef unsigned short bf16;
typedef short bf16x8 __attribute__((ext_vector_type(8)));
typedef float f32x4 __attribute__((ext_vector_type(4)));
typedef float f32x2 __attribute__((ext_vector_type(2)));
typedef unsigned u32x4 __attribute__((ext_vector_type(4)));
typedef unsigned u32x2 __attribute__((ext_vector_type(2)));

constexpr int D = 2048, SEQ = 4096, NB = 2, MP = NB * SEQ, NS = 128, M = MP + NS, MPAD = 8448, NL = 2, NMOD = NB + NS;
constexpr int NIN = 10240, NGU = 11264, DFF = 5632, NADA = 6 * D, RP = 1984, PASTLEN = 8192;
constexpr int NWAVES = 8, NTHR = 512;

constexpr size_t al(size_t x) { return (x + 255) & ~(size_t)255; }
constexpr size_t WL_IN = 0, WL_CAT = WL_IN + al((size_t)NIN * D * 2), WL_O = WL_CAT + al((size_t)D * D * 2), WL_GU = WL_O + al((size_t)D * D * 2), WL_DN = WL_GU + al((size_t)NGU * D * 2),
                 WL_W2 = WL_DN + al((size_t)D * DFF * 2), WL_A2 = WL_W2 + al(512 * 96 * 2), WL_G2 = WL_A2 + al(512 * 96 * 2), WL_V1 = WL_G2 + al(512 * 256 * 2), WL_V2 = WL_V1 + al(32 * 512 * 2),
                 WL_PW = WL_V2 + al(512 * 32 * 2), WL_SIZE = WL_PW + al(4 * 128 * 128 * 2);
constexpr size_t WS_W = 0;
constexpr size_t WS_ROPE = WS_W + 2 * WL_SIZE;
constexpr size_t WS_SILC = WS_ROPE + al((size_t)4097 * 64 * 4);
constexpr size_t WS_MOD = WS_SILC + al((size_t)256 * D * 2);
constexpr size_t WS_X = WS_MOD + al((size_t)NL * NMOD * NADA * 4);
constexpr size_t WS_H = WS_X + al((size_t)MPAD * D * 4);
constexpr size_t WS_Q = WS_H + al((size_t)MPAD * D * 2);
constexpr size_t WS_K = WS_Q + al((size_t)MPAD * 1024 * 2);
constexpr size_t WS_V = WS_K + al((size_t)MPAD * 256 * 2);
constexpr size_t WS_U = WS_V + al((size_t)MPAD * 256 * 2);
constexpr size_t WS_PR = WS_U + al((size_t)MPAD * 512 * 4);
constexpr size_t WS_MG = WS_PR;
constexpr size_t WS_CAT = WS_PR + al((size_t)MPAD * D * 4);
constexpr size_t WS_RW = WS_CAT + al((size_t)MPAD * D * 2);
constexpr size_t RW_STRIDE = al((size_t)MPAD * 512 * 4);
constexpr size_t WS_GT = WS_RW + 9 * RW_STRIDE;
constexpr size_t WS_ADAW = WS_GT;
constexpr size_t WS_SLAB = WS_GT + al((size_t)MPAD * 6144 * 2);
constexpr size_t WS_SLABM = WS_SLAB + al((size_t)11 * NS * D * 4);
constexpr size_t WS_CTL = WS_SLABM + al((size_t)4 * NS * D * 4);
constexpr size_t WS_CTL_BYTES = 32768;
constexpr size_t WS_END = WS_CTL + WS_CTL_BYTES;
static_assert((size_t)2 * NADA * D * 2 <= (size_t)MPAD * 6144 * 2, "ada weights fit under the gates");

constexpr size_t O_YP = 0, O_YS = O_YP + (size_t)MP * D, O_KP = O_YS + (size_t)NS * D, O_VP = O_KP + (size_t)NL * NB * 128 * 256, O_PP = O_VP + (size_t)NL * NB * 128 * 256,
                 O_SP = O_PP + (size_t)NL * NB * 15 * 512, O_WP = O_SP + (size_t)NL * NB * RP, O_KS = O_WP + (size_t)NL * NB * 8 * 4096, O_VS = O_KS + (size_t)NL * NS * 128 * 256,
                 O_PS = O_VS + (size_t)NL * NS * 128 * 256, O_SS = O_PS + (size_t)NL * NS * 15 * 512, O_WS = O_SS + (size_t)NL * NS * RP, O_END = O_WS + (size_t)NL * NS * 8 * 4096;

__device__ __forceinline__ unsigned f2bf(float f) { unsigned u = __builtin_bit_cast(unsigned, f); return (u + 0x7fffu + ((u >> 16) & 1u)) >> 16; }
__device__ __forceinline__ unsigned pk2(float lo, float hi) { return f2bf(lo) | (f2bf(hi) << 16); }
__device__ __forceinline__ float bf2f(unsigned short b) { return __builtin_bit_cast(float, (unsigned)b << 16); }
__device__ __forceinline__ float bflo(unsigned w) { return __builtin_bit_cast(float, w << 16); }
__device__ __forceinline__ float bfhi(unsigned w) { return __builtin_bit_cast(float, w & 0xffff0000u); }
__device__ __forceinline__ float fsigm(float x) { return __builtin_amdgcn_rcpf(1.f + __expf(-x)); }
__device__ __forceinline__ float wave_sum(float v) {
#pragma unroll
    for (int o = 1; o < 64; o <<= 1) v += __shfl_xor(v, o);
    return v;
}
__device__ __forceinline__ int modrow(int m) { return m < MP ? (m >> 12) : NB + (m - MP); }
__device__ __forceinline__ int posidx(int m) { return m < MP ? (m & (SEQ - 1)) : 4096; }
__device__ __forceinline__ int pi_d(int p) { return 32 * ((p >> 2) & 1) + 16 * (p >> 5) + 4 * ((p >> 3) & 3) + (p & 3); }

struct Args { const float* in[39]; float* out; unsigned char* ws; int ph_lo, ph_hi; };

struct Frame {
    LAS unsigned char* lds;
    int tid, lane, wave, G, bid;
    float* out; unsigned char* ws;
};
template <int K> __device__ __forceinline__ const float* inp() { GAS const float* p; asm volatile("s_load_dwordx2 %0, %1, %2\n\ts_waitcnt lgkmcnt(0)" : "=s"(p) : "s"(__builtin_amdgcn_kernarg_segment_ptr()), "n"(K * 8) : "memory"); return (const float*)p; }
#define INP(k) inp<k>()
__device__ __forceinline__ unsigned char* wl(const Frame& F, int l, size_t off) { return F.ws + WS_W + (size_t)l * WL_SIZE + off; }
__device__ __forceinline__ float* rwbuf(const Frame& F, int i) { return (float*)(F.ws + WS_RW + (size_t)i * RW_STRIDE); }
enum { RW_R = 0, RW_W, RW_K, RW_V, RW_A, RW_B, RW_G, RW_Y, RW_VF };

struct TSrc { const float* w; long long d2; int ld; int mode; };
__device__ __forceinline__ const float* colsrc(const TSrc& s, int n) {
    if (s.mode == 0) return s.w + n;
    if (s.mode == 1) {
        if (n < 1280) { const int h = n >> 6, p = n & 63; return s.w + h * 64 + pi_d(p); }
        if (n < 4032) return s.w + n;
        if (n < 4096) return nullptr;
        return s.w + (n - 64);
    }
      { const int g8 = n >> 3, i = n & 7; return (const float*)((const char*)s.w + (i < 4 ? 0ll : s.d2)) + 4 * g8 + (i & 3); }
}
__device__ __forceinline__ void transpose_item(const TSrc& s, int K, bf16* WT, size_t ldt, int kcol0, LAS float* scr, int kb, int nb, int lane) {
    const int k0 = 64 * kb, n0 = 32 * nb, gq = lane & 7, kr = lane >> 3;
    const float* cp = colsrc(s, n0 + 4 * gq);
#pragma unroll
    for (int i = 0; i < 8; ++i) { const int kk = 8 * i + kr; const f32x4 v = cp ? *(const f32x4*)(cp + (size_t)(k0 + kk) * s.ld) : (f32x4){0.f, 0.f, 0.f, 0.f};
        LAS float* d = scr + kk * 33 + 4 * gq; d[0] = v.x; d[1] = v.y; d[2] = v.z; d[3] = v.w; }
    asm volatile("s_waitcnt lgkmcnt(0)" ::: "memory");
    const int c = lane & 7;
#pragma unroll
    for (int j = 0; j < 4; ++j) { const int n = (lane >> 3) + 8 * j; const LAS float* p = scr + (8 * c) * 33 + n;
        u32x4 o; o.x = pk2(p[0 * 33], p[1 * 33]); o.y = pk2(p[2 * 33], p[3 * 33]); o.z = pk2(p[4 * 33], p[5 * 33]); o.w = pk2(p[6 * 33], p[7 * 33]);
        *(u32x4*)(WT + (size_t)(n0 + n) * ldt + kcol0 + k0 + 8 * c) = o; }
    asm volatile("s_waitcnt lgkmcnt(0)" ::: "memory");
}
__device__ __forceinline__ void small_transpose(const float* src, int K, int N, bf16* dst, int ldt, int gt, int ngt) {
    for (int i = gt; i < N * K; i += ngt) { const int n = i / K, k = i - n * K; dst[(size_t)n * ldt + k] = (bf16)f2bf(src[(size_t)k * N + n]); }
}
__device__ __forceinline__ void p0_prologue(const Frame& F, int lmask, bool common, int wb, int nwb, int cls) {
    LAS float* scr = (LAS float*)(F.lds + F.wave * 16384);
    const int gw = wb * NWAVES + F.wave, NGW = nwb * NWAVES;
    constexpr int J_ADA = 32 * 384, J_IN = 32 * 320, J_CA = 16 * 64, J_CP = 8 * 64, J_CR = 8 * 64, J_O = 32 * 64, J_GU = 32 * 352, J_DN = 88 * 64;
    constexpr int PER_L = J_ADA + J_IN + J_CA + J_CP + J_CR + J_O + J_GU + J_DN;
    constexpr int TOT = NL * PER_L; const int nrk = cls == 0 ? TOT : cls == 1 ? (TOT / 32) * 27 + (TOT % 32 < 27 ? TOT % 32 : 27) : (TOT / 32) * 5 + (TOT % 32 > 27 ? TOT % 32 - 27 : 0);
    for (int rk = gw; rk < nrk; rk += NGW) {
        const int it = cls == 0 ? rk : cls == 1 ? (rk / 27) * 32 + rk % 27 : (rk / 5) * 32 + 27 + rk % 5;
        const int l = it / PER_L; int r = it - l * PER_L;
        if (r < J_ADA ? !common : !((lmask >> l) & 1)) continue;
        TSrc s; s.d2 = 0; s.mode = 0; bf16* WT; size_t ldt; int K, nn, kcol0 = 0;
        if (r < J_ADA) { s.w = INP(9) + (size_t)l * D * NADA; s.ld = NADA; WT = (bf16*)(F.ws + WS_ADAW) + (size_t)l * NADA * D; ldt = D; K = D; nn = 384; }
        else if ((r -= J_ADA) < J_IN) { s.w = INP(13) + (size_t)l * D * 10176; s.ld = 10176; s.mode = 1; WT = (bf16*)wl(F, l, WL_IN); ldt = D; K = D; nn = 320; }
        else if ((r -= J_IN) < J_CA) { s.w = INP(15) + (size_t)l * 1024 * D; s.ld = D; WT = (bf16*)wl(F, l, WL_CAT); ldt = D; K = 1024; nn = 64; }
        else if ((r -= J_CA) < J_CP) { s.w = INP(18) + (size_t)l * 512 * D; s.ld = D; WT = (bf16*)wl(F, l, WL_CAT); ldt = D; K = 512; nn = 64; kcol0 = 1024; }
        else if ((r -= J_CP) < J_CR) { s.w = INP(30) + (size_t)l * 512 * D; s.ld = D; WT = (bf16*)wl(F, l, WL_CAT); ldt = D; K = 512; nn = 64; kcol0 = 1536; }
        else if ((r -= J_CR) < J_O) { s.w = INP(34) + (size_t)l * D * D; s.ld = D; WT = (bf16*)wl(F, l, WL_O); ldt = D; K = D; nn = 64; }
        else if ((r -= J_O) < J_GU) { s.w = INP(35) + (size_t)l * D * DFF; s.d2 = (const char*)INP(36) - (const char*)INP(35); s.ld = DFF; s.mode = 2; WT = (bf16*)wl(F, l, WL_GU); ldt = D; K = D; nn = 352; }
        else { r -= J_GU; s.w = INP(37) + (size_t)l * DFF * D; s.ld = D; WT = (bf16*)wl(F, l, WL_DN); ldt = DFF; K = DFF; nn = 64; }
        (void)K;
        transpose_item(s, K, WT, ldt, kcol0, scr, r / nn, r % nn, F.lane);
    }
    const int gt = wb * NTHR + F.tid, ngt = nwb * NTHR;
    for (int l = 0; l < NL; ++l) { if (!((lmask >> l) & 1)) continue;
        small_transpose(INP(21) + (size_t)l * 96 * 512, 96, 512, (bf16*)wl(F, l, WL_W2), 96, gt, ngt);
        small_transpose(INP(23) + (size_t)l * 96 * 512, 96, 512, (bf16*)wl(F, l, WL_A2), 96, gt, ngt);
        small_transpose(INP(24) + (size_t)l * 256 * 512, 256, 512, (bf16*)wl(F, l, WL_G2), 256, gt, ngt);
        for (int g = 0; g < 4; ++g) small_transpose(INP(16) + ((size_t)l * 4 + g) * 128 * 128, 128, 128, (bf16*)wl(F, l, WL_PW) + g * 128 * 128, 128, gt, ngt);
    }
    if (lmask & 2) { small_transpose(INP(31), 512, 32, (bf16*)wl(F, 1, WL_V1), 512, gt, ngt);
        small_transpose(INP(32), 32, 512, (bf16*)wl(F, 1, WL_V2), 32, gt, ngt); }
    if (!common) return;
    if (wb == 0 && F.tid < 2) ((unsigned*)(F.ws + WS_CTL))[64 * F.tid] = 0u;
    for (int i = gt; i < 256 * D; i += ngt) { const int r = i >> 11, k = i & (D - 1); float v = 0.f;
        if (r < NMOD) { const float c = r < NB ? INP(2)[r * D + k] : INP(3)[(r - NB) * D + k]; v = c / (1.f + expf(-c)); }
        ((bf16*)(F.ws + WS_SILC))[i] = (bf16)f2bf(v); }
    for (int i = gt; i < 4097 * 32; i += ngt) { const int p = i >> 5, d = i & 31; const float pos = p < 4096 ? (float)p : (float)PASTLEN;
        const float inv = powf(10000.f, -(float)d * (2.0f / 64.f)), ang = pos * inv; float* t = (float*)(F.ws + WS_ROPE) + (size_t)p * 64; t[d] = cosf(ang); t[32 + d] = sinf(ang); }
}

__device__ __forceinline__ void norm_phase(const Frame& F, int l, int which  , int nslab  ) {
    const int gw = F.bid * NWAVES + F.wave, NGW = F.G * NWAVES;
    const float* g = which == 0 ? INP(11) + l * D : which == 1 ? INP(12) + l * D : INP(38); const float* xp0 = INP(0); const float* xp1 = INP(1);
    for (int m = gw; m < M; m += NGW) {
        const float* xr = (which == 0 && l == 0) ? (m < MP ? xp0 + (size_t)m * D : xp1 + (size_t)(m - MP) * D) : (const float*)(F.ws + WS_X) + (size_t)m * D;
        f32x4 v[8], gv[8], shv[8], scv[8]; float s = 0.f;
        const float* mod = (const float*)(F.ws + WS_MOD) + ((size_t)l * NMOD + modrow(m)) * NADA + (which == 0 ? 0 : 3 * D);
#pragma unroll
        for (int j = 0; j < 8; ++j) { v[j] = *(const f32x4*)(xr + j * 256 + F.lane * 4); gv[j] = *(const f32x4*)(g + j * 256 + F.lane * 4);
            if (which != 2) { shv[j] = *(const f32x4*)(mod + j * 256 + F.lane * 4); scv[j] = *(const f32x4*)(mod + D + j * 256 + F.lane * 4); } else { shv[j] = gv[j]; scv[j] = gv[j]; } }
        if (nslab && m >= MP) { const float* sl = (const float*)(F.ws + WS_SLAB) + (size_t)(m - MP) * D + F.lane * 4;
            for (int q = 0; q < nslab; ++q) {
#pragma unroll
                for (int j = 0; j < 8; ++j) v[j] += *(const f32x4*)(sl + (size_t)q * NS * D + j * 256); }
            float* xs = (float*)(F.ws + WS_X) + (size_t)m * D;
#pragma unroll
            for (int j = 0; j < 8; ++j) *(f32x4*)(xs + j * 256 + F.lane * 4) = v[j]; }
#pragma unroll
        for (int j = 0; j < 8; ++j) { s += (v[j].x * v[j].x + v[j].y * v[j].y) + (v[j].z * v[j].z + v[j].w * v[j].w); }
        const float rs = rsqrtf(wave_sum(s) * (1.f / D) + 1e-6f);
        if (which == 0 && l == 0 && m >= MP) { float* xs = (float*)(F.ws + WS_X) + (size_t)m * D;
#pragma unroll
            for (int j = 0; j < 8; ++j) *(f32x4*)(xs + j * 256 + F.lane * 4) = v[j]; }
        if (which == 2) { float* o = F.out + O_YP + (size_t)m * D;
#pragma unroll
            for (int j = 0; j < 8; ++j) *(f32x4*)(o + j * 256 + F.lane * 4) = v[j] * rs * gv[j]; }
        else { bf16* o = (bf16*)(F.ws + WS_H) + (size_t)m * D;
#pragma unroll
            for (int j = 0; j < 8; ++j) { const int c = j * 256 + F.lane * 4; const f32x4 y = v[j] * rs * gv[j] * (scv[j] + 1.f) + shv[j]; u32x2 w; w.x = pk2(y.x, y.y); w.y = pk2(y.z, y.w); *(u32x2*)(o + c) = w; } }
    }
}
}
#ifdef MK_TS_ID
#ifndef MK_TS_BLOCK
#define MK_TS_BLOCK 0
#endif
#define TSB2(id, ldsp) do { if ((id) == MK_TS_ID && blockIdx.x == MK_TS_BLOCK && threadIdx.x == 0) *(volatile __attribute__((address_space(3))) unsigned*)((ldsp) + 135168 - 64) -= (unsigned)__builtin_amdgcn_s_memrealtime(); } while (0)
#define TSE2(id, ldsp) do { if ((id) == MK_TS_ID && blockIdx.x == MK_TS_BLOCK && threadIdx.x == 0) *(volatile __attribute__((address_space(3))) unsigned*)((ldsp) + 135168 - 64) += (unsigned)__builtin_amdgcn_s_memrealtime(); } while (0)
#else
#define TSB2(id, ldsp) do {} while (0)
#define TSE2(id, ldsp) do {} while (0)
#endif
namespace mk {
constexpr int BM = 256, BK = 64, HALF = 128, HTB = HALF * BK * 2, STAGE_BYTES = 8 * HTB, NXCD = 8, WGM = 8;
__device__ __forceinline__ int lds_byte(int r, int c) { const int st = (r >> 4) * 2 + (c >> 5), rr = r & 15, cc = c & 31, ob = rr * 64 + cc * 2; return st * 1024 + (ob ^ (((ob >> 9) & 1) << 5)); }
__device__ __forceinline__ void stage_rc(int b, int& R, int& C) { const int st = b / 1024, sb = b % 1024, swz = sb ^ (((sb >> 9) & 1) << 5); R = (st >> 1) * 16 + swz / 64; C = (st & 1) * 32 + (swz % 64) / 2; }
__device__ __forceinline__ int perm32(int rho) { const int n = rho >> 4, i = rho & 15; return 8 * (i >> 2) + 4 * n + (i & 3); }

struct Unit { int pm, pn, seg; };
enum { G_ADA = 0, G_IN, G_MG, G_WO, G_GU, G_DN };
struct Gemm { const bf16* A; const bf16* Bt; int ld, M, N, K, mode, layer; };

struct Rect { int pm0, nM, pn0, nN; };
struct Sched {
    Rect ra, rb; int G, c, nseg, ksb;
    __device__ __forceinline__ void init(const Rect& a, const Rect& b, int G_, int c_, int nseg_, int ksb_ = 0) { ra = a; rb = b; G = G_; c = c_; nseg = nseg_; ksb = ksb_; }
    __device__ __forceinline__ bool next(int i, Unit& u) const {
        const int ti = i / nseg, seg = i - ti * nseg, nA = ra.nM * ra.nN, nB = rb.nM * rb.nN;
        const long L = (long)ti * G + c; if (L >= nA + nB) return false;
        const bool inA = L < nA; const int pm0 = inA ? ra.pm0 : rb.pm0, nM = inA ? ra.nM : rb.nM, pn0 = inA ? ra.pn0 : rb.pn0, nN = inA ? ra.nN : rb.nN, nwg = nM * nN;
        int wgid = inA ? (int)L : (int)L - nA; { const int q = nwg / NXCD, r = nwg % NXCD, xcd = wgid % NXCD, off = wgid / NXCD; wgid = (xcd < r ? xcd * (q + 1) : r * (q + 1) + (xcd - r) * q) + off; }
        const int nig = WGM * nN, gid = wgid / nig, fm = gid * WGM, gsz = (nM - fm) < WGM ? (nM - fm) : WGM;
        u.pm = pm0 + fm + ((wgid % nig) % gsz); u.pn = pn0 + (wgid % nig) / gsz; u.seg = seg;
        if (!inA && ksb > 0) { const int q = u.pn - pn0; u.seg = q / ksb; u.pn = pn0 + q % ksb; }
        return true;
    }
};

typedef __bf16 bf16x2_t __attribute__((ext_vector_type(2)));
__device__ __forceinline__ unsigned cvt_pk_bf16(float lo, float hi) { const f32x2 v = {lo, hi}; const bf16x2_t b = __builtin_convertvector(v, bf16x2_t); return __builtin_bit_cast(unsigned, b); }
__device__ __forceinline__ f32x4 sig4(f32x4 v) { f32x4 r; r.x = fsigm(v.x); r.y = fsigm(v.y); r.z = fsigm(v.z); r.w = fsigm(v.w); return r; }

__device__ __forceinline__ float gclamp(float g) { return fmaxf(g, 1e-18f); }
struct Epi {
    const Frame* F; int mode, layer;
    __device__ __forceinline__ void rescale(f32x4 (&acc)[2][2][4][2], const Unit& u, int sp, int wr, int wc, int fr, int fq) const {
        int row0 = u.pm * BM + wr * 64 + fr; asm volatile("" : "+v"(row0)); const int c0 = u.pn * BM + wc * 32 + 8 * fq; const bf16* gt = (const bf16*)(F->ws + WS_GT) + sp * D + c0;
#pragma unroll
        for (int ai = 0; ai < 2; ++ai)
#pragma unroll
            for (int m = 0; m < 4; ++m) { const int r = row0 + ai * HALF + m * 16; const int rr = r < M ? r : M - 1;
#pragma unroll
                for (int bj = 0; bj < 2; ++bj) { const u32x4 ga = *(const u32x4*)(gt + (size_t)rr * 6144 + bj * HALF), gb = *(const u32x4*)(gt + (size_t)rr * 6144 + D + bj * HALF);
                    f32x4& v0 = acc[ai][bj][m][0]; f32x4& v1 = acc[ai][bj][m][1];
                    v0.x *= gclamp(bflo(ga.x)) * __builtin_amdgcn_rcpf(gclamp(bflo(gb.x))); v0.y *= gclamp(bfhi(ga.x)) * __builtin_amdgcn_rcpf(gclamp(bfhi(gb.x)));
                    v0.z *= gclamp(bflo(ga.y)) * __builtin_amdgcn_rcpf(gclamp(bflo(gb.y))); v0.w *= gclamp(bfhi(ga.y)) * __builtin_amdgcn_rcpf(gclamp(bfhi(gb.y)));
                    v1.x *= gclamp(bflo(ga.z)) * __builtin_amdgcn_rcpf(gclamp(bflo(gb.z))); v1.y *= gclamp(bfhi(ga.z)) * __builtin_amdgcn_rcpf(gclamp(bfhi(gb.z)));
                    v1.z *= gclamp(bflo(ga.w)) * __builtin_amdgcn_rcpf(gclamp(bflo(gb.w))); v1.w *= gclamp(bfhi(ga.w)) * __builtin_amdgcn_rcpf(gclamp(bfhi(gb.w))); }
                if (m & 1) asm volatile("" ::: "memory"); }
    }
    __device__ __forceinline__ void operator()(const f32x4 (&acc)[2][2][4][2], const Unit& u, int wr, int wc, int fr, int fq) const {
        const Frame& Fr = *F; const int l = layer;
        int row0 = u.pm * BM + wr * 64 + fr; const int colb = u.pn * BM + wc * 32 + 8 * fq;
        asm volatile("" : "+v"(row0));
        unsigned char* ws = Fr.ws;
        if (mode == G_ADA) {
            const float* ab = INP(10);
#pragma unroll
            for (int ai = 0; ai < 2; ++ai)
#pragma unroll
                for (int m = 0; m < 4; ++m) { const int r = row0 + ai * HALF + m * 16; if (r < NMOD) {
#pragma unroll
                    for (int bj = 0; bj < 2; ++bj) { const int c = colb + bj * HALF, ll = c / NADA, j = c - ll * NADA; float* o = (float*)(ws + WS_MOD) + ((size_t)ll * NMOD + r) * NADA + j;
                        *(f32x4*)o = acc[ai][bj][m][0] + *(const f32x4*)(ab + c); *(f32x4*)(o + 4) = acc[ai][bj][m][1] + *(const f32x4*)(ab + c + 4); } } }
        } else if (mode == G_IN) {
            const int pn = u.pn;
            if (pn < 5) {
                const int wp = wc & 1; const float* rt = (const float*)(ws + WS_ROPE);
#pragma unroll
                for (int ai = 0; ai < 2; ++ai)
#pragma unroll
                    for (int m = 0; m < 4; ++m) { const int r = row0 + ai * HALF + m * 16; if (r < M) {
                        const float* tp = rt + (size_t)posidx(r) * 64 + 16 * wp + 4 * fq; const f32x4 cs = *(const f32x4*)tp, sn = *(const f32x4*)(tp + 32);
#pragma unroll
                        for (int bj = 0; bj < 2; ++bj) { const f32x4 x1 = acc[ai][bj][m][0], x2 = acc[ai][bj][m][1]; const f32x4 o1 = x1 * cs - x2 * sn, o2 = x2 * cs + x1 * sn;
                            u32x4 w; w.x = cvt_pk_bf16(o1.x, o1.y); w.y = cvt_pk_bf16(o1.z, o1.w); w.z = cvt_pk_bf16(o2.x, o2.y); w.w = cvt_pk_bf16(o2.z, o2.w);
                            const int hc = bj * HALF + wc * 32 + 8 * fq;
                            if (pn < 4) *(u32x4*)((bf16*)(ws + WS_Q) + (size_t)r * 1024 + pn * 256 + hc) = w;
                            else { *(u32x4*)((bf16*)(ws + WS_K) + (size_t)r * 256 + hc) = w;
                                const int hk = hc >> 6, d1 = 16 * wp + 4 * fq; float* ko = nullptr;
                                if (r < MP) { const int t = r & (SEQ - 1); if (t >= SEQ - 128) ko = Fr.out + O_KP + ((((size_t)l * NB + (r >> 12)) * 128 + (t - (SEQ - 128))) * 4 + hk) * 64; }
                                else ko = Fr.out + O_KS + ((((size_t)l * NS + (r - MP)) * 128 + 127) * 4 + hk) * 64;
                                if (ko) { *(f32x4*)(ko + d1) = o1; *(f32x4*)(ko + d1 + 32) = o2; } } } } }
            } else if (pn == 5) {
#pragma unroll
                for (int ai = 0; ai < 2; ++ai)
#pragma unroll
                    for (int m = 0; m < 4; ++m) { const int r = row0 + ai * HALF + m * 16; if (r < M) {
#pragma unroll
                        for (int bj = 0; bj < 2; ++bj) { const f32x4 v0 = acc[ai][bj][m][0], v1 = acc[ai][bj][m][1]; const int hc = bj * HALF + wc * 32 + 8 * fq;
                            u32x4 w; w.x = cvt_pk_bf16(v0.x, v0.y); w.y = cvt_pk_bf16(v0.z, v0.w); w.z = cvt_pk_bf16(v1.x, v1.y); w.w = cvt_pk_bf16(v1.z, v1.w);
                            *(u32x4*)((bf16*)(ws + WS_V) + (size_t)r * 256 + hc) = w;
                            float* vo = nullptr;
                            if (r < MP) { const int t = r & (SEQ - 1); if (t >= SEQ - 128) vo = Fr.out + O_VP + (((size_t)l * NB + (r >> 12)) * 128 + (t - (SEQ - 128))) * 256; }
                            else vo = Fr.out + O_VS + (((size_t)l * NS + (r - MP)) * 128 + 127) * 256;
                            if (vo) { *(f32x4*)(vo + hc) = v0; *(f32x4*)(vo + hc + 4) = v1; } } } }
            } else if (pn < 16) {
                float* base = pn < 8 ? (float*)(ws + WS_U) : (float*)(ws + WS_PR); const int ld = pn < 8 ? 512 : 2048, c0 = (pn < 8 ? (pn - 6) : (pn - 8)) * 256 + wc * 32 + 8 * fq;
#pragma unroll
                for (int ai = 0; ai < 2; ++ai)
#pragma unroll
                    for (int m = 0; m < 4; ++m) { const int r = row0 + ai * HALF + m * 16; if (r < M) {
#pragma unroll
                        for (int bj = 0; bj < 2; ++bj) { float* o = base + (size_t)r * ld + c0 + bj * HALF; *(f32x4*)o = acc[ai][bj][m][0]; *(f32x4*)(o + 4) = acc[ai][bj][m][1]; } } }
            } else {
                const int c0 = (pn - 16) * 256 + wc * 32 + 8 * fq;
#pragma unroll
                for (int ai = 0; ai < 2; ++ai)
#pragma unroll
                    for (int m = 0; m < 4; ++m) { const int r = row0 + ai * HALF + m * 16; if (r < M) {
#pragma unroll
                        for (int bj = 0; bj < 2; ++bj) { const f32x4 v0 = sig4(acc[ai][bj][m][0]), v1 = sig4(acc[ai][bj][m][1]);
                            u32x4 w; w.x = cvt_pk_bf16(v0.x, v0.y); w.y = cvt_pk_bf16(v0.z, v0.w); w.z = cvt_pk_bf16(v1.x, v1.y); w.w = cvt_pk_bf16(v1.z, v1.w);
                            *(u32x4*)((bf16*)(ws + WS_GT) + (size_t)r * 6144 + c0 + bj * HALF) = w; } } }
            }
        } else if (mode == G_MG && u.pm == MPAD / BM - 1) {
            const int c0 = u.pn * BM + wc * 32 + 8 * fq, br = u.seg < 2 ? 0 : u.seg - 1;
#pragma unroll
            for (int m = 0; m < 4; ++m) { const int r = row0 + m * 16; if (r < M) { float* so = (float*)(ws + WS_SLABM) + ((size_t)u.seg * NS + (r - MP)) * D;
#pragma unroll
                for (int bj = 0; bj < 2; ++bj) { const int c = c0 + bj * HALF; const u32x4 gw = *(const u32x4*)((const bf16*)(ws + WS_GT) + (size_t)r * 6144 + br * D + c);
                    f32x4 v0 = acc[0][bj][m][0], v1 = acc[0][bj][m][1];
                    v0.x *= gclamp(bflo(gw.x)); v0.y *= gclamp(bfhi(gw.x)); v0.z *= gclamp(bflo(gw.y)); v0.w *= gclamp(bfhi(gw.y)); v1.x *= gclamp(bflo(gw.z)); v1.y *= gclamp(bfhi(gw.z)); v1.z *= gclamp(bflo(gw.w)); v1.w *= gclamp(bfhi(gw.w));
                    *(f32x4*)(so + c) = v0; *(f32x4*)(so + c + 4) = v1; } } }
        } else if (mode == G_MG) {
            const int c0 = u.pn * BM + wc * 32 + 8 * fq;
#pragma unroll
            for (int ai = 0; ai < 2; ++ai)
#pragma unroll
                for (int m = 0; m < 4; ++m) { const int r = row0 + ai * HALF + m * 16; if (r < M) {
#pragma unroll
                    for (int bj = 0; bj < 2; ++bj) { const int c = c0 + bj * HALF; const u32x4 gw = *(const u32x4*)((const bf16*)(ws + WS_GT) + (size_t)r * 6144 + 2 * D + c);
                        f32x4 v0 = acc[ai][bj][m][0], v1 = acc[ai][bj][m][1];
                        v0.x *= gclamp(bflo(gw.x)); v0.y *= gclamp(bfhi(gw.x)); v0.z *= gclamp(bflo(gw.y)); v0.w *= gclamp(bfhi(gw.y)); v1.x *= gclamp(bflo(gw.z)); v1.y *= gclamp(bfhi(gw.z)); v1.z *= gclamp(bflo(gw.w)); v1.w *= gclamp(bfhi(gw.w));
                        u32x4 w; w.x = cvt_pk_bf16(v0.x, v0.y); w.y = cvt_pk_bf16(v0.z, v0.w); w.z = cvt_pk_bf16(v1.x, v1.y); w.w = cvt_pk_bf16(v1.z, v1.w); *(u32x4*)((bf16*)(ws + WS_MG) + (size_t)r * D + c) = w; } } }
        } else if (mode == G_WO || mode == G_DN) {
            const int c0 = u.pn * BM + wc * 32 + 8 * fq; const int goff = mode == G_WO ? 2 * D : 5 * D;
            if (u.pm == MPAD / BM - 1) {
#pragma unroll
                for (int m = 0; m < 4; ++m) { const int r = row0 + m * 16; if (r < M) {
                    const float* gp = (const float*)(ws + WS_MOD) + ((size_t)l * NMOD + modrow(r)) * NADA + goff; float* so = (float*)(ws + WS_SLAB) + ((size_t)u.seg * NS + (r - MP)) * D;
#pragma unroll
                    for (int bj = 0; bj < 2; ++bj) { const int c = c0 + bj * HALF; const f32x4 g0 = *(const f32x4*)(gp + c), g1 = *(const f32x4*)(gp + c + 4);
                        *(f32x4*)(so + c) = (g0 + 1.f) * acc[0][bj][m][0]; *(f32x4*)(so + c + 4) = (g1 + 1.f) * acc[0][bj][m][1]; } } }
            } else {
                const float* gp = (const float*)(ws + WS_MOD) + ((size_t)l * NMOD + (u.pm >> 4)) * NADA + goff + c0;
                const f32x4 ga0 = *(const f32x4*)gp + 1.f, ga1 = *(const f32x4*)(gp + 4) + 1.f, gb0 = *(const f32x4*)(gp + HALF) + 1.f, gb1 = *(const f32x4*)(gp + HALF + 4) + 1.f;
                const float* xbase = (mode == G_WO && l == 0) ? INP(0) : (const float*)(ws + WS_X); float* xob = (float*)(ws + WS_X);
#pragma unroll
                for (int am = 0; am < 8; am += 2) { f32x4 xv[2][4];
#pragma unroll
                    for (int q = 0; q < 2; ++q) { const int ai = (am + q) >> 2, m = (am + q) & 3; const float* xin = xbase + (size_t)(row0 + ai * HALF + m * 16) * D + c0;
                        xv[q][0] = *(const f32x4*)xin; xv[q][1] = *(const f32x4*)(xin + 4); xv[q][2] = *(const f32x4*)(xin + HALF); xv[q][3] = *(const f32x4*)(xin + HALF + 4); }
#pragma unroll
                    for (int q = 0; q < 2; ++q) { const int ai = (am + q) >> 2, m = (am + q) & 3; float* xo = xob + (size_t)(row0 + ai * HALF + m * 16) * D + c0;
                        *(f32x4*)xo = xv[q][0] + ga0 * acc[ai][0][m][0]; *(f32x4*)(xo + 4) = xv[q][1] + ga1 * acc[ai][0][m][1];
                        *(f32x4*)(xo + HALF) = xv[q][2] + gb0 * acc[ai][1][m][0]; *(f32x4*)(xo + HALF + 4) = xv[q][3] + gb1 * acc[ai][1][m][1]; }
                    asm volatile("" ::: "memory"); }
            }
        } else {
            const int c0 = u.pn * 128 + wc * 16 + 4 * fq;
#pragma unroll
            for (int ai = 0; ai < 2; ++ai)
#pragma unroll
                for (int m = 0; m < 4; ++m) { const int r = row0 + ai * HALF + m * 16; if (r < M) {
#pragma unroll
                    for (int bj = 0; bj < 2; ++bj) { const f32x4 g = acc[ai][bj][m][0], up = acc[ai][bj][m][1]; const f32x4 a = g * sig4(g) * up;
                        u32x2 w; w.x = cvt_pk_bf16(a.x, a.y); w.y = cvt_pk_bf16(a.z, a.w); *(u32x2*)((bf16*)(ws + WS_GT) + (size_t)r * DFF + c0 + bj * 64) = w; } } }
        }
    }
};

__device__ __forceinline__ void gemm_phase(LAS unsigned char* lds, const Gemm g, const Sched& S, const Epi& E, const int tid  ) {
    const int wid = __builtin_amdgcn_readfirstlane(tid >> 6), lane = tid & 63, wr = wid >> 2, wc = wid & 3, fr = lane & 15, fq = lane >> 4;
    unsigned voffA[2], voffB[2];
#pragma unroll
    for (int i = 0; i < 2; ++i) { int R, C; stage_rc(tid * 16 + i * 8192, R, C); const int Rb = (R & ~31) + perm32(R & 31);
        voffA[i] = (unsigned)(R * g.ld + C) * 2u; voffB[i] = (unsigned)(Rb * g.ld + C) * 2u; }
    constexpr unsigned kstep = BK * 2;
    const unsigned hstep = (unsigned)HALF * (unsigned)g.ld * 2u; const bool mgd = g.mode == G_MG; const int ntfull = g.K / BK;
    const bool ksd = g.mode == G_WO || g.mode == G_DN || g.mode == G_MG;
#define PG8_KS(u) (ksd && (u).pm == MPAD / BM - 1)
#define PG8_KA(u) (PG8_KS(u) ? (unsigned)(u).seg * 512u : 0u)
#define PG8_NT(u) (PG8_KS(u) ? 8 : ntfull)
#define PG8_TILE(p, u) (((unsigned)(p) * (unsigned)BM * (unsigned)g.ld + PG8_KA(u)) * 2u)
    const unsigned ldsw = (unsigned)wid * 1024u;
    const int aoff = lds_byte(wr * 64 + fr, fq * 8), boff = lds_byte(wc * 32 + fr, fq * 8);
#define PG8_SA(b, h) (((b) * 2 + (h)) * HTB)
#define PG8_SB(b, h) ((4 + (b) * 2 + (h)) * HTB)
#define PG8_STAGE(bufoff, gbase, soff, voff) do { _Pragma("unroll") for (int _i = 0; _i < 2; ++_i) \
        __builtin_amdgcn_global_load_lds((const unsigned*)((const char*)(gbase) + (size_t)((voff)[_i] + (unsigned)(soff))), (LAS unsigned*)(lds + (bufoff) + ldsw + _i * 8192), 16, 0, 0); } while (0)
#define PG8_STA(bufoff, soff) PG8_STAGE(bufoff, g.A, soff, voffA)
#define PG8_STB(bufoff, soff) PG8_STAGE(bufoff, g.Bt, soff, voffB)
#define PG8_LDA(dst, b, h) do { _Pragma("unroll") for (int m = 0; m < 4; ++m) _Pragma("unroll") for (int k = 0; k < 2; ++k) dst[m][k] = *(const LAS bf16x8*)(lds + PG8_SA(b, h) + aoff + m * 2048 + k * 1024); } while (0)
#define PG8_LDB(dst, b, h) do { _Pragma("unroll") for (int n = 0; n < 2; ++n) _Pragma("unroll") for (int k = 0; k < 2; ++k) dst[n][k] = *(const LAS bf16x8*)(lds + PG8_SB(b, h) + boff + n * 2048 + k * 1024); } while (0)
#define PG8_MMA(ai, bj, At, Bt) do { __builtin_amdgcn_s_setprio(1); _Pragma("unroll") for (int m = 0; m < 4; ++m) _Pragma("unroll") for (int n = 0; n < 2; ++n) _Pragma("unroll") for (int k = 0; k < 2; ++k) \
        acc[ai][bj][m][n] = __builtin_amdgcn_mfma_f32_16x16x32_bf16(Bt[n][k], At[m][k], acc[ai][bj][m][n], 0, 0, 0); __builtin_amdgcn_s_setprio(0); } while (0)
#define PG8_WAIT_V(n) asm volatile("s_waitcnt vmcnt(" #n ")" ::: "memory")
#define PG8_WAIT_L(n) asm volatile("s_waitcnt lgkmcnt(" #n ")" ::: "memory")
#define PG8_BAR __builtin_amdgcn_s_barrier()
#define PG8_SCHED __builtin_amdgcn_sched_barrier(0)
    Unit cur, nxt; int ui = 0;
    if (!S.next(0, cur)) return;
    f32x4 acc[2][2][4][2];
#pragma unroll
    for (int a = 0; a < 2; ++a)
#pragma unroll
        for (int b = 0; b < 2; ++b)
#pragma unroll
            for (int m = 0; m < 4; ++m)
#pragma unroll
                for (int n = 0; n < 2; ++n) acc[a][b][m][n] = (f32x4){0.f, 0.f, 0.f, 0.f};
    bf16x8 At[4][2], B0[2][2], B1[2][2];
    unsigned cA = PG8_TILE(cur.pm, cur), cB = PG8_TILE(cur.pn, cur);
    PG8_STB(PG8_SB(0, 0), cB); PG8_STB(PG8_SB(0, 1), cB + hstep); PG8_STA(PG8_SA(0, 0), cA); PG8_STA(PG8_SA(0, 1), cA + hstep);
    if (wr == 1) PG8_BAR;
    PG8_WAIT_V(2); PG8_BAR;
    PG8_STB(PG8_SB(1, 0), cB + kstep); PG8_STA(PG8_SA(1, 0), cA + kstep); PG8_STB(PG8_SB(1, 1), cB + hstep + kstep);
    PG8_WAIT_V(6); PG8_BAR;
    for (;;) {
        const bool has_next = S.next(ui + 1, nxt);
        const unsigned nA = has_next ? PG8_TILE(nxt.pm, nxt) : cA, nB = has_next ? PG8_TILE(nxt.pn, nxt) : cB;
        const int nt = PG8_NT(cur);
        TSB2(50 + 2 * g.mode, lds);
        for (int t = 0; t < nt; t += 2) {
            const bool last = (t == nt - 2);
            if (mgd && !PG8_KS(cur) && (t == 16 || t == 24)) E.rescale(acc, cur, t == 16 ? 0 : 1, wr, wc, fr, fq);
            const unsigned a1 = cA + (unsigned)(t + 1) * kstep;
            const unsigned a2 = last ? nA : cA + (unsigned)(t + 2) * kstep, b2 = last ? nB : cB + (unsigned)(t + 2) * kstep;
            const unsigned a3 = a2 + kstep, b3 = b2 + kstep;
            PG8_LDB(B0, 0, 0); PG8_LDB(B1, 0, 1); PG8_SCHED; PG8_LDA(At, 0, 0); PG8_STA(PG8_SA(1, 1), a1 + hstep);
            PG8_WAIT_V(8); PG8_WAIT_L(0); PG8_BAR; PG8_MMA(0, 0, At, B0); PG8_MMA(0, 1, At, B1); PG8_BAR; PG8_SCHED;
            PG8_LDA(At, 0, 1); PG8_STB(PG8_SB(0, 0), b2); PG8_STB(PG8_SB(0, 1), b2 + hstep); PG8_STA(PG8_SA(0, 0), a2);
            PG8_WAIT_V(8); PG8_WAIT_L(0); PG8_BAR; PG8_MMA(1, 0, At, B0); PG8_MMA(1, 1, At, B1); PG8_BAR; PG8_SCHED;
            PG8_LDB(B0, 1, 0); PG8_LDB(B1, 1, 1); PG8_SCHED; PG8_LDA(At, 1, 0); PG8_STA(PG8_SA(0, 1), a2 + hstep);
            PG8_WAIT_V(8); PG8_WAIT_L(0); PG8_BAR; PG8_MMA(0, 0, At, B0); PG8_MMA(0, 1, At, B1); PG8_BAR; PG8_SCHED;
            PG8_LDA(At, 1, 1); PG8_STB(PG8_SB(1, 0), b3); PG8_STB(PG8_SB(1, 1), b3 + hstep); PG8_STA(PG8_SA(1, 0), a3);
            PG8_WAIT_V(8); PG8_WAIT_L(0); PG8_BAR; PG8_MMA(1, 0, At, B0); PG8_MMA(1, 1, At, B1); PG8_BAR; PG8_SCHED;
        }
        if (wr == 0) PG8_BAR;
        TSE2(50 + 2 * g.mode, lds);
        TSB2(51 + 2 * g.mode, lds); E(acc, cur, wr, wc, fr, fq); TSE2(51 + 2 * g.mode, lds);
        if (!has_next) break;
#pragma unroll
        for (int a = 0; a < 2; ++a)
#pragma unroll
            for (int b = 0; b < 2; ++b)
#pragma unroll
                for (int m = 0; m < 4; ++m)
#pragma unroll
                    for (int n = 0; n < 2; ++n) acc[a][b][m][n] = (f32x4){0.f, 0.f, 0.f, 0.f};
        cur = nxt; cA = nA; cB = nB; ++ui;
        if (wr == 1) PG8_BAR;
    }
    PG8_WAIT_V(0);
    PG8_BAR;
#undef PG8_KS
#undef PG8_KA
#undef PG8_NT
#undef PG8_TILE
#undef PG8_STA
#undef PG8_STB
#undef PG8_SA
#undef PG8_SB
#undef PG8_STAGE
#undef PG8_LDA
#undef PG8_LDB
#undef PG8_MMA
#undef PG8_WAIT_V
#undef PG8_WAIT_L
#undef PG8_BAR
#undef PG8_SCHED
}
}
namespace mk {
#define MFMA16(a, b, c) __builtin_amdgcn_mfma_f32_16x16x32_bf16((a), (b), (c), 0, 0, 0)
__device__ __forceinline__ bf16x8 pack8(f32x4 a, f32x4 b) { u32x4 w; w.x = cvt_pk_bf16(a.x, a.y); w.y = cvt_pk_bf16(a.z, a.w); w.z = cvt_pk_bf16(b.x, b.y); w.w = cvt_pk_bf16(b.z, b.w); return __builtin_bit_cast(bf16x8, w); }
typedef short s16x4 __attribute__((ext_vector_type(4)));
__device__ __forceinline__ bf16x8 cat44(s16x4 a, s16x4 b) { return (bf16x8){a[0], a[1], a[2], a[3], b[0], b[1], b[2], b[3]}; }
constexpr float LOG2E = 1.4426950408889634f;

constexpr int AK_STRIDE = 144, AV_STRIDE = 560;
constexpr int A_KOFF = 0, A_VOFF = 256 * AK_STRIDE, A_BYTES = A_VOFF + 64 * AV_STRIDE;
__device__ __forceinline__ void attn_prompt_unit(const Frame& F, int l, int b, int blk, int hk) {
    LAS unsigned char* Ks = F.lds + A_KOFF; LAS unsigned char* Vt = F.lds + A_VOFF;
    const bf16* Kg = (const bf16*)(F.ws + WS_K); const bf16* Vg = (const bf16*)(F.ws + WS_V); const bf16* Qg = (const bf16*)(F.ws + WS_Q);
    const int kp0 = blk * 128 - 128;
#pragma unroll
    for (int ch = F.tid; ch < 2048; ch += NTHR) { const int i = ch >> 3, dc = ch & 7, kp = kp0 + i;
        u32x4 kv = (u32x4){0u, 0u, 0u, 0u}, vv = kv;
        if (kp >= 0) { const size_t m = (size_t)b * SEQ + kp; kv = *(const u32x4*)(Kg + m * 256 + hk * 64 + dc * 8); vv = *(const u32x4*)(Vg + m * 256 + hk * 64 + dc * 8); }
        *(LAS u32x4*)(Ks + i * AK_STRIDE + dc * 16) = kv;
        LAS unsigned short* vp = (LAS unsigned short*)(Vt + (dc * 8) * AV_STRIDE) + i;
        vp[0 * (AV_STRIDE / 2)] = (unsigned short)(vv.x & 0xffff); vp[1 * (AV_STRIDE / 2)] = (unsigned short)(vv.x >> 16); vp[2 * (AV_STRIDE / 2)] = (unsigned short)(vv.y & 0xffff); vp[3 * (AV_STRIDE / 2)] = (unsigned short)(vv.y >> 16);
        vp[4 * (AV_STRIDE / 2)] = (unsigned short)(vv.z & 0xffff); vp[5 * (AV_STRIDE / 2)] = (unsigned short)(vv.z >> 16); vp[6 * (AV_STRIDE / 2)] = (unsigned short)(vv.w & 0xffff); vp[7 * (AV_STRIDE / 2)] = (unsigned short)(vv.w >> 16); }
    for (int i = F.tid; i < 64 * 24; i += NTHR) { const int d = i / 24, c = i % 24; ((LAS unsigned short*)(Vt + d * AV_STRIDE))[256 + c] = 0; }
    const int g = F.lane >> 4, c16 = F.lane & 15;
    const float* sinkp = INP(14) + l * 16;
    bf16x8 q0n, q1n;
    { const int gi = F.wave * 4, hq = hk * 4 + (gi >> 3), qs = gi & 7; const size_t mq = (size_t)b * SEQ + blk * 128 + 16 * qs + c16;
      q0n = *(const bf16x8*)(Qg + mq * 1024 + hq * 64 + 8 * g); q1n = *(const bf16x8*)(Qg + mq * 1024 + hq * 64 + 32 + 8 * g); }
    __syncthreads();
#pragma unroll 1
    for (int it = 0; it < 4; ++it) {
        const int gi = F.wave * 4 + it, hq = hk * 4 + (gi >> 3), qs = gi & 7;
        const int tqr = 16 * qs + c16;
        const size_t mq = (size_t)b * SEQ + blk * 128 + tqr;
        const bf16x8 q0 = q0n, q1 = q1n;
        if (it < 3) { const int gn = gi + 1, hn = hk * 4 + (gn >> 3), qn_ = gn & 7; const size_t mn = (size_t)b * SEQ + blk * 128 + 16 * qn_ + c16;
            q0n = *(const bf16x8*)(Qg + mn * 1024 + hn * 64 + 8 * g); q1n = *(const bf16x8*)(Qg + mn * 1024 + hn * 64 + 32 + 8 * g); }
        f32x4 s[10];
#pragma unroll
        for (int j = 0; j < 9; ++j) { LAS const unsigned char* kr = Ks + (16 * (qs + j) + c16) * AK_STRIDE + 16 * g;
            const bf16x8 k0 = *(LAS const bf16x8*)kr, k1 = *(LAS const bf16x8*)(kr + 64);
            f32x4 a = (f32x4){0.f, 0.f, 0.f, 0.f}; a = MFMA16(k0, q0, a); a = MFMA16(k1, q1, a); s[j] = a; }
        const float sk2 = sinkp[hq] * LOG2E; float mx = sk2;
#pragma unroll
        for (int j = 0; j < 9; ++j)
#pragma unroll
            for (int r = 0; r < 4; ++r) { const int i = 16 * (qs + j) + 4 * g + r; const bool ok = (i >= tqr) && (i <= tqr + 128) && (kp0 + i >= 0);
                const float v = ok ? s[j][r] * (0.125f * LOG2E) : -1e30f; s[j][r] = v; mx = fmaxf(mx, v); }
        mx = fmaxf(mx, __shfl_xor(mx, 16)); mx = fmaxf(mx, __shfl_xor(mx, 32));
        float sum = 0.f;
#pragma unroll
        for (int j = 0; j < 9; ++j)
#pragma unroll
            for (int r = 0; r < 4; ++r) { const float p = __builtin_amdgcn_exp2f(s[j][r] - mx); s[j][r] = p; sum += p; }
        s[9] = (f32x4){0.f, 0.f, 0.f, 0.f};
        sum += __shfl_xor(sum, 16); sum += __shfl_xor(sum, 32);
        const float rl = 1.f / (sum + __builtin_amdgcn_exp2f(sk2 - mx));
        f32x4 o[4];
#pragma unroll
        for (int dt = 0; dt < 4; ++dt) o[dt] = (f32x4){0.f, 0.f, 0.f, 0.f};
#pragma unroll
        for (int kk = 0; kk < 5; ++kk) { const bf16x8 pf = pack8(s[2 * kk], s[2 * kk + 1]);
#pragma unroll
            for (int dt = 0; dt < 4; ++dt) { LAS const unsigned char* vr = Vt + (16 * dt + c16) * AV_STRIDE + (16 * (qs + 2 * kk) + 4 * g) * 2;
                const s16x4 v0 = *(LAS const s16x4*)vr, v1 = *(LAS const s16x4*)(vr + 32);
                o[dt] = MFMA16(cat44(v0, v1), pf, o[dt]); } }
        bf16* op = (bf16*)(F.ws + WS_CAT) + mq * D + hq * 64 + 4 * g;
#pragma unroll
        for (int dt = 0; dt < 4; ++dt) { const f32x4 v = o[dt] * rl; u32x2 w; w.x = cvt_pk_bf16(v.x, v.y); w.y = cvt_pk_bf16(v.z, v.w); *(u32x2*)(op + 16 * dt) = w; }
    }
    __syncthreads();
}

__device__ __forceinline__ void attn_sample_unit(const Frame& F, int l, int s_, int hf) {
    LAS float* qn = (LAS float*)F.lds;
    LAS float* kn = qn + 512;
    LAS float* vn = kn + 128;
    LAS float* sc = vn + 128;
    LAS float* rl = sc + 8 * 132;
    const int m = MP + s_; const float* sinkp = INP(14) + l * 16 + 8 * hf;
    const float* ck = INP(4) + ((size_t)l * NS + s_) * 128 * 256; const float* cv = INP(5) + ((size_t)l * NS + s_) * 128 * 256;
    { const int h = F.tid >> 6, p = F.tid & 63; qn[h * 64 + pi_d(p)] = bf2f(((const bf16*)(F.ws + WS_Q))[(size_t)m * 1024 + 512 * hf + F.tid]) * (0.125f * LOG2E); }
    if (F.tid < 128) { const int h = F.tid >> 6, p = F.tid & 63; kn[h * 64 + pi_d(p)] = bf2f(((const bf16*)(F.ws + WS_K))[(size_t)m * 256 + 128 * hf + F.tid]); vn[F.tid] = bf2f(((const bf16*)(F.ws + WS_V))[(size_t)m * 256 + 128 * hf + F.tid]); }
    { float* ko = F.out + O_KS + ((size_t)l * NS + s_) * 128 * 256; float* vo = F.out + O_VS + ((size_t)l * NS + s_) * 128 * 256; const int i0_ = 64 * hf * 64, i1_ = hf ? 127 * 64 : 64 * 64;
#pragma unroll 4
      for (int i = i0_ + F.tid; i < i1_; i += NTHR) { const f32x4 a = *(const f32x4*)(ck + 256 + 4 * i), b = *(const f32x4*)(cv + 256 + 4 * i); *(f32x4*)(ko + 4 * i) = a; *(f32x4*)(vo + 4 * i) = b; } }
    __syncthreads();
    for (int idx = F.tid; idx < 8 * 129; idx += NTHR) { const int hq = idx / 129, j = idx - hq * 129, hk = hq >> 2; float a = 0.f;
        if (j < 128) { const float* kr = ck + (size_t)j * 256 + (2 * hf + hk) * 64;
#pragma unroll
            for (int d = 0; d < 64; d += 4) { const f32x4 kv = *(const f32x4*)(kr + d); a += qn[hq * 64 + d] * kv.x + qn[hq * 64 + d + 1] * kv.y + qn[hq * 64 + d + 2] * kv.z + qn[hq * 64 + d + 3] * kv.w; } }
        else { for (int d = 0; d < 64; ++d) a += qn[hq * 64 + d] * kn[hk * 64 + d]; }
        sc[hq * 132 + j] = a; }
    __syncthreads();
    { const int hq = F.wave; const float sk2 = sinkp[hq] * LOG2E;
        float mx = sk2; for (int j = F.lane; j < 129; j += 64) mx = fmaxf(mx, sc[hq * 132 + j]);
#pragma unroll
        for (int o = 1; o < 64; o <<= 1) mx = fmaxf(mx, __shfl_xor(mx, o));
        float sum = 0.f; for (int j = F.lane; j < 129; j += 64) { const float p = __builtin_amdgcn_exp2f(sc[hq * 132 + j] - mx); sc[hq * 132 + j] = p; sum += p; }
        sum = wave_sum(sum); if (F.lane == 0) rl[hq] = 1.f / (sum + __builtin_amdgcn_exp2f(sk2 - mx)); }
    __syncthreads();
    { const int hq = F.tid >> 6, d = F.tid & 63, hk = hq >> 2; float a = 0.f; const float* vc = cv + (2 * hf + hk) * 64 + d;
#pragma unroll 16
        for (int j = 0; j < 128; ++j) a += sc[hq * 132 + j] * vc[(size_t)j * 256];
        a += sc[hq * 132 + 128] * vn[hk * 64 + d];
        ((bf16*)(F.ws + WS_CAT))[(size_t)m * D + 512 * hf + F.tid] = (bf16)f2bf(a * rl[hq]); }
    __syncthreads();
}

constexpr int PL_STRIDE = 272;
__device__ __forceinline__ void pool_unit(const Frame& F, int l, int rt, int gi) {
    LAS unsigned char* dT = F.lds; LAS unsigned char* Wt = F.lds + 128 * PL_STRIDE;
    const float* U = (const float*)(F.ws + WS_U); const int w = 2 << gi, m0 = rt * 128;
    { const bf16* pw = (const bf16*)wl(F, l, WL_PW) + (size_t)gi * 128 * 128;
      for (int ch = F.tid; ch < 2048; ch += NTHR) { const int e = ch >> 4, cc = ch & 15; *(LAS u32x4*)(Wt + e * PL_STRIDE + cc * 16) = *(const u32x4*)(pw + e * 128 + cc * 8); } }
    { const int c = F.tid & 127, strip = F.tid >> 7, col = gi * 128 + c;
      if (rt < 64) { const int t0 = (m0 & (SEQ - 1)) + 32 * strip; const float* up = U + (size_t)(m0 + 32 * strip) * 512 + col;
          float uv[47];
#pragma unroll
          for (int j = 0; j < 47; ++j) { const int t = t0 - 15 + j; uv[j] = t >= 0 ? up[(ptrdiff_t)(j - 15) * 512] : 0.f; }
          LAS unsigned short* dp = (LAS unsigned short*)(dT + (32 * strip) * PL_STRIDE) + c;
#define POOL_D(W) { float sum = 0.f; _Pragma("unroll") for (int j = 1; j < W; ++j) sum += uv[15 - j]; \
              _Pragma("unroll") for (int k = 0; k < 32; ++k) { const int t = t0 + k; sum += uv[15 + k]; const float cnt = (float)(t + 1 < W ? t + 1 : W); \
                  dp[k * (PL_STRIDE / 2)] = (unsigned short)f2bf(sum / cnt - uv[15 + k]); sum -= uv[15 + k - W + 1]; } }
          if (gi == 0) POOL_D(2) else if (gi == 1) POOL_D(4) else if (gi == 2) POOL_D(8) else POOL_D(16)
#undef POOL_D
      }
      else { const float* sp = INP(6) + (size_t)l * NS * 15 * 512;
#pragma unroll 4
          for (int k = 0; k < 32; ++k) { const int s_ = 32 * strip + k; const float uc = U[(size_t)(MP + s_) * 512 + col]; float hv[15];
#pragma unroll
              for (int j = 1; j < 16; ++j) hv[j - 1] = sp[((size_t)s_ * 15 + 15 - j) * 512 + col];
              float sum = uc;
#pragma unroll
              for (int j = 1; j < 16; ++j) sum += j < w ? hv[j - 1] : 0.f;
              ((LAS unsigned short*)(dT + s_ * PL_STRIDE))[c] = (unsigned short)f2bf(sum / (float)w - uc); } } }
    __syncthreads();
    const int g = F.lane >> 4, c16 = F.lane & 15;
    f32x4 acc[8];
#pragma unroll
    for (int et = 0; et < 8; ++et) acc[et] = (f32x4){0.f, 0.f, 0.f, 0.f};
#pragma unroll
    for (int ks = 0; ks < 4; ++ks) { const bf16x8 df = *(LAS const bf16x8*)(dT + (16 * F.wave + c16) * PL_STRIDE + (32 * ks + 8 * g) * 2);
#pragma unroll
        for (int et = 0; et < 8; ++et) { const bf16x8 wf = *(LAS const bf16x8*)(Wt + (16 * et + c16) * PL_STRIDE + (32 * ks + 8 * g) * 2); acc[et] = MFMA16(wf, df, acc[et]); } }
    const int m = m0 + 16 * F.wave + c16; const float* psc = INP(17) + l * 512 + gi * 128;
    if (m < M) { bf16* op = (bf16*)(F.ws + WS_CAT) + (size_t)m * D + 1024 + gi * 128 + 4 * g;
#pragma unroll
        for (int et = 0; et < 8; ++et) { const f32x4 v = acc[et] * *(const f32x4*)(psc + 16 * et + 4 * g); u32x2 wv; wv.x = cvt_pk_bf16(v.x, v.y); wv.y = cvt_pk_bf16(v.z, v.w); *(u32x2*)(op + 16 * et) = wv; } }
    __syncthreads();
}
__device__ __forceinline__ void state_outs(const Frame& F, int l) {
    const int gt = F.bid * NTHR + F.tid, ngt = F.G * NTHR; const float* U = (const float*)(F.ws + WS_U); const float* PR = (const float*)(F.ws + WS_PR);
    for (int i = gt; i < NB * 15 * 512; i += ngt) { const int b = i / (15 * 512), j = (i >> 9) % 15, c = i & 511; F.out[O_PP + (size_t)l * NB * 15 * 512 + i] = U[((size_t)b * SEQ + SEQ - 15 + j) * 512 + c]; }
    const float* sp = INP(6) + (size_t)l * NS * 15 * 512;
    for (int i = gt; i < NS * 15 * 512; i += ngt) { const int s_ = i / (15 * 512), j = (i >> 9) % 15, c = i & 511; F.out[O_PS + (size_t)l * NS * 15 * 512 + i] = j < 14 ? sp[i + 512] : U[(size_t)(MP + s_) * 512 + c]; }
    for (int i = gt; i < NB * RP; i += ngt) { const int b = i / RP, c = i - b * RP; F.out[O_SP + (size_t)l * NB * RP + i] = PR[((size_t)b * SEQ + SEQ - 1) * 2048 + c]; }
    for (int i = gt; i < NS * RP; i += ngt) { const int s_ = i / RP, c = i - s_ * RP; F.out[O_SS + (size_t)l * NS * RP + i] = PR[(size_t)(MP + s_) * 2048 + c]; }
}

template <int CTRL> __device__ __forceinline__ float dpp_f(float x) { return __builtin_bit_cast(float, __builtin_amdgcn_mov_dpp(__builtin_bit_cast(int, x), CTRL, 0xf, 0xf, true)); }
__device__ __forceinline__ float row16_sum(float x) {
    x += dpp_f<0xB1>(x); x += dpp_f<0x4E>(x); x += dpp_f<0x141>(x); x += dpp_f<0x128>(x); return x;
}
constexpr int RA_STRIDE = 1936;
constexpr int R_T1OFF = 32 * RA_STRIDE, RT_STRIDE = 80;
struct XmRow { const float* p; const float* pv; float pz; };
__device__ __forceinline__ XmRow xm_row(const float* PR, const float* sshift, int m) {
    XmRow r; r.p = PR + (size_t)m * 2048; const bool first = m < MP && (m & (SEQ - 1)) == 0;
    r.pv = m >= MP ? sshift + (size_t)(m - MP) * RP : first ? r.p : r.p - 2048; r.pz = first ? 0.f : 1.f; return r;
}
__device__ __forceinline__ float xm_at(const XmRow& r, const float* mu, int c) { const float p = r.p[c]; return p + (r.pv[c] * r.pz - p) * mu[c]; }
__device__ __forceinline__ f32x4 xm4_at(const XmRow& r, const float* mu, int c) { const f32x4 p = *(const f32x4*)(r.p + c); return p + (*(const f32x4*)(r.pv + c) * r.pz - p) * *(const f32x4*)(mu + c); }
template <int KS> __device__ __forceinline__ void lora_mm(f32x4 (&acc)[4], const bf16* Wt, int ldw, int nbase, LAS const unsigned char* Arow, int acol, int g, int c16) {
#pragma unroll
    for (int nt = 0; nt < 4; ++nt) acc[nt] = (f32x4){0.f, 0.f, 0.f, 0.f};
#pragma unroll
    for (int ks = 0; ks < KS; ++ks) { const bf16x8 af = *(LAS const bf16x8*)(Arow + (acol + 32 * ks + 8 * g) * 2);
#pragma unroll
        for (int nt = 0; nt < 4; ++nt) { const bf16x8 wf = *(const bf16x8*)(Wt + (size_t)(nbase + 16 * nt + c16) * ldw + 32 * ks + 8 * g); acc[nt] = MFMA16(wf, af, acc[nt]); } }
}
__device__ __forceinline__ float frcp(float x) { return __builtin_amdgcn_rcpf(x); }
__device__ __forceinline__ f32x4 fsig4(f32x4 v) { f32x4 r; r.x = frcp(1.f + __expf(-v.x)); r.y = frcp(1.f + __expf(-v.y)); r.z = frcp(1.f + __expf(-v.z)); r.w = frcp(1.f + __expf(-v.w)); return r; }
__device__ __forceinline__ void rwkv_prep_unit(const Frame& F, int l, int ti) {
    int tid_l = F.tid; asm volatile("" : "+v"(tid_l)); const int lane_l = tid_l & 63;
    LAS unsigned char* Aop = F.lds; LAS unsigned char* T1 = F.lds + R_T1OFF;
    const float* PR = (const float*)(F.ws + WS_PR); const float* sshift = INP(7) + (size_t)l * NS * RP; const float* mu = INP(19) + l * RP;
    const int m0 = ti * 32; const bool vres = l > 0;
    TSB2(70, F.lds);
#pragma unroll
    for (int q0 = 0; q0 < 8; q0 += 4) { f32x4 xv[4];
#pragma unroll
        for (int q = 0; q < 4; ++q) if (q0 + q < 7) { const int i = tid_l + (q0 + q) * NTHR, r = i / 112, c4 = i - r * 112; const XmRow xr = xm_row(PR, sshift, m0 + r); xv[q] = xm4_at(xr, mu, 1536 + 4 * c4); }
#pragma unroll
        for (int q = 0; q < 4; ++q) if (q0 + q < 7) { const int i = tid_l + (q0 + q) * NTHR, r = i / 112, c4 = i - r * 112, c = 4 * c4; f32x4 y = xv[q];
            if (c < 96) { y.x = 1.f - 2.f * frcp(1.f + __expf(2.f * y.x)); y.y = 1.f - 2.f * frcp(1.f + __expf(2.f * y.y)); y.z = 1.f - 2.f * frcp(1.f + __expf(2.f * y.z)); y.w = 1.f - 2.f * frcp(1.f + __expf(2.f * y.w)); }
            else if (c >= 192) y = fsig4(y);
            u32x2 w; w.x = cvt_pk_bf16(y.x, y.y); w.y = cvt_pk_bf16(y.z, y.w); *(LAS u32x2*)(Aop + r * RA_STRIDE + c * 2) = w; }
        asm volatile("" ::: "memory"); __builtin_amdgcn_sched_barrier(0); }
    if (vres) {
#pragma unroll
        for (int q0 = 0; q0 < 8; q0 += 4) { f32x4 xv[4];
#pragma unroll
            for (int q = 0; q < 4; ++q) { const int i = tid_l + (q0 + q) * NTHR, r = i >> 7, c4 = i & 127; const XmRow xr = xm_row(PR, sshift, m0 + r); xv[q] = xm4_at(xr, mu, 1024 + 4 * c4); }
#pragma unroll
            for (int q = 0; q < 4; ++q) { const int i = tid_l + (q0 + q) * NTHR, r = i >> 7, c4 = i & 127; u32x2 w; w.x = cvt_pk_bf16(xv[q].x, xv[q].y); w.y = cvt_pk_bf16(xv[q].z, xv[q].w); *(LAS u32x2*)(Aop + r * RA_STRIDE + (448 + 4 * c4) * 2) = w; }
            asm volatile("" ::: "memory"); __builtin_amdgcn_sched_barrier(0); } }
    __syncthreads();
    TSE2(70, F.lds); TSB2(71, F.lds);
    const int g = lane_l >> 4, c16 = lane_l & 15, nb = 64 * F.wave;
    if (vres) {
        if (F.wave < 4) { const int mt = F.wave >> 1, nt = F.wave & 1; f32x4 a = (f32x4){0.f, 0.f, 0.f, 0.f}; const bf16* w1 = (const bf16*)wl(F, 1, WL_V1) + (size_t)(16 * nt + c16) * 512 + 8 * g;
#pragma unroll
            for (int kh = 0; kh < 2; ++kh) { bf16x8 wf[8];
#pragma unroll
                for (int ks = 0; ks < 8; ++ks) wf[ks] = *(const bf16x8*)(w1 + 32 * (8 * kh + ks));
#pragma unroll
                for (int ks = 0; ks < 8; ++ks) { const bf16x8 af = *(LAS const bf16x8*)(Aop + (16 * mt + c16) * RA_STRIDE + (448 + 32 * (8 * kh + ks) + 8 * g) * 2); a = MFMA16(wf[ks], af, a); }
                asm volatile("" ::: "memory"); __builtin_amdgcn_sched_barrier(0); }
            u32x2 wv; wv.x = cvt_pk_bf16(a.x, a.y); wv.y = cvt_pk_bf16(a.z, a.w); *(LAS u32x2*)(T1 + (16 * mt + c16) * RT_STRIDE + (16 * nt + 4 * g) * 2) = wv;
#if MK_DEBUG
            *(f32x4*)((float*)(F.ws + WS_H) + (size_t)(m0 + 16 * mt + c16) * 32 + 16 * nt + 4 * g) = a;
#endif
            }
        __syncthreads();
    }
    LAS unsigned char* Aimg = F.lds + 65536; LAS unsigned char* Limg = F.lds + 65536 + 32768;
    size_t ro[2]; int mrow[2];
#pragma unroll
    for (int mt = 0; mt < 2; ++mt) { int m = m0 + 16 * mt + c16; asm volatile("" : "+v"(m)); mrow[mt] = m; ro[mt] = (size_t)m * 512 + nb + 4 * g; }
    TSE2(71, F.lds); TSB2(72, F.lds);
#define LORA_PASS(WT, LDW, ACOL, KS0, NKS, ACC) do { bf16x8 wq_[NKS][4]; const bf16* pw_ = (const bf16*)(WT) + (size_t)(nb + c16) * (LDW) + 8 * g + 32 * (KS0); \
        _Pragma("unroll") for (int ks = 0; ks < NKS; ++ks) _Pragma("unroll") for (int nt = 0; nt < 4; ++nt) wq_[ks][nt] = *(const bf16x8*)(pw_ + (size_t)16 * nt * (LDW) + 32 * ks); \
        _Pragma("unroll") for (int mt = 0; mt < 2; ++mt) { LAS const unsigned char* Arow_ = Aop + (16 * mt + c16) * RA_STRIDE + ((ACOL) + 32 * (KS0) + 8 * g) * 2; \
            _Pragma("unroll") for (int ks = 0; ks < NKS; ++ks) { const bf16x8 af_ = *(LAS const bf16x8*)(Arow_ + 64 * ks); \
                _Pragma("unroll") for (int nt = 0; nt < 4; ++nt) ACC[mt][nt] = MFMA16(wq_[ks][nt], af_, ACC[mt][nt]); } } \
        asm volatile("" ::: "memory"); __builtin_amdgcn_sched_barrier(0); } while (0)
#define LORA_ZERO(ACC) do { _Pragma("unroll") for (int mt = 0; mt < 2; ++mt) _Pragma("unroll") for (int nt = 0; nt < 4; ++nt) ACC[mt][nt] = (f32x4){0.f, 0.f, 0.f, 0.f}; } while (0)
    {
        const float* a0p = INP(22) + l * 512; f32x4 acc[2][4]; LORA_ZERO(acc); LORA_PASS(wl(F, l, WL_A2), 96, 96, 0, 2, acc); LORA_PASS(wl(F, l, WL_A2), 96, 96, 2, 1, acc);
#pragma unroll
        for (int mt = 0; mt < 2; ++mt)
#pragma unroll
            for (int nt = 0; nt < 4; ++nt) { const f32x4 a = fsig4(acc[mt][nt] + *(const f32x4*)(a0p + nb + 16 * nt + 4 * g)); u32x2 w; w.x = cvt_pk_bf16(a.x, a.y); w.y = cvt_pk_bf16(a.z, a.w);
                *(LAS u32x2*)(Aimg + ((16 * mt + c16) * 512 + nb + 16 * nt + 4 * g) * 2) = w; } }
    {
        const float* w0p = INP(20) + l * 512; float* Wb = rwbuf(F, RW_W); f32x4 acc[2][4]; LORA_ZERO(acc); LORA_PASS(wl(F, l, WL_W2), 96, 0, 0, 2, acc); LORA_PASS(wl(F, l, WL_W2), 96, 0, 2, 1, acc);
#pragma unroll
        for (int mt = 0; mt < 2; ++mt)
#pragma unroll
            for (int nt = 0; nt < 4; ++nt) { const f32x4 z = acc[mt][nt] + *(const f32x4*)(w0p + nb + 16 * nt + 4 * g); f32x4 dec;
#pragma unroll
                for (int e = 0; e < 4; ++e) { const float zz = -z[e]; const float sp = fmaxf(zz, 0.f) + __logf(1.f + __expf(-fabsf(zz))); dec[e] = __expf(-__expf(-sp - 0.5f)); }
                *(f32x4*)(Wb + ro[mt] + 16 * nt) = dec; } }
    {
        float* Gb = rwbuf(F, RW_G); f32x4 acc[2][4]; LORA_ZERO(acc); LORA_PASS(wl(F, l, WL_G2), 256, 192, 0, 2, acc); LORA_PASS(wl(F, l, WL_G2), 256, 192, 2, 2, acc); LORA_PASS(wl(F, l, WL_G2), 256, 192, 4, 2, acc); LORA_PASS(wl(F, l, WL_G2), 256, 192, 6, 2, acc);
#pragma unroll
        for (int mt = 0; mt < 2; ++mt)
#pragma unroll
            for (int nt = 0; nt < 4; ++nt) *(f32x4*)(Gb + ro[mt] + 16 * nt) = acc[mt][nt]; }
#undef LORA_PASS
#undef LORA_ZERO
    TSE2(72, F.lds); TSB2(73, F.lds);
    if (vres) {
#pragma unroll
        for (int mt = 0; mt < 2; ++mt) { const bf16x8 tf = *(LAS const bf16x8*)(T1 + (16 * mt + c16) * RT_STRIDE + (8 * g) * 2); const f32x4 z4 = (f32x4){0.f, 0.f, 0.f, 0.f};
#pragma unroll
            for (int nt = 0; nt < 4; ++nt) { const bf16x8 wf = *(const bf16x8*)((const bf16*)wl(F, 1, WL_V2) + (size_t)(nb + 16 * nt + c16) * 32 + 8 * g); const f32x4 lv = MFMA16(wf, tf, z4);
                u32x2 w; w.x = cvt_pk_bf16(lv.x, lv.y); w.y = cvt_pk_bf16(lv.z, lv.w); *(LAS u32x2*)(Limg + ((16 * mt + c16) * 512 + nb + 16 * nt + 4 * g) * 2) = w;
#if MK_DEBUG
                *(f32x4*)(rwbuf(F, RW_Y) + ro[mt] + 16 * nt) = lv;
#endif
            } } }
    __syncthreads();
    {   const float* vbp = INP(33); const float* kkp = INP(25) + l * 512; const float* kap = INP(26) + l * 512;
        float* Rb = rwbuf(F, RW_R); float* Kb = rwbuf(F, RW_K); float* Vb = rwbuf(F, RW_V); float* Ab = rwbuf(F, RW_A); float* Bb = rwbuf(F, RW_B); float* VF = rwbuf(F, RW_VF);
        const int r = tid_l >> 4, j16 = tid_l & 15; int m = m0 + r; asm volatile("" : "+v"(m)); const XmRow xr = xm_row(PR, sshift, m);
#pragma unroll 4
        for (int h = 0; h < 8; ++h) { const int n = 64 * h + 4 * j16; const size_t o = (size_t)m * 512 + n;
            const f32x4 rx = xm4_at(xr, mu, n), k = xm4_at(xr, mu, 512 + n); f32x4 v = xm4_at(xr, mu, 1024 + n);
            const u32x2 aw = *(LAS const u32x2*)(Aimg + (r * 512 + n) * 2); f32x4 a; a.x = bflo(aw.x); a.y = bfhi(aw.x); a.z = bflo(aw.y); a.w = bfhi(aw.y);
            const f32x4 kk = k * *(const f32x4*)(kkp + n);
            const float ss = row16_sum((kk.x * kk.x + kk.y * kk.y) + (kk.z * kk.z + kk.w * kk.w)), rn = 1.f / fmaxf(sqrtf(ss), 1e-12f);
            *(f32x4*)(Rb + o) = rx;
            *(f32x4*)(Kb + o) = k * ((a - 1.f) * *(const f32x4*)(kap + n) + 1.f);
            if (!vres) *(f32x4*)(VF + o) = v;
            else { const u32x2 lw = *(LAS const u32x2*)(Limg + (r * 512 + n) * 2); f32x4 lv; lv.x = bflo(lw.x); lv.y = bfhi(lw.x); lv.z = bflo(lw.y); lv.w = bfhi(lw.y);
                const f32x4 vf = *(const f32x4*)(VF + o); v = v + (vf - v) * fsig4(lv + *(const f32x4*)(vbp + n)); }
            *(f32x4*)(Vb + o) = v;
            const f32x4 kn = kk * rn; *(f32x4*)(Ab + o) = -kn; *(f32x4*)(Bb + o) = kn * a; } }
    TSE2(73, F.lds);
    __syncthreads();
}

constexpr int SC_T = 32, SC_ARR = SC_T * 64 * 4, SC_BUF = 5 * SC_ARR + SC_T * 16 * 4, SC_NSLOT = 3;
static_assert(SC_NSLOT * SC_BUF <= 131072, "scan ring fits the phase LDS");
__device__ __forceinline__ float wave_sum64(float x) { x = row16_sum(x); x += __shfl_xor(x, 16); x += __shfl_xor(x, 32); return x; }
__device__ __forceinline__ void scan_prompt_unit(const Frame& F, int l, int b, int h, int qt) {
    const size_t rowb = (size_t)b * SEQ;
    constexpr int NCH = SEQ / SC_T;
    if (F.wave >= 4) {
        const float* src0 = rwbuf(F, RW_W); const float* src1 = rwbuf(F, RW_A); const float* src2 = rwbuf(F, RW_B); const float* src3 = rwbuf(F, RW_K); const float* src4 = rwbuf(F, RW_R); const float* Vb = rwbuf(F, RW_V);
        const int lt = F.tid - 256, lw = F.wave - 4;
        const size_t g0 = (rowb + (lt >> 4)) * 512 + h * 64 + 4 * (lt & 15), g1 = g0 + (size_t)16 * 512;
        const size_t gv0 = (rowb + (lt & 31)) * 512 + h * 64 + qt * 16 + (lt >> 5), gv1 = gv0 + 8;
        const unsigned l0 = (unsigned)lw * 1024u, l1 = l0 + 4096u;
#define SC_GL(src, goff, slot, arr, loff) __builtin_amdgcn_global_load_lds((const unsigned*)((src) + (goff)), (LAS unsigned*)(F.lds + (slot) * SC_BUF + (arr) * SC_ARR + (loff)), 16, 0, 0)
#define SC_STAGE(ch_, slot_) do { const size_t co_ = (size_t)(ch_) * SC_T * 512; \
            SC_GL(src0, g0 + co_, slot_, 0, l0); SC_GL(src0, g1 + co_, slot_, 0, l1); SC_GL(src1, g0 + co_, slot_, 1, l0); SC_GL(src1, g1 + co_, slot_, 1, l1); SC_GL(src2, g0 + co_, slot_, 2, l0); SC_GL(src2, g1 + co_, slot_, 2, l1); \
            SC_GL(src3, g0 + co_, slot_, 3, l0); SC_GL(src3, g1 + co_, slot_, 3, l1); SC_GL(src4, g0 + co_, slot_, 4, l0); SC_GL(src4, g1 + co_, slot_, 4, l1); \
            __builtin_amdgcn_global_load_lds((const unsigned*)(Vb + gv0 + co_), (LAS unsigned*)(F.lds + (slot_) * SC_BUF + 5 * SC_ARR + lw * 256), 4, 0, 0); \
            __builtin_amdgcn_global_load_lds((const unsigned*)(Vb + gv1 + co_), (LAS unsigned*)(F.lds + (slot_) * SC_BUF + 5 * SC_ARR + 1024 + lw * 256), 4, 0, 0); } while (0)
        SC_STAGE(0, 0); SC_STAGE(1, 1);
        asm volatile("s_waitcnt vmcnt(12)" ::: "memory");
        __builtin_amdgcn_s_barrier();
        int slot = 2;
        for (int ch = 0; ch < NCH; ++ch) {
            if (ch + 2 < NCH) { SC_STAGE(ch + 2, slot);
                asm volatile("s_waitcnt vmcnt(12)" ::: "memory"); }
            else asm volatile("s_waitcnt vmcnt(0)" ::: "memory");
            __builtin_amdgcn_s_barrier();
            slot = slot == 2 ? 0 : slot + 1;
        }
#undef SC_GL
#undef SC_STAGE
    } else {
        float* Yb = rwbuf(F, RW_Y);
        const int rg = F.lane >> 4, j4 = F.lane & 15, rloc = F.wave * 4 + rg;
        f32x4 s = (f32x4){0.f, 0.f, 0.f, 0.f}; float ypv[16]; const bool b8 = (j4 & 8) != 0, b4 = (j4 & 4) != 0, b2 = (j4 & 2) != 0, b1 = (j4 & 1) != 0;
        float* yp = Yb + (rowb + j4) * 512 + h * 64 + qt * 16 + rloc;
        __builtin_amdgcn_s_barrier(); asm volatile("" ::: "memory");
        int slot = 0;
        for (int ch = 0; ch < NCH; ++ch) {
            LAS const unsigned char* bp = F.lds + slot * SC_BUF + j4 * 16; LAS const f32x4* vp = (LAS const f32x4*)(F.lds + slot * SC_BUF + 5 * SC_ARR + rloc * 128);
            f32x4 w = *(LAS const f32x4*)(bp + 0 * SC_ARR), a = *(LAS const f32x4*)(bp + 1 * SC_ARR), bb = *(LAS const f32x4*)(bp + 2 * SC_ARR), k = *(LAS const f32x4*)(bp + 3 * SC_ARR), r = *(LAS const f32x4*)(bp + 4 * SC_ARR);
            f32x4 vq = vp[0];
#pragma unroll
            for (int tt = 0; tt < SC_T; ++tt) {
                const float v = vq[tt & 3];
                asm volatile("" :: "v"(w), "v"(a), "v"(bb), "v"(k), "v"(r), "v"(vq));
                __builtin_amdgcn_sched_barrier(0);
                f32x4 wn = w, an = a, bn = bb, kn = k, rn = r, vqn = vq;
                if (tt + 1 < SC_T) { wn = *(LAS const f32x4*)(bp + 0 * SC_ARR + (tt + 1) * 256); an = *(LAS const f32x4*)(bp + 1 * SC_ARR + (tt + 1) * 256); bn = *(LAS const f32x4*)(bp + 2 * SC_ARR + (tt + 1) * 256);
                    kn = *(LAS const f32x4*)(bp + 3 * SC_ARR + (tt + 1) * 256); rn = *(LAS const f32x4*)(bp + 4 * SC_ARR + (tt + 1) * 256); if ((tt & 3) == 3) vqn = vp[(tt + 1) >> 2]; }
                __builtin_amdgcn_sched_barrier(0);
                const f32x4 p = s * w + k * v;
                const float sa = row16_sum(fmaf(s.w, a.w, fmaf(s.z, a.z, fmaf(s.y, a.y, s.x * a.x))));
                s = bb * sa + p;
                ypv[tt & 15] = fmaf(s.w, r.w, fmaf(s.z, r.z, fmaf(s.y, r.y, s.x * r.x)));
                if ((tt & 15) == 15) {
                    float q8[8], q4[4], q2[2];
#pragma unroll
                    for (int kq = 0; kq < 8; ++kq) { const float keep = b8 ? ypv[kq + 8] : ypv[kq], send = b8 ? ypv[kq] : ypv[kq + 8]; q8[kq] = keep + dpp_f<0x128>(send); }
#pragma unroll
                    for (int kq = 0; kq < 4; ++kq) { const float keep = b4 ? q8[kq + 4] : q8[kq], send = b4 ? q8[kq] : q8[kq + 4]; q4[kq] = keep + dpp_f<0x141>(send); }
#pragma unroll
                    for (int kq = 0; kq < 2; ++kq) { const float keep = b2 ? q4[kq + 2] : q4[kq], send = b2 ? q4[kq] : q4[kq + 2]; q2[kq] = keep + dpp_f<0x4E>(send); }
                    { const float keep = b1 ? q2[1] : q2[0], send = b1 ? q2[0] : q2[1]; yp[(size_t)(ch * SC_T + (tt & ~15)) * 512] = keep + dpp_f<0xB1>(send); }
                }
                w = wn; a = an; bb = bn; k = kn; r = rn; vq = vqn;
            }
            __builtin_amdgcn_s_barrier(); asm volatile("" ::: "memory");
            slot = slot == 2 ? 0 : slot + 1;
        }
        *(f32x4*)(F.out + O_WP + ((((size_t)l * NB + b) * 8 + h) * 64 + qt * 16 + rloc) * 64 + 4 * j4) = s;
    }
    __syncthreads();
}
__device__ __forceinline__ void scan_sample_wave(const Frame& F, int l, int s_, int h) {
    const size_t m = MP + s_; const int rg = F.lane >> 4, j4 = F.lane & 15; const size_t o = m * 512 + h * 64 + 4 * j4;
    const f32x4 w = *(const f32x4*)(rwbuf(F, RW_W) + o), a = *(const f32x4*)(rwbuf(F, RW_A) + o), bb = *(const f32x4*)(rwbuf(F, RW_B) + o), k = *(const f32x4*)(rwbuf(F, RW_K) + o), r = *(const f32x4*)(rwbuf(F, RW_R) + o);
    const float* S0 = INP(8) + (((size_t)l * NS + s_) * 8 + h) * 4096; float* S1 = F.out + O_WS + (((size_t)l * NS + s_) * 8 + h) * 4096;
    const int row = 4 * j4 + rg; const size_t orow = m * 512 + h * 64 + row;
    const float v_my = rwbuf(F, RW_V)[orow], g_my = rwbuf(F, RW_G)[orow], rk_r = INP(27)[l * 512 + h * 64 + row], lg_r = INP(28)[l * 512 + h * 64 + row], lb_r = INP(29)[l * 512 + h * 64 + row];
    const f32x4 rk4 = *(const f32x4*)(INP(27) + l * 512 + h * 64 + 4 * j4);
    (void)rk_r;
    float yk = 0.f;
#pragma unroll 4
    for (int i0 = 0; i0 < 16; ++i0) { const int i = 4 * i0 + rg; f32x4 s = *(const f32x4*)(S0 + i * 64 + 4 * j4); const float v = rwbuf(F, RW_V)[m * 512 + h * 64 + i];
        const float sa = row16_sum((s.x * a.x + s.y * a.y) + (s.z * a.z + s.w * a.w));
        s = s * w + bb * sa + k * v;
        const float y = row16_sum((s.x * r.x + s.y * r.y) + (s.z * r.z + s.w * r.w));
        *(f32x4*)(S1 + i * 64 + 4 * j4) = s; yk = (j4 == i0) ? y : yk; }
    const float bon = row16_sum((r.x * k.x * rk4.x + r.y * k.y * rk4.y) + (r.z * k.z * rk4.z + r.w * k.w * rk4.w));
    const float mu = wave_sum64(yk) * (1.f / 64.f), dv = yk - mu, var = wave_sum64(dv * dv) * (1.f / 64.f);
    ((bf16*)(F.ws + WS_CAT))[m * D + 1536 + h * 64 + row] = (bf16)f2bf((dv * rsqrtf(var + 64e-5f) * lg_r + lb_r + bon * v_my) * g_my);
#if MK_DEBUG
    rwbuf(F, RW_Y)[orow] = yk;
#endif
}
__device__ __forceinline__ void rwkv_post_phase(const Frame& F, int l) {
    const int gw = F.bid * NWAVES + F.wave, NGW = F.G * NWAVES; const float* rkp = INP(27) + l * 512; const float* lgp = INP(28) + l * 512; const float* lbp = INP(29) + l * 512;
    const float* Yb = rwbuf(F, RW_Y); const float* Rb = rwbuf(F, RW_R); const float* Kb = rwbuf(F, RW_K); const float* Vb = rwbuf(F, RW_V); const float* Gb = rwbuf(F, RW_G);
    for (int it0 = gw * 4; it0 < MP * 8; it0 += NGW * 4) {
        float y[4], r[4], k[4], v[4], g[4];
#pragma unroll
        for (int q = 0; q < 4; ++q) { const int it = it0 + q, m = it >> 3, h = it & 7; const size_t o = (size_t)m * 512 + h * 64 + F.lane; y[q] = Yb[o]; r[q] = Rb[o]; k[q] = Kb[o]; v[q] = Vb[o]; g[q] = Gb[o]; }
#pragma unroll
        for (int q = 0; q < 4; ++q) { const int it = it0 + q, m = it >> 3, h = it & 7, c = h * 64 + F.lane;
            const float mu = wave_sum64(y[q]) * (1.f / 64.f), dv = y[q] - mu, var = wave_sum64(dv * dv) * (1.f / 64.f), bon = wave_sum64(r[q] * k[q] * rkp[c]);
            ((bf16*)(F.ws + WS_CAT))[(size_t)m * D + 1536 + c] = (bf16)f2bf((dv * rsqrtf(var + 64e-5f) * lgp[c] + lbp[c] + bon * v[q]) * g[q]); }
    }
}
}
namespace mk {
namespace cg = cooperative_groups;
constexpr int LDS_BYTES = 135168;
constexpr int TS_OFF = LDS_BYTES - 64;
#ifdef MK_TS_ID
#ifndef MK_TS_BLOCK
#define MK_TS_BLOCK 0
#endif
#ifndef MK_TS_AMP
#define MK_TS_AMP 8
#endif
#define TSB(id, ldsp) do { if ((id) == MK_TS_ID && blockIdx.x == MK_TS_BLOCK && threadIdx.x == 0) *(volatile LAS unsigned*)((ldsp) + TS_OFF) -= (unsigned)__builtin_amdgcn_s_memrealtime(); } while (0)
#define TSE(id, ldsp) do { if ((id) == MK_TS_ID && blockIdx.x == MK_TS_BLOCK && threadIdx.x == 0) *(volatile LAS unsigned*)((ldsp) + TS_OFF) += (unsigned)__builtin_amdgcn_s_memrealtime(); } while (0)
#else
#define TSB(id, ldsp) do {} while (0)
#define TSE(id, ldsp) do {} while (0)
#endif
constexpr int PH_PRO = 0, PH_ADA = 1, PH_L0 = 2, PH_PER_L = 10, PH_FINAL = PH_L0 + NL * PH_PER_L, N_PHASES = PH_FINAL + 1;
enum { LP_NORM1 = 0, LP_IN, LP_MIX, LP_SCAN, LP_POST, LP_MG, LP_WO, LP_NORM2, LP_GU, LP_DN };

__device__ __forceinline__ void mix_phase(const Frame& F, int l) {
    TSB(40, F.lds);
    for (int u = F.bid; u < 256; u += F.G) rwkv_prep_unit(F, l, u);
    TSE(40, F.lds);
    TSB(44, F.lds); state_outs(F, l); TSE(44, F.lds);
}
constexpr int SCAN_BLOCKS = 64;
constexpr int GL_PM_SPLIT = 10;
__device__ __forceinline__ void scan_phase(const Frame& F, int l) {
    if (F.bid < SCAN_BLOCKS) scan_prompt_unit(F, l, F.bid >> 5, (F.bid >> 2) & 7, F.bid & 3);
    else { const int nb_ = F.G - SCAN_BLOCKS, wb = F.bid - SCAN_BLOCKS; const int nw = nb_ * NWAVES; unsigned* ctl = (unsigned*)(F.ws + WS_CTL) + 64 * l;
        if (wb < 4) { rwkv_prep_unit(F, l, 256 + wb); asm volatile("s_waitcnt vmcnt(0)" ::: "memory"); __syncthreads();
            if (F.tid == 0) { __builtin_amdgcn_fence(__ATOMIC_RELEASE, "agent"); asm volatile("s_waitcnt vmcnt(0)" ::: "memory"); __hip_atomic_fetch_add(ctl, 1u, __ATOMIC_RELAXED, __HIP_MEMORY_SCOPE_AGENT); } }
        TSB(41, F.lds);
        for (int a = wb; a < 256; a += nb_) attn_prompt_unit(F, l, a >> 7, (a >> 2) & 31, a & 3);
        TSE(41, F.lds); TSB(42, F.lds);
        for (int p = (wb + 64) % nb_; p < 260; p += nb_) pool_unit(F, l, p >> 2, p & 3);
        TSE(42, F.lds); TSB(43, F.lds);
        for (int s_ = (wb + 132) % nb_; s_ < 2 * NS; s_ += nb_) attn_sample_unit(F, l, s_ >> 1, s_ & 1);
        TSE(43, F.lds);
        __syncthreads();
        Gemm g; g.layer = l; g.ld = D; g.M = MPAD; g.K = D; g.N = NIN; g.A = (const bf16*)(F.ws + WS_H); g.Bt = (const bf16*)wl(F, l, WL_IN); g.mode = G_IN;
        Sched S; S.init(Rect{GL_PM_SPLIT, MPAD / BM - GL_PM_SPLIT, 16, 24}, Rect{0, 0, 0, 0}, F.G - SCAN_BLOCKS, F.bid - SCAN_BLOCKS, 1); Epi E; E.F = &F; E.mode = G_IN; E.layer = l;
        TSB(45, F.lds); gemm_phase(F.lds, g, S, E, F.tid); TSE(45, F.lds);
        if (l == 0) { TSB(46, F.lds); p0_prologue(F, 2, false, wb, nb_, 0); TSE(46, F.lds); }
        if (F.tid == 0) { unsigned sp = 0; while (__hip_atomic_load(ctl, __ATOMIC_RELAXED, __HIP_MEMORY_SCOPE_AGENT) < 4u && ++sp < (1u << 26)) __builtin_amdgcn_s_sleep(8);
            __builtin_amdgcn_fence(__ATOMIC_ACQUIRE, "agent"); asm volatile("s_waitcnt vmcnt(0)" ::: "memory"); }
        __syncthreads();
        for (int u = wb * NWAVES + F.wave; u < NS * 8; u += nw) scan_sample_wave(F, l, u >> 3, u & 7); }
}

#define XB_TMO      128
#define XB_XCNT(j)  (256  + 64 * (j))
#define XB_XSUB(j)  (1280 + 64 * (j))
#define XB_XGEN(j)  (2304 + 64 * (j))
#define XB_TOP      3328
#define XB_TOPGEN   3392
#define XCD_BAR_WORDS 3456
#define XB_SPIN_CAP (1u << 18)

__device__ __forceinline__ unsigned xb_ld(unsigned* p)              { return __hip_atomic_load(p, __ATOMIC_RELAXED, __HIP_MEMORY_SCOPE_AGENT); }
__device__ __forceinline__ unsigned xb_add(unsigned* p, unsigned v) { return __hip_atomic_fetch_add(p, v, __ATOMIC_RELAXED, __HIP_MEMORY_SCOPE_AGENT); }
__device__ __forceinline__ unsigned xb_xcc_id() { return (unsigned)__builtin_amdgcn_s_getreg((3 << 11) | 20) & 0xFu; }
#define XB_SPIN(cond, bar) do { unsigned _sp = 0; while (cond) { __builtin_amdgcn_s_sleep(1); \
    if ((++_sp & 255u) == 0u) { if (xb_ld(&(bar)[XB_TMO])) break; if (_sp > XB_SPIN_CAP) { atomicAdd(&(bar)[XB_TMO], 1u); break; } } } } while (0)

struct XcdBarrier {
    unsigned* bar; unsigned x;
    volatile LAS unsigned* st;
};

__device__ __forceinline__ XcdBarrier xcd_barrier_post(unsigned* bar, volatile LAS unsigned* st) {
    XcdBarrier b; b.bar = bar; b.x = xb_xcc_id(); b.st = st;
    if (threadIdx.x == 0) (void)xb_add(&bar[XB_XCNT(b.x)], 1u);
    return b;
}
__device__ __forceinline__ void xcd_barrier_complete(unsigned* bar, unsigned x, unsigned& nloc, unsigned& nx) {
    const unsigned G = gridDim.x * gridDim.y * gridDim.z;
    unsigned sum, cnt, mine, sp = 0u;
    for (;;) {
        sum = 0u; cnt = 0u; mine = 0u;
#pragma unroll
        for (unsigned j = 0; j < 16; ++j) { const unsigned c = xb_ld(&bar[XB_XCNT(j)]); sum += c; cnt += (c > 0u) ? 1u : 0u; mine = (j == x) ? c : mine; }
        if (sum == G) break;
        __builtin_amdgcn_s_sleep(1);
        if ((++sp & 255u) == 0u) { if (xb_ld(&bar[XB_TMO])) break; if (sp > XB_SPIN_CAP) { atomicAdd(&bar[XB_TMO], 1u); break; } }
    }
    nloc = mine > 0u ? mine : 1u; nx = cnt > 0u ? cnt : 1u;
}

__device__ __forceinline__ void xcd_barrier(const XcdBarrier& b) {
    asm volatile("s_waitcnt vmcnt(0)" ::: "memory");
    __syncthreads();
    if (threadIdx.x == 0) {
        unsigned* bar = b.bar;
        __builtin_amdgcn_s_waitcnt(0);
        unsigned nloc = b.st[0], nx = b.st[1];
        if (nloc == 0u) { xcd_barrier_complete(bar, b.x, nloc, nx); b.st[0] = nloc; b.st[1] = nx; }
        const unsigned old = xb_add(&bar[XB_XSUB(b.x)], 1u);
        const unsigned gen = old / nloc;
        if (old + 1u == (gen + 1u) * nloc) {
            __builtin_amdgcn_fence(__ATOMIC_RELEASE, "agent");
            asm volatile("s_waitcnt vmcnt(0)" ::: "memory");
            const unsigned og = xb_add(&bar[XB_TOP], 1u);
            const unsigned tg = og / nx;
            if (og + 1u == (tg + 1u) * nx) xb_add(&bar[XB_TOPGEN], 1u);
            else XB_SPIN(xb_ld(&bar[XB_TOPGEN]) == tg, bar);
            __builtin_amdgcn_fence(__ATOMIC_ACQUIRE, "agent");
            xb_add(&bar[XB_XGEN(b.x)], 1u);
            asm volatile("s_waitcnt vmcnt(0)" ::: "memory");
        } else {
            XB_SPIN(xb_ld(&bar[XB_XGEN(b.x)]) == gen, bar);
            __builtin_amdgcn_fence(__ATOMIC_ACQUIRE, "agent");
            asm volatile("s_waitcnt vmcnt(0)" ::: "memory");
        }
    }
    __syncthreads();
}


__global__ void __launch_bounds__(NTHR, 2) __attribute__((target("no-packed-fp32-ops"))) mega(Args args) {
    extern __shared__ __attribute__((aligned(16))) unsigned char lds_raw[];
    cg::grid_group grid = cg::this_grid();
    if (threadIdx.x < 2) ((volatile LAS unsigned*)((LAS unsigned char*)lds_raw + TS_OFF - 64))[threadIdx.x] = 0u;
    __syncthreads();
    const XcdBarrier xbar = xcd_barrier_post((unsigned*)(args.ws + WS_CTL + 4096), (volatile LAS unsigned*)((LAS unsigned char*)lds_raw + TS_OFF - 64));
#ifdef MK_TS_ID
    if (threadIdx.x == 0) *(volatile LAS unsigned*)((LAS unsigned char*)lds_raw + TS_OFF) = 0u;
#endif
    for (int ph = args.ph_lo; ph < args.ph_hi; ++ph) {
        Frame F; { GAS unsigned char* ws_ = (GAS unsigned char*)args.ws; GAS float* out_ = (GAS float*)args.out; int tid_ = threadIdx.x; int bid_ = blockIdx.x; int G_ = gridDim.x;
            asm volatile("" : "+s"(ws_), "+s"(out_), "+v"(tid_), "+s"(bid_), "+s"(G_));
            F.lds = (LAS unsigned char*)lds_raw; F.tid = tid_; F.lane = tid_ & 63; F.wave = __builtin_amdgcn_readfirstlane(tid_ >> 6); F.G = G_; F.bid = bid_; F.out = (float*)out_; F.ws = (unsigned char*)ws_; }
        const int l = ph >= PH_L0 && ph < PH_FINAL ? (ph - PH_L0) / PH_PER_L : 0, lp = ph >= PH_L0 && ph < PH_FINAL ? (ph - PH_L0) % PH_PER_L : -1;
        TSB(ph == PH_PRO ? 1 : ph == PH_ADA ? 2 : ph == PH_FINAL ? 3 : 10 + lp, F.lds);
#ifndef MK_NO_PRO
        if (ph == PH_PRO) p0_prologue(F, 0, true, F.bid, F.G, 0); else
#endif
#ifndef MK_NO_NORM
        if (ph == PH_FINAL || lp == LP_NORM1 || lp == LP_NORM2) norm_phase(F, l, ph == PH_FINAL ? 2 : lp == LP_NORM1 ? 0 : 1, ph == PH_FINAL ? 11 : lp == LP_NORM2 ? 4 : (l > 0 ? 11 : 0)); else
#endif
#ifndef MK_NO_MIX
        if (lp == LP_MIX) { mix_phase(F, l);
#ifdef MK_DUP_MIX
            __syncthreads(); mix_phase(F, l);
#endif
        } else
#endif
#ifndef MK_NO_SCAN
        if (lp == LP_SCAN) { scan_phase(F, l);
#ifdef MK_DUP_SCAN
            __syncthreads(); scan_phase(F, l);
#endif
        } else
#endif
#ifndef MK_NO_POST
        if (lp == LP_POST) rwkv_post_phase(F, l); else
#endif
#ifndef MK_NO_GEMM
        {
            Gemm g; g.layer = l; g.ld = D; g.M = MPAD; g.K = D;
            if (ph == PH_ADA) { g.A = (const bf16*)(F.ws + WS_SILC); g.Bt = (const bf16*)(F.ws + WS_ADAW); g.M = 256; g.N = 2 * NADA; g.mode = G_ADA; }
            else if (lp == LP_IN) { g.A = (const bf16*)(F.ws + WS_H); g.Bt = (const bf16*)wl(F, l, WL_IN); g.N = NIN; g.mode = G_IN; }
            else if (lp == LP_MG) { g.A = (const bf16*)(F.ws + WS_CAT); g.Bt = (const bf16*)wl(F, l, WL_CAT); g.N = D; g.mode = G_MG; }
            else if (lp == LP_WO) { g.A = (const bf16*)(F.ws + WS_MG); g.Bt = (const bf16*)wl(F, l, WL_O); g.N = D; g.mode = G_WO; }
            else if (lp == LP_GU) { g.A = (const bf16*)(F.ws + WS_H); g.Bt = (const bf16*)wl(F, l, WL_GU); g.N = NGU; g.mode = G_GU; }
            else { g.A = (const bf16*)(F.ws + WS_GT); g.Bt = (const bf16*)wl(F, l, WL_DN); g.N = D; g.K = DFF; g.ld = DFF; g.mode = G_DN; }
            Sched S; Epi E; E.F = &F; E.mode = g.mode; E.layer = l;
            if (g.mode == G_WO && F.bid < 32) {
                const int ks = F.bid >> 3;
                const float* sl = (const float*)(F.ws + WS_SLABM); bf16* mg = (bf16*)(F.ws + WS_MG) + (size_t)MP * D;
                for (int i = F.tid; i < NS * 128; i += NTHR) { const int r = i >> 7, c = ks * 512 + (i & 127) * 4; const size_t o = (size_t)r * D + c;
                    const f32x4 v = *(const f32x4*)(sl + o) + *(const f32x4*)(sl + (size_t)NS * D + o) + *(const f32x4*)(sl + (size_t)2 * NS * D + o) + *(const f32x4*)(sl + (size_t)3 * NS * D + o);
                    u32x2 w; w.x = cvt_pk_bf16(v.x, v.y); w.y = cvt_pk_bf16(v.z, v.w); *(u32x2*)(mg + o) = w; }
                asm volatile("s_waitcnt vmcnt(0)" ::: "memory"); __syncthreads();
            }
            if (lp == LP_IN && ph != PH_ADA) S.init(Rect{0, MPAD / BM, 0, 16}, Rect{0, GL_PM_SPLIT, 16, 24}, F.G, F.bid, 1);
            else if (g.mode == G_WO || g.mode == G_DN || g.mode == G_MG) S.init(Rect{0, MPAD / BM - 1, 0, 8}, Rect{MPAD / BM - 1, 1, 0, 8 * (g.K / 512)}, F.G, F.bid, 1, 8);
            else S.init(Rect{0, g.M / BM, 0, g.N / BM}, Rect{0, 0, 0, 0}, F.G, F.bid, 1);
            gemm_phase(F.lds, g, S, E, F.tid);
            if (ph == PH_ADA) { if (F.bid < 96) p0_prologue(F, 1, false, F.bid, 96, 2); else p0_prologue(F, 1, false, F.bid - 96, F.G - 96, 1); }
        }
#else
        {}
#endif
        TSE(ph == PH_PRO ? 1 : ph == PH_ADA ? 2 : ph == PH_FINAL ? 3 : 10 + lp, F.lds);
        TSB(30, F.lds);
        if (ph + 1 < args.ph_hi) { if (args.ph_hi < 0) grid.sync();   else xcd_barrier(xbar); }
        TSE(30, F.lds);
    }
#ifdef MK_EXTRA_SYNCS
    for (int i = 0; i < MK_EXTRA_SYNCS; ++i) xcd_barrier(xbar);
#endif
#ifdef MK_TS_ID
    if (blockIdx.x == MK_TS_BLOCK && threadIdx.x == 0) { const unsigned want = *(volatile LAS unsigned*)((LAS unsigned char*)lds_raw + TS_OFF) * (unsigned)MK_TS_AMP; const unsigned t0 = (unsigned)__builtin_amdgcn_s_memrealtime();
        while ((unsigned)__builtin_amdgcn_s_memrealtime() - t0 < want) __builtin_amdgcn_s_sleep(32); }
#endif
}
}
#ifndef MK_DEBUG
#define MK_DEBUG 0
#endif
extern "C" void kernel_launch(void* const* d_in, const int* in_sizes, int n_in, void* d_out, int out_size, void* d_ws, size_t ws_size, hipStream_t stream) {
    using namespace mk;
    static int grid = 0;
    if (grid == 0) {
        nv::WS wtmp; const size_t need_nv = nv::carve((float*)d_ws, wtmp) * 4; const size_t need = MK_DEBUG ? (need_nv > WS_END ? need_nv : WS_END) + (16u << 20) : WS_END;
        if (n_in != 39 || (size_t)out_size != O_END || ws_size < need) { fprintf(stderr, "kernel_launch: unexpected shapes: n_in %d out %d (want %zu) ws %zu (need %zu)\n", n_in, out_size, (size_t)O_END, ws_size, need); grid = -1; return; }
        int dev = 0, cus = 0, per_cu = 0;
        if (hipGetDevice(&dev) != hipSuccess || hipDeviceGetAttribute(&cus, hipDeviceAttributeMultiprocessorCount, dev) != hipSuccess) { grid = -1; return; }
        if (hipFuncSetAttribute((const void*)mega, hipFuncAttributeMaxDynamicSharedMemorySize, LDS_BYTES) != hipSuccess) { fprintf(stderr, "kernel_launch: hipFuncSetAttribute failed\n"); grid = -1; return; }
        if (hipOccupancyMaxActiveBlocksPerMultiprocessor(&per_cu, (const void*)mega, NTHR, LDS_BYTES) != hipSuccess || per_cu < 1) { fprintf(stderr, "kernel_launch: occupancy query says %d blocks per CU\n", per_cu); per_cu = 1; }
        (void)hipGetLastError();
        grid = cus;
        fprintf(stderr, "kernel_launch: grid %d (cus %d, per_cu %d), ws %zu need %zu\n", grid, cus, per_cu, ws_size, need);
    }
    if (grid < 0) return;
    Args a{};
    for (int i = 0; i < 39; ++i) a.in[i] = (const float*)d_in[i];
    a.out = (float*)d_out; a.ws = (unsigned char*)d_ws;
    if (hipMemsetAsync((unsigned char*)d_ws + WS_CTL, 0, WS_CTL_BYTES, stream) != hipSuccess) { fprintf(stderr, "kernel_launch: hipMemsetAsync of the control words failed\n"); return; }
#if MK_DEBUG
    dbg::Ctx dc; dc.probes = (float*)((unsigned char*)d_ws + ((ws_size - (12u << 20)) & ~(size_t)255)); dc.err = dc.probes + (size_t)dbg::NIDS * dbg::NPROBE; dc.on = 1;
    (void)hipMemsetAsync(dc.err, 0, dbg::NIDS * 4 * sizeof(float), stream);
    unsigned char* ws = (unsigned char*)d_ws;
    for (int ph = 0; ph < N_PHASES; ++ph) {
        a.ph_lo = ph; a.ph_hi = ph + 1;
        hipLaunchKernelGGL(mega, dim3(grid), dim3(NTHR), LDS_BYTES, stream, a);
        using namespace dbg;
        const int l = ph >= PH_L0 && ph < PH_FINAL ? (ph - PH_L0) / PH_PER_L : 0, lp = ph >= PH_L0 && ph < PH_FINAL ? (ph - PH_L0) % PH_PER_L : -1, tb = T_L0 + l * T_PER_L;
        if (ph == PH_ADA) save(&dc, stream, T_MOD, ws + WS_MOD, K_F32, NADA, 0, NL * NMOD, NADA);
        if (lp == LP_NORM1) save(&dc, stream, tb + T_H1, ws + WS_H, K_BF16, D, 0, M, D);
        if (lp == LP_IN) { save(&dc, stream, tb + T_Q, ws + WS_Q, K_QPERM, 1024, 0, M, 1024); save(&dc, stream, tb + T_K, ws + WS_K, K_QPERM, 256, 0, M, 256); save(&dc, stream, tb + T_V, ws + WS_V, K_BF16, 256, 0, M, 256);
            save(&dc, stream, tb + T_U, ws + WS_U, K_F32, 512, 0, M, 512); save(&dc, stream, tb + T_PR, ws + WS_PR, K_F32, 2048, 0, M, RP); }
        if (lp == LP_SCAN) { save(&dc, stream, tb + T_OA, ws + WS_CAT, K_BF16, D, 0, M, 1024); save(&dc, stream, tb + T_ZP, ws + WS_CAT, K_BF16, D, 1024, M, 512); }
        if (lp == LP_SCAN) {
            for (int i = 0; i < 7; ++i) save(&dc, stream, tb + T_R + i, ws + WS_RW + (size_t)i * RW_STRIDE, K_F32, 512, 0, M, 512);
            if (l == 1) { save(&dc, stream, 59, ws + WS_RW + (size_t)RW_Y * RW_STRIDE, K_F32, 512, 0, M, 512); save(&dc, stream, 60, ws + WS_H, K_F32, 32, 0, M, 32); } }
        if (lp == LP_SCAN) save(&dc, stream, tb + T_GT, ws + WS_GT, K_BF16, 6144, 0, M, 6144);
        if (lp == LP_SCAN) save(&dc, stream, tb + T_Y, ws + WS_RW + (size_t)RW_Y * RW_STRIDE, K_F32, 512, 0, M, 512);
        if (lp == LP_POST) save(&dc, stream, tb + T_YR, ws + WS_CAT, K_BF16, D, 1536, M, 512);
        if (lp == LP_MG) save(&dc, stream, tb + T_MG, ws + WS_MG, K_BF16, D, 0, M, D);
        if (lp == LP_NORM2) { save(&dc, stream, tb + T_X1, ws + WS_X, K_F32, D, 0, M, D); save(&dc, stream, tb + T_H2, ws + WS_H, K_BF16, D, 0, M, D); }
        if (lp == LP_GU) save(&dc, stream, tb + T_ACT, ws + WS_GT, K_BF16, DFF, 0, M, DFF);
        if ((lp == LP_NORM1 && l > 0) || ph == PH_FINAL) save(&dc, stream, T_L0 + (ph == PH_FINAL ? 1 : l - 1) * T_PER_L + T_X2, ws + WS_X, K_F32, D, 0, M, D);
    }
    const size_t ooff[13] = {O_YP, O_YS, O_KP, O_VP, O_PP, O_SP, O_WP, O_KS, O_VS, O_PS, O_SS, O_WS, O_END}; const int ocol[12] = {2048, 2048, 256, 256, 512, 1984, 64, 256, 256, 512, 1984, 64};
    for (int i = 0; i < 12; ++i) dbg::save(&dc, stream, dbg::T_OUT0 + i, (float*)d_out + ooff[i], dbg::K_F32, ocol[i], 0, (int)((ooff[i + 1] - ooff[i]) / ocol[i]), ocol[i]);
    nv::In in; for (int i = 0; i < 39; ++i) in.p[i] = (const float*)d_in[i];
    nv::forward(in, (float*)d_out, (float*)d_ws, stream, &dc);
    for (int i = 0; i < 12; ++i) dbg::cmp(&dc, stream, dbg::T_OUT0 + i, (float*)d_out + ooff[i], ocol[i], 0, (int)((ooff[i + 1] - ooff[i]) / ocol[i]), ocol[i]);
#ifndef DBG_WANT_ID
#define DBG_WANT_ID -1
#endif
    dbg::inject<<<1, 1, 0, stream>>>(dc.err, (float*)d_out, (float*)d_out + O_YS, DBG_WANT_ID >= 0 ? dbg::NIDS : dbg::T_N, DBG_WANT_ID);
#else
    a.ph_lo = 0; a.ph_hi = N_PHASES;
    void* kargs[] = {&a};
    const hipError_t e = hipLaunchCooperativeKernel((const void*)mega, dim3(grid), dim3(NTHR), kargs, LDS_BYTES, stream);
    if (e != hipSuccess) fprintf(stderr, "kernel_launch: cooperative launch failed: %s (grid %d)\n", hipGetErrorString(e), grid);
#endif
}
```

```cpp
#define MK_DEBUG 0
#include <hip/hip_runtime.h>
#include <hip/hip_cooperative_groups.h>
#include <cstdio>
#include <cstdint>
namespace dbg {
constexpr int NPROBE = 16384, NSPECIAL = 2048, NIDS = 64;
struct Ctx { float* probes; float* err; int on; };
__device__ __forceinline__ unsigned hash32(unsigned x) { x ^= x >> 16; x *= 0x7feb352dU; x ^= x >> 15; x *= 0x846ca68bU; x ^= x >> 16; return x; }
__device__ __forceinline__ void probe_rc(int id, int k, int R, int C, int& r, int& c) {
    const unsigned h1 = hash32((unsigned)(id * 1000003 + k * 2 + 1)), h2 = hash32((unsigned)(id * 7919 + k * 2 + 77777));
    c = (int)(h2 % (unsigned)C);
    if (R == 8320 && k < NSPECIAL) { const int sp[16] = {0, 1, 15, 16, 127, 128, 129, 4095, 4096, 4097, 8190, 8191, 8192, 8193, 8255, 8319}; r = sp[k >> 7]; }
    else r = (int)(h1 % (unsigned)R);
}
enum { K_F32 = 0, K_BF16 = 1, K_QPERM = 2 };
__device__ __forceinline__ float opt_read(const void* p, int kind, size_t ld, int coff, int r, int c) {
    if (kind == K_F32) return ((const float*)p)[(size_t)r * ld + coff + c];
    if (kind == K_QPERM) { const int h = c >> 6, d = c & 63, pp = 32 * ((d >> 4) & 1) + 8 * ((d >> 2) & 3) + 4 * (d >> 5) + (d & 3); c = h * 64 + pp; }
    const unsigned short b = ((const unsigned short*)p)[(size_t)r * ld + coff + c]; return __builtin_bit_cast(float, (unsigned)b << 16);
}
__global__ void probe_save(float* probes, int id, const void* p, int kind, size_t ld, int coff, int R, int C) {
    const int k = blockIdx.x * blockDim.x + threadIdx.x; if (k >= NPROBE) return; int r, c; probe_rc(id, k, R, C, r, c);
    probes[(size_t)id * NPROBE + k] = opt_read(p, kind, ld, coff, r, c);
}
__global__ void probe_cmp(const float* probes, float* err, int id, const float* gold, size_t ld, int coff, int R, int C, int sig) {
    const int k = blockIdx.x * blockDim.x + threadIdx.x; if (k >= NPROBE) return; int r, c; probe_rc(id, k, R, C, r, c);
    float g = gold[(size_t)r * ld + coff + c]; if (sig) g = 1.f / (1.f + expf(-g));
    float o = probes[(size_t)id * NPROBE + k]; float d = o - g; if (!(d == d) || fabsf(d) > 1e18f) d = 1e18f;
    const int sp = (R == 8320 && k < NSPECIAL) ? 0 : 2;
    atomicAdd(&err[id * 4 + sp], d * d); atomicAdd(&err[id * 4 + sp + 1], g * g);
}
__global__ void inject(const float* err, float* out, float* ys, int nids, int want_id) {
    if (threadIdx.x || blockIdx.x) return;
    int rid = 89, which = 0; float rel = 1e-3f;
    for (int id = 0; id < nids; ++id) {
        const float r_rand = sqrtf(err[id * 4 + 2] / fmaxf(err[id * 4 + 3], 1e-30f)), r_sp = err[id * 4 + 1] > 0.f ? sqrtf(err[id * 4 + 0] / fmaxf(err[id * 4 + 1], 1e-30f)) : 0.f;
        if (want_id >= 0) { if (id == want_id) { rid = id; which = 0; rel = r_rand; break; } continue; }
        if (r_rand > 0.05f) { rid = id; which = 0; rel = r_rand; break; } else if (r_sp > 0.10f) { rid = id; which = 1; rel = r_sp; break; } }
    const float c1 = (float)(10 + rid) * (which ? 1e5f : 1e3f); float f = (log10f(fmaxf(rel, 1e-3f)) + 3.f) * 0.25f; f = fminf(fmaxf(f, 0.f), 1.f);
    out[0] = c1; ys[0] = c1 * (0.2f + 0.6f * f);
}
inline void save(const Ctx* c, hipStream_t st, int id, const void* p, int kind, size_t ld, int coff, int R, int C) { if (c && c->on) probe_save<<<NPROBE / 256, 256, 0, st>>>(c->probes, id, p, kind, ld, coff, R, C); }
inline void cmp(const Ctx* c, hipStream_t st, int id, const float* gold, size_t ld, int coff, int R, int C, int sig = 0) { if (c && c->on) probe_cmp<<<NPROBE / 256, 256, 0, st>>>(c->probes, c->err, id, gold, ld, coff, R, C, sig); }
enum { T_MOD = 0, T_L0 = 1, T_PER_L = 23, T_OUT0 = T_L0 + 2 * T_PER_L, T_N = T_OUT0 + 12 };
enum { T_H1 = 0, T_Q, T_K, T_V, T_U, T_PR, T_GT, T_OA, T_ZP, T_R, T_W, T_KK, T_VV, T_A, T_B, T_G, T_Y, T_YR, T_MG, T_X1, T_H2, T_ACT, T_X2 };
}
namespace nv {
constexpr int D = 2048, SEQ = 4096, NB = 2, MP = NB * SEQ, NS = 128, M = MP + NS, NL = 2;
constexpr int INW = 10176, OQ = 0, OK_ = 1024, OV = 1280, OU = 1536, OPR = 2048, OGL = 4032;
constexpr int RP = 1984, DFF = 5632, NMOD = NB + NS;
constexpr int PASTLEN = 8192;

__device__ __forceinline__ float sigm(float x) { return 1.f / (1.f + expf(-x)); }
__device__ __forceinline__ float silu(float x) { return x / (1.f + expf(-x)); }
__device__ __forceinline__ int modrow(int m) { return m < MP ? m / SEQ : NB + (m - MP); }
__device__ __forceinline__ int posof(int m) { return m < MP ? m % SEQ : PASTLEN; }

__global__ void __launch_bounds__(256) gemm(const float* __restrict__ A, int lda, const float* __restrict__ B, int ldb, float* __restrict__ C, int ldc, int Mm, int N, int K) {
    __shared__ float As[16][68], Bs[16][68];
    const int tx = threadIdx.x & 15, ty = threadIdx.x >> 4, m0 = blockIdx.y * 64, n0 = blockIdx.x * 64;
    float acc[4][4];
#pragma unroll
    for (int i = 0; i < 4; ++i)
#pragma unroll
        for (int j = 0; j < 4; ++j) acc[i][j] = 0.f;
    for (int k0 = 0; k0 < K; k0 += 16) {
        for (int i = threadIdx.x; i < 1024; i += 256) { const int r = i >> 4, c = i & 15; As[c][r] = (m0 + r < Mm) ? A[(size_t)(m0 + r) * lda + k0 + c] : 0.f; }
        for (int i = threadIdx.x; i < 1024; i += 256) { const int r = i >> 6, c = i & 63; Bs[r][c] = (n0 + c < N) ? B[(size_t)(k0 + r) * ldb + n0 + c] : 0.f; }
        __syncthreads();
#pragma unroll
        for (int kk = 0; kk < 16; ++kk) {
            float a[4], b[4];
#pragma unroll
            for (int i = 0; i < 4; ++i) { a[i] = As[kk][ty * 4 + i]; b[i] = Bs[kk][tx * 4 + i]; }
#pragma unroll
            for (int i = 0; i < 4; ++i)
#pragma unroll
                for (int j = 0; j < 4; ++j) acc[i][j] += a[i] * b[j];
        }
        __syncthreads();
    }
#pragma unroll
    for (int i = 0; i < 4; ++i)
#pragma unroll
        for (int j = 0; j < 4; ++j) { const int m = m0 + ty * 4 + i, n = n0 + tx * 4 + j; if (m < Mm && n < N) C[(size_t)m * ldc + n] = acc[i][j]; }
}

__global__ void silu_c(const float* cp, const float* cs, float* out) {
    const int i = blockIdx.x * blockDim.x + threadIdx.x; if (i >= NMOD * D) return;
    const int r = i / D, k = i % D; const float c = r < NB ? cp[r * D + k] : cs[(r - NB) * D + k]; out[i] = silu(c);
}
__global__ void add_bias(float* mod, const float* b, int n, int N) { const int i = blockIdx.x * blockDim.x + threadIdx.x; if (i < n) mod[i] += b[i % N]; }

__global__ void __launch_bounds__(256) modnorm(const float* xa, const float* xb, const float* g, const float* mod, int sh_off, int sc_off, float* out, size_t out_split_off) {
    const int m = blockIdx.x; const float* x = m < MP ? xa + (size_t)m * D : xb + (size_t)(m - MP) * D;
    __shared__ float red[256]; float s = 0.f;
    for (int k = threadIdx.x; k < D; k += 256) { const float v = x[k]; s += v * v; }
    red[threadIdx.x] = s; __syncthreads();
    for (int o = 128; o > 0; o >>= 1) { if (threadIdx.x < o) red[threadIdx.x] += red[threadIdx.x + o]; __syncthreads(); }
    const float rs = rsqrtf(red[0] / D + 1e-6f); const int br = modrow(m);
    float* o = m < MP ? out + (size_t)m * D : out + out_split_off + (size_t)(m - MP) * D;
    for (int k = threadIdx.x; k < D; k += 256) { float v = x[k] * rs * g[k]; if (mod) v = v * (1.f + mod[(size_t)br * 6 * D + sc_off + k]) + mod[(size_t)br * 6 * D + sh_off + k]; o[k] = v; }
}

__global__ void rope(float* z) {
    const int i = blockIdx.x * blockDim.x + threadIdx.x; if (i >= M * 20 * 32) return;
    const int m = i / 640, hh = (i / 32) % 20, d = i % 32; const float pos = (float)posof(m);
    const float inv = powf(10000.f, -(float)d * 2.0f / 64.f), ang = pos * inv, c = cosf(ang), s = sinf(ang);
    float* p = z + (size_t)m * INW + hh * 64; const float x1 = p[d], x2 = p[d + 32]; p[d] = x1 * c - x2 * s; p[d + 32] = x2 * c + x1 * s;
}

__global__ void attn_prompt(const float* z, const float* sink, float* oattn) {
    const int i = blockIdx.x * blockDim.x + threadIdx.x; if (i >= MP * 16) return;
    const int m = i / 16, hq = i % 16, hk = hq / 4, t = m % SEQ; const float* q = z + (size_t)m * INW + OQ + hq * 64;
    const int lo = t - 128 < 0 ? 0 : t - 128; const float sk = sink[hq];
    float mx = sk;
    for (int kp = lo; kp <= t; ++kp) { const float* k = z + (size_t)(m - t + kp) * INW + OK_ + hk * 64; float s = 0.f; for (int d = 0; d < 64; ++d) s += q[d] * k[d]; s *= 0.125f; mx = fmaxf(mx, s); }
    float den = expf(sk - mx); float o[64];
#pragma unroll
    for (int d = 0; d < 64; ++d) o[d] = 0.f;
    for (int kp = lo; kp <= t; ++kp) { const float* k = z + (size_t)(m - t + kp) * INW + OK_ + hk * 64; const float* v = z + (size_t)(m - t + kp) * INW + OV + hk * 64; float s = 0.f; for (int d = 0; d < 64; ++d) s += q[d] * k[d]; s *= 0.125f;
        const float p = expf(s - mx); den += p;
#pragma unroll
        for (int d = 0; d < 64; ++d) o[d] += p * v[d]; }
#pragma unroll
    for (int d = 0; d < 64; ++d) oattn[(size_t)m * 1024 + hq * 64 + d] = o[d] / den;
}
__global__ void attn_sample(const float* z, const float* sink, const float* ck, const float* cv, float* oattn) {
    const int i = blockIdx.x * blockDim.x + threadIdx.x; if (i >= NS * 16) return;
    const int s_ = i / 16, hq = i % 16, hk = hq / 4, m = MP + s_; const float* q = z + (size_t)m * INW + OQ + hq * 64; const float sk = sink[hq];
    float mx = sk;
    for (int j = 0; j <= 128; ++j) { const float* k = j < 128 ? ck + ((size_t)(s_ * 128 + j) * 4 + hk) * 64 : z + (size_t)m * INW + OK_ + hk * 64; float s = 0.f; for (int d = 0; d < 64; ++d) s += q[d] * k[d]; s *= 0.125f; mx = fmaxf(mx, s); }
    float den = expf(sk - mx); float o[64];
#pragma unroll
    for (int d = 0; d < 64; ++d) o[d] = 0.f;
    for (int j = 0; j <= 128; ++j) { const float* k = j < 128 ? ck + ((size_t)(s_ * 128 + j) * 4 + hk) * 64 : z + (size_t)m * INW + OK_ + hk * 64;
        const float* v = j < 128 ? cv + ((size_t)(s_ * 128 + j) * 4 + hk) * 64 : z + (size_t)m * INW + OV + hk * 64; float s = 0.f; for (int d = 0; d < 64; ++d) s += q[d] * k[d]; s *= 0.125f;
        const float p = expf(s - mx); den += p;
#pragma unroll
        for (int d = 0; d < 64; ++d) o[d] += p * v[d]; }
#pragma unroll
    for (int d = 0; d < 64; ++d) oattn[(size_t)m * 1024 + hq * 64 + d] = o[d] / den;
}
__global__ void kv_out(const float* z, const float* ck, const float* cv, float* kp, float* vp, float* ks, float* vs) {
    const int i = blockIdx.x * blockDim.x + threadIdx.x;
    if (i < NB * 128 * 256) { const int b = i / (128 * 256), j = (i / 256) % 128, c = i % 256; const size_t m = (size_t)b * SEQ + SEQ - 128 + j; kp[i] = z[m * INW + OK_ + c]; vp[i] = z[m * INW + OV + c]; }
    if (i < NS * 128 * 256) { const int s_ = i / (128 * 256), j = (i / 256) % 128, c = i % 256;
        if (j < 127) { ks[i] = ck[i + 256]; vs[i] = cv[i + 256]; } else { ks[i] = z[(size_t)(MP + s_) * INW + OK_ + c]; vs[i] = z[(size_t)(MP + s_) * INW + OV + c]; } }
}
__global__ void pool_d(const float* z, const float* spool, float* dbuf) {
    const int i = blockIdx.x * blockDim.x + threadIdx.x; if (i >= M * 512) return;
    const int m = i / 512, c = i % 512, gi = c / 128, w = 2 << gi; float sum = 0.f; float cnt;
    if (m < MP) { const int t = m % SEQ; for (int j = 0; j < w; ++j) if (t - j >= 0) sum += z[(size_t)(m - j) * INW + OU + c]; cnt = (float)(t + 1 < w ? t + 1 : w); }
    else { const int s_ = m - MP; sum = z[(size_t)m * INW + OU + c]; for (int j = 1; j < w; ++j) sum += spool[((size_t)s_ * 15 + 15 - j) * 512 + c]; cnt = (float)w; }
    dbuf[i] = sum / cnt - z[(size_t)m * INW + OU + c];
}
__global__ void pool_z(const float* dbuf, const float* pw, const float* pscale, float* zpool) {
    const int i = blockIdx.x * blockDim.x + threadIdx.x; if (i >= M * 512) return;
    const int m = i / 512, c = i % 512, gi = c / 128, e = c % 128; float s = 0.f;
    for (int k = 0; k < 128; ++k) s += dbuf[(size_t)m * 512 + gi * 128 + k] * pw[(gi * 128 + k) * 128 + e];
    zpool[i] = s * pscale[c];
}
__global__ void pool_out(const float* z, const float* spool, float* pp, float* ps) {
    const int i = blockIdx.x * blockDim.x + threadIdx.x;
    if (i < NB * 15 * 512) { const int b = i / (15 * 512), j = (i / 512) % 15, c = i % 512; pp[i] = z[((size_t)b * SEQ + SEQ - 15 + j) * INW + OU + c]; }
    if (i < NS * 15 * 512) { const int s_ = i / (15 * 512), j = (i / 512) % 15, c = i % 512; ps[i] = j < 14 ? spool[i + 512] : z[(size_t)(MP + s_) * INW + OU + c]; }
}
__global__ void rwkv_xm(const float* z, const float* sshift, const float* mu, float* xm) {
    const int i = blockIdx.x * blockDim.x + threadIdx.x; if (i >= M * RP) return;
    const int m = i / RP, c = i % RP; const float p = z[(size_t)m * INW + OPR + c]; float pv;
    if (m < MP) pv = (m % SEQ) ? z[(size_t)(m - 1) * INW + OPR + c] : 0.f; else pv = sshift[(size_t)(m - MP) * RP + c];
    xm[i] = p + (pv - p) * mu[c];
}
__global__ void shift_out(const float* z, float* sp, float* ss) {
    const int i = blockIdx.x * blockDim.x + threadIdx.x;
    if (i < NB * RP) { const int b = i / RP, c = i % RP; sp[i] = z[((size_t)b * SEQ + SEQ - 1) * INW + OPR + c]; }
    if (i < NS * RP) { const int s_ = i / RP, c = i % RP; ss[i] = z[(size_t)(MP + s_) * INW + OPR + c]; }
}
__global__ void __launch_bounds__(64) rwkv_prep(const float* xm, const float* w0, const float* w2, const float* a0, const float* a2, const float* g2, const float* k_k, const float* k_a,
                                                 const float* T2, const float* vb, float* vfirst, int has_vres,
                                                 float* R, float* W, float* Kk, float* V, float* A, float* Bb, float* G) {
    const int m = blockIdx.x / 8, h = blockIdx.x % 8, c = h * 64 + threadIdx.x; const float* x = xm + (size_t)m * RP;
    float s = w0[c]; for (int k = 0; k < 96; ++k) s += tanhf(x[1536 + k]) * w2[k * 512 + c];
    const float z_ = -s; const float sp = z_ > 20.f ? z_ : log1pf(expf(z_)); const float wlog = -sp - 0.5f; const float decay = expf(-expf(wlog));
    float sa = a0[c]; for (int k = 0; k < 96; ++k) sa += x[1632 + k] * a2[k * 512 + c]; const float a = sigm(sa);
    float g = 0.f; for (int k = 0; k < 256; ++k) g += sigm(x[1728 + k]) * g2[k * 512 + c];
    float v = x[1024 + c];
    if (!has_vres) vfirst[(size_t)m * 512 + c] = v;
    else { const float acc = vb[c] + T2[(size_t)m * 512 + c]; v = v + (vfirst[(size_t)m * 512 + c] - v) * sigm(acc); }
    const float r = x[c], k = x[512 + c]; float kk = k * k_k[c];
    __shared__ float red[64]; red[threadIdx.x] = kk * kk; __syncthreads();
    for (int o = 32; o > 0; o >>= 1) { if (threadIdx.x < o) red[threadIdx.x] += red[threadIdx.x + o]; __syncthreads(); }
    kk = kk / fmaxf(sqrtf(red[0]), 1e-12f); const float k2 = k * (1.f + (a - 1.f) * k_a[c]);
    const size_t o = (size_t)m * 512 + c; R[o] = r; W[o] = decay; Kk[o] = k2; V[o] = v; A[o] = -kk; Bb[o] = kk * a; G[o] = g;
}
__global__ void __launch_bounds__(64) rwkv_scan(const float* R, const float* W, const float* Kk, const float* V, const float* A, const float* Bb, const float* S0, float* Sout, float* Y, int row0, int T) {
    const int seq = blockIdx.x / 8, h = blockIdx.x % 8, i = threadIdx.x; float S[64];
#pragma unroll
    for (int j = 0; j < 64; ++j) S[j] = S0 ? S0[(((size_t)seq * 8 + h) * 64 + i) * 64 + j] : 0.f;
    __shared__ float sr[16][64], sw[16][64], sk[16][64], sa[16][64], sb[16][64], sv[16][64];
    for (int t0 = 0; t0 < T; t0 += 16) { const int nt = T - t0 < 16 ? T - t0 : 16;
        __syncthreads();
        for (int tt = 0; tt < nt; ++tt) { const size_t o = ((size_t)row0 + (size_t)seq * T + t0 + tt) * 512 + h * 64 + i; sr[tt][i] = R[o]; sw[tt][i] = W[o]; sk[tt][i] = Kk[o]; sa[tt][i] = A[o]; sb[tt][i] = Bb[o]; sv[tt][i] = V[o]; }
        __syncthreads();
        for (int tt = 0; tt < nt; ++tt) { float dot = 0.f; const float v = sv[tt][i];
#pragma unroll
            for (int j = 0; j < 64; ++j) dot += S[j] * sa[tt][j];
            float y = 0.f;
#pragma unroll
            for (int j = 0; j < 64; ++j) { S[j] = S[j] * sw[tt][j] + dot * sb[tt][j] + v * sk[tt][j]; y += S[j] * sr[tt][j]; }
            Y[((size_t)row0 + (size_t)seq * T + t0 + tt) * 512 + h * 64 + i] = y; } }
#pragma unroll
    for (int j = 0; j < 64; ++j) Sout[(((size_t)seq * 8 + h) * 64 + i) * 64 + j] = S[j];
}
__global__ void __launch_bounds__(64) rwkv_post(const float* Y, const float* R, const float* Kk, const float* V, const float* G, const float* r_k, const float* lg, const float* lb, float* yout) {
    const int m = blockIdx.x / 8, h = blockIdx.x % 8, i = threadIdx.x, c = h * 64 + i; const size_t o = (size_t)m * 512 + c;
    __shared__ float red[64]; const float y = Y[o];
    red[i] = y; __syncthreads(); for (int s = 32; s > 0; s >>= 1) { if (i < s) red[i] += red[i + s]; __syncthreads(); } const float mu = red[0] / 64.f; __syncthreads();
    red[i] = (y - mu) * (y - mu); __syncthreads(); for (int s = 32; s > 0; s >>= 1) { if (i < s) red[i] += red[i + s]; __syncthreads(); } const float var = red[0] / 64.f; __syncthreads();
    red[i] = R[o] * Kk[o] * r_k[c]; __syncthreads(); for (int s = 32; s > 0; s >>= 1) { if (i < s) red[i] += red[i + s]; __syncthreads(); } const float bon = red[0];
    yout[o] = ((y - mu) * rsqrtf(var + 64e-5f) * lg[c] + lb[c] + bon * V[o]) * G[o];
}
__global__ void merge_acc(const float* z, const float* P, int goff, float* merged, int first) {
    const int i = blockIdx.x * blockDim.x + threadIdx.x; if (i >= M * D) return; const int m = i / D, n = i % D;
    const float v = sigm(z[(size_t)m * INW + OGL + goff + n]) * P[i]; merged[i] = first ? v : merged[i] + v;
}
__global__ void resid(const float* xa, const float* xb, const float* P, const float* mod, int gt_off, float* xout) {
    const int i = blockIdx.x * blockDim.x + threadIdx.x; if (i >= M * D) return; const int m = i / D, n = i % D;
    const float x = m < MP ? xa[i] : xb[(size_t)(m - MP) * D + n]; xout[i] = x + (1.f + mod[(size_t)modrow(m) * 6 * D + gt_off + n]) * P[i];
}
__global__ void swiglu(const float* gbuf, const float* ubuf, float* act, int n) { const int i = blockIdx.x * blockDim.x + threadIdx.x; if (i < n) act[i] = silu(gbuf[i]) * ubuf[i]; }

struct In { const float* p[39]; };
inline void G(hipStream_t st, const float* A, int lda, const float* B, int ldb, float* C, int ldc, int Mm, int N, int K) { gemm<<<dim3((N + 63) / 64, (Mm + 63) / 64), 256, 0, st>>>(A, lda, B, ldb, C, ldc, Mm, N, K); }
#define EW(n) ((int)(((size_t)(n) + 255) / 256)), 256, 0, st

struct WS { float *silc, *mod, *h, *z, *xm, *R, *W, *K, *V, *A, *B, *G, *Y, *vfirst, *dbuf, *cat_a, *cat_p, *cat_r, *P, *merged, *x1, *xres, *fg, *fu, *T1; };
inline size_t carve(float* base, WS& w) {
    size_t o = 0; auto take = [&](size_t n) { float* p = base + o; o += (n + 63) & ~(size_t)63; return p; };
    w.silc = take((size_t)NMOD * D); w.mod = take((size_t)NL * NMOD * 6 * D); w.T1 = take((size_t)M * 32);
    w.h = take((size_t)M * D); w.P = w.h;
    w.xm = take((size_t)M * D); w.x1 = w.xm;
    w.cat_a = take((size_t)M * 1024); w.cat_p = take((size_t)M * 512); w.cat_r = take((size_t)M * 512); w.xres = take((size_t)M * D);
    w.z = take((size_t)M * INW);
    w.R = take((size_t)M * 512); w.W = take((size_t)M * 512); w.K = take((size_t)M * 512); w.V = take((size_t)M * 512); w.A = take((size_t)M * 512); w.B = take((size_t)M * 512); w.G = take((size_t)M * 512);
    w.Y = take((size_t)M * 512); w.vfirst = take((size_t)M * 512); w.dbuf = take((size_t)M * 512);
    w.merged = w.R;
    w.fg = w.z; w.fu = w.z + (size_t)M * DFF;
    return o;
}
constexpr size_t O_YP = 0, O_YS = O_YP + (size_t)MP * D, O_KP = O_YS + (size_t)NS * D, O_VP = O_KP + (size_t)NL * NB * 128 * 256, O_PP = O_VP + (size_t)NL * NB * 128 * 256,
                 O_SP = O_PP + (size_t)NL * NB * 15 * 512, O_WP = O_SP + (size_t)NL * NB * RP, O_KS = O_WP + (size_t)NL * NB * 8 * 4096, O_VS = O_KS + (size_t)NL * NS * 128 * 256,
                 O_PS = O_VS + (size_t)NL * NS * 128 * 256, O_SS = O_PS + (size_t)NL * NS * 15 * 512, O_WS = O_SS + (size_t)NL * NS * RP, O_END = O_WS + (size_t)NL * NS * 8 * 4096;

inline void forward(const In& in, float* out, float* wsf, hipStream_t st, const dbg::Ctx* dc = nullptr) {
    using namespace dbg;
    WS w; carve(wsf, w);
    const float *xp = in.p[0], *xs = in.p[1];
    silu_c<<<EW(NMOD * D)>>>(in.p[2], in.p[3], w.silc);
    for (int l = 0; l < NL; ++l) { G(st, w.silc, D, in.p[9] + (size_t)l * D * 6 * D, 6 * D, w.mod + (size_t)l * NMOD * 6 * D, 6 * D, NMOD, 6 * D, D);
        add_bias<<<EW(NMOD * 6 * D)>>>(w.mod + (size_t)l * NMOD * 6 * D, in.p[10] + (size_t)l * 6 * D, NMOD * 6 * D, 6 * D); }
    cmp(dc, st, T_MOD, w.mod, 6 * D, 0, NL * NMOD, 6 * D);
    const float* xa = xp; const float* xb = xs;
    for (int l = 0; l < NL; ++l) {
        const float* mod = w.mod + (size_t)l * NMOD * 6 * D; const int tb = T_L0 + l * T_PER_L;
        modnorm<<<M, 256, 0, st>>>(xa, xb, in.p[11] + l * D, mod, 0, D, w.h, (size_t)MP * D);
        cmp(dc, st, tb + T_H1, w.h, D, 0, M, D);
        G(st, w.h, D, in.p[13] + (size_t)l * D * INW, INW, w.z, INW, M, INW, D);
        rope<<<EW(M * 640)>>>(w.z);
        cmp(dc, st, tb + T_Q, w.z, INW, OQ, M, 1024); cmp(dc, st, tb + T_K, w.z, INW, OK_, M, 256); cmp(dc, st, tb + T_V, w.z, INW, OV, M, 256); cmp(dc, st, tb + T_U, w.z, INW, OU, M, 512);
        cmp(dc, st, tb + T_PR, w.z, INW, OPR, M, RP); cmp(dc, st, tb + T_GT, w.z, INW, OGL, M, 6144, 1);
        const float* ck = in.p[4] + (size_t)l * NS * 128 * 256; const float* cv = in.p[5] + (size_t)l * NS * 128 * 256;
        attn_prompt<<<(MP * 16 + 63) / 64, 64, 0, st>>>(w.z, in.p[14] + l * 16, w.cat_a);
        attn_sample<<<(NS * 16 + 63) / 64, 64, 0, st>>>(w.z, in.p[14] + l * 16, ck, cv, w.cat_a);
        kv_out<<<EW(NS * 128 * 256)>>>(w.z, ck, cv, out + O_KP + (size_t)l * NB * 128 * 256, out + O_VP + (size_t)l * NB * 128 * 256, out + O_KS + (size_t)l * NS * 128 * 256, out + O_VS + (size_t)l * NS * 128 * 256);
        const float* sp = in.p[6] + (size_t)l * NS * 15 * 512;
        pool_d<<<EW(M * 512)>>>(w.z, sp, w.dbuf);
        pool_z<<<EW(M * 512)>>>(w.dbuf, in.p[16] + (size_t)l * 4 * 128 * 128, in.p[17] + l * 512, w.cat_p);
        pool_out<<<EW(NS * 15 * 512)>>>(w.z, sp, out + O_PP + (size_t)l * NB * 15 * 512, out + O_PS + (size_t)l * NS * 15 * 512);
        rwkv_xm<<<EW((size_t)M * RP)>>>(w.z, in.p[7] + (size_t)l * NS * RP, in.p[19] + l * RP, w.xm);
        shift_out<<<EW(NS * RP)>>>(w.z, out + O_SP + (size_t)l * NB * RP, out + O_SS + (size_t)l * NS * RP);
        if (l > 0) { G(st, w.xm + 1024, RP, in.p[31], 32, w.T1, 32, M, 32, 512); G(st, w.T1, 32, in.p[32], 512, w.dbuf, 512, M, 512, 32); }
        if (l > 0) { cmp(dc, st, 59, w.dbuf, 512, 0, M, 512); cmp(dc, st, 60, w.T1, 32, 0, M, 32); }
        rwkv_prep<<<M * 8, 64, 0, st>>>(w.xm, in.p[20] + l * 512, in.p[21] + (size_t)l * 96 * 512, in.p[22] + l * 512, in.p[23] + (size_t)l * 96 * 512, in.p[24] + (size_t)l * 256 * 512, in.p[25] + l * 512, in.p[26] + l * 512,
                                         w.dbuf, in.p[33], w.vfirst, l > 0, w.R, w.W, w.K, w.V, w.A, w.B, w.G);
        cmp(dc, st, tb + T_OA, w.cat_a, 1024, 0, M, 1024); cmp(dc, st, tb + T_ZP, w.cat_p, 512, 0, M, 512);
        cmp(dc, st, tb + T_R, w.R, 512, 0, M, 512); cmp(dc, st, tb + T_W, w.W, 512, 0, M, 512); cmp(dc, st, tb + T_KK, w.K, 512, 0, M, 512); cmp(dc, st, tb + T_VV, w.V, 512, 0, M, 512);
        cmp(dc, st, tb + T_A, w.A, 512, 0, M, 512); cmp(dc, st, tb + T_B, w.B, 512, 0, M, 512); cmp(dc, st, tb + T_G, w.G, 512, 0, M, 512);
        rwkv_scan<<<NB * 8, 64, 0, st>>>(w.R, w.W, w.K, w.V, w.A, w.B, nullptr, out + O_WP + (size_t)l * NB * 8 * 4096, w.Y, 0, SEQ);
        rwkv_scan<<<NS * 8, 64, 0, st>>>(w.R, w.W, w.K, w.V, w.A, w.B, in.p[8] + (size_t)l * NS * 8 * 4096, out + O_WS + (size_t)l * NS * 8 * 4096, w.Y, MP, 1);
        cmp(dc, st, tb + T_Y, w.Y, 512, 0, M, 512);
        rwkv_post<<<M * 8, 64, 0, st>>>(w.Y, w.R, w.K, w.V, w.G, in.p[27] + l * 512, in.p[28] + l * 512, in.p[29] + l * 512, w.cat_r);
        cmp(dc, st, tb + T_YR, w.cat_r, 512, 0, M, 512);
        G(st, w.cat_a, 1024, in.p[15] + (size_t)l * 1024 * D, D, w.P, D, M, D, 1024); merge_acc<<<EW((size_t)M * D)>>>(w.z, w.P, 0, w.merged, 1);
        G(st, w.cat_p, 512, in.p[18] + (size_t)l * 512 * D, D, w.P, D, M, D, 512);   merge_acc<<<EW((size_t)M * D)>>>(w.z, w.P, D, w.merged, 0);
        G(st, w.cat_r, 512, in.p[30] + (size_t)l * 512 * D, D, w.P, D, M, D, 512);   merge_acc<<<EW((size_t)M * D)>>>(w.z, w.P, 2 * D, w.merged, 0);
        cmp(dc, st, tb + T_MG, w.merged, D, 0, M, D);
        G(st, w.merged, D, in.p[34] + (size_t)l * D * D, D, w.P, D, M, D, D);
        resid<<<EW((size_t)M * D)>>>(xa, xb, w.P, mod, 2 * D, w.x1);
        cmp(dc, st, tb + T_X1, w.x1, D, 0, M, D);
        modnorm<<<M, 256, 0, st>>>(w.x1, w.x1 + (size_t)MP * D, in.p[12] + l * D, mod, 3 * D, 4 * D, w.h, (size_t)MP * D);
        cmp(dc, st, tb + T_H2, w.h, D, 0, M, D);
        G(st, w.h, D, in.p[35] + (size_t)l * D * DFF, DFF, w.fg, DFF, M, DFF, D);
        G(st, w.h, D, in.p[36] + (size_t)l * D * DFF, DFF, w.fu, DFF, M, DFF, D);
        swiglu<<<EW((size_t)M * DFF)>>>(w.fg, w.fu, w.fg, M * DFF);
        cmp(dc, st, tb + T_ACT, w.fg, DFF, 0, M, DFF);
        G(st, w.fg, DFF, in.p[37] + (size_t)l * DFF * D, D, w.P, D, M, D, DFF);
        resid<<<EW((size_t)M * D)>>>(w.x1, w.x1 + (size_t)MP * D, w.P, mod, 5 * D, w.xres);
        cmp(dc, st, tb + T_X2, w.xres, D, 0, M, D);
        xa = w.xres; xb = w.xres + (size_t)MP * D;
    }
    modnorm<<<M, 256, 0, st>>>(xa, xb, in.p[38], nullptr, 0, 0, out + O_YP, (size_t)MP * D);
}
#undef EW
}
namespace mk {
#define LAS __attribute__((address_space(3)))
#define GAS __attribute__((address_space(1)))
typedef unsigned short bf16;
typedef short bf16x8 __attribute__((ext_vector_type(8)));
typedef float f32x4 __attribute__((ext_vector_type(4)));
typedef float f32x2 __attribute__((ext_vector_type(2)));
typedef unsigned u32x4 __attribute__((ext_vector_type(4)));
typedef unsigned u32x2 __attribute__((ext_vector_type(2)));

constexpr int D = 2048, SEQ = 4096, NB = 2, MP = NB * SEQ, NS = 128, M = MP + NS, MPAD = 8448, NL = 2, NMOD = NB + NS;
constexpr int NIN = 10240, NGU = 11264, DFF = 5632, NADA = 6 * D, RP = 1984, PASTLEN = 8192;
constexpr int NWAVES = 8, NTHR = 512;

constexpr size_t al(size_t x) { return (x + 255) & ~(size_t)255; }
constexpr size_t WL_IN = 0, WL_CAT = WL_IN + al((size_t)NIN * D * 2), WL_O = WL_CAT + al((size_t)D * D * 2), WL_GU = WL_O + al((size_t)D * D * 2), WL_DN = WL_GU + al((size_t)NGU * D * 2),
                 WL_W2 = WL_DN + al((size_t)D * DFF * 2), WL_A2 = WL_W2 + al(512 * 96 * 2), WL_G2 = WL_A2 + al(512 * 96 * 2), WL_V1 = WL_G2 + al(512 * 256 * 2), WL_V2 = WL_V1 + al(32 * 512 * 2),
                 WL_PW = WL_V2 + al(512 * 32 * 2), WL_SIZE = WL_PW + al(4 * 128 * 128 * 2);
constexpr size_t WS_W = 0;
constexpr size_t WS_ROPE = WS_W + 2 * WL_SIZE;
constexpr size_t WS_SILC = WS_ROPE + al((size_t)4097 * 64 * 4);
constexpr size_t WS_MOD = WS_SILC + al((size_t)256 * D * 2);
constexpr size_t WS_X = WS_MOD + al((size_t)NL * NMOD * NADA * 4);
constexpr size_t WS_H = WS_X + al((size_t)MPAD * D * 4);
constexpr size_t WS_Q = WS_H + al((size_t)MPAD * D * 2);
constexpr size_t WS_K = WS_Q + al((size_t)MPAD * 1024 * 2);
constexpr size_t WS_V = WS_K + al((size_t)MPAD * 256 * 2);
constexpr size_t WS_U = WS_V + al((size_t)MPAD * 256 * 2);
constexpr size_t WS_PR = WS_U + al((size_t)MPAD * 512 * 4);
constexpr size_t WS_MG = WS_PR;
constexpr size_t WS_CAT = WS_PR + al((size_t)MPAD * D * 4);
constexpr size_t WS_RW = WS_CAT + al((size_t)MPAD * D * 2);
constexpr size_t RW_STRIDE = al((size_t)MPAD * 512 * 4);
constexpr size_t WS_GT = WS_RW + 9 * RW_STRIDE;
constexpr size_t WS_ADAW = WS_GT;
constexpr size_t WS_SLAB = WS_GT + al((size_t)MPAD * 6144 * 2);
constexpr size_t WS_SLABM = WS_SLAB + al((size_t)11 * NS * D * 4);
constexpr size_t WS_CTL = WS_SLABM + al((size_t)4 * NS * D * 4);
constexpr size_t WS_CTL_BYTES = 32768;
constexpr size_t WS_END = WS_CTL + WS_CTL_BYTES;
static_assert((size_t)2 * NADA * D * 2 <= (size_t)MPAD * 6144 * 2, "ada weights fit under the gates");

constexpr size_t O_YP = 0, O_YS = O_YP + (size_t)MP * D, O_KP = O_YS + (size_t)NS * D, O_VP = O_KP + (size_t)NL * NB * 128 * 256, O_PP = O_VP + (size_t)NL * NB * 128 * 256,
                 O_SP = O_PP + (size_t)NL * NB * 15 * 512, O_WP = O_SP + (size_t)NL * NB * RP, O_KS = O_WP + (size_t)NL * NB * 8 * 4096, O_VS = O_KS + (size_t)NL * NS * 128 * 256,
                 O_PS = O_VS + (size_t)NL * NS * 128 * 256, O_SS = O_PS + (size_t)NL * NS * 15 * 512, O_WS = O_SS + (size_t)NL * NS * RP, O_END = O_WS + (size_t)NL * NS * 8 * 4096;

__device__ __forceinline__ unsigned f2bf(float f) { unsigned u = __builtin_bit_cast(unsigned, f); return (u + 0x7fffu + ((u >> 16) & 1u)) >> 16; }
__device__ __forceinline__ unsigned pk2(float lo, float hi) { return f2bf(lo) | (f2bf(hi) << 16); }
__device__ __forceinline__ float bf2f(unsigned short b) { return __builtin_bit_cast(float, (unsigned)b << 16); }
__device__ __forceinline__ float bflo(unsigned w) { return __builtin_bit_cast(float, w << 16); }
__device__ __forceinline__ float bfhi(unsigned w) { return __builtin_bit_cast(float, w & 0xffff0000u); }
__device__ __forceinline__ float fsigm(float x) { return __builtin_amdgcn_rcpf(1.f + __expf(-x)); }
__device__ __forceinline__ float wave_sum(float v) {
#pragma unroll
    for (int o = 1; o < 64; o <<= 1) v += __shfl_xor(v, o);
    return v;
}
__device__ __forceinline__ int modrow(int m) { return m < MP ? (m >> 12) : NB + (m - MP); }
__device__ __forceinline__ int posidx(int m) { return m < MP ? (m & (SEQ - 1)) : 4096; }
__device__ __forceinline__ int pi_d(int p) { return 32 * ((p >> 2) & 1) + 16 * (p >> 5) + 4 * ((p >> 3) & 3) + (p & 3); }

struct Args { const float* in[39]; float* out; unsigned char* ws; int ph_lo, ph_hi; };

struct Frame {
    LAS unsigned char* lds;
    int tid, lane, wave, G, bid;
    float* out; unsigned char* ws;
};
template <int K> __device__ __forceinline__ const float* inp() { GAS const float* p; asm volatile("s_load_dwordx2 %0, %1, %2\n\ts_waitcnt lgkmcnt(0)" : "=s"(p) : "s"(__builtin_amdgcn_kernarg_segment_ptr()), "n"(K * 8) : "memory"); return (const float*)p; }
#define INP(k) inp<k>()
__device__ __forceinline__ unsigned char* wl(const Frame& F, int l, size_t off) { return F.ws + WS_W + (size_t)l * WL_SIZE + off; }
__device__ __forceinline__ float* rwbuf(const Frame& F, int i) { return (float*)(F.ws + WS_RW + (size_t)i * RW_STRIDE); }
enum { RW_R = 0, RW_W, RW_K, RW_V, RW_A, RW_B, RW_G, RW_Y, RW_VF };

struct TSrc { const float* w; long long d2; int ld; int mode; };
__device__ __forceinline__ const float* colsrc(const TSrc& s, int n) {
    if (s.mode == 0) return s.w + n;
    if (s.mode == 1) {
        if (n < 1280) { const int h = n >> 6, p = n & 63; return s.w + h * 64 + pi_d(p); }
        if (n < 4032) return s.w + n;
        if (n < 4096) return nullptr;
        return s.w + (n - 64);
    }
      { const int g8 = n >> 3, i = n & 7; return (const float*)((const char*)s.w + (i < 4 ? 0ll : s.d2)) + 4 * g8 + (i & 3); }
}
__device__ __forceinline__ void transpose_item(const TSrc& s, int K, bf16* WT, size_t ldt, int kcol0, LAS float* scr, int kb, int nb, int lane) {
    const int k0 = 64 * kb, n0 = 32 * nb, gq = lane & 7, kr = lane >> 3;
    const float* cp = colsrc(s, n0 + 4 * gq);
#pragma unroll
    for (int i = 0; i < 8; ++i) { const int kk = 8 * i + kr; const f32x4 v = cp ? *(const f32x4*)(cp + (size_t)(k0 + kk) * s.ld) : (f32x4){0.f, 0.f, 0.f, 0.f};
        LAS float* d = scr + kk * 33 + 4 * gq; d[0] = v.x; d[1] = v.y; d[2] = v.z; d[3] = v.w; }
    asm volatile("s_waitcnt lgkmcnt(0)" ::: "memory");
    const int c = lane & 7;
#pragma unroll
    for (int j = 0; j < 4; ++j) { const int n = (lane >> 3) + 8 * j; const LAS float* p = scr + (8 * c) * 33 + n;
        u32x4 o; o.x = pk2(p[0 * 33], p[1 * 33]); o.y = pk2(p[2 * 33], p[3 * 33]); o.z = pk2(p[4 * 33], p[5 * 33]); o.w = pk2(p[6 * 33], p[7 * 33]);
        *(u32x4*)(WT + (size_t)(n0 + n) * ldt + kcol0 + k0 + 8 * c) = o; }
    asm volatile("s_waitcnt lgkmcnt(0)" ::: "memory");
}
__device__ __forceinline__ void small_transpose(const float* src, int K, int N, bf16* dst, int ldt, int gt, int ngt) {
    for (int i = gt; i < N * K; i += ngt) { const int n = i / K, k = i - n * K; dst[(size_t)n * ldt + k] = (bf16)f2bf(src[(size_t)k * N + n]); }
}
__device__ __forceinline__ void p0_prologue(const Frame& F, int lmask, bool common, int wb, int nwb, int cls) {
    LAS float* scr = (LAS float*)(F.lds + F.wave * 16384);
    const int gw = wb * NWAVES + F.wave, NGW = nwb * NWAVES;
    constexpr int J_ADA = 32 * 384, J_IN = 32 * 320, J_CA = 16 * 64, J_CP = 8 * 64, J_CR = 8 * 64, J_O = 32 * 64, J_GU = 32 * 352, J_DN = 88 * 64;
    constexpr int PER_L = J_ADA + J_IN + J_CA + J_CP + J_CR + J_O + J_GU + J_DN;
    constexpr int TOT = NL * PER_L; const int nrk = cls == 0 ? TOT : cls == 1 ? (TOT / 32) * 27 + (TOT % 32 < 27 ? TOT % 32 : 27) : (TOT / 32) * 5 + (TOT % 32 > 27 ? TOT % 32 - 27 : 0);
    for (int rk = gw; rk < nrk; rk += NGW) {
        const int it = cls == 0 ? rk : cls == 1 ? (rk / 27) * 32 + rk % 27 : (rk / 5) * 32 + 27 + rk % 5;
        const int l = it / PER_L; int r = it - l * PER_L;
        if (r < J_ADA ? !common : !((lmask >> l) & 1)) continue;
        TSrc s; s.d2 = 0; s.mode = 0; bf16* WT; size_t ldt; int K, nn, kcol0 = 0;
        if (r < J_ADA) { s.w = INP(9) + (size_t)l * D * NADA; s.ld = NADA; WT = (bf16*)(F.ws + WS_ADAW) + (size_t)l * NADA * D; ldt = D; K = D; nn = 384; }
        else if ((r -= J_ADA) < J_IN) { s.w = INP(13) + (size_t)l * D * 10176; s.ld = 10176; s.mode = 1; WT = (bf16*)wl(F, l, WL_IN); ldt = D; K = D; nn = 320; }
        else if ((r -= J_IN) < J_CA) { s.w = INP(15) + (size_t)l * 1024 * D; s.ld = D; WT = (bf16*)wl(F, l, WL_CAT); ldt = D; K = 1024; nn = 64; }
        else if ((r -= J_CA) < J_CP) { s.w = INP(18) + (size_t)l * 512 * D; s.ld = D; WT = (bf16*)wl(F, l, WL_CAT); ldt = D; K = 512; nn = 64; kcol0 = 1024; }
        else if ((r -= J_CP) < J_CR) { s.w = INP(30) + (size_t)l * 512 * D; s.ld = D; WT = (bf16*)wl(F, l, WL_CAT); ldt = D; K = 512; nn = 64; kcol0 = 1536; }
        else if ((r -= J_CR) < J_O) { s.w = INP(34) + (size_t)l * D * D; s.ld = D; WT = (bf16*)wl(F, l, WL_O); ldt = D; K = D; nn = 64; }
        else if ((r -= J_O) < J_GU) { s.w = INP(35) + (size_t)l * D * DFF; s.d2 = (const char*)INP(36) - (const char*)INP(35); s.ld = DFF; s.mode = 2; WT = (bf16*)wl(F, l, WL_GU); ldt = D; K = D; nn = 352; }
        else { r -= J_GU; s.w = INP(37) + (size_t)l * DFF * D; s.ld = D; WT = (bf16*)wl(F, l, WL_DN); ldt = DFF; K = DFF; nn = 64; }
        (void)K;
        transpose_item(s, K, WT, ldt, kcol0, scr, r / nn, r % nn, F.lane);
    }
    const int gt = wb * NTHR + F.tid, ngt = nwb * NTHR;
    for (int l = 0; l < NL; ++l) { if (!((lmask >> l) & 1)) continue;
        small_transpose(INP(21) + (size_t)l * 96 * 512, 96, 512, (bf16*)wl(F, l, WL_W2), 96, gt, ngt);
        small_transpose(INP(23) + (size_t)l * 96 * 512, 96, 512, (bf16*)wl(F, l, WL_A2), 96, gt, ngt);
        small_transpose(INP(24) + (size_t)l * 256 * 512, 256, 512, (bf16*)wl(F, l, WL_G2), 256, gt, ngt);
        for (int g = 0; g < 4; ++g) small_transpose(INP(16) + ((size_t)l * 4 + g) * 128 * 128, 128, 128, (bf16*)wl(F, l, WL_PW) + g * 128 * 128, 128, gt, ngt);
    }
    if (lmask & 2) { small_transpose(INP(31), 512, 32, (bf16*)wl(F, 1, WL_V1), 512, gt, ngt);
        small_transpose(INP(32), 32, 512, (bf16*)wl(F, 1, WL_V2), 32, gt, ngt); }
    if (!common) return;
    if (wb == 0 && F.tid < 2) ((unsigned*)(F.ws + WS_CTL))[64 * F.tid] = 0u;
    for (int i = gt; i < 256 * D; i += ngt) { const int r = i >> 11, k = i & (D - 1); float v = 0.f;
        if (r < NMOD) { const float c = r < NB ? INP(2)[r * D + k] : INP(3)[(r - NB) * D + k]; v = c / (1.f + expf(-c)); }
        ((bf16*)(F.ws + WS_SILC))[i] = (bf16)f2bf(v); }
    for (int i = gt; i < 4097 * 32; i += ngt) { const int p = i >> 5, d = i & 31; const float pos = p < 4096 ? (float)p : (float)PASTLEN;
        const float inv = powf(10000.f, -(float)d * (2.0f / 64.f)), ang = pos * inv; float* t = (float*)(F.ws + WS_ROPE) + (size_t)p * 64; t[d] = cosf(ang); t[32 + d] = sinf(ang); }
}

__device__ __forceinline__ void norm_phase(const Frame& F, int l, int which  , int nslab  ) {
    const int gw = F.bid * NWAVES + F.wave, NGW = F.G * NWAVES;
    const float* g = which == 0 ? INP(11) + l * D : which == 1 ? INP(12) + l * D : INP(38); const float* xp0 = INP(0); const float* xp1 = INP(1);
    for (int m = gw; m < M; m += NGW) {
        const float* xr = (which == 0 && l == 0) ? (m < MP ? xp0 + (size_t)m * D : xp1 + (size_t)(m - MP) * D) : (const float*)(F.ws + WS_X) + (size_t)m * D;
        f32x4 v[8], gv[8], shv[8], scv[8]; float s = 0.f;
        const float* mod = (const float*)(F.ws + WS_MOD) + ((size_t)l * NMOD + modrow(m)) * NADA + (which == 0 ? 0 : 3 * D);
#pragma unroll
        for (int j = 0; j < 8; ++j) { v[j] = *(const f32x4*)(xr + j * 256 + F.lane * 4); gv[j] = *(const f32x4*)(g + j * 256 + F.lane * 4);
            if (which != 2) { shv[j] = *(const f32x4*)(mod + j * 256 + F.lane * 4); scv[j] = *(const f32x4*)(mod + D + j * 256 + F.lane * 4); } else { shv[j] = gv[j]; scv[j] = gv[j]; } }
        if (nslab && m >= MP) { const float* sl = (const float*)(F.ws + WS_SLAB) + (size_t)(m - MP) * D + F.lane * 4;
            for (int q = 0; q < nslab; ++q) {
#pragma unroll
                for (int j = 0; j < 8; ++j) v[j] += *(const f32x4*)(sl + (size_t)q * NS * D + j * 256); }
            float* xs = (float*)(F.ws + WS_X) + (size_t)m * D;
#pragma unroll
            for (int j = 0; j < 8; ++j) *(f32x4*)(xs + j * 256 + F.lane * 4) = v[j]; }
#pragma unroll
        for (int j = 0; j < 8; ++j) { s += (v[j].x * v[j].x + v[j].y * v[j].y) + (v[j].z * v[j].z + v[j].w * v[j].w); }
        const float rs = rsqrtf(wave_sum(s) * (1.f / D) + 1e-6f);
        if (which == 0 && l == 0 && m >= MP) { float* xs = (float*)(F.ws + WS_X) + (size_t)m * D;
#pragma unroll
            for (int j = 0; j < 8; ++j) *(f32x4*)(xs + j * 256 + F.lane * 4) = v[j]; }
        if (which == 2) { float* o = F.out + O_YP + (size_t)m * D;
#pragma unroll
            for (int j = 0; j < 8; ++j) *(f32x4*)(o + j * 256 + F.lane * 4) = v[j] * rs * gv[j]; }
        else { bf16* o = (bf16*)(F.ws + WS_H) + (size_t)m * D;
#pragma unroll
            for (int j = 0; j < 8; ++j) { const int c = j * 256 + F.lane * 4; const f32x4 y = v[j] * rs * gv[j] * (scv[j] + 1.f) + shv[j]; u32x2 w; w.x = pk2(y.x, y.y); w.y = pk2(y.z, y.w); *(u32x2*)(o + c) = w; } }
    }
}
}
#ifdef MK_TS_ID
#ifndef MK_TS_BLOCK
#define MK_TS_BLOCK 0
#endif
#define TSB2(id, ldsp) do { if ((id) == MK_TS_ID && blockIdx.x == MK_TS_BLOCK && threadIdx.x == 0) *(volatile __attribute__((address_space(3))) unsigned*)((ldsp) + 135168 - 64) -= (unsigned)__builtin_amdgcn_s_memrealtime(); } while (0)
#define TSE2(id, ldsp) do { if ((id) == MK_TS_ID && blockIdx.x == MK_TS_BLOCK && threadIdx.x == 0) *(volatile __attribute__((address_space(3))) unsigned*)((ldsp) + 135168 - 64) += (unsigned)__builtin_amdgcn_s_memrealtime(); } while (0)
#else
#define TSB2(id, ldsp) do {} while (0)
#define TSE2(id, ldsp) do {} while (0)
#endif
namespace mk {
constexpr int BM = 256, BK = 64, HALF = 128, HTB = HALF * BK * 2, STAGE_BYTES = 8 * HTB, NXCD = 8, WGM = 8;
__device__ __forceinline__ int lds_byte(int r, int c) { const int st = (r >> 4) * 2 + (c >> 5), rr = r & 15, cc = c & 31, ob = rr * 64 + cc * 2; return st * 1024 + (ob ^ (((ob >> 9) & 1) << 5)); }
__device__ __forceinline__ void stage_rc(int b, int& R, int& C) { const int st = b / 1024, sb = b % 1024, swz = sb ^ (((sb >> 9) & 1) << 5); R = (st >> 1) * 16 + swz / 64; C = (st & 1) * 32 + (swz % 64) / 2; }
__device__ __forceinline__ int perm32(int rho) { const int n = rho >> 4, i = rho & 15; return 8 * (i >> 2) + 4 * n + (i & 3); }

struct Unit { int pm, pn, seg; };
enum { G_ADA = 0, G_IN, G_MG, G_WO, G_GU, G_DN };
struct Gemm { const bf16* A; const bf16* Bt; int ld, M, N, K, mode, layer; };

struct Rect { int pm0, nM, pn0, nN; };
struct Sched {
    Rect ra, rb; int G, c, nseg, ksb;
    __device__ __forceinline__ void init(const Rect& a, const Rect& b, int G_, int c_, int nseg_, int ksb_ = 0) { ra = a; rb = b; G = G_; c = c_; nseg = nseg_; ksb = ksb_; }
    __device__ __forceinline__ bool next(int i, Unit& u) const {
        const int ti = i / nseg, seg = i - ti * nseg, nA = ra.nM * ra.nN, nB = rb.nM * rb.nN;
        const long L = (long)ti * G + c; if (L >= nA + nB) return false;
        const bool inA = L < nA; const int pm0 = inA ? ra.pm0 : rb.pm0, nM = inA ? ra.nM : rb.nM, pn0 = inA ? ra.pn0 : rb.pn0, nN = inA ? ra.nN : rb.nN, nwg = nM * nN;
        int wgid = inA ? (int)L : (int)L - nA; { const int q = nwg / NXCD, r = nwg % NXCD, xcd = wgid % NXCD, off = wgid / NXCD; wgid = (xcd < r ? xcd * (q + 1) : r * (q + 1) + (xcd - r) * q) + off; }
        const int nig = WGM * nN, gid = wgid / nig, fm = gid * WGM, gsz = (nM - fm) < WGM ? (nM - fm) : WGM;
        u.pm = pm0 + fm + ((wgid % nig) % gsz); u.pn = pn0 + (wgid % nig) / gsz; u.seg = seg;
        if (!inA && ksb > 0) { const int q = u.pn - pn0; u.seg = q / ksb; u.pn = pn0 + q % ksb; }
        return true;
    }
};

typedef __bf16 bf16x2_t __attribute__((ext_vector_type(2)));
__device__ __forceinline__ unsigned cvt_pk_bf16(float lo, float hi) { const f32x2 v = {lo, hi}; const bf16x2_t b = __builtin_convertvector(v, bf16x2_t); return __builtin_bit_cast(unsigned, b); }
__device__ __forceinline__ f32x4 sig4(f32x4 v) { f32x4 r; r.x = fsigm(v.x); r.y = fsigm(v.y); r.z = fsigm(v.z); r.w = fsigm(v.w); return r; }

__device__ __forceinline__ float gclamp(float g) { return fmaxf(g, 1e-18f); }
struct Epi {
    const Frame* F; int mode, layer;
    __device__ __forceinline__ void rescale(f32x4 (&acc)[2][2][4][2], const Unit& u, int sp, int wr, int wc, int fr, int fq) const {
        int row0 = u.pm * BM + wr * 64 + fr; asm volatile("" : "+v"(row0)); const int c0 = u.pn * BM + wc * 32 + 8 * fq; const bf16* gt = (const bf16*)(F->ws + WS_GT) + sp * D + c0;
#pragma unroll
        for (int ai = 0; ai < 2; ++ai)
#pragma unroll
            for (int m = 0; m < 4; ++m) { const int r = row0 + ai * HALF + m * 16; const int rr = r < M ? r : M - 1;
#pragma unroll
                for (int bj = 0; bj < 2; ++bj) { const u32x4 ga = *(const u32x4*)(gt + (size_t)rr * 6144 + bj * HALF), gb = *(const u32x4*)(gt + (size_t)rr * 6144 + D + bj * HALF);
                    f32x4& v0 = acc[ai][bj][m][0]; f32x4& v1 = acc[ai][bj][m][1];
                    v0.x *= gclamp(bflo(ga.x)) * __builtin_amdgcn_rcpf(gclamp(bflo(gb.x))); v0.y *= gclamp(bfhi(ga.x)) * __builtin_amdgcn_rcpf(gclamp(bfhi(gb.x)));
                    v0.z *= gclamp(bflo(ga.y)) * __builtin_amdgcn_rcpf(gclamp(bflo(gb.y))); v0.w *= gclamp(bfhi(ga.y)) * __builtin_amdgcn_rcpf(gclamp(bfhi(gb.y)));
                    v1.x *= gclamp(bflo(ga.z)) * __builtin_amdgcn_rcpf(gclamp(bflo(gb.z))); v1.y *= gclamp(bfhi(ga.z)) * __builtin_amdgcn_rcpf(gclamp(bfhi(gb.z)));
                    v1.z *= gclamp(bflo(ga.w)) * __builtin_amdgcn_rcpf(gclamp(bflo(gb.w))); v1.w *= gclamp(bfhi(ga.w)) * __builtin_amdgcn_rcpf(gclamp(bfhi(gb.w))); }
                if (m & 1) asm volatile("" ::: "memory"); }
    }
    __device__ __forceinline__ void operator()(const f32x4 (&acc)[2][2][4][2], const Unit& u, int wr, int wc, int fr, int fq) const {
        const Frame& Fr = *F; const int l = layer;
        int row0 = u.pm * BM + wr * 64 + fr; const int colb = u.pn * BM + wc * 32 + 8 * fq;
        asm volatile("" : "+v"(row0));
        unsigned char* ws = Fr.ws;
        if (mode == G_ADA) {
            const float* ab = INP(10);
#pragma unroll
            for (int ai = 0; ai < 2; ++ai)
#pragma unroll
                for (int m = 0; m < 4; ++m) { const int r = row0 + ai * HALF + m * 16; if (r < NMOD) {
#pragma unroll
                    for (int bj = 0; bj < 2; ++bj) { const int c = colb + bj * HALF, ll = c / NADA, j = c - ll * NADA; float* o = (float*)(ws + WS_MOD) + ((size_t)ll * NMOD + r) * NADA + j;
                        *(f32x4*)o = acc[ai][bj][m][0] + *(const f32x4*)(ab + c); *(f32x4*)(o + 4) = acc[ai][bj][m][1] + *(const f32x4*)(ab + c + 4); } } }
        } else if (mode == G_IN) {
            const int pn = u.pn;
            if (pn < 5) {
                const int wp = wc & 1; const float* rt = (const float*)(ws + WS_ROPE);
#pragma unroll
                for (int ai = 0; ai < 2; ++ai)
#pragma unroll
                    for (int m = 0; m < 4; ++m) { const int r = row0 + ai * HALF + m * 16; if (r < M) {
                        const float* tp = rt + (size_t)posidx(r) * 64 + 16 * wp + 4 * fq; const f32x4 cs = *(const f32x4*)tp, sn = *(const f32x4*)(tp + 32);
#pragma unroll
                        for (int bj = 0; bj < 2; ++bj) { const f32x4 x1 = acc[ai][bj][m][0], x2 = acc[ai][bj][m][1]; const f32x4 o1 = x1 * cs - x2 * sn, o2 = x2 * cs + x1 * sn;
                            u32x4 w; w.x = cvt_pk_bf16(o1.x, o1.y); w.y = cvt_pk_bf16(o1.z, o1.w); w.z = cvt_pk_bf16(o2.x, o2.y); w.w = cvt_pk_bf16(o2.z, o2.w);
                            const int hc = bj * HALF + wc * 32 + 8 * fq;
                            if (pn < 4) *(u32x4*)((bf16*)(ws + WS_Q) + (size_t)r * 1024 + pn * 256 + hc) = w;
                            else { *(u32x4*)((bf16*)(ws + WS_K) + (size_t)r * 256 + hc) = w;
                                const int hk = hc >> 6, d1 = 16 * wp + 4 * fq; float* ko = nullptr;
                                if (r < MP) { const int t = r & (SEQ - 1); if (t >= SEQ - 128) ko = Fr.out + O_KP + ((((size_t)l * NB + (r >> 12)) * 128 + (t - (SEQ - 128))) * 4 + hk) * 64; }
                                else ko = Fr.out + O_KS + ((((size_t)l * NS + (r - MP)) * 128 + 127) * 4 + hk) * 64;
                                if (ko) { *(f32x4*)(ko + d1) = o1; *(f32x4*)(ko + d1 + 32) = o2; } } } } }
            } else if (pn == 5) {
#pragma unroll
                for (int ai = 0; ai < 2; ++ai)
#pragma unroll
                    for (int m = 0; m < 4; ++m) { const int r = row0 + ai * HALF + m * 16; if (r < M) {
#pragma unroll
                        for (int bj = 0; bj < 2; ++bj) { const f32x4 v0 = acc[ai][bj][m][0], v1 = acc[ai][bj][m][1]; const int hc = bj * HALF + wc * 32 + 8 * fq;
                            u32x4 w; w.x = cvt_pk_bf16(v0.x, v0.y); w.y = cvt_pk_bf16(v0.z, v0.w); w.z = cvt_pk_bf16(v1.x, v1.y); w.w = cvt_pk_bf16(v1.z, v1.w);
                            *(u32x4*)((bf16*)(ws + WS_V) + (size_t)r * 256 + hc) = w;
                            float* vo = nullptr;
                            if (r < MP) { const int t = r & (SEQ - 1); if (t >= SEQ - 128) vo = Fr.out + O_VP + (((size_t)l * NB + (r >> 12)) * 128 + (t - (SEQ - 128))) * 256; }
                            else vo = Fr.out + O_VS + (((size_t)l * NS + (r - MP)) * 128 + 127) * 256;
                            if (vo) { *(f32x4*)(vo + hc) = v0; *(f32x4*)(vo + hc + 4) = v1; } } } }
            } else if (pn < 16) {
                float* base = pn < 8 ? (float*)(ws + WS_U) : (float*)(ws + WS_PR); const int ld = pn < 8 ? 512 : 2048, c0 = (pn < 8 ? (pn - 6) : (pn - 8)) * 256 + wc * 32 + 8 * fq;
#pragma unroll
                for (int ai = 0; ai < 2; ++ai)
#pragma unroll
                    for (int m = 0; m < 4; ++m) { const int r = row0 + ai * HALF + m * 16; if (r < M) {
#pragma unroll
                        for (int bj = 0; bj < 2; ++bj) { float* o = base + (size_t)r * ld + c0 + bj * HALF; *(f32x4*)o = acc[ai][bj][m][0]; *(f32x4*)(o + 4) = acc[ai][bj][m][1]; } } }
            } else {
                const int c0 = (pn - 16) * 256 + wc * 32 + 8 * fq;
#pragma unroll
                for (int ai = 0; ai < 2; ++ai)
#pragma unroll
                    for (int m = 0; m < 4; ++m) { const int r = row0 + ai * HALF + m * 16; if (r < M) {
#pragma unroll
                        for (int bj = 0; bj < 2; ++bj) { const f32x4 v0 = sig4(acc[ai][bj][m][0]), v1 = sig4(acc[ai][bj][m][1]);
                            u32x4 w; w.x = cvt_pk_bf16(v0.x, v0.y); w.y = cvt_pk_bf16(v0.z, v0.w); w.z = cvt_pk_bf16(v1.x, v1.y); w.w = cvt_pk_bf16(v1.z, v1.w);
                            *(u32x4*)((bf16*)(ws + WS_GT) + (size_t)r * 6144 + c0 + bj * HALF) = w; } } }
            }
        } else if (mode == G_MG && u.pm == MPAD / BM - 1) {
            const int c0 = u.pn * BM + wc * 32 + 8 * fq, br = u.seg < 2 ? 0 : u.seg - 1;
#pragma unroll
            for (int m = 0; m < 4; ++m) { const int r = row0 + m * 16; if (r < M) { float* so = (float*)(ws + WS_SLABM) + ((size_t)u.seg * NS + (r - MP)) * D;
#pragma unroll
                for (int bj = 0; bj < 2; ++bj) { const int c = c0 + bj * HALF; const u32x4 gw = *(const u32x4*)((const bf16*)(ws + WS_GT) + (size_t)r * 6144 + br * D + c);
                    f32x4 v0 = acc[0][bj][m][0], v1 = acc[0][bj][m][1];
                    v0.x *= gclamp(bflo(gw.x)); v0.y *= gclamp(bfhi(gw.x)); v0.z *= gclamp(bflo(gw.y)); v0.w *= gclamp(bfhi(gw.y)); v1.x *= gclamp(bflo(gw.z)); v1.y *= gclamp(bfhi(gw.z)); v1.z *= gclamp(bflo(gw.w)); v1.w *= gclamp(bfhi(gw.w));
                    *(f32x4*)(so + c) = v0; *(f32x4*)(so + c + 4) = v1; } } }
        } else if (mode == G_MG) {
            const int c0 = u.pn * BM + wc * 32 + 8 * fq;
#pragma unroll
            for (int ai = 0; ai < 2; ++ai)
#pragma unroll
                for (int m = 0; m < 4; ++m) { const int r = row0 + ai * HALF + m * 16; if (r < M) {
#pragma unroll
                    for (int bj = 0; bj < 2; ++bj) { const int c = c0 + bj * HALF; const u32x4 gw = *(const u32x4*)((const bf16*)(ws + WS_GT) + (size_t)r * 6144 + 2 * D + c);
                        f32x4 v0 = acc[ai][bj][m][0], v1 = acc[ai][bj][m][1];
                        v0.x *= gclamp(bflo(gw.x)); v0.y *= gclamp(bfhi(gw.x)); v0.z *= gclamp(bflo(gw.y)); v0.w *= gclamp(bfhi(gw.y)); v1.x *= gclamp(bflo(gw.z)); v1.y *= gclamp(bfhi(gw.z)); v1.z *= gclamp(bflo(gw.w)); v1.w *= gclamp(bfhi(gw.w));
                        u32x4 w; w.x = cvt_pk_bf16(v0.x, v0.y); w.y = cvt_pk_bf16(v0.z, v0.w); w.z = cvt_pk_bf16(v1.x, v1.y); w.w = cvt_pk_bf16(v1.z, v1.w); *(u32x4*)((bf16*)(ws + WS_MG) + (size_t)r * D + c) = w; } } }
        } else if (mode == G_WO || mode == G_DN) {
            const int c0 = u.pn * BM + wc * 32 + 8 * fq; const int goff = mode == G_WO ? 2 * D : 5 * D;
            if (u.pm == MPAD / BM - 1) {
#pragma unroll
                for (int m = 0; m < 4; ++m) { const int r = row0 + m * 16; if (r < M) {
                    const float* gp = (const float*)(ws + WS_MOD) + ((size_t)l * NMOD + modrow(r)) * NADA + goff; float* so = (float*)(ws + WS_SLAB) + ((size_t)u.seg * NS + (r - MP)) * D;
#pragma unroll
                    for (int bj = 0; bj < 2; ++bj) { const int c = c0 + bj * HALF; const f32x4 g0 = *(const f32x4*)(gp + c), g1 = *(const f32x4*)(gp + c + 4);
                        *(f32x4*)(so + c) = (g0 + 1.f) * acc[0][bj][m][0]; *(f32x4*)(so + c + 4) = (g1 + 1.f) * acc[0][bj][m][1]; } } }
            } else {
                const float* gp = (const float*)(ws + WS_MOD) + ((size_t)l * NMOD + (u.pm >> 4)) * NADA + goff + c0;
                const f32x4 ga0 = *(const f32x4*)gp + 1.f, ga1 = *(const f32x4*)(gp + 4) + 1.f, gb0 = *(const f32x4*)(gp + HALF) + 1.f, gb1 = *(const f32x4*)(gp + HALF + 4) + 1.f;
                const float* xbase = (mode == G_WO && l == 0) ? INP(0) : (const float*)(ws + WS_X); float* xob = (float*)(ws + WS_X);
#pragma unroll
                for (int am = 0; am < 8; am += 2) { f32x4 xv[2][4];
#pragma unroll
                    for (int q = 0; q < 2; ++q) { const int ai = (am + q) >> 2, m = (am + q) & 3; const float* xin = xbase + (size_t)(row0 + ai * HALF + m * 16) * D + c0;
                        xv[q][0] = *(const f32x4*)xin; xv[q][1] = *(const f32x4*)(xin + 4); xv[q][2] = *(const f32x4*)(xin + HALF); xv[q][3] = *(const f32x4*)(xin + HALF + 4); }
#pragma unroll
                    for (int q = 0; q < 2; ++q) { const int ai = (am + q) >> 2, m = (am + q) & 3; float* xo = xob + (size_t)(row0 + ai * HALF + m * 16) * D + c0;
                        *(f32x4*)xo = xv[q][0] + ga0 * acc[ai][0][m][0]; *(f32x4*)(xo + 4) = xv[q][1] + ga1 * acc[ai][0][m][1];
                        *(f32x4*)(xo + HALF) = xv[q][2] + gb0 * acc[ai][1][m][0]; *(f32x4*)(xo + HALF + 4) = xv[q][3] + gb1 * acc[ai][1][m][1]; }
                    asm volatile("" ::: "memory"); }
            }
        } else {
            const int c0 = u.pn * 128 + wc * 16 + 4 * fq;
#pragma unroll
            for (int ai = 0; ai < 2; ++ai)
#pragma unroll
                for (int m = 0; m < 4; ++m) { const int r = row0 + ai * HALF + m * 16; if (r < M) {
#pragma unroll
                    for (int bj = 0; bj < 2; ++bj) { const f32x4 g = acc[ai][bj][m][0], up = acc[ai][bj][m][1]; const f32x4 a = g * sig4(g) * up;
                        u32x2 w; w.x = cvt_pk_bf16(a.x, a.y); w.y = cvt_pk_bf16(a.z, a.w); *(u32x2*)((bf16*)(ws + WS_GT) + (size_t)r * DFF + c0 + bj * 64) = w; } } }
        }
    }
};

__device__ __forceinline__ void gemm_phase(LAS unsigned char* lds, const Gemm g, const Sched& S, const Epi& E, const int tid  ) {
    const int wid = __builtin_amdgcn_readfirstlane(tid >> 6), lane = tid & 63, wr = wid >> 2, wc = wid & 3, fr = lane & 15, fq = lane >> 4;
    unsigned voffA[2], voffB[2];
#pragma unroll
    for (int i = 0; i < 2; ++i) { int R, C; stage_rc(tid * 16 + i * 8192, R, C); const int Rb = (R & ~31) + perm32(R & 31);
        voffA[i] = (unsigned)(R * g.ld + C) * 2u; voffB[i] = (unsigned)(Rb * g.ld + C) * 2u; }
    constexpr unsigned kstep = BK * 2;
    const unsigned hstep = (unsigned)HALF * (unsigned)g.ld * 2u; const bool mgd = g.mode == G_MG; const int ntfull = g.K / BK;
    const bool ksd = g.mode == G_WO || g.mode == G_DN || g.mode == G_MG;
#define PG8_KS(u) (ksd && (u).pm == MPAD / BM - 1)
#define PG8_KA(u) (PG8_KS(u) ? (unsigned)(u).seg * 512u : 0u)
#define PG8_NT(u) (PG8_KS(u) ? 8 : ntfull)
#define PG8_TILE(p, u) (((unsigned)(p) * (unsigned)BM * (unsigned)g.ld + PG8_KA(u)) * 2u)
    const unsigned ldsw = (unsigned)wid * 1024u;
    const int aoff = lds_byte(wr * 64 + fr, fq * 8), boff = lds_byte(wc * 32 + fr, fq * 8);
#define PG8_SA(b, h) (((b) * 2 + (h)) * HTB)
#define PG8_SB(b, h) ((4 + (b) * 2 + (h)) * HTB)
#define PG8_STAGE(bufoff, gbase, soff, voff) do { _Pragma("unroll") for (int _i = 0; _i < 2; ++_i) \
        __builtin_amdgcn_global_load_lds((const unsigned*)((const char*)(gbase) + (size_t)((voff)[_i] + (unsigned)(soff))), (LAS unsigned*)(lds + (bufoff) + ldsw + _i * 8192), 16, 0, 0); } while (0)
#define PG8_STA(bufoff, soff) PG8_STAGE(bufoff, g.A, soff, voffA)
#define PG8_STB(bufoff, soff) PG8_STAGE(bufoff, g.Bt, soff, voffB)
#define PG8_LDA(dst, b, h) do { _Pragma("unroll") for (int m = 0; m < 4; ++m) _Pragma("unroll") for (int k = 0; k < 2; ++k) dst[m][k] = *(const LAS bf16x8*)(lds + PG8_SA(b, h) + aoff + m * 2048 + k * 1024); } while (0)
#define PG8_LDB(dst, b, h) do { _Pragma("unroll") for (int n = 0; n < 2; ++n) _Pragma("unroll") for (int k = 0; k < 2; ++k) dst[n][k] = *(const LAS bf16x8*)(lds + PG8_SB(b, h) + boff + n * 2048 + k * 1024); } while (0)
#define PG8_MMA(ai, bj, At, Bt) do { __builtin_amdgcn_s_setprio(1); _Pragma("unroll") for (int m = 0; m < 4; ++m) _Pragma("unroll") for (int n = 0; n < 2; ++n) _Pragma("unroll") for (int k = 0; k < 2; ++k) \
        acc[ai][bj][m][n] = __builtin_amdgcn_mfma_f32_16x16x32_bf16(Bt[n][k], At[m][k], acc[ai][bj][m][n], 0, 0, 0); __builtin_amdgcn_s_setprio(0); } while (0)
#define PG8_WAIT_V(n) asm volatile("s_waitcnt vmcnt(" #n ")" ::: "memory")
#define PG8_WAIT_L(n) asm volatile("s_waitcnt lgkmcnt(" #n ")" ::: "memory")
#define PG8_BAR __builtin_amdgcn_s_barrier()
#define PG8_SCHED __builtin_amdgcn_sched_barrier(0)
    Unit cur, nxt; int ui = 0;
    if (!S.next(0, cur)) return;
    f32x4 acc[2][2][4][2];
#pragma unroll
    for (int a = 0; a < 2; ++a)
#pragma unroll
        for (int b = 0; b < 2; ++b)
#pragma unroll
            for (int m = 0; m < 4; ++m)
#pragma unroll
                for (int n = 0; n < 2; ++n) acc[a][b][m][n] = (f32x4){0.f, 0.f, 0.f, 0.f};
    bf16x8 At[4][2], B0[2][2], B1[2][2];
    unsigned cA = PG8_TILE(cur.pm, cur), cB = PG8_TILE(cur.pn, cur);
    PG8_STB(PG8_SB(0, 0), cB); PG8_STB(PG8_SB(0, 1), cB + hstep); PG8_STA(PG8_SA(0, 0), cA); PG8_STA(PG8_SA(0, 1), cA + hstep);
    if (wr == 1) PG8_BAR;
    PG8_WAIT_V(2); PG8_BAR;
    PG8_STB(PG8_SB(1, 0), cB + kstep); PG8_STA(PG8_SA(1, 0), cA + kstep); PG8_STB(PG8_SB(1, 1), cB + hstep + kstep);
    PG8_WAIT_V(6); PG8_BAR;
    for (;;) {
        const bool has_next = S.next(ui + 1, nxt);
        const unsigned nA = has_next ? PG8_TILE(nxt.pm, nxt) : cA, nB = has_next ? PG8_TILE(nxt.pn, nxt) : cB;
        const int nt = PG8_NT(cur);
        TSB2(50 + 2 * g.mode, lds);
        for (int t = 0; t < nt; t += 2) {
            const bool last = (t == nt - 2);
            if (mgd && !PG8_KS(cur) && (t == 16 || t == 24)) E.rescale(acc, cur, t == 16 ? 0 : 1, wr, wc, fr, fq);
            const unsigned a1 = cA + (unsigned)(t + 1) * kstep;
            const unsigned a2 = last ? nA : cA + (unsigned)(t + 2) * kstep, b2 = last ? nB : cB + (unsigned)(t + 2) * kstep;
            const unsigned a3 = a2 + kstep, b3 = b2 + kstep;
            PG8_LDB(B0, 0, 0); PG8_LDB(B1, 0, 1); PG8_SCHED; PG8_LDA(At, 0, 0); PG8_STA(PG8_SA(1, 1), a1 + hstep);
            PG8_WAIT_V(8); PG8_WAIT_L(0); PG8_BAR; PG8_MMA(0, 0, At, B0); PG8_MMA(0, 1, At, B1); PG8_BAR; PG8_SCHED;
            PG8_LDA(At, 0, 1); PG8_STB(PG8_SB(0, 0), b2); PG8_STB(PG8_SB(0, 1), b2 + hstep); PG8_STA(PG8_SA(0, 0), a2);
            PG8_WAIT_V(8); PG8_WAIT_L(0); PG8_BAR; PG8_MMA(1, 0, At, B0); PG8_MMA(1, 1, At, B1); PG8_BAR; PG8_SCHED;
            PG8_LDB(B0, 1, 0); PG8_LDB(B1, 1, 1); PG8_SCHED; PG8_LDA(At, 1, 0); PG8_STA(PG8_SA(0, 1), a2 + hstep);
            PG8_WAIT_V(8); PG8_WAIT_L(0); PG8_BAR; PG8_MMA(0, 0, At, B0); PG8_MMA(0, 1, At, B1); PG8_BAR; PG8_SCHED;
            PG8_LDA(At, 1, 1); PG8_STB(PG8_SB(1, 0), b3); PG8_STB(PG8_SB(1, 1), b3 + hstep); PG8_STA(PG8_SA(1, 0), a3);
            PG8_WAIT_V(8); PG8_WAIT_L(0); PG8_BAR; PG8_MMA(1, 0, At, B0); PG8_MMA(1, 1, At, B1); PG8_BAR; PG8_SCHED;
        }
        if (wr == 0) PG8_BAR;
        TSE2(50 + 2 * g.mode, lds);
        TSB2(51 + 2 * g.mode, lds); E(acc, cur, wr, wc, fr, fq); TSE2(51 + 2 * g.mode, lds);
        if (!has_next) break;
#pragma unroll
        for (int a = 0; a < 2; ++a)
#pragma unroll
            for (int b = 0; b < 2; ++b)
#pragma unroll
                for (int m = 0; m < 4; ++m)
#pragma unroll
                    for (int n = 0; n < 2; ++n) acc[a][b][m][n] = (f32x4){0.f, 0.f, 0.f, 0.f};
        cur = nxt; cA = nA; cB = nB; ++ui;
        if (wr == 1) PG8_BAR;
    }
    PG8_WAIT_V(0);
    PG8_BAR;
#undef PG8_KS
#undef PG8_KA
#undef PG8_NT
#undef PG8_TILE
#undef PG8_STA
#undef PG8_STB
#undef PG8_SA
#undef PG8_SB
#undef PG8_STAGE
#undef PG8_LDA
#undef PG8_LDB
#undef PG8_MMA
#undef PG8_WAIT_V
#undef PG8_WAIT_L
#undef PG8_BAR
#undef PG8_SCHED
}
}
namespace mk {
#define MFMA16(a, b, c) __builtin_amdgcn_mfma_f32_16x16x32_bf16((a), (b), (c), 0, 0, 0)
__device__ __forceinline__ bf16x8 pack8(f32x4 a, f32x4 b) { u32x4 w; w.x = cvt_pk_bf16(a.x, a.y); w.y = cvt_pk_bf16(a.z, a.w); w.z = cvt_pk_bf16(b.x, b.y); w.w = cvt_pk_bf16(b.z, b.w); return __builtin_bit_cast(bf16x8, w); }
typedef short s16x4 __attribute__((ext_vector_type(4)));
__device__ __forceinline__ bf16x8 cat44(s16x4 a, s16x4 b) { return (bf16x8){a[0], a[1], a[2], a[3], b[0], b[1], b[2], b[3]}; }
constexpr float LOG2E = 1.4426950408889634f;

constexpr int AK_STRIDE = 144, AV_STRIDE = 560;
constexpr int A_KOFF = 0, A_VOFF = 256 * AK_STRIDE, A_BYTES = A_VOFF + 64 * AV_STRIDE;
__device__ __forceinline__ void attn_prompt_unit(const Frame& F, int l, int b, int blk, int hk) {
    LAS unsigned char* Ks = F.lds + A_KOFF; LAS unsigned char* Vt = F.lds + A_VOFF;
    const bf16* Kg = (const bf16*)(F.ws + WS_K); const bf16* Vg = (const bf16*)(F.ws + WS_V); const bf16* Qg = (const bf16*)(F.ws + WS_Q);
    const int kp0 = blk * 128 - 128;
#pragma unroll
    for (int ch = F.tid; ch < 2048; ch += NTHR) { const int i = ch >> 3, dc = ch & 7, kp = kp0 + i;
        u32x4 kv = (u32x4){0u, 0u, 0u, 0u}, vv = kv;
        if (kp >= 0) { const size_t m = (size_t)b * SEQ + kp; kv = *(const u32x4*)(Kg + m * 256 + hk * 64 + dc * 8); vv = *(const u32x4*)(Vg + m * 256 + hk * 64 + dc * 8); }
        *(LAS u32x4*)(Ks + i * AK_STRIDE + dc * 16) = kv;
        LAS unsigned short* vp = (LAS unsigned short*)(Vt + (dc * 8) * AV_STRIDE) + i;
        vp[0 * (AV_STRIDE / 2)] = (unsigned short)(vv.x & 0xffff); vp[1 * (AV_STRIDE / 2)] = (unsigned short)(vv.x >> 16); vp[2 * (AV_STRIDE / 2)] = (unsigned short)(vv.y & 0xffff); vp[3 * (AV_STRIDE / 2)] = (unsigned short)(vv.y >> 16);
        vp[4 * (AV_STRIDE / 2)] = (unsigned short)(vv.z & 0xffff); vp[5 * (AV_STRIDE / 2)] = (unsigned short)(vv.z >> 16); vp[6 * (AV_STRIDE / 2)] = (unsigned short)(vv.w & 0xffff); vp[7 * (AV_STRIDE / 2)] = (unsigned short)(vv.w >> 16); }
    for (int i = F.tid; i < 64 * 24; i += NTHR) { const int d = i / 24, c = i % 24; ((LAS unsigned short*)(Vt + d * AV_STRIDE))[256 + c] = 0; }
    const int g = F.lane >> 4, c16 = F.lane & 15;
    const float* sinkp = INP(14) + l * 16;
    bf16x8 q0n, q1n;
    { const int gi = F.wave * 4, hq = hk * 4 + (gi >> 3), qs = gi & 7; const size_t mq = (size_t)b * SEQ + blk * 128 + 16 * qs + c16;
      q0n = *(const bf16x8*)(Qg + mq * 1024 + hq * 64 + 8 * g); q1n = *(const bf16x8*)(Qg + mq * 1024 + hq * 64 + 32 + 8 * g); }
    __syncthreads();
#pragma unroll 1
    for (int it = 0; it < 4; ++it) {
        const int gi = F.wave * 4 + it, hq = hk * 4 + (gi >> 3), qs = gi & 7;
        const int tqr = 16 * qs + c16;
        const size_t mq = (size_t)b * SEQ + blk * 128 + tqr;
        const bf16x8 q0 = q0n, q1 = q1n;
        if (it < 3) { const int gn = gi + 1, hn = hk * 4 + (gn >> 3), qn_ = gn & 7; const size_t mn = (size_t)b * SEQ + blk * 128 + 16 * qn_ + c16;
            q0n = *(const bf16x8*)(Qg + mn * 1024 + hn * 64 + 8 * g); q1n = *(const bf16x8*)(Qg + mn * 1024 + hn * 64 + 32 + 8 * g); }
        f32x4 s[10];
#pragma unroll
        for (int j = 0; j < 9; ++j) { LAS const unsigned char* kr = Ks + (16 * (qs + j) + c16) * AK_STRIDE + 16 * g;
            const bf16x8 k0 = *(LAS const bf16x8*)kr, k1 = *(LAS const bf16x8*)(kr + 64);
            f32x4 a = (f32x4){0.f, 0.f, 0.f, 0.f}; a = MFMA16(k0, q0, a); a = MFMA16(k1, q1, a); s[j] = a; }
        const float sk2 = sinkp[hq] * LOG2E; float mx = sk2;
#pragma unroll
        for (int j = 0; j < 9; ++j)
#pragma unroll
            for (int r = 0; r < 4; ++r) { const int i = 16 * (qs + j) + 4 * g + r; const bool ok = (i >= tqr) && (i <= tqr + 128) && (kp0 + i >= 0);
                const float v = ok ? s[j][r] * (0.125f * LOG2E) : -1e30f; s[j][r] = v; mx = fmaxf(mx, v); }
        mx = fmaxf(mx, __shfl_xor(mx, 16)); mx = fmaxf(mx, __shfl_xor(mx, 32));
        float sum = 0.f;
#pragma unroll
        for (int j = 0; j < 9; ++j)
#pragma unroll
            for (int r = 0; r < 4; ++r) { const float p = __builtin_amdgcn_exp2f(s[j][r] - mx); s[j][r] = p; sum += p; }
        s[9] = (f32x4){0.f, 0.f, 0.f, 0.f};
        sum += __shfl_xor(sum, 16); sum += __shfl_xor(sum, 32);
        const float rl = 1.f / (sum + __builtin_amdgcn_exp2f(sk2 - mx));
        f32x4 o[4];
#pragma unroll
        for (int dt = 0; dt < 4; ++dt) o[dt] = (f32x4){0.f, 0.f, 0.f, 0.f};
#pragma unroll
        for (int kk = 0; kk < 5; ++kk) { const bf16x8 pf = pack8(s[2 * kk], s[2 * kk + 1]);
#pragma unroll
            for (int dt = 0; dt < 4; ++dt) { LAS const unsigned char* vr = Vt + (16 * dt + c16) * AV_STRIDE + (16 * (qs + 2 * kk) + 4 * g) * 2;
                const s16x4 v0 = *(LAS const s16x4*)vr, v1 = *(LAS const s16x4*)(vr + 32);
                o[dt] = MFMA16(cat44(v0, v1), pf, o[dt]); } }
        bf16* op = (bf16*)(F.ws + WS_CAT) + mq * D + hq * 64 + 4 * g;
#pragma unroll
        for (int dt = 0; dt < 4; ++dt) { const f32x4 v = o[dt] * rl; u32x2 w; w.x = cvt_pk_bf16(v.x, v.y); w.y = cvt_pk_bf16(v.z, v.w); *(u32x2*)(op + 16 * dt) = w; }
    }
    __syncthreads();
}

__device__ __forceinline__ void attn_sample_unit(const Frame& F, int l, int s_, int hf) {
    LAS float* qn = (LAS float*)F.lds;
    LAS float* kn = qn + 512;
    LAS float* vn = kn + 128;
    LAS float* sc = vn + 128;
    LAS float* rl = sc + 8 * 132;
    const int m = MP + s_; const float* sinkp = INP(14) + l * 16 + 8 * hf;
    const float* ck = INP(4) + ((size_t)l * NS + s_) * 128 * 256; const float* cv = INP(5) + ((size_t)l * NS + s_) * 128 * 256;
    { const int h = F.tid >> 6, p = F.tid & 63; qn[h * 64 + pi_d(p)] = bf2f(((const bf16*)(F.ws + WS_Q))[(size_t)m * 1024 + 512 * hf + F.tid]) * (0.125f * LOG2E); }
    if (F.tid < 128) { const int h = F.tid >> 6, p = F.tid & 63; kn[h * 64 + pi_d(p)] = bf2f(((const bf16*)(F.ws + WS_K))[(size_t)m * 256 + 128 * hf + F.tid]); vn[F.tid] = bf2f(((const bf16*)(F.ws + WS_V))[(size_t)m * 256 + 128 * hf + F.tid]); }
    { float* ko = F.out + O_KS + ((size_t)l * NS + s_) * 128 * 256; float* vo = F.out + O_VS + ((size_t)l * NS + s_) * 128 * 256; const int i0_ = 64 * hf * 64, i1_ = hf ? 127 * 64 : 64 * 64;
#pragma unroll 4
      for (int i = i0_ + F.tid; i < i1_; i += NTHR) { const f32x4 a = *(const f32x4*)(ck + 256 + 4 * i), b = *(const f32x4*)(cv + 256 + 4 * i); *(f32x4*)(ko + 4 * i) = a; *(f32x4*)(vo + 4 * i) = b; } }
    __syncthreads();
    for (int idx = F.tid; idx < 8 * 129; idx += NTHR) { const int hq = idx / 129, j = idx - hq * 129, hk = hq >> 2; float a = 0.f;
        if (j < 128) { const float* kr = ck + (size_t)j * 256 + (2 * hf + hk) * 64;
#pragma unroll
            for (int d = 0; d < 64; d += 4) { const f32x4 kv = *(const f32x4*)(kr + d); a += qn[hq * 64 + d] * kv.x + qn[hq * 64 + d + 1] * kv.y + qn[hq * 64 + d + 2] * kv.z + qn[hq * 64 + d + 3] * kv.w; } }
        else { for (int d = 0; d < 64; ++d) a += qn[hq * 64 + d] * kn[hk * 64 + d]; }
        sc[hq * 132 + j] = a; }
    __syncthreads();
    { const int hq = F.wave; const float sk2 = sinkp[hq] * LOG2E;
        float mx = sk2; for (int j = F.lane; j < 129; j += 64) mx = fmaxf(mx, sc[hq * 132 + j]);
#pragma unroll
        for (int o = 1; o < 64; o <<= 1) mx = fmaxf(mx, __shfl_xor(mx, o));
        float sum = 0.f; for (int j = F.lane; j < 129; j += 64) { const float p = __builtin_amdgcn_exp2f(sc[hq * 132 + j] - mx); sc[hq * 132 + j] = p; sum += p; }
        sum = wave_sum(sum); if (F.lane == 0) rl[hq] = 1.f / (sum + __builtin_amdgcn_exp2f(sk2 - mx)); }
    __syncthreads();
    { const int hq = F.tid >> 6, d = F.tid & 63, hk = hq >> 2; float a = 0.f; const float* vc = cv + (2 * hf + hk) * 64 + d;
#pragma unroll 16
        for (int j = 0; j < 128; ++j) a += sc[hq * 132 + j] * vc[(size_t)j * 256];
        a += sc[hq * 132 + 128] * vn[hk * 64 + d];
        ((bf16*)(F.ws + WS_CAT))[(size_t)m * D + 512 * hf + F.tid] = (bf16)f2bf(a * rl[hq]); }
    __syncthreads();
}

constexpr int PL_STRIDE = 272;
__device__ __forceinline__ void pool_unit(const Frame& F, int l, int rt, int gi) {
    LAS unsigned char* dT = F.lds; LAS unsigned char* Wt = F.lds + 128 * PL_STRIDE;
    const float* U = (const float*)(F.ws + WS_U); const int w = 2 << gi, m0 = rt * 128;
    { const bf16* pw = (const bf16*)wl(F, l, WL_PW) + (size_t)gi * 128 * 128;
      for (int ch = F.tid; ch < 2048; ch += NTHR) { const int e = ch >> 4, cc = ch & 15; *(LAS u32x4*)(Wt + e * PL_STRIDE + cc * 16) = *(const u32x4*)(pw + e * 128 + cc * 8); } }
    { const int c = F.tid & 127, strip = F.tid >> 7, col = gi * 128 + c;
      if (rt < 64) { const int t0 = (m0 & (SEQ - 1)) + 32 * strip; const float* up = U + (size_t)(m0 + 32 * strip) * 512 + col;
          float uv[47];
#pragma unroll
          for (int j = 0; j < 47; ++j) { const int t = t0 - 15 + j; uv[j] = t >= 0 ? up[(ptrdiff_t)(j - 15) * 512] : 0.f; }
          LAS unsigned short* dp = (LAS unsigned short*)(dT + (32 * strip) * PL_STRIDE) + c;
#define POOL_D(W) { float sum = 0.f; _Pragma("unroll") for (int j = 1; j < W; ++j) sum += uv[15 - j]; \
              _Pragma("unroll") for (int k = 0; k < 32; ++k) { const int t = t0 + k; sum += uv[15 + k]; const float cnt = (float)(t + 1 < W ? t + 1 : W); \
                  dp[k * (PL_STRIDE / 2)] = (unsigned short)f2bf(sum / cnt - uv[15 + k]); sum -= uv[15 + k - W + 1]; } }
          if (gi == 0) POOL_D(2) else if (gi == 1) POOL_D(4) else if (gi == 2) POOL_D(8) else POOL_D(16)
#undef POOL_D
      }
      else { const float* sp = INP(6) + (size_t)l * NS * 15 * 512;
#pragma unroll 4
          for (int k = 0; k < 32; ++k) { const int s_ = 32 * strip + k; const float uc = U[(size_t)(MP + s_) * 512 + col]; float hv[15];
#pragma unroll
              for (int j = 1; j < 16; ++j) hv[j - 1] = sp[((size_t)s_ * 15 + 15 - j) * 512 + col];
              float sum = uc;
#pragma unroll
              for (int j = 1; j < 16; ++j) sum += j < w ? hv[j - 1] : 0.f;
              ((LAS unsigned short*)(dT + s_ * PL_STRIDE))[c] = (unsigned short)f2bf(sum / (float)w - uc); } } }
    __syncthreads();
    const int g = F.lane >> 4, c16 = F.lane & 15;
    f32x4 acc[8];
#pragma unroll
    for (int et = 0; et < 8; ++et) acc[et] = (f32x4){0.f, 0.f, 0.f, 0.f};
#pragma unroll
    for (int ks = 0; ks < 4; ++ks) { const bf16x8 df = *(LAS const bf16x8*)(dT + (16 * F.wave + c16) * PL_STRIDE + (32 * ks + 8 * g) * 2);
#pragma unroll
        for (int et = 0; et < 8; ++et) { const bf16x8 wf = *(LAS const bf16x8*)(Wt + (16 * et + c16) * PL_STRIDE + (32 * ks + 8 * g) * 2); acc[et] = MFMA16(wf, df, acc[et]); } }
    const int m = m0 + 16 * F.wave + c16; const float* psc = INP(17) + l * 512 + gi * 128;
    if (m < M) { bf16* op = (bf16*)(F.ws + WS_CAT) + (size_t)m * D + 1024 + gi * 128 + 4 * g;
#pragma unroll
        for (int et = 0; et < 8; ++et) { const f32x4 v = acc[et] * *(const f32x4*)(psc + 16 * et + 4 * g); u32x2 wv; wv.x = cvt_pk_bf16(v.x, v.y); wv.y = cvt_pk_bf16(v.z, v.w); *(u32x2*)(op + 16 * et) = wv; } }
    __syncthreads();
}
__device__ __forceinline__ void state_outs(const Frame& F, int l) {
    const int gt = F.bid * NTHR + F.tid, ngt = F.G * NTHR; const float* U = (const float*)(F.ws + WS_U); const float* PR = (const float*)(F.ws + WS_PR);
    for (int i = gt; i < NB * 15 * 512; i += ngt) { const int b = i / (15 * 512), j = (i >> 9) % 15, c = i & 511; F.out[O_PP + (size_t)l * NB * 15 * 512 + i] = U[((size_t)b * SEQ + SEQ - 15 + j) * 512 + c]; }
    const float* sp = INP(6) + (size_t)l * NS * 15 * 512;
    for (int i = gt; i < NS * 15 * 512; i += ngt) { const int s_ = i / (15 * 512), j = (i >> 9) % 15, c = i & 511; F.out[O_PS + (size_t)l * NS * 15 * 512 + i] = j < 14 ? sp[i + 512] : U[(size_t)(MP + s_) * 512 + c]; }
    for (int i = gt; i < NB * RP; i += ngt) { const int b = i / RP, c = i - b * RP; F.out[O_SP + (size_t)l * NB * RP + i] = PR[((size_t)b * SEQ + SEQ - 1) * 2048 + c]; }
    for (int i = gt; i < NS * RP; i += ngt) { const int s_ = i / RP, c = i - s_ * RP; F.out[O_SS + (size_t)l * NS * RP + i] = PR[(size_t)(MP + s_) * 2048 + c]; }
}

template <int CTRL> __device__ __forceinline__ float dpp_f(float x) { return __builtin_bit_cast(float, __builtin_amdgcn_mov_dpp(__builtin_bit_cast(int, x), CTRL, 0xf, 0xf, true)); }
__device__ __forceinline__ float row16_sum(float x) {
    x += dpp_f<0xB1>(x); x += dpp_f<0x4E>(x); x += dpp_f<0x141>(x); x += dpp_f<0x128>(x); return x;
}
constexpr int RA_STRIDE = 1936;
constexpr int R_T1OFF = 32 * RA_STRIDE, RT_STRIDE = 80;
struct XmRow { const float* p; const float* pv; float pz; };
__device__ __forceinline__ XmRow xm_row(const float* PR, const float* sshift, int m) {
    XmRow r; r.p = PR + (size_t)m * 2048; const bool first = m < MP && (m & (SEQ - 1)) == 0;
    r.pv = m >= MP ? sshift + (size_t)(m - MP) * RP : first ? r.p : r.p - 2048; r.pz = first ? 0.f : 1.f; return r;
}
__device__ __forceinline__ float xm_at(const XmRow& r, const float* mu, int c) { const float p = r.p[c]; return p + (r.pv[c] * r.pz - p) * mu[c]; }
__device__ __forceinline__ f32x4 xm4_at(const XmRow& r, const float* mu, int c) { const f32x4 p = *(const f32x4*)(r.p + c); return p + (*(const f32x4*)(r.pv + c) * r.pz - p) * *(const f32x4*)(mu + c); }
template <int KS> __device__ __forceinline__ void lora_mm(f32x4 (&acc)[4], const bf16* Wt, int ldw, int nbase, LAS const unsigned char* Arow, int acol, int g, int c16) {
#pragma unroll
    for (int nt = 0; nt < 4; ++nt) acc[nt] = (f32x4){0.f, 0.f, 0.f, 0.f};
#pragma unroll
    for (int ks = 0; ks < KS; ++ks) { const bf16x8 af = *(LAS const bf16x8*)(Arow + (acol + 32 * ks + 8 * g) * 2);
#pragma unroll
        for (int nt = 0; nt < 4; ++nt) { const bf16x8 wf = *(const bf16x8*)(Wt + (size_t)(nbase + 16 * nt + c16) * ldw + 32 * ks + 8 * g); acc[nt] = MFMA16(wf, af, acc[nt]); } }
}
__device__ __forceinline__ float frcp(float x) { return __builtin_amdgcn_rcpf(x); }
__device__ __forceinline__ f32x4 fsig4(f32x4 v) { f32x4 r; r.x = frcp(1.f + __expf(-v.x)); r.y = frcp(1.f + __expf(-v.y)); r.z = frcp(1.f + __expf(-v.z)); r.w = frcp(1.f + __expf(-v.w)); return r; }
__device__ __forceinline__ void rwkv_prep_unit(const Frame& F, int l, int ti) {
    int tid_l = F.tid; asm volatile("" : "+v"(tid_l)); const int lane_l = tid_l & 63;
    LAS unsigned char* Aop = F.lds; LAS unsigned char* T1 = F.lds + R_T1OFF;
    const float* PR = (const float*)(F.ws + WS_PR); const float* sshift = INP(7) + (size_t)l * NS * RP; const float* mu = INP(19) + l * RP;
    const int m0 = ti * 32; const bool vres = l > 0;
    TSB2(70, F.lds);
#pragma unroll
    for (int q0 = 0; q0 < 8; q0 += 4) { f32x4 xv[4];
#pragma unroll
        for (int q = 0; q < 4; ++q) if (q0 + q < 7) { const int i = tid_l + (q0 + q) * NTHR, r = i / 112, c4 = i - r * 112; const XmRow xr = xm_row(PR, sshift, m0 + r); xv[q] = xm4_at(xr, mu, 1536 + 4 * c4); }
#pragma unroll
        for (int q = 0; q < 4; ++q) if (q0 + q < 7) { const int i = tid_l + (q0 + q) * NTHR, r = i / 112, c4 = i - r * 112, c = 4 * c4; f32x4 y = xv[q];
            if (c < 96) { y.x = 1.f - 2.f * frcp(1.f + __expf(2.f * y.x)); y.y = 1.f - 2.f * frcp(1.f + __expf(2.f * y.y)); y.z = 1.f - 2.f * frcp(1.f + __expf(2.f * y.z)); y.w = 1.f - 2.f * frcp(1.f + __expf(2.f * y.w)); }
            else if (c >= 192) y = fsig4(y);
            u32x2 w; w.x = cvt_pk_bf16(y.x, y.y); w.y = cvt_pk_bf16(y.z, y.w); *(LAS u32x2*)(Aop + r * RA_STRIDE + c * 2) = w; }
        asm volatile("" ::: "memory"); __builtin_amdgcn_sched_barrier(0); }
    if (vres) {
#pragma unroll
        for (int q0 = 0; q0 < 8; q0 += 4) { f32x4 xv[4];
#pragma unroll
            for (int q = 0; q < 4; ++q) { const int i = tid_l + (q0 + q) * NTHR, r = i >> 7, c4 = i & 127; const XmRow xr = xm_row(PR, sshift, m0 + r); xv[q] = xm4_at(xr, mu, 1024 + 4 * c4); }
#pragma unroll
            for (int q = 0; q < 4; ++q) { const int i = tid_l + (q0 + q) * NTHR, r = i >> 7, c4 = i & 127; u32x2 w; w.x = cvt_pk_bf16(xv[q].x, xv[q].y); w.y = cvt_pk_bf16(xv[q].z, xv[q].w); *(LAS u32x2*)(Aop + r * RA_STRIDE + (448 + 4 * c4) * 2) = w; }
            asm volatile("" ::: "memory"); __builtin_amdgcn_sched_barrier(0); } }
    __syncthreads();
    TSE2(70, F.lds); TSB2(71, F.lds);
    const int g = lane_l >> 4, c16 = lane_l & 15, nb = 64 * F.wave;
    if (vres) {
        if (F.wave < 4) { const int mt = F.wave >> 1, nt = F.wave & 1; f32x4 a = (f32x4){0.f, 0.f, 0.f, 0.f}; const bf16* w1 = (const bf16*)wl(F, 1, WL_V1) + (size_t)(16 * nt + c16) * 512 + 8 * g;
#pragma unroll
            for (int kh = 0; kh < 2; ++kh) { bf16x8 wf[8];
#pragma unroll
                for (int ks = 0; ks < 8; ++ks) wf[ks] = *(const bf16x8*)(w1 + 32 * (8 * kh + ks));
#pragma unroll
                for (int ks = 0; ks < 8; ++ks) { const bf16x8 af = *(LAS const bf16x8*)(Aop + (16 * mt + c16) * RA_STRIDE + (448 + 32 * (8 * kh + ks) + 8 * g) * 2); a = MFMA16(wf[ks], af, a); }
                asm volatile("" ::: "memory"); __builtin_amdgcn_sched_barrier(0); }
            u32x2 wv; wv.x = cvt_pk_bf16(a.x, a.y); wv.y = cvt_pk_bf16(a.z, a.w); *(LAS u32x2*)(T1 + (16 * mt + c16) * RT_STRIDE + (16 * nt + 4 * g) * 2) = wv;
#if MK_DEBUG
            *(f32x4*)((float*)(F.ws + WS_H) + (size_t)(m0 + 16 * mt + c16) * 32 + 16 * nt + 4 * g) = a;
#endif
            }
        __syncthreads();
    }
    LAS unsigned char* Aimg = F.lds + 65536; LAS unsigned char* Limg = F.lds + 65536 + 32768;
    size_t ro[2]; int mrow[2];
#pragma unroll
    for (int mt = 0; mt < 2; ++mt) { int m = m0 + 16 * mt + c16; asm volatile("" : "+v"(m)); mrow[mt] = m; ro[mt] = (size_t)m * 512 + nb + 4 * g; }
    TSE2(71, F.lds); TSB2(72, F.lds);
#define LORA_PASS(WT, LDW, ACOL, KS0, NKS, ACC) do { bf16x8 wq_[NKS][4]; const bf16* pw_ = (const bf16*)(WT) + (size_t)(nb + c16) * (LDW) + 8 * g + 32 * (KS0); \
        _Pragma("unroll") for (int ks = 0; ks < NKS; ++ks) _Pragma("unroll") for (int nt = 0; nt < 4; ++nt) wq_[ks][nt] = *(const bf16x8*)(pw_ + (size_t)16 * nt * (LDW) + 32 * ks); \
        _Pragma("unroll") for (int mt = 0; mt < 2; ++mt) { LAS const unsigned char* Arow_ = Aop + (16 * mt + c16) * RA_STRIDE + ((ACOL) + 32 * (KS0) + 8 * g) * 2; \
            _Pragma("unroll") for (int ks = 0; ks < NKS; ++ks) { const bf16x8 af_ = *(LAS const bf16x8*)(Arow_ + 64 * ks); \
                _Pragma("unroll") for (int nt = 0; nt < 4; ++nt) ACC[mt][nt] = MFMA16(wq_[ks][nt], af_, ACC[mt][nt]); } } \
        asm volatile("" ::: "memory"); __builtin_amdgcn_sched_barrier(0); } while (0)
#define LORA_ZERO(ACC) do { _Pragma("unroll") for (int mt = 0; mt < 2; ++mt) _Pragma("unroll") for (int nt = 0; nt < 4; ++nt) ACC[mt][nt] = (f32x4){0.f, 0.f, 0.f, 0.f}; } while (0)
    {
        const float* a0p = INP(22) + l * 512; f32x4 acc[2][4]; LORA_ZERO(acc); LORA_PASS(wl(F, l, WL_A2), 96, 96, 0, 2, acc); LORA_PASS(wl(F, l, WL_A2), 96, 96, 2, 1, acc);
#pragma unroll
        for (int mt = 0; mt < 2; ++mt)
#pragma unroll
            for (int nt = 0; nt < 4; ++nt) { const f32x4 a = fsig4(acc[mt][nt] + *(const f32x4*)(a0p + nb + 16 * nt + 4 * g)); u32x2 w; w.x = cvt_pk_bf16(a.x, a.y); w.y = cvt_pk_bf16(a.z, a.w);
                *(LAS u32x2*)(Aimg + ((16 * mt + c16) * 512 + nb + 16 * nt + 4 * g) * 2) = w; } }
    {
        const float* w0p = INP(20) + l * 512; float* Wb = rwbuf(F, RW_W); f32x4 acc[2][4]; LORA_ZERO(acc); LORA_PASS(wl(F, l, WL_W2), 96, 0, 0, 2, acc); LORA_PASS(wl(F, l, WL_W2), 96, 0, 2, 1, acc);
#pragma unroll
        for (int mt = 0; mt < 2; ++mt)
#pragma unroll
            for (int nt = 0; nt < 4; ++nt) { const f32x4 z = acc[mt][nt] + *(const f32x4*)(w0p + nb + 16 * nt + 4 * g); f32x4 dec;
#pragma unroll
                for (int e = 0; e < 4; ++e) { const float zz = -z[e]; const float sp = fmaxf(zz, 0.f) + __logf(1.f + __expf(-fabsf(zz))); dec[e] = __expf(-__expf(-sp - 0.5f)); }
                *(f32x4*)(Wb + ro[mt] + 16 * nt) = dec; } }
    {
        float* Gb = rwbuf(F, RW_G); f32x4 acc[2][4]; LORA_ZERO(acc); LORA_PASS(wl(F, l, WL_G2), 256, 192, 0, 2, acc); LORA_PASS(wl(F, l, WL_G2), 256, 192, 2, 2, acc); LORA_PASS(wl(F, l, WL_G2), 256, 192, 4, 2, acc); LORA_PASS(wl(F, l, WL_G2), 256, 192, 6, 2, acc);
#pragma unroll
        for (int mt = 0; mt < 2; ++mt)
#pragma unroll
            for (int nt = 0; nt < 4; ++nt) *(f32x4*)(Gb + ro[mt] + 16 * nt) = acc[mt][nt]; }
#undef LORA_PASS
#undef LORA_ZERO
    TSE2(72, F.lds); TSB2(73, F.lds);
    if (vres) {
#pragma unroll
        for (int mt = 0; mt < 2; ++mt) { const bf16x8 tf = *(LAS const bf16x8*)(T1 + (16 * mt + c16) * RT_STRIDE + (8 * g) * 2); const f32x4 z4 = (f32x4){0.f, 0.f, 0.f, 0.f};
#pragma unroll
            for (int nt = 0; nt < 4; ++nt) { const bf16x8 wf = *(const bf16x8*)((const bf16*)wl(F, 1, WL_V2) + (size_t)(nb + 16 * nt + c16) * 32 + 8 * g); const f32x4 lv = MFMA16(wf, tf, z4);
                u32x2 w; w.x = cvt_pk_bf16(lv.x, lv.y); w.y = cvt_pk_bf16(lv.z, lv.w); *(LAS u32x2*)(Limg + ((16 * mt + c16) * 512 + nb + 16 * nt + 4 * g) * 2) = w;
#if MK_DEBUG
                *(f32x4*)(rwbuf(F, RW_Y) + ro[mt] + 16 * nt) = lv;
#endif
            } } }
    __syncthreads();
    {   const float* vbp = INP(33); const float* kkp = INP(25) + l * 512; const float* kap = INP(26) + l * 512;
        float* Rb = rwbuf(F, RW_R); float* Kb = rwbuf(F, RW_K); float* Vb = rwbuf(F, RW_V); float* Ab = rwbuf(F, RW_A); float* Bb = rwbuf(F, RW_B); float* VF = rwbuf(F, RW_VF);
        const int r = tid_l >> 4, j16 = tid_l & 15; int m = m0 + r; asm volatile("" : "+v"(m)); const XmRow xr = xm_row(PR, sshift, m);
#pragma unroll 4
        for (int h = 0; h < 8; ++h) { const int n = 64 * h + 4 * j16; const size_t o = (size_t)m * 512 + n;
            const f32x4 rx = xm4_at(xr, mu, n), k = xm4_at(xr, mu, 512 + n); f32x4 v = xm4_at(xr, mu, 1024 + n);
            const u32x2 aw = *(LAS const u32x2*)(Aimg + (r * 512 + n) * 2); f32x4 a; a.x = bflo(aw.x); a.y = bfhi(aw.x); a.z = bflo(aw.y); a.w = bfhi(aw.y);
            const f32x4 kk = k * *(const f32x4*)(kkp + n);
            const float ss = row16_sum((kk.x * kk.x + kk.y * kk.y) + (kk.z * kk.z + kk.w * kk.w)), rn = 1.f / fmaxf(sqrtf(ss), 1e-12f);
            *(f32x4*)(Rb + o) = rx;
            *(f32x4*)(Kb + o) = k * ((a - 1.f) * *(const f32x4*)(kap + n) + 1.f);
            if (!vres) *(f32x4*)(VF + o) = v;
            else { const u32x2 lw = *(LAS const u32x2*)(Limg + (r * 512 + n) * 2); f32x4 lv; lv.x = bflo(lw.x); lv.y = bfhi(lw.x); lv.z = bflo(lw.y); lv.w = bfhi(lw.y);
                const f32x4 vf = *(const f32x4*)(VF + o); v = v + (vf - v) * fsig4(lv + *(const f32x4*)(vbp + n)); }
            *(f32x4*)(Vb + o) = v;
            const f32x4 kn = kk * rn; *(f32x4*)(Ab + o) = -kn; *(f32x4*)(Bb + o) = kn * a; } }
    TSE2(73, F.lds);
    __syncthreads();
}

constexpr int SC_T = 32, SC_ARR = SC_T * 64 * 4, SC_BUF = 5 * SC_ARR + SC_T * 16 * 4, SC_NSLOT = 3;
static_assert(SC_NSLOT * SC_BUF <= 131072, "scan ring fits the phase LDS");
__device__ __forceinline__ float wave_sum64(float x) { x = row16_sum(x); x += __shfl_xor(x, 16); x += __shfl_xor(x, 32); return x; }
__device__ __forceinline__ void scan_prompt_unit(const Frame& F, int l, int b, int h, int qt) {
    const size_t rowb = (size_t)b * SEQ;
    constexpr int NCH = SEQ / SC_T;
    if (F.wave >= 4) {
        const float* src0 = rwbuf(F, RW_W); const float* src1 = rwbuf(F, RW_A); const float* src2 = rwbuf(F, RW_B); const float* src3 = rwbuf(F, RW_K); const float* src4 = rwbuf(F, RW_R); const float* Vb = rwbuf(F, RW_V);
        const int lt = F.tid - 256, lw = F.wave - 4;
        const size_t g0 = (rowb + (lt >> 4)) * 512 + h * 64 + 4 * (lt & 15), g1 = g0 + (size_t)16 * 512;
        const size_t gv0 = (rowb + (lt & 31)) * 512 + h * 64 + qt * 16 + (lt >> 5), gv1 = gv0 + 8;
        const unsigned l0 = (unsigned)lw * 1024u, l1 = l0 + 4096u;
#define SC_GL(src, goff, slot, arr, loff) __builtin_amdgcn_global_load_lds((const unsigned*)((src) + (goff)), (LAS unsigned*)(F.lds + (slot) * SC_BUF + (arr) * SC_ARR + (loff)), 16, 0, 0)
#define SC_STAGE(ch_, slot_) do { const size_t co_ = (size_t)(ch_) * SC_T * 512; \
            SC_GL(src0, g0 + co_, slot_, 0, l0); SC_GL(src0, g1 + co_, slot_, 0, l1); SC_GL(src1, g0 + co_, slot_, 1, l0); SC_GL(src1, g1 + co_, slot_, 1, l1); SC_GL(src2, g0 + co_, slot_, 2, l0); SC_GL(src2, g1 + co_, slot_, 2, l1); \
            SC_GL(src3, g0 + co_, slot_, 3, l0); SC_GL(src3, g1 + co_, slot_, 3, l1); SC_GL(src4, g0 + co_, slot_, 4, l0); SC_GL(src4, g1 + co_, slot_, 4, l1); \
            __builtin_amdgcn_global_load_lds((const unsigned*)(Vb + gv0 + co_), (LAS unsigned*)(F.lds + (slot_) * SC_BUF + 5 * SC_ARR + lw * 256), 4, 0, 0); \
            __builtin_amdgcn_global_load_lds((const unsigned*)(Vb + gv1 + co_), (LAS unsigned*)(F.lds + (slot_) * SC_BUF + 5 * SC_ARR + 1024 + lw * 256), 4, 0, 0); } while (0)
        SC_STAGE(0, 0); SC_STAGE(1, 1);
        asm volatile("s_waitcnt vmcnt(12)" ::: "memory");
        __builtin_amdgcn_s_barrier();
        int slot = 2;
        for (int ch = 0; ch < NCH; ++ch) {
            if (ch + 2 < NCH) { SC_STAGE(ch + 2, slot);
                asm volatile("s_waitcnt vmcnt(12)" ::: "memory"); }
            else asm volatile("s_waitcnt vmcnt(0)" ::: "memory");
            __builtin_amdgcn_s_barrier();
            slot = slot == 2 ? 0 : slot + 1;
        }
#undef SC_GL
#undef SC_STAGE
    } else {
        float* Yb = rwbuf(F, RW_Y);
        const int rg = F.lane >> 4, j4 = F.lane & 15, rloc = F.wave * 4 + rg;
        f32x4 s = (f32x4){0.f, 0.f, 0.f, 0.f}; float ypv[16]; const bool b8 = (j4 & 8) != 0, b4 = (j4 & 4) != 0, b2 = (j4 & 2) != 0, b1 = (j4 & 1) != 0;
        float* yp = Yb + (rowb + j4) * 512 + h * 64 + qt * 16 + rloc;
        __builtin_amdgcn_s_barrier(); asm volatile("" ::: "memory");
        int slot = 0;
        for (int ch = 0; ch < NCH; ++ch) {
            LAS const unsigned char* bp = F.lds + slot * SC_BUF + j4 * 16; LAS const f32x4* vp = (LAS const f32x4*)(F.lds + slot * SC_BUF + 5 * SC_ARR + rloc * 128);
            f32x4 w = *(LAS const f32x4*)(bp + 0 * SC_ARR), a = *(LAS const f32x4*)(bp + 1 * SC_ARR), bb = *(LAS const f32x4*)(bp + 2 * SC_ARR), k = *(LAS const f32x4*)(bp + 3 * SC_ARR), r = *(LAS const f32x4*)(bp + 4 * SC_ARR);
            f32x4 vq = vp[0];
#pragma unroll
            for (int tt = 0; tt < SC_T; ++tt) {
                const float v = vq[tt & 3];
                asm volatile("" :: "v"(w), "v"(a), "v"(bb), "v"(k), "v"(r), "v"(vq));
                __builtin_amdgcn_sched_barrier(0);
                f32x4 wn = w, an = a, bn = bb, kn = k, rn = r, vqn = vq;
                if (tt + 1 < SC_T) { wn = *(LAS const f32x4*)(bp + 0 * SC_ARR + (tt + 1) * 256); an = *(LAS const f32x4*)(bp + 1 * SC_ARR + (tt + 1) * 256); bn = *(LAS const f32x4*)(bp + 2 * SC_ARR + (tt + 1) * 256);
                    kn = *(LAS const f32x4*)(bp + 3 * SC_ARR + (tt + 1) * 256); rn = *(LAS const f32x4*)(bp + 4 * SC_ARR + (tt + 1) * 256); if ((tt & 3) == 3) vqn = vp[(tt + 1) >> 2]; }
                __builtin_amdgcn_sched_barrier(0);
                const f32x4 p = s * w + k * v;
                const float sa = row16_sum(fmaf(s.w, a.w, fmaf(s.z, a.z, fmaf(s.y, a.y, s.x * a.x))));
                s = bb * sa + p;
                ypv[tt & 15] = fmaf(s.w, r.w, fmaf(s.z, r.z, fmaf(s.y, r.y, s.x * r.x)));
                if ((tt & 15) == 15) {
                    float q8[8], q4[4], q2[2];
#pragma unroll
                    for (int kq = 0; kq < 8; ++kq) { const float keep = b8 ? ypv[kq + 8] : ypv[kq], send = b8 ? ypv[kq] : ypv[kq + 8]; q8[kq] = keep + dpp_f<0x128>(send); }
#pragma unroll
                    for (int kq = 0; kq < 4; ++kq) { const float keep = b4 ? q8[kq + 4] : q8[kq], send = b4 ? q8[kq] : q8[kq + 4]; q4[kq] = keep + dpp_f<0x141>(send); }
#pragma unroll
                    for (int kq = 0; kq < 2; ++kq) { const float keep = b2 ? q4[kq + 2] : q4[kq], send = b2 ? q4[kq] : q4[kq + 2]; q2[kq] = keep + dpp_f<0x4E>(send); }
                    { const float keep = b1 ? q2[1] : q2[0], send = b1 ? q2[0] : q2[1]; yp[(size_t)(ch * SC_T + (tt & ~15)) * 512] = keep + dpp_f<0xB1>(send); }
                }
                w = wn; a = an; bb = bn; k = kn; r = rn; vq = vqn;
            }
            __builtin_amdgcn_s_barrier(); asm volatile("" ::: "memory");
            slot = slot == 2 ? 0 : slot + 1;
        }
        *(f32x4*)(F.out + O_WP + ((((size_t)l * NB + b) * 8 + h) * 64 + qt * 16 + rloc) * 64 + 4 * j4) = s;
    }
    __syncthreads();
}
__device__ __forceinline__ void scan_sample_wave(const Frame& F, int l, int s_, int h) {
    const size_t m = MP + s_; const int rg = F.lane >> 4, j4 = F.lane & 15; const size_t o = m * 512 + h * 64 + 4 * j4;
    const f32x4 w = *(const f32x4*)(rwbuf(F, RW_W) + o), a = *(const f32x4*)(rwbuf(F, RW_A) + o), bb = *(const f32x4*)(rwbuf(F, RW_B) + o), k = *(const f32x4*)(rwbuf(F, RW_K) + o), r = *(const f32x4*)(rwbuf(F, RW_R) + o);
    const float* S0 = INP(8) + (((size_t)l * NS + s_) * 8 + h) * 4096; float* S1 = F.out + O_WS + (((size_t)l * NS + s_) * 8 + h) * 4096;
    const int row = 4 * j4 + rg; const size_t orow = m * 512 + h * 64 + row;
    const float v_my = rwbuf(F, RW_V)[orow], g_my = rwbuf(F, RW_G)[orow], rk_r = INP(27)[l * 512 + h * 64 + row], lg_r = INP(28)[l * 512 + h * 64 + row], lb_r = INP(29)[l * 512 + h * 64 + row];
    const f32x4 rk4 = *(const f32x4*)(INP(27) + l * 512 + h * 64 + 4 * j4);
    (void)rk_r;
    float yk = 0.f;
#pragma unroll 4
    for (int i0 = 0; i0 < 16; ++i0) { const int i = 4 * i0 + rg; f32x4 s = *(const f32x4*)(S0 + i * 64 + 4 * j4); const float v = rwbuf(F, RW_V)[m * 512 + h * 64 + i];
        const float sa = row16_sum((s.x * a.x + s.y * a.y) + (s.z * a.z + s.w * a.w));
        s = s * w + bb * sa + k * v;
        const float y = row16_sum((s.x * r.x + s.y * r.y) + (s.z * r.z + s.w * r.w));
        *(f32x4*)(S1 + i * 64 + 4 * j4) = s; yk = (j4 == i0) ? y : yk; }
    const float bon = row16_sum((r.x * k.x * rk4.x + r.y * k.y * rk4.y) + (r.z * k.z * rk4.z + r.w * k.w * rk4.w));
    const float mu = wave_sum64(yk) * (1.f / 64.f), dv = yk - mu, var = wave_sum64(dv * dv) * (1.f / 64.f);
    ((bf16*)(F.ws + WS_CAT))[m * D + 1536 + h * 64 + row] = (bf16)f2bf((dv * rsqrtf(var + 64e-5f) * lg_r + lb_r + bon * v_my) * g_my);
#if MK_DEBUG
    rwbuf(F, RW_Y)[orow] = yk;
#endif
}
__device__ __forceinline__ void rwkv_post_phase(const Frame& F, int l, int wb, int nwb) {
    const int gw = wb * NWAVES + F.wave, NGW = nwb * NWAVES; const float* rkp = INP(27) + l * 512; const float* lgp = INP(28) + l * 512; const float* lbp = INP(29) + l * 512;
    const float* Yb = rwbuf(F, RW_Y); const float* Rb = rwbuf(F, RW_R); const float* Kb = rwbuf(F, RW_K); const float* Vb = rwbuf(F, RW_V); const float* Gb = rwbuf(F, RW_G);
    for (int it0 = gw * 4; it0 < MP * 8; it0 += NGW * 4) {
        float y[4], r[4], k[4], v[4], g[4];
#pragma unroll
        for (int q = 0; q < 4; ++q) { const int it = it0 + q, m = it >> 3, h = it & 7; const size_t o = (size_t)m * 512 + h * 64 + F.lane; y[q] = Yb[o]; r[q] = Rb[o]; k[q] = Kb[o]; v[q] = Vb[o]; g[q] = Gb[o]; }
#pragma unroll
        for (int q = 0; q < 4; ++q) { const int it = it0 + q, m = it >> 3, h = it & 7, c = h * 64 + F.lane;
            const float mu = wave_sum64(y[q]) * (1.f / 64.f), dv = y[q] - mu, var = wave_sum64(dv * dv) * (1.f / 64.f), bon = wave_sum64(r[q] * k[q] * rkp[c]);
            ((bf16*)(F.ws + WS_CAT))[(size_t)m * D + 1536 + c] = (bf16)f2bf((dv * rsqrtf(var + 64e-5f) * lgp[c] + lbp[c] + bon * v[q]) * g[q]); }
    }
}
}
namespace mk {
namespace cg = cooperative_groups;
constexpr int LDS_BYTES = 135168;
constexpr int TS_OFF = LDS_BYTES - 64;
#ifdef MK_TS_ID
#ifndef MK_TS_BLOCK
#define MK_TS_BLOCK 0
#endif
#ifndef MK_TS_AMP
#define MK_TS_AMP 8
#endif
#define TSB(id, ldsp) do { if ((id) == MK_TS_ID && blockIdx.x == MK_TS_BLOCK && threadIdx.x == 0) *(volatile LAS unsigned*)((ldsp) + TS_OFF) -= (unsigned)__builtin_amdgcn_s_memrealtime(); } while (0)
#define TSE(id, ldsp) do { if ((id) == MK_TS_ID && blockIdx.x == MK_TS_BLOCK && threadIdx.x == 0) *(volatile LAS unsigned*)((ldsp) + TS_OFF) += (unsigned)__builtin_amdgcn_s_memrealtime(); } while (0)
#else
#define TSB(id, ldsp) do {} while (0)
#define TSE(id, ldsp) do {} while (0)
#endif
constexpr int PH_PRO = 0, PH_ADA = 1, PH_L0 = 2, PH_PER_L = 10, PH_FINAL = PH_L0 + NL * PH_PER_L, N_PHASES = PH_FINAL + 1;
enum { LP_NORM1 = 0, LP_IN, LP_MIX, LP_SCAN, LP_POST, LP_MG, LP_WO, LP_NORM2, LP_GU, LP_DN };

__device__ __forceinline__ void mix_phase(const Frame& F, int l) {
    TSB(40, F.lds);
    for (int u = F.bid; u < 256; u += F.G) rwkv_prep_unit(F, l, u);
    TSE(40, F.lds);
    TSB(44, F.lds); state_outs(F, l); TSE(44, F.lds);
}
constexpr int SCAN_BLOCKS = 64;
constexpr int GL_PM_SPLIT = 10;
__device__ __forceinline__ void scan_phase(const Frame& F, int l) {
    if (F.bid < SCAN_BLOCKS) scan_prompt_unit(F, l, F.bid >> 5, (F.bid >> 2) & 7, F.bid & 3);
    else { const int nb_ = F.G - SCAN_BLOCKS, wb = F.bid - SCAN_BLOCKS; const int nw = nb_ * NWAVES; unsigned* ctl = (unsigned*)(F.ws + WS_CTL) + 64 * l;
        if (wb < 4) { rwkv_prep_unit(F, l, 256 + wb); asm volatile("s_waitcnt vmcnt(0)" ::: "memory"); __syncthreads();
            if (F.tid == 0) { __builtin_amdgcn_fence(__ATOMIC_RELEASE, "agent"); asm volatile("s_waitcnt vmcnt(0)" ::: "memory"); __hip_atomic_fetch_add(ctl, 1u, __ATOMIC_RELAXED, __HIP_MEMORY_SCOPE_AGENT); } }
        TSB(41, F.lds);
        for (int a = wb; a < 256; a += nb_) attn_prompt_unit(F, l, a >> 7, (a >> 2) & 31, a & 3);
        TSE(41, F.lds); TSB(42, F.lds);
        for (int p = (wb + 64) % nb_; p < 260; p += nb_) pool_unit(F, l, p >> 2, p & 3);
        TSE(42, F.lds); TSB(43, F.lds);
        for (int s_ = (wb + 132) % nb_; s_ < 2 * NS; s_ += nb_) attn_sample_unit(F, l, s_ >> 1, s_ & 1);
        TSE(43, F.lds);
        __syncthreads();
        Gemm g; g.layer = l; g.ld = D; g.M = MPAD; g.K = D; g.N = NIN; g.A = (const bf16*)(F.ws + WS_H); g.Bt = (const bf16*)wl(F, l, WL_IN); g.mode = G_IN;
        Sched S; S.init(Rect{GL_PM_SPLIT, MPAD / BM - GL_PM_SPLIT, 16, 24}, Rect{0, 0, 0, 0}, F.G - SCAN_BLOCKS, F.bid - SCAN_BLOCKS, 1); Epi E; E.F = &F; E.mode = G_IN; E.layer = l;
        TSB(45, F.lds); gemm_phase(F.lds, g, S, E, F.tid); TSE(45, F.lds);
        if (l == 0) { TSB(46, F.lds); p0_prologue(F, 2, false, wb, nb_, 0); TSE(46, F.lds); }
        if (F.tid == 0) { unsigned sp = 0; while (__hip_atomic_load(ctl, __ATOMIC_RELAXED, __HIP_MEMORY_SCOPE_AGENT) < 4u && ++sp < (1u << 26)) __builtin_amdgcn_s_sleep(8);
            __builtin_amdgcn_fence(__ATOMIC_ACQUIRE, "agent"); asm volatile("s_waitcnt vmcnt(0)" ::: "memory"); }
        __syncthreads();
        for (int u = wb * NWAVES + F.wave; u < NS * 8; u += nw) scan_sample_wave(F, l, u >> 3, u & 7); }
}

#define XB_TMO      128
#define XB_XCNT(j)  (256  + 64 * (j))
#define XB_XSUB(j)  (1280 + 64 * (j))
#define XB_XGEN(j)  (2304 + 64 * (j))
#define XB_TOP      3328
#define XB_TOPGEN   3392
#define XCD_BAR_WORDS 3456
#define XB_SPIN_CAP (1u << 18)

__device__ __forceinline__ unsigned xb_ld(unsigned* p)              { return __hip_atomic_load(p, __ATOMIC_RELAXED, __HIP_MEMORY_SCOPE_AGENT); }
__device__ __forceinline__ unsigned xb_add(unsigned* p, unsigned v) { return __hip_atomic_fetch_add(p, v, __ATOMIC_RELAXED, __HIP_MEMORY_SCOPE_AGENT); }
__device__ __forceinline__ unsigned xb_xcc_id() { return (unsigned)__builtin_amdgcn_s_getreg((3 << 11) | 20) & 0xFu; }
#define XB_SPIN(cond, bar) do { unsigned _sp = 0; while (cond) { __builtin_amdgcn_s_sleep(1); \
    if ((++_sp & 255u) == 0u) { if (xb_ld(&(bar)[XB_TMO])) break; if (_sp > XB_SPIN_CAP) { atomicAdd(&(bar)[XB_TMO], 1u); break; } } } } while (0)

struct XcdBarrier {
    unsigned* bar; unsigned x;
    volatile LAS unsigned* st;
};

__device__ __forceinline__ XcdBarrier xcd_barrier_post(unsigned* bar, volatile LAS unsigned* st) {
    XcdBarrier b; b.bar = bar; b.x = xb_xcc_id(); b.st = st;
    if (threadIdx.x == 0) (void)xb_add(&bar[XB_XCNT(b.x)], 1u);
    return b;
}
__device__ __forceinline__ void xcd_barrier_complete(unsigned* bar, unsigned x, unsigned& nloc, unsigned& nx) {
    const unsigned G = gridDim.x * gridDim.y * gridDim.z;
    unsigned sum, cnt, mine, sp = 0u;
    for (;;) {
        sum = 0u; cnt = 0u; mine = 0u;
#pragma unroll
        for (unsigned j = 0; j < 16; ++j) { const unsigned c = xb_ld(&bar[XB_XCNT(j)]); sum += c; cnt += (c > 0u) ? 1u : 0u; mine = (j == x) ? c : mine; }
        if (sum == G) break;
        __builtin_amdgcn_s_sleep(1);
        if ((++sp & 255u) == 0u) { if (xb_ld(&bar[XB_TMO])) break; if (sp > XB_SPIN_CAP) { atomicAdd(&bar[XB_TMO], 1u); break; } }
    }
    nloc = mine > 0u ? mine : 1u; nx = cnt > 0u ? cnt : 1u;
}

__device__ __forceinline__ void xcd_barrier(const XcdBarrier& b) {
    asm volatile("s_waitcnt vmcnt(0)" ::: "memory");
    __syncthreads();
    if (threadIdx.x == 0) {
        unsigned* bar = b.bar;
        __builtin_amdgcn_s_waitcnt(0);
        unsigned nloc = b.st[0], nx = b.st[1];
        if (nloc == 0u) { xcd_barrier_complete(bar, b.x, nloc, nx); b.st[0] = nloc; b.st[1] = nx; }
        const unsigned old = xb_add(&bar[XB_XSUB(b.x)], 1u);
        const unsigned gen = old / nloc;
        if (old + 1u == (gen + 1u) * nloc) {
            __builtin_amdgcn_fence(__ATOMIC_RELEASE, "agent");
            asm volatile("s_waitcnt vmcnt(0)" ::: "memory");
            const unsigned og = xb_add(&bar[XB_TOP], 1u);
            const unsigned tg = og / nx;
            if (og + 1u == (tg + 1u) * nx) xb_add(&bar[XB_TOPGEN], 1u);
            else XB_SPIN(xb_ld(&bar[XB_TOPGEN]) == tg, bar);
            __builtin_amdgcn_fence(__ATOMIC_ACQUIRE, "agent");
            xb_add(&bar[XB_XGEN(b.x)], 1u);
            asm volatile("s_waitcnt vmcnt(0)" ::: "memory");
        } else {
            XB_SPIN(xb_ld(&bar[XB_XGEN(b.x)]) == gen, bar);
            __builtin_amdgcn_fence(__ATOMIC_ACQUIRE, "agent");
            asm volatile("s_waitcnt vmcnt(0)" ::: "memory");
        }
    }
    __syncthreads();
}


__global__ void __launch_bounds__(NTHR, 2) __attribute__((target("no-packed-fp32-ops"))) mega(Args args) {
    extern __shared__ __attribute__((aligned(16))) unsigned char lds_raw[];
    cg::grid_group grid = cg::this_grid();
    if (threadIdx.x < 2) ((volatile LAS unsigned*)((LAS unsigned char*)lds_raw + TS_OFF - 64))[threadIdx.x] = 0u;
    __syncthreads();
    const XcdBarrier xbar = xcd_barrier_post((unsigned*)(args.ws + WS_CTL + 4096), (volatile LAS unsigned*)((LAS unsigned char*)lds_raw + TS_OFF - 64));
#ifdef MK_TS_ID
    if (threadIdx.x == 0) *(volatile LAS unsigned*)((LAS unsigned char*)lds_raw + TS_OFF) = 0u;
#endif
    for (int ph = args.ph_lo; ph < args.ph_hi; ++ph) {
        Frame F; { GAS unsigned char* ws_ = (GAS unsigned char*)args.ws; GAS float* out_ = (GAS float*)args.out; int tid_ = threadIdx.x; int bid_ = blockIdx.x; int G_ = gridDim.x;
            asm volatile("" : "+s"(ws_), "+s"(out_), "+v"(tid_), "+s"(bid_), "+s"(G_));
            F.lds = (LAS unsigned char*)lds_raw; F.tid = tid_; F.lane = tid_ & 63; F.wave = __builtin_amdgcn_readfirstlane(tid_ >> 6); F.G = G_; F.bid = bid_; F.out = (float*)out_; F.ws = (unsigned char*)ws_; }
        const int l = ph >= PH_L0 && ph < PH_FINAL ? (ph - PH_L0) / PH_PER_L : 0, lp = ph >= PH_L0 && ph < PH_FINAL ? (ph - PH_L0) % PH_PER_L : -1;
        TSB(ph == PH_PRO ? 1 : ph == PH_ADA ? 2 : ph == PH_FINAL ? 3 : 10 + lp, F.lds);
#ifndef MK_NO_PRO
        if (ph == PH_PRO) p0_prologue(F, 0, true, F.bid, F.G, 0); else
#endif
#ifndef MK_NO_NORM
        if (ph == PH_FINAL || lp == LP_NORM1 || lp == LP_NORM2) norm_phase(F, l, ph == PH_FINAL ? 2 : lp == LP_NORM1 ? 0 : 1, ph == PH_FINAL ? 11 : lp == LP_NORM2 ? 4 : (l > 0 ? 11 : 0)); else
#endif
#ifndef MK_NO_MIX
        if (lp == LP_MIX) { mix_phase(F, l);
#ifdef MK_DUP_MIX
            __syncthreads(); mix_phase(F, l);
#endif
        } else
#endif
#ifndef MK_NO_SCAN
        if (lp == LP_SCAN) { scan_phase(F, l);
#ifdef MK_DUP_SCAN
            __syncthreads(); scan_phase(F, l);
#endif
        } else
#endif
#ifndef MK_NO_GEMM
        {
            Gemm g; g.layer = l; g.ld = D; g.M = MPAD; g.K = D;
            if (ph == PH_ADA) { g.A = (const bf16*)(F.ws + WS_SILC); g.Bt = (const bf16*)(F.ws + WS_ADAW); g.M = 256; g.N = 2 * NADA; g.mode = G_ADA; }
            else if (lp == LP_IN) { g.A = (const bf16*)(F.ws + WS_H); g.Bt = (const bf16*)wl(F, l, WL_IN); g.N = NIN; g.mode = G_IN; }
            else if (lp == LP_MG || lp == LP_POST) { g.A = (const bf16*)(F.ws + WS_CAT); g.Bt = (const bf16*)wl(F, l, WL_CAT); g.N = D; g.mode = G_MG; }
            else if (lp == LP_WO) { g.A = (const bf16*)(F.ws + WS_MG); g.Bt = (const bf16*)wl(F, l, WL_O); g.N = D; g.mode = G_WO; }
            else if (lp == LP_GU) { g.A = (const bf16*)(F.ws + WS_H); g.Bt = (const bf16*)wl(F, l, WL_GU); g.N = NGU; g.mode = G_GU; }
            else { g.A = (const bf16*)(F.ws + WS_GT); g.Bt = (const bf16*)wl(F, l, WL_DN); g.N = D; g.K = DFF; g.ld = DFF; g.mode = G_DN; }
            Sched S; Epi E; E.F = &F; E.mode = g.mode; E.layer = l;
            if (lp == LP_IN && ph != PH_ADA) S.init(Rect{0, MPAD / BM, 0, 16}, Rect{0, GL_PM_SPLIT, 16, 24}, F.G, F.bid, 1);
            else if (lp == LP_POST) S.init(Rect{0, 0, 0, 8}, Rect{MPAD / BM - 1, 1, 0, 8 * (D / 512)}, F.G, F.bid, 1, 8);
            else if (lp == LP_MG) S.init(Rect{0, MPAD / BM - 1, 0, 8}, Rect{0, 0, 0, 0}, F.G, F.bid, 1);
            else if (g.mode == G_WO || g.mode == G_DN) S.init(Rect{0, MPAD / BM - 1, 0, 8}, Rect{MPAD / BM - 1, 1, 0, 8 * (g.K / 512)}, F.G, F.bid, 1, 8);
            else S.init(Rect{0, g.M / BM, 0, g.N / BM}, Rect{0, 0, 0, 0}, F.G, F.bid, 1);
            TSB(47, F.lds);
            if (lp == LP_MG) {
                const float* sl = (const float*)(F.ws + WS_SLABM); bf16* mg = (bf16*)(F.ws + WS_MG) + (size_t)MP * D;
                for (int i = F.bid * NTHR + F.tid; i < NS * (D / 4); i += F.G * NTHR) { const size_t o = (size_t)i * 4;
                    const f32x4 t = (*(const f32x4*)(sl + o) + *(const f32x4*)(sl + (size_t)NS * D + o)) + (*(const f32x4*)(sl + (size_t)2 * NS * D + o) + *(const f32x4*)(sl + (size_t)3 * NS * D + o));
                    u32x2 w; w.x = cvt_pk_bf16(t.x, t.y); w.y = cvt_pk_bf16(t.z, t.w); *(u32x2*)(mg + o) = w; } }
            TSE(47, F.lds);
            gemm_phase(F.lds, g, S, E, F.tid);
            if (lp == LP_POST) { constexpr int NSU = 8 * (D / 512); const bool split = F.G > 2 * NSU; const int wb = split ? F.bid - NSU : F.bid, nwb = split ? F.G - NSU : F.G;
                if (wb >= 0) rwkv_post_phase(F, l, wb, nwb); }
            if (ph == PH_ADA) { if (F.bid < 96) p0_prologue(F, 1, false, F.bid, 96, 2); else p0_prologue(F, 1, false, F.bid - 96, F.G - 96, 1); }
        }
#else
        {}
#endif
        TSE(ph == PH_PRO ? 1 : ph == PH_ADA ? 2 : ph == PH_FINAL ? 3 : 10 + lp, F.lds);
        TSB(30, F.lds);
        if (ph + 1 < args.ph_hi) { if (args.ph_hi < 0) grid.sync();   else xcd_barrier(xbar); }
        TSE(30, F.lds);
    }
#ifdef MK_EXTRA_SYNCS
    for (int i = 0; i < MK_EXTRA_SYNCS; ++i) xcd_barrier(xbar);
#endif
#ifdef MK_TS_ID
    if (blockIdx.x == MK_TS_BLOCK && threadIdx.x == 0) { const unsigned want = *(volatile LAS unsigned*)((LAS unsigned char*)lds_raw + TS_OFF) * (unsigned)MK_TS_AMP; const unsigned t0 = (unsigned)__builtin_amdgcn_s_memrealtime();
        while ((unsigned)__builtin_amdgcn_s_memrealtime() - t0 < want) __builtin_amdgcn_s_sleep(32); }
#endif
}
}
#ifndef MK_DEBUG
#define MK_DEBUG 0
#endif
extern "C" void kernel_launch(void* const* d_in, const int* in_sizes, int n_in, void* d_out, int out_size, void* d_ws, size_t ws_size, hipStream_t stream) {
    using namespace mk;
    static int grid = 0;
    if (grid == 0) {
        nv::WS wtmp; const size_t need_nv = nv::carve((float*)d_ws, wtmp) * 4; const size_t need = MK_DEBUG ? (need_nv > WS_END ? need_nv : WS_END) + (16u << 20) : WS_END;
        if (n_in != 39 || (size_t)out_size != O_END || ws_size < need) { fprintf(stderr, "kernel_launch: unexpected shapes: n_in %d out %d (want %zu) ws %zu (need %zu)\n", n_in, out_size, (size_t)O_END, ws_size, need); grid = -1; return; }
        int dev = 0, cus = 0, per_cu = 0;
        if (hipGetDevice(&dev) != hipSuccess || hipDeviceGetAttribute(&cus, hipDeviceAttributeMultiprocessorCount, dev) != hipSuccess) { grid = -1; return; }
        if (hipFuncSetAttribute((const void*)mega, hipFuncAttributeMaxDynamicSharedMemorySize, LDS_BYTES) != hipSuccess) { fprintf(stderr, "kernel_launch: hipFuncSetAttribute failed\n"); grid = -1; return; }
        if (hipOccupancyMaxActiveBlocksPerMultiprocessor(&per_cu, (const void*)mega, NTHR, LDS_BYTES) != hipSuccess || per_cu < 1) { fprintf(stderr, "kernel_launch: occupancy query says %d blocks per CU\n", per_cu); per_cu = 1; }
        (void)hipGetLastError();
        grid = cus;
        fprintf(stderr, "kernel_launch: grid %d (cus %d, per_cu %d), ws %zu need %zu\n", grid, cus, per_cu, ws_size, need);
    }
    if (grid < 0) return;
    Args a{};
    for (int i = 0; i < 39; ++i) a.in[i] = (const float*)d_in[i];
    a.out = (float*)d_out; a.ws = (unsigned char*)d_ws;
    if (hipMemsetAsync((unsigned char*)d_ws + WS_CTL, 0, WS_CTL_BYTES, stream) != hipSuccess) { fprintf(stderr, "kernel_launch: hipMemsetAsync of the control words failed\n"); return; }
#if MK_DEBUG
    dbg::Ctx dc; dc.probes = (float*)((unsigned char*)d_ws + ((ws_size - (12u << 20)) & ~(size_t)255)); dc.err = dc.probes + (size_t)dbg::NIDS * dbg::NPROBE; dc.on = 1;
    (void)hipMemsetAsync(dc.err, 0, dbg::NIDS * 4 * sizeof(float), stream);
    unsigned char* ws = (unsigned char*)d_ws;
    for (int ph = 0; ph < N_PHASES; ++ph) {
        a.ph_lo = ph; a.ph_hi = ph + 1;
        hipLaunchKernelGGL(mega, dim3(grid), dim3(NTHR), LDS_BYTES, stream, a);
        using namespace dbg;
        const int l = ph >= PH_L0 && ph < PH_FINAL ? (ph - PH_L0) / PH_PER_L : 0, lp = ph >= PH_L0 && ph < PH_FINAL ? (ph - PH_L0) % PH_PER_L : -1, tb = T_L0 + l * T_PER_L;
        if (ph == PH_ADA) save(&dc, stream, T_MOD, ws + WS_MOD, K_F32, NADA, 0, NL * NMOD, NADA);
        if (lp == LP_NORM1) save(&dc, stream, tb + T_H1, ws + WS_H, K_BF16, D, 0, M, D);
        if (lp == LP_IN) { save(&dc, stream, tb + T_Q, ws + WS_Q, K_QPERM, 1024, 0, M, 1024); save(&dc, stream, tb + T_K, ws + WS_K, K_QPERM, 256, 0, M, 256); save(&dc, stream, tb + T_V, ws + WS_V, K_BF16, 256, 0, M, 256);
            save(&dc, stream, tb + T_U, ws + WS_U, K_F32, 512, 0, M, 512); save(&dc, stream, tb + T_PR, ws + WS_PR, K_F32, 2048, 0, M, RP); }
        if (lp == LP_SCAN) { save(&dc, stream, tb + T_OA, ws + WS_CAT, K_BF16, D, 0, M, 1024); save(&dc, stream, tb + T_ZP, ws + WS_CAT, K_BF16, D, 1024, M, 512); }
        if (lp == LP_SCAN) {
            for (int i = 0; i < 7; ++i) save(&dc, stream, tb + T_R + i, ws + WS_RW + (size_t)i * RW_STRIDE, K_F32, 512, 0, M, 512);
            if (l == 1) { save(&dc, stream, 59, ws + WS_RW + (size_t)RW_Y * RW_STRIDE, K_F32, 512, 0, M, 512); save(&dc, stream, 60, ws + WS_H, K_F32, 32, 0, M, 32); } }
        if (lp == LP_SCAN) save(&dc, stream, tb + T_GT, ws + WS_GT, K_BF16, 6144, 0, M, 6144);
        if (lp == LP_SCAN) save(&dc, stream, tb + T_Y, ws + WS_RW + (size_t)RW_Y * RW_STRIDE, K_F32, 512, 0, M, 512);
        if (lp == LP_POST) save(&dc, stream, tb + T_YR, ws + WS_CAT, K_BF16, D, 1536, M, 512);
        if (lp == LP_WO) save(&dc, stream, tb + T_MG, ws + WS_MG, K_BF16, D, 0, M, D);
        if (lp == LP_NORM2) { save(&dc, stream, tb + T_X1, ws + WS_X, K_F32, D, 0, M, D); save(&dc, stream, tb + T_H2, ws + WS_H, K_BF16, D, 0, M, D); }
        if (lp == LP_GU) save(&dc, stream, tb + T_ACT, ws + WS_GT, K_BF16, DFF, 0, M, DFF);
        if ((lp == LP_NORM1 && l > 0) || ph == PH_FINAL) save(&dc, stream, T_L0 + (ph == PH_FINAL ? 1 : l - 1) * T_PER_L + T_X2, ws + WS_X, K_F32, D, 0, M, D);
    }
    const size_t ooff[13] = {O_YP, O_YS, O_KP, O_VP, O_PP, O_SP, O_WP, O_KS, O_VS, O_PS, O_SS, O_WS, O_END}; const int ocol[12] = {2048, 2048, 256, 256, 512, 1984, 64, 256, 256, 512, 1984, 64};
    for (int i = 0; i < 12; ++i) dbg::save(&dc, stream, dbg::T_OUT0 + i, (float*)d_out + ooff[i], dbg::K_F32, ocol[i], 0, (int)((ooff[i + 1] - ooff[i]) / ocol[i]), ocol[i]);
    nv::In in; for (int i = 0; i < 39; ++i) in.p[i] = (const float*)d_in[i];
    nv::forward(in, (float*)d_out, (float*)d_ws, stream, &dc);
    for (int i = 0; i < 12; ++i) dbg::cmp(&dc, stream, dbg::T_OUT0 + i, (float*)d_out + ooff[i], ocol[i], 0, (int)((ooff[i + 1] - ooff[i]) / ocol[i]), ocol[i]);
#ifndef DBG_WANT_ID
#define DBG_WANT_ID -1
#endif
    dbg::inject<<<1, 1, 0, stream>>>(dc.err, (float*)d_out, (float*)d_out + O_YS, DBG_WANT_ID >= 0 ? dbg::NIDS : dbg::T_N, DBG_WANT_ID);
#else
    a.ph_lo = 0; a.ph_hi = N_PHASES;
    void* kargs[] = {&a};
    const hipError_t e = hipLaunchCooperativeKernel((const void*)mega, dim3(grid), dim3(NTHR), kargs, LDS_BYTES, stream);
    if (e != hipSuccess) fprintf(stderr, "kernel_launch: cooperative launch failed: %s (grid %d)\n", hipGetErrorString(e), grid);
#endif
}
```

```cpp
#define MK_DEBUG 0
#include <hip/hip_runtime.h>
#include <hip/hip_cooperative_groups.h>
#include <cstdio>
#include <cstdint>
namespace dbg {
constexpr int NPROBE = 16384, NSPECIAL = 2048, NIDS = 64;
struct Ctx { float* probes; float* err; int on; };
__device__ __forceinline__ unsigned hash32(unsigned x) { x ^= x >> 16; x *= 0x7feb352dU; x ^= x >> 15; x *= 0x846ca68bU; x ^= x >> 16; return x; }
__device__ __forceinline__ void probe_rc(int id, int k, int R, int C, int& r, int& c) {
    const unsigned h1 = hash32((unsigned)(id * 1000003 + k * 2 + 1)), h2 = hash32((unsigned)(id * 7919 + k * 2 + 77777));
    c = (int)(h2 % (unsigned)C);
    if (R == 8320 && k < NSPECIAL) { const int sp[16] = {0, 1, 15, 16, 127, 128, 129, 4095, 4096, 4097, 8190, 8191, 8192, 8193, 8255, 8319}; r = sp[k >> 7]; }
    else r = (int)(h1 % (unsigned)R);
}
enum { K_F32 = 0, K_BF16 = 1, K_QPERM = 2 };
__device__ __forceinline__ float opt_read(const void* p, int kind, size_t ld, int coff, int r, int c) {
    if (kind == K_F32) return ((const float*)p)[(size_t)r * ld + coff + c];
    if (kind == K_QPERM) { const int h = c >> 6, d = c & 63, pp = 32 * ((d >> 4) & 1) + 8 * ((d >> 2) & 3) + 4 * (d >> 5) + (d & 3); c = h * 64 + pp; }
    const unsigned short b = ((const unsigned short*)p)[(size_t)r * ld + coff + c]; return __builtin_bit_cast(float, (unsigned)b << 16);
}
__global__ void probe_save(float* probes, int id, const void* p, int kind, size_t ld, int coff, int R, int C) {
    const int k = blockIdx.x * blockDim.x + threadIdx.x; if (k >= NPROBE) return; int r, c; probe_rc(id, k, R, C, r, c);
    probes[(size_t)id * NPROBE + k] = opt_read(p, kind, ld, coff, r, c);
}
__global__ void probe_cmp(const float* probes, float* err, int id, const float* gold, size_t ld, int coff, int R, int C, int sig) {
    const int k = blockIdx.x * blockDim.x + threadIdx.x; if (k >= NPROBE) return; int r, c; probe_rc(id, k, R, C, r, c);
    float g = gold[(size_t)r * ld + coff + c]; if (sig) g = 1.f / (1.f + expf(-g));
    float o = probes[(size_t)id * NPROBE + k]; float d = o - g; if (!(d == d) || fabsf(d) > 1e18f) d = 1e18f;
    const int sp = (R == 8320 && k < NSPECIAL) ? 0 : 2;
    atomicAdd(&err[id * 4 + sp], d * d); atomicAdd(&err[id * 4 + sp + 1], g * g);
}
__global__ void inject(const float* err, float* out, float* ys, int nids, int want_id) {
    if (threadIdx.x || blockIdx.x) return;
    int rid = 89, which = 0; float rel = 1e-3f;
    for (int id = 0; id < nids; ++id) {
        const float r_rand = sqrtf(err[id * 4 + 2] / fmaxf(err[id * 4 + 3], 1e-30f)), r_sp = err[id * 4 + 1] > 0.f ? sqrtf(err[id * 4 + 0] / fmaxf(err[id * 4 + 1], 1e-30f)) : 0.f;
        if (want_id >= 0) { if (id == want_id) { rid = id; which = 0; rel = r_rand; break; } continue; }
        if (r_rand > 0.05f) { rid = id; which = 0; rel = r_rand; break; } else if (r_sp > 0.10f) { rid = id; which = 1; rel = r_sp; break; } }
    const float c1 = (float)(10 + rid) * (which ? 1e5f : 1e3f); float f = (log10f(fmaxf(rel, 1e-3f)) + 3.f) * 0.25f; f = fminf(fmaxf(f, 0.f), 1.f);
    out[0] = c1; ys[0] = c1 * (0.2f + 0.6f * f);
}
inline void save(const Ctx* c, hipStream_t st, int id, const void* p, int kind, size_t ld, int coff, int R, int C) { if (c && c->on) probe_save<<<NPROBE / 256, 256, 0, st>>>(c->probes, id, p, kind, ld, coff, R, C); }
inline void cmp(const Ctx* c, hipStream_t st, int id, const float* gold, size_t ld, int coff, int R, int C, int sig = 0) { if (c && c->on) probe_cmp<<<NPROBE / 256, 256, 0, st>>>(c->probes, c->err, id, gold, ld, coff, R, C, sig); }
enum { T_MOD = 0, T_L0 = 1, T_PER_L = 23, T_OUT0 = T_L0 + 2 * T_PER_L, T_N = T_OUT0 + 12 };
enum { T_H1 = 0, T_Q, T_K, T_V, T_U, T_PR, T_GT, T_OA, T_ZP, T_R, T_W, T_KK, T_VV, T_A, T_B, T_G, T_Y, T_YR, T_MG, T_X1, T_H2, T_ACT, T_X2 };
}
namespace nv {
constexpr int D = 2048, SEQ = 4096, NB = 2, MP = NB * SEQ, NS = 128, M = MP + NS, NL = 2;
constexpr int INW = 10176, OQ = 0, OK_ = 1024, OV = 1280, OU = 1536, OPR = 2048, OGL = 4032;
constexpr int RP = 1984, DFF = 5632, NMOD = NB + NS;
constexpr int PASTLEN = 8192;

__device__ __forceinline__ float sigm(float x) { return 1.f / (1.f + expf(-x)); }
__device__ __forceinline__ float silu(float x) { return x / (1.f + expf(-x)); }
__device__ __forceinline__ int modrow(int m) { return m < MP ? m / SEQ : NB + (m - MP); }
__device__ __forceinline__ int posof(int m) { return m < MP ? m % SEQ : PASTLEN; }

__global__ void __launch_bounds__(256) gemm(const float* __restrict__ A, int lda, const float* __restrict__ B, int ldb, float* __restrict__ C, int ldc, int Mm, int N, int K) {
    __shared__ float As[16][68], Bs[16][68];
    const int tx = threadIdx.x & 15, ty = threadIdx.x >> 4, m0 = blockIdx.y * 64, n0 = blockIdx.x * 64;
    float acc[4][4];
#pragma unroll
    for (int i = 0; i < 4; ++i)
#pragma unroll
        for (int j = 0; j < 4; ++j) acc[i][j] = 0.f;
    for (int k0 = 0; k0 < K; k0 += 16) {
        for (int i = threadIdx.x; i < 1024; i += 256) { const int r = i >> 4, c = i & 15; As[c][r] = (m0 + r < Mm) ? A[(size_t)(m0 + r) * lda + k0 + c] : 0.f; }
        for (int i = threadIdx.x; i < 1024; i += 256) { const int r = i >> 6, c = i & 63; Bs[r][c] = (n0 + c < N) ? B[(size_t)(k0 + r) * ldb + n0 + c] : 0.f; }
        __syncthreads();
#pragma unroll
        for (int kk = 0; kk < 16; ++kk) {
            float a[4], b[4];
#pragma unroll
            for (int i = 0; i < 4; ++i) { a[i] = As[kk][ty * 4 + i]; b[i] = Bs[kk][tx * 4 + i]; }
#pragma unroll
            for (int i = 0; i < 4; ++i)
#pragma unroll
                for (int j = 0; j < 4; ++j) acc[i][j] += a[i] * b[j];
        }
        __syncthreads();
    }
#pragma unroll
    for (int i = 0; i < 4; ++i)
#pragma unroll
        for (int j = 0; j < 4; ++j) { const int m = m0 + ty * 4 + i, n = n0 + tx * 4 + j; if (m < Mm && n < N) C[(size_t)m * ldc + n] = acc[i][j]; }
}

__global__ void silu_c(const float* cp, const float* cs, float* out) {
    const int i = blockIdx.x * blockDim.x + threadIdx.x; if (i >= NMOD * D) return;
    const int r = i / D, k = i % D; const float c = r < NB ? cp[r * D + k] : cs[(r - NB) * D + k]; out[i] = silu(c);
}
__global__ void add_bias(float* mod, const float* b, int n, int N) { const int i = blockIdx.x * blockDim.x + threadIdx.x; if (i < n) mod[i] += b[i % N]; }

__global__ void __launch_bounds__(256) modnorm(const float* xa, const float* xb, const float* g, const float* mod, int sh_off, int sc_off, float* out, size_t out_split_off) {
    const int m = blockIdx.x; const float* x = m < MP ? xa + (size_t)m * D : xb + (size_t)(m - MP) * D;
    __shared__ float red[256]; float s = 0.f;
    for (int k = threadIdx.x; k < D; k += 256) { const float v = x[k]; s += v * v; }
    red[threadIdx.x] = s; __syncthreads();
    for (int o = 128; o > 0; o >>= 1) { if (threadIdx.x < o) red[threadIdx.x] += red[threadIdx.x + o]; __syncthreads(); }
    const float rs = rsqrtf(red[0] / D + 1e-6f); const int br = modrow(m);
    float* o = m < MP ? out + (size_t)m * D : out + out_split_off + (size_t)(m - MP) * D;
    for (int k = threadIdx.x; k < D; k += 256) { float v = x[k] * rs * g[k]; if (mod) v = v * (1.f + mod[(size_t)br * 6 * D + sc_off + k]) + mod[(size_t)br * 6 * D + sh_off + k]; o[k] = v; }
}

__global__ void rope(float* z) {
    const int i = blockIdx.x * blockDim.x + threadIdx.x; if (i >= M * 20 * 32) return;
    const int m = i / 640, hh = (i / 32) % 20, d = i % 32; const float pos = (float)posof(m);
    const float inv = powf(10000.f, -(float)d * 2.0f / 64.f), ang = pos * inv, c = cosf(ang), s = sinf(ang);
    float* p = z + (size_t)m * INW + hh * 64; const float x1 = p[d], x2 = p[d + 32]; p[d] = x1 * c - x2 * s; p[d + 32] = x2 * c + x1 * s;
}

__global__ void attn_prompt(const float* z, const float* sink, float* oattn) {
    const int i = blockIdx.x * blockDim.x + threadIdx.x; if (i >= MP * 16) return;
    const int m = i / 16, hq = i % 16, hk = hq / 4, t = m % SEQ; const float* q = z + (size_t)m * INW + OQ + hq * 64;
    const int lo = t - 128 < 0 ? 0 : t - 128; const float sk = sink[hq];
    float mx = sk;
    for (int kp = lo; kp <= t; ++kp) { const float* k = z + (size_t)(m - t + kp) * INW + OK_ + hk * 64; float s = 0.f; for (int d = 0; d < 64; ++d) s += q[d] * k[d]; s *= 0.125f; mx = fmaxf(mx, s); }
    float den = expf(sk - mx); float o[64];
#pragma unroll
    for (int d = 0; d < 64; ++d) o[d] = 0.f;
    for (int kp = lo; kp <= t; ++kp) { const float* k = z + (size_t)(m - t + kp) * INW + OK_ + hk * 64; const float* v = z + (size_t)(m - t + kp) * INW + OV + hk * 64; float s = 0.f; for (int d = 0; d < 64; ++d) s += q[d] * k[d]; s *= 0.125f;
        const float p = expf(s - mx); den += p;
#pragma unroll
        for (int d = 0; d < 64; ++d) o[d] += p * v[d]; }
#pragma unroll
    for (int d = 0; d < 64; ++d) oattn[(size_t)m * 1024 + hq * 64 + d] = o[d] / den;
}
__global__ void attn_sample(const float* z, const float* sink, const float* ck, const float* cv, float* oattn) {
    const int i = blockIdx.x * blockDim.x + threadIdx.x; if (i >= NS * 16) return;
    const int s_ = i / 16, hq = i % 16, hk = hq / 4, m = MP + s_; const float* q = z + (size_t)m * INW + OQ + hq * 64; const float sk = sink[hq];
    float mx = sk;
    for (int j = 0; j <= 128; ++j) { const float* k = j < 128 ? ck + ((size_t)(s_ * 128 + j) * 4 + hk) * 64 : z + (size_t)m * INW + OK_ + hk * 64; float s = 0.f; for (int d = 0; d < 64; ++d) s += q[d] * k[d]; s *= 0.125f; mx = fmaxf(mx, s); }
    float den = expf(sk - mx); float o[64];
#pragma unroll
    for (int d = 0; d < 64; ++d) o[d] = 0.f;
    for (int j = 0; j <= 128; ++j) { const float* k = j < 128 ? ck + ((size_t)(s_ * 128 + j) * 4 + hk) * 64 : z + (size_t)m * INW + OK_ + hk * 64;
        const float* v = j < 128 ? cv + ((size_t)(s_ * 128 + j) * 4 + hk) * 64 : z + (size_t)m * INW + OV + hk * 64; float s = 0.f; for (int d = 0; d < 64; ++d) s += q[d] * k[d]; s *= 0.125f;
        const float p = expf(s - mx); den += p;
#pragma unroll
        for (int d = 0; d < 64; ++d) o[d] += p * v[d]; }
#pragma unroll
    for (int d = 0; d < 64; ++d) oattn[(size_t)m * 1024 + hq * 64 + d] = o[d] / den;
}
__global__ void kv_out(const float* z, const float* ck, const float* cv, float* kp, float* vp, float* ks, float* vs) {
    const int i = blockIdx.x * blockDim.x + threadIdx.x;
    if (i < NB * 128 * 256) { const int b = i / (128 * 256), j = (i / 256) % 128, c = i % 256; const size_t m = (size_t)b * SEQ + SEQ - 128 + j; kp[i] = z[m * INW + OK_ + c]; vp[i] = z[m * INW + OV + c]; }
    if (i < NS * 128 * 256) { const int s_ = i / (128 * 256), j = (i / 256) % 128, c = i % 256;
        if (j < 127) { ks[i] = ck[i + 256]; vs[i] = cv[i + 256]; } else { ks[i] = z[(size_t)(MP + s_) * INW + OK_ + c]; vs[i] = z[(size_t)(MP + s_) * INW + OV + c]; } }
}
__global__ void pool_d(const float* z, const float* spool, float* dbuf) {
    const int i = blockIdx.x * blockDim.x + threadIdx.x; if (i >= M * 512) return;
    const int m = i / 512, c = i % 512, gi = c / 128, w = 2 << gi; float sum = 0.f; float cnt;
    if (m < MP) { const int t = m % SEQ; for (int j = 0; j < w; ++j) if (t - j >= 0) sum += z[(size_t)(m - j) * INW + OU + c]; cnt = (float)(t + 1 < w ? t + 1 : w); }
    else { const int s_ = m - MP; sum = z[(size_t)m * INW + OU + c]; for (int j = 1; j < w; ++j) sum += spool[((size_t)s_ * 15 + 15 - j) * 512 + c]; cnt = (float)w; }
    dbuf[i] = sum / cnt - z[(size_t)m * INW + OU + c];
}
__global__ void pool_z(const float* dbuf, const float* pw, const float* pscale, float* zpool) {
    const int i = blockIdx.x * blockDim.x + threadIdx.x; if (i >= M * 512) return;
    const int m = i / 512, c = i % 512, gi = c / 128, e = c % 128; float s = 0.f;
    for (int k = 0; k < 128; ++k) s += dbuf[(size_t)m * 512 + gi * 128 + k] * pw[(gi * 128 + k) * 128 + e];
    zpool[i] = s * pscale[c];
}
__global__ void pool_out(const float* z, const float* spool, float* pp, float* ps) {
    const int i = blockIdx.x * blockDim.x + threadIdx.x;
    if (i < NB * 15 * 512) { const int b = i / (15 * 512), j = (i / 512) % 15, c = i % 512; pp[i] = z[((size_t)b * SEQ + SEQ - 15 + j) * INW + OU + c]; }
    if (i < NS * 15 * 512) { const int s_ = i / (15 * 512), j = (i / 512) % 15, c = i % 512; ps[i] = j < 14 ? spool[i + 512] : z[(size_t)(MP + s_) * INW + OU + c]; }
}
__global__ void rwkv_xm(const float* z, const float* sshift, const float* mu, float* xm) {
    const int i = blockIdx.x * blockDim.x + threadIdx.x; if (i >= M * RP) return;
    const int m = i / RP, c = i % RP; const float p = z[(size_t)m * INW + OPR + c]; float pv;
    if (m < MP) pv = (m % SEQ) ? z[(size_t)(m - 1) * INW + OPR + c] : 0.f; else pv = sshift[(size_t)(m - MP) * RP + c];
    xm[i] = p + (pv - p) * mu[c];
}
__global__ void shift_out(const float* z, float* sp, float* ss) {
    const int i = blockIdx.x * blockDim.x + threadIdx.x;
    if (i < NB * RP) { const int b = i / RP, c = i % RP; sp[i] = z[((size_t)b * SEQ + SEQ - 1) * INW + OPR + c]; }
    if (i < NS * RP) { const int s_ = i / RP, c = i % RP; ss[i] = z[(size_t)(MP + s_) * INW + OPR + c]; }
}
__global__ void __launch_bounds__(64) rwkv_prep(const float* xm, const float* w0, const float* w2, const float* a0, const float* a2, const float* g2, const float* k_k, const float* k_a,
                                                 const float* T2, const float* vb, float* vfirst, int has_vres,
                                                 float* R, float* W, float* Kk, float* V, float* A, float* Bb, float* G) {
    const int m = blockIdx.x / 8, h = blockIdx.x % 8, c = h * 64 + threadIdx.x; const float* x = xm + (size_t)m * RP;
    float s = w0[c]; for (int k = 0; k < 96; ++k) s += tanhf(x[1536 + k]) * w2[k * 512 + c];
    const float z_ = -s; const float sp = z_ > 20.f ? z_ : log1pf(expf(z_)); const float wlog = -sp - 0.5f; const float decay = expf(-expf(wlog));
    float sa = a0[c]; for (int k = 0; k < 96; ++k) sa += x[1632 + k] * a2[k * 512 + c]; const float a = sigm(sa);
    float g = 0.f; for (int k = 0; k < 256; ++k) g += sigm(x[1728 + k]) * g2[k * 512 + c];
    float v = x[1024 + c];
    if (!has_vres) vfirst[(size_t)m * 512 + c] = v;
    else { const float acc = vb[c] + T2[(size_t)m * 512 + c]; v = v + (vfirst[(size_t)m * 512 + c] - v) * sigm(acc); }
    const float r = x[c], k = x[512 + c]; float kk = k * k_k[c];
    __shared__ float red[64]; red[threadIdx.x] = kk * kk; __syncthreads();
    for (int o = 32; o > 0; o >>= 1) { if (threadIdx.x < o) red[threadIdx.x] += red[threadIdx.x + o]; __syncthreads(); }
    kk = kk / fmaxf(sqrtf(red[0]), 1e-12f); const float k2 = k * (1.f + (a - 1.f) * k_a[c]);
    const size_t o = (size_t)m * 512 + c; R[o] = r; W[o] = decay; Kk[o] = k2; V[o] = v; A[o] = -kk; Bb[o] = kk * a; G[o] = g;
}
__global__ void __launch_bounds__(64) rwkv_scan(const float* R, const float* W, const float* Kk, const float* V, const float* A, const float* Bb, const float* S0, float* Sout, float* Y, int row0, int T) {
    const int seq = blockIdx.x / 8, h = blockIdx.x % 8, i = threadIdx.x; float S[64];
#pragma unroll
    for (int j = 0; j < 64; ++j) S[j] = S0 ? S0[(((size_t)seq * 8 + h) * 64 + i) * 64 + j] : 0.f;
    __shared__ float sr[16][64], sw[16][64], sk[16][64], sa[16][64], sb[16][64], sv[16][64];
    for (int t0 = 0; t0 < T; t0 += 16) { const int nt = T - t0 < 16 ? T - t0 : 16;
        __syncthreads();
        for (int tt = 0; tt < nt; ++tt) { const size_t o = ((size_t)row0 + (size_t)seq * T + t0 + tt) * 512 + h * 64 + i; sr[tt][i] = R[o]; sw[tt][i] = W[o]; sk[tt][i] = Kk[o]; sa[tt][i] = A[o]; sb[tt][i] = Bb[o]; sv[tt][i] = V[o]; }
        __syncthreads();
        for (int tt = 0; tt < nt; ++tt) { float dot = 0.f; const float v = sv[tt][i];
#pragma unroll
            for (int j = 0; j < 64; ++j) dot += S[j] * sa[tt][j];
            float y = 0.f;
#pragma unroll
            for (int j = 0; j < 64; ++j) { S[j] = S[j] * sw[tt][j] + dot * sb[tt][j] + v * sk[tt][j]; y += S[j] * sr[tt][j]; }
            Y[((size_t)row0 + (size_t)seq * T + t0 + tt) * 512 + h * 64 + i] = y; } }
#pragma unroll
    for (int j = 0; j < 64; ++j) Sout[(((size_t)seq * 8 + h) * 64 + i) * 64 + j] = S[j];
}
__global__ void __launch_bounds__(64) rwkv_post(const float* Y, const float* R, const float* Kk, const float* V, const float* G, const float* r_k, const float* lg, const float* lb, float* yout) {
    const int m = blockIdx.x / 8, h = blockIdx.x % 8, i = threadIdx.x, c = h * 64 + i; const size_t o = (size_t)m * 512 + c;
    __shared__ float red[64]; const float y = Y[o];
    red[i] = y; __syncthreads(); for (int s = 32; s > 0; s >>= 1) { if (i < s) red[i] += red[i + s]; __syncthreads(); } const float mu = red[0] / 64.f; __syncthreads();
    red[i] = (y - mu) * (y - mu); __syncthreads(); for (int s = 32; s > 0; s >>= 1) { if (i < s) red[i] += red[i + s]; __syncthreads(); } const float var = red[0] / 64.f; __syncthreads();
    red[i] = R[o] * Kk[o] * r_k[c]; __syncthreads(); for (int s = 32; s > 0; s >>= 1) { if (i < s) red[i] += red[i + s]; __syncthreads(); } const float bon = red[0];
    yout[o] = ((y - mu) * rsqrtf(var + 64e-5f) * lg[c] + lb[c] + bon * V[o]) * G[o];
}
__global__ void merge_acc(const float* z, const float* P, int goff, float* merged, int first) {
    const int i = blockIdx.x * blockDim.x + threadIdx.x; if (i >= M * D) return; const int m = i / D, n = i % D;
    const float v = sigm(z[(size_t)m * INW + OGL + goff + n]) * P[i]; merged[i] = first ? v : merged[i] + v;
}
__global__ void resid(const float* xa, const float* xb, const float* P, const float* mod, int gt_off, float* xout) {
    const int i = blockIdx.x * blockDim.x + threadIdx.x; if (i >= M * D) return; const int m = i / D, n = i % D;
    const float x = m < MP ? xa[i] : xb[(size_t)(m - MP) * D + n]; xout[i] = x + (1.f + mod[(size_t)modrow(m) * 6 * D + gt_off + n]) * P[i];
}
__global__ void swiglu(const float* gbuf, const float* ubuf, float* act, int n) { const int i = blockIdx.x * blockDim.x + threadIdx.x; if (i < n) act[i] = silu(gbuf[i]) * ubuf[i]; }

struct In { const float* p[39]; };
inline void G(hipStream_t st, const float* A, int lda, const float* B, int ldb, float* C, int ldc, int Mm, int N, int K) { gemm<<<dim3((N + 63) / 64, (Mm + 63) / 64), 256, 0, st>>>(A, lda, B, ldb, C, ldc, Mm, N, K); }
#define EW(n) ((int)(((size_t)(n) + 255) / 256)), 256, 0, st

struct WS { float *silc, *mod, *h, *z, *xm, *R, *W, *K, *V, *A, *B, *G, *Y, *vfirst, *dbuf, *cat_a, *cat_p, *cat_r, *P, *merged, *x1, *xres, *fg, *fu, *T1; };
inline size_t carve(float* base, WS& w) {
    size_t o = 0; auto take = [&](size_t n) { float* p = base + o; o += (n + 63) & ~(size_t)63; return p; };
    w.silc = take((size_t)NMOD * D); w.mod = take((size_t)NL * NMOD * 6 * D); w.T1 = take((size_t)M * 32);
    w.h = take((size_t)M * D); w.P = w.h;
    w.xm = take((size_t)M * D); w.x1 = w.xm;
    w.cat_a = take((size_t)M * 1024); w.cat_p = take((size_t)M * 512); w.cat_r = take((size_t)M * 512); w.xres = take((size_t)M * D);
    w.z = take((size_t)M * INW);
    w.R = take((size_t)M * 512); w.W = take((size_t)M * 512); w.K = take((size_t)M * 512); w.V = take((size_t)M * 512); w.A = take((size_t)M * 512); w.B = take((size_t)M * 512); w.G = take((size_t)M * 512);
    w.Y = take((size_t)M * 512); w.vfirst = take((size_t)M * 512); w.dbuf = take((size_t)M * 512);
    w.merged = w.R;
    w.fg = w.z; w.fu = w.z + (size_t)M * DFF;
    return o;
}
constexpr size_t O_YP = 0, O_YS = O_YP + (size_t)MP * D, O_KP = O_YS + (size_t)NS * D, O_VP = O_KP + (size_t)NL * NB * 128 * 256, O_PP = O_VP + (size_t)NL * NB * 128 * 256,
                 O_SP = O_PP + (size_t)NL * NB * 15 * 512, O_WP = O_SP + (size_t)NL * NB * RP, O_KS = O_WP + (size_t)NL * NB * 8 * 4096, O_VS = O_KS + (size_t)NL * NS * 128 * 256,
                 O_PS = O_VS + (size_t)NL * NS * 128 * 256, O_SS = O_PS + (size_t)NL * NS * 15 * 512, O_WS = O_SS + (size_t)NL * NS * RP, O_END = O_WS + (size_t)NL * NS * 8 * 4096;

inline void forward(const In& in, float* out, float* wsf, hipStream_t st, const dbg::Ctx* dc = nullptr) {
    using namespace dbg;
    WS w; carve(wsf, w);
    const float *xp = in.p[0], *xs = in.p[1];
    silu_c<<<EW(NMOD * D)>>>(in.p[2], in.p[3], w.silc);
    for (int l = 0; l < NL; ++l) { G(st, w.silc, D, in.p[9] + (size_t)l * D * 6 * D, 6 * D, w.mod + (size_t)l * NMOD * 6 * D, 6 * D, NMOD, 6 * D, D);
        add_bias<<<EW(NMOD * 6 * D)>>>(w.mod + (size_t)l * NMOD * 6 * D, in.p[10] + (size_t)l * 6 * D, NMOD * 6 * D, 6 * D); }
    cmp(dc, st, T_MOD, w.mod, 6 * D, 0, NL * NMOD, 6 * D);
    const float* xa = xp; const float* xb = xs;
    for (int l = 0; l < NL; ++l) {
        const float* mod = w.mod + (size_t)l * NMOD * 6 * D; const int tb = T_L0 + l * T_PER_L;
        modnorm<<<M, 256, 0, st>>>(xa, xb, in.p[11] + l * D, mod, 0, D, w.h, (size_t)MP * D);
        cmp(dc, st, tb + T_H1, w.h, D, 0, M, D);
        G(st, w.h, D, in.p[13] + (size_t)l * D * INW, INW, w.z, INW, M, INW, D);
        rope<<<EW(M * 640)>>>(w.z);
        cmp(dc, st, tb + T_Q, w.z, INW, OQ, M, 1024); cmp(dc, st, tb + T_K, w.z, INW, OK_, M, 256); cmp(dc, st, tb + T_V, w.z, INW, OV, M, 256); cmp(dc, st, tb + T_U, w.z, INW, OU, M, 512);
        cmp(dc, st, tb + T_PR, w.z, INW, OPR, M, RP); cmp(dc, st, tb + T_GT, w.z, INW, OGL, M, 6144, 1);
        const float* ck = in.p[4] + (size_t)l * NS * 128 * 256; const float* cv = in.p[5] + (size_t)l * NS * 128 * 256;
        attn_prompt<<<(MP * 16 + 63) / 64, 64, 0, st>>>(w.z, in.p[14] + l * 16, w.cat_a);
        attn_sample<<<(NS * 16 + 63) / 64, 64, 0, st>>>(w.z, in.p[14] + l * 16, ck, cv, w.cat_a);
        kv_out<<<EW(NS * 128 * 256)>>>(w.z, ck, cv, out + O_KP + (size_t)l * NB * 128 * 256, out + O_VP + (size_t)l * NB * 128 * 256, out + O_KS + (size_t)l * NS * 128 * 256, out + O_VS + (size_t)l * NS * 128 * 256);
        const float* sp = in.p[6] + (size_t)l * NS * 15 * 512;
        pool_d<<<EW(M * 512)>>>(w.z, sp, w.dbuf);
        pool_z<<<EW(M * 512)>>>(w.dbuf, in.p[16] + (size_t)l * 4 * 128 * 128, in.p[17] + l * 512, w.cat_p);
        pool_out<<<EW(NS * 15 * 512)>>>(w.z, sp, out + O_PP + (size_t)l * NB * 15 * 512, out + O_PS + (size_t)l * NS * 15 * 512);
        rwkv_xm<<<EW((size_t)M * RP)>>>(w.z, in.p[7] + (size_t)l * NS * RP, in.p[19] + l * RP, w.xm);
        shift_out<<<EW(NS * RP)>>>(w.z, out + O_SP + (size_t)l * NB * RP, out + O_SS + (size_t)l * NS * RP);
        if (l > 0) { G(st, w.xm + 1024, RP, in.p[31], 32, w.T1, 32, M, 32, 512); G(st, w.T1, 32, in.p[32], 512, w.dbuf, 512, M, 512, 32); }
        if (l > 0) { cmp(dc, st, 59, w.dbuf, 512, 0, M, 512); cmp(dc, st, 60, w.T1, 32, 0, M, 32); }
        rwkv_prep<<<M * 8, 64, 0, st>>>(w.xm, in.p[20] + l * 512, in.p[21] + (size_t)l * 96 * 512, in.p[22] + l * 512, in.p[23] + (size_t)l * 96 * 512, in.p[24] + (size_t)l * 256 * 512, in.p[25] + l * 512, in.p[26] + l * 512,
                                         w.dbuf, in.p[33], w.vfirst, l > 0, w.R, w.W, w.K, w.V, w.A, w.B, w.G);
        cmp(dc, st, tb + T_OA, w.cat_a, 1024, 0, M, 1024); cmp(dc, st, tb + T_ZP, w.cat_p, 512, 0, M, 512);
        cmp(dc, st, tb + T_R, w.R, 512, 0, M, 512); cmp(dc, st, tb + T_W, w.W, 512, 0, M, 512); cmp(dc, st, tb + T_KK, w.K, 512, 0, M, 512); cmp(dc, st, tb + T_VV, w.V, 512, 0, M, 512);
        cmp(dc, st, tb + T_A, w.A, 512, 0, M, 512); cmp(dc, st, tb + T_B, w.B, 512, 0, M, 512); cmp(dc, st, tb + T_G, w.G, 512, 0, M, 512);
        rwkv_scan<<<NB * 8, 64, 0, st>>>(w.R, w.W, w.K, w.V, w.A, w.B, nullptr, out + O_WP + (size_t)l * NB * 8 * 4096, w.Y, 0, SEQ);
        rwkv_scan<<<NS * 8, 64, 0, st>>>(w.R, w.W, w.K, w.V, w.A, w.B, in.p[8] + (size_t)l * NS * 8 * 4096, out + O_WS + (size_t)l * NS * 8 * 4096, w.Y, MP, 1);
        cmp(dc, st, tb + T_Y, w.Y, 512, 0, M, 512);
        rwkv_post<<<M * 8, 64, 0, st>>>(w.Y, w.R, w.K, w.V, w.G, in.p[27] + l * 512, in.p[28] + l * 512, in.p[29] + l * 512, w.cat_r);
        cmp(dc, st, tb + T_YR, w.cat_r, 512, 0, M, 512);
        G(st, w.cat_a, 1024, in.p[15] + (size_t)l * 1024 * D, D, w.P, D, M, D, 1024); merge_acc<<<EW((size_t)M * D)>>>(w.z, w.P, 0, w.merged, 1);
        G(st, w.cat_p, 512, in.p[18] + (size_t)l * 512 * D, D, w.P, D, M, D, 512);   merge_acc<<<EW((size_t)M * D)>>>(w.z, w.P, D, w.merged, 0);
        G(st, w.cat_r, 512, in.p[30] + (size_t)l * 512 * D, D, w.P, D, M, D, 512);   merge_acc<<<EW((size_t)M * D)>>>(w.z, w.P, 2 * D, w.merged, 0);
        cmp(dc, st, tb + T_MG, w.merged, D, 0, M, D);
        G(st, w.merged, D, in.p[34] + (size_t)l * D * D, D, w.P, D, M, D, D);
        resid<<<EW((size_t)M * D)>>>(xa, xb, w.P, mod, 2 * D, w.x1);
        cmp(dc, st, tb + T_X1, w.x1, D, 0, M, D);
        modnorm<<<M, 256, 0, st>>>(w.x1, w.x1 + (size_t)MP * D, in.p[12] + l * D, mod, 3 * D, 4 * D, w.h, (size_t)MP * D);
        cmp(dc, st, tb + T_H2, w.h, D, 0, M, D);
        G(st, w.h, D, in.p[35] + (size_t)l * D * DFF, DFF, w.fg, DFF, M, DFF, D);
        G(st, w.h, D, in.p[36] + (size_t)l * D * DFF, DFF, w.fu, DFF, M, DFF, D);
        swiglu<<<EW((size_t)M * DFF)>>>(w.fg, w.fu, w.fg, M * DFF);
        cmp(dc, st, tb + T_ACT, w.fg, DFF, 0, M, DFF);
        G(st, w.fg, DFF, in.p[37] + (size_t)l * DFF * D, D, w.P, D, M, D, DFF);
        resid<<<EW((size_t)M * D)>>>(w.x1, w.x1 + (size_t)MP * D, w.P, mod, 5 * D, w.xres);
        cmp(dc, st, tb + T_X2, w.xres, D, 0, M, D);
        xa = w.xres; xb = w.xres + (size_t)MP * D;
    }
    modnorm<<<M, 256, 0, st>>>(xa, xb, in.p[38], nullptr, 0, 0, out + O_YP, (size_t)MP * D);
}
#undef EW
}
namespace mk {
#define LAS __attribute__((address_space(3)))
#define GAS __attribute__((address_space(1)))
typedef unsigned short bf16;
typedef short bf16x8 __attribute__((ext_vector_type(8)));
typedef float f32x4 __attribute__((ext_vector_type(4)));
typedef float f32x2 __attribute__((ext_vector_type(2)));
typedef unsigned u32x4 __attribute__((ext_vector_type(4)));
typedef unsigned u32x2 __attribute__((ext_vector_type(2)));

constexpr int D = 2048, SEQ = 4096, NB = 2, MP = NB * SEQ, NS = 128, M = MP + NS, MPAD = 8448, NL = 2, NMOD = NB + NS;
constexpr int NIN = 10240, NGU = 11264, DFF = 5632, NADA = 6 * D, RP = 1984, PASTLEN = 8192;
constexpr int NWAVES = 8, NTHR = 512;

constexpr size_t al(size_t x) { return (x + 255) & ~(size_t)255; }
constexpr size_t WL_IN = 0, WL_CAT = WL_IN + al((size_t)NIN * D * 2), WL_O = WL_CAT + al((size_t)D * D * 2), WL_GU = WL_O + al((size_t)D * D * 2), WL_DN = WL_GU + al((size_t)NGU * D * 2),
                 WL_W2 = WL_DN + al((size_t)D * DFF * 2), WL_A2 = WL_W2 + al(512 * 96 * 2), WL_G2 = WL_A2 + al(512 * 96 * 2), WL_V1 = WL_G2 + al(512 * 256 * 2), WL_V2 = WL_V1 + al(32 * 512 * 2),
                 WL_PW = WL_V2 + al(512 * 32 * 2), WL_SIZE = WL_PW + al(4 * 128 * 128 * 2);
constexpr size_t WS_W = 0;
constexpr size_t WS_ROPE = WS_W + 2 * WL_SIZE;
constexpr size_t WS_SILC = WS_ROPE + al((size_t)4097 * 64 * 4);
constexpr size_t WS_MOD = WS_SILC + al((size_t)256 * D * 2);
constexpr size_t WS_X = WS_MOD + al((size_t)NL * NMOD * NADA * 4);
constexpr size_t WS_H = WS_X + al((size_t)MPAD * D * 4);
constexpr size_t WS_Q = WS_H + al((size_t)MPAD * D * 2);
constexpr size_t WS_K = WS_Q + al((size_t)MPAD * 1024 * 2);
constexpr size_t WS_V = WS_K + al((size_t)MPAD * 256 * 2);
constexpr size_t WS_U = WS_V + al((size_t)MPAD * 256 * 2);
constexpr size_t WS_PR = WS_U + al((size_t)MPAD * 512 * 4);
constexpr size_t WS_MG = WS_PR;
constexpr size_t WS_CAT = WS_PR + al((size_t)MPAD * D * 4);
constexpr size_t WS_RW = WS_CAT + al((size_t)MPAD * D * 2);
constexpr size_t RW_STRIDE = al((size_t)MPAD * 512 * 4);
constexpr size_t WS_GT = WS_RW + 9 * RW_STRIDE;
constexpr size_t WS_ADAW = WS_GT;
constexpr size_t WS_SLAB = WS_GT + al((size_t)MPAD * 6144 * 2);
constexpr size_t WS_SLABM = WS_SLAB + al((size_t)11 * NS * D * 4);
constexpr size_t WS_CTL = WS_SLABM + al((size_t)4 * NS * D * 4);
constexpr size_t WS_CTL_BYTES = 32768;
constexpr size_t WS_END = WS_CTL + WS_CTL_BYTES;
static_assert((size_t)2 * NADA * D * 2 <= (size_t)MPAD * 6144 * 2, "ada weights fit under the gates");

constexpr size_t O_YP = 0, O_YS = O_YP + (size_t)MP * D, O_KP = O_YS + (size_t)NS * D, O_VP = O_KP + (size_t)NL * NB * 128 * 256, O_PP = O_VP + (size_t)NL * NB * 128 * 256,
                 O_SP = O_PP + (size_t)NL * NB * 15 * 512, O_WP = O_SP + (size_t)NL * NB * RP, O_KS = O_WP + (size_t)NL * NB * 8 * 4096, O_VS = O_KS + (size_t)NL * NS * 128 * 256,
                 O_PS = O_VS + (size_t)NL * NS * 128 * 256, O_SS = O_PS + (size_t)NL * NS * 15 * 512, O_WS = O_SS + (size_t)NL * NS * RP, O_END = O_WS + (size_t)NL * NS * 8 * 4096;

__device__ __forceinline__ unsigned f2bf(float f) { unsigned u = __builtin_bit_cast(unsigned, f); return (u + 0x7fffu + ((u >> 16) & 1u)) >> 16; }
__device__ __forceinline__ unsigned pk2(float lo, float hi) { return f2bf(lo) | (f2bf(hi) << 16); }
__device__ __forceinline__ float bf2f(unsigned short b) { return __builtin_bit_cast(float, (unsigned)b << 16); }
__device__ __forceinline__ float bflo(unsigned w) { return __builtin_bit_cast(float, w << 16); }
__device__ __forceinline__ float bfhi(unsigned w) { return __builtin_bit_cast(float, w & 0xffff0000u); }
__device__ __forceinline__ float fsigm(float x) { return __builtin_amdgcn_rcpf(1.f + __expf(-x)); }
__device__ __forceinline__ float wave_sum(float v) {
#pragma unroll
    for (int o = 1; o < 64; o <<= 1) v += __shfl_xor(v, o);
    return v;
}
__device__ __forceinline__ int modrow(int m) { return m < MP ? (m >> 12) : NB + (m - MP); }
__device__ __forceinline__ int posidx(int m) { return m < MP ? (m & (SEQ - 1)) : 4096; }
__device__ __forceinline__ int pi_d(int p) { return 32 * ((p >> 2) & 1) + 16 * (p >> 5) + 4 * ((p >> 3) & 3) + (p & 3); }

struct Args { const float* in[39]; float* out; unsigned char* ws; int ph_lo, ph_hi; };

struct Frame {
    LAS unsigned char* lds;
    int tid, lane, wave, G, bid;
    float* out; unsigned char* ws;
};
template <int K> __device__ __forceinline__ const float* inp() { GAS const float* p; asm volatile("s_load_dwordx2 %0, %1, %2\n\ts_waitcnt lgkmcnt(0)" : "=s"(p) : "s"(__builtin_amdgcn_kernarg_segment_ptr()), "n"(K * 8) : "memory"); return (const float*)p; }
#define INP(k) inp<k>()
__device__ __forceinline__ unsigned char* wl(const Frame& F, int l, size_t off) { return F.ws + WS_W + (size_t)l * WL_SIZE + off; }
__device__ __forceinline__ float* rwbuf(const Frame& F, int i) { return (float*)(F.ws + WS_RW + (size_t)i * RW_STRIDE); }
enum { RW_R = 0, RW_W, RW_K, RW_V, RW_A, RW_B, RW_G, RW_Y, RW_VF };

struct TSrc { const float* w; long long d2; int ld; int mode; };
__device__ __forceinline__ const float* colsrc(const TSrc& s, int n) {
    if (s.mode == 0) return s.w + n;
    if (s.mode == 1) {
        if (n < 1280) { const int h = n >> 6, p = n & 63; return s.w + h * 64 + pi_d(p); }
        if (n < 4032) return s.w + n;
        if (n < 4096) return nullptr;
        return s.w + (n - 64);
    }
      { const int g8 = n >> 3, i = n & 7; return (const float*)((const char*)s.w + (i < 4 ? 0ll : s.d2)) + 4 * g8 + (i & 3); }
}
__device__ __forceinline__ void titem_load(const TSrc& s, int kb, int nb, int lane, f32x4 (&v)[16]) {
    const int k0 = 64 * kb, n0 = 64 * nb, gq = lane & 15, kr = lane >> 4;
    const float* cp = colsrc(s, n0 + 4 * gq);
#pragma unroll
    for (int i = 0; i < 16; ++i) { const int kk = 4 * i + kr; v[i] = cp ? *(const f32x4*)(cp + (size_t)(k0 + kk) * s.ld) : (f32x4){0.f, 0.f, 0.f, 0.f}; }
}
__device__ __forceinline__ void titem_store(const f32x4 (&v)[16], bf16* WT, size_t ldt, int kcol0, LAS float* scr, int kb, int nb, int lane) {
    const int k0 = 64 * kb, n0 = 64 * nb, gq = lane & 15, kr = lane >> 4;
#pragma unroll
    for (int i = 0; i < 16; ++i) { const int kk = 4 * i + kr; LAS float* d = scr + kk * 65 + 4 * gq; d[0] = v[i].x; d[1] = v[i].y; d[2] = v[i].z; d[3] = v[i].w; }
    asm volatile("s_waitcnt lgkmcnt(0)" ::: "memory");
    const int c = lane & 7;
#pragma unroll
    for (int j = 0; j < 8; ++j) { const int n = (lane >> 3) + 8 * j; const LAS float* p = scr + (8 * c) * 65 + n;
        u32x4 o; o.x = pk2(p[0 * 65], p[1 * 65]); o.y = pk2(p[2 * 65], p[3 * 65]); o.z = pk2(p[4 * 65], p[5 * 65]); o.w = pk2(p[6 * 65], p[7 * 65]);
        *(u32x4*)(WT + (size_t)(n0 + n) * ldt + kcol0 + k0 + 8 * c) = o; }
    asm volatile("s_waitcnt lgkmcnt(0)" ::: "memory");
}
__device__ __forceinline__ void small_transpose(const float* src, int K, int N, bf16* dst, int ldt, int gt, int ngt) {
    for (int i = gt; i < N * K; i += ngt) { const int n = i / K, k = i - n * K; dst[(size_t)n * ldt + k] = (bf16)f2bf(src[(size_t)k * N + n]); }
}
__device__ __forceinline__ void p0_prologue(const Frame& F, int lmask, bool common, int wb, int nwb, int cls) {
    LAS float* scr = (LAS float*)(F.lds + F.wave * 16640);
    const int gw = wb * NWAVES + F.wave, NGW = nwb * NWAVES;
    constexpr int J_ADA = 32 * 192, J_IN = 32 * 160, J_CA = 16 * 32, J_CP = 8 * 32, J_CR = 8 * 32, J_O = 32 * 32, J_GU = 32 * 176, J_DN = 88 * 32;
    constexpr int PER_L = J_ADA + J_IN + J_CA + J_CP + J_CR + J_O + J_GU + J_DN;
    constexpr int TOT = NL * PER_L; const int nrk = cls == 0 ? TOT : cls == 1 ? (TOT / 32) * 27 + (TOT % 32 < 27 ? TOT % 32 : 27) : (TOT / 32) * 5 + (TOT % 32 > 27 ? TOT % 32 - 27 : 0);
    auto item = [&](int rk, TSrc& s, bf16*& WT, size_t& ldt, int& kcol0, int& kb, int& nb) -> bool {
        const int it = cls == 0 ? rk : cls == 1 ? (rk / 27) * 32 + rk % 27 : (rk / 5) * 32 + 27 + rk % 5;
        const int l = it / PER_L; int r = it - l * PER_L;
        if (r < J_ADA ? !common : !((lmask >> (l + (r >= J_ADA + J_IN ? 2 : 0))) & 1)) return false;
        s.d2 = 0; s.mode = 0; int nn; kcol0 = 0;
        if (r < J_ADA) { s.w = INP(9) + (size_t)l * D * NADA; s.ld = NADA; WT = (bf16*)(F.ws + WS_ADAW) + (size_t)l * NADA * D; ldt = D; nn = 192; }
        else if ((r -= J_ADA) < J_IN) { s.w = INP(13) + (size_t)l * D * 10176; s.ld = 10176; s.mode = 1; WT = (bf16*)wl(F, l, WL_IN); ldt = D; nn = 160; }
        else if ((r -= J_IN) < J_CA) { s.w = INP(15) + (size_t)l * 1024 * D; s.ld = D; WT = (bf16*)wl(F, l, WL_CAT); ldt = D; nn = 32; }
        else if ((r -= J_CA) < J_CP) { s.w = INP(18) + (size_t)l * 512 * D; s.ld = D; WT = (bf16*)wl(F, l, WL_CAT); ldt = D; nn = 32; kcol0 = 1024; }
        else if ((r -= J_CP) < J_CR) { s.w = INP(30) + (size_t)l * 512 * D; s.ld = D; WT = (bf16*)wl(F, l, WL_CAT); ldt = D; nn = 32; kcol0 = 1536; }
        else if ((r -= J_CR) < J_O) { s.w = INP(34) + (size_t)l * D * D; s.ld = D; WT = (bf16*)wl(F, l, WL_O); ldt = D; nn = 32; }
        else if ((r -= J_O) < J_GU) { s.w = INP(35) + (size_t)l * D * DFF; s.d2 = (const char*)INP(36) - (const char*)INP(35); s.ld = DFF; s.mode = 2; WT = (bf16*)wl(F, l, WL_GU); ldt = D; nn = 176; }
        else { r -= J_GU; s.w = INP(37) + (size_t)l * DFF * D; s.ld = D; WT = (bf16*)wl(F, l, WL_DN); ldt = DFF; nn = 32; }
        kb = r / nn; nb = r % nn; return true; };
    {   f32x4 vc[16], vn[16]; TSrc s; bf16* WTc = nullptr; size_t ldc = 0; int kcc = 0, kbc = 0, nbc = 0; bool have = false; int rk = gw;
        for (; rk < nrk && !have; rk += NGW) { have = item(rk, s, WTc, ldc, kcc, kbc, nbc); if (have) titem_load(s, kbc, nbc, F.lane, vc); }
        while (have) { bf16* WTn = nullptr; size_t ldn = 0; int kcn = 0, kbn = 0, nbn = 0; bool hn = false;
            for (; rk < nrk && !hn; rk += NGW) { hn = item(rk, s, WTn, ldn, kcn, kbn, nbn); if (hn) titem_load(s, kbn, nbn, F.lane, vn); }
            asm volatile("" ::: "memory"); __builtin_amdgcn_sched_barrier(0);
            titem_store(vc, WTc, ldc, kcc, scr, kbc, nbc, F.lane);
            asm volatile("" ::: "memory"); __builtin_amdgcn_sched_barrier(0);
            have = hn; WTc = WTn; ldc = ldn; kcc = kcn; kbc = kbn; nbc = nbn;
#pragma unroll
            for (int i = 0; i < 16; ++i) vc[i] = vn[i]; } }
    const int gt = wb * NTHR + F.tid, ngt = nwb * NTHR;
    for (int l = 0; l < NL; ++l) { if (!((lmask >> l) & 1)) continue;
        small_transpose(INP(21) + (size_t)l * 96 * 512, 96, 512, (bf16*)wl(F, l, WL_W2), 96, gt, ngt);
        small_transpose(INP(23) + (size_t)l * 96 * 512, 96, 512, (bf16*)wl(F, l, WL_A2), 96, gt, ngt);
        small_transpose(INP(24) + (size_t)l * 256 * 512, 256, 512, (bf16*)wl(F, l, WL_G2), 256, gt, ngt);
        for (int g = 0; g < 4; ++g) small_transpose(INP(16) + ((size_t)l * 4 + g) * 128 * 128, 128, 128, (bf16*)wl(F, l, WL_PW) + g * 128 * 128, 128, gt, ngt);
    }
    if (lmask & 2) { small_transpose(INP(31), 512, 32, (bf16*)wl(F, 1, WL_V1), 512, gt, ngt);
        small_transpose(INP(32), 32, 512, (bf16*)wl(F, 1, WL_V2), 32, gt, ngt); }
    if (!common) return;
    if (wb == 0 && F.tid < 2) ((unsigned*)(F.ws + WS_CTL))[64 * F.tid] = 0u;
    for (int i0 = gt; i0 < 256 * D; i0 += 4 * ngt) { float cv[4];
#pragma unroll
        for (int q = 0; q < 4; ++q) { const int i = i0 + q * ngt, r = i >> 11, k = i & (D - 1); cv[q] = 0.f; if (i < 256 * D && r < NMOD) cv[q] = r < NB ? INP(2)[r * D + k] : INP(3)[(r - NB) * D + k]; }
        asm volatile("" ::: "memory"); __builtin_amdgcn_sched_barrier(0);
#pragma unroll
        for (int q = 0; q < 4; ++q) { const int i = i0 + q * ngt; if (i < 256 * D) { const float c = cv[q]; ((bf16*)(F.ws + WS_SILC))[i] = (bf16)f2bf(c / (1.f + expf(-c))); } } }
    for (int i = gt; i < 4097 * 32; i += ngt) { const int p = i >> 5, d = i & 31; const float pos = p < 4096 ? (float)p : (float)PASTLEN;
        const float inv = powf(10000.f, -(float)d * (2.0f / 64.f)), ang = pos * inv; float* t = (float*)(F.ws + WS_ROPE) + (size_t)p * 64; t[d] = cosf(ang); t[32 + d] = sinf(ang); }
}

__device__ __forceinline__ void norm_phase(const Frame& F, int l, int which  , int nslab  ) {
    const int gw = F.bid * NWAVES + F.wave, NGW = F.G * NWAVES;
    const float* g = which == 0 ? INP(11) + l * D : which == 1 ? INP(12) + l * D : INP(38); const float* xp0 = INP(0); const float* xp1 = INP(1);
    const int mend = nslab ? MP : M;
    if (nslab) {
        for (int s_ = F.bid; s_ < NS; s_ += F.G) { const int m = MP + s_, c = F.wave * 256 + F.lane * 4;
            float* xs = (float*)(F.ws + WS_X) + (size_t)m * D + c; const float* sl = (const float*)(F.ws + WS_SLAB) + (size_t)s_ * D + c;
            const float* mod = (const float*)(F.ws + WS_MOD) + ((size_t)l * NMOD + modrow(m)) * NADA + (which == 0 ? 0 : 3 * D) + c;
            f32x4 sv[11]; f32x4 v = *(const f32x4*)xs; const f32x4 gv = *(const f32x4*)(g + c); f32x4 shv = gv, scv = gv; if (which != 2) { shv = *(const f32x4*)mod; scv = *(const f32x4*)(mod + D); }
#pragma unroll
            for (int q = 0; q < 11; ++q) { sv[q] = (f32x4){0.f, 0.f, 0.f, 0.f}; if (q < nslab) sv[q] = *(const f32x4*)(sl + (size_t)q * NS * D); }
            asm volatile("" ::: "memory"); __builtin_amdgcn_sched_barrier(0);
#pragma unroll
            for (int q = 0; q < 11; ++q) v += sv[q];
            *(f32x4*)xs = v;
            const float ps = wave_sum((v.x * v.x + v.y * v.y) + (v.z * v.z + v.w * v.w));
            __syncthreads(); if (F.lane == 0) ((LAS float*)F.lds)[F.wave] = ps; __syncthreads();
            float tot = 0.f;
#pragma unroll
            for (int j = 0; j < NWAVES; ++j) tot += ((LAS const float*)F.lds)[j];
            const float rs = rsqrtf(tot * (1.f / D) + 1e-6f);
            if (which == 2) *(f32x4*)(F.out + O_YP + (size_t)m * D + c) = v * rs * gv;
            else { const f32x4 y = v * rs * gv * (scv + 1.f) + shv; u32x2 w; w.x = pk2(y.x, y.y); w.y = pk2(y.z, y.w); *(u32x2*)((bf16*)(F.ws + WS_H) + (size_t)m * D + c) = w; } } }
    for (int m = gw; m < mend; m += NGW) {
        const float* xr = (which == 0 && l == 0) ? (m < MP ? xp0 + (size_t)m * D : xp1 + (size_t)(m - MP) * D) : (const float*)(F.ws + WS_X) + (size_t)m * D;
        f32x4 v[8], gv[8], shv[8], scv[8]; float s = 0.f;
        const float* mod = (const float*)(F.ws + WS_MOD) + ((size_t)l * NMOD + modrow(m)) * NADA + (which == 0 ? 0 : 3 * D);
#pragma unroll
        for (int j = 0; j < 8; ++j) { v[j] = *(const f32x4*)(xr + j * 256 + F.lane * 4); gv[j] = *(const f32x4*)(g + j * 256 + F.lane * 4);
            if (which != 2) { shv[j] = *(const f32x4*)(mod + j * 256 + F.lane * 4); scv[j] = *(const f32x4*)(mod + D + j * 256 + F.lane * 4); } else { shv[j] = gv[j]; scv[j] = gv[j]; } }
#pragma unroll
        for (int j = 0; j < 8; ++j) { s += (v[j].x * v[j].x + v[j].y * v[j].y) + (v[j].z * v[j].z + v[j].w * v[j].w); }
        const float rs = rsqrtf(wave_sum(s) * (1.f / D) + 1e-6f);
        if (which == 0 && l == 0 && m >= MP) { float* xs = (float*)(F.ws + WS_X) + (size_t)m * D;
#pragma unroll
            for (int j = 0; j < 8; ++j) *(f32x4*)(xs + j * 256 + F.lane * 4) = v[j]; }
        if (which == 2) { float* o = F.out + O_YP + (size_t)m * D;
#pragma unroll
            for (int j = 0; j < 8; ++j) *(f32x4*)(o + j * 256 + F.lane * 4) = v[j] * rs * gv[j]; }
        else { bf16* o = (bf16*)(F.ws + WS_H) + (size_t)m * D;
#pragma unroll
            for (int j = 0; j < 8; ++j) { const int c = j * 256 + F.lane * 4; const f32x4 y = v[j] * rs * gv[j] * (scv[j] + 1.f) + shv[j]; u32x2 w; w.x = pk2(y.x, y.y); w.y = pk2(y.z, y.w); *(u32x2*)(o + c) = w; } }
    }
}
}
#ifdef MK_TS_ID
#ifndef MK_TS_BLOCK
#define MK_TS_BLOCK 0
#endif
#define TSB2(id, ldsp) do { if ((id) == MK_TS_ID && blockIdx.x == MK_TS_BLOCK && threadIdx.x == 0) *(volatile __attribute__((address_space(3))) unsigned*)((ldsp) + 135168 - 64) -= (unsigned)__builtin_amdgcn_s_memrealtime(); } while (0)
#define TSE2(id, ldsp) do { if ((id) == MK_TS_ID && blockIdx.x == MK_TS_BLOCK && threadIdx.x == 0) *(volatile __attribute__((address_space(3))) unsigned*)((ldsp) + 135168 - 64) += (unsigned)__builtin_amdgcn_s_memrealtime(); } while (0)
#else
#define TSB2(id, ldsp) do {} while (0)
#define TSE2(id, ldsp) do {} while (0)
#endif
namespace mk {
constexpr int BM = 256, BK = 64, HALF = 128, HTB = HALF * BK * 2, STAGE_BYTES = 8 * HTB, NXCD = 8, WGM = 8;
__device__ __forceinline__ int lds_byte(int r, int c) { const int st = (r >> 4) * 2 + (c >> 5), rr = r & 15, cc = c & 31, ob = rr * 64 + cc * 2; return st * 1024 + (ob ^ (((ob >> 9) & 1) << 5)); }
__device__ __forceinline__ void stage_rc(int b, int& R, int& C) { const int st = b / 1024, sb = b % 1024, swz = sb ^ (((sb >> 9) & 1) << 5); R = (st >> 1) * 16 + swz / 64; C = (st & 1) * 32 + (swz % 64) / 2; }
__device__ __forceinline__ int perm32(int rho) { const int n = rho >> 4, i = rho & 15; return 8 * (i >> 2) + 4 * n + (i & 3); }

struct Unit { int pm, pn, seg; };
enum { G_ADA = 0, G_IN, G_MG, G_WO, G_GU, G_DN };
struct Gemm { const bf16* A; const bf16* Bt; int ld, M, N, K, mode, layer; };

struct Rect { int pm0, nM, pn0, nN; };
struct Sched {
    Rect ra, rb; int G, c, nseg, ksb;
    __device__ __forceinline__ void init(const Rect& a, const Rect& b, int G_, int c_, int nseg_, int ksb_ = 0) { ra = a; rb = b; G = G_; c = c_; nseg = nseg_; ksb = ksb_; }
    __device__ __forceinline__ bool next(int i, Unit& u) const {
        const int ti = i / nseg, seg = i - ti * nseg, nA = ra.nM * ra.nN, nB = rb.nM * rb.nN;
        const long L = (long)ti * G + c; if (L >= nA + nB) return false;
        const bool inA = L < nA; const int pm0 = inA ? ra.pm0 : rb.pm0, nM = inA ? ra.nM : rb.nM, pn0 = inA ? ra.pn0 : rb.pn0, nN = inA ? ra.nN : rb.nN, nwg = nM * nN;
        int wgid = inA ? (int)L : (int)L - nA; { const int q = nwg / NXCD, r = nwg % NXCD, xcd = wgid % NXCD, off = wgid / NXCD; wgid = (xcd < r ? xcd * (q + 1) : r * (q + 1) + (xcd - r) * q) + off; }
        const int nig = WGM * nN, gid = wgid / nig, fm = gid * WGM, gsz = (nM - fm) < WGM ? (nM - fm) : WGM;
        u.pm = pm0 + fm + ((wgid % nig) % gsz); u.pn = pn0 + (wgid % nig) / gsz; u.seg = seg;
        if (!inA && ksb > 0) { const int q = u.pn - pn0; u.seg = q / ksb; u.pn = pn0 + q % ksb; }
        return true;
    }
};

typedef __bf16 bf16x2_t __attribute__((ext_vector_type(2)));
__device__ __forceinline__ unsigned cvt_pk_bf16(float lo, float hi) { const f32x2 v = {lo, hi}; const bf16x2_t b = __builtin_convertvector(v, bf16x2_t); return __builtin_bit_cast(unsigned, b); }
__device__ __forceinline__ f32x4 sig4(f32x4 v) { f32x4 r; r.x = fsigm(v.x); r.y = fsigm(v.y); r.z = fsigm(v.z); r.w = fsigm(v.w); return r; }

__device__ __forceinline__ float gclamp(float g) { return fmaxf(g, 1e-18f); }
struct Epi {
    const Frame* F; int mode, layer;
    __device__ __forceinline__ void rescale(f32x4 (&acc)[2][2][4][2], const Unit& u, int sp, int wr, int wc, int fr, int fq) const {
        int row0 = u.pm * BM + wr * 64 + fr; asm volatile("" : "+v"(row0)); const int c0 = u.pn * BM + wc * 32 + 8 * fq; const bf16* gt = (const bf16*)(F->ws + WS_GT) + sp * D + c0;
#pragma unroll
        for (int ai = 0; ai < 2; ++ai) { u32x4 ga[4][2], gb[4][2];
#pragma unroll
            for (int m = 0; m < 4; ++m) { const int r = row0 + ai * HALF + m * 16; const int rr = r < M ? r : M - 1;
#pragma unroll
                for (int bj = 0; bj < 2; ++bj) { ga[m][bj] = *(const u32x4*)(gt + (size_t)rr * 6144 + bj * HALF); gb[m][bj] = *(const u32x4*)(gt + (size_t)rr * 6144 + D + bj * HALF); } }
            asm volatile("" ::: "memory"); __builtin_amdgcn_sched_barrier(0);
#pragma unroll
            for (int m = 0; m < 4; ++m)
#pragma unroll
                for (int bj = 0; bj < 2; ++bj) { const u32x4 a_ = ga[m][bj], b_ = gb[m][bj];
                    f32x4& v0 = acc[ai][bj][m][0]; f32x4& v1 = acc[ai][bj][m][1];
                    v0.x *= gclamp(bflo(a_.x)) * __builtin_amdgcn_rcpf(gclamp(bflo(b_.x))); v0.y *= gclamp(bfhi(a_.x)) * __builtin_amdgcn_rcpf(gclamp(bfhi(b_.x)));
                    v0.z *= gclamp(bflo(a_.y)) * __builtin_amdgcn_rcpf(gclamp(bflo(b_.y))); v0.w *= gclamp(bfhi(a_.y)) * __builtin_amdgcn_rcpf(gclamp(bfhi(b_.y)));
                    v1.x *= gclamp(bflo(a_.z)) * __builtin_amdgcn_rcpf(gclamp(bflo(b_.z))); v1.y *= gclamp(bfhi(a_.z)) * __builtin_amdgcn_rcpf(gclamp(bfhi(b_.z)));
                    v1.z *= gclamp(bflo(a_.w)) * __builtin_amdgcn_rcpf(gclamp(bflo(b_.w))); v1.w *= gclamp(bfhi(a_.w)) * __builtin_amdgcn_rcpf(gclamp(bfhi(b_.w))); }
            asm volatile("" ::: "memory"); __builtin_amdgcn_sched_barrier(0); }
    }
    __device__ __forceinline__ void operator()(const f32x4 (&acc)[2][2][4][2], const Unit& u, int wr, int wc, int fr, int fq) const {
        const Frame& Fr = *F; const int l = layer;
        int row0 = u.pm * BM + wr * 64 + fr; const int colb = u.pn * BM + wc * 32 + 8 * fq;
        asm volatile("" : "+v"(row0));
        unsigned char* ws = Fr.ws;
        if (mode == G_ADA) {
            const float* ab = INP(10);
#pragma unroll
            for (int ai = 0; ai < 2; ++ai)
#pragma unroll
                for (int m = 0; m < 4; ++m) { const int r = row0 + ai * HALF + m * 16; if (r < NMOD) {
#pragma unroll
                    for (int bj = 0; bj < 2; ++bj) { const int c = colb + bj * HALF, ll = c / NADA, j = c - ll * NADA; float* o = (float*)(ws + WS_MOD) + ((size_t)ll * NMOD + r) * NADA + j;
                        *(f32x4*)o = acc[ai][bj][m][0] + *(const f32x4*)(ab + c); *(f32x4*)(o + 4) = acc[ai][bj][m][1] + *(const f32x4*)(ab + c + 4); } } }
        } else if (mode == G_IN) {
            const int pn = u.pn;
            if (pn < 5) {
                const int wp = wc & 1; const float* rt = (const float*)(ws + WS_ROPE);
#pragma unroll
                for (int ai = 0; ai < 2; ++ai) { f32x4 csv[4], snv[4];
#pragma unroll
                    for (int m = 0; m < 4; ++m) { const int r = row0 + ai * HALF + m * 16, rr = r < M ? r : M - 1; const float* tp = rt + (size_t)posidx(rr) * 64 + 16 * wp + 4 * fq; csv[m] = *(const f32x4*)tp; snv[m] = *(const f32x4*)(tp + 32); }
                    asm volatile("" ::: "memory"); __builtin_amdgcn_sched_barrier(0);
#pragma unroll
                    for (int m = 0; m < 4; ++m) { const int r = row0 + ai * HALF + m * 16; if (r < M) {
                        const f32x4 cs = csv[m], sn = snv[m];
#pragma unroll
                        for (int bj = 0; bj < 2; ++bj) { const f32x4 x1 = acc[ai][bj][m][0], x2 = acc[ai][bj][m][1]; const f32x4 o1 = x1 * cs - x2 * sn, o2 = x2 * cs + x1 * sn;
                            u32x4 w; w.x = cvt_pk_bf16(o1.x, o1.y); w.y = cvt_pk_bf16(o1.z, o1.w); w.z = cvt_pk_bf16(o2.x, o2.y); w.w = cvt_pk_bf16(o2.z, o2.w);
                            const int hc = bj * HALF + wc * 32 + 8 * fq;
                            if (pn < 4) *(u32x4*)((bf16*)(ws + WS_Q) + (size_t)r * 1024 + pn * 256 + hc) = w;
                            else { *(u32x4*)((bf16*)(ws + WS_K) + (size_t)r * 256 + hc) = w;
                                const int hk = hc >> 6, d1 = 16 * wp + 4 * fq; float* ko = nullptr;
                                if (r < MP) { const int t = r & (SEQ - 1); if (t >= SEQ - 128) ko = Fr.out + O_KP + ((((size_t)l * NB + (r >> 12)) * 128 + (t - (SEQ - 128))) * 4 + hk) * 64; }
                                else ko = Fr.out + O_KS + ((((size_t)l * NS + (r - MP)) * 128 + 127) * 4 + hk) * 64;
                                if (ko) { *(f32x4*)(ko + d1) = o1; *(f32x4*)(ko + d1 + 32) = o2; } } } } }
                    asm volatile("" ::: "memory"); __builtin_amdgcn_sched_barrier(0); }
            } else if (pn == 5) {
#pragma unroll
                for (int ai = 0; ai < 2; ++ai)
#pragma unroll
                    for (int m = 0; m < 4; ++m) { const int r = row0 + ai * HALF + m * 16; if (r < M) {
#pragma unroll
                        for (int bj = 0; bj < 2; ++bj) { const f32x4 v0 = acc[ai][bj][m][0], v1 = acc[ai][bj][m][1]; const int hc = bj * HALF + wc * 32 + 8 * fq;
                            u32x4 w; w.x = cvt_pk_bf16(v0.x, v0.y); w.y = cvt_pk_bf16(v0.z, v0.w); w.z = cvt_pk_bf16(v1.x, v1.y); w.w = cvt_pk_bf16(v1.z, v1.w);
                            *(u32x4*)((bf16*)(ws + WS_V) + (size_t)r * 256 + hc) = w;
                            float* vo = nullptr;
                            if (r < MP) { const int t = r & (SEQ - 1); if (t >= SEQ - 128) vo = Fr.out + O_VP + (((size_t)l * NB + (r >> 12)) * 128 + (t - (SEQ - 128))) * 256; }
                            else vo = Fr.out + O_VS + (((size_t)l * NS + (r - MP)) * 128 + 127) * 256;
                            if (vo) { *(f32x4*)(vo + hc) = v0; *(f32x4*)(vo + hc + 4) = v1; } } } }
            } else if (pn < 16) {
                float* base = pn < 8 ? (float*)(ws + WS_U) : (float*)(ws + WS_PR); const int ld = pn < 8 ? 512 : 2048, c0 = (pn < 8 ? (pn - 6) : (pn - 8)) * 256 + wc * 32 + 8 * fq;
#pragma unroll
                for (int ai = 0; ai < 2; ++ai)
#pragma unroll
                    for (int m = 0; m < 4; ++m) { const int r = row0 + ai * HALF + m * 16; if (r < M) {
#pragma unroll
                        for (int bj = 0; bj < 2; ++bj) { float* o = base + (size_t)r * ld + c0 + bj * HALF; *(f32x4*)o = acc[ai][bj][m][0]; *(f32x4*)(o + 4) = acc[ai][bj][m][1]; } } }
            } else {
                const int c0 = (pn - 16) * 256 + wc * 32 + 8 * fq;
#pragma unroll
                for (int ai = 0; ai < 2; ++ai)
#pragma unroll
                    for (int m = 0; m < 4; ++m) { const int r = row0 + ai * HALF + m * 16; if (r < M) {
#pragma unroll
                        for (int bj = 0; bj < 2; ++bj) { const f32x4 v0 = sig4(acc[ai][bj][m][0]), v1 = sig4(acc[ai][bj][m][1]);
                            u32x4 w; w.x = cvt_pk_bf16(v0.x, v0.y); w.y = cvt_pk_bf16(v0.z, v0.w); w.z = cvt_pk_bf16(v1.x, v1.y); w.w = cvt_pk_bf16(v1.z, v1.w);
                            *(u32x4*)((bf16*)(ws + WS_GT) + (size_t)r * 6144 + c0 + bj * HALF) = w; } } }
            }
        } else if (mode == G_MG && u.pm == MPAD / BM - 1) {
            const int c0 = u.pn * BM + wc * 32 + 8 * fq, br = u.seg < 2 ? 0 : u.seg - 1;
            u32x4 gwv[4][2];
#pragma unroll
            for (int m = 0; m < 4; ++m) { const int r = row0 + m * 16, rr = r < M ? r : M - 1;
#pragma unroll
                for (int bj = 0; bj < 2; ++bj) gwv[m][bj] = *(const u32x4*)((const bf16*)(ws + WS_GT) + (size_t)rr * 6144 + br * D + c0 + bj * HALF); }
            asm volatile("" ::: "memory"); __builtin_amdgcn_sched_barrier(0);
#pragma unroll
            for (int m = 0; m < 4; ++m) { const int r = row0 + m * 16; if (r < M) { float* so = (float*)(ws + WS_SLABM) + ((size_t)u.seg * NS + (r - MP)) * D;
#pragma unroll
                for (int bj = 0; bj < 2; ++bj) { const int c = c0 + bj * HALF; const u32x4 gw = gwv[m][bj];
                    f32x4 v0 = acc[0][bj][m][0], v1 = acc[0][bj][m][1];
                    v0.x *= gclamp(bflo(gw.x)); v0.y *= gclamp(bfhi(gw.x)); v0.z *= gclamp(bflo(gw.y)); v0.w *= gclamp(bfhi(gw.y)); v1.x *= gclamp(bflo(gw.z)); v1.y *= gclamp(bfhi(gw.z)); v1.z *= gclamp(bflo(gw.w)); v1.w *= gclamp(bfhi(gw.w));
                    *(f32x4*)(so + c) = v0; *(f32x4*)(so + c + 4) = v1; } } }
        } else if (mode == G_MG) {
            const int c0 = u.pn * BM + wc * 32 + 8 * fq;
#pragma unroll
            for (int ai = 0; ai < 2; ++ai) { u32x4 gwv[4][2];
#pragma unroll
                for (int m = 0; m < 4; ++m)
#pragma unroll
                    for (int bj = 0; bj < 2; ++bj) gwv[m][bj] = *(const u32x4*)((const bf16*)(ws + WS_GT) + (size_t)(row0 + ai * HALF + m * 16) * 6144 + 2 * D + c0 + bj * HALF);
                asm volatile("" ::: "memory"); __builtin_amdgcn_sched_barrier(0);
#pragma unroll
                for (int m = 0; m < 4; ++m) { const int r = row0 + ai * HALF + m * 16; {
#pragma unroll
                    for (int bj = 0; bj < 2; ++bj) { const int c = c0 + bj * HALF; const u32x4 gw = gwv[m][bj];
                        f32x4 v0 = acc[ai][bj][m][0], v1 = acc[ai][bj][m][1];
                        v0.x *= gclamp(bflo(gw.x)); v0.y *= gclamp(bfhi(gw.x)); v0.z *= gclamp(bflo(gw.y)); v0.w *= gclamp(bfhi(gw.y)); v1.x *= gclamp(bflo(gw.z)); v1.y *= gclamp(bfhi(gw.z)); v1.z *= gclamp(bflo(gw.w)); v1.w *= gclamp(bfhi(gw.w));
                        u32x4 w; w.x = cvt_pk_bf16(v0.x, v0.y); w.y = cvt_pk_bf16(v0.z, v0.w); w.z = cvt_pk_bf16(v1.x, v1.y); w.w = cvt_pk_bf16(v1.z, v1.w); *(u32x4*)((bf16*)(ws + WS_MG) + (size_t)r * D + c) = w; } } }
                asm volatile("" ::: "memory"); __builtin_amdgcn_sched_barrier(0); }
        } else if (mode == G_WO || mode == G_DN) {
            const int c0 = u.pn * BM + wc * 32 + 8 * fq; const int goff = mode == G_WO ? 2 * D : 5 * D;
            if (u.pm == MPAD / BM - 1) {
                f32x4 ggv[4][2][2];
#pragma unroll
                for (int m = 0; m < 4; ++m) { const int r = row0 + m * 16, rr = r < M ? r : M - 1; const float* gp = (const float*)(ws + WS_MOD) + ((size_t)l * NMOD + modrow(rr)) * NADA + goff + c0;
#pragma unroll
                    for (int bj = 0; bj < 2; ++bj) { ggv[m][bj][0] = *(const f32x4*)(gp + bj * HALF); ggv[m][bj][1] = *(const f32x4*)(gp + bj * HALF + 4); } }
                asm volatile("" ::: "memory"); __builtin_amdgcn_sched_barrier(0);
#pragma unroll
                for (int m = 0; m < 4; ++m) { const int r = row0 + m * 16; if (r < M) {
                    float* so = (float*)(ws + WS_SLAB) + ((size_t)u.seg * NS + (r - MP)) * D;
#pragma unroll
                    for (int bj = 0; bj < 2; ++bj) { const int c = c0 + bj * HALF; const f32x4 g0 = ggv[m][bj][0], g1 = ggv[m][bj][1];
                        *(f32x4*)(so + c) = (g0 + 1.f) * acc[0][bj][m][0]; *(f32x4*)(so + c + 4) = (g1 + 1.f) * acc[0][bj][m][1]; } } }
            } else {
                const float* gp = (const float*)(ws + WS_MOD) + ((size_t)l * NMOD + (u.pm >> 4)) * NADA + goff + c0;
                const f32x4 ga0 = *(const f32x4*)gp + 1.f, ga1 = *(const f32x4*)(gp + 4) + 1.f, gb0 = *(const f32x4*)(gp + HALF) + 1.f, gb1 = *(const f32x4*)(gp + HALF + 4) + 1.f;
                const float* xbase = (mode == G_WO && l == 0) ? INP(0) : (const float*)(ws + WS_X); float* xob = (float*)(ws + WS_X);
#pragma unroll
                for (int am = 0; am < 8; am += 2) { f32x4 xv[2][4];
#pragma unroll
                    for (int q = 0; q < 2; ++q) { const int ai = (am + q) >> 2, m = (am + q) & 3; const float* xin = xbase + (size_t)(row0 + ai * HALF + m * 16) * D + c0;
                        xv[q][0] = *(const f32x4*)xin; xv[q][1] = *(const f32x4*)(xin + 4); xv[q][2] = *(const f32x4*)(xin + HALF); xv[q][3] = *(const f32x4*)(xin + HALF + 4); }
#pragma unroll
                    for (int q = 0; q < 2; ++q) { const int ai = (am + q) >> 2, m = (am + q) & 3; float* xo = xob + (size_t)(row0 + ai * HALF + m * 16) * D + c0;
                        *(f32x4*)xo = xv[q][0] + ga0 * acc[ai][0][m][0]; *(f32x4*)(xo + 4) = xv[q][1] + ga1 * acc[ai][0][m][1];
                        *(f32x4*)(xo + HALF) = xv[q][2] + gb0 * acc[ai][1][m][0]; *(f32x4*)(xo + HALF + 4) = xv[q][3] + gb1 * acc[ai][1][m][1]; }
                    asm volatile("" ::: "memory"); }
            }
        } else {
            const int c0 = u.pn * 128 + wc * 16 + 4 * fq;
#pragma unroll
            for (int ai = 0; ai < 2; ++ai)
#pragma unroll
                for (int m = 0; m < 4; ++m) { const int r = row0 + ai * HALF + m * 16; if (r < M) {
#pragma unroll
                    for (int bj = 0; bj < 2; ++bj) { const f32x4 g = acc[ai][bj][m][0], up = acc[ai][bj][m][1]; const f32x4 a = g * sig4(g) * up;
                        u32x2 w; w.x = cvt_pk_bf16(a.x, a.y); w.y = cvt_pk_bf16(a.z, a.w); *(u32x2*)((bf16*)(ws + WS_GT) + (size_t)r * DFF + c0 + bj * 64) = w; } } }
        }
    }
};

__device__ __forceinline__ void gemm_phase(LAS unsigned char* lds, const Gemm g, const Sched& S, const Epi& E, const int tid  ) {
    const int wid = __builtin_amdgcn_readfirstlane(tid >> 6), lane = tid & 63, wr = wid >> 2, wc = wid & 3, fr = lane & 15, fq = lane >> 4;
    unsigned voffA[2], voffB[2];
#pragma unroll
    for (int i = 0; i < 2; ++i) { int R, C; stage_rc(tid * 16 + i * 8192, R, C); const int Rb = (R & ~31) + perm32(R & 31);
        voffA[i] = (unsigned)(R * g.ld + C) * 2u; voffB[i] = (unsigned)(Rb * g.ld + C) * 2u; }
    constexpr unsigned kstep = BK * 2;
    const unsigned hstep = (unsigned)HALF * (unsigned)g.ld * 2u; const bool mgd = g.mode == G_MG; const int ntfull = g.K / BK;
    const bool ksd = g.mode == G_WO || g.mode == G_DN || g.mode == G_MG;
#define PG8_KS(u) (ksd && (u).pm == MPAD / BM - 1)
#define PG8_KA(u) (PG8_KS(u) ? (unsigned)(u).seg * 512u : 0u)
#define PG8_NT(u) (PG8_KS(u) ? 8 : ntfull)
#define PG8_TILE(p, u) (((unsigned)(p) * (unsigned)BM * (unsigned)g.ld + PG8_KA(u)) * 2u)
    const unsigned ldsw = (unsigned)wid * 1024u;
    const int aoff = lds_byte(wr * 64 + fr, fq * 8), boff = lds_byte(wc * 32 + fr, fq * 8);
#define PG8_SA(b, h) (((b) * 2 + (h)) * HTB)
#define PG8_SB(b, h) ((4 + (b) * 2 + (h)) * HTB)
#define PG8_STAGE(bufoff, gbase, soff, voff) do { _Pragma("unroll") for (int _i = 0; _i < 2; ++_i) \
        __builtin_amdgcn_global_load_lds((const unsigned*)((const char*)(gbase) + (size_t)((voff)[_i] + (unsigned)(soff))), (LAS unsigned*)(lds + (bufoff) + ldsw + _i * 8192), 16, 0, 0); } while (0)
#define PG8_STA(bufoff, soff) PG8_STAGE(bufoff, g.A, soff, voffA)
#define PG8_STB(bufoff, soff) PG8_STAGE(bufoff, g.Bt, soff, voffB)
#define PG8_LDA(dst, b, h) do { _Pragma("unroll") for (int m = 0; m < 4; ++m) _Pragma("unroll") for (int k = 0; k < 2; ++k) dst[m][k] = *(const LAS bf16x8*)(lds + PG8_SA(b, h) + aoff + m * 2048 + k * 1024); } while (0)
#define PG8_LDB(dst, b, h) do { _Pragma("unroll") for (int n = 0; n < 2; ++n) _Pragma("unroll") for (int k = 0; k < 2; ++k) dst[n][k] = *(const LAS bf16x8*)(lds + PG8_SB(b, h) + boff + n * 2048 + k * 1024); } while (0)
#define PG8_MMA(ai, bj, At, Bt) do { __builtin_amdgcn_s_setprio(1); _Pragma("unroll") for (int m = 0; m < 4; ++m) _Pragma("unroll") for (int n = 0; n < 2; ++n) _Pragma("unroll") for (int k = 0; k < 2; ++k) \
        acc[ai][bj][m][n] = __builtin_amdgcn_mfma_f32_16x16x32_bf16(Bt[n][k], At[m][k], acc[ai][bj][m][n], 0, 0, 0); __builtin_amdgcn_s_setprio(0); } while (0)
#define PG8_WAIT_V(n) asm volatile("s_waitcnt vmcnt(" #n ")" ::: "memory")
#define PG8_WAIT_L(n) asm volatile("s_waitcnt lgkmcnt(" #n ")" ::: "memory")
#define PG8_BAR __builtin_amdgcn_s_barrier()
#define PG8_SCHED __builtin_amdgcn_sched_barrier(0)
    Unit cur, nxt; int ui = 0;
    if (!S.next(0, cur)) return;
    f32x4 acc[2][2][4][2];
#pragma unroll
    for (int a = 0; a < 2; ++a)
#pragma unroll
        for (int b = 0; b < 2; ++b)
#pragma unroll
            for (int m = 0; m < 4; ++m)
#pragma unroll
                for (int n = 0; n < 2; ++n) acc[a][b][m][n] = (f32x4){0.f, 0.f, 0.f, 0.f};
    bf16x8 At[4][2], B0[2][2], B1[2][2];
    unsigned cA = PG8_TILE(cur.pm, cur), cB = PG8_TILE(cur.pn, cur);
    PG8_STB(PG8_SB(0, 0), cB); PG8_STB(PG8_SB(0, 1), cB + hstep); PG8_STA(PG8_SA(0, 0), cA); PG8_STA(PG8_SA(0, 1), cA + hstep);
    if (wr == 1) PG8_BAR;
    PG8_WAIT_V(2); PG8_BAR;
    PG8_STB(PG8_SB(1, 0), cB + kstep); PG8_STA(PG8_SA(1, 0), cA + kstep); PG8_STB(PG8_SB(1, 1), cB + hstep + kstep);
    PG8_WAIT_V(6); PG8_BAR;
    for (;;) {
        const bool has_next = S.next(ui + 1, nxt);
        const unsigned nA = has_next ? PG8_TILE(nxt.pm, nxt) : cA, nB = has_next ? PG8_TILE(nxt.pn, nxt) : cB;
        const int nt = PG8_NT(cur);
        TSB2(50 + 2 * g.mode, lds);
        for (int t = 0; t < nt; t += 2) {
            const bool last = (t == nt - 2);
            if (mgd && !PG8_KS(cur) && (t == 16 || t == 24)) E.rescale(acc, cur, t == 16 ? 0 : 1, wr, wc, fr, fq);
            const unsigned a1 = cA + (unsigned)(t + 1) * kstep;
            const unsigned a2 = last ? nA : cA + (unsigned)(t + 2) * kstep, b2 = last ? nB : cB + (unsigned)(t + 2) * kstep;
            const unsigned a3 = a2 + kstep, b3 = b2 + kstep;
            PG8_LDB(B0, 0, 0); PG8_LDB(B1, 0, 1); PG8_SCHED; PG8_LDA(At, 0, 0); PG8_STA(PG8_SA(1, 1), a1 + hstep);
            PG8_WAIT_V(8); PG8_WAIT_L(0); PG8_BAR; PG8_MMA(0, 0, At, B0); PG8_MMA(0, 1, At, B1); PG8_BAR; PG8_SCHED;
            PG8_LDA(At, 0, 1); PG8_STB(PG8_SB(0, 0), b2); PG8_STB(PG8_SB(0, 1), b2 + hstep); PG8_STA(PG8_SA(0, 0), a2);
            PG8_WAIT_V(8); PG8_WAIT_L(0); PG8_BAR; PG8_MMA(1, 0, At, B0); PG8_MMA(1, 1, At, B1); PG8_BAR; PG8_SCHED;
            PG8_LDB(B0, 1, 0); PG8_LDB(B1, 1, 1); PG8_SCHED; PG8_LDA(At, 1, 0); PG8_STA(PG8_SA(0, 1), a2 + hstep);
            PG8_WAIT_V(8); PG8_WAIT_L(0); PG8_BAR; PG8_MMA(0, 0, At, B0); PG8_MMA(0, 1, At, B1); PG8_BAR; PG8_SCHED;
            PG8_LDA(At, 1, 1); PG8_STB(PG8_SB(1, 0), b3); PG8_STB(PG8_SB(1, 1), b3 + hstep); PG8_STA(PG8_SA(1, 0), a3);
            PG8_WAIT_V(8); PG8_WAIT_L(0); PG8_BAR; PG8_MMA(1, 0, At, B0); PG8_MMA(1, 1, At, B1); PG8_BAR; PG8_SCHED;
        }
        if (wr == 0) PG8_BAR;
        TSE2(50 + 2 * g.mode, lds);
        TSB2(51 + 2 * g.mode, lds); E(acc, cur, wr, wc, fr, fq); TSE2(51 + 2 * g.mode, lds);
        if (!has_next) break;
#pragma unroll
        for (int a = 0; a < 2; ++a)
#pragma unroll
            for (int b = 0; b < 2; ++b)
#pragma unroll
                for (int m = 0; m < 4; ++m)
#pragma unroll
                    for (int n = 0; n < 2; ++n) acc[a][b][m][n] = (f32x4){0.f, 0.f, 0.f, 0.f};
        cur = nxt; cA = nA; cB = nB; ++ui;
        if (wr == 1) PG8_BAR;
    }
    PG8_WAIT_V(0);
    PG8_BAR;
#undef PG8_KS
#undef PG8_KA
#undef PG8_NT
#undef PG8_TILE
#undef PG8_STA
#undef PG8_STB
#undef PG8_SA
#undef PG8_SB
#undef PG8_STAGE
#undef PG8_LDA
#undef PG8_LDB
#undef PG8_MMA
#undef PG8_WAIT_V
#undef PG8_WAIT_L
#undef PG8_BAR
#undef PG8_SCHED
}
}
namespace mk {
#define MFMA16(a, b, c) __builtin_amdgcn_mfma_f32_16x16x32_bf16((a), (b), (c), 0, 0, 0)
__device__ __forceinline__ bf16x8 pack8(f32x4 a, f32x4 b) { u32x4 w; w.x = cvt_pk_bf16(a.x, a.y); w.y = cvt_pk_bf16(a.z, a.w); w.z = cvt_pk_bf16(b.x, b.y); w.w = cvt_pk_bf16(b.z, b.w); return __builtin_bit_cast(bf16x8, w); }
typedef short s16x4 __attribute__((ext_vector_type(4)));
__device__ __forceinline__ bf16x8 cat44(s16x4 a, s16x4 b) { return (bf16x8){a[0], a[1], a[2], a[3], b[0], b[1], b[2], b[3]}; }
constexpr float LOG2E = 1.4426950408889634f;

constexpr int AK_STRIDE = 144, AV_STRIDE = 560;
constexpr int A_KOFF = 0, A_VOFF = 256 * AK_STRIDE, A_BYTES = A_VOFF + 64 * AV_STRIDE;
__device__ __forceinline__ void attn_prompt_unit(const Frame& F, int l, int b, int blk, int hk) {
    LAS unsigned char* Ks = F.lds + A_KOFF; LAS unsigned char* Vt = F.lds + A_VOFF;
    const bf16* Kg = (const bf16*)(F.ws + WS_K); const bf16* Vg = (const bf16*)(F.ws + WS_V); const bf16* Qg = (const bf16*)(F.ws + WS_Q);
    const int kp0 = blk * 128 - 128;
#pragma unroll
    for (int ch = F.tid; ch < 2048; ch += NTHR) { const int i = ch >> 3, dc = ch & 7, kp = kp0 + i;
        u32x4 kv = (u32x4){0u, 0u, 0u, 0u}, vv = kv;
        if (kp >= 0) { const size_t m = (size_t)b * SEQ + kp; kv = *(const u32x4*)(Kg + m * 256 + hk * 64 + dc * 8); vv = *(const u32x4*)(Vg + m * 256 + hk * 64 + dc * 8); }
        *(LAS u32x4*)(Ks + i * AK_STRIDE + dc * 16) = kv;
        LAS unsigned short* vp = (LAS unsigned short*)(Vt + (dc * 8) * AV_STRIDE) + i;
        vp[0 * (AV_STRIDE / 2)] = (unsigned short)(vv.x & 0xffff); vp[1 * (AV_STRIDE / 2)] = (unsigned short)(vv.x >> 16); vp[2 * (AV_STRIDE / 2)] = (unsigned short)(vv.y & 0xffff); vp[3 * (AV_STRIDE / 2)] = (unsigned short)(vv.y >> 16);
        vp[4 * (AV_STRIDE / 2)] = (unsigned short)(vv.z & 0xffff); vp[5 * (AV_STRIDE / 2)] = (unsigned short)(vv.z >> 16); vp[6 * (AV_STRIDE / 2)] = (unsigned short)(vv.w & 0xffff); vp[7 * (AV_STRIDE / 2)] = (unsigned short)(vv.w >> 16); }
    for (int i = F.tid; i < 64 * 24; i += NTHR) { const int d = i / 24, c = i % 24; ((LAS unsigned short*)(Vt + d * AV_STRIDE))[256 + c] = 0; }
    const int g = F.lane >> 4, c16 = F.lane & 15;
    const float* sinkp = INP(14) + l * 16;
    bf16x8 q0n, q1n;
    { const int gi = F.wave * 4, hq = hk * 4 + (gi >> 3), qs = gi & 7; const size_t mq = (size_t)b * SEQ + blk * 128 + 16 * qs + c16;
      q0n = *(const bf16x8*)(Qg + mq * 1024 + hq * 64 + 8 * g); q1n = *(const bf16x8*)(Qg + mq * 1024 + hq * 64 + 32 + 8 * g); }
    __syncthreads();
#pragma unroll 1
    for (int it = 0; it < 4; ++it) {
        const int gi = F.wave * 4 + it, hq = hk * 4 + (gi >> 3), qs = gi & 7;
        const int tqr = 16 * qs + c16;
        const size_t mq = (size_t)b * SEQ + blk * 128 + tqr;
        const bf16x8 q0 = q0n, q1 = q1n;
        if (it < 3) { const int gn = gi + 1, hn = hk * 4 + (gn >> 3), qn_ = gn & 7; const size_t mn = (size_t)b * SEQ + blk * 128 + 16 * qn_ + c16;
            q0n = *(const bf16x8*)(Qg + mn * 1024 + hn * 64 + 8 * g); q1n = *(const bf16x8*)(Qg + mn * 1024 + hn * 64 + 32 + 8 * g); }
        f32x4 s[10];
#pragma unroll
        for (int j = 0; j < 9; ++j) { LAS const unsigned char* kr = Ks + (16 * (qs + j) + c16) * AK_STRIDE + 16 * g;
            const bf16x8 k0 = *(LAS const bf16x8*)kr, k1 = *(LAS const bf16x8*)(kr + 64);
            f32x4 a = (f32x4){0.f, 0.f, 0.f, 0.f}; a = MFMA16(k0, q0, a); a = MFMA16(k1, q1, a); s[j] = a; }
        const float sk2 = sinkp[hq] * LOG2E; float mx = sk2;
#pragma unroll
        for (int j = 0; j < 9; ++j)
#pragma unroll
            for (int r = 0; r < 4; ++r) { const int i = 16 * (qs + j) + 4 * g + r; const bool ok = (i >= tqr) && (i <= tqr + 128) && (kp0 + i >= 0);
                const float v = ok ? s[j][r] * (0.125f * LOG2E) : -1e30f; s[j][r] = v; mx = fmaxf(mx, v); }
        mx = fmaxf(mx, __shfl_xor(mx, 16)); mx = fmaxf(mx, __shfl_xor(mx, 32));
        float sum = 0.f;
#pragma unroll
        for (int j = 0; j < 9; ++j)
#pragma unroll
            for (int r = 0; r < 4; ++r) { const float p = __builtin_amdgcn_exp2f(s[j][r] - mx); s[j][r] = p; sum += p; }
        s[9] = (f32x4){0.f, 0.f, 0.f, 0.f};
        sum += __shfl_xor(sum, 16); sum += __shfl_xor(sum, 32);
        const float rl = 1.f / (sum + __builtin_amdgcn_exp2f(sk2 - mx));
        f32x4 o[4];
#pragma unroll
        for (int dt = 0; dt < 4; ++dt) o[dt] = (f32x4){0.f, 0.f, 0.f, 0.f};
#pragma unroll
        for (int kk = 0; kk < 5; ++kk) { const bf16x8 pf = pack8(s[2 * kk], s[2 * kk + 1]);
#pragma unroll
            for (int dt = 0; dt < 4; ++dt) { LAS const unsigned char* vr = Vt + (16 * dt + c16) * AV_STRIDE + (16 * (qs + 2 * kk) + 4 * g) * 2;
                const s16x4 v0 = *(LAS const s16x4*)vr, v1 = *(LAS const s16x4*)(vr + 32);
                o[dt] = MFMA16(cat44(v0, v1), pf, o[dt]); } }
        bf16* op = (bf16*)(F.ws + WS_CAT) + mq * D + hq * 64 + 4 * g;
#pragma unroll
        for (int dt = 0; dt < 4; ++dt) { const f32x4 v = o[dt] * rl; u32x2 w; w.x = cvt_pk_bf16(v.x, v.y); w.y = cvt_pk_bf16(v.z, v.w); *(u32x2*)(op + 16 * dt) = w; }
    }
    __syncthreads();
}

__device__ __forceinline__ void attn_sample_unit(const Frame& F, int l, int s_, int hf) {
    LAS float* qn = (LAS float*)F.lds;
    LAS float* kn = qn + 512;
    LAS float* vn = kn + 128;
    LAS float* sc = vn + 128;
    LAS float* rl = sc + 8 * 132;
    const int m = MP + s_; const float* sinkp = INP(14) + l * 16 + 8 * hf;
    const float* ck = INP(4) + ((size_t)l * NS + s_) * 128 * 256; const float* cv = INP(5) + ((size_t)l * NS + s_) * 128 * 256;
    { const int h = F.tid >> 6, p = F.tid & 63; qn[h * 64 + pi_d(p)] = bf2f(((const bf16*)(F.ws + WS_Q))[(size_t)m * 1024 + 512 * hf + F.tid]) * (0.125f * LOG2E); }
    if (F.tid < 128) { const int h = F.tid >> 6, p = F.tid & 63; kn[h * 64 + pi_d(p)] = bf2f(((const bf16*)(F.ws + WS_K))[(size_t)m * 256 + 128 * hf + F.tid]); vn[F.tid] = bf2f(((const bf16*)(F.ws + WS_V))[(size_t)m * 256 + 128 * hf + F.tid]); }
    { float* ko = F.out + O_KS + ((size_t)l * NS + s_) * 128 * 256; float* vo = F.out + O_VS + ((size_t)l * NS + s_) * 128 * 256; const int i0_ = 64 * hf * 64, i1_ = hf ? 127 * 64 : 64 * 64;
#pragma unroll 4
      for (int i = i0_ + F.tid; i < i1_; i += NTHR) { const f32x4 a = *(const f32x4*)(ck + 256 + 4 * i), b = *(const f32x4*)(cv + 256 + 4 * i); *(f32x4*)(ko + 4 * i) = a; *(f32x4*)(vo + 4 * i) = b; } }
    __syncthreads();
    for (int idx = F.tid; idx < 8 * 129; idx += NTHR) { const int hq = idx / 129, j = idx - hq * 129, hk = hq >> 2; float a = 0.f;
        if (j < 128) { const float* kr = ck + (size_t)j * 256 + (2 * hf + hk) * 64;
#pragma unroll
            for (int d = 0; d < 64; d += 4) { const f32x4 kv = *(const f32x4*)(kr + d); a += qn[hq * 64 + d] * kv.x + qn[hq * 64 + d + 1] * kv.y + qn[hq * 64 + d + 2] * kv.z + qn[hq * 64 + d + 3] * kv.w; } }
        else { for (int d = 0; d < 64; ++d) a += qn[hq * 64 + d] * kn[hk * 64 + d]; }
        sc[hq * 132 + j] = a; }
    __syncthreads();
    { const int hq = F.wave; const float sk2 = sinkp[hq] * LOG2E;
        float mx = sk2; for (int j = F.lane; j < 129; j += 64) mx = fmaxf(mx, sc[hq * 132 + j]);
#pragma unroll
        for (int o = 1; o < 64; o <<= 1) mx = fmaxf(mx, __shfl_xor(mx, o));
        float sum = 0.f; for (int j = F.lane; j < 129; j += 64) { const float p = __builtin_amdgcn_exp2f(sc[hq * 132 + j] - mx); sc[hq * 132 + j] = p; sum += p; }
        sum = wave_sum(sum); if (F.lane == 0) rl[hq] = 1.f / (sum + __builtin_amdgcn_exp2f(sk2 - mx)); }
    __syncthreads();
    { const int hq = F.tid >> 6, d = F.tid & 63, hk = hq >> 2; float a = 0.f; const float* vc = cv + (2 * hf + hk) * 64 + d;
#pragma unroll 16
        for (int j = 0; j < 128; ++j) a += sc[hq * 132 + j] * vc[(size_t)j * 256];
        a += sc[hq * 132 + 128] * vn[hk * 64 + d];
        ((bf16*)(F.ws + WS_CAT))[(size_t)m * D + 512 * hf + F.tid] = (bf16)f2bf(a * rl[hq]); }
    __syncthreads();
}

constexpr int PL_STRIDE = 272;
__device__ __forceinline__ void pool_unit(const Frame& F, int l, int rt, int gi) {
    LAS unsigned char* dT = F.lds; LAS unsigned char* Wt = F.lds + 128 * PL_STRIDE;
    const float* U = (const float*)(F.ws + WS_U); const int w = 2 << gi, m0 = rt * 128;
    { const bf16* pw = (const bf16*)wl(F, l, WL_PW) + (size_t)gi * 128 * 128;
      for (int ch = F.tid; ch < 2048; ch += NTHR) { const int e = ch >> 4, cc = ch & 15; *(LAS u32x4*)(Wt + e * PL_STRIDE + cc * 16) = *(const u32x4*)(pw + e * 128 + cc * 8); } }
    { const int c = F.tid & 127, strip = F.tid >> 7, col = gi * 128 + c;
      if (rt < 64) { const int t0 = (m0 & (SEQ - 1)) + 32 * strip; const float* up = U + (size_t)(m0 + 32 * strip) * 512 + col;
          float uv[47];
#pragma unroll
          for (int j = 0; j < 47; ++j) { const int t = t0 - 15 + j; uv[j] = t >= 0 ? up[(ptrdiff_t)(j - 15) * 512] : 0.f; }
          LAS unsigned short* dp = (LAS unsigned short*)(dT + (32 * strip) * PL_STRIDE) + c;
#define POOL_D(W) { float sum = 0.f; _Pragma("unroll") for (int j = 1; j < W; ++j) sum += uv[15 - j]; \
              _Pragma("unroll") for (int k = 0; k < 32; ++k) { const int t = t0 + k; sum += uv[15 + k]; const float cnt = (float)(t + 1 < W ? t + 1 : W); \
                  dp[k * (PL_STRIDE / 2)] = (unsigned short)f2bf(sum / cnt - uv[15 + k]); sum -= uv[15 + k - W + 1]; } }
          if (gi == 0) POOL_D(2) else if (gi == 1) POOL_D(4) else if (gi == 2) POOL_D(8) else POOL_D(16)
#undef POOL_D
      }
      else { const float* sp = INP(6) + (size_t)l * NS * 15 * 512;
#pragma unroll 4
          for (int k = 0; k < 32; ++k) { const int s_ = 32 * strip + k; const float uc = U[(size_t)(MP + s_) * 512 + col]; float hv[15];
#pragma unroll
              for (int j = 1; j < 16; ++j) hv[j - 1] = sp[((size_t)s_ * 15 + 15 - j) * 512 + col];
              float sum = uc;
#pragma unroll
              for (int j = 1; j < 16; ++j) sum += j < w ? hv[j - 1] : 0.f;
              ((LAS unsigned short*)(dT + s_ * PL_STRIDE))[c] = (unsigned short)f2bf(sum / (float)w - uc); } } }
    __syncthreads();
    const int g = F.lane >> 4, c16 = F.lane & 15;
    f32x4 acc[8];
#pragma unroll
    for (int et = 0; et < 8; ++et) acc[et] = (f32x4){0.f, 0.f, 0.f, 0.f};
#pragma unroll
    for (int ks = 0; ks < 4; ++ks) { const bf16x8 df = *(LAS const bf16x8*)(dT + (16 * F.wave + c16) * PL_STRIDE + (32 * ks + 8 * g) * 2);
#pragma unroll
        for (int et = 0; et < 8; ++et) { const bf16x8 wf = *(LAS const bf16x8*)(Wt + (16 * et + c16) * PL_STRIDE + (32 * ks + 8 * g) * 2); acc[et] = MFMA16(wf, df, acc[et]); } }
    const int m = m0 + 16 * F.wave + c16; const float* psc = INP(17) + l * 512 + gi * 128;
    if (m < M) { bf16* op = (bf16*)(F.ws + WS_CAT) + (size_t)m * D + 1024 + gi * 128 + 4 * g;
#pragma unroll
        for (int et = 0; et < 8; ++et) { const f32x4 v = acc[et] * *(const f32x4*)(psc + 16 * et + 4 * g); u32x2 wv; wv.x = cvt_pk_bf16(v.x, v.y); wv.y = cvt_pk_bf16(v.z, v.w); *(u32x2*)(op + 16 * et) = wv; } }
    __syncthreads();
}
__device__ __forceinline__ void state_outs(const Frame& F, int l) {
    const int gt = F.bid * NTHR + F.tid, ngt = F.G * NTHR; const float* U = (const float*)(F.ws + WS_U); const float* PR = (const float*)(F.ws + WS_PR); const float* sp = INP(6) + (size_t)l * NS * 15 * 512;
    constexpr int N1 = NB * 15 * 512, N2 = NS * 15 * 512, N3 = NB * RP, N4 = NS * RP, NT = N1 + N2 + N3 + N4;
    for (int i0 = gt; i0 < NT; i0 += 5 * ngt) { float v[5]; size_t d[5];
#pragma unroll
        for (int q = 0; q < 5; ++q) { int i = i0 + q * ngt; v[q] = 0.f; d[q] = 0; if (i < NT) { const float* s;
            if (i < N1) { const int b = i / (15 * 512), j = (i >> 9) % 15, c = i & 511; d[q] = O_PP + (size_t)l * N1 + i; s = U + ((size_t)b * SEQ + SEQ - 15 + j) * 512 + c; }
            else if ((i -= N1) < N2) { const int s_ = i / (15 * 512), j = (i >> 9) % 15, c = i & 511; d[q] = O_PS + (size_t)l * N2 + i; s = j < 14 ? sp + i + 512 : U + (size_t)(MP + s_) * 512 + c; }
            else if ((i -= N2) < N3) { const int b = i / RP, c = i - b * RP; d[q] = O_SP + (size_t)l * N3 + i; s = PR + ((size_t)b * SEQ + SEQ - 1) * 2048 + c; }
            else { i -= N3; const int s_ = i / RP, c = i - s_ * RP; d[q] = O_SS + (size_t)l * N4 + i; s = PR + (size_t)(MP + s_) * 2048 + c; }
            v[q] = *s; } }
        asm volatile("" ::: "memory"); __builtin_amdgcn_sched_barrier(0);
#pragma unroll
        for (int q = 0; q < 5; ++q) if (i0 + q * ngt < NT) F.out[d[q]] = v[q];
        asm volatile("" ::: "memory"); __builtin_amdgcn_sched_barrier(0); }
}

template <int CTRL> __device__ __forceinline__ float dpp_f(float x) { return __builtin_bit_cast(float, __builtin_amdgcn_mov_dpp(__builtin_bit_cast(int, x), CTRL, 0xf, 0xf, true)); }
__device__ __forceinline__ float row16_sum(float x) {
    x += dpp_f<0xB1>(x); x += dpp_f<0x4E>(x); x += dpp_f<0x141>(x); x += dpp_f<0x128>(x); return x;
}
constexpr int RA_STRIDE = 1936;
constexpr int R_T1OFF = 32 * RA_STRIDE, RT_STRIDE = 80;
struct XmRow { const float* p; const float* pv; float pz; };
__device__ __forceinline__ XmRow xm_row(const float* PR, const float* sshift, int m) {
    XmRow r; r.p = PR + (size_t)m * 2048; const bool first = m < MP && (m & (SEQ - 1)) == 0;
    r.pv = m >= MP ? sshift + (size_t)(m - MP) * RP : first ? r.p : r.p - 2048; r.pz = first ? 0.f : 1.f; return r;
}
__device__ __forceinline__ float xm_at(const XmRow& r, const float* mu, int c) { const float p = r.p[c]; return p + (r.pv[c] * r.pz - p) * mu[c]; }
__device__ __forceinline__ f32x4 xm4_at(const XmRow& r, const float* mu, int c) { const f32x4 p = *(const f32x4*)(r.p + c); return p + (*(const f32x4*)(r.pv + c) * r.pz - p) * *(const f32x4*)(mu + c); }
template <int KS> __device__ __forceinline__ void lora_mm(f32x4 (&acc)[4], const bf16* Wt, int ldw, int nbase, LAS const unsigned char* Arow, int acol, int g, int c16) {
#pragma unroll
    for (int nt = 0; nt < 4; ++nt) acc[nt] = (f32x4){0.f, 0.f, 0.f, 0.f};
#pragma unroll
    for (int ks = 0; ks < KS; ++ks) { const bf16x8 af = *(LAS const bf16x8*)(Arow + (acol + 32 * ks + 8 * g) * 2);
#pragma unroll
        for (int nt = 0; nt < 4; ++nt) { const bf16x8 wf = *(const bf16x8*)(Wt + (size_t)(nbase + 16 * nt + c16) * ldw + 32 * ks + 8 * g); acc[nt] = MFMA16(wf, af, acc[nt]); } }
}
__device__ __forceinline__ float frcp(float x) { return __builtin_amdgcn_rcpf(x); }
__device__ __forceinline__ f32x4 fsig4(f32x4 v) { f32x4 r; r.x = frcp(1.f + __expf(-v.x)); r.y = frcp(1.f + __expf(-v.y)); r.z = frcp(1.f + __expf(-v.z)); r.w = frcp(1.f + __expf(-v.w)); return r; }
__device__ __forceinline__ void rwkv_prep_unit(const Frame& F, int l, int ti) {
    int tid_l = F.tid; asm volatile("" : "+v"(tid_l)); const int lane_l = tid_l & 63;
    LAS unsigned char* Aop = F.lds; LAS unsigned char* T1 = F.lds + R_T1OFF;
    const float* PR = (const float*)(F.ws + WS_PR); const float* sshift = INP(7) + (size_t)l * NS * RP; const float* mu = INP(19) + l * RP;
    const int m0 = ti * 32; const bool vres = l > 0;
    TSB2(70, F.lds);
#pragma unroll
    for (int q0 = 0; q0 < 8; q0 += 4) { f32x4 xv[4];
#pragma unroll
        for (int q = 0; q < 4; ++q) if (q0 + q < 7) { const int i = tid_l + (q0 + q) * NTHR, r = i / 112, c4 = i - r * 112; const XmRow xr = xm_row(PR, sshift, m0 + r); xv[q] = xm4_at(xr, mu, 1536 + 4 * c4); }
#pragma unroll
        for (int q = 0; q < 4; ++q) if (q0 + q < 7) { const int i = tid_l + (q0 + q) * NTHR, r = i / 112, c4 = i - r * 112, c = 4 * c4; f32x4 y = xv[q];
            if (c < 96) { y.x = 1.f - 2.f * frcp(1.f + __expf(2.f * y.x)); y.y = 1.f - 2.f * frcp(1.f + __expf(2.f * y.y)); y.z = 1.f - 2.f * frcp(1.f + __expf(2.f * y.z)); y.w = 1.f - 2.f * frcp(1.f + __expf(2.f * y.w)); }
            else if (c >= 192) y = fsig4(y);
            u32x2 w; w.x = cvt_pk_bf16(y.x, y.y); w.y = cvt_pk_bf16(y.z, y.w); *(LAS u32x2*)(Aop + r * RA_STRIDE + c * 2) = w; }
        asm volatile("" ::: "memory"); __builtin_amdgcn_sched_barrier(0); }
    if (vres) {
#pragma unroll
        for (int q0 = 0; q0 < 8; q0 += 4) { f32x4 xv[4];
#pragma unroll
            for (int q = 0; q < 4; ++q) { const int i = tid_l + (q0 + q) * NTHR, r = i >> 7, c4 = i & 127; const XmRow xr = xm_row(PR, sshift, m0 + r); xv[q] = xm4_at(xr, mu, 1024 + 4 * c4); }
#pragma unroll
            for (int q = 0; q < 4; ++q) { const int i = tid_l + (q0 + q) * NTHR, r = i >> 7, c4 = i & 127; u32x2 w; w.x = cvt_pk_bf16(xv[q].x, xv[q].y); w.y = cvt_pk_bf16(xv[q].z, xv[q].w); *(LAS u32x2*)(Aop + r * RA_STRIDE + (448 + 4 * c4) * 2) = w; }
            asm volatile("" ::: "memory"); __builtin_amdgcn_sched_barrier(0); } }
    __syncthreads();
    TSE2(70, F.lds); TSB2(71, F.lds);
    const int g = lane_l >> 4, c16 = lane_l & 15, nb = 64 * F.wave;
    if (vres) {
        if (F.wave < 4) { const int mt = F.wave >> 1, nt = F.wave & 1; f32x4 a = (f32x4){0.f, 0.f, 0.f, 0.f}; const bf16* w1 = (const bf16*)wl(F, 1, WL_V1) + (size_t)(16 * nt + c16) * 512 + 8 * g;
#pragma unroll
            for (int kh = 0; kh < 2; ++kh) { bf16x8 wf[8];
#pragma unroll
                for (int ks = 0; ks < 8; ++ks) wf[ks] = *(const bf16x8*)(w1 + 32 * (8 * kh + ks));
#pragma unroll
                for (int ks = 0; ks < 8; ++ks) { const bf16x8 af = *(LAS const bf16x8*)(Aop + (16 * mt + c16) * RA_STRIDE + (448 + 32 * (8 * kh + ks) + 8 * g) * 2); a = MFMA16(wf[ks], af, a); }
                asm volatile("" ::: "memory"); __builtin_amdgcn_sched_barrier(0); }
            u32x2 wv; wv.x = cvt_pk_bf16(a.x, a.y); wv.y = cvt_pk_bf16(a.z, a.w); *(LAS u32x2*)(T1 + (16 * mt + c16) * RT_STRIDE + (16 * nt + 4 * g) * 2) = wv;
#if MK_DEBUG
            *(f32x4*)((float*)(F.ws + WS_H) + (size_t)(m0 + 16 * mt + c16) * 32 + 16 * nt + 4 * g) = a;
#endif
            }
        __syncthreads();
    }
    LAS unsigned char* Aimg = F.lds + 65536; LAS unsigned char* Limg = F.lds + 65536 + 32768;
    size_t ro[2]; int mrow[2];
#pragma unroll
    for (int mt = 0; mt < 2; ++mt) { int m = m0 + 16 * mt + c16; asm volatile("" : "+v"(m)); mrow[mt] = m; ro[mt] = (size_t)m * 512 + nb + 4 * g; }
    TSE2(71, F.lds); TSB2(72, F.lds);
#define LORA_PASS(WT, LDW, ACOL, KS0, NKS, ACC) do { bf16x8 wq_[NKS][4]; const bf16* pw_ = (const bf16*)(WT) + (size_t)(nb + c16) * (LDW) + 8 * g + 32 * (KS0); \
        _Pragma("unroll") for (int ks = 0; ks < NKS; ++ks) _Pragma("unroll") for (int nt = 0; nt < 4; ++nt) wq_[ks][nt] = *(const bf16x8*)(pw_ + (size_t)16 * nt * (LDW) + 32 * ks); \
        _Pragma("unroll") for (int mt = 0; mt < 2; ++mt) { LAS const unsigned char* Arow_ = Aop + (16 * mt + c16) * RA_STRIDE + ((ACOL) + 32 * (KS0) + 8 * g) * 2; \
            _Pragma("unroll") for (int ks = 0; ks < NKS; ++ks) { const bf16x8 af_ = *(LAS const bf16x8*)(Arow_ + 64 * ks); \
                _Pragma("unroll") for (int nt = 0; nt < 4; ++nt) ACC[mt][nt] = MFMA16(wq_[ks][nt], af_, ACC[mt][nt]); } } \
        asm volatile("" ::: "memory"); __builtin_amdgcn_sched_barrier(0); } while (0)
#define LORA_ZERO(ACC) do { _Pragma("unroll") for (int mt = 0; mt < 2; ++mt) _Pragma("unroll") for (int nt = 0; nt < 4; ++nt) ACC[mt][nt] = (f32x4){0.f, 0.f, 0.f, 0.f}; } while (0)
    {
        const float* a0p = INP(22) + l * 512; f32x4 acc[2][4]; LORA_ZERO(acc); LORA_PASS(wl(F, l, WL_A2), 96, 96, 0, 3, acc);
#pragma unroll
        for (int mt = 0; mt < 2; ++mt)
#pragma unroll
            for (int nt = 0; nt < 4; ++nt) { const f32x4 a = fsig4(acc[mt][nt] + *(const f32x4*)(a0p + nb + 16 * nt + 4 * g)); u32x2 w; w.x = cvt_pk_bf16(a.x, a.y); w.y = cvt_pk_bf16(a.z, a.w);
                *(LAS u32x2*)(Aimg + ((16 * mt + c16) * 512 + nb + 16 * nt + 4 * g) * 2) = w; } }
    {
        const float* w0p = INP(20) + l * 512; float* Wb = rwbuf(F, RW_W); f32x4 acc[2][4]; LORA_ZERO(acc); LORA_PASS(wl(F, l, WL_W2), 96, 0, 0, 3, acc);
#pragma unroll
        for (int mt = 0; mt < 2; ++mt)
#pragma unroll
            for (int nt = 0; nt < 4; ++nt) { const f32x4 z = acc[mt][nt] + *(const f32x4*)(w0p + nb + 16 * nt + 4 * g); f32x4 dec;
#pragma unroll
                for (int e = 0; e < 4; ++e) { const float zz = -z[e]; const float sp = fmaxf(zz, 0.f) + __logf(1.f + __expf(-fabsf(zz))); dec[e] = __expf(-__expf(-sp - 0.5f)); }
                *(f32x4*)(Wb + ro[mt] + 16 * nt) = dec; } }
    {
        float* Gb = rwbuf(F, RW_G); f32x4 acc[2][4]; LORA_ZERO(acc); LORA_PASS(wl(F, l, WL_G2), 256, 192, 0, 4, acc); LORA_PASS(wl(F, l, WL_G2), 256, 192, 4, 4, acc);
#pragma unroll
        for (int mt = 0; mt < 2; ++mt)
#pragma unroll
            for (int nt = 0; nt < 4; ++nt) *(f32x4*)(Gb + ro[mt] + 16 * nt) = acc[mt][nt]; }
#undef LORA_PASS
#undef LORA_ZERO
    TSE2(72, F.lds); TSB2(73, F.lds);
    if (vres) {
#pragma unroll
        for (int mt = 0; mt < 2; ++mt) { const bf16x8 tf = *(LAS const bf16x8*)(T1 + (16 * mt + c16) * RT_STRIDE + (8 * g) * 2); const f32x4 z4 = (f32x4){0.f, 0.f, 0.f, 0.f};
#pragma unroll
            for (int nt = 0; nt < 4; ++nt) { const bf16x8 wf = *(const bf16x8*)((const bf16*)wl(F, 1, WL_V2) + (size_t)(nb + 16 * nt + c16) * 32 + 8 * g); const f32x4 lv = MFMA16(wf, tf, z4);
                u32x2 w; w.x = cvt_pk_bf16(lv.x, lv.y); w.y = cvt_pk_bf16(lv.z, lv.w); *(LAS u32x2*)(Limg + ((16 * mt + c16) * 512 + nb + 16 * nt + 4 * g) * 2) = w;
#if MK_DEBUG
                *(f32x4*)(rwbuf(F, RW_Y) + ro[mt] + 16 * nt) = lv;
#endif
            } } }
    __syncthreads();
    {   const float* vbp = INP(33); const float* kkp = INP(25) + l * 512; const float* kap = INP(26) + l * 512;
        float* Rb = rwbuf(F, RW_R); float* Kb = rwbuf(F, RW_K); float* Vb = rwbuf(F, RW_V); float* Ab = rwbuf(F, RW_A); float* Bb = rwbuf(F, RW_B); float* VF = rwbuf(F, RW_VF);
        const int r = tid_l >> 4, j16 = tid_l & 15; int m = m0 + r; asm volatile("" : "+v"(m)); const XmRow xr = xm_row(PR, sshift, m);
#pragma unroll 1
        for (int hb = 0; hb < 8; hb += 2) {
            f32x4 pc_[2][3], pp_[2][3], pm_[2][3], kk_[2], ka_[2], vf_[2], vb_[2];
#pragma unroll
            for (int hh = 0; hh < 2; ++hh) { const int n = 64 * (hb + hh) + 4 * j16; const size_t o = (size_t)m * 512 + n;
#pragma unroll
                for (int s_ = 0; s_ < 3; ++s_) { pc_[hh][s_] = *(const f32x4*)(xr.p + 512 * s_ + n); pp_[hh][s_] = *(const f32x4*)(xr.pv + 512 * s_ + n); pm_[hh][s_] = *(const f32x4*)(mu + 512 * s_ + n); }
                kk_[hh] = *(const f32x4*)(kkp + n); ka_[hh] = *(const f32x4*)(kap + n);
                if (vres) { vf_[hh] = *(const f32x4*)(VF + o); vb_[hh] = *(const f32x4*)(vbp + n); } }
            asm volatile("" ::: "memory"); __builtin_amdgcn_sched_barrier(0);
#pragma unroll
            for (int hh = 0; hh < 2; ++hh) { const int n = 64 * (hb + hh) + 4 * j16; const size_t o = (size_t)m * 512 + n;
                const f32x4 rx = pc_[hh][0] + (pp_[hh][0] * xr.pz - pc_[hh][0]) * pm_[hh][0], k = pc_[hh][1] + (pp_[hh][1] * xr.pz - pc_[hh][1]) * pm_[hh][1]; f32x4 v = pc_[hh][2] + (pp_[hh][2] * xr.pz - pc_[hh][2]) * pm_[hh][2];
                const u32x2 aw = *(LAS const u32x2*)(Aimg + (r * 512 + n) * 2); f32x4 a; a.x = bflo(aw.x); a.y = bfhi(aw.x); a.z = bflo(aw.y); a.w = bfhi(aw.y);
                const f32x4 kk = k * kk_[hh];
                const float ss = row16_sum((kk.x * kk.x + kk.y * kk.y) + (kk.z * kk.z + kk.w * kk.w)), rn = 1.f / fmaxf(sqrtf(ss), 1e-12f);
                *(f32x4*)(Rb + o) = rx;
                *(f32x4*)(Kb + o) = k * ((a - 1.f) * ka_[hh] + 1.f);
                if (!vres) *(f32x4*)(VF + o) = v;
                else { const u32x2 lw = *(LAS const u32x2*)(Limg + (r * 512 + n) * 2); f32x4 lv; lv.x = bflo(lw.x); lv.y = bfhi(lw.x); lv.z = bflo(lw.y); lv.w = bfhi(lw.y);
                    v = v + (vf_[hh] - v) * fsig4(lv + vb_[hh]); }
                *(f32x4*)(Vb + o) = v;
                const f32x4 kn = kk * rn; *(f32x4*)(Ab + o) = -kn; *(f32x4*)(Bb + o) = kn * a; }
            asm volatile("" ::: "memory"); __builtin_amdgcn_sched_barrier(0); } }
    TSE2(73, F.lds);
    __syncthreads();
}

#ifndef SC_STAG
#define SC_STAG 0
#endif
constexpr int SC_T = 32, SC_ARR = SC_T * 64 * 4, SC_BUF = 5 * SC_ARR + SC_T * 16 * 4, SC_NSLOT = 3;
static_assert(SC_NSLOT * SC_BUF <= 131072, "scan ring fits the phase LDS");
__device__ __forceinline__ float wave_sum64(float x) { x = row16_sum(x); x += __shfl_xor(x, 16); x += __shfl_xor(x, 32); return x; }
__device__ __forceinline__ void scan_prompt_unit(const Frame& F, int l, int b, int h, int qt) {
    const size_t rowb = (size_t)b * SEQ;
    constexpr int NCH = SEQ / SC_T;
    if (F.wave >= 4) {
        const float* src0 = rwbuf(F, RW_W); const float* src1 = rwbuf(F, RW_A); const float* src2 = rwbuf(F, RW_B); const float* src3 = rwbuf(F, RW_K); const float* src4 = rwbuf(F, RW_R); const float* Vb = rwbuf(F, RW_V);
        const int lt = F.tid - 256, lw = F.wave - 4;
        const size_t g0 = (rowb + (lt >> 4)) * 512 + h * 64 + 4 * (lt & 15), g1 = g0 + (size_t)16 * 512;
        const size_t gv0 = (rowb + (lt & 31)) * 512 + h * 64 + qt * 16 + (lt >> 5), gv1 = gv0 + 8;
        const unsigned l0 = (unsigned)lw * 1024u, l1 = l0 + 4096u;
#define SC_GL(src, goff, slot, arr, loff) __builtin_amdgcn_global_load_lds((const unsigned*)((src) + (goff)), (LAS unsigned*)(F.lds + (slot) * SC_BUF + (arr) * SC_ARR + (loff)), 16, 0, 0)
#define SC_STAGE(ch_, slot_) do { const size_t co_ = (size_t)(ch_) * SC_T * 512; \
            SC_GL(src0, g0 + co_, slot_, 0, l0); SC_GL(src0, g1 + co_, slot_, 0, l1); SC_GL(src1, g0 + co_, slot_, 1, l0); SC_GL(src1, g1 + co_, slot_, 1, l1); SC_GL(src2, g0 + co_, slot_, 2, l0); SC_GL(src2, g1 + co_, slot_, 2, l1); \
            SC_GL(src3, g0 + co_, slot_, 3, l0); SC_GL(src3, g1 + co_, slot_, 3, l1); SC_GL(src4, g0 + co_, slot_, 4, l0); SC_GL(src4, g1 + co_, slot_, 4, l1); \
            __builtin_amdgcn_global_load_lds((const unsigned*)(Vb + gv0 + co_), (LAS unsigned*)(F.lds + (slot_) * SC_BUF + 5 * SC_ARR + lw * 256), 4, 0, 0); \
            __builtin_amdgcn_global_load_lds((const unsigned*)(Vb + gv1 + co_), (LAS unsigned*)(F.lds + (slot_) * SC_BUF + 5 * SC_ARR + 1024 + lw * 256), 4, 0, 0); } while (0)
        SC_STAGE(0, 0); SC_STAGE(1, 1);
        asm volatile("s_waitcnt vmcnt(12)" ::: "memory");
        __builtin_amdgcn_s_barrier();
        int slot = 2;
        for (int ch = 0; ch < NCH; ++ch) {
            if (ch + 2 < NCH) { SC_STAGE(ch + 2, slot);
                asm volatile("s_waitcnt vmcnt(12)" ::: "memory"); }
            else asm volatile("s_waitcnt vmcnt(0)" ::: "memory");
            __builtin_amdgcn_s_barrier();
            slot = slot == 2 ? 0 : slot + 1;
        }
#undef SC_GL
#undef SC_STAGE
    } else {
        float* Yb = rwbuf(F, RW_Y);
        const int rg = F.lane >> 4, j4 = F.lane & 15, rloc = F.wave * 4 + rg;
        f32x4 s = (f32x4){0.f, 0.f, 0.f, 0.f}; float ypv[16]; const bool b8 = (j4 & 8) != 0, b4 = (j4 & 4) != 0, b2 = (j4 & 2) != 0, b1 = (j4 & 1) != 0;
        float* yp = Yb + (rowb + j4) * 512 + h * 64 + qt * 16 + rloc;
        __builtin_amdgcn_s_barrier(); asm volatile("" ::: "memory");
        int slot = 0;
        for (int ch = 0; ch < NCH; ++ch) {
            for (int i_ = 0; i_ < SC_STAG * F.wave; ++i_) asm volatile("s_nop 10");
            LAS const unsigned char* bp = F.lds + slot * SC_BUF + j4 * 16; LAS const f32x4* vp = (LAS const f32x4*)(F.lds + slot * SC_BUF + 5 * SC_ARR + rloc * 128);
            f32x4 w = *(LAS const f32x4*)(bp + 0 * SC_ARR), a = *(LAS const f32x4*)(bp + 1 * SC_ARR), bb = *(LAS const f32x4*)(bp + 2 * SC_ARR), k = *(LAS const f32x4*)(bp + 3 * SC_ARR), r = *(LAS const f32x4*)(bp + 4 * SC_ARR);
            f32x4 vq = vp[0];
#pragma unroll
            for (int tt = 0; tt < SC_T; ++tt) {
                const float v = vq[tt & 3];
                asm volatile("" :: "v"(w), "v"(a), "v"(bb), "v"(k), "v"(r), "v"(vq));
                __builtin_amdgcn_sched_barrier(0);
                f32x4 wn = w, an = a, bn = bb, kn = k, rn = r, vqn = vq;
                if (tt + 1 < SC_T) { wn = *(LAS const f32x4*)(bp + 0 * SC_ARR + (tt + 1) * 256); an = *(LAS const f32x4*)(bp + 1 * SC_ARR + (tt + 1) * 256); bn = *(LAS const f32x4*)(bp + 2 * SC_ARR + (tt + 1) * 256);
                    kn = *(LAS const f32x4*)(bp + 3 * SC_ARR + (tt + 1) * 256); rn = *(LAS const f32x4*)(bp + 4 * SC_ARR + (tt + 1) * 256); if ((tt & 3) == 3) vqn = vp[(tt + 1) >> 2]; }
                __builtin_amdgcn_sched_barrier(0);
                const f32x4 p = s * w + k * v;
                const float sa = row16_sum(fmaf(s.w, a.w, fmaf(s.z, a.z, fmaf(s.y, a.y, s.x * a.x))));
                s = bb * sa + p;
                ypv[tt & 15] = fmaf(s.w, r.w, fmaf(s.z, r.z, fmaf(s.y, r.y, s.x * r.x)));
                if ((tt & 15) == 15) {
                    float q8[8], q4[4], q2[2];
#pragma unroll
                    for (int kq = 0; kq < 8; ++kq) { const float keep = b8 ? ypv[kq + 8] : ypv[kq], send = b8 ? ypv[kq] : ypv[kq + 8]; q8[kq] = keep + dpp_f<0x128>(send); }
#pragma unroll
                    for (int kq = 0; kq < 4; ++kq) { const float keep = b4 ? q8[kq + 4] : q8[kq], send = b4 ? q8[kq] : q8[kq + 4]; q4[kq] = keep + dpp_f<0x141>(send); }
#pragma unroll
                    for (int kq = 0; kq < 2; ++kq) { const float keep = b2 ? q4[kq + 2] : q4[kq], send = b2 ? q4[kq] : q4[kq + 2]; q2[kq] = keep + dpp_f<0x4E>(send); }
                    { const float keep = b1 ? q2[1] : q2[0], send = b1 ? q2[0] : q2[1]; yp[(size_t)(ch * SC_T + (tt & ~15)) * 512] = keep + dpp_f<0xB1>(send); }
                }
                w = wn; a = an; bb = bn; k = kn; r = rn; vq = vqn;
            }
            __builtin_amdgcn_s_barrier(); asm volatile("" ::: "memory");
            slot = slot == 2 ? 0 : slot + 1;
        }
        *(f32x4*)(F.out + O_WP + ((((size_t)l * NB + b) * 8 + h) * 64 + qt * 16 + rloc) * 64 + 4 * j4) = s;
    }
    __syncthreads();
}
__device__ __forceinline__ void scan_sample_wave(const Frame& F, int l, int s_, int h) {
    const size_t m = MP + s_; const int rg = F.lane >> 4, j4 = F.lane & 15; const size_t o = m * 512 + h * 64 + 4 * j4;
    const f32x4 w = *(const f32x4*)(rwbuf(F, RW_W) + o), a = *(const f32x4*)(rwbuf(F, RW_A) + o), bb = *(const f32x4*)(rwbuf(F, RW_B) + o), k = *(const f32x4*)(rwbuf(F, RW_K) + o), r = *(const f32x4*)(rwbuf(F, RW_R) + o);
    const float* S0 = INP(8) + (((size_t)l * NS + s_) * 8 + h) * 4096; float* S1 = F.out + O_WS + (((size_t)l * NS + s_) * 8 + h) * 4096;
    const int row = 4 * j4 + rg; const size_t orow = m * 512 + h * 64 + row;
    const float v_my = rwbuf(F, RW_V)[orow], g_my = rwbuf(F, RW_G)[orow], rk_r = INP(27)[l * 512 + h * 64 + row], lg_r = INP(28)[l * 512 + h * 64 + row], lb_r = INP(29)[l * 512 + h * 64 + row];
    const f32x4 rk4 = *(const f32x4*)(INP(27) + l * 512 + h * 64 + 4 * j4);
    (void)rk_r;
    float yk = 0.f;
#pragma unroll 4
    for (int i0 = 0; i0 < 16; ++i0) { const int i = 4 * i0 + rg; f32x4 s = *(const f32x4*)(S0 + i * 64 + 4 * j4); const float v = rwbuf(F, RW_V)[m * 512 + h * 64 + i];
        const float sa = row16_sum((s.x * a.x + s.y * a.y) + (s.z * a.z + s.w * a.w));
        s = s * w + bb * sa + k * v;
        const float y = row16_sum((s.x * r.x + s.y * r.y) + (s.z * r.z + s.w * r.w));
        *(f32x4*)(S1 + i * 64 + 4 * j4) = s; yk = (j4 == i0) ? y : yk; }
    const float bon = row16_sum((r.x * k.x * rk4.x + r.y * k.y * rk4.y) + (r.z * k.z * rk4.z + r.w * k.w * rk4.w));
    const float mu = wave_sum64(yk) * (1.f / 64.f), dv = yk - mu, var = wave_sum64(dv * dv) * (1.f / 64.f);
    ((bf16*)(F.ws + WS_CAT))[m * D + 1536 + h * 64 + row] = (bf16)f2bf((dv * rsqrtf(var + 64e-5f) * lg_r + lb_r + bon * v_my) * g_my);
#if MK_DEBUG
    rwbuf(F, RW_Y)[orow] = yk;
#endif
}
__device__ __forceinline__ void rwkv_post_phase(const Frame& F, int l, int wb, int nwb) {
    const int gw = wb * NWAVES + F.wave, NGW = nwb * NWAVES; const float* rkp = INP(27) + l * 512; const float* lgp = INP(28) + l * 512; const float* lbp = INP(29) + l * 512;
    const float* Yb = rwbuf(F, RW_Y); const float* Rb = rwbuf(F, RW_R); const float* Kb = rwbuf(F, RW_K); const float* Vb = rwbuf(F, RW_V); const float* Gb = rwbuf(F, RW_G);
    float rkq[8], lgq[8], lbq[8];
#pragma unroll
    for (int q = 0; q < 8; ++q) { const int c = q * 64 + F.lane; rkq[q] = rkp[c]; lgq[q] = lgp[c]; lbq[q] = lbp[c]; }
    for (int m = gw; m < MP; m += NGW) {
        float y[8], r[8], k[8], v[8], g[8];
#pragma unroll
        for (int q = 0; q < 8; ++q) { const size_t o = (size_t)m * 512 + q * 64 + F.lane; y[q] = Yb[o]; r[q] = Rb[o]; k[q] = Kb[o]; v[q] = Vb[o]; g[q] = Gb[o]; }
        asm volatile("" ::: "memory"); __builtin_amdgcn_sched_barrier(0);
#pragma unroll
        for (int q = 0; q < 8; ++q) { const int c = q * 64 + F.lane;
            const float mu = wave_sum64(y[q]) * (1.f / 64.f), dv = y[q] - mu, var = wave_sum64(dv * dv) * (1.f / 64.f), bon = wave_sum64(r[q] * k[q] * rkq[q]);
            ((bf16*)(F.ws + WS_CAT))[(size_t)m * D + 1536 + c] = (bf16)f2bf((dv * rsqrtf(var + 64e-5f) * lgq[q] + lbq[q] + bon * v[q]) * g[q]); }
        asm volatile("" ::: "memory"); __builtin_amdgcn_sched_barrier(0);
    }
}
}
namespace mk {
namespace cg = cooperative_groups;
constexpr int LDS_BYTES = 135168;
constexpr int TS_OFF = LDS_BYTES - 64;
#ifdef MK_TS_ID
#ifndef MK_TS_BLOCK
#define MK_TS_BLOCK 0
#endif
#ifndef MK_TS_AMP
#define MK_TS_AMP 8
#endif
#define TSB(id, ldsp) do { if ((id) == MK_TS_ID && blockIdx.x == MK_TS_BLOCK && threadIdx.x == 0) *(volatile LAS unsigned*)((ldsp) + TS_OFF) -= (unsigned)__builtin_amdgcn_s_memrealtime(); } while (0)
#define TSE(id, ldsp) do { if ((id) == MK_TS_ID && blockIdx.x == MK_TS_BLOCK && threadIdx.x == 0) *(volatile LAS unsigned*)((ldsp) + TS_OFF) += (unsigned)__builtin_amdgcn_s_memrealtime(); } while (0)
#else
#define TSB(id, ldsp) do {} while (0)
#define TSE(id, ldsp) do {} while (0)
#endif
constexpr int PH_PRO = 0, PH_ADA = 1, PH_L0 = 2, PH_PER_L = 10, PH_FINAL = PH_L0 + NL * PH_PER_L, N_PHASES = PH_FINAL + 1;
enum { LP_NORM1 = 0, LP_IN, LP_MIX, LP_SCAN, LP_POST, LP_MG, LP_WO, LP_NORM2, LP_GU, LP_DN };

__device__ __forceinline__ void mix_phase(const Frame& F, int l) {
    TSB(40, F.lds);
    for (int u = F.bid; u < 256; u += F.G) rwkv_prep_unit(F, l, u);
    TSE(40, F.lds);
    TSB(44, F.lds); state_outs(F, l); TSE(44, F.lds);
}
constexpr int SCAN_BLOCKS = 64;
constexpr int GL_PM_SPLIT = 10;
__device__ __forceinline__ void scan_phase(const Frame& F, int l) {
    if (F.bid < SCAN_BLOCKS) scan_prompt_unit(F, l, F.bid >> 5, (F.bid >> 2) & 7, F.bid & 3);
    else { const int nb_ = F.G - SCAN_BLOCKS, wb = F.bid - SCAN_BLOCKS; const int nw = nb_ * NWAVES; unsigned* ctl = (unsigned*)(F.ws + WS_CTL) + 64 * l;
        if (wb < 4) { rwkv_prep_unit(F, l, 256 + wb); asm volatile("s_waitcnt vmcnt(0)" ::: "memory"); __syncthreads();
            if (F.tid == 0) { __builtin_amdgcn_fence(__ATOMIC_RELEASE, "agent"); asm volatile("s_waitcnt vmcnt(0)" ::: "memory"); __hip_atomic_fetch_add(ctl, 1u, __ATOMIC_RELAXED, __HIP_MEMORY_SCOPE_AGENT); } }
        TSB(41, F.lds);
        for (int a = wb; a < 256; a += nb_) attn_prompt_unit(F, l, a >> 7, (a >> 2) & 31, a & 3);
        TSE(41, F.lds); TSB(42, F.lds);
        for (int p = (wb + 64) % nb_; p < 260; p += nb_) pool_unit(F, l, p >> 2, p & 3);
        TSE(42, F.lds); TSB(43, F.lds);
        for (int s_ = (wb + 132) % nb_; s_ < 2 * NS; s_ += nb_) attn_sample_unit(F, l, s_ >> 1, s_ & 1);
        TSE(43, F.lds);
        __syncthreads();
        Gemm g; g.layer = l; g.ld = D; g.M = MPAD; g.K = D; g.N = NIN; g.A = (const bf16*)(F.ws + WS_H); g.Bt = (const bf16*)wl(F, l, WL_IN); g.mode = G_IN;
        Sched S; S.init(Rect{GL_PM_SPLIT, MPAD / BM - GL_PM_SPLIT, 16, 24}, Rect{0, 0, 0, 0}, F.G - SCAN_BLOCKS, F.bid - SCAN_BLOCKS, 1); Epi E; E.F = &F; E.mode = G_IN; E.layer = l;
        TSB(45, F.lds); gemm_phase(F.lds, g, S, E, F.tid); TSE(45, F.lds);
        TSB(46, F.lds); p0_prologue(F, l == 0 ? 2 : 8, false, wb, nb_, 0); TSE(46, F.lds);
        if (F.tid == 0) { unsigned sp = 0; while (__hip_atomic_load(ctl, __ATOMIC_RELAXED, __HIP_MEMORY_SCOPE_AGENT) < 4u && ++sp < (1u << 26)) __builtin_amdgcn_s_sleep(8);
            __builtin_amdgcn_fence(__ATOMIC_ACQUIRE, "agent"); asm volatile("s_waitcnt vmcnt(0)" ::: "memory"); }
        __syncthreads();
        for (int u = wb * NWAVES + F.wave; u < NS * 8; u += nw) scan_sample_wave(F, l, u >> 3, u & 7); }
}

#define XB_TMO      128
#define XB_XCNT(j)  (256  + 64 * (j))
#define XB_XSUB(j)  (1280 + 64 * (j))
#define XB_XGEN(j)  (2304 + 64 * (j))
#define XB_TOP      3328
#define XB_TOPGEN   3392
#define XCD_BAR_WORDS 3456
#define XB_SPIN_CAP (1u << 18)

__device__ __forceinline__ unsigned xb_ld(unsigned* p)              { return __hip_atomic_load(p, __ATOMIC_RELAXED, __HIP_MEMORY_SCOPE_AGENT); }
__device__ __forceinline__ unsigned xb_add(unsigned* p, unsigned v) { return __hip_atomic_fetch_add(p, v, __ATOMIC_RELAXED, __HIP_MEMORY_SCOPE_AGENT); }
__device__ __forceinline__ unsigned xb_xcc_id() { return (unsigned)__builtin_amdgcn_s_getreg((3 << 11) | 20) & 0xFu; }
#define XB_SPIN(cond, bar) do { unsigned _sp = 0; while (cond) { __builtin_amdgcn_s_sleep(1); \
    if ((++_sp & 255u) == 0u) { if (xb_ld(&(bar)[XB_TMO])) break; if (_sp > XB_SPIN_CAP) { atomicAdd(&(bar)[XB_TMO], 1u); break; } } } } while (0)

struct XcdBarrier {
    unsigned* bar; unsigned x;
    volatile LAS unsigned* st;
};

__device__ __forceinline__ XcdBarrier xcd_barrier_post(unsigned* bar, volatile LAS unsigned* st) {
    XcdBarrier b; b.bar = bar; b.x = xb_xcc_id(); b.st = st;
    if (threadIdx.x == 0) (void)xb_add(&bar[XB_XCNT(b.x)], 1u);
    return b;
}
__device__ __forceinline__ void xcd_barrier_complete(unsigned* bar, unsigned x, unsigned& nloc, unsigned& nx) {
    const unsigned G = gridDim.x * gridDim.y * gridDim.z;
    unsigned sum, cnt, mine, sp = 0u;
    for (;;) {
        sum = 0u; cnt = 0u; mine = 0u;
#pragma unroll
        for (unsigned j = 0; j < 16; ++j) { const unsigned c = xb_ld(&bar[XB_XCNT(j)]); sum += c; cnt += (c > 0u) ? 1u : 0u; mine = (j == x) ? c : mine; }
        if (sum == G) break;
        __builtin_amdgcn_s_sleep(1);
        if ((++sp & 255u) == 0u) { if (xb_ld(&bar[XB_TMO])) break; if (sp > XB_SPIN_CAP) { atomicAdd(&bar[XB_TMO], 1u); break; } }
    }
    nloc = mine > 0u ? mine : 1u; nx = cnt > 0u ? cnt : 1u;
}

__device__ __forceinline__ void xcd_barrier(const XcdBarrier& b) {
    asm volatile("s_waitcnt vmcnt(0)" ::: "memory");
    __syncthreads();
    if (threadIdx.x == 0) {
        unsigned* bar = b.bar;
        __builtin_amdgcn_s_waitcnt(0);
        unsigned nloc = b.st[0], nx = b.st[1];
        if (nloc == 0u) { xcd_barrier_complete(bar, b.x, nloc, nx); b.st[0] = nloc; b.st[1] = nx; }
        const unsigned old = xb_add(&bar[XB_XSUB(b.x)], 1u);
        const unsigned gen = old / nloc;
        if (old + 1u == (gen + 1u) * nloc) {
            __builtin_amdgcn_fence(__ATOMIC_RELEASE, "agent");
            asm volatile("s_waitcnt vmcnt(0)" ::: "memory");
            const unsigned og = xb_add(&bar[XB_TOP], 1u);
            const unsigned tg = og / nx;
            if (og + 1u == (tg + 1u) * nx) xb_add(&bar[XB_TOPGEN], 1u);
            else XB_SPIN(xb_ld(&bar[XB_TOPGEN]) == tg, bar);
            __builtin_amdgcn_fence(__ATOMIC_ACQUIRE, "agent");
            xb_add(&bar[XB_XGEN(b.x)], 1u);
            asm volatile("s_waitcnt vmcnt(0)" ::: "memory");
        } else {
            XB_SPIN(xb_ld(&bar[XB_XGEN(b.x)]) == gen, bar);
            __builtin_amdgcn_fence(__ATOMIC_ACQUIRE, "agent");
            asm volatile("s_waitcnt vmcnt(0)" ::: "memory");
        }
    }
    __syncthreads();
}


__global__ void __launch_bounds__(NTHR, 2) __attribute__((target("no-packed-fp32-ops"))) mega(Args args) {
    extern __shared__ __attribute__((aligned(16))) unsigned char lds_raw[];
    cg::grid_group grid = cg::this_grid();
    if (threadIdx.x < 2) ((volatile LAS unsigned*)((LAS unsigned char*)lds_raw + TS_OFF - 64))[threadIdx.x] = 0u;
    __syncthreads();
    const XcdBarrier xbar = xcd_barrier_post((unsigned*)(args.ws + WS_CTL + 4096), (volatile LAS unsigned*)((LAS unsigned char*)lds_raw + TS_OFF - 64));
#ifdef MK_TS_ID
    if (threadIdx.x == 0) *(volatile LAS unsigned*)((LAS unsigned char*)lds_raw + TS_OFF) = 0u;
#endif
    for (int ph = args.ph_lo; ph < args.ph_hi; ++ph) {
        Frame F; { GAS unsigned char* ws_ = (GAS unsigned char*)args.ws; GAS float* out_ = (GAS float*)args.out; int tid_ = threadIdx.x; int bid_ = blockIdx.x; int G_ = gridDim.x;
            asm volatile("" : "+s"(ws_), "+s"(out_), "+v"(tid_), "+s"(bid_), "+s"(G_));
            F.lds = (LAS unsigned char*)lds_raw; F.tid = tid_; F.lane = tid_ & 63; F.wave = __builtin_amdgcn_readfirstlane(tid_ >> 6); F.G = G_; F.bid = bid_; F.out = (float*)out_; F.ws = (unsigned char*)ws_; }
        const int l = ph >= PH_L0 && ph < PH_FINAL ? (ph - PH_L0) / PH_PER_L : 0, lp = ph >= PH_L0 && ph < PH_FINAL ? (ph - PH_L0) % PH_PER_L : -1;
        TSB(ph == PH_PRO ? 1 : ph == PH_ADA ? 2 : ph == PH_FINAL ? 3 : 10 + lp, F.lds);
#ifndef MK_NO_PRO
        if (ph == PH_PRO) p0_prologue(F, 0, true, F.bid, F.G, 0); else
#endif
#ifndef MK_NO_NORM
        if (ph == PH_FINAL || lp == LP_NORM1 || lp == LP_NORM2) norm_phase(F, l, ph == PH_FINAL ? 2 : lp == LP_NORM1 ? 0 : 1, ph == PH_FINAL ? 11 : lp == LP_NORM2 ? 4 : (l > 0 ? 11 : 0)); else
#endif
#ifndef MK_NO_MIX
        if (lp == LP_MIX) { mix_phase(F, l);
#ifdef MK_DUP_MIX
            __syncthreads(); mix_phase(F, l);
#endif
        } else
#endif
#ifndef MK_NO_SCAN
        if (lp == LP_SCAN) { scan_phase(F, l);
#ifdef MK_DUP_SCAN
            __syncthreads(); scan_phase(F, l);
#endif
        } else
#endif
#ifndef MK_NO_GEMM
        {
            Gemm g; g.layer = l; g.ld = D; g.M = MPAD; g.K = D;
            if (ph == PH_ADA) { g.A = (const bf16*)(F.ws + WS_SILC); g.Bt = (const bf16*)(F.ws + WS_ADAW); g.M = 256; g.N = 2 * NADA; g.mode = G_ADA; }
            else if (lp == LP_IN) { g.A = (const bf16*)(F.ws + WS_H); g.Bt = (const bf16*)wl(F, l, WL_IN); g.N = NIN; g.mode = G_IN; }
            else if (lp == LP_MG || lp == LP_POST) { g.A = (const bf16*)(F.ws + WS_CAT); g.Bt = (const bf16*)wl(F, l, WL_CAT); g.N = D; g.mode = G_MG; }
            else if (lp == LP_WO) { g.A = (const bf16*)(F.ws + WS_MG); g.Bt = (const bf16*)wl(F, l, WL_O); g.N = D; g.mode = G_WO; }
            else if (lp == LP_GU) { g.A = (const bf16*)(F.ws + WS_H); g.Bt = (const bf16*)wl(F, l, WL_GU); g.N = NGU; g.mode = G_GU; }
            else { g.A = (const bf16*)(F.ws + WS_GT); g.Bt = (const bf16*)wl(F, l, WL_DN); g.N = D; g.K = DFF; g.ld = DFF; g.mode = G_DN; }
            Sched S; Epi E; E.F = &F; E.mode = g.mode; E.layer = l;
            if (lp == LP_IN && ph != PH_ADA) S.init(Rect{0, MPAD / BM, 0, 16}, Rect{0, GL_PM_SPLIT, 16, 24}, F.G, F.bid, 1);
            else if (lp == LP_POST) S.init(Rect{0, 0, 0, 8}, Rect{MPAD / BM - 1, 1, 0, 8 * (D / 512)}, F.G, F.bid, 1, 8);
            else if (lp == LP_MG) S.init(Rect{0, MPAD / BM - 1, 0, 8}, Rect{0, 0, 0, 0}, F.G, F.bid, 1);
            else if (g.mode == G_WO || g.mode == G_DN) S.init(Rect{0, MPAD / BM - 1, 0, 8}, Rect{MPAD / BM - 1, 1, 0, 8 * (g.K / 512)}, F.G, F.bid, 1, 8);
            else S.init(Rect{0, g.M / BM, 0, g.N / BM}, Rect{0, 0, 0, 0}, F.G, F.bid, 1);
            TSB(47, F.lds);
            if (lp == LP_MG) {
                const float* sl = (const float*)(F.ws + WS_SLABM); bf16* mg = (bf16*)(F.ws + WS_MG) + (size_t)MP * D;
                for (int i = F.bid * NTHR + F.tid; i < NS * (D / 4); i += F.G * NTHR) { const size_t o = (size_t)i * 4;
                    const f32x4 t = (*(const f32x4*)(sl + o) + *(const f32x4*)(sl + (size_t)NS * D + o)) + (*(const f32x4*)(sl + (size_t)2 * NS * D + o) + *(const f32x4*)(sl + (size_t)3 * NS * D + o));
                    u32x2 w; w.x = cvt_pk_bf16(t.x, t.y); w.y = cvt_pk_bf16(t.z, t.w); *(u32x2*)(mg + o) = w; } }
            TSE(47, F.lds);
            gemm_phase(F.lds, g, S, E, F.tid);
            if (lp == LP_POST) { constexpr int NSU = 8 * (D / 512); const bool split = F.G > 2 * NSU; const int wb = split ? F.bid - NSU : F.bid, nwb = split ? F.G - NSU : F.G;
                if (wb >= 0) rwkv_post_phase(F, l, wb, nwb); }
            if (ph == PH_ADA) { if (F.bid < 96) p0_prologue(F, 5, false, F.bid, 96, 2); else p0_prologue(F, 5, false, F.bid - 96, F.G - 96, 1); }
        }
#else
        {}
#endif
        TSE(ph == PH_PRO ? 1 : ph == PH_ADA ? 2 : ph == PH_FINAL ? 3 : 10 + lp, F.lds);
        TSB(30, F.lds);
        if (ph + 1 < args.ph_hi) { if (args.ph_hi < 0) grid.sync();   else xcd_barrier(xbar); }
        TSE(30, F.lds);
    }
#ifdef MK_EXTRA_SYNCS
    for (int i = 0; i < MK_EXTRA_SYNCS; ++i) xcd_barrier(xbar);
#endif
#ifdef MK_TS_ID
    if (blockIdx.x == MK_TS_BLOCK && threadIdx.x == 0) { const unsigned want = *(volatile LAS unsigned*)((LAS unsigned char*)lds_raw + TS_OFF) * (unsigned)MK_TS_AMP; const unsigned t0 = (unsigned)__builtin_amdgcn_s_memrealtime();
        while ((unsigned)__builtin_amdgcn_s_memrealtime() - t0 < want) __builtin_amdgcn_s_sleep(32); }
#endif
}
}
#ifndef MK_DEBUG
#define MK_DEBUG 0
#endif
extern "C" void kernel_launch(void* const* d_in, const int* in_sizes, int n_in, void* d_out, int out_size, void* d_ws, size_t ws_size, hipStream_t stream) {
    using namespace mk;
    static int grid = 0;
    if (grid == 0) {
        nv::WS wtmp; const size_t need_nv = nv::carve((float*)d_ws, wtmp) * 4; const size_t need = MK_DEBUG ? (need_nv > WS_END ? need_nv : WS_END) + (16u << 20) : WS_END;
        if (n_in != 39 || (size_t)out_size != O_END || ws_size < need) { fprintf(stderr, "kernel_launch: unexpected shapes: n_in %d out %d (want %zu) ws %zu (need %zu)\n", n_in, out_size, (size_t)O_END, ws_size, need); grid = -1; return; }
        int dev = 0, cus = 0, per_cu = 0;
        if (hipGetDevice(&dev) != hipSuccess || hipDeviceGetAttribute(&cus, hipDeviceAttributeMultiprocessorCount, dev) != hipSuccess) { grid = -1; return; }
        if (hipFuncSetAttribute((const void*)mega, hipFuncAttributeMaxDynamicSharedMemorySize, LDS_BYTES) != hipSuccess) { fprintf(stderr, "kernel_launch: hipFuncSetAttribute failed\n"); grid = -1; return; }
        if (hipOccupancyMaxActiveBlocksPerMultiprocessor(&per_cu, (const void*)mega, NTHR, LDS_BYTES) != hipSuccess || per_cu < 1) { fprintf(stderr, "kernel_launch: occupancy query says %d blocks per CU\n", per_cu); per_cu = 1; }
        (void)hipGetLastError();
        grid = cus;
        fprintf(stderr, "kernel_launch: grid %d (cus %d, per_cu %d), ws %zu need %zu\n", grid, cus, per_cu, ws_size, need);
    }
    if (grid < 0) return;
    Args a{};
    for (int i = 0; i < 39; ++i) a.in[i] = (const float*)d_in[i];
    a.out = (float*)d_out; a.ws = (unsigned char*)d_ws;
    if (hipMemsetAsync((unsigned char*)d_ws + WS_CTL, 0, WS_CTL_BYTES, stream) != hipSuccess) { fprintf(stderr, "kernel_launch: hipMemsetAsync of the control words failed\n"); return; }
#if MK_DEBUG
    dbg::Ctx dc; dc.probes = (float*)((unsigned char*)d_ws + ((ws_size - (12u << 20)) & ~(size_t)255)); dc.err = dc.probes + (size_t)dbg::NIDS * dbg::NPROBE; dc.on = 1;
    (void)hipMemsetAsync(dc.err, 0, dbg::NIDS * 4 * sizeof(float), stream);
    unsigned char* ws = (unsigned char*)d_ws;
    for (int ph = 0; ph < N_PHASES; ++ph) {
        a.ph_lo = ph; a.ph_hi = ph + 1;
        hipLaunchKernelGGL(mega, dim3(grid), dim3(NTHR), LDS_BYTES, stream, a);
        using namespace dbg;
        const int l = ph >= PH_L0 && ph < PH_FINAL ? (ph - PH_L0) / PH_PER_L : 0, lp = ph >= PH_L0 && ph < PH_FINAL ? (ph - PH_L0) % PH_PER_L : -1, tb = T_L0 + l * T_PER_L;
        if (ph == PH_ADA) save(&dc, stream, T_MOD, ws + WS_MOD, K_F32, NADA, 0, NL * NMOD, NADA);
        if (lp == LP_NORM1) save(&dc, stream, tb + T_H1, ws + WS_H, K_BF16, D, 0, M, D);
        if (lp == LP_IN) { save(&dc, stream, tb + T_Q, ws + WS_Q, K_QPERM, 1024, 0, M, 1024); save(&dc, stream, tb + T_K, ws + WS_K, K_QPERM, 256, 0, M, 256); save(&dc, stream, tb + T_V, ws + WS_V, K_BF16, 256, 0, M, 256);
            save(&dc, stream, tb + T_U, ws + WS_U, K_F32, 512, 0, M, 512); save(&dc, stream, tb + T_PR, ws + WS_PR, K_F32, 2048, 0, M, RP); }
        if (lp == LP_SCAN) { save(&dc, stream, tb + T_OA, ws + WS_CAT, K_BF16, D, 0, M, 1024); save(&dc, stream, tb + T_ZP, ws + WS_CAT, K_BF16, D, 1024, M, 512); }
        if (lp == LP_SCAN) {
            for (int i = 0; i < 7; ++i) save(&dc, stream, tb + T_R + i, ws + WS_RW + (size_t)i * RW_STRIDE, K_F32, 512, 0, M, 512);
            if (l == 1) { save(&dc, stream, 59, ws + WS_RW + (size_t)RW_Y * RW_STRIDE, K_F32, 512, 0, M, 512); save(&dc, stream, 60, ws + WS_H, K_F32, 32, 0, M, 32); } }
        if (lp == LP_SCAN) save(&dc, stream, tb + T_GT, ws + WS_GT, K_BF16, 6144, 0, M, 6144);
        if (lp == LP_SCAN) save(&dc, stream, tb + T_Y, ws + WS_RW + (size_t)RW_Y * RW_STRIDE, K_F32, 512, 0, M, 512);
        if (lp == LP_POST) save(&dc, stream, tb + T_YR, ws + WS_CAT, K_BF16, D, 1536, M, 512);
        if (lp == LP_WO) save(&dc, stream, tb + T_MG, ws + WS_MG, K_BF16, D, 0, M, D);
        if (lp == LP_NORM2) { save(&dc, stream, tb + T_X1, ws + WS_X, K_F32, D, 0, M, D); save(&dc, stream, tb + T_H2, ws + WS_H, K_BF16, D, 0, M, D); }
        if (lp == LP_GU) save(&dc, stream, tb + T_ACT, ws + WS_GT, K_BF16, DFF, 0, M, DFF);
        if ((lp == LP_NORM1 && l > 0) || ph == PH_FINAL) save(&dc, stream, T_L0 + (ph == PH_FINAL ? 1 : l - 1) * T_PER_L + T_X2, ws + WS_X, K_F32, D, 0, M, D);
    }
    const size_t ooff[13] = {O_YP, O_YS, O_KP, O_VP, O_PP, O_SP, O_WP, O_KS, O_VS, O_PS, O_SS, O_WS, O_END}; const int ocol[12] = {2048, 2048, 256, 256, 512, 1984, 64, 256, 256, 512, 1984, 64};
    for (int i = 0; i < 12; ++i) dbg::save(&dc, stream, dbg::T_OUT0 + i, (float*)d_out + ooff[i], dbg::K_F32, ocol[i], 0, (int)((ooff[i + 1] - ooff[i]) / ocol[i]), ocol[i]);
    nv::In in; for (int i = 0; i < 39; ++i) in.p[i] = (const float*)d_in[i];
    nv::forward(in, (float*)d_out, (float*)d_ws, stream, &dc);
    for (int i = 0; i < 12; ++i) dbg::cmp(&dc, stream, dbg::T_OUT0 + i, (float*)d_out + ooff[i], ocol[i], 0, (int)((ooff[i + 1] - ooff[i]) / ocol[i]), ocol[i]);
#ifndef DBG_WANT_ID
#define DBG_WANT_ID -1
#endif
    dbg::inject<<<1, 1, 0, stream>>>(dc.err, (float*)d_out, (float*)d_out + O_YS, DBG_WANT_ID >= 0 ? dbg::NIDS : dbg::T_N, DBG_WANT_ID);
#else
    a.ph_lo = 0; a.ph_hi = N_PHASES;
    void* kargs[] = {&a};
    const hipError_t e = hipLaunchCooperativeKernel((const void*)mega, dim3(grid), dim3(NTHR), kargs, LDS_BYTES, stream);
    if (e != hipSuccess) fprintf(stderr, "kernel_launch: cooperative launch failed: %s (grid %d)\n", hipGetErrorString(e), grid);
#endif
}
```
